# Optimizing an MI355X kernel written in HIP

```python
import jax, jax.numpy as jnp
from jax import lax
import numpy as np

D_MODEL = 1024
BATCH = 4
SEQ = 4096
DEPTH = 2

MEM_LEN = 256
D_MIX = D_MODEL
HEAD_DIM = 64
SG_WIDTH = D_MIX // 2
SG_GROUPS = SG_WIDTH // HEAD_DIM
SG_CHUNK = 128
NSA_WIDTH = D_MIX - SG_WIDTH
NSA_HEADS = NSA_WIDTH // HEAD_DIM
NSA_KV_HEADS = 2
NSA_GROUP = NSA_HEADS // NSA_KV_HEADS
KV_WIDTH = NSA_KV_HEADS * HEAD_DIM
N_BRANCH = 3
CMP_BLOCK = 32
CMP_STRIDE = 16
CMP_HIDDEN = 256
SLC_BLOCK = 64
SLC_TOPK = 16
WINDOW = 512
Q_BLOCK = 128
FORCE_SCORE = 1e4
IN_COLS = 2 * SG_WIDTH + NSA_WIDTH + 6 * KV_WIDTH + NSA_HEADS * N_BRANCH
MEM_HEADS = 4
MEM_HEAD_DIM = 128
D_FF = 4 * D_MODEL
EPS = 1e-6

kernel_name = "hybrid_sgmlp_nsa_memory_block"


def rms_norm(x, g):
    xf = x.astype(jnp.float32)
    y = xf * lax.rsqrt(jnp.mean(xf * xf, axis=-1, keepdims=True) + EPS)
    return (y * g.astype(jnp.float32)).astype(x.dtype)


def layer_norm(x, g, b):
    xf = x.astype(jnp.float32)
    mu = jnp.mean(xf, axis=-1, keepdims=True)
    xc = xf - mu
    y = xc * lax.rsqrt(jnp.mean(xc * xc, axis=-1, keepdims=True) + EPS)
    return (y * g.astype(jnp.float32) + b.astype(jnp.float32)).astype(x.dtype)


def masked_softmax(s, mask):
    s = jnp.where(mask, s.astype(jnp.float32), -jnp.inf)
    m = jnp.max(s, axis=-1, keepdims=True)
    m = jnp.where(jnp.isfinite(m), m, 0.0)
    e = jnp.exp(s - m)
    d = jnp.sum(e, axis=-1, keepdims=True)
    return e / jnp.where(d > 0, d, 1.0)


def spatial_gating_unit(u, v, ln_g, ln_b, w_s, b_s):
    B, T, _ = u.shape
    v = layer_norm(v, ln_g, ln_b)
    vb = v.reshape(B, T // SG_CHUNK, SG_CHUNK, SG_GROUPS, HEAD_DIM)
    causal = jnp.tril(jnp.ones((SG_CHUNK, SG_CHUNK), dtype=bool))
    w = jnp.where(causal[None], w_s, 0)
    s = jnp.einsum('gts,bcsgd->bctgd', w, vb) + b_s.T[None, None, :, :, None]
    return u * s.reshape(B, T, SG_WIDTH)


def compress_blocks(k, pos, w1, b1, w2, b2):
    B, T, H, d = k.shape
    kc = k.reshape(B, T // CMP_STRIDE, CMP_STRIDE, H, d)
    blocks = jnp.concatenate([kc[:, :-1], kc[:, 1:]], axis=2) + pos[None, None, :, None, :]
    flat = blocks.transpose(0, 1, 3, 2, 4).reshape(B, -1, H, CMP_BLOCK * d)
    h = jax.nn.gelu(flat @ w1 + b1)
    return h @ w2 + b2


def nsa_attention(q, kv, gate_logits, q_norm_g, k_norm_g, cmp_pos, cmp_w1, cmp_b1, cmp_w2, cmp_b2):
    B, T = q.shape[:2]
    H, G, d = NSA_KV_HEADS, NSA_GROUP, HEAD_DIM
    n_cmp = T // CMP_STRIDE - 1
    n_slc = T // SLC_BLOCK
    n_sel = min(SLC_TOPK, n_slc)
    n_qb = T // Q_BLOCK
    scale = HEAD_DIM ** -0.5
    t_pos = jnp.arange(T)

    q = rms_norm(q.reshape(B, T, H, G, d), q_norm_g)
    k_cmp, v_cmp, k_slc, v_slc, k_win, v_win = [
        a.reshape(B, T, H, d) for a in jnp.split(kv, 6, axis=-1)]

    kc = rms_norm(compress_blocks(k_cmp, cmp_pos[0], cmp_w1[0], cmp_b1[0], cmp_w2[0], cmp_b2[0]), k_norm_g[0])
    vc = compress_blocks(v_cmp, cmp_pos[1], cmp_w1[1], cmp_b1[1], cmp_w2[1], cmp_b2[1])
    s_cmp = jnp.einsum('bthgd,bnhd->bhgtn', q, kc) * scale
    cmp_end = jnp.arange(n_cmp) * CMP_STRIDE + CMP_BLOCK - 1
    p_cmp = masked_softmax(s_cmp, cmp_end[None, :] <= t_pos[:, None])
    o_cmp = jnp.einsum('bhgtn,bnhd->bthgd', p_cmp.astype(vc.dtype), vc)

    cs = jnp.arange(n_cmp) * CMP_STRIDE
    ss = jnp.arange(n_slc) * SLC_BLOCK
    overlap = jnp.clip(jnp.minimum(cs[:, None] + CMP_BLOCK, ss[None, :] + SLC_BLOCK)
                       - jnp.maximum(cs[:, None], ss[None, :]), 0, None).astype(jnp.float32) / CMP_BLOCK
    imp = jnp.einsum('bhgtn,nj->bhtj', p_cmp, overlap)
    t_blk = t_pos[:, None] // SLC_BLOCK
    j = jnp.arange(n_slc)[None, :]
    forced = (j == 0) | (j == t_blk) | (j == t_blk - 1)
    imp = jnp.where(forced, FORCE_SCORE, jnp.where(j <= t_blk, imp, -FORCE_SCORE))
    _, sel = lax.top_k(imp, n_sel)

    k_slc = rms_norm(k_slc, k_norm_g[1])
    kb = k_slc.reshape(B, n_slc, SLC_BLOCK, H, d).transpose(0, 3, 1, 2, 4)
    vb = v_slc.reshape(B, n_slc, SLC_BLOCK, H, d).transpose(0, 3, 1, 2, 4)
    qb = q.reshape(B, n_qb, Q_BLOCK, H, G, d).transpose(1, 0, 2, 3, 4, 5)
    sb = sel.reshape(B, H, n_qb, Q_BLOCK, n_sel).transpose(2, 0, 1, 3, 4)
    tb = t_pos.reshape(n_qb, Q_BLOCK)
    bi = jnp.arange(B)[:, None, None, None]
    hi = jnp.arange(H)[None, :, None, None]

    def selected_block(args):
        qc, ic, tc = args
        kg = kb[bi, hi, ic].reshape(B, H, Q_BLOCK, n_sel * SLC_BLOCK, d)
        vg = vb[bi, hi, ic].reshape(B, H, Q_BLOCK, n_sel * SLC_BLOCK, d)
        key_pos = (ic[..., None] * SLC_BLOCK + jnp.arange(SLC_BLOCK)).reshape(B, H, Q_BLOCK, n_sel * SLC_BLOCK)
        mask = (key_pos <= tc[None, None, :, None])[:, :, None]
        s = jnp.einsum('bthgd,bhtmd->bhgtm', qc, kg) * scale
        p = masked_softmax(s, mask)
        return jnp.einsum('bhgtm,bhtmd->bthgd', p.astype(vg.dtype), vg)

    o_slc = lax.map(selected_block, (qb, sb, tb)).transpose(1, 0, 2, 3, 4, 5).reshape(B, T, H, G, d)

    k_win = rms_norm(k_win, k_norm_g[2])
    pad = ((0, 0), (WINDOW, 0), (0, 0), (0, 0))
    kp = jnp.pad(k_win, pad)
    vp = jnp.pad(v_win, pad)
    win_idx = jnp.arange(n_qb)[:, None] * Q_BLOCK + jnp.arange(WINDOW + Q_BLOCK)[None, :]
    kw = kp[:, win_idx]
    vw = vp[:, win_idx]
    qw = q.reshape(B, n_qb, Q_BLOCK, H, G, d)
    s_win = jnp.einsum('bcthgd,bckhd->bhgctk', qw, kw) * scale
    q_abs = tb[:, :, None]
    k_abs = (win_idx - WINDOW)[:, None, :]
    win_mask = (k_abs <= q_abs) & (k_abs > q_abs - WINDOW) & (k_abs >= 0)
    p_win = masked_softmax(s_win, win_mask)
    o_win = jnp.einsum('bhgctk,bckhd->bcthgd', p_win.astype(vw.dtype), vw).reshape(B, T, H, G, d)

    g = jax.nn.sigmoid(gate_logits.astype(jnp.float32)).reshape(B, T, H, G, N_BRANCH).astype(q.dtype)
    o = g[..., 0:1] * o_cmp + g[..., 1:2] * o_slc + g[..., 2:3] * o_win
    return o.reshape(B, T, NSA_WIDTH)


def memory_cross_attention(h, mem, kv_norm_g, w_mq, w_mkv, q_g, k_g, w_mo):
    B, T, _ = h.shape
    M = mem.shape[1]
    q = rms_norm((h @ w_mq).reshape(B, T, MEM_HEADS, MEM_HEAD_DIM), q_g)
    k, v = jnp.split(rms_norm(mem, kv_norm_g) @ w_mkv, 2, axis=-1)
    k = rms_norm(k.reshape(B, M, MEM_HEADS, MEM_HEAD_DIM), k_g)
    v = v.reshape(B, M, MEM_HEADS, MEM_HEAD_DIM)
    s = jnp.einsum('bthd,bmhd->bhtm', q, k) * MEM_HEAD_DIM ** -0.5
    p = jax.nn.softmax(s.astype(jnp.float32), axis=-1).astype(v.dtype)
    o = jnp.einsum('bhtm,bmhd->bthd', p, v).reshape(B, T, MEM_HEADS * MEM_HEAD_DIM)
    return o @ w_mo


def setup_inputs(seed: int = 0) -> dict:
    key = jax.random.key(seed)
    ks = jax.random.split(key, 32)

    def nrm(k, shape, scale):
        return jax.random.normal(k, shape, jnp.float32) * scale

    def gain(k, shape):
        return 1.0 + 0.05 * jax.random.normal(k, shape, jnp.float32)

    L = DEPTH
    return {
        'x': nrm(ks[0], (BATCH, SEQ, D_MODEL), 1.0),
        'mem': nrm(ks[1], (BATCH, MEM_LEN, D_MODEL), 1.0),
        'norm_mix_g': gain(ks[2], (L, D_MODEL)),
        'w_in': nrm(ks[3], (L, D_MODEL, IN_COLS), D_MODEL ** -0.5),
        'sg_ln_g': gain(ks[4], (L, SG_WIDTH)),
        'sg_ln_b': nrm(ks[5], (L, SG_WIDTH), 0.02),
        'sg_w': nrm(ks[6], (L, SG_GROUPS, SG_CHUNK, SG_CHUNK), SG_CHUNK ** -0.5),
        'sg_b': 1.0 + nrm(ks[7], (L, SG_GROUPS, SG_CHUNK), 0.1),
        'q_norm_g': gain(ks[8], (L, HEAD_DIM)),
        'k_norm_g': gain(ks[9], (L, N_BRANCH, HEAD_DIM)),
        'cmp_pos': nrm(ks[10], (L, 2, CMP_BLOCK, HEAD_DIM), 0.5),
        'cmp_w1': nrm(ks[11], (L, 2, CMP_BLOCK * HEAD_DIM, CMP_HIDDEN), (CMP_BLOCK * HEAD_DIM) ** -0.5),
        'cmp_b1': nrm(ks[12], (L, 2, CMP_HIDDEN), 0.02),
        'cmp_w2': nrm(ks[13], (L, 2, CMP_HIDDEN, HEAD_DIM), CMP_HIDDEN ** -0.5),
        'cmp_b2': nrm(ks[14], (L, 2, HEAD_DIM), 0.02),
        'mix_out_g': gain(ks[15], (L, 2, SG_WIDTH)),
        'w_out': nrm(ks[16], (L, D_MIX, D_MODEL), D_MIX ** -0.5),
        'norm_mem_g': gain(ks[17], (L, D_MODEL)),
        'mem_kv_norm_g': gain(ks[18], (L, D_MODEL)),
        'w_mq': nrm(ks[19], (L, D_MODEL, MEM_HEADS * MEM_HEAD_DIM), D_MODEL ** -0.5),
        'w_mkv': nrm(ks[20], (L, D_MODEL, 2 * MEM_HEADS * MEM_HEAD_DIM), D_MODEL ** -0.5),
        'mem_q_norm_g': gain(ks[21], (L, MEM_HEAD_DIM)),
        'mem_k_norm_g': gain(ks[22], (L, MEM_HEAD_DIM)),
        'w_mo': nrm(ks[23], (L, MEM_HEADS * MEM_HEAD_DIM, D_MODEL), (MEM_HEADS * MEM_HEAD_DIM) ** -0.5),
        'norm_ffn_g': gain(ks[24], (L, D_MODEL)),
        'w_ff1': nrm(ks[25], (L, D_MODEL, D_FF), D_MODEL ** -0.5),
        'w_ff2': nrm(ks[26], (L, D_FF, D_MODEL), D_FF ** -0.5),
    }


def reference(x, mem, norm_mix_g, w_in, sg_ln_g, sg_ln_b, sg_w, sg_b, q_norm_g, k_norm_g,
              cmp_pos, cmp_w1, cmp_b1, cmp_w2, cmp_b2, mix_out_g, w_out,
              norm_mem_g, mem_kv_norm_g, w_mq, w_mkv, mem_q_norm_g, mem_k_norm_g, w_mo,
              norm_ffn_g, w_ff1, w_ff2):
    splits = [SG_WIDTH, 2 * SG_WIDTH, 2 * SG_WIDTH + NSA_WIDTH,
              2 * SG_WIDTH + NSA_WIDTH + 6 * KV_WIDTH]
    for l in range(DEPTH):
        h = rms_norm(x, norm_mix_g[l])
        z = h @ w_in[l]
        u, v, q, kv, gl = jnp.split(z, splits, axis=-1)
        a = spatial_gating_unit(jax.nn.gelu(u), jax.nn.gelu(v), sg_ln_g[l], sg_ln_b[l], sg_w[l], sg_b[l])
        b = nsa_attention(q, kv, gl, q_norm_g[l], k_norm_g[l], cmp_pos[l], cmp_w1[l], cmp_b1[l],
                          cmp_w2[l], cmp_b2[l])
        mixed = jnp.concatenate([rms_norm(a, mix_out_g[l, 0]), rms_norm(b, mix_out_g[l, 1])], axis=-1)
        x = x + mixed @ w_out[l]
        x = x + memory_cross_attention(rms_norm(x, norm_mem_g[l]), mem, mem_kv_norm_g[l], w_mq[l],
                                       w_mkv[l], mem_q_norm_g[l], mem_k_norm_g[l], w_mo[l])
        h = rms_norm(x, norm_ffn_g[l])
        x = x + jnp.square(jax.nn.relu(h @ w_ff1[l])) @ w_ff2[l]
    return x
```

```cpp
#include <hip/hip_runtime.h>
#include <stdint.h>
#include <math.h>

namespace nv {
constexpr int Bsz = 4, T = 4096, D = 1024, NTOK = Bsz * T, INC = 2328, MEML = 256;
constexpr float EPS = 1e-6f;

__device__ __forceinline__ float gelu_tanh(float x) { const float k0 = 0.7978845608028654f, k1 = 0.044715f; float u = k0 * (x + k1 * x * x * x); return 0.5f * x * (1.f + tanhf(u)); }
__device__ __forceinline__ float wave_sum(float v) { for (int o = 32; o > 0; o >>= 1) v += __shfl_xor(v, o); return v; }
__device__ __forceinline__ float wave_max(float v) { for (int o = 32; o > 0; o >>= 1) v = fmaxf(v, __shfl_xor(v, o)); return v; }

__global__ void k_rmsnorm(const float* in, long in_stride, float* out, long out_stride, int hpr, int Dn, const float* g, int nrows) {
    int r = blockIdx.x * 4 + (threadIdx.x >> 6); if (r >= nrows) return; int lane = threadIdx.x & 63;
    const float* p = in + (long)(r / hpr) * in_stride + (long)(r % hpr) * Dn; float* q = out + (long)(r / hpr) * out_stride + (long)(r % hpr) * Dn;
    float s = 0.f; for (int i = lane; i < Dn; i += 64) { float v = p[i]; s += v * v; }
    s = wave_sum(s); float rs = rsqrtf(s / Dn + EPS);
    for (int i = lane; i < Dn; i += 64) q[i] = p[i] * rs * g[i];
}
__global__ void k_layernorm(float* io, long stride, int Dn, const float* g, const float* b, int nrows) {
    int r = blockIdx.x * 4 + (threadIdx.x >> 6); if (r >= nrows) return; int lane = threadIdx.x & 63;
    float* p = io + (long)r * stride; float s = 0.f; for (int i = lane; i < Dn; i += 64) s += p[i];
    s = wave_sum(s); float mu = s / Dn; float q = 0.f; for (int i = lane; i < Dn; i += 64) { float d = p[i] - mu; q += d * d; }
    q = wave_sum(q); float rs = rsqrtf(q / Dn + EPS);
    for (int i = lane; i < Dn; i += 64) p[i] = (p[i] - mu) * rs * g[i] + b[i];
}
__global__ void k_gelu_inplace(float* io, long stride, int ncols, int nrows) {
    long i = (long)blockIdx.x * blockDim.x + threadIdx.x; if (i >= (long)nrows * ncols) return; long r = i / ncols; int c = i % ncols; float* p = io + r * stride + c; *p = gelu_tanh(*p);
}
template <int ACT> __global__ void __launch_bounds__(256) k_gemm(const float* A, long lda, const float* Bm, long ldb, float* C, long ldc, const float* bias, int M, int N, int K, int accum) {
    __shared__ float As[16][128 + 4]; __shared__ float Bs[16][128 + 4];
    const int tid = threadIdx.x, tx = tid & 15, ty = tid >> 4; const int m0 = blockIdx.y * 128, n0 = blockIdx.x * 128;
    float acc[8][8];
#pragma unroll
    for (int i = 0; i < 8; ++i)
#pragma unroll
        for (int j = 0; j < 8; ++j) acc[i][j] = 0.f;
    for (int k0 = 0; k0 < K; k0 += 16) {
#pragma unroll
        for (int it = 0; it < 8; ++it) { int i = tid + it * 256; int r = i >> 4, c = i & 15; int gr = m0 + r; As[c][r] = (gr < M) ? A[(long)gr * lda + k0 + c] : 0.f; }
#pragma unroll
        for (int it = 0; it < 8; ++it) { int i = tid + it * 256; int r = i >> 7, c = i & 127; int gc = n0 + c; Bs[r][c] = (gc < N) ? Bm[(long)(k0 + r) * ldb + gc] : 0.f; }
        __syncthreads();
#pragma unroll
        for (int kk = 0; kk < 16; ++kk) { float a[8], b[8];
#pragma unroll
            for (int i = 0; i < 8; ++i) a[i] = As[kk][ty * 8 + i];
#pragma unroll
            for (int j = 0; j < 8; ++j) b[j] = Bs[kk][tx * 8 + j];
#pragma unroll
            for (int i = 0; i < 8; ++i)
#pragma unroll
                for (int j = 0; j < 8; ++j) acc[i][j] += a[i] * b[j]; }
        __syncthreads();
    }
#pragma unroll
    for (int i = 0; i < 8; ++i) { int gr = m0 + ty * 8 + i; if (gr >= M) continue;
#pragma unroll
        for (int j = 0; j < 8; ++j) { int gc = n0 + tx * 8 + j; if (gc >= N) continue; float v = acc[i][j]; if (bias) v += bias[gc];
            if (ACT == 1) v = gelu_tanh(v); if (ACT == 2) { v = fmaxf(v, 0.f); v = v * v; }
            float* p = C + (long)gr * ldc + gc; if (accum) v += *p; *p = v; } }
}
__global__ void k_sgu_mix(const float* z, const float* w, const float* bs, float* out  ) {
    long i = (long)blockIdx.x * blockDim.x + threadIdx.x; if (i >= (long)NTOK * 512) return; int ch = i & 511; long tok = i >> 9; int g = ch >> 6; int tt = tok & 127; long tok0 = tok - tt;
    const float* wr = w + ((long)g * 128 + tt) * 128; float s = 0.f; for (int k = 0; k <= tt; ++k) s += wr[k] * z[(tok0 + k) * INC + 512 + ch];
    s += bs[g * 128 + tt]; out[tok * 1024 + ch] = z[tok * INC + ch] * s;
}
__global__ void k_build_flat(const float* z, int col0, const float* pos, float* flat) {
    long i = (long)blockIdx.x * blockDim.x + threadIdx.x; if (i >= (long)Bsz * 255 * 2 * 2048) return; int pd = i & 2047; long row = i >> 11; int h = row & 1; long bn = row >> 1; int n = bn % 255; int b = bn / 255; int p = pd >> 6, d = pd & 63;
    flat[i] = z[((long)b * T + 16 * n + p) * INC + col0 + h * 64 + d] + pos[p * 64 + d];
}
__global__ void __launch_bounds__(256) k_cmp_attn(const float* z, const float* kc, const float* vc, float* bmix  , unsigned long long* masks) {
    const int t = blockIdx.x, b = blockIdx.y >> 1, hk = blockIdx.y & 1, tid = threadIdx.x, lane = tid & 63, wv = tid >> 6; const long tok = (long)b * T + t;
    __shared__ float qs[4][64]; __shared__ float sc[4][256]; __shared__ float red[4][4]; __shared__ float imp[64]; __shared__ unsigned mk[2];
    qs[wv][lane] = z[tok * INC + 1024 + (hk * 4 + wv) * 64 + lane]; if (tid < 2) mk[tid] = 0u; __syncthreads();
    const int nvalid = (t >= 31) ? (t - 31) / 16 + 1 : 0;
    float s[4] = {-INFINITY, -INFINITY, -INFINITY, -INFINITY};
    if (tid < nvalid) { const float* kr = kc + (((long)b * 255 + tid) * 2 + hk) * 64; float a0 = 0, a1 = 0, a2 = 0, a3 = 0; for (int d = 0; d < 64; ++d) { float kv = kr[d]; a0 += qs[0][d] * kv; a1 += qs[1][d] * kv; a2 += qs[2][d] * kv; a3 += qs[3][d] * kv; }
        s[0] = a0 * 0.125f; s[1] = a1 * 0.125f; s[2] = a2 * 0.125f; s[3] = a3 * 0.125f; }
    for (int g = 0; g < 4; ++g) { float m = wave_max(s[g]); if (lane == 0) red[g][wv] = m; } __syncthreads();
    float e[4];
    for (int g = 0; g < 4; ++g) { float m = fmaxf(fmaxf(red[g][0], red[g][1]), fmaxf(red[g][2], red[g][3])); if (!(m > -INFINITY)) m = 0.f; e[g] = (tid < nvalid) ? expf(s[g] - m) : 0.f; } __syncthreads();
    for (int g = 0; g < 4; ++g) { float q = wave_sum(e[g]); if (lane == 0) red[g][wv] = q; } __syncthreads();
    for (int g = 0; g < 4; ++g) { float dsum = red[g][0] + red[g][1] + red[g][2] + red[g][3]; sc[g][tid] = e[g] / (dsum > 0.f ? dsum : 1.f); } __syncthreads();
    if (tid < 64) { const int j = tid; float v = 0.f; for (int g = 0; g < 4; ++g) { for (int r = 0; r < 3; ++r) { int n = 4 * j + r; if (n < 255) v += sc[g][n]; } if (4 * j + 3 < 255) v += 0.5f * sc[g][4 * j + 3]; if (j > 0) v += 0.5f * sc[g][4 * j - 1]; }
        const int tb = t >> 6; const bool forced = (j == 0) || (j == tb) || (j == tb - 1); imp[j] = forced ? 1e4f : (j <= tb ? v : -1e4f); } __syncthreads();
    if (tid < 64) { const int j = tid; const float v = imp[j]; int rank = 0; for (int k = 0; k < 64; ++k) { float o = imp[k]; rank += (o > v) || (o == v && k < j); } if (rank < 16) atomicOr(&mk[j >> 5], 1u << (j & 31)); } __syncthreads();
    if (tid == 0) masks[tok * 2 + hk] = ((unsigned long long)mk[1] << 32) | mk[0];
    { const int g = wv, d = lane; float o = 0.f; for (int n = 0; n < nvalid; ++n) o += sc[g][n] * vc[(((long)b * 255 + n) * 2 + hk) * 64 + d];
      const float gl = z[tok * INC + 2304 + (hk * 4 + g) * 3 + 0]; bmix[tok * 1024 + (hk * 4 + g) * 64 + d] = o / (1.f + expf(-gl)); }
}
__global__ void __launch_bounds__(256) k_slc_attn(const float* z, const unsigned long long* masks, float* bmix) {
    const int t = blockIdx.x, b = blockIdx.y >> 1, hk = blockIdx.y & 1, tid = threadIdx.x, lane = tid & 63, g = tid >> 6; const long tok = (long)b * T + t;
    __shared__ float qs[4][64]; __shared__ float sc[4][1024]; __shared__ int blk[16];
    qs[g][lane] = z[tok * INC + 1024 + (hk * 4 + g) * 64 + lane];
    const unsigned long long m = masks[tok * 2 + hk]; const int tb = t >> 6; int nsel = 0; for (int j = 0; j <= tb; ++j) if ((m >> j) & 1ull) { if (tid == 0) blk[nsel] = j; ++nsel; }
    __syncthreads();
    const int kcol = 1536 + 256 + hk * 64, vcol = 1536 + 384 + hk * 64;
    float mx = -INFINITY;
    for (int sidx = 0; sidx < nsel; ++sidx) { const int kp = blk[sidx] * 64 + lane; float s = -INFINITY; if (kp <= t) { const float* kr = z + ((long)b * T + kp) * INC + kcol; float a = 0.f; for (int d = 0; d < 64; ++d) a += qs[g][d] * kr[d]; s = a * 0.125f; } sc[g][sidx * 64 + lane] = s; mx = fmaxf(mx, s); }
    mx = wave_max(mx); float sum = 0.f;
    for (int sidx = 0; sidx < nsel; ++sidx) { float s = sc[g][sidx * 64 + lane]; float e = (s > -INFINITY) ? expf(s - mx) : 0.f; sc[g][sidx * 64 + lane] = e; sum += e; }
    sum = wave_sum(sum); const float inv = 1.f / (sum > 0.f ? sum : 1.f); __syncthreads();
    float o = 0.f; for (int sidx = 0; sidx < nsel; ++sidx) { const long base = ((long)b * T + blk[sidx] * 64) * INC + vcol + lane; for (int i = 0; i < 64; ++i) o += sc[g][sidx * 64 + i] * z[base + (long)i * INC]; }
    const float gl = z[tok * INC + 2304 + (hk * 4 + g) * 3 + 1]; bmix[tok * 1024 + (hk * 4 + g) * 64 + lane] += (o * inv) / (1.f + expf(-gl));
}
__global__ void __launch_bounds__(256) k_win_attn(const float* z, float* bmix) {
    const int t = blockIdx.x, b = blockIdx.y >> 1, hk = blockIdx.y & 1, tid = threadIdx.x, lane = tid & 63, g = tid >> 6; const long tok = (long)b * T + t;
    __shared__ float qs[4][64]; __shared__ float sc[4][512];
    qs[g][lane] = z[tok * INC + 1024 + (hk * 4 + g) * 64 + lane]; __syncthreads();
    const int kcol = 1536 + 512 + hk * 64, vcol = 1536 + 640 + hk * 64; const int k0 = t - 511;
    float mx = -INFINITY;
    for (int i = lane; i < 512; i += 64) { const int kp = k0 + i; float s = -INFINITY; if (kp >= 0) { const float* kr = z + ((long)b * T + kp) * INC + kcol; float a = 0.f; for (int d = 0; d < 64; ++d) a += qs[g][d] * kr[d]; s = a * 0.125f; } sc[g][i] = s; mx = fmaxf(mx, s); }
    mx = wave_max(mx); float sum = 0.f;
    for (int i = lane; i < 512; i += 64) { float s = sc[g][i]; float e = (s > -INFINITY) ? expf(s - mx) : 0.f; sc[g][i] = e; sum += e; }
    sum = wave_sum(sum); const float inv = 1.f / (sum > 0.f ? sum : 1.f); __syncthreads();
    float o = 0.f; for (int i = 0; i < 512; ++i) { const int kp = k0 + i; if (kp >= 0) o += sc[g][i] * z[((long)b * T + kp) * INC + vcol + lane]; }
    const float gl = z[tok * INC + 2304 + (hk * 4 + g) * 3 + 2]; bmix[tok * 1024 + (hk * 4 + g) * 64 + lane] += (o * inv) / (1.f + expf(-gl));
}
__global__ void __launch_bounds__(256) k_mem_attn(const float* qm, const float* kvm, float* om) {
    const long tok = blockIdx.x; const int b = tok / T, tid = threadIdx.x, lane = tid & 63, h = tid >> 6;
    __shared__ float qs[4][128]; __shared__ float sc[4][256];
    qs[h][lane] = qm[tok * 512 + h * 128 + lane]; qs[h][lane + 64] = qm[tok * 512 + h * 128 + 64 + lane]; __syncthreads();
    const float scale = 0.08838834764831845f; float mx = -INFINITY;
    for (int i = lane; i < 256; i += 64) { const float* kr = kvm + ((long)b * 256 + i) * 1024 + h * 128; float a = 0.f; for (int d = 0; d < 128; ++d) a += qs[h][d] * kr[d]; a *= scale; sc[h][i] = a; mx = fmaxf(mx, a); }
    mx = wave_max(mx); float sum = 0.f; for (int i = lane; i < 256; i += 64) { float e = expf(sc[h][i] - mx); sc[h][i] = e; sum += e; } sum = wave_sum(sum); __syncthreads();
    for (int dd = 0; dd < 2; ++dd) { const int d = lane + dd * 64; float o = 0.f; for (int i = 0; i < 256; ++i) o += sc[h][i] * kvm[((long)b * 256 + i) * 1024 + 512 + h * 128 + d]; om[tok * 512 + h * 128 + d] = o / sum; }
}
}

extern "C" void kernel_launch(void* const* d_in, const int* in_sizes, int n_in, void* d_out, int out_size, void* d_ws, size_t ws_size, hipStream_t stream) {
    using namespace nv;
    const float* x_in = (const float*)d_in[0]; const float* mem = (const float*)d_in[1];
    const float* norm_mix_g = (const float*)d_in[2]; const float* w_in = (const float*)d_in[3]; const float* sg_ln_g = (const float*)d_in[4]; const float* sg_ln_b = (const float*)d_in[5];
    const float* sg_w = (const float*)d_in[6]; const float* sg_b = (const float*)d_in[7]; const float* q_norm_g = (const float*)d_in[8]; const float* k_norm_g = (const float*)d_in[9];
    const float* cmp_pos = (const float*)d_in[10]; const float* cmp_w1 = (const float*)d_in[11]; const float* cmp_b1 = (const float*)d_in[12]; const float* cmp_w2 = (const float*)d_in[13]; const float* cmp_b2 = (const float*)d_in[14];
    const float* mix_out_g = (const float*)d_in[15]; const float* w_out = (const float*)d_in[16]; const float* norm_mem_g = (const float*)d_in[17]; const float* mem_kv_norm_g = (const float*)d_in[18];
    const float* w_mq = (const float*)d_in[19]; const float* w_mkv = (const float*)d_in[20]; const float* mem_q_norm_g = (const float*)d_in[21]; const float* mem_k_norm_g = (const float*)d_in[22]; const float* w_mo = (const float*)d_in[23];
    const float* norm_ffn_g = (const float*)d_in[24]; const float* w_ff1 = (const float*)d_in[25]; const float* w_ff2 = (const float*)d_in[26];
    float* x = (float*)d_out; float* ws = (float*)d_ws;
    float* hn = ws;
    float* z = hn + (size_t)NTOK * 1024;
    float* flat = z + (size_t)NTOK * INC;
    float* hid = flat + (size_t)2040 * 2048;
    float* kc = hid + (size_t)2040 * 256;
    float* vc = kc + (size_t)2040 * 64;
    float* memn = vc + (size_t)2040 * 64;
    float* kvm = memn + (size_t)1024 * 1024;
    unsigned long long* masks = (unsigned long long*)(kvm + (size_t)1024 * 1024);
    hipMemcpyAsync(x, x_in, (size_t)NTOK * 1024 * 4, hipMemcpyDeviceToDevice, stream);
    auto gemm = [&](int act, const float* A, long lda, const float* Bm, long ldb, float* C, long ldc, const float* bias, int M, int N, int K, int accum) {
        dim3 grid((N + 127) / 128, (M + 127) / 128);
        if (act == 0) k_gemm<0><<<grid, 256, 0, stream>>>(A, lda, Bm, ldb, C, ldc, bias, M, N, K, accum);
        else if (act == 1) k_gemm<1><<<grid, 256, 0, stream>>>(A, lda, Bm, ldb, C, ldc, bias, M, N, K, accum);
        else k_gemm<2><<<grid, 256, 0, stream>>>(A, lda, Bm, ldb, C, ldc, bias, M, N, K, accum); };
    auto rms = [&](const float* in, long is, float* out, long os, int hpr, int Dn, const float* g, int nrows) { k_rmsnorm<<<(nrows + 3) / 4, 256, 0, stream>>>(in, is, out, os, hpr, Dn, g, nrows); };
    for (int l = 0; l < 2; ++l) {
        rms(x, 1024, hn, 1024, 1, 1024, norm_mix_g + l * 1024, NTOK);
        gemm(0, hn, 1024, w_in + (size_t)l * 1024 * INC, INC, z, INC, nullptr, NTOK, INC, 1024, 0);
        k_gelu_inplace<<<(NTOK * 1024 + 255) / 256, 256, 0, stream>>>(z, INC, 1024, NTOK);
        k_layernorm<<<NTOK / 4, 256, 0, stream>>>(z + 512, INC, 512, sg_ln_g + l * 512, sg_ln_b + l * 512, NTOK);
        float* mixed = hn;
        k_sgu_mix<<<(NTOK * 512) / 256, 256, 0, stream>>>(z, sg_w + (size_t)l * 8 * 128 * 128, sg_b + l * 8 * 128, mixed);
        rms(z + 1024, INC, z + 1024, INC, 8, 64, q_norm_g + l * 64, NTOK * 8);
        rms(z + 1536 + 256, INC, z + 1536 + 256, INC, 2, 64, k_norm_g + (l * 3 + 1) * 64, NTOK * 2);
        rms(z + 1536 + 512, INC, z + 1536 + 512, INC, 2, 64, k_norm_g + (l * 3 + 2) * 64, NTOK * 2);
        for (int kv = 0; kv < 2; ++kv) {
            k_build_flat<<<(Bsz * 255 * 2 * 2048 + 255) / 256, 256, 0, stream>>>(z, 1536 + kv * 128, cmp_pos + (size_t)(l * 2 + kv) * 32 * 64, flat);
            gemm(1, flat, 2048, cmp_w1 + (size_t)(l * 2 + kv) * 2048 * 256, 256, hid, 256, cmp_b1 + (l * 2 + kv) * 256, 2040, 256, 2048, 0);
            float* dst = kv ? vc : kc;
            gemm(0, hid, 256, cmp_w2 + (size_t)(l * 2 + kv) * 256 * 64, 64, dst, 64, cmp_b2 + (l * 2 + kv) * 64, 2040, 64, 256, 0);
            if (kv == 0) rms(kc, 64, kc, 64, 1, 64, k_norm_g + (l * 3 + 0) * 64, 2040);
        }
        k_cmp_attn<<<dim3(T, Bsz * 2), 256, 0, stream>>>(z, kc, vc, mixed + 512, masks);
        k_slc_attn<<<dim3(T, Bsz * 2), 256, 0, stream>>>(z, masks, mixed + 512);
        k_win_attn<<<dim3(T, Bsz * 2), 256, 0, stream>>>(z, mixed + 512);
        rms(mixed, 1024, mixed, 1024, 1, 512, mix_out_g + (l * 2 + 0) * 512, NTOK);
        rms(mixed + 512, 1024, mixed + 512, 1024, 1, 512, mix_out_g + (l * 2 + 1) * 512, NTOK);
        gemm(0, mixed, 1024, w_out + (size_t)l * 1024 * 1024, 1024, x, 1024, nullptr, NTOK, 1024, 1024, 1);
        float* qm = z; float* om = z + (size_t)NTOK * 512;
        rms(x, 1024, hn, 1024, 1, 1024, norm_mem_g + l * 1024, NTOK);
        gemm(0, hn, 1024, w_mq + (size_t)l * 1024 * 512, 512, qm, 512, nullptr, NTOK, 512, 1024, 0);
        rms(qm, 512, qm, 512, 4, 128, mem_q_norm_g + l * 128, NTOK * 4);
        rms(mem, 1024, memn, 1024, 1, 1024, mem_kv_norm_g + l * 1024, Bsz * MEML);
        gemm(0, memn, 1024, w_mkv + (size_t)l * 1024 * 1024, 1024, kvm, 1024, nullptr, Bsz * MEML, 1024, 1024, 0);
        rms(kvm, 1024, kvm, 1024, 4, 128, mem_k_norm_g + l * 128, Bsz * MEML * 4);
        k_mem_attn<<<NTOK, 256, 0, stream>>>(qm, kvm, om);
        gemm(0, om, 512, w_mo + (size_t)l * 512 * 1024, 1024, x, 1024, nullptr, NTOK, 1024, 512, 1);
        rms(x, 1024, hn, 1024, 1, 1024, norm_ffn_g + l * 1024, NTOK);
        for (int c = 0; c < 4; ++c) { float* hch = z;
            gemm(2, hn + (size_t)c * 4096 * 1024, 1024, w_ff1 + (size_t)l * 1024 * 4096, 4096, hch, 4096, nullptr, 4096, 4096, 1024, 0);
            gemm(0, hch, 4096, w_ff2 + (size_t)l * 4096 * 1024, 1024, x + (size_t)c * 4096 * 1024, 1024, nullptr, 4096, 1024, 4096, 1); }
    }
}
```

```cpp
#include <hip/hip_runtime.h>
#include <stdint.h>
#include <math.h>

namespace pg8 {
#define PG8_LAS __attribute__((address_space(3)))
typedef unsigned short bf16_t;
typedef short bf16x8 __attribute__((ext_vector_type(8)));
typedef float f32x4 __attribute__((ext_vector_type(4)));
typedef float f32x2 __attribute__((ext_vector_type(2)));
typedef unsigned u32x4 __attribute__((ext_vector_type(4)));
typedef unsigned u32x2 __attribute__((ext_vector_type(2)));
constexpr int BM = 256, BK = 64, HALF = 128, HTB = HALF * BK * 2, STAGE_BYTES = 8 * HTB, NXCD = 8, WGM = 8;

__host__ __device__ __forceinline__ int lds_byte(int r, int c) { const int st = (r >> 4) * 2 + (c >> 5), rr = r & 15, cc = c & 31, ob = rr * 64 + cc * 2; return st * 1024 + (ob ^ (((ob >> 9) & 1) << 5)); }
__host__ __device__ __forceinline__ void stage_rc(int b, int& R, int& C) { const int st = b / 1024, sb = b % 1024, swz = sb ^ (((sb >> 9) & 1) << 5); R = (st >> 1) * 16 + swz / 64; C = (st & 1) * 32 + (swz % 64) / 2; }
__host__ __device__ __forceinline__ int perm32(int rho) { const int n = rho >> 4, i = rho & 15; return 8 * (i >> 2) + 4 * n + (i & 3); }

struct Unit { int pm, pn; };
struct Gemm { const bf16_t* A; const bf16_t* Bt; int K; int lda; int kstepA; size_t a_s0, a_s1; };
__device__ __forceinline__ Gemm make_gemm(const bf16_t* A, const bf16_t* Bt, int K) { Gemm g; g.A = A; g.Bt = Bt; g.K = K; g.lda = K; g.kstepA = BK * 2; g.a_s0 = (size_t)BM * K * 2; g.a_s1 = 2 * g.a_s0; return g; }

struct StaticOrder {
    int nM, nN, nwg, G, c;
    __device__ void init(int M, int N, int G_, int c_) { nM = M / BM; nN = N / BM; nwg = nM * nN; G = G_; c = c_; }
    __device__ bool next(int i, Unit& u) const {
        const long L = (long)i * G + c; if (L >= nwg) return false;
        int wgid = (int)L; { const int q = nwg / NXCD, r = nwg % NXCD, xcd = wgid % NXCD, off = wgid / NXCD; wgid = (xcd < r ? xcd * (q + 1) : r * (q + 1) + (xcd - r) * q) + off; }
        const int nig = WGM * nN, gid = wgid / nig, fm = gid * WGM, gsz = (nM - fm) < WGM ? (nM - fm) : WGM;
        u.pm = fm + ((wgid % nig) % gsz); u.pn = (wgid % nig) / gsz; return true;
    }
};
struct OneUnit { int has; Unit u; __device__ bool next(int i, Unit& o) const { if (i > 0 || !has) return false; o = u; return true; } };

__device__ __forceinline__ unsigned cvt_pk_bf16(float lo, float hi) { unsigned r; asm volatile("v_cvt_pk_bf16_f32 %0, %1, %2" : "=v"(r) : "v"(lo), "v"(hi)); return r; }
__device__ __forceinline__ float gelu_tanh(float x) { const float u = 0.7978845608028654f * (x + 0.044715f * x * x * x); const float e = __builtin_amdgcn_exp2f(-2.885390081777927f * u); return x * __builtin_amdgcn_rcpf(1.f + e); }

template <int ACT  > struct EpiBf16G {
    static constexpr bool PERM = true, AFTER_DRAIN = false;
    bf16_t* O; int ldc; const float* bias; const float* ssq; float inv_n;
    __device__ __forceinline__ void operator()(const f32x4 (&acc)[2][2][4][2], const Unit& u, int wr, int wc, int fr, int fq) const {
        const int row0 = u.pm * BM + wr * 64 + fr, col0 = u.pn * BM + wc * 32 + 8 * fq;
        f32x4 bv[2][2];
#pragma unroll
        for (int bj = 0; bj < 2; ++bj)
#pragma unroll
            for (int n = 0; n < 2; ++n) bv[bj][n] = bias ? *(const f32x4*)(bias + col0 + bj * HALF + 4 * n) : (f32x4){0.f, 0.f, 0.f, 0.f};
#pragma unroll
        for (int ai = 0; ai < 2; ++ai)
#pragma unroll
            for (int m = 0; m < 4; ++m) { const int row = row0 + ai * HALF + m * 16; const float rs = ssq ? rsqrtf(ssq[row] * inv_n + 1e-6f) : 1.f; bf16_t* rowp = O + (size_t)row * ldc + col0;
#pragma unroll
                for (int bj = 0; bj < 2; ++bj) { f32x4 v0 = (acc[ai][bj][m][0] + bv[bj][0]) * rs, v1 = (acc[ai][bj][m][1] + bv[bj][1]) * rs;
                    if (ACT == 1) {
#pragma unroll
                        for (int e = 0; e < 4; ++e) { v0[e] = gelu_tanh(v0[e]); v1[e] = gelu_tanh(v1[e]); } }
                    if (ACT == 2) {
#pragma unroll
                        for (int e = 0; e < 4; ++e) { float a = fmaxf(v0[e], 0.f), b = fmaxf(v1[e], 0.f); v0[e] = a * a; v1[e] = b * b; } }
                    u32x4 w; w.x = cvt_pk_bf16(v0[0], v0[1]); w.y = cvt_pk_bf16(v0[2], v0[3]); w.z = cvt_pk_bf16(v1[0], v1[1]); w.w = cvt_pk_bf16(v1[2], v1[3]);
                    *(u32x4*)(rowp + bj * HALF) = w; } }
    }
};
struct EpiInProj {
    static constexpr bool PERM = true, AFTER_DRAIN = false;
    bf16_t *U, *V, *Q, *KV; float* GL; const float* ssq;
    __device__ __forceinline__ void operator()(const f32x4 (&acc)[2][2][4][2], const Unit& u, int wr, int wc, int fr, int fq) const {
        const int row0 = u.pm * BM + wr * 64 + fr, cit0 = wc * 32 + 8 * fq; const int pn = u.pn;
        bf16_t* base; int ldc, cofs; bool act = false;
        if (pn < 2) { base = U; ldc = 512; cofs = pn * 256; act = true; } else if (pn < 4) { base = V; ldc = 512; cofs = (pn - 2) * 256; act = true; }
        else if (pn < 6) { base = Q; ldc = 512; cofs = (pn - 4) * 256; } else { base = KV; ldc = 768; cofs = (pn - 6) * 256; }
#pragma unroll
        for (int ai = 0; ai < 2; ++ai)
#pragma unroll
            for (int m = 0; m < 4; ++m) { const int row = row0 + ai * HALF + m * 16; const float rs = rsqrtf(ssq[row] * (1.f / 1024.f) + 1e-6f);
#pragma unroll
                for (int bj = 0; bj < 2; ++bj) { f32x4 v0 = acc[ai][bj][m][0] * rs, v1 = acc[ai][bj][m][1] * rs; const int cit = cit0 + bj * HALF;
                    if (pn == 9) { if (cit < 24) { *(f32x4*)(GL + (size_t)row * 24 + cit) = v0; *(f32x4*)(GL + (size_t)row * 24 + cit + 4) = v1; } }
                    else { if (act) {
#pragma unroll
                            for (int e = 0; e < 4; ++e) { v0[e] = gelu_tanh(v0[e]); v1[e] = gelu_tanh(v1[e]); } }
                        u32x4 w; w.x = cvt_pk_bf16(v0[0], v0[1]); w.y = cvt_pk_bf16(v0[2], v0[3]); w.z = cvt_pk_bf16(v1[0], v1[1]); w.w = cvt_pk_bf16(v1[2], v1[3]);
                        *(u32x4*)(base + (size_t)row * ldc + cofs + cit) = w; } } }
    }
};
struct EpiResid {
    static constexpr bool PERM = false, AFTER_DRAIN = false;
    float* X; bf16_t* XB; float* ssq;
    __device__ __forceinline__ void operator()(const f32x4 (&acc)[2][2][4][2], const Unit& u, int wr, int wc, int fr, int fq) const {
        const int col0 = u.pn * BM + wc * 32 + 4 * fq;
#pragma unroll
        for (int ai = 0; ai < 2; ++ai)
#pragma unroll
            for (int m = 0; m < 4; ++m) { const int row = u.pm * BM + ai * HALF + wr * 64 + m * 16 + fr; float sq = 0.f;
#pragma unroll
                for (int bj = 0; bj < 2; ++bj)
#pragma unroll
                    for (int n = 0; n < 2; ++n) { const size_t off = (size_t)row * 1024 + col0 + bj * HALF + n * 16; f32x4 xv = *(const f32x4*)(X + off); xv = xv + acc[ai][bj][m][n]; *(f32x4*)(X + off) = xv;
                        if (XB) { sq += (xv[0] * xv[0] + xv[1] * xv[1]) + (xv[2] * xv[2] + xv[3] * xv[3]); u32x2 w; w.x = cvt_pk_bf16(xv[0], xv[1]); w.y = cvt_pk_bf16(xv[2], xv[3]); *(u32x2*)(XB + off) = w; } }
                if (XB) { sq += __shfl_xor(sq, 16); sq += __shfl_xor(sq, 32); if (fq == 0) atomicAdd(ssq + row, sq); } }
    }
};

template <class Epi, class Sched, bool ALIGN_EPI>
__device__ __forceinline__ void gemm_phase(PG8_LAS unsigned char* lds, const Gemm g, const Sched& S, const Epi& E) {
    int tid_ = threadIdx.x; asm volatile("" : "+v"(tid_));
    const int tid = tid_, wid = __builtin_amdgcn_readfirstlane(tid >> 6), lane = tid & 63, wr = wid >> 2, wc = wid & 3, fr = lane & 15, fq = lane >> 4;
    const int K = g.K, nt = K / BK;
    unsigned voffA[2], voffB[2];
#pragma unroll
    for (int i = 0; i < 2; ++i) { int R, C; stage_rc(tid * 16 + i * 8192, R, C); const int Rb = Epi::PERM ? ((R & ~31) + perm32(R & 31)) : R;
        voffA[i] = (unsigned)(R * g.lda + C) * 2u; voffB[i] = (unsigned)(Rb * K + C) * 2u; }
    const size_t kstepA = (size_t)g.kstepA, kstepB = (size_t)(BK * 2);
    const size_t hstepA = (size_t)HALF * g.lda * 2, hstepB = (size_t)HALF * K * 2, tstepB = 2 * hstepB;
    const unsigned ldsw = (unsigned)wid * 1024u;
    const int aoff = lds_byte(wr * 64 + fr, fq * 8), boff = lds_byte(wc * 32 + fr, fq * 8);
#define PG8_ABASE(pm) ((const char*)g.A + (size_t)((pm) >> 1) * g.a_s1 + (size_t)((pm) & 1) * g.a_s0)
#define PG8_SA(b, h) (((b) * 2 + (h)) * HTB)
#define PG8_SB(b, h) ((4 + (b) * 2 + (h)) * HTB)
#define PG8_STAGE(bufoff, gbase, voff) do { _Pragma("unroll") for (int _i = 0; _i < 2; ++_i) \
        __builtin_amdgcn_global_load_lds((const unsigned*)((const char*)(gbase) + (voff)[_i]), (PG8_LAS unsigned*)(lds + (bufoff) + ldsw + _i * 8192), 16, 0, 0); } while (0)
#define PG8_LDA(dst, b, h) do { _Pragma("unroll") for (int m = 0; m < 4; ++m) _Pragma("unroll") for (int k = 0; k < 2; ++k) dst[m][k] = *(const PG8_LAS bf16x8*)(lds + PG8_SA(b, h) + aoff + m * 2048 + k * 1024); } while (0)
#define PG8_LDB(dst, b, h) do { _Pragma("unroll") for (int n = 0; n < 2; ++n) _Pragma("unroll") for (int k = 0; k < 2; ++k) dst[n][k] = *(const PG8_LAS bf16x8*)(lds + PG8_SB(b, h) + boff + n * 2048 + k * 1024); } while (0)
#define PG8_MMA(ai, bj, At, Bt) do { __builtin_amdgcn_s_setprio(1); _Pragma("unroll") for (int m = 0; m < 4; ++m) _Pragma("unroll") for (int n = 0; n < 2; ++n) _Pragma("unroll") for (int k = 0; k < 2; ++k) \
        acc[ai][bj][m][n] = __builtin_amdgcn_mfma_f32_16x16x32_bf16(Bt[n][k], At[m][k], acc[ai][bj][m][n], 0, 0, 0); __builtin_amdgcn_s_setprio(0); } while (0)
#define PG8_WAIT_V(n) asm volatile("s_waitcnt vmcnt(" #n ")" ::: "memory")
#define PG8_WAIT_L(n) asm volatile("s_waitcnt lgkmcnt(" #n ")" ::: "memory")
#define PG8_BAR __builtin_amdgcn_s_barrier()
#define PG8_SCHED __builtin_amdgcn_sched_barrier(0)
    Unit cur, nxt; int ui = 0;
    if (!S.next(0, cur)) return;
    f32x4 acc[2][2][4][2];
#pragma unroll
    for (int a = 0; a < 2; ++a)
#pragma unroll
        for (int b = 0; b < 2; ++b)
#pragma unroll
            for (int m = 0; m < 4; ++m)
#pragma unroll
                for (int n = 0; n < 2; ++n) acc[a][b][m][n] = (f32x4){0.f, 0.f, 0.f, 0.f};
    bf16x8 At[4][2], B0[2][2], B1[2][2];
    const char* cA = PG8_ABASE(cur.pm); const char* cB = (const char*)g.Bt + (size_t)cur.pn * tstepB;
    PG8_STAGE(PG8_SB(0, 0), cB, voffB); PG8_STAGE(PG8_SB(0, 1), cB + hstepB, voffB); PG8_STAGE(PG8_SA(0, 0), cA, voffA); PG8_STAGE(PG8_SA(0, 1), cA + hstepA, voffA);
    if (wr == 1) PG8_BAR;
    PG8_WAIT_V(2); PG8_BAR;
    PG8_STAGE(PG8_SB(1, 0), cB + kstepB, voffB); PG8_STAGE(PG8_SA(1, 0), cA + kstepA, voffA); PG8_STAGE(PG8_SB(1, 1), cB + hstepB + kstepB, voffB);
    PG8_WAIT_V(6); PG8_BAR;
    for (;;) {
        const bool has_next = S.next(ui + 1, nxt);
        const char* nA = has_next ? PG8_ABASE(nxt.pm) : cA; const char* nB = has_next ? (const char*)g.Bt + (size_t)nxt.pn * tstepB : cB;
        for (int t = 0; t < nt; t += 2) {
            const bool last = (t == nt - 2);
            const char* a1 = cA + (size_t)(t + 1) * kstepA;
            const char* a2 = last ? nA : cA + (size_t)(t + 2) * kstepA; const char* b2 = last ? nB : cB + (size_t)(t + 2) * kstepB;
            const char* a3 = a2 + kstepA; const char* b3 = b2 + kstepB;
            PG8_LDB(B0, 0, 0); PG8_LDB(B1, 0, 1); PG8_SCHED; PG8_LDA(At, 0, 0); PG8_STAGE(PG8_SA(1, 1), a1 + hstepA, voffA);
            PG8_WAIT_V(8); PG8_WAIT_L(0); PG8_BAR; PG8_MMA(0, 0, At, B0); PG8_MMA(0, 1, At, B1); PG8_BAR; PG8_SCHED;
            PG8_LDA(At, 0, 1); PG8_STAGE(PG8_SB(0, 0), b2, voffB); PG8_STAGE(PG8_SB(0, 1), b2 + hstepB, voffB); PG8_STAGE(PG8_SA(0, 0), a2, voffA);
            PG8_WAIT_V(8); PG8_WAIT_L(0); PG8_BAR; PG8_MMA(1, 0, At, B0); PG8_MMA(1, 1, At, B1); PG8_BAR; PG8_SCHED;
            PG8_LDB(B0, 1, 0); PG8_LDB(B1, 1, 1); PG8_SCHED; PG8_LDA(At, 1, 0); PG8_STAGE(PG8_SA(0, 1), a2 + hstepA, voffA);
            PG8_WAIT_V(8); PG8_WAIT_L(0); PG8_BAR; PG8_MMA(0, 0, At, B0); PG8_MMA(0, 1, At, B1); PG8_BAR; PG8_SCHED;
            PG8_LDA(At, 1, 1); PG8_STAGE(PG8_SB(1, 0), b3, voffB); PG8_STAGE(PG8_SB(1, 1), b3 + hstepB, voffB); PG8_STAGE(PG8_SA(1, 0), a3, voffA);
            PG8_WAIT_V(8); PG8_WAIT_L(0); PG8_BAR; PG8_MMA(1, 0, At, B0); PG8_MMA(1, 1, At, B1); PG8_BAR; PG8_SCHED;
        }
        if constexpr (ALIGN_EPI) { if (wr == 0) PG8_BAR; }
        if constexpr (!Epi::AFTER_DRAIN) { E(acc, cur, wr, wc, fr, fq); }
        if (!has_next) break;
#pragma unroll
        for (int a = 0; a < 2; ++a)
#pragma unroll
            for (int b = 0; b < 2; ++b)
#pragma unroll
                for (int m = 0; m < 4; ++m)
#pragma unroll
                    for (int n = 0; n < 2; ++n) acc[a][b][m][n] = (f32x4){0.f, 0.f, 0.f, 0.f};
        cur = nxt; cA = nA; cB = nB; ++ui;
        if constexpr (ALIGN_EPI) { if (wr == 1) PG8_BAR; }
    }
    PG8_WAIT_V(0);
    if constexpr (!ALIGN_EPI) { if (wr == 0) PG8_BAR; }
    PG8_BAR;
    if constexpr (Epi::AFTER_DRAIN) { E.fused(acc, cur, wr, wc, fr, fq, lds, wid, lane); }
#undef PG8_ABASE
#undef PG8_SA
#undef PG8_SB
#undef PG8_STAGE
#undef PG8_LDA
#undef PG8_LDB
#undef PG8_MMA
#undef PG8_WAIT_V
#undef PG8_WAIT_L
#undef PG8_BAR
#undef PG8_SCHED
}
}

namespace mk {
using pg8::bf16_t; using pg8::f32x4; using pg8::u32x4; using pg8::u32x2; using pg8::cvt_pk_bf16;
#define LAS __attribute__((address_space(3)))
constexpr int NB = 4, T = 4096, D = 1024, NTOK = NB * T, INC = 2328, INP = 2560, FF = 4096;
constexpr size_t MiB = 1u << 20;
constexpr size_t WS_CTL = 0;
constexpr size_t WS_W = 1 * MiB, W_LAYER = 30 * MiB;
constexpr size_t W_IN = 0, W_OUT = 5 * MiB, W_MQ = 7 * MiB, W_MKV = 8 * MiB, W_MO = 10 * MiB, W_FF1 = 11 * MiB, W_FF2 = 19 * MiB, W_C1 = 27 * MiB, W_C2 = 29 * MiB, W_SG = 29 * MiB + 128 * 1024, W_B1P = 29 * MiB + 512 * 1024;
constexpr size_t WS_XB = 61 * MiB;
constexpr size_t WS_OV = 93 * MiB;
constexpr size_t WS_U = WS_OV, WS_V = WS_OV + 16 * MiB, WS_Q = WS_OV + 32 * MiB, WS_KV = WS_OV + 48 * MiB, WS_MIX = WS_OV + 72 * MiB, WS_QM = WS_OV + 104 * MiB, WS_OM = WS_OV + 120 * MiB;
constexpr size_t WS_HB = WS_OV;
constexpr size_t WS_SM = 229 * MiB;
constexpr size_t WS_GL = WS_SM, WS_KC = WS_SM + 2 * MiB, WS_VC = WS_KC + 256 * 1024, WS_HID = WS_SM + 3 * MiB, WS_MASK = WS_SM + 5 * MiB, WS_MEMB = WS_SM + 6 * MiB, WS_KVM = WS_SM + 8 * MiB, WS_END = WS_SM + 10 * MiB;
static_assert(WS_END <= 256 * MiB, "ws map");
constexpr int SSQ_MEM_OFF = 6 * NTOK;

struct Args { const float* in[27]; float* out; unsigned char* ws; int ph_lo, ph_hi; };
enum { I_X = 0, I_MEM, I_NMG, I_WIN, I_SGLNG, I_SGLNB, I_SGW, I_SGB, I_QNG, I_KNG, I_CPOS, I_CW1, I_CB1, I_CW2, I_CB2, I_MOG, I_WOUT, I_NMEMG, I_MKVG, I_WMQ, I_WMKV, I_MQG, I_MKG, I_WMO, I_NFG, I_WFF1, I_WFF2 };

__device__ __forceinline__ float bf2f(unsigned short b) { return __uint_as_float((unsigned)b << 16); }
__device__ __forceinline__ float wave_sum(float v) {
#pragma unroll
    for (int o = 1; o < 64; o <<= 1) v += __shfl_xor(v, o);
    return v; }

__device__ __forceinline__ void transpose_item(const float* W, int K, int N, int Npad, const float* gain, bf16_t* WT, LAS float* scr, int item, int lane) {
    const int nblk = Npad / 32, kb = item / nblk, nb = item % nblk, k0 = 64 * kb, n0 = 32 * nb;
    const int nn = n0 + (lane & 31);
#pragma unroll 8
    for (int i = 0; i < 32; ++i) { const int kk = 2 * i + (lane >> 5); float v = 0.f; if (nn < N) { v = W[(size_t)(k0 + kk) * N + nn]; if (gain) v *= gain[k0 + kk]; } scr[kk * 33 + (lane & 31)] = v; }
    asm volatile("s_waitcnt lgkmcnt(0)" ::: "memory");
    const int c = lane & 7;
#pragma unroll
    for (int j = 0; j < 4; ++j) { const int n = (lane >> 3) + 8 * j; const LAS float* s = scr + (8 * c) * 33 + n;
        u32x4 o; o.x = cvt_pk_bf16(s[0 * 33], s[1 * 33]); o.y = cvt_pk_bf16(s[2 * 33], s[3 * 33]); o.z = cvt_pk_bf16(s[4 * 33], s[5 * 33]); o.w = cvt_pk_bf16(s[6 * 33], s[7 * 33]);
        *(u32x4*)(WT + (size_t)(n0 + n) * K + k0 + 8 * c) = o; }
    asm volatile("s_waitcnt lgkmcnt(0)" ::: "memory");
}

__device__ __forceinline__ void prologue(const Args& a, LAS unsigned char* lds, int gw, int NGW, int wave, int lane) {
    LAS float* scr = (LAS float*)(lds + wave * 16384);
    unsigned char* ws = a.ws; float* ctl = (float*)(ws + WS_CTL);
    int it0 = 0;
#define TR_MAT(Wp, K_, N_, NP_, Gp, DST) { const int cnt = ((K_) / 64) * ((NP_) / 32); for (int it = gw; it < it0 + cnt; it += NGW) { if (it >= it0) transpose_item((Wp), (K_), (N_), (NP_), (Gp), (bf16_t*)(DST), scr, it - it0, lane); } it0 += cnt; }
    for (int l = 0; l < 2; ++l) {
        unsigned char* wl = ws + WS_W + l * W_LAYER;
        TR_MAT(a.in[I_WIN] + (size_t)l * 1024 * INC, 1024, INC, INP, a.in[I_NMG] + l * 1024, wl + W_IN)
        TR_MAT(a.in[I_WOUT] + (size_t)l * 1024 * 1024, 1024, 1024, 1024, a.in[I_MOG] + l * 1024, wl + W_OUT)
        TR_MAT(a.in[I_WMQ] + (size_t)l * 1024 * 512, 1024, 512, 512, a.in[I_NMEMG] + l * 1024, wl + W_MQ)
        TR_MAT(a.in[I_WMKV] + (size_t)l * 1024 * 1024, 1024, 1024, 1024, a.in[I_MKVG] + l * 1024, wl + W_MKV)
        TR_MAT(a.in[I_WMO] + (size_t)l * 512 * 1024, 512, 1024, 1024, (const float*)nullptr, wl + W_MO)
        TR_MAT(a.in[I_WFF1] + (size_t)l * 1024 * 4096, 1024, 4096, 4096, a.in[I_NFG] + l * 1024, wl + W_FF1)
        TR_MAT(a.in[I_WFF2] + (size_t)l * 4096 * 1024, 4096, 1024, 1024, (const float*)nullptr, wl + W_FF2)
        for (int kv = 0; kv < 2; ++kv) {
            TR_MAT(a.in[I_CW1] + (size_t)(l * 2 + kv) * 2048 * 256, 2048, 256, 256, (const float*)nullptr, wl + W_C1 + (size_t)kv * 256 * 2048 * 2)
            TR_MAT(a.in[I_CW2] + (size_t)(l * 2 + kv) * 256 * 64, 256, 64, 64, (const float*)nullptr, wl + W_C2 + (size_t)kv * 64 * 256 * 2)
        }
    }
#undef TR_MAT
    { const float* x = a.in[I_X]; bf16_t* XB = (bf16_t*)(ws + WS_XB);
      for (int r = gw; r < NTOK; r += NGW) { const f32x4* xr = (const f32x4*)(x + (size_t)r * 1024) + lane; f32x4* orow = (f32x4*)(a.out + (size_t)r * 1024) + lane; unsigned long long* xb = (unsigned long long*)(XB + (size_t)r * 1024) + lane; float s = 0.f;
#pragma unroll
          for (int j = 0; j < 4; ++j) { const f32x4 v = xr[64 * j]; orow[64 * j] = v; s += (v[0] * v[0] + v[1] * v[1]) + (v[2] * v[2] + v[3] * v[3]); xb[64 * j] = (unsigned long long)cvt_pk_bf16(v[0], v[1]) | ((unsigned long long)cvt_pk_bf16(v[2], v[3]) << 32); }
          s = wave_sum(s); if (lane == 0) ctl[r] = s; if (lane >= 1 && lane <= 5) ctl[lane * NTOK + r] = 0.f; } }
    { const float* mem = a.in[I_MEM]; bf16_t* MB = (bf16_t*)(ws + WS_MEMB);
      for (int r = gw; r < 1024; r += NGW) { const f32x4* xr = (const f32x4*)(mem + (size_t)r * 1024) + lane; unsigned long long* xb = (unsigned long long*)(MB + (size_t)r * 1024) + lane; float s = 0.f;
#pragma unroll
          for (int j = 0; j < 4; ++j) { const f32x4 v = xr[64 * j]; s += (v[0] * v[0] + v[1] * v[1]) + (v[2] * v[2] + v[3] * v[3]); xb[64 * j] = (unsigned long long)cvt_pk_bf16(v[0], v[1]) | ((unsigned long long)cvt_pk_bf16(v[2], v[3]) << 32); }
          s = wave_sum(s); if (lane == 0) ctl[SSQ_MEM_OFF + r] = s; } }
    for (int it = gw; it < 16; it += NGW) { const int lk = it >> 2, j = (it & 3) * 64 + lane; const float* W1 = a.in[I_CW1] + (size_t)lk * 2048 * 256; const float* pos = a.in[I_CPOS] + (size_t)lk * 2048; float s = a.in[I_CB1][lk * 256 + j];
        for (int k = 0; k < 2048; ++k) s += pos[k] * W1[(size_t)k * 256 + j];
        ((float*)(ws + WS_W + (lk >> 1) * W_LAYER + W_B1P))[(lk & 1) * 256 + j] = s; }
}

constexpr int LDS_BYTES = 147456;
__global__ void __launch_bounds__(512, 2) mega(Args args) {
    extern __shared__ __attribute__((aligned(16))) unsigned char lds_raw[];
    LAS unsigned char* lds = (LAS unsigned char*)lds_raw;
    const int tid = threadIdx.x, lane = tid & 63, wave = __builtin_amdgcn_readfirstlane(tid >> 6);
    const int G = gridDim.x, bx = blockIdx.x;
    const int gw = bx * 8 + wave, NGW = G * 8;
    if (args.ph_lo == 0) prologue(args, lds, gw, NGW, wave, lane);
    for (int ph = args.ph_lo > 1 ? args.ph_lo : 1; ph < args.ph_hi; ++ph) {
        unsigned char* ws = args.ws; float* xout = args.out; asm volatile("" : "+s"(ws), "+s"(xout));
        float* ctl = (float*)(ws + WS_CTL); bf16_t* XB = (bf16_t*)(ws + WS_XB);
        const int l = (ph - 1) / 10, p = (ph - 1) % 10; unsigned char* wl = ws + WS_W + l * W_LAYER;
        if (p == 0) {
            pg8::Gemm g = pg8::make_gemm(XB, (const bf16_t*)(wl + W_IN), 1024); pg8::StaticOrder S; S.init(NTOK, INP, G, bx);
            pg8::EpiInProj E{(bf16_t*)(ws + WS_U), (bf16_t*)(ws + WS_V), (bf16_t*)(ws + WS_Q), (bf16_t*)(ws + WS_KV), (float*)(ws + WS_GL), ctl + (l == 0 ? 0 : 3) * NTOK};
            pg8::gemm_phase<pg8::EpiInProj, pg8::StaticOrder, true>(lds, g, S, E);
        } else if (p == 1) {
            if (bx < 16) { const int kv = bx >> 3, pm = bx & 7;
                pg8::Gemm g; g.A = (const bf16_t*)(ws + WS_KV) + kv * 128; g.Bt = (const bf16_t*)(wl + W_C1 + (size_t)kv * 256 * 2048 * 2); g.K = 2048; g.lda = 16 * 768; g.kstepA = 768 * 2; g.a_s0 = 64 * 2; g.a_s1 = (size_t)T * 768 * 2;
                pg8::OneUnit S{1, {pm, 0}};
                pg8::EpiBf16G<1> E{(bf16_t*)(ws + WS_HID) + (size_t)kv * 2048 * 256, 256, (const float*)(wl + W_B1P) + kv * 256, nullptr, 0.f};
                pg8::gemm_phase<pg8::EpiBf16G<1>, pg8::OneUnit, true>(lds, g, S, E);
            } else if (bx < 32) { const int i = bx - 16;
                pg8::Gemm g = pg8::make_gemm((const bf16_t*)(ws + WS_MEMB), (const bf16_t*)(wl + W_MKV), 1024); pg8::OneUnit S{1, {i >> 2, i & 3}};
                pg8::EpiBf16G<0> E{(bf16_t*)(ws + WS_KVM), 1024, nullptr, ctl + SSQ_MEM_OFF, 1.f / 1024.f};
                pg8::gemm_phase<pg8::EpiBf16G<0>, pg8::OneUnit, true>(lds, g, S, E);
            }
        } else if (p == 4) {
            pg8::Gemm g = pg8::make_gemm((const bf16_t*)(ws + WS_MIX), (const bf16_t*)(wl + W_OUT), 1024); pg8::StaticOrder S; S.init(NTOK, 1024, G, bx);
            pg8::EpiResid E{xout, XB, ctl + (l * 3 + 1) * NTOK};
            pg8::gemm_phase<pg8::EpiResid, pg8::StaticOrder, true>(lds, g, S, E);
        } else if (p == 5) {
            pg8::Gemm g = pg8::make_gemm(XB, (const bf16_t*)(wl + W_MQ), 1024); pg8::StaticOrder S; S.init(NTOK, 512, G, bx);
            pg8::EpiBf16G<0> E{(bf16_t*)(ws + WS_QM), 512, nullptr, ctl + (l * 3 + 1) * NTOK, 1.f / 1024.f};
            pg8::gemm_phase<pg8::EpiBf16G<0>, pg8::StaticOrder, true>(lds, g, S, E);
        } else if (p == 7) {
            pg8::Gemm g = pg8::make_gemm((const bf16_t*)(ws + WS_OM), (const bf16_t*)(wl + W_MO), 512); pg8::StaticOrder S; S.init(NTOK, 1024, G, bx);
            pg8::EpiResid E{xout, XB, ctl + (l * 3 + 2) * NTOK};
            pg8::gemm_phase<pg8::EpiResid, pg8::StaticOrder, true>(lds, g, S, E);
        } else if (p == 8) {
            pg8::Gemm g = pg8::make_gemm(XB, (const bf16_t*)(wl + W_FF1), 1024); pg8::StaticOrder S; S.init(NTOK, FF, G, bx);
            pg8::EpiBf16G<2> E{(bf16_t*)(ws + WS_HB), FF, nullptr, ctl + (l * 3 + 2) * NTOK, 1.f / 1024.f};
            pg8::gemm_phase<pg8::EpiBf16G<2>, pg8::StaticOrder, true>(lds, g, S, E);
        } else if (p == 9) {
            pg8::Gemm g = pg8::make_gemm((const bf16_t*)(ws + WS_HB), (const bf16_t*)(wl + W_FF2), FF); pg8::StaticOrder S; S.init(NTOK, 1024, G, bx);
            pg8::EpiResid E{xout, l == 0 ? XB : (bf16_t*)nullptr, ctl + 3 * NTOK};
            pg8::gemm_phase<pg8::EpiResid, pg8::StaticOrder, true>(lds, g, S, E);
        }
    }
}

__device__ __forceinline__ float wave_max(float v) { for (int o = 32; o > 0; o >>= 1) v = fmaxf(v, __shfl_xor(v, o)); return v; }
__global__ void k_tokprep(bf16_t* Q, bf16_t* KV, const bf16_t* Vb, float* lnstat, const float* qg, const float* kg  ) {
    const int tok = blockIdx.x * 4 + (threadIdx.x >> 6), lane = threadIdx.x & 63;
    { float s = 0.f, s2 = 0.f; for (int i = lane; i < 512; i += 64) { float v = bf2f(Vb[(size_t)tok * 512 + i]); s += v; s2 += v * v; } s = wave_sum(s); s2 = wave_sum(s2); const float mu = s / 512.f; const float var = fmaxf(s2 / 512.f - mu * mu, 0.f);
      if (lane == 0) { lnstat[tok * 2] = mu; lnstat[tok * 2 + 1] = rsqrtf(var + 1e-6f); } }
    for (int h = 0; h < 8; ++h) { bf16_t* p = Q + (size_t)tok * 512 + h * 64; float v = bf2f(p[lane]); float ss = wave_sum(v * v); p[lane] = (bf16_t)(cvt_pk_bf16(v * rsqrtf(ss / 64.f + 1e-6f) * qg[lane] * (0.125f * 1.4426950408889634f), 0.f) & 0xffff); }
    for (int br = 1; br < 3; ++br) for (int h = 0; h < 2; ++h) { bf16_t* p = KV + (size_t)tok * 768 + br * 256 + h * 64; float v = bf2f(p[lane]); float ss = wave_sum(v * v); p[lane] = (bf16_t)(cvt_pk_bf16(v * rsqrtf(ss / 64.f + 1e-6f) * kg[br * 64 + lane], 0.f) & 0xffff); }
}
__global__ void k_sgu_mix(const bf16_t* U, const bf16_t* Vb, const float* lnstat, const float* lng, const float* lnb, const float* w, const float* bs, float* out) {
    long i = (long)blockIdx.x * blockDim.x + threadIdx.x; int ch = i & 511; long tok = i >> 9; int g = ch >> 6; int tt = tok & 127; long tok0 = tok - tt;
    const float* wr = w + ((long)g * 128 + tt) * 128; float s = 0.f; const float gg = lng[ch], bb = lnb[ch];
    for (int k = 0; k <= tt; ++k) { const float v = (bf2f(Vb[(tok0 + k) * 512 + ch]) - lnstat[(tok0 + k) * 2]) * lnstat[(tok0 + k) * 2 + 1] * gg + bb; s += wr[k] * v; }
    s += bs[g * 128 + tt]; out[tok * 512 + ch] = bf2f(U[tok * 512 + ch]) * s;
}
__global__ void k_rms512_to_mixed(const float* in, bf16_t* MIX, int coff) {
    const int tok = blockIdx.x * 4 + (threadIdx.x >> 6), lane = threadIdx.x & 63; const float* p = in + (size_t)tok * 512; float s = 0.f; for (int i = lane; i < 512; i += 64) s += p[i] * p[i]; s = wave_sum(s); const float rs = rsqrtf(s / 512.f + 1e-6f);
    for (int i = lane; i < 512; i += 64) MIX[(size_t)tok * 1024 + coff + i] = (bf16_t)(cvt_pk_bf16(p[i] * rs, 0.f) & 0xffff);
}
__global__ void k_cmp2(const bf16_t* hid, const bf16_t* w2t, const float* b2, const float* kg0, bf16_t* KC, bf16_t* VC) {
    const int row = blockIdx.x * 4 + (threadIdx.x >> 6), lane = threadIdx.x & 63;
    for (int kv = 0; kv < 2; ++kv) { const bf16_t* h = hid + (size_t)kv * 2048 * 256 + (size_t)row * 256; const bf16_t* w = w2t + (size_t)kv * 64 * 256 + (size_t)lane * 256; float s = b2[kv * 64 + lane];
        for (int k = 0; k < 256; ++k) s += bf2f(h[k]) * bf2f(w[k]);
        if (kv == 0) { float ss = wave_sum(s * s); s = s * rsqrtf(ss / 64.f + 1e-6f) * kg0[lane]; }
        if ((row & 255) == 255) s = 0.f;
        (kv ? VC : KC)[(size_t)row * 64 + lane] = (bf16_t)(cvt_pk_bf16(s, 0.f) & 0xffff); }
}
__global__ void __launch_bounds__(256) k_cmp_attn(const bf16_t* Q, const bf16_t* KC, const bf16_t* VC, const float* GL, float* bmix, unsigned long long* masks) {
    const int t = blockIdx.x, b = blockIdx.y >> 1, hk = blockIdx.y & 1, tid = threadIdx.x, lane = tid & 63, wv = tid >> 6; const long tok = (long)b * T + t;
    __shared__ float qs[4][64]; __shared__ float sc[4][256]; __shared__ float red[4][4]; __shared__ float imp[64]; __shared__ unsigned mk[2];
    qs[wv][lane] = bf2f(Q[tok * 512 + (hk * 4 + wv) * 64 + lane]); if (tid < 2) mk[tid] = 0u; __syncthreads();
    const int nvalid = (t >= 31) ? (t - 31) / 16 + 1 : 0;
    float e[4] = {0.f, 0.f, 0.f, 0.f};
    if (tid < nvalid) { const bf16_t* kr = KC + ((long)(b * 2 + hk) * 256 + tid) * 64; float a0 = 0, a1 = 0, a2 = 0, a3 = 0; for (int d = 0; d < 64; ++d) { float kv = bf2f(kr[d]); a0 += qs[0][d] * kv; a1 += qs[1][d] * kv; a2 += qs[2][d] * kv; a3 += qs[3][d] * kv; }
        e[0] = exp2f(a0); e[1] = exp2f(a1); e[2] = exp2f(a2); e[3] = exp2f(a3); }
    for (int g = 0; g < 4; ++g) { float q = wave_sum(e[g]); if (lane == 0) red[g][wv] = q; } __syncthreads();
    for (int g = 0; g < 4; ++g) { float dsum = red[g][0] + red[g][1] + red[g][2] + red[g][3]; sc[g][tid] = e[g] / (dsum > 0.f ? dsum : 1.f); } __syncthreads();
    if (tid < 64) { const int j = tid; float v = 0.f; for (int g = 0; g < 4; ++g) { for (int r = 0; r < 3; ++r) { int n = 4 * j + r; if (n < 255) v += sc[g][n]; } if (4 * j + 3 < 255) v += 0.5f * sc[g][4 * j + 3]; if (j > 0) v += 0.5f * sc[g][4 * j - 1]; }
        const int tb = t >> 6; const bool forced = (j == 0) || (j == tb) || (j == tb - 1); imp[j] = forced ? 1e4f : (j <= tb ? v : -1e4f); } __syncthreads();
    if (tid < 64) { const int j = tid; const float v = imp[j]; int rank = 0; for (int k = 0; k < 64; ++k) { float o = imp[k]; rank += (o > v) || (o == v && k < j); } if (rank < 16) atomicOr(&mk[j >> 5], 1u << (j & 31)); } __syncthreads();
    if (tid == 0) masks[tok * 2 + hk] = ((unsigned long long)mk[1] << 32) | mk[0];
    { const int g = wv, d = lane; float o = 0.f; for (int n = 0; n < nvalid; ++n) o += sc[g][n] * bf2f(VC[((long)(b * 2 + hk) * 256 + n) * 64 + d]);
      const float gl = GL[tok * 24 + (hk * 4 + g) * 3 + 0]; bmix[tok * 512 + (hk * 4 + g) * 64 + d] = o / (1.f + expf(-gl)); }
}
__global__ void __launch_bounds__(256) k_slc_attn(const bf16_t* Q, const bf16_t* KV, const float* GL, const unsigned long long* masks, float* bmix) {
    const int t = blockIdx.x, b = blockIdx.y >> 1, hk = blockIdx.y & 1, tid = threadIdx.x, lane = tid & 63, g = tid >> 6; const long tok = (long)b * T + t;
    __shared__ float qs[4][64]; __shared__ float sc[4][1024]; __shared__ int blk[16];
    qs[g][lane] = bf2f(Q[tok * 512 + (hk * 4 + g) * 64 + lane]);
    const unsigned long long m = masks[tok * 2 + hk]; const int tb = t >> 6; int nsel = 0; for (int j = 0; j <= tb; ++j) if ((m >> j) & 1ull) { if (tid == 0) blk[nsel] = j; ++nsel; }
    __syncthreads();
    const int kcol = 256 + hk * 64, vcol = 384 + hk * 64; float sum = 0.f;
    for (int sidx = 0; sidx < nsel; ++sidx) { const int kp = blk[sidx] * 64 + lane; float e = 0.f; if (kp <= t) { const bf16_t* kr = KV + ((long)b * T + kp) * 768 + kcol; float a = 0.f; for (int d = 0; d < 64; ++d) a += qs[g][d] * bf2f(kr[d]); e = exp2f(a); } sc[g][sidx * 64 + lane] = e; sum += e; }
    sum = wave_sum(sum); const float inv = 1.f / (sum > 0.f ? sum : 1.f); __syncthreads();
    float o = 0.f; for (int sidx = 0; sidx < nsel; ++sidx) { const long base = ((long)b * T + blk[sidx] * 64) * 768 + vcol + lane; for (int i = 0; i < 64; ++i) o += sc[g][sidx * 64 + i] * bf2f(KV[base + (long)i * 768]); }
    const float gl = GL[tok * 24 + (hk * 4 + g) * 3 + 1]; bmix[tok * 512 + (hk * 4 + g) * 64 + lane] += (o * inv) / (1.f + expf(-gl));
}
__global__ void __launch_bounds__(256) k_win_attn(const bf16_t* Q, const bf16_t* KV, const float* GL, float* bmix) {
    const int t = blockIdx.x, b = blockIdx.y >> 1, hk = blockIdx.y & 1, tid = threadIdx.x, lane = tid & 63, g = tid >> 6; const long tok = (long)b * T + t;
    __shared__ float qs[4][64]; __shared__ float sc[4][512];
    qs[g][lane] = bf2f(Q[tok * 512 + (hk * 4 + g) * 64 + lane]); __syncthreads();
    const int kcol = 512 + hk * 64, vcol = 640 + hk * 64; const int k0 = t - 511; float sum = 0.f;
    for (int i = lane; i < 512; i += 64) { const int kp = k0 + i; float e = 0.f; if (kp >= 0) { const bf16_t* kr = KV + ((long)b * T + kp) * 768 + kcol; float a = 0.f; for (int d = 0; d < 64; ++d) a += qs[g][d] * bf2f(kr[d]); e = exp2f(a); } sc[g][i] = e; sum += e; }
    sum = wave_sum(sum); const float inv = 1.f / (sum > 0.f ? sum : 1.f); __syncthreads();
    float o = 0.f; for (int i = 0; i < 512; ++i) { const int kp = k0 + i; if (kp >= 0) o += sc[g][i] * bf2f(KV[((long)b * T + kp) * 768 + vcol + lane]); }
    const float gl = GL[tok * 24 + (hk * 4 + g) * 3 + 2]; bmix[tok * 512 + (hk * 4 + g) * 64 + lane] += (o * inv) / (1.f + expf(-gl));
}
__global__ void k_memk_norm(bf16_t* KVM, const float* kg) {
    const int r = blockIdx.x * 4 + (threadIdx.x >> 6), lane = threadIdx.x & 63; bf16_t* p = KVM + (size_t)(r >> 2) * 1024 + (r & 3) * 128; float v0 = bf2f(p[lane]), v1 = bf2f(p[lane + 64]); float ss = wave_sum(v0 * v0 + v1 * v1); const float rs = rsqrtf(ss / 128.f + 1e-6f);
    p[lane] = (bf16_t)(cvt_pk_bf16(v0 * rs * kg[lane], 0.f) & 0xffff); p[lane + 64] = (bf16_t)(cvt_pk_bf16(v1 * rs * kg[lane + 64], 0.f) & 0xffff);
}
__global__ void __launch_bounds__(256) k_mem_attn(const bf16_t* QM, const bf16_t* KVM, const float* qg, bf16_t* OM) {
    const long tok = blockIdx.x; const int b = tok / T, tid = threadIdx.x, lane = tid & 63, h = tid >> 6;
    __shared__ float qs[4][128]; __shared__ float sc[4][256];
    { float v0 = bf2f(QM[tok * 512 + h * 128 + lane]), v1 = bf2f(QM[tok * 512 + h * 128 + 64 + lane]); float ss = wave_sum(v0 * v0 + v1 * v1); const float rs = rsqrtf(ss / 128.f + 1e-6f) * (0.08838834764831845f * 1.4426950408889634f);
      qs[h][lane] = v0 * rs * qg[lane]; qs[h][lane + 64] = v1 * rs * qg[lane + 64]; } __syncthreads();
    float sum = 0.f;
    for (int i = lane; i < 256; i += 64) { const bf16_t* kr = KVM + ((long)b * 256 + i) * 1024 + h * 128; float a = 0.f; for (int d = 0; d < 128; ++d) a += qs[h][d] * bf2f(kr[d]); float e = exp2f(a); sc[h][i] = e; sum += e; }
    sum = wave_sum(sum); __syncthreads();
    for (int dd = 0; dd < 2; ++dd) { const int d = lane + dd * 64; float o = 0.f; for (int i = 0; i < 256; ++i) o += sc[h][i] * bf2f(KVM[((long)b * 256 + i) * 1024 + 512 + h * 128 + d]); OM[tok * 512 + h * 128 + d] = (bf16_t)(cvt_pk_bf16(o / sum, 0.f) & 0xffff); }
}
}

extern "C" void kernel_launch(void* const* d_in, const int* in_sizes, int n_in, void* d_out, int out_size, void* d_ws, size_t ws_size, hipStream_t stream) {
    using namespace mk;
    static int inited = 0;
    if (!inited) { (void)hipFuncSetAttribute((const void*)mega, hipFuncAttributeMaxDynamicSharedMemorySize, LDS_BYTES); inited = 1; }
    Args a{}; for (int i = 0; i < 27; ++i) a.in[i] = (const float*)d_in[i]; a.out = (float*)d_out; a.ws = (unsigned char*)d_ws;
    unsigned char* ws = (unsigned char*)d_ws;
    auto run = [&](int lo, int hi) { a.ph_lo = lo; a.ph_hi = hi; hipLaunchKernelGGL(mega, dim3(256), dim3(512), LDS_BYTES, stream, a); };
    bf16_t* U = (bf16_t*)(ws + WS_U); bf16_t* Vb = (bf16_t*)(ws + WS_V); bf16_t* Q = (bf16_t*)(ws + WS_Q); bf16_t* KV = (bf16_t*)(ws + WS_KV); bf16_t* MIX = (bf16_t*)(ws + WS_MIX);
    float* GL = (float*)(ws + WS_GL); bf16_t* KC = (bf16_t*)(ws + WS_KC); bf16_t* VC = (bf16_t*)(ws + WS_VC); bf16_t* HID = (bf16_t*)(ws + WS_HID); unsigned long long* MASK = (unsigned long long*)(ws + WS_MASK);
    bf16_t* KVM = (bf16_t*)(ws + WS_KVM); bf16_t* QM = (bf16_t*)(ws + WS_QM); bf16_t* OM = (bf16_t*)(ws + WS_OM);
    float* scratch = (float*)(ws + WS_QM);
    float* lnstat = (float*)(ws + WS_CTL) + 8 * NTOK;
    run(0, 1);
    for (int l = 0; l < 2; ++l) { const int base = 1 + 10 * l; unsigned char* wl = ws + WS_W + l * W_LAYER;
        run(base + 0, base + 1);
        run(base + 1, base + 2);
        k_tokprep<<<NTOK / 4, 256, 0, stream>>>(Q, KV, Vb, lnstat, a.in[I_QNG] + l * 64, a.in[I_KNG] + l * 192);
        k_sgu_mix<<<NTOK * 512 / 256, 256, 0, stream>>>(U, Vb, lnstat, a.in[I_SGLNG] + l * 512, a.in[I_SGLNB] + l * 512, a.in[I_SGW] + (size_t)l * 8 * 128 * 128, a.in[I_SGB] + l * 8 * 128, scratch);
        k_rms512_to_mixed<<<NTOK / 4, 256, 0, stream>>>(scratch, MIX, 0);
        k_cmp2<<<2048 / 4, 256, 0, stream>>>(HID, (const bf16_t*)(wl + W_C2), a.in[I_CB2] + l * 128, a.in[I_KNG] + l * 192, KC, VC);
        k_cmp_attn<<<dim3(T, NB * 2), 256, 0, stream>>>(Q, KC, VC, GL, scratch, MASK);
        k_slc_attn<<<dim3(T, NB * 2), 256, 0, stream>>>(Q, KV, GL, MASK, scratch);
        k_win_attn<<<dim3(T, NB * 2), 256, 0, stream>>>(Q, KV, GL, scratch);
        k_rms512_to_mixed<<<NTOK / 4, 256, 0, stream>>>(scratch, MIX, 512);
        run(base + 4, base + 5);
        run(base + 5, base + 6);
        k_memk_norm<<<1024, 256, 0, stream>>>(KVM, a.in[I_MKG] + l * 128);
        k_mem_attn<<<NTOK, 256, 0, stream>>>(QM, KVM, a.in[I_MQG] + l * 128, OM);
        run(base + 7, base + 8);
        run(base + 8, base + 9);
        run(base + 9, base + 10);
    }
}
```

```cpp
#include <hip/hip_runtime.h>
#include <hip/hip_cooperative_groups.h>
#include <stdint.h>
#include <math.h>

namespace pg8 {
#define PG8_LAS __attribute__((address_space(3)))
typedef unsigned short bf16_t;
typedef short bf16x8 __attribute__((ext_vector_type(8)));
typedef float f32x4 __attribute__((ext_vector_type(4)));
typedef float f32x2 __attribute__((ext_vector_type(2)));
typedef unsigned u32x4 __attribute__((ext_vector_type(4)));
typedef unsigned u32x2 __attribute__((ext_vector_type(2)));
constexpr int BM = 256, BK = 64, HALF = 128, HTB = HALF * BK * 2, STAGE_BYTES = 8 * HTB, NXCD = 8, WGM = 8;

__host__ __device__ __forceinline__ int lds_byte(int r, int c) { const int st = (r >> 4) * 2 + (c >> 5), rr = r & 15, cc = c & 31, ob = rr * 64 + cc * 2; return st * 1024 + (ob ^ (((ob >> 9) & 1) << 5)); }
__host__ __device__ __forceinline__ void stage_rc(int b, int& R, int& C) { const int st = b / 1024, sb = b % 1024, swz = sb ^ (((sb >> 9) & 1) << 5); R = (st >> 1) * 16 + swz / 64; C = (st & 1) * 32 + (swz % 64) / 2; }
__host__ __device__ __forceinline__ int perm32(int rho) { const int n = rho >> 4, i = rho & 15; return 8 * (i >> 2) + 4 * n + (i & 3); }

struct Unit { int pm, pn; };
struct Gemm { const bf16_t* A; const bf16_t* Bt; int K; int lda; int kstepA; size_t a_s0, a_s1; };
__device__ __forceinline__ Gemm make_gemm(const bf16_t* A, const bf16_t* Bt, int K) { Gemm g; g.A = A; g.Bt = Bt; g.K = K; g.lda = K; g.kstepA = BK * 2; g.a_s0 = (size_t)BM * K * 2; g.a_s1 = 2 * g.a_s0; return g; }

struct StaticOrder {
    int nM, nN, nwg, G, c;
    __device__ void init(int M, int N, int G_, int c_) { nM = M / BM; nN = N / BM; nwg = nM * nN; G = G_; c = c_; }
    __device__ bool next(int i, Unit& u) const {
        const long L = (long)i * G + c; if (L >= nwg) return false;
        int wgid = (int)L; { const int q = nwg / NXCD, r = nwg % NXCD, xcd = wgid % NXCD, off = wgid / NXCD; wgid = (xcd < r ? xcd * (q + 1) : r * (q + 1) + (xcd - r) * q) + off; }
        const int nig = WGM * nN, gid = wgid / nig, fm = gid * WGM, gsz = (nM - fm) < WGM ? (nM - fm) : WGM;
        u.pm = fm + ((wgid % nig) % gsz); u.pn = (wgid % nig) / gsz; return true;
    }
};
struct OneUnit { int has; Unit u; __device__ bool next(int i, Unit& o) const { if (i > 0 || !has) return false; o = u; return true; } };

__device__ __forceinline__ unsigned cvt_pk_bf16(float lo, float hi) { unsigned r; asm volatile("v_cvt_pk_bf16_f32 %0, %1, %2" : "=v"(r) : "v"(lo), "v"(hi)); return r; }
__device__ __forceinline__ float gelu_tanh(float x) { const float u = 0.7978845608028654f * (x + 0.044715f * x * x * x); const float e = __builtin_amdgcn_exp2f(-2.885390081777927f * u); return x * __builtin_amdgcn_rcpf(1.f + e); }

template <int ACT  > struct EpiBf16G {
    static constexpr bool PERM = true, AFTER_DRAIN = false;
    bf16_t* O; int ldc; const float* bias; const float* ssq; float inv_n;
    __device__ __forceinline__ void operator()(const f32x4 (&acc)[2][2][4][2], const Unit& u, int wr, int wc, int fr, int fq) const {
        const int row0 = u.pm * BM + wr * 64 + fr, col0 = u.pn * BM + wc * 32 + 8 * fq;
        f32x4 bv[2][2];
#pragma unroll
        for (int bj = 0; bj < 2; ++bj)
#pragma unroll
            for (int n = 0; n < 2; ++n) bv[bj][n] = bias ? *(const f32x4*)(bias + col0 + bj * HALF + 4 * n) : (f32x4){0.f, 0.f, 0.f, 0.f};
#pragma unroll
        for (int ai = 0; ai < 2; ++ai)
#pragma unroll
            for (int m = 0; m < 4; ++m) { const int row = row0 + ai * HALF + m * 16; const float rs = ssq ? rsqrtf(ssq[row] * inv_n + 1e-6f) : 1.f; bf16_t* rowp = O + (size_t)row * ldc + col0;
#pragma unroll
                for (int bj = 0; bj < 2; ++bj) { f32x4 v0 = (acc[ai][bj][m][0] + bv[bj][0]) * rs, v1 = (acc[ai][bj][m][1] + bv[bj][1]) * rs;
                    if (ACT == 1) {
#pragma unroll
                        for (int e = 0; e < 4; ++e) { v0[e] = gelu_tanh(v0[e]); v1[e] = gelu_tanh(v1[e]); } }
                    if (ACT == 2) {
#pragma unroll
                        for (int e = 0; e < 4; ++e) { float a = fmaxf(v0[e], 0.f), b = fmaxf(v1[e], 0.f); v0[e] = a * a; v1[e] = b * b; } }
                    u32x4 w; w.x = cvt_pk_bf16(v0[0], v0[1]); w.y = cvt_pk_bf16(v0[2], v0[3]); w.z = cvt_pk_bf16(v1[0], v1[1]); w.w = cvt_pk_bf16(v1[2], v1[3]);
                    *(u32x4*)(rowp + bj * HALF) = w; } }
    }
};
struct EpiInProj {
    static constexpr bool PERM = true, AFTER_DRAIN = false;
    bf16_t *U, *V, *Q, *KV; float* GL; const float* ssq;
    __device__ __forceinline__ void operator()(const f32x4 (&acc)[2][2][4][2], const Unit& u, int wr, int wc, int fr, int fq) const {
        const int row0 = u.pm * BM + wr * 64 + fr, cit0 = wc * 32 + 8 * fq; const int pn = u.pn;
        bf16_t* base; int ldc, cofs; bool act = false;
        if (pn < 2) { base = U; ldc = 512; cofs = pn * 256; act = true; } else if (pn < 4) { base = V; ldc = 512; cofs = (pn - 2) * 256; act = true; }
        else if (pn < 6) { base = Q; ldc = 512; cofs = (pn - 4) * 256; } else { base = KV; ldc = 768; cofs = (pn - 6) * 256; }
#pragma unroll
        for (int ai = 0; ai < 2; ++ai)
#pragma unroll
            for (int m = 0; m < 4; ++m) { const int row = row0 + ai * HALF + m * 16; const float rs = rsqrtf(ssq[row] * (1.f / 1024.f) + 1e-6f);
#pragma unroll
                for (int bj = 0; bj < 2; ++bj) { f32x4 v0 = acc[ai][bj][m][0] * rs, v1 = acc[ai][bj][m][1] * rs; const int cit = cit0 + bj * HALF;
                    if (pn == 9) { if (cit < 24) { *(f32x4*)(GL + (size_t)row * 24 + cit) = v0; *(f32x4*)(GL + (size_t)row * 24 + cit + 4) = v1; } }
                    else { if (act) {
#pragma unroll
                            for (int e = 0; e < 4; ++e) { v0[e] = gelu_tanh(v0[e]); v1[e] = gelu_tanh(v1[e]); } }
                        u32x4 w; w.x = cvt_pk_bf16(v0[0], v0[1]); w.y = cvt_pk_bf16(v0[2], v0[3]); w.z = cvt_pk_bf16(v1[0], v1[1]); w.w = cvt_pk_bf16(v1[2], v1[3]);
                        *(u32x4*)(base + (size_t)row * ldc + cofs + cit) = w; } } }
    }
};
struct EpiResid {
    static constexpr bool PERM = false, AFTER_DRAIN = false;
    float* X; bf16_t* XB; float* ssq;
    __device__ __forceinline__ void operator()(const f32x4 (&acc)[2][2][4][2], const Unit& u, int wr, int wc, int fr, int fq) const {
        const int col0 = u.pn * BM + wc * 32 + 4 * fq;
#pragma unroll
        for (int ai = 0; ai < 2; ++ai)
#pragma unroll
            for (int m = 0; m < 4; ++m) { const int row = u.pm * BM + ai * HALF + wr * 64 + m * 16 + fr; float sq = 0.f;
#pragma unroll
                for (int bj = 0; bj < 2; ++bj)
#pragma unroll
                    for (int n = 0; n < 2; ++n) { const size_t off = (size_t)row * 1024 + col0 + bj * HALF + n * 16; f32x4 xv = *(const f32x4*)(X + off); xv = xv + acc[ai][bj][m][n]; *(f32x4*)(X + off) = xv;
                        if (XB) { sq += (xv[0] * xv[0] + xv[1] * xv[1]) + (xv[2] * xv[2] + xv[3] * xv[3]); u32x2 w; w.x = cvt_pk_bf16(xv[0], xv[1]); w.y = cvt_pk_bf16(xv[2], xv[3]); *(u32x2*)(XB + off) = w; } }
                if (XB) { sq += __shfl_xor(sq, 16); sq += __shfl_xor(sq, 32); if (fq == 0) atomicAdd(ssq + row, sq); } }
    }
};

template <class Epi, class Sched, bool ALIGN_EPI>
__device__ __forceinline__ void gemm_phase(PG8_LAS unsigned char* lds, const Gemm g, const Sched& S, const Epi& E) {
    int tid_ = threadIdx.x; asm volatile("" : "+v"(tid_));
    const int tid = tid_, wid = __builtin_amdgcn_readfirstlane(tid >> 6), lane = tid & 63, wr = wid >> 2, wc = wid & 3, fr = lane & 15, fq = lane >> 4;
    const int K = g.K, nt = K / BK;
    unsigned voffA[2], voffB[2];
#pragma unroll
    for (int i = 0; i < 2; ++i) { int R, C; stage_rc(tid * 16 + i * 8192, R, C); const int Rb = Epi::PERM ? ((R & ~31) + perm32(R & 31)) : R;
        voffA[i] = (unsigned)(R * g.lda + C) * 2u; voffB[i] = (unsigned)(Rb * K + C) * 2u; }
    const size_t kstepA = (size_t)g.kstepA, kstepB = (size_t)(BK * 2);
    const size_t hstepA = (size_t)HALF * g.lda * 2, hstepB = (size_t)HALF * K * 2, tstepB = 2 * hstepB;
    const unsigned ldsw = (unsigned)wid * 1024u;
    const int aoff = lds_byte(wr * 64 + fr, fq * 8), boff = lds_byte(wc * 32 + fr, fq * 8);
#define PG8_ABASE(pm) ((const char*)g.A + (size_t)((pm) >> 1) * g.a_s1 + (size_t)((pm) & 1) * g.a_s0)
#define PG8_SA(b, h) (((b) * 2 + (h)) * HTB)
#define PG8_SB(b, h) ((4 + (b) * 2 + (h)) * HTB)
#define PG8_STAGE(bufoff, gbase, voff) do { _Pragma("unroll") for (int _i = 0; _i < 2; ++_i) \
        __builtin_amdgcn_global_load_lds((const unsigned*)((const char*)(gbase) + (voff)[_i]), (PG8_LAS unsigned*)(lds + (bufoff) + ldsw + _i * 8192), 16, 0, 0); } while (0)
#define PG8_LDA(dst, b, h) do { _Pragma("unroll") for (int m = 0; m < 4; ++m) _Pragma("unroll") for (int k = 0; k < 2; ++k) dst[m][k] = *(const PG8_LAS bf16x8*)(lds + PG8_SA(b, h) + aoff + m * 2048 + k * 1024); } while (0)
#define PG8_LDB(dst, b, h) do { _Pragma("unroll") for (int n = 0; n < 2; ++n) _Pragma("unroll") for (int k = 0; k < 2; ++k) dst[n][k] = *(const PG8_LAS bf16x8*)(lds + PG8_SB(b, h) + boff + n * 2048 + k * 1024); } while (0)
#define PG8_MMA(ai, bj, At, Bt) do { __builtin_amdgcn_s_setprio(1); _Pragma("unroll") for (int m = 0; m < 4; ++m) _Pragma("unroll") for (int n = 0; n < 2; ++n) _Pragma("unroll") for (int k = 0; k < 2; ++k) \
        acc[ai][bj][m][n] = __builtin_amdgcn_mfma_f32_16x16x32_bf16(Bt[n][k], At[m][k], acc[ai][bj][m][n], 0, 0, 0); __builtin_amdgcn_s_setprio(0); } while (0)
#define PG8_WAIT_V(n) asm volatile("s_waitcnt vmcnt(" #n ")" ::: "memory")
#define PG8_WAIT_L(n) asm volatile("s_waitcnt lgkmcnt(" #n ")" ::: "memory")
#define PG8_BAR __builtin_amdgcn_s_barrier()
#define PG8_SCHED __builtin_amdgcn_sched_barrier(0)
    Unit cur, nxt; int ui = 0;
    if (!S.next(0, cur)) return;
    f32x4 acc[2][2][4][2];
#pragma unroll
    for (int a = 0; a < 2; ++a)
#pragma unroll
        for (int b = 0; b < 2; ++b)
#pragma unroll
            for (int m = 0; m < 4; ++m)
#pragma unroll
                for (int n = 0; n < 2; ++n) acc[a][b][m][n] = (f32x4){0.f, 0.f, 0.f, 0.f};
    bf16x8 At[4][2], B0[2][2], B1[2][2];
    const char* cA = PG8_ABASE(cur.pm); const char* cB = (const char*)g.Bt + (size_t)cur.pn * tstepB;
    PG8_STAGE(PG8_SB(0, 0), cB, voffB); PG8_STAGE(PG8_SB(0, 1), cB + hstepB, voffB); PG8_STAGE(PG8_SA(0, 0), cA, voffA); PG8_STAGE(PG8_SA(0, 1), cA + hstepA, voffA);
    if (wr == 1) PG8_BAR;
    PG8_WAIT_V(2); PG8_BAR;
    PG8_STAGE(PG8_SB(1, 0), cB + kstepB, voffB); PG8_STAGE(PG8_SA(1, 0), cA + kstepA, voffA); PG8_STAGE(PG8_SB(1, 1), cB + hstepB + kstepB, voffB);
    PG8_WAIT_V(6); PG8_BAR;
    for (;;) {
        const bool has_next = S.next(ui + 1, nxt);
        const char* nA = has_next ? PG8_ABASE(nxt.pm) : cA; const char* nB = has_next ? (const char*)g.Bt + (size_t)nxt.pn * tstepB : cB;
        for (int t = 0; t < nt; t += 2) {
            const bool last = (t == nt - 2);
            const char* a1 = cA + (size_t)(t + 1) * kstepA;
            const char* a2 = last ? nA : cA + (size_t)(t + 2) * kstepA; const char* b2 = last ? nB : cB + (size_t)(t + 2) * kstepB;
            const char* a3 = a2 + kstepA; const char* b3 = b2 + kstepB;
            PG8_LDB(B0, 0, 0); PG8_LDB(B1, 0, 1); PG8_SCHED; PG8_LDA(At, 0, 0); PG8_STAGE(PG8_SA(1, 1), a1 + hstepA, voffA);
            PG8_WAIT_V(8); PG8_WAIT_L(0); PG8_BAR; PG8_MMA(0, 0, At, B0); PG8_MMA(0, 1, At, B1); PG8_BAR; PG8_SCHED;
            PG8_LDA(At, 0, 1); PG8_STAGE(PG8_SB(0, 0), b2, voffB); PG8_STAGE(PG8_SB(0, 1), b2 + hstepB, voffB); PG8_STAGE(PG8_SA(0, 0), a2, voffA);
            PG8_WAIT_V(8); PG8_WAIT_L(0); PG8_BAR; PG8_MMA(1, 0, At, B0); PG8_MMA(1, 1, At, B1); PG8_BAR; PG8_SCHED;
            PG8_LDB(B0, 1, 0); PG8_LDB(B1, 1, 1); PG8_SCHED; PG8_LDA(At, 1, 0); PG8_STAGE(PG8_SA(0, 1), a2 + hstepA, voffA);
            PG8_WAIT_V(8); PG8_WAIT_L(0); PG8_BAR; PG8_MMA(0, 0, At, B0); PG8_MMA(0, 1, At, B1); PG8_BAR; PG8_SCHED;
            PG8_LDA(At, 1, 1); PG8_STAGE(PG8_SB(1, 0), b3, voffB); PG8_STAGE(PG8_SB(1, 1), b3 + hstepB, voffB); PG8_STAGE(PG8_SA(1, 0), a3, voffA);
            PG8_WAIT_V(8); PG8_WAIT_L(0); PG8_BAR; PG8_MMA(1, 0, At, B0); PG8_MMA(1, 1, At, B1); PG8_BAR; PG8_SCHED;
        }
        if constexpr (ALIGN_EPI) { if (wr == 0) PG8_BAR; }
        if constexpr (!Epi::AFTER_DRAIN) { E(acc, cur, wr, wc, fr, fq); }
        if (!has_next) break;
#pragma unroll
        for (int a = 0; a < 2; ++a)
#pragma unroll
            for (int b = 0; b < 2; ++b)
#pragma unroll
                for (int m = 0; m < 4; ++m)
#pragma unroll
                    for (int n = 0; n < 2; ++n) acc[a][b][m][n] = (f32x4){0.f, 0.f, 0.f, 0.f};
        cur = nxt; cA = nA; cB = nB; ++ui;
        if constexpr (ALIGN_EPI) { if (wr == 1) PG8_BAR; }
    }
    PG8_WAIT_V(0);
    if constexpr (!ALIGN_EPI) { if (wr == 0) PG8_BAR; }
    PG8_BAR;
    if constexpr (Epi::AFTER_DRAIN) { E.fused(acc, cur, wr, wc, fr, fq, lds, wid, lane); }
#undef PG8_ABASE
#undef PG8_SA
#undef PG8_SB
#undef PG8_STAGE
#undef PG8_LDA
#undef PG8_LDB
#undef PG8_MMA
#undef PG8_WAIT_V
#undef PG8_WAIT_L
#undef PG8_BAR
#undef PG8_SCHED
}
}

namespace mk {
using pg8::bf16_t; using pg8::f32x4; using pg8::u32x4; using pg8::u32x2; using pg8::cvt_pk_bf16;
#define LAS __attribute__((address_space(3)))
constexpr int NB = 4, T = 4096, D = 1024, NTOK = NB * T, INC = 2328, INP = 2560, FF = 4096;
constexpr size_t MiB = 1u << 20;
constexpr size_t WS_CTL = 0;
constexpr size_t WS_W = 1 * MiB, W_LAYER = 30 * MiB;
constexpr size_t W_IN = 0, W_OUT = 5 * MiB, W_MQ = 7 * MiB, W_MKV = 8 * MiB, W_MO = 10 * MiB, W_FF1 = 11 * MiB, W_FF2 = 19 * MiB, W_C1 = 27 * MiB, W_C2 = 29 * MiB, W_SG = 29 * MiB + 128 * 1024, W_B1P = 29 * MiB + 512 * 1024;
constexpr size_t WS_XB = 61 * MiB;
constexpr size_t WS_OV = 93 * MiB;
constexpr size_t WS_U = WS_OV, WS_V = WS_OV + 16 * MiB, WS_Q = WS_OV + 32 * MiB, WS_KV = WS_OV + 48 * MiB, WS_MIX = WS_OV + 72 * MiB, WS_QM = WS_OV + 104 * MiB, WS_OM = WS_OV + 120 * MiB;
constexpr size_t WS_HB = WS_OV;
constexpr size_t WS_SM = 229 * MiB;
constexpr size_t WS_GL = WS_SM, WS_KC = WS_SM + 2 * MiB, WS_VC = WS_KC + 256 * 1024, WS_HID = WS_SM + 3 * MiB, WS_MASK = WS_SM + 5 * MiB, WS_MEMB = WS_SM + 6 * MiB, WS_KVM = WS_SM + 8 * MiB, WS_END = WS_SM + 10 * MiB;
static_assert(WS_END <= 256 * MiB, "ws map");
constexpr int SSQ_MEM_OFF = 6 * NTOK;

struct Args { const float* in[27]; float* out; unsigned char* ws; int ph_lo, ph_hi; };
enum { I_X = 0, I_MEM, I_NMG, I_WIN, I_SGLNG, I_SGLNB, I_SGW, I_SGB, I_QNG, I_KNG, I_CPOS, I_CW1, I_CB1, I_CW2, I_CB2, I_MOG, I_WOUT, I_NMEMG, I_MKVG, I_WMQ, I_WMKV, I_MQG, I_MKG, I_WMO, I_NFG, I_WFF1, I_WFF2 };

__device__ __forceinline__ float bf2f(unsigned short b) { return __uint_as_float((unsigned)b << 16); }
__device__ __forceinline__ float wave_sum(float v) {
#pragma unroll
    for (int o = 1; o < 64; o <<= 1) v += __shfl_xor(v, o);
    return v; }

__device__ __forceinline__ void transpose_item(const float* W, int K, int N, int Npad, const float* gain, bf16_t* WT, LAS float* scr, int item, int lane) {
    const int nblk = Npad / 32, kb = item / nblk, nb = item % nblk, k0 = 64 * kb, n0 = 32 * nb;
    const int nn = n0 + (lane & 31);
#pragma unroll 8
    for (int i = 0; i < 32; ++i) { const int kk = 2 * i + (lane >> 5); float v = 0.f; if (nn < N) { v = W[(size_t)(k0 + kk) * N + nn]; if (gain) v *= gain[k0 + kk]; } scr[kk * 33 + (lane & 31)] = v; }
    asm volatile("s_waitcnt lgkmcnt(0)" ::: "memory");
    const int c = lane & 7;
#pragma unroll
    for (int j = 0; j < 4; ++j) { const int n = (lane >> 3) + 8 * j; const LAS float* s = scr + (8 * c) * 33 + n;
        u32x4 o; o.x = cvt_pk_bf16(s[0 * 33], s[1 * 33]); o.y = cvt_pk_bf16(s[2 * 33], s[3 * 33]); o.z = cvt_pk_bf16(s[4 * 33], s[5 * 33]); o.w = cvt_pk_bf16(s[6 * 33], s[7 * 33]);
        *(u32x4*)(WT + (size_t)(n0 + n) * K + k0 + 8 * c) = o; }
    asm volatile("s_waitcnt lgkmcnt(0)" ::: "memory");
}

__device__ __forceinline__ void prologue(const Args& a, LAS unsigned char* lds, int gw, int NGW, int wave, int lane) {
    LAS float* scr = (LAS float*)(lds + wave * 16384);
    unsigned char* ws = a.ws; float* ctl = (float*)(ws + WS_CTL);
    int it0 = 0;
#define TR_MAT(Wp, K_, N_, NP_, Gp, DST) { const int cnt = ((K_) / 64) * ((NP_) / 32); for (int it = gw; it < it0 + cnt; it += NGW) { if (it >= it0) transpose_item((Wp), (K_), (N_), (NP_), (Gp), (bf16_t*)(DST), scr, it - it0, lane); } it0 += cnt; }
    for (int l = 0; l < 2; ++l) {
        unsigned char* wl = ws + WS_W + l * W_LAYER;
        TR_MAT(a.in[I_WIN] + (size_t)l * 1024 * INC, 1024, INC, INP, a.in[I_NMG] + l * 1024, wl + W_IN)
        TR_MAT(a.in[I_WOUT] + (size_t)l * 1024 * 1024, 1024, 1024, 1024, a.in[I_MOG] + l * 1024, wl + W_OUT)
        TR_MAT(a.in[I_WMQ] + (size_t)l * 1024 * 512, 1024, 512, 512, a.in[I_NMEMG] + l * 1024, wl + W_MQ)
        TR_MAT(a.in[I_WMKV] + (size_t)l * 1024 * 1024, 1024, 1024, 1024, a.in[I_MKVG] + l * 1024, wl + W_MKV)
        TR_MAT(a.in[I_WMO] + (size_t)l * 512 * 1024, 512, 1024, 1024, (const float*)nullptr, wl + W_MO)
        TR_MAT(a.in[I_WFF1] + (size_t)l * 1024 * 4096, 1024, 4096, 4096, a.in[I_NFG] + l * 1024, wl + W_FF1)
        TR_MAT(a.in[I_WFF2] + (size_t)l * 4096 * 1024, 4096, 1024, 1024, (const float*)nullptr, wl + W_FF2)
        for (int kv = 0; kv < 2; ++kv) {
            TR_MAT(a.in[I_CW1] + (size_t)(l * 2 + kv) * 2048 * 256, 2048, 256, 256, (const float*)nullptr, wl + W_C1 + (size_t)kv * 256 * 2048 * 2)
            TR_MAT(a.in[I_CW2] + (size_t)(l * 2 + kv) * 256 * 64, 256, 64, 64, (const float*)nullptr, wl + W_C2 + (size_t)kv * 64 * 256 * 2)
        }
    }
#undef TR_MAT
    { const float* x = a.in[I_X]; bf16_t* XB = (bf16_t*)(ws + WS_XB);
      for (int r = gw; r < NTOK; r += NGW) { const f32x4* xr = (const f32x4*)(x + (size_t)r * 1024) + lane; f32x4* orow = (f32x4*)(a.out + (size_t)r * 1024) + lane; unsigned long long* xb = (unsigned long long*)(XB + (size_t)r * 1024) + lane; float s = 0.f;
#pragma unroll
          for (int j = 0; j < 4; ++j) { const f32x4 v = xr[64 * j]; orow[64 * j] = v; s += (v[0] * v[0] + v[1] * v[1]) + (v[2] * v[2] + v[3] * v[3]); xb[64 * j] = (unsigned long long)cvt_pk_bf16(v[0], v[1]) | ((unsigned long long)cvt_pk_bf16(v[2], v[3]) << 32); }
          s = wave_sum(s); if (lane == 0) ctl[r] = s; if (lane >= 1 && lane <= 5) ctl[lane * NTOK + r] = 0.f; } }
    { const float* mem = a.in[I_MEM]; bf16_t* MB = (bf16_t*)(ws + WS_MEMB);
      for (int r = gw; r < 1024; r += NGW) { const f32x4* xr = (const f32x4*)(mem + (size_t)r * 1024) + lane; unsigned long long* xb = (unsigned long long*)(MB + (size_t)r * 1024) + lane; float s = 0.f;
#pragma unroll
          for (int j = 0; j < 4; ++j) { const f32x4 v = xr[64 * j]; s += (v[0] * v[0] + v[1] * v[1]) + (v[2] * v[2] + v[3] * v[3]); xb[64 * j] = (unsigned long long)cvt_pk_bf16(v[0], v[1]) | ((unsigned long long)cvt_pk_bf16(v[2], v[3]) << 32); }
          s = wave_sum(s); if (lane == 0) ctl[SSQ_MEM_OFF + r] = s; } }
    for (int it = gw; it < 16; it += NGW) { const int lk = it >> 2, j = (it & 3) * 64 + lane; const float* W1 = a.in[I_CW1] + (size_t)lk * 2048 * 256; const float* pos = a.in[I_CPOS] + (size_t)lk * 2048; float s = a.in[I_CB1][lk * 256 + j];
        for (int k = 0; k < 2048; ++k) s += pos[k] * W1[(size_t)k * 256 + j];
        ((float*)(ws + WS_W + (lk >> 1) * W_LAYER + W_B1P))[(lk & 1) * 256 + j] = s; }
    for (int it = gw; it < 2 * 8 * 128; it += NGW) { const int t = it & 127; const float* wr = a.in[I_SGW] + (size_t)it * 128; unsigned* dst = (unsigned*)(ws + WS_W + (it >> 10) * W_LAYER + W_SG) + (size_t)(it & 1023) * 64 + lane;
        float v[2];
#pragma unroll
        for (int e = 0; e < 2; ++e) { const int p = lane * 2 + e, ks = p >> 4, hh = (p >> 3) & 1, j = p & 7, sidx = 16 * ks + 8 * (j >> 2) + 4 * hh + (j & 3); v[e] = sidx <= t ? wr[sidx] : 0.f; }
        *dst = cvt_pk_bf16(v[0], v[1]); }
}

typedef float f32x16 __attribute__((ext_vector_type(16)));
typedef short s16x4 __attribute__((ext_vector_type(4)));
typedef short v4i16_t __attribute__((ext_vector_type(4)));
using pg8::bf16x8;
__device__ __forceinline__ int crow(int r, int hi) { return (r & 3) + 8 * (r >> 2) + 4 * hi; }
__device__ __forceinline__ s16x4 vtr(const LAS char* p) { return __builtin_bit_cast(s16x4, __builtin_amdgcn_ds_read_tr16_b64_v4i16((LAS v4i16_t*)p)); }
#define MFMA32(a, b, c) __builtin_amdgcn_mfma_f32_32x32x16_bf16(a, b, c, 0, 0, 0)
#define VFRAG(lo, hi) (bf16x8){lo[0], lo[1], lo[2], lo[3], hi[0], hi[1], hi[2], hi[3]}
__device__ __forceinline__ void lds_fadd(LAS float* p, float v) { (void)__hip_atomic_fetch_add(p, v, __ATOMIC_RELAXED, __HIP_MEMORY_SCOPE_WORKGROUP); }
__device__ __forceinline__ unsigned short f2bf(float f) { return (unsigned short)(cvt_pk_bf16(f, 0.f) & 0xffffu); }

__device__ __forceinline__ void tokprep_token(bf16_t* Q, bf16_t* KV, const float* qg, const float* kg, int tok, int lane) {
    { u32x4* p = (u32x4*)(Q + (size_t)tok * 512) + lane; const u32x4 w = *p; float v[8];
#pragma unroll
      for (int i = 0; i < 4; ++i) { v[2 * i] = __uint_as_float(w[i] << 16); v[2 * i + 1] = __uint_as_float(w[i] & 0xffff0000u); }
      float ss = 0.f;
#pragma unroll
      for (int i = 0; i < 8; ++i) ss += v[i] * v[i];
      ss += __shfl_xor(ss, 1); ss += __shfl_xor(ss, 2); ss += __shfl_xor(ss, 4);
      const float rs = rsqrtf(ss * (1.f / 64.f) + 1e-6f) * (0.125f * 1.4426950408889634f); const float* g = qg + (lane & 7) * 8;
      u32x4 o;
#pragma unroll
      for (int i = 0; i < 4; ++i) o[i] = cvt_pk_bf16(v[2 * i] * rs * g[2 * i], v[2 * i + 1] * rs * g[2 * i + 1]);
      *p = o; }
    if (lane < 32) { const int br = 1 + (lane >> 4); u32x4* p = (u32x4*)(KV + (size_t)tok * 768 + br * 256) + (lane & 15); const u32x4 w = *p; float v[8];
#pragma unroll
      for (int i = 0; i < 4; ++i) { v[2 * i] = __uint_as_float(w[i] << 16); v[2 * i + 1] = __uint_as_float(w[i] & 0xffff0000u); }
      float ss = 0.f;
#pragma unroll
      for (int i = 0; i < 8; ++i) ss += v[i] * v[i];
      ss += __shfl_xor(ss, 1); ss += __shfl_xor(ss, 2); ss += __shfl_xor(ss, 4);
      const float rs = rsqrtf(ss * (1.f / 64.f) + 1e-6f); const float* g = kg + br * 64 + (lane & 7) * 8;
      u32x4 o;
#pragma unroll
      for (int i = 0; i < 4; ++i) o[i] = cvt_pk_bf16(v[2 * i] * rs * g[2 * i], v[2 * i + 1] * rs * g[2 * i + 1]);
      *p = o; }
}
__device__ __forceinline__ void cmp2_row(const bf16_t* HID, const bf16_t* w2t, const float* b2, const float* kg0, bf16_t* KC, bf16_t* VC, int row, int lane) {
#pragma unroll 1
    for (int kv = 0; kv < 2; ++kv) { const u32x4* h = (const u32x4*)(HID + (size_t)kv * 2048 * 256 + (size_t)row * 256); const u32x4* w = (const u32x4*)(w2t + (size_t)kv * 64 * 256 + (size_t)lane * 256); float s = b2[kv * 64 + lane];
#pragma unroll 4
        for (int k = 0; k < 32; ++k) { const u32x4 a = h[k], b = w[k];
#pragma unroll
            for (int i = 0; i < 4; ++i) s += __uint_as_float(a[i] << 16) * __uint_as_float(b[i] << 16) + __uint_as_float(a[i] & 0xffff0000u) * __uint_as_float(b[i] & 0xffff0000u); }
        if (kv == 0) { const float ss = wave_sum(s * s); s = s * rsqrtf(ss * (1.f / 64.f) + 1e-6f) * kg0[lane]; }
        if ((row & 255) == 255) s = 0.f;
        (kv ? VC : KC)[(size_t)row * 64 + lane] = f2bf(s); }
}
__device__ __forceinline__ void memk_norm_item(bf16_t* KVM, const float* kg, int r, int lane) {
    unsigned* p = (unsigned*)(KVM + (size_t)(r >> 2) * 1024 + (r & 3) * 128) + lane; const unsigned w = *p; const float v0 = __uint_as_float(w << 16), v1 = __uint_as_float(w & 0xffff0000u);
    const float ss = wave_sum(v0 * v0 + v1 * v1); const float rs = rsqrtf(ss * (1.f / 128.f) + 1e-6f); *p = cvt_pk_bf16(v0 * rs * kg[2 * lane], v1 * rs * kg[2 * lane + 1]);
}

constexpr int SG_STAT = 0, SG_SSQ = 1024, SG_VN = 2048;
__device__ __forceinline__ void sgu_unit(LAS unsigned char* lds, int unit, const bf16_t* U, const bf16_t* Vb, const bf16_t* Wsg, const float* lng, const float* lnb, const float* sgb, bf16_t* MIX) {
    int tid_ = threadIdx.x; asm volatile("" : "+v"(tid_)); const int tid = tid_, lane = tid & 63, g = __builtin_amdgcn_readfirstlane(tid >> 6), r32 = lane & 31, hi = lane >> 5;
    const int tok0 = unit * 128;
    LAS float* STAT = (LAS float*)(lds + SG_STAT); LAS float* SSQA = (LAS float*)(lds + SG_SSQ);
    { const int tl = tid >> 2, part = tid & 3; const u32x4* p = (const u32x4*)(Vb + (size_t)(tok0 + tl) * 512 + part * 128); float s = 0.f, s2 = 0.f;
#pragma unroll 4
      for (int i = 0; i < 16; ++i) { const u32x4 w = p[i];
#pragma unroll
          for (int e = 0; e < 4; ++e) { const float a = __uint_as_float(w[e] << 16), b = __uint_as_float(w[e] & 0xffff0000u); s += a + b; s2 += a * a + b * b; } }
      s += __shfl_xor(s, 1); s += __shfl_xor(s, 2); s2 += __shfl_xor(s2, 1); s2 += __shfl_xor(s2, 2);
      if (part == 0) { const float mu = s * (1.f / 512.f); const float var = fmaxf(s2 * (1.f / 512.f) - mu * mu, 0.f); STAT[tl * 2] = mu; STAT[tl * 2 + 1] = rsqrtf(var + 1e-6f); }
      if (tid < 128) SSQA[tid] = 0.f; }
    __syncthreads();
    LAS unsigned char* VN = lds + SG_VN + g * 16384;
    { const int piece = lane & 7; float gg[8], bb[8];
#pragma unroll
      for (int i = 0; i < 8; ++i) { gg[i] = lng[g * 64 + piece * 8 + i]; bb[i] = lnb[g * 64 + piece * 8 + i]; }
#pragma unroll 4
      for (int it = 0; it < 16; ++it) { const int row = it * 8 + (lane >> 3); const u32x4 w = *(const u32x4*)(Vb + (size_t)(tok0 + row) * 512 + g * 64 + piece * 8); const float mu = STAT[row * 2], rs = STAT[row * 2 + 1]; u32x4 o;
#pragma unroll
          for (int e = 0; e < 4; ++e) { const float a = (__uint_as_float(w[e] << 16) - mu) * rs * gg[2 * e] + bb[2 * e], b = (__uint_as_float(w[e] & 0xffff0000u) - mu) * rs * gg[2 * e + 1] + bb[2 * e + 1]; o[e] = cvt_pk_bf16(a, b); }
          *(LAS u32x4*)(VN + (piece >> 2) * 8192 + row * 64 + (piece & 3) * 16) = o; } }
    asm volatile("s_waitcnt lgkmcnt(0)" ::: "memory");
    f32x16 acc[2][4];
#pragma unroll
    for (int dh = 0; dh < 2; ++dh)
#pragma unroll
        for (int mt = 0; mt < 4; ++mt)
#pragma unroll
            for (int r = 0; r < 16; ++r) acc[dh][mt][r] = 0.f;
    const LAS char* vb = (const LAS char*)VN + ((lane >> 4) & 1) * 32 + (lane & 3) * 8 + (4 * hi + ((lane & 15) >> 2)) * 64;
    const bf16_t* wrow = Wsg + ((size_t)g * 128 + r32) * 128 + 8 * hi;
#pragma unroll
    for (int ks = 0; ks < 8; ++ks) { bf16x8 vf[2];
#pragma unroll
        for (int dh = 0; dh < 2; ++dh) { const s16x4 lo = vtr(vb + dh * 8192 + ks * 1024), hh = vtr(vb + dh * 8192 + ks * 1024 + 512); vf[dh] = VFRAG(lo, hh); }
#pragma unroll
        for (int mt = 0; mt < 4; ++mt) { if (ks <= 2 * mt + 1) { const bf16x8 wf = *(const bf16x8*)(wrow + (size_t)mt * 32 * 128 + ks * 16);
                acc[0][mt] = MFMA32(vf[0], wf, acc[0][mt]); acc[1][mt] = MFMA32(vf[1], wf, acc[1][mt]); } } }
#pragma unroll
    for (int mt = 0; mt < 4; ++mt) { const int t = mt * 32 + r32; const float bias = sgb[g * 128 + t]; const bf16_t* up = U + (size_t)(tok0 + t) * 512 + g * 64 + 4 * hi; float ss = 0.f;
#pragma unroll
        for (int dh = 0; dh < 2; ++dh)
#pragma unroll
            for (int a4 = 0; a4 < 4; ++a4) { const u32x2 w = *(const u32x2*)(up + dh * 32 + a4 * 8);
                const float u0 = __uint_as_float(w.x << 16), u1 = __uint_as_float(w.x & 0xffff0000u), u2 = __uint_as_float(w.y << 16), u3 = __uint_as_float(w.y & 0xffff0000u);
                float x0 = u0 * (acc[dh][mt][4 * a4] + bias), x1 = u1 * (acc[dh][mt][4 * a4 + 1] + bias), x2 = u2 * (acc[dh][mt][4 * a4 + 2] + bias), x3 = u3 * (acc[dh][mt][4 * a4 + 3] + bias);
                acc[dh][mt][4 * a4] = x0; acc[dh][mt][4 * a4 + 1] = x1; acc[dh][mt][4 * a4 + 2] = x2; acc[dh][mt][4 * a4 + 3] = x3; ss += (x0 * x0 + x1 * x1) + (x2 * x2 + x3 * x3); }
        ss += __shfl_xor(ss, 32); if (hi == 0) lds_fadd(SSQA + t, ss); }
    __syncthreads();
#pragma unroll
    for (int mt = 0; mt < 4; ++mt) { const int t = mt * 32 + r32; const float rs = rsqrtf(SSQA[t] * (1.f / 512.f) + 1e-6f); bf16_t* op = MIX + (size_t)(tok0 + t) * 1024 + g * 64 + 4 * hi;
#pragma unroll
        for (int dh = 0; dh < 2; ++dh)
#pragma unroll
            for (int a4 = 0; a4 < 4; ++a4) { u32x2 w; w.x = cvt_pk_bf16(acc[dh][mt][4 * a4] * rs, acc[dh][mt][4 * a4 + 1] * rs); w.y = cvt_pk_bf16(acc[dh][mt][4 * a4 + 2] * rs, acc[dh][mt][4 * a4 + 3] * rs); *(u32x2*)(op + dh * 32 + a4 * 8) = w; } }
    __syncthreads();
}

constexpr int A_KB = 0, A_VB = 32768, A_IMP = 65536, A_MASK = A_IMP + 2 * 32 * 65 * 4, A_SSQ = A_MASK + 512;
template <int MODE>
__device__ __forceinline__ void attn_seg(LAS unsigned char* lds, const bf16_t* Kb, const bf16_t* Vb, int pitch, int hstride, int tile_lo, int tile_hi, const bf16x8 (&qr)[4], f32x16 (&oT)[2], float& lsum,
                                         int kmin, int kmax, unsigned mlo, unsigned mhi, int tq, float inv_l, int kvh, int wave, int lane, int r32, int hi) {
    if (tile_lo > tile_hi) return;
    constexpr bool HASV = (MODE != 0);
    u32x4 sk0, sk1, sv0, sv1;
    const bf16_t* kthr = Kb + (size_t)lane * pitch + wave * 8; const bf16_t* vthr = Vb + (size_t)(16 * (wave & 3) + (lane >> 2)) * pitch + (wave >> 2) * 32 + (lane & 3) * 8;
    const int sdst = wave * 1024 + lane * 16;
#define A_LD(tile) do { const size_t to_ = (size_t)(tile) * 64 * pitch; sk0 = *(const u32x4*)(kthr + to_); sk1 = *(const u32x4*)(kthr + to_ + hstride); if (HASV) { sv0 = *(const u32x4*)(vthr + to_); sv1 = *(const u32x4*)(vthr + to_ + hstride); } } while (0)
#define A_ST(so) do { *(LAS u32x4*)(lds + A_KB + (so) + sdst) = sk0; *(LAS u32x4*)(lds + A_KB + (so) + 8192 + sdst) = sk1; if (HASV) { *(LAS u32x4*)(lds + A_VB + (so) + sdst) = sv0; *(LAS u32x4*)(lds + A_VB + (so) + 8192 + sdst) = sv1; } } while (0)
    const LAS char* kbase = (const LAS char*)(lds + A_KB) + kvh * 8192 + hi * 1024 + r32 * 16;
    const LAS char* vbase = (const LAS char*)(lds + A_VB) + kvh * 8192 + ((lane >> 4) & 1) * 32 + (lane & 3) * 8 + (4 * hi + ((lane & 15) >> 2)) * 64;
    LAS float* IMP = (LAS float*)(lds + A_IMP) + (kvh * 32 + r32) * 65;
    A_LD(tile_lo); A_ST(0); __syncthreads();
#pragma unroll 1
    for (int tile = tile_lo; tile <= tile_hi; ++tile) {
        const int so = ((tile - tile_lo) & 1) * 16384;
        if (tile < tile_hi) A_LD(tile + 1);
        bf16x8 kf[8];
#pragma unroll
        for (int d0 = 0; d0 < 4; ++d0) { kf[2 * d0] = *(const LAS bf16x8*)(kbase + so + d0 * 2048); kf[2 * d0 + 1] = *(const LAS bf16x8*)(kbase + so + d0 * 2048 + 512); }
        f32x16 p0, p1;
#pragma unroll
        for (int r = 0; r < 16; ++r) { p0[r] = 0.f; p1[r] = 0.f; }
#pragma unroll
        for (int d0 = 0; d0 < 4; ++d0) { p0 = MFMA32(kf[2 * d0], qr[d0], p0); p1 = MFMA32(kf[2 * d0 + 1], qr[d0], p1); }
        int a, bb;
        if (MODE == 2) { const unsigned sel = tile < 32 ? (mlo >> tile) & 1u : (mhi >> (tile - 32)) & 1u; a = sel ? -64 * tile : (1 << 20); bb = sel ? tq - 64 * tile : (1 << 20); }
        else { a = kmin - 64 * tile; bb = kmax - 64 * tile; }
#pragma unroll
        for (int r = 0; r < 16; ++r) { p0[r] = __builtin_amdgcn_exp2f(p0[r]); p1[r] = __builtin_amdgcn_exp2f(p1[r]); }
        if (!__all(a <= 0 && bb >= 63)) { const unsigned span = (unsigned)(bb - a);
#pragma unroll
            for (int r = 0; r < 16; ++r) { const int rel = crow(r, hi); p0[r] = ((unsigned)(rel - a) <= span) ? p0[r] : 0.f; p1[r] = ((unsigned)(rel + 32 - a) <= span) ? p1[r] : 0.f; } }
        if (MODE == 1) {
#pragma unroll
            for (int r = 0; r < 16; ++r) { p0[r] *= inv_l; p1[r] *= inv_l; }
#pragma unroll
            for (int a4 = 0; a4 < 4; ++a4) { const int j0 = 16 * tile + 2 * a4 + hi;
                const float h0 = 0.5f * p0[4 * a4 + 3], h1 = 0.5f * p1[4 * a4 + 3];
                lds_fadd(IMP + j0, (p0[4 * a4] + p0[4 * a4 + 1]) + (p0[4 * a4 + 2] + h0)); lds_fadd(IMP + j0 + 1, h0);
                lds_fadd(IMP + j0 + 8, (p1[4 * a4] + p1[4 * a4 + 1]) + (p1[4 * a4 + 2] + h1)); lds_fadd(IMP + j0 + 9, h1); }
        } else { float s = 0.f;
#pragma unroll
            for (int r = 0; r < 16; ++r) s += p0[r] + p1[r];
            lsum += s; }
        if (HASV) {
            bf16x8 pa[4];
            { u32x4 w0, w1, w2, w3;
#pragma unroll
              for (int i = 0; i < 4; ++i) { w0[i] = cvt_pk_bf16(p0[2 * i], p0[2 * i + 1]); w1[i] = cvt_pk_bf16(p0[8 + 2 * i], p0[8 + 2 * i + 1]); w2[i] = cvt_pk_bf16(p1[2 * i], p1[2 * i + 1]); w3[i] = cvt_pk_bf16(p1[8 + 2 * i], p1[8 + 2 * i + 1]); }
              pa[0] = __builtin_bit_cast(bf16x8, w0); pa[1] = __builtin_bit_cast(bf16x8, w1); pa[2] = __builtin_bit_cast(bf16x8, w2); pa[3] = __builtin_bit_cast(bf16x8, w3); }
#pragma unroll
            for (int dh = 0; dh < 2; ++dh)
#pragma unroll
                for (int ks = 0; ks < 4; ++ks) { const s16x4 lo = vtr(vbase + so + dh * 4096 + ks * 1024), hh = vtr(vbase + so + dh * 4096 + ks * 1024 + 512); oT[dh] = MFMA32(VFRAG(lo, hh), pa[ks], oT[dh]); }
        }
        if (tile < tile_hi) A_ST(so ^ 16384);
        __syncthreads();
    }
#undef A_LD
#undef A_ST
}

__device__ __forceinline__ void attn_unit(LAS unsigned char* lds, int b, int qt, const bf16_t* Q, const bf16_t* KV, const bf16_t* KC, const bf16_t* VC, const float* GL, bf16_t* MIX) {
    int tid_ = threadIdx.x; asm volatile("" : "+v"(tid_)); const int tid = tid_, lane = tid & 63, wave = __builtin_amdgcn_readfirstlane(tid >> 6), r32 = lane & 31, hi = lane >> 5, kvh = wave >> 2;
    const int t0 = qt * 32, tq = t0 + r32; const size_t tok = (size_t)b * T + tq;
    bf16x8 qr[4];
#pragma unroll
    for (int d0 = 0; d0 < 4; ++d0) qr[d0] = *(const bf16x8*)(Q + tok * 512 + wave * 64 + d0 * 16 + hi * 8);
    LAS float* IMPA = (LAS float*)(lds + A_IMP); LAS unsigned* MASKL = (LAS unsigned*)(lds + A_MASK); LAS float* SSQL = (LAS float*)(lds + A_SSQ);
    for (int i = tid; i < 2 * 32 * 65; i += 512) IMPA[i] = 0.f;
    if (tid < 32) SSQL[tid] = 0.f;
    const float* glp = GL + tok * 24 + wave * 3;
    const float g0 = 1.f / (1.f + __expf(-glp[0])), g1 = 1.f / (1.f + __expf(-glp[1])), g2 = 1.f / (1.f + __expf(-glp[2]));
    f32x16 tot[2], oT[2];
    const int nvalid = tq >= 31 ? (tq - 31) / 16 + 1 : 0; const int ntc = (2 * qt + 1 + 63) >> 6;
    const int ckmin = nvalid > 0 ? 0 : (1 << 20), ckmax = nvalid > 0 ? nvalid - 1 : (1 << 20);
    const bf16_t* KCb = KC + (size_t)(b * 2) * 256 * 64; const bf16_t* VCb = VC + (size_t)(b * 2) * 256 * 64;
    float lc = 0.f;
#pragma unroll
    for (int r = 0; r < 16; ++r) { oT[0][r] = 0.f; oT[1][r] = 0.f; }
    attn_seg<0>(lds, KCb, VCb, 64, 256 * 64, 0, ntc - 1, qr, oT, lc, ckmin, ckmax, 0u, 0u, tq, 0.f, kvh, wave, lane, r32, hi);
    lc += __shfl_xor(lc, 32); const float inv_lc = lc > 0.f ? 1.f / lc : 0.f;
    { float dummy = 0.f; attn_seg<1>(lds, KCb, VCb, 64, 256 * 64, 0, ntc - 1, qr, oT, dummy, ckmin, ckmax, 0u, 0u, tq, inv_lc, kvh, wave, lane, r32, hi); }
#pragma unroll
    for (int r = 0; r < 16; ++r) { tot[0][r] = oT[0][r] * g0; tot[1][r] = oT[1][r] * g0; oT[0][r] = 0.f; oT[1][r] = 0.f; }
    { const int pair = tid >> 3, jj = tid & 7, qq = pair & 31; const int tb = (t0 + qq) >> 6; LAS float* row = IMPA + pair * 65; float val[8];
#pragma unroll
      for (int k = 0; k < 8; ++k) { const int j = jj * 8 + k; const float v = row[j]; const bool forced = (j == 0) || (j == tb) || (j == tb - 1); val[k] = forced ? 1e4f : (j <= tb ? v : -1e4f); }
#pragma unroll
      for (int k = 0; k < 8; ++k) row[jj * 8 + k] = val[k];
      asm volatile("s_waitcnt lgkmcnt(0)" ::: "memory");
      int rank[8];
#pragma unroll
      for (int k = 0; k < 8; ++k) rank[k] = 0;
#pragma unroll 4
      for (int j2 = 0; j2 < 64; ++j2) { const float o = row[j2];
#pragma unroll
          for (int k = 0; k < 8; ++k) rank[k] += ((o > val[k]) || (o == val[k] && j2 < jj * 8 + k)) ? 1 : 0; }
      unsigned bits = 0u;
#pragma unroll
      for (int k = 0; k < 8; ++k) bits |= (rank[k] < 16) ? (1u << k) : 0u;
      unsigned lo = jj < 4 ? bits << (jj * 8) : 0u, hw = jj >= 4 ? bits << ((jj - 4) * 8) : 0u;
      lo |= __shfl_xor(lo, 1); lo |= __shfl_xor(lo, 2); lo |= __shfl_xor(lo, 4); hw |= __shfl_xor(hw, 1); hw |= __shfl_xor(hw, 2); hw |= __shfl_xor(hw, 4);
      if (jj == 0) { MASKL[pair * 2] = lo; MASKL[pair * 2 + 1] = hw; } }
    __syncthreads();
    const unsigned mlo = MASKL[(kvh * 32 + r32) * 2], mhi = MASKL[(kvh * 32 + r32) * 2 + 1];
    const int jmax = (t0 + 31) >> 6;
    const bf16_t* KVb = KV + (size_t)b * T * 768;
    float ls = 0.f;
    attn_seg<2>(lds, KVb + 256, KVb + 384, 768, 64, 0, jmax, qr, oT, ls, 0, 0, mlo, mhi, tq, 0.f, kvh, wave, lane, r32, hi);
    ls += __shfl_xor(ls, 32);
    { const float c = ls > 0.f ? g1 / ls : 0.f;
#pragma unroll
      for (int r = 0; r < 16; ++r) { tot[0][r] += oT[0][r] * c; tot[1][r] += oT[1][r] * c; oT[0][r] = 0.f; oT[1][r] = 0.f; } }
    float lw = 0.f; const int jlo = t0 >= 511 ? (t0 - 511) >> 6 : 0;
    attn_seg<3>(lds, KVb + 512, KVb + 640, 768, 64, jlo, jmax, qr, oT, lw, tq - 511, tq, 0u, 0u, tq, 0.f, kvh, wave, lane, r32, hi);
    lw += __shfl_xor(lw, 32);
    { const float c = lw > 0.f ? g2 / lw : 0.f;
#pragma unroll
      for (int r = 0; r < 16; ++r) { tot[0][r] += oT[0][r] * c; tot[1][r] += oT[1][r] * c; } }
    { float ss = 0.f;
#pragma unroll
      for (int r = 0; r < 16; ++r) ss += tot[0][r] * tot[0][r] + tot[1][r] * tot[1][r];
      ss += __shfl_xor(ss, 32); if (hi == 0) lds_fadd(SSQL + r32, ss); }
    __syncthreads();
    { const float rs = rsqrtf(SSQL[r32] * (1.f / 512.f) + 1e-6f); bf16_t* op = MIX + tok * 1024 + 512 + wave * 64 + 4 * hi;
#pragma unroll
      for (int dh = 0; dh < 2; ++dh)
#pragma unroll
          for (int a4 = 0; a4 < 4; ++a4) { u32x2 w; w.x = cvt_pk_bf16(tot[dh][4 * a4] * rs, tot[dh][4 * a4 + 1] * rs); w.y = cvt_pk_bf16(tot[dh][4 * a4 + 2] * rs, tot[dh][4 * a4 + 3] * rs); *(u32x2*)(op + dh * 32 + a4 * 8) = w; } }
    __syncthreads();
}

__device__ __forceinline__ void memattn_unit(LAS unsigned char* lds, int b, int h, int qt, const bf16_t* QM, const bf16_t* KVM, const float* qg, bf16_t* OM) {
    int tid_ = threadIdx.x; asm volatile("" : "+v"(tid_)); const int tid = tid_, lane = tid & 63, wave = __builtin_amdgcn_readfirstlane(tid >> 6), r32 = lane & 31, hi = lane >> 5;
    const size_t tok = (size_t)b * T + qt * 256 + wave * 32 + r32;
    bf16x8 qr[8];
    { float v[64]; float ss = 0.f;
#pragma unroll
      for (int d0 = 0; d0 < 8; ++d0) { const u32x4 w = *(const u32x4*)(QM + tok * 512 + h * 128 + d0 * 16 + hi * 8);
#pragma unroll
          for (int i = 0; i < 4; ++i) { const float a = __uint_as_float(w[i] << 16), c = __uint_as_float(w[i] & 0xffff0000u); v[d0 * 8 + 2 * i] = a; v[d0 * 8 + 2 * i + 1] = c; ss += a * a + c * c; } }
      ss += __shfl_xor(ss, 32); const float rs = rsqrtf(ss * (1.f / 128.f) + 1e-6f) * (0.08838834764831845f * 1.4426950408889634f);
#pragma unroll
      for (int d0 = 0; d0 < 8; ++d0) { u32x4 w; const float* gp = qg + d0 * 16 + hi * 8;
#pragma unroll
          for (int i = 0; i < 4; ++i) w[i] = cvt_pk_bf16(v[d0 * 8 + 2 * i] * rs * gp[2 * i], v[d0 * 8 + 2 * i + 1] * rs * gp[2 * i + 1]);
          qr[d0] = __builtin_bit_cast(bf16x8, w); } }
    const bf16_t* Kg = KVM + (size_t)b * 256 * 1024 + h * 128; const bf16_t* Vg = Kg + 512;
    u32x4 sk[2], sv[2];
#define M_LD(tile) do { _Pragma("unroll") for (int i = 0; i < 2; ++i) { sk[i] = *(const u32x4*)(Kg + (size_t)((tile) * 64 + lane) * 1024 + (wave * 2 + i) * 8); const int p = i * 512 + tid; \
        sv[i] = *(const u32x4*)(Vg + (size_t)((tile) * 64 + ((p & 255) >> 2)) * 1024 + (p >> 8) * 32 + (p & 3) * 8); } } while (0)
#define M_ST(so) do { _Pragma("unroll") for (int i = 0; i < 2; ++i) { *(LAS u32x4*)(lds + (so) + (wave * 2 + i) * 1024 + lane * 16) = sk[i]; *(LAS u32x4*)(lds + 32768 + (so) + (i * 512 + tid) * 16) = sv[i]; } } while (0)
    const LAS char* kbase = (const LAS char*)lds + hi * 1024 + r32 * 16;
    const LAS char* vbase = (const LAS char*)lds + 32768 + ((lane >> 4) & 1) * 32 + (lane & 3) * 8 + (4 * hi + ((lane & 15) >> 2)) * 64;
    f32x16 oT[4]; float lsum = 0.f;
#pragma unroll
    for (int dq = 0; dq < 4; ++dq)
#pragma unroll
        for (int r = 0; r < 16; ++r) oT[dq][r] = 0.f;
    M_LD(0); M_ST(0); __syncthreads();
#pragma unroll 1
    for (int tile = 0; tile < 4; ++tile) { const int so = (tile & 1) * 16384;
        if (tile < 3) M_LD(tile + 1);
        f32x16 p0, p1;
#pragma unroll
        for (int r = 0; r < 16; ++r) { p0[r] = 0.f; p1[r] = 0.f; }
#pragma unroll
        for (int d0 = 0; d0 < 8; ++d0) { const bf16x8 k0 = *(const LAS bf16x8*)(kbase + so + d0 * 2048), k1 = *(const LAS bf16x8*)(kbase + so + d0 * 2048 + 512); p0 = MFMA32(k0, qr[d0], p0); p1 = MFMA32(k1, qr[d0], p1); }
        float s = 0.f;
#pragma unroll
        for (int r = 0; r < 16; ++r) { p0[r] = __builtin_amdgcn_exp2f(p0[r]); p1[r] = __builtin_amdgcn_exp2f(p1[r]); s += p0[r] + p1[r]; }
        lsum += s;
        bf16x8 pa[4];
        { u32x4 w0, w1, w2, w3;
#pragma unroll
          for (int i = 0; i < 4; ++i) { w0[i] = cvt_pk_bf16(p0[2 * i], p0[2 * i + 1]); w1[i] = cvt_pk_bf16(p0[8 + 2 * i], p0[8 + 2 * i + 1]); w2[i] = cvt_pk_bf16(p1[2 * i], p1[2 * i + 1]); w3[i] = cvt_pk_bf16(p1[8 + 2 * i], p1[8 + 2 * i + 1]); }
          pa[0] = __builtin_bit_cast(bf16x8, w0); pa[1] = __builtin_bit_cast(bf16x8, w1); pa[2] = __builtin_bit_cast(bf16x8, w2); pa[3] = __builtin_bit_cast(bf16x8, w3); }
#pragma unroll
        for (int dq = 0; dq < 4; ++dq)
#pragma unroll
            for (int ks = 0; ks < 4; ++ks) { const s16x4 lo = vtr(vbase + so + dq * 4096 + ks * 1024), hh = vtr(vbase + so + dq * 4096 + ks * 1024 + 512); oT[dq] = MFMA32(VFRAG(lo, hh), pa[ks], oT[dq]); }
        if (tile < 3) M_ST(so ^ 16384);
        __syncthreads();
    }
#undef M_LD
#undef M_ST
    lsum += __shfl_xor(lsum, 32); const float il = 1.f / lsum; bf16_t* op = OM + tok * 512 + h * 128 + 4 * hi;
#pragma unroll
    for (int dq = 0; dq < 4; ++dq)
#pragma unroll
        for (int a4 = 0; a4 < 4; ++a4) { u32x2 w; w.x = cvt_pk_bf16(oT[dq][4 * a4] * il, oT[dq][4 * a4 + 1] * il); w.y = cvt_pk_bf16(oT[dq][4 * a4 + 2] * il, oT[dq][4 * a4 + 3] * il); *(u32x2*)(op + dq * 32 + a4 * 8) = w; }
}

constexpr int LDS_BYTES = 147456;
__global__ void __launch_bounds__(512, 2) mega(Args args) {
    extern __shared__ __attribute__((aligned(16))) unsigned char lds_raw[];
    LAS unsigned char* lds = (LAS unsigned char*)lds_raw;
    const int G = gridDim.x, bx = blockIdx.x, NGW = G * 8;
    if (args.ph_lo == 0) { const int tid0 = threadIdx.x, wave0 = __builtin_amdgcn_readfirstlane(tid0 >> 6); prologue(args, lds, bx * 8 + wave0, NGW, wave0, tid0 & 63); }
    for (int ph = args.ph_lo > 1 ? args.ph_lo : 1; ph < args.ph_hi; ++ph) {
        if (ph > args.ph_lo) cooperative_groups::this_grid().sync();
        unsigned char* ws = args.ws; float* xout = args.out; asm volatile("" : "+s"(ws), "+s"(xout));
        int tidp = threadIdx.x; asm volatile("" : "+v"(tidp)); const int lane = tidp & 63, wave = __builtin_amdgcn_readfirstlane(tidp >> 6), gw = bx * 8 + wave;
        float* ctl = (float*)(ws + WS_CTL); bf16_t* XB = (bf16_t*)(ws + WS_XB);
        const int l = (ph - 1) / 10, p = (ph - 1) % 10; unsigned char* wl = ws + WS_W + l * W_LAYER;
        if (p == 0) {
            pg8::Gemm g = pg8::make_gemm(XB, (const bf16_t*)(wl + W_IN), 1024); pg8::StaticOrder S; S.init(NTOK, INP, G, bx);
            pg8::EpiInProj E{(bf16_t*)(ws + WS_U), (bf16_t*)(ws + WS_V), (bf16_t*)(ws + WS_Q), (bf16_t*)(ws + WS_KV), (float*)(ws + WS_GL), ctl + (l == 0 ? 0 : 3) * NTOK};
            pg8::gemm_phase<pg8::EpiInProj, pg8::StaticOrder, true>(lds, g, S, E);
        } else if (p == 1) {
            if (bx < 16) { const int kv = bx >> 3, pm = bx & 7;
                pg8::Gemm g; g.A = (const bf16_t*)(ws + WS_KV) + kv * 128; g.Bt = (const bf16_t*)(wl + W_C1 + (size_t)kv * 256 * 2048 * 2); g.K = 2048; g.lda = 16 * 768; g.kstepA = 768 * 2; g.a_s0 = 64 * 2; g.a_s1 = (size_t)T * 768 * 2;
                pg8::OneUnit S{1, {pm, 0}};
                pg8::EpiBf16G<1> E{(bf16_t*)(ws + WS_HID) + (size_t)kv * 2048 * 256, 256, (const float*)(wl + W_B1P) + kv * 256, nullptr, 0.f};
                pg8::gemm_phase<pg8::EpiBf16G<1>, pg8::OneUnit, true>(lds, g, S, E);
            } else if (bx < 32) { const int i = bx - 16;
                pg8::Gemm g = pg8::make_gemm((const bf16_t*)(ws + WS_MEMB), (const bf16_t*)(wl + W_MKV), 1024); pg8::OneUnit S{1, {i >> 2, i & 3}};
                pg8::EpiBf16G<0> E{(bf16_t*)(ws + WS_KVM), 1024, nullptr, ctl + SSQ_MEM_OFF, 1.f / 1024.f};
                pg8::gemm_phase<pg8::EpiBf16G<0>, pg8::OneUnit, true>(lds, g, S, E);
            }
        } else if (p == 2) {
            for (int u = bx; u < 128; u += G) sgu_unit(lds, u, (const bf16_t*)(ws + WS_U), (const bf16_t*)(ws + WS_V), (const bf16_t*)(wl + W_SG), args.in[I_SGLNG] + l * 512, args.in[I_SGLNB] + l * 512, args.in[I_SGB] + l * 1024, (bf16_t*)(ws + WS_MIX));
            for (int t = gw; t < NTOK; t += NGW) tokprep_token((bf16_t*)(ws + WS_Q), (bf16_t*)(ws + WS_KV), args.in[I_QNG] + l * 64, args.in[I_KNG] + l * 192, t, lane);
            for (int r = gw; r < 2048; r += NGW) cmp2_row((const bf16_t*)(ws + WS_HID), (const bf16_t*)(wl + W_C2), args.in[I_CB2] + l * 128, args.in[I_KNG] + l * 192, (bf16_t*)(ws + WS_KC), (bf16_t*)(ws + WS_VC), r, lane);
        } else if (p == 3) {
            for (int r = gw; r < 4096; r += NGW) memk_norm_item((bf16_t*)(ws + WS_KVM), args.in[I_MKG] + l * 128, r, lane);
            for (int i = bx; i < 256; i += G) { const int b = (i & 7) >> 1, idx = (i >> 3) * 2 + (i & 1);
                attn_unit(lds, b, 127 - idx, (const bf16_t*)(ws + WS_Q), (const bf16_t*)(ws + WS_KV), (const bf16_t*)(ws + WS_KC), (const bf16_t*)(ws + WS_VC), (const float*)(ws + WS_GL), (bf16_t*)(ws + WS_MIX));
                attn_unit(lds, b, idx, (const bf16_t*)(ws + WS_Q), (const bf16_t*)(ws + WS_KV), (const bf16_t*)(ws + WS_KC), (const bf16_t*)(ws + WS_VC), (const float*)(ws + WS_GL), (bf16_t*)(ws + WS_MIX)); }
        } else if (p == 6) {
            for (int i = bx; i < 256; i += G) { const int b = (i & 7) >> 1, rest = (i >> 3) * 2 + (i & 1);
                memattn_unit(lds, b, rest >> 4, rest & 15, (const bf16_t*)(ws + WS_QM), (const bf16_t*)(ws + WS_KVM), args.in[I_MQG] + l * 128, (bf16_t*)(ws + WS_OM)); }
        } else if (p == 4) {
            pg8::Gemm g = pg8::make_gemm((const bf16_t*)(ws + WS_MIX), (const bf16_t*)(wl + W_OUT), 1024); pg8::StaticOrder S; S.init(NTOK, 1024, G, bx);
            pg8::EpiResid E{xout, XB, ctl + (l * 3 + 1) * NTOK};
            pg8::gemm_phase<pg8::EpiResid, pg8::StaticOrder, true>(lds, g, S, E);
        } else if (p == 5) {
            pg8::Gemm g = pg8::make_gemm(XB, (const bf16_t*)(wl + W_MQ), 1024); pg8::StaticOrder S; S.init(NTOK, 512, G, bx);
            pg8::EpiBf16G<0> E{(bf16_t*)(ws + WS_QM), 512, nullptr, ctl + (l * 3 + 1) * NTOK, 1.f / 1024.f};
            pg8::gemm_phase<pg8::EpiBf16G<0>, pg8::StaticOrder, true>(lds, g, S, E);
        } else if (p == 7) {
            pg8::Gemm g = pg8::make_gemm((const bf16_t*)(ws + WS_OM), (const bf16_t*)(wl + W_MO), 512); pg8::StaticOrder S; S.init(NTOK, 1024, G, bx);
            pg8::EpiResid E{xout, XB, ctl + (l * 3 + 2) * NTOK};
            pg8::gemm_phase<pg8::EpiResid, pg8::StaticOrder, true>(lds, g, S, E);
        } else if (p == 8) {
            pg8::Gemm g = pg8::make_gemm(XB, (const bf16_t*)(wl + W_FF1), 1024); pg8::StaticOrder S; S.init(NTOK, FF, G, bx);
            pg8::EpiBf16G<2> E{(bf16_t*)(ws + WS_HB), FF, nullptr, ctl + (l * 3 + 2) * NTOK, 1.f / 1024.f};
            pg8::gemm_phase<pg8::EpiBf16G<2>, pg8::StaticOrder, true>(lds, g, S, E);
        } else if (p == 9) {
            pg8::Gemm g = pg8::make_gemm((const bf16_t*)(ws + WS_HB), (const bf16_t*)(wl + W_FF2), FF); pg8::StaticOrder S; S.init(NTOK, 1024, G, bx);
            pg8::EpiResid E{xout, l == 0 ? XB : (bf16_t*)nullptr, ctl + 3 * NTOK};
            pg8::gemm_phase<pg8::EpiResid, pg8::StaticOrder, true>(lds, g, S, E);
        }
    }
}

}

#ifndef MK_FUSED
#define MK_FUSED 1
#endif
extern "C" void kernel_launch(void* const* d_in, const int* in_sizes, int n_in, void* d_out, int out_size, void* d_ws, size_t ws_size, hipStream_t stream) {
    using namespace mk;
    static int grid = 0;
    if (!grid) { (void)hipFuncSetAttribute((const void*)mega, hipFuncAttributeMaxDynamicSharedMemorySize, LDS_BYTES);
        int dev = 0, cus = 0, per_cu = 0; (void)hipGetDevice(&dev); (void)hipDeviceGetAttribute(&cus, hipDeviceAttributeMultiprocessorCount, dev);
        (void)hipOccupancyMaxActiveBlocksPerMultiprocessor(&per_cu, (const void*)mega, 512, LDS_BYTES);
        grid = cus * (per_cu < 1 ? 1 : per_cu); if (grid > 256) grid = 256; }
    Args a{}; for (int i = 0; i < 27; ++i) a.in[i] = (const float*)d_in[i]; a.out = (float*)d_out; a.ws = (unsigned char*)d_ws;
#if MK_FUSED
    a.ph_lo = 0; a.ph_hi = 21; void* kargs[] = {&a};
    (void)hipLaunchCooperativeKernel((const void*)mega, dim3(grid), dim3(512), kargs, LDS_BYTES, stream);
#else
    for (int ph = 0; ph < 21; ++ph) { a.ph_lo = ph; a.ph_hi = ph + 1; hipLaunchKernelGGL(mega, dim3(grid), dim3(512), LDS_BYTES, stream, a); }
#endif
}
```

```cpp
#include <hip/hip_runtime.h>
#include <hip/hip_cooperative_groups.h>
#include <stdint.h>
#include <math.h>

namespace pg8 {
#define PG8_LAS __attribute__((address_space(3)))
typedef unsigned short bf16_t;
typedef short bf16x8 __attribute__((ext_vector_type(8)));
typedef float f32x4 __attribute__((ext_vector_type(4)));
typedef float f32x2 __attribute__((ext_vector_type(2)));
typedef unsigned u32x4 __attribute__((ext_vector_type(4)));
typedef unsigned u32x2 __attribute__((ext_vector_type(2)));
constexpr int BM = 256, BK = 64, HALF = 128, HTB = HALF * BK * 2, STAGE_BYTES = 8 * HTB, NXCD = 8, WGM = 8;

__host__ __device__ __forceinline__ int lds_byte(int r, int c) { const int st = (r >> 4) * 2 + (c >> 5), rr = r & 15, cc = c & 31, ob = rr * 64 + cc * 2; return st * 1024 + (ob ^ (((ob >> 9) & 1) << 5)); }
__host__ __device__ __forceinline__ void stage_rc(int b, int& R, int& C) { const int st = b / 1024, sb = b % 1024, swz = sb ^ (((sb >> 9) & 1) << 5); R = (st >> 1) * 16 + swz / 64; C = (st & 1) * 32 + (swz % 64) / 2; }
__host__ __device__ __forceinline__ int perm32(int rho) { const int n = rho >> 4, i = rho & 15; return 8 * (i >> 2) + 4 * n + (i & 3); }

struct Unit { int pm, pn; };
struct Gemm { const bf16_t* A; const bf16_t* Bt; int K; int lda; int kstepA; size_t a_s0, a_s1; };
__device__ __forceinline__ Gemm make_gemm(const bf16_t* A, const bf16_t* Bt, int K) { Gemm g; g.A = A; g.Bt = Bt; g.K = K; g.lda = K; g.kstepA = BK * 2; g.a_s0 = (size_t)BM * K * 2; g.a_s1 = 2 * g.a_s0; return g; }

struct StaticOrder {
    int nM, nN, nwg, G, c;
    __device__ void init(int M, int N, int G_, int c_) { nM = M / BM; nN = N / BM; nwg = nM * nN; G = G_; c = c_; }
    __device__ bool next(int i, Unit& u) const {
        const long L = (long)i * G + c; if (L >= nwg) return false;
        int wgid = (int)L; { const int q = nwg / NXCD, r = nwg % NXCD, xcd = wgid % NXCD, off = wgid / NXCD; wgid = (xcd < r ? xcd * (q + 1) : r * (q + 1) + (xcd - r) * q) + off; }
        const int nig = WGM * nN, gid = wgid / nig, fm = gid * WGM, gsz = (nM - fm) < WGM ? (nM - fm) : WGM;
        u.pm = fm + ((wgid % nig) % gsz); u.pn = (wgid % nig) / gsz; return true;
    }
};
struct OneUnit { int has; Unit u; __device__ bool next(int i, Unit& o) const { if (i > 0 || !has) return false; o = u; return true; } };

__device__ __forceinline__ unsigned cvt_pk_bf16(float lo, float hi) { unsigned r; asm volatile("v_cvt_pk_bf16_f32 %0, %1, %2" : "=v"(r) : "v"(lo), "v"(hi)); return r; }
__device__ __forceinline__ float gelu_tanh(float x) { const float u = 0.7978845608028654f * (x + 0.044715f * x * x * x); const float e = __builtin_amdgcn_exp2f(-2.885390081777927f * u); return x * __builtin_amdgcn_rcpf(1.f + e); }

template <int ACT  > struct EpiBf16G {
    static constexpr bool PERM = true, AFTER_DRAIN = false;
    bf16_t* O; int ldc; const float* bias; const float* ssq; float inv_n;
    __device__ __forceinline__ void operator()(const f32x4 (&acc)[2][2][4][2], const Unit& u, int wr, int wc, int fr, int fq) const {
        const int row0 = u.pm * BM + wr * 64 + fr, col0 = u.pn * BM + wc * 32 + 8 * fq;
        f32x4 bv[2][2];
#pragma unroll
        for (int bj = 0; bj < 2; ++bj)
#pragma unroll
            for (int n = 0; n < 2; ++n) bv[bj][n] = bias ? *(const f32x4*)(bias + col0 + bj * HALF + 4 * n) : (f32x4){0.f, 0.f, 0.f, 0.f};
#pragma unroll
        for (int ai = 0; ai < 2; ++ai)
#pragma unroll
            for (int m = 0; m < 4; ++m) { const int row = row0 + ai * HALF + m * 16; const float rs = ssq ? rsqrtf(ssq[row] * inv_n + 1e-6f) : 1.f; bf16_t* rowp = O + (size_t)row * ldc + col0;
#pragma unroll
                for (int bj = 0; bj < 2; ++bj) { f32x4 v0 = (acc[ai][bj][m][0] + bv[bj][0]) * rs, v1 = (acc[ai][bj][m][1] + bv[bj][1]) * rs;
                    if (ACT == 1) {
#pragma unroll
                        for (int e = 0; e < 4; ++e) { v0[e] = gelu_tanh(v0[e]); v1[e] = gelu_tanh(v1[e]); } }
                    if (ACT == 2) {
#pragma unroll
                        for (int e = 0; e < 4; ++e) { float a = fmaxf(v0[e], 0.f), b = fmaxf(v1[e], 0.f); v0[e] = a * a; v1[e] = b * b; } }
                    u32x4 w; w.x = cvt_pk_bf16(v0[0], v0[1]); w.y = cvt_pk_bf16(v0[2], v0[3]); w.z = cvt_pk_bf16(v1[0], v1[1]); w.w = cvt_pk_bf16(v1[2], v1[3]);
                    *(u32x4*)(rowp + bj * HALF) = w; } }
    }
};
struct EpiInProj {
    static constexpr bool PERM = true, AFTER_DRAIN = false;
    bf16_t *U, *V, *Q, *KV; float* GL; const float* ssq;
    __device__ __forceinline__ void operator()(const f32x4 (&acc)[2][2][4][2], const Unit& u, int wr, int wc, int fr, int fq) const {
        const int row0 = u.pm * BM + wr * 64 + fr, cit0 = wc * 32 + 8 * fq; const int pn = u.pn;
        bf16_t* base; int ldc, cofs; bool act = false;
        if (pn < 2) { base = U; ldc = 512; cofs = pn * 256; act = true; } else if (pn < 4) { base = V; ldc = 512; cofs = (pn - 2) * 256; act = true; }
        else if (pn < 6) { base = Q; ldc = 512; cofs = (pn - 4) * 256; } else { base = KV; ldc = 768; cofs = (pn - 6) * 256; }
#pragma unroll
        for (int ai = 0; ai < 2; ++ai)
#pragma unroll
            for (int m = 0; m < 4; ++m) { const int row = row0 + ai * HALF + m * 16; const float rs = rsqrtf(ssq[row] * (1.f / 1024.f) + 1e-6f);
#pragma unroll
                for (int bj = 0; bj < 2; ++bj) { f32x4 v0 = acc[ai][bj][m][0] * rs, v1 = acc[ai][bj][m][1] * rs; const int cit = cit0 + bj * HALF;
                    if (pn == 9) { if (cit < 24) { *(f32x4*)(GL + (size_t)row * 24 + cit) = v0; *(f32x4*)(GL + (size_t)row * 24 + cit + 4) = v1; } }
                    else { if (act) {
#pragma unroll
                            for (int e = 0; e < 4; ++e) { v0[e] = gelu_tanh(v0[e]); v1[e] = gelu_tanh(v1[e]); } }
                        u32x4 w; w.x = cvt_pk_bf16(v0[0], v0[1]); w.y = cvt_pk_bf16(v0[2], v0[3]); w.z = cvt_pk_bf16(v1[0], v1[1]); w.w = cvt_pk_bf16(v1[2], v1[3]);
                        *(u32x4*)(base + (size_t)row * ldc + cofs + cit) = w; } } }
    }
};
struct EpiResid {
    static constexpr bool PERM = false, AFTER_DRAIN = false;
    float* X; bf16_t* XB; float* ssq;
    __device__ __forceinline__ void operator()(const f32x4 (&acc)[2][2][4][2], const Unit& u, int wr, int wc, int fr, int fq) const {
        const int col0 = u.pn * BM + wc * 32 + 4 * fq;
#pragma unroll
        for (int ai = 0; ai < 2; ++ai)
#pragma unroll
            for (int m = 0; m < 4; ++m) { const int row = u.pm * BM + ai * HALF + wr * 64 + m * 16 + fr; float sq = 0.f;
#pragma unroll
                for (int bj = 0; bj < 2; ++bj)
#pragma unroll
                    for (int n = 0; n < 2; ++n) { const size_t off = (size_t)row * 1024 + col0 + bj * HALF + n * 16; f32x4 xv = *(const f32x4*)(X + off); xv = xv + acc[ai][bj][m][n]; *(f32x4*)(X + off) = xv;
                        if (XB) { sq += (xv[0] * xv[0] + xv[1] * xv[1]) + (xv[2] * xv[2] + xv[3] * xv[3]); u32x2 w; w.x = cvt_pk_bf16(xv[0], xv[1]); w.y = cvt_pk_bf16(xv[2], xv[3]); *(u32x2*)(XB + off) = w; } }
                if (XB) { sq += __shfl_xor(sq, 16); sq += __shfl_xor(sq, 32); if (fq == 0) atomicAdd(ssq + row, sq); } }
    }
};

template <class Epi, class Sched, bool ALIGN_EPI>
__device__ __forceinline__ void gemm_phase(PG8_LAS unsigned char* lds, const Gemm g, const Sched& S, const Epi& E) {
    int tid_ = threadIdx.x; asm volatile("" : "+v"(tid_));
    const int tid = tid_, wid = __builtin_amdgcn_readfirstlane(tid >> 6), lane = tid & 63, wr = wid >> 2, wc = wid & 3, fr = lane & 15, fq = lane >> 4;
    const int K = g.K, nt = K / BK;
    unsigned voffA[2], voffB[2];
#pragma unroll
    for (int i = 0; i < 2; ++i) { int R, C; stage_rc(tid * 16 + i * 8192, R, C); const int Rb = Epi::PERM ? ((R & ~31) + perm32(R & 31)) : R;
        voffA[i] = (unsigned)(R * g.lda + C) * 2u; voffB[i] = (unsigned)(Rb * K + C) * 2u; }
    const size_t kstepA = (size_t)g.kstepA, kstepB = (size_t)(BK * 2);
    const size_t hstepA = (size_t)HALF * g.lda * 2, hstepB = (size_t)HALF * K * 2, tstepB = 2 * hstepB;
    const unsigned ldsw = (unsigned)wid * 1024u;
    const int aoff = lds_byte(wr * 64 + fr, fq * 8), boff = lds_byte(wc * 32 + fr, fq * 8);
#define PG8_ABASE(pm) ((const char*)g.A + (size_t)((pm) >> 1) * g.a_s1 + (size_t)((pm) & 1) * g.a_s0)
#define PG8_SA(b, h) (((b) * 2 + (h)) * HTB)
#define PG8_SB(b, h) ((4 + (b) * 2 + (h)) * HTB)
#define PG8_STAGE(bufoff, gbase, voff) do { _Pragma("unroll") for (int _i = 0; _i < 2; ++_i) \
        __builtin_amdgcn_global_load_lds((const unsigned*)((const char*)(gbase) + (voff)[_i]), (PG8_LAS unsigned*)(lds + (bufoff) + ldsw + _i * 8192), 16, 0, 0); } while (0)
#define PG8_LDA(dst, b, h) do { _Pragma("unroll") for (int m = 0; m < 4; ++m) _Pragma("unroll") for (int k = 0; k < 2; ++k) dst[m][k] = *(const PG8_LAS bf16x8*)(lds + PG8_SA(b, h) + aoff + m * 2048 + k * 1024); } while (0)
#define PG8_LDB(dst, b, h) do { _Pragma("unroll") for (int n = 0; n < 2; ++n) _Pragma("unroll") for (int k = 0; k < 2; ++k) dst[n][k] = *(const PG8_LAS bf16x8*)(lds + PG8_SB(b, h) + boff + n * 2048 + k * 1024); } while (0)
#define PG8_MMA(ai, bj, At, Bt) do { __builtin_amdgcn_s_setprio(1); _Pragma("unroll") for (int m = 0; m < 4; ++m) _Pragma("unroll") for (int n = 0; n < 2; ++n) _Pragma("unroll") for (int k = 0; k < 2; ++k) \
        acc[ai][bj][m][n] = __builtin_amdgcn_mfma_f32_16x16x32_bf16(Bt[n][k], At[m][k], acc[ai][bj][m][n], 0, 0, 0); __builtin_amdgcn_s_setprio(0); } while (0)
#define PG8_WAIT_V(n) asm volatile("s_waitcnt vmcnt(" #n ")" ::: "memory")
#define PG8_WAIT_L(n) asm volatile("s_waitcnt lgkmcnt(" #n ")" ::: "memory")
#define PG8_BAR __builtin_amdgcn_s_barrier()
#define PG8_SCHED __builtin_amdgcn_sched_barrier(0)
    Unit cur, nxt; int ui = 0;
    if (!S.next(0, cur)) return;
    f32x4 acc[2][2][4][2];
#pragma unroll
    for (int a = 0; a < 2; ++a)
#pragma unroll
        for (int b = 0; b < 2; ++b)
#pragma unroll
            for (int m = 0; m < 4; ++m)
#pragma unroll
                for (int n = 0; n < 2; ++n) acc[a][b][m][n] = (f32x4){0.f, 0.f, 0.f, 0.f};
    bf16x8 At[4][2], B0[2][2], B1[2][2];
    const char* cA = PG8_ABASE(cur.pm); const char* cB = (const char*)g.Bt + (size_t)cur.pn * tstepB;
    PG8_STAGE(PG8_SB(0, 0), cB, voffB); PG8_STAGE(PG8_SB(0, 1), cB + hstepB, voffB); PG8_STAGE(PG8_SA(0, 0), cA, voffA); PG8_STAGE(PG8_SA(0, 1), cA + hstepA, voffA);
    if (wr == 1) PG8_BAR;
    PG8_WAIT_V(2); PG8_BAR;
    PG8_STAGE(PG8_SB(1, 0), cB + kstepB, voffB); PG8_STAGE(PG8_SA(1, 0), cA + kstepA, voffA); PG8_STAGE(PG8_SB(1, 1), cB + hstepB + kstepB, voffB);
    PG8_WAIT_V(6); PG8_BAR;
    for (;;) {
        const bool has_next = S.next(ui + 1, nxt);
        const char* nA = has_next ? PG8_ABASE(nxt.pm) : cA; const char* nB = has_next ? (const char*)g.Bt + (size_t)nxt.pn * tstepB : cB;
        for (int t = 0; t < nt; t += 2) {
            const bool last = (t == nt - 2);
            const char* a1 = cA + (size_t)(t + 1) * kstepA;
            const char* a2 = last ? nA : cA + (size_t)(t + 2) * kstepA; const char* b2 = last ? nB : cB + (size_t)(t + 2) * kstepB;
            const char* a3 = a2 + kstepA; const char* b3 = b2 + kstepB;
            PG8_LDB(B0, 0, 0); PG8_LDB(B1, 0, 1); PG8_SCHED; PG8_LDA(At, 0, 0); PG8_STAGE(PG8_SA(1, 1), a1 + hstepA, voffA);
            PG8_WAIT_V(8); PG8_WAIT_L(0); PG8_BAR; PG8_MMA(0, 0, At, B0); PG8_MMA(0, 1, At, B1); PG8_BAR; PG8_SCHED;
            PG8_LDA(At, 0, 1); PG8_STAGE(PG8_SB(0, 0), b2, voffB); PG8_STAGE(PG8_SB(0, 1), b2 + hstepB, voffB); PG8_STAGE(PG8_SA(0, 0), a2, voffA);
            PG8_WAIT_V(8); PG8_WAIT_L(0); PG8_BAR; PG8_MMA(1, 0, At, B0); PG8_MMA(1, 1, At, B1); PG8_BAR; PG8_SCHED;
            PG8_LDB(B0, 1, 0); PG8_LDB(B1, 1, 1); PG8_SCHED; PG8_LDA(At, 1, 0); PG8_STAGE(PG8_SA(0, 1), a2 + hstepA, voffA);
            PG8_WAIT_V(8); PG8_WAIT_L(0); PG8_BAR; PG8_MMA(0, 0, At, B0); PG8_MMA(0, 1, At, B1); PG8_BAR; PG8_SCHED;
            PG8_LDA(At, 1, 1); PG8_STAGE(PG8_SB(1, 0), b3, voffB); PG8_STAGE(PG8_SB(1, 1), b3 + hstepB, voffB); PG8_STAGE(PG8_SA(1, 0), a3, voffA);
            PG8_WAIT_V(8); PG8_WAIT_L(0); PG8_BAR; PG8_MMA(1, 0, At, B0); PG8_MMA(1, 1, At, B1); PG8_BAR; PG8_SCHED;
        }
        if constexpr (ALIGN_EPI) { if (wr == 0) PG8_BAR; }
        if constexpr (!Epi::AFTER_DRAIN) { E(acc, cur, wr, wc, fr, fq); }
        if (!has_next) break;
#pragma unroll
        for (int a = 0; a < 2; ++a)
#pragma unroll
            for (int b = 0; b < 2; ++b)
#pragma unroll
                for (int m = 0; m < 4; ++m)
#pragma unroll
                    for (int n = 0; n < 2; ++n) acc[a][b][m][n] = (f32x4){0.f, 0.f, 0.f, 0.f};
        cur = nxt; cA = nA; cB = nB; ++ui;
        if constexpr (ALIGN_EPI) { if (wr == 1) PG8_BAR; }
    }
    PG8_WAIT_V(0);
    if constexpr (!ALIGN_EPI) { if (wr == 0) PG8_BAR; }
    PG8_BAR;
    if constexpr (Epi::AFTER_DRAIN) { E.fused(acc, cur, wr, wc, fr, fq, lds, wid, lane); }
#undef PG8_ABASE
#undef PG8_SA
#undef PG8_SB
#undef PG8_STAGE
#undef PG8_LDA
#undef PG8_LDB
#undef PG8_MMA
#undef PG8_WAIT_V
#undef PG8_WAIT_L
#undef PG8_BAR
#undef PG8_SCHED
}
}

namespace mk {
using pg8::bf16_t; using pg8::f32x4; using pg8::u32x4; using pg8::u32x2; using pg8::cvt_pk_bf16;
#define LAS __attribute__((address_space(3)))
constexpr int NB = 4, T = 4096, D = 1024, NTOK = NB * T, INC = 2328, INP = 2560, FF = 4096;
constexpr size_t MiB = 1u << 20;
constexpr size_t WS_CTL = 0;
constexpr size_t WS_W = 1 * MiB, W_LAYER = 30 * MiB;
constexpr size_t W_IN = 0, W_OUT = 5 * MiB, W_MQ = 7 * MiB, W_MKV = 8 * MiB, W_MO = 10 * MiB, W_FF1 = 11 * MiB, W_FF2 = 19 * MiB, W_C1 = 27 * MiB, W_C2 = 29 * MiB, W_SG = 29 * MiB + 128 * 1024, W_B1P = 29 * MiB + 512 * 1024;
constexpr size_t WS_XB = 61 * MiB;
constexpr size_t WS_OV = 93 * MiB;
constexpr size_t WS_U = WS_OV, WS_V = WS_OV + 16 * MiB, WS_Q = WS_OV + 32 * MiB, WS_KV = WS_OV + 48 * MiB, WS_MIX = WS_OV + 72 * MiB, WS_QM = WS_OV + 104 * MiB, WS_OM = WS_OV + 120 * MiB;
constexpr size_t WS_HB = WS_OV;
constexpr size_t WS_SM = 229 * MiB;
constexpr size_t WS_GL = WS_SM, WS_KC = WS_SM + 2 * MiB, WS_VC = WS_KC + 256 * 1024, WS_HID = WS_SM + 3 * MiB, WS_MASK = WS_SM + 5 * MiB, WS_MEMB = WS_SM + 6 * MiB, WS_KVM = WS_SM + 8 * MiB, WS_END = WS_SM + 10 * MiB;
static_assert(WS_END <= 256 * MiB, "ws map");
constexpr int SSQ_MEM_OFF = 6 * NTOK;

struct Args { const float* in[27]; float* out; unsigned char* ws; int ph_lo, ph_hi; };
enum { I_X = 0, I_MEM, I_NMG, I_WIN, I_SGLNG, I_SGLNB, I_SGW, I_SGB, I_QNG, I_KNG, I_CPOS, I_CW1, I_CB1, I_CW2, I_CB2, I_MOG, I_WOUT, I_NMEMG, I_MKVG, I_WMQ, I_WMKV, I_MQG, I_MKG, I_WMO, I_NFG, I_WFF1, I_WFF2 };

__device__ __forceinline__ float bf2f(unsigned short b) { return __uint_as_float((unsigned)b << 16); }
__device__ __forceinline__ float wave_sum(float v) {
#pragma unroll
    for (int o = 1; o < 64; o <<= 1) v += __shfl_xor(v, o);
    return v; }

__device__ __forceinline__ void transpose_item(const float* W, int K, int N, int Npad, const float* gain, bf16_t* WT, LAS float* scr, int item, int lane) {
    const int nblk = Npad / 32, kb = item / nblk, nb = item % nblk, k0 = 64 * kb, n0 = 32 * nb;
    const int nn = n0 + (lane & 31);
#pragma unroll 8
    for (int i = 0; i < 32; ++i) { const int kk = 2 * i + (lane >> 5); float v = 0.f; if (nn < N) { v = W[(size_t)(k0 + kk) * N + nn]; if (gain) v *= gain[k0 + kk]; } scr[kk * 33 + (lane & 31)] = v; }
    asm volatile("s_waitcnt lgkmcnt(0)" ::: "memory");
    const int c = lane & 7;
#pragma unroll
    for (int j = 0; j < 4; ++j) { const int n = (lane >> 3) + 8 * j; const LAS float* s = scr + (8 * c) * 33 + n;
        u32x4 o; o.x = cvt_pk_bf16(s[0 * 33], s[1 * 33]); o.y = cvt_pk_bf16(s[2 * 33], s[3 * 33]); o.z = cvt_pk_bf16(s[4 * 33], s[5 * 33]); o.w = cvt_pk_bf16(s[6 * 33], s[7 * 33]);
        *(u32x4*)(WT + (size_t)(n0 + n) * K + k0 + 8 * c) = o; }
    asm volatile("s_waitcnt lgkmcnt(0)" ::: "memory");
}

__device__ __forceinline__ void prologue(const Args& a, LAS unsigned char* lds, int gw, int NGW, int wave, int lane) {
    LAS float* scr = (LAS float*)(lds + wave * 16384);
    unsigned char* ws = a.ws; float* ctl = (float*)(ws + WS_CTL);
    int it0 = 0;
#define TR_MAT(Wp, K_, N_, NP_, Gp, DST) { const int cnt = ((K_) / 64) * ((NP_) / 32); for (int it = gw; it < it0 + cnt; it += NGW) { if (it >= it0) transpose_item((Wp), (K_), (N_), (NP_), (Gp), (bf16_t*)(DST), scr, it - it0, lane); } it0 += cnt; }
    for (int l = 0; l < 2; ++l) {
        unsigned char* wl = ws + WS_W + l * W_LAYER;
        TR_MAT(a.in[I_WIN] + (size_t)l * 1024 * INC, 1024, INC, INP, a.in[I_NMG] + l * 1024, wl + W_IN)
        TR_MAT(a.in[I_WOUT] + (size_t)l * 1024 * 1024, 1024, 1024, 1024, a.in[I_MOG] + l * 1024, wl + W_OUT)
        TR_MAT(a.in[I_WMQ] + (size_t)l * 1024 * 512, 1024, 512, 512, a.in[I_NMEMG] + l * 1024, wl + W_MQ)
        TR_MAT(a.in[I_WMKV] + (size_t)l * 1024 * 1024, 1024, 1024, 1024, a.in[I_MKVG] + l * 1024, wl + W_MKV)
        TR_MAT(a.in[I_WMO] + (size_t)l * 512 * 1024, 512, 1024, 1024, (const float*)nullptr, wl + W_MO)
        TR_MAT(a.in[I_WFF1] + (size_t)l * 1024 * 4096, 1024, 4096, 4096, a.in[I_NFG] + l * 1024, wl + W_FF1)
        TR_MAT(a.in[I_WFF2] + (size_t)l * 4096 * 1024, 4096, 1024, 1024, (const float*)nullptr, wl + W_FF2)
        for (int kv = 0; kv < 2; ++kv) {
            TR_MAT(a.in[I_CW1] + (size_t)(l * 2 + kv) * 2048 * 256, 2048, 256, 256, (const float*)nullptr, wl + W_C1 + (size_t)kv * 256 * 2048 * 2)
            TR_MAT(a.in[I_CW2] + (size_t)(l * 2 + kv) * 256 * 64, 256, 64, 64, (const float*)nullptr, wl + W_C2 + (size_t)kv * 64 * 256 * 2)
        }
    }
#undef TR_MAT
    { const float* x = a.in[I_X]; bf16_t* XB = (bf16_t*)(ws + WS_XB);
      for (int r = gw; r < NTOK; r += NGW) { const f32x4* xr = (const f32x4*)(x + (size_t)r * 1024) + lane; f32x4* orow = (f32x4*)(a.out + (size_t)r * 1024) + lane; unsigned long long* xb = (unsigned long long*)(XB + (size_t)r * 1024) + lane; float s = 0.f;
#pragma unroll
          for (int j = 0; j < 4; ++j) { const f32x4 v = xr[64 * j]; orow[64 * j] = v; s += (v[0] * v[0] + v[1] * v[1]) + (v[2] * v[2] + v[3] * v[3]); xb[64 * j] = (unsigned long long)cvt_pk_bf16(v[0], v[1]) | ((unsigned long long)cvt_pk_bf16(v[2], v[3]) << 32); }
          s = wave_sum(s); if (lane == 0) ctl[r] = s; if (lane >= 1 && lane <= 5) ctl[lane * NTOK + r] = 0.f; } }
    { const float* mem = a.in[I_MEM]; bf16_t* MB = (bf16_t*)(ws + WS_MEMB);
      for (int r = gw; r < 1024; r += NGW) { const f32x4* xr = (const f32x4*)(mem + (size_t)r * 1024) + lane; unsigned long long* xb = (unsigned long long*)(MB + (size_t)r * 1024) + lane; float s = 0.f;
#pragma unroll
          for (int j = 0; j < 4; ++j) { const f32x4 v = xr[64 * j]; s += (v[0] * v[0] + v[1] * v[1]) + (v[2] * v[2] + v[3] * v[3]); xb[64 * j] = (unsigned long long)cvt_pk_bf16(v[0], v[1]) | ((unsigned long long)cvt_pk_bf16(v[2], v[3]) << 32); }
          s = wave_sum(s); if (lane == 0) ctl[SSQ_MEM_OFF + r] = s; } }
    for (int it = gw; it < 16; it += NGW) { const int lk = it >> 2, j = (it & 3) * 64 + lane; const float* W1 = a.in[I_CW1] + (size_t)lk * 2048 * 256; const float* pos = a.in[I_CPOS] + (size_t)lk * 2048; float s = a.in[I_CB1][lk * 256 + j];
        for (int k = 0; k < 2048; ++k) s += pos[k] * W1[(size_t)k * 256 + j];
        ((float*)(ws + WS_W + (lk >> 1) * W_LAYER + W_B1P))[(lk & 1) * 256 + j] = s; }
    for (int it = gw; it < 2 * 8 * 128; it += NGW) { const int t = it & 127; const float* wr = a.in[I_SGW] + (size_t)it * 128; unsigned* dst = (unsigned*)(ws + WS_W + (it >> 10) * W_LAYER + W_SG) + (size_t)(it & 1023) * 64 + lane;
        float v[2];
#pragma unroll
        for (int e = 0; e < 2; ++e) { const int p = lane * 2 + e, ks = p >> 4, hh = (p >> 3) & 1, j = p & 7, sidx = 16 * ks + 8 * (j >> 2) + 4 * hh + (j & 3); v[e] = sidx <= t ? wr[sidx] : 0.f; }
        *dst = cvt_pk_bf16(v[0], v[1]); }
}

typedef float f32x16 __attribute__((ext_vector_type(16)));
typedef short s16x4 __attribute__((ext_vector_type(4)));
typedef short v4i16_t __attribute__((ext_vector_type(4)));
using pg8::bf16x8;
__device__ __forceinline__ int crow(int r, int hi) { return (r & 3) + 8 * (r >> 2) + 4 * hi; }
__device__ __forceinline__ s16x4 vtr(const LAS char* p) { return __builtin_bit_cast(s16x4, __builtin_amdgcn_ds_read_tr16_b64_v4i16((LAS v4i16_t*)p)); }
#define MFMA32(a, b, c) __builtin_amdgcn_mfma_f32_32x32x16_bf16(a, b, c, 0, 0, 0)
#define VFRAG(lo, hi) (bf16x8){lo[0], lo[1], lo[2], lo[3], hi[0], hi[1], hi[2], hi[3]}
__device__ __forceinline__ void lds_fadd(LAS float* p, float v) { (void)__hip_atomic_fetch_add(p, v, __ATOMIC_RELAXED, __HIP_MEMORY_SCOPE_WORKGROUP); }
__device__ __forceinline__ unsigned short f2bf(float f) { return (unsigned short)(cvt_pk_bf16(f, 0.f) & 0xffffu); }

__device__ __forceinline__ void tokprep_token(bf16_t* Q, bf16_t* KV, const float* qg, const float* kg, int tok, int lane) {
    { u32x4* p = (u32x4*)(Q + (size_t)tok * 512) + lane; const u32x4 w = *p; float v[8];
#pragma unroll
      for (int i = 0; i < 4; ++i) { v[2 * i] = __uint_as_float(w[i] << 16); v[2 * i + 1] = __uint_as_float(w[i] & 0xffff0000u); }
      float ss = 0.f;
#pragma unroll
      for (int i = 0; i < 8; ++i) ss += v[i] * v[i];
      ss += __shfl_xor(ss, 1); ss += __shfl_xor(ss, 2); ss += __shfl_xor(ss, 4);
      const float rs = rsqrtf(ss * (1.f / 64.f) + 1e-6f) * (0.125f * 1.4426950408889634f); const float* g = qg + (lane & 7) * 8;
      u32x4 o;
#pragma unroll
      for (int i = 0; i < 4; ++i) o[i] = cvt_pk_bf16(v[2 * i] * rs * g[2 * i], v[2 * i + 1] * rs * g[2 * i + 1]);
      *p = o; }
    if (lane < 32) { const int br = 1 + (lane >> 4); u32x4* p = (u32x4*)(KV + (size_t)tok * 768 + br * 256) + (lane & 15); const u32x4 w = *p; float v[8];
#pragma unroll
      for (int i = 0; i < 4; ++i) { v[2 * i] = __uint_as_float(w[i] << 16); v[2 * i + 1] = __uint_as_float(w[i] & 0xffff0000u); }
      float ss = 0.f;
#pragma unroll
      for (int i = 0; i < 8; ++i) ss += v[i] * v[i];
      ss += __shfl_xor(ss, 1); ss += __shfl_xor(ss, 2); ss += __shfl_xor(ss, 4);
      const float rs = rsqrtf(ss * (1.f / 64.f) + 1e-6f); const float* g = kg + br * 64 + (lane & 7) * 8;
      u32x4 o;
#pragma unroll
      for (int i = 0; i < 4; ++i) o[i] = cvt_pk_bf16(v[2 * i] * rs * g[2 * i], v[2 * i + 1] * rs * g[2 * i + 1]);
      *p = o; }
}
__device__ __forceinline__ void cmp2_row(const bf16_t* HID, const bf16_t* w2t, const float* b2, const float* kg0, bf16_t* KC, bf16_t* VC, int row, int lane) {
#pragma unroll 1
    for (int kv = 0; kv < 2; ++kv) { const u32x4* h = (const u32x4*)(HID + (size_t)kv * 2048 * 256 + (size_t)row * 256); const u32x4* w = (const u32x4*)(w2t + (size_t)kv * 64 * 256 + (size_t)lane * 256); float s = b2[kv * 64 + lane];
#pragma unroll 4
        for (int k = 0; k < 32; ++k) { const u32x4 a = h[k], b = w[k];
#pragma unroll
            for (int i = 0; i < 4; ++i) s += __uint_as_float(a[i] << 16) * __uint_as_float(b[i] << 16) + __uint_as_float(a[i] & 0xffff0000u) * __uint_as_float(b[i] & 0xffff0000u); }
        if (kv == 0) { const float ss = wave_sum(s * s); s = s * rsqrtf(ss * (1.f / 64.f) + 1e-6f) * kg0[lane]; }
        if ((row & 255) == 255) s = 0.f;
        (kv ? VC : KC)[(size_t)row * 64 + lane] = f2bf(s); }
}
__device__ __forceinline__ void memk_norm_item(bf16_t* KVM, const float* kg, int r, int lane) {
    unsigned* p = (unsigned*)(KVM + (size_t)(r >> 2) * 1024 + (r & 3) * 128) + lane; const unsigned w = *p; const float v0 = __uint_as_float(w << 16), v1 = __uint_as_float(w & 0xffff0000u);
    const float ss = wave_sum(v0 * v0 + v1 * v1); const float rs = rsqrtf(ss * (1.f / 128.f) + 1e-6f); *p = cvt_pk_bf16(v0 * rs * kg[2 * lane], v1 * rs * kg[2 * lane + 1]);
}

constexpr int SG_STAT = 0, SG_SSQ = 1024, SG_VN = 2048;
__device__ __forceinline__ void sgu_unit(LAS unsigned char* lds, int unit, const bf16_t* U, const bf16_t* Vb, const bf16_t* Wsg, const float* lng, const float* lnb, const float* sgb, bf16_t* MIX) {
    int tid_ = threadIdx.x; asm volatile("" : "+v"(tid_)); const int tid = tid_, lane = tid & 63, g = __builtin_amdgcn_readfirstlane(tid >> 6), r32 = lane & 31, hi = lane >> 5;
    const int tok0 = unit * 128;
    LAS float* STAT = (LAS float*)(lds + SG_STAT); LAS float* SSQA = (LAS float*)(lds + SG_SSQ);
    { const int tl = tid >> 2, part = tid & 3; const u32x4* p = (const u32x4*)(Vb + (size_t)(tok0 + tl) * 512 + part * 128); float s = 0.f, s2 = 0.f;
#pragma unroll 4
      for (int i = 0; i < 16; ++i) { const u32x4 w = p[i];
#pragma unroll
          for (int e = 0; e < 4; ++e) { const float a = __uint_as_float(w[e] << 16), b = __uint_as_float(w[e] & 0xffff0000u); s += a + b; s2 += a * a + b * b; } }
      s += __shfl_xor(s, 1); s += __shfl_xor(s, 2); s2 += __shfl_xor(s2, 1); s2 += __shfl_xor(s2, 2);
      if (part == 0) { const float mu = s * (1.f / 512.f); const float var = fmaxf(s2 * (1.f / 512.f) - mu * mu, 0.f); STAT[tl * 2] = mu; STAT[tl * 2 + 1] = rsqrtf(var + 1e-6f); }
      if (tid < 128) SSQA[tid] = 0.f; }
    __syncthreads();
    LAS unsigned char* VN = lds + SG_VN + g * 16384;
    { const int piece = lane & 7; float gg[8], bb[8];
#pragma unroll
      for (int i = 0; i < 8; ++i) { gg[i] = lng[g * 64 + piece * 8 + i]; bb[i] = lnb[g * 64 + piece * 8 + i]; }
#pragma unroll 4
      for (int it = 0; it < 16; ++it) { const int row = it * 8 + (lane >> 3); const u32x4 w = *(const u32x4*)(Vb + (size_t)(tok0 + row) * 512 + g * 64 + piece * 8); const float mu = STAT[row * 2], rs = STAT[row * 2 + 1]; u32x4 o;
#pragma unroll
          for (int e = 0; e < 4; ++e) { const float a = (__uint_as_float(w[e] << 16) - mu) * rs * gg[2 * e] + bb[2 * e], b = (__uint_as_float(w[e] & 0xffff0000u) - mu) * rs * gg[2 * e + 1] + bb[2 * e + 1]; o[e] = cvt_pk_bf16(a, b); }
          *(LAS u32x4*)(VN + (piece >> 2) * 8192 + row * 64 + (piece & 3) * 16) = o; } }
    asm volatile("s_waitcnt lgkmcnt(0)" ::: "memory");
    f32x16 acc[2][4];
#pragma unroll
    for (int dh = 0; dh < 2; ++dh)
#pragma unroll
        for (int mt = 0; mt < 4; ++mt)
#pragma unroll
            for (int r = 0; r < 16; ++r) acc[dh][mt][r] = 0.f;
    const LAS char* vb = (const LAS char*)VN + ((lane >> 4) & 1) * 32 + (lane & 3) * 8 + (4 * hi + ((lane & 15) >> 2)) * 64;
    const bf16_t* wrow = Wsg + ((size_t)g * 128 + r32) * 128 + 8 * hi;
#pragma unroll
    for (int ks = 0; ks < 8; ++ks) { bf16x8 vf[2];
#pragma unroll
        for (int dh = 0; dh < 2; ++dh) { const s16x4 lo = vtr(vb + dh * 8192 + ks * 1024), hh = vtr(vb + dh * 8192 + ks * 1024 + 512); vf[dh] = VFRAG(lo, hh); }
#pragma unroll
        for (int mt = 0; mt < 4; ++mt) { if (ks <= 2 * mt + 1) { const bf16x8 wf = *(const bf16x8*)(wrow + (size_t)mt * 32 * 128 + ks * 16);
                acc[0][mt] = MFMA32(vf[0], wf, acc[0][mt]); acc[1][mt] = MFMA32(vf[1], wf, acc[1][mt]); } } }
#pragma unroll
    for (int mt = 0; mt < 4; ++mt) { const int t = mt * 32 + r32; const float bias = sgb[g * 128 + t]; const bf16_t* up = U + (size_t)(tok0 + t) * 512 + g * 64 + 4 * hi; float ss = 0.f;
#pragma unroll
        for (int dh = 0; dh < 2; ++dh)
#pragma unroll
            for (int a4 = 0; a4 < 4; ++a4) { const u32x2 w = *(const u32x2*)(up + dh * 32 + a4 * 8);
                const float u0 = __uint_as_float(w.x << 16), u1 = __uint_as_float(w.x & 0xffff0000u), u2 = __uint_as_float(w.y << 16), u3 = __uint_as_float(w.y & 0xffff0000u);
                float x0 = u0 * (acc[dh][mt][4 * a4] + bias), x1 = u1 * (acc[dh][mt][4 * a4 + 1] + bias), x2 = u2 * (acc[dh][mt][4 * a4 + 2] + bias), x3 = u3 * (acc[dh][mt][4 * a4 + 3] + bias);
                acc[dh][mt][4 * a4] = x0; acc[dh][mt][4 * a4 + 1] = x1; acc[dh][mt][4 * a4 + 2] = x2; acc[dh][mt][4 * a4 + 3] = x3; ss += (x0 * x0 + x1 * x1) + (x2 * x2 + x3 * x3); }
        ss += __shfl_xor(ss, 32); if (hi == 0) lds_fadd(SSQA + t, ss); }
    __syncthreads();
#pragma unroll
    for (int mt = 0; mt < 4; ++mt) { const int t = mt * 32 + r32; const float rs = rsqrtf(SSQA[t] * (1.f / 512.f) + 1e-6f); bf16_t* op = MIX + (size_t)(tok0 + t) * 1024 + g * 64 + 4 * hi;
#pragma unroll
        for (int dh = 0; dh < 2; ++dh)
#pragma unroll
            for (int a4 = 0; a4 < 4; ++a4) { u32x2 w; w.x = cvt_pk_bf16(acc[dh][mt][4 * a4] * rs, acc[dh][mt][4 * a4 + 1] * rs); w.y = cvt_pk_bf16(acc[dh][mt][4 * a4 + 2] * rs, acc[dh][mt][4 * a4 + 3] * rs); *(u32x2*)(op + dh * 32 + a4 * 8) = w; } }
    __syncthreads();
}

constexpr int A_KB = 0, A_VB = 32768, A_IMP = 65536, A_MASK = A_IMP + 2 * 32 * 65 * 4, A_SSQ = A_MASK + 512;
template <int MODE>
__device__ __forceinline__ void attn_seg(LAS unsigned char* lds, const bf16_t* Kb, const bf16_t* Vb, int pitch, int hstride, int tile_lo, int tile_hi, const bf16x8 (&qr)[4], f32x16 (&oT)[2], float& lsum,
                                         int kmin, int kmax, unsigned mlo, unsigned mhi, int tq, float inv_l, int kvh, int wave, int lane, int r32, int hi) {
    if (tile_lo > tile_hi) return;
    constexpr bool HASV = (MODE != 0);
    u32x4 sk0, sk1, sv0, sv1;
    const bf16_t* kthr = Kb + (size_t)lane * pitch + wave * 8; const bf16_t* vthr = Vb + (size_t)(16 * (wave & 3) + (lane >> 2)) * pitch + (wave >> 2) * 32 + (lane & 3) * 8;
    const int sdst = wave * 1024 + lane * 16;
#define A_LD(tile) do { const size_t to_ = (size_t)(tile) * 64 * pitch; sk0 = *(const u32x4*)(kthr + to_); sk1 = *(const u32x4*)(kthr + to_ + hstride); if (HASV) { sv0 = *(const u32x4*)(vthr + to_); sv1 = *(const u32x4*)(vthr + to_ + hstride); } } while (0)
#define A_ST(so) do { *(LAS u32x4*)(lds + A_KB + (so) + sdst) = sk0; *(LAS u32x4*)(lds + A_KB + (so) + 8192 + sdst) = sk1; if (HASV) { *(LAS u32x4*)(lds + A_VB + (so) + sdst) = sv0; *(LAS u32x4*)(lds + A_VB + (so) + 8192 + sdst) = sv1; } } while (0)
    const LAS char* kbase = (const LAS char*)(lds + A_KB) + kvh * 8192 + hi * 1024 + r32 * 16;
    const LAS char* vbase = (const LAS char*)(lds + A_VB) + kvh * 8192 + ((lane >> 4) & 1) * 32 + (lane & 3) * 8 + (4 * hi + ((lane & 15) >> 2)) * 64;
    LAS float* IMP = (LAS float*)(lds + A_IMP) + (kvh * 32 + r32) * 65;
    A_LD(tile_lo); A_ST(0); __syncthreads();
#pragma unroll 1
    for (int tile = tile_lo; tile <= tile_hi; ++tile) {
        const int so = ((tile - tile_lo) & 1) * 16384;
        if (tile < tile_hi) A_LD(tile + 1);
        bf16x8 kf[8];
#pragma unroll
        for (int d0 = 0; d0 < 4; ++d0) { kf[2 * d0] = *(const LAS bf16x8*)(kbase + so + d0 * 2048); kf[2 * d0 + 1] = *(const LAS bf16x8*)(kbase + so + d0 * 2048 + 512); }
        f32x16 p0, p1;
#pragma unroll
        for (int r = 0; r < 16; ++r) { p0[r] = 0.f; p1[r] = 0.f; }
#pragma unroll
        for (int d0 = 0; d0 < 4; ++d0) { p0 = MFMA32(kf[2 * d0], qr[d0], p0); p1 = MFMA32(kf[2 * d0 + 1], qr[d0], p1); }
        int a, bb;
        if (MODE == 2) { const unsigned sel = tile < 32 ? (mlo >> tile) & 1u : (mhi >> (tile - 32)) & 1u; a = sel ? -64 * tile : (1 << 20); bb = sel ? tq - 64 * tile : (1 << 20); }
        else { a = kmin - 64 * tile; bb = kmax - 64 * tile; }
#pragma unroll
        for (int r = 0; r < 16; ++r) { p0[r] = __builtin_amdgcn_exp2f(p0[r]); p1[r] = __builtin_amdgcn_exp2f(p1[r]); }
        if (!__all(a <= 0 && bb >= 63)) { const unsigned span = (unsigned)(bb - a);
#pragma unroll
            for (int r = 0; r < 16; ++r) { const int rel = crow(r, hi); p0[r] = ((unsigned)(rel - a) <= span) ? p0[r] : 0.f; p1[r] = ((unsigned)(rel + 32 - a) <= span) ? p1[r] : 0.f; } }
        if (MODE == 1) {
#pragma unroll
            for (int r = 0; r < 16; ++r) { p0[r] *= inv_l; p1[r] *= inv_l; }
#pragma unroll
            for (int a4 = 0; a4 < 4; ++a4) { const int j0 = 16 * tile + 2 * a4 + hi;
                const float h0 = 0.5f * p0[4 * a4 + 3], h1 = 0.5f * p1[4 * a4 + 3];
                lds_fadd(IMP + j0, (p0[4 * a4] + p0[4 * a4 + 1]) + (p0[4 * a4 + 2] + h0)); lds_fadd(IMP + j0 + 1, h0);
                lds_fadd(IMP + j0 + 8, (p1[4 * a4] + p1[4 * a4 + 1]) + (p1[4 * a4 + 2] + h1)); lds_fadd(IMP + j0 + 9, h1); }
        } else { float s = 0.f;
#pragma unroll
            for (int r = 0; r < 16; ++r) s += p0[r] + p1[r];
            lsum += s; }
        if (HASV) {
            bf16x8 pa[4];
            { u32x4 w0, w1, w2, w3;
#pragma unroll
              for (int i = 0; i < 4; ++i) { w0[i] = cvt_pk_bf16(p0[2 * i], p0[2 * i + 1]); w1[i] = cvt_pk_bf16(p0[8 + 2 * i], p0[8 + 2 * i + 1]); w2[i] = cvt_pk_bf16(p1[2 * i], p1[2 * i + 1]); w3[i] = cvt_pk_bf16(p1[8 + 2 * i], p1[8 + 2 * i + 1]); }
              pa[0] = __builtin_bit_cast(bf16x8, w0); pa[1] = __builtin_bit_cast(bf16x8, w1); pa[2] = __builtin_bit_cast(bf16x8, w2); pa[3] = __builtin_bit_cast(bf16x8, w3); }
#pragma unroll
            for (int dh = 0; dh < 2; ++dh)
#pragma unroll
                for (int ks = 0; ks < 4; ++ks) { const s16x4 lo = vtr(vbase + so + dh * 4096 + ks * 1024), hh = vtr(vbase + so + dh * 4096 + ks * 1024 + 512); oT[dh] = MFMA32(VFRAG(lo, hh), pa[ks], oT[dh]); }
        }
        if (tile < tile_hi) A_ST(so ^ 16384);
        __syncthreads();
    }
#undef A_LD
#undef A_ST
}

__device__ __forceinline__ void attn_unit(LAS unsigned char* lds, int b, int qt, const bf16_t* Q, const bf16_t* KV, const bf16_t* KC, const bf16_t* VC, const float* GL, bf16_t* MIX) {
    int tid_ = threadIdx.x; asm volatile("" : "+v"(tid_)); const int tid = tid_, lane = tid & 63, wave = __builtin_amdgcn_readfirstlane(tid >> 6), r32 = lane & 31, hi = lane >> 5, kvh = wave >> 2;
    const int t0 = qt * 32, tq = t0 + r32; const size_t tok = (size_t)b * T + tq;
    bf16x8 qr[4];
#pragma unroll
    for (int d0 = 0; d0 < 4; ++d0) qr[d0] = *(const bf16x8*)(Q + tok * 512 + wave * 64 + d0 * 16 + hi * 8);
    LAS float* IMPA = (LAS float*)(lds + A_IMP); LAS unsigned* MASKL = (LAS unsigned*)(lds + A_MASK); LAS float* SSQL = (LAS float*)(lds + A_SSQ);
    for (int i = tid; i < 2 * 32 * 65; i += 512) IMPA[i] = 0.f;
    if (tid < 32) SSQL[tid] = 0.f;
    const float* glp = GL + tok * 24 + wave * 3;
    const float g0 = 1.f / (1.f + __expf(-glp[0])), g1 = 1.f / (1.f + __expf(-glp[1])), g2 = 1.f / (1.f + __expf(-glp[2]));
    f32x16 tot[2], oT[2];
    const int nvalid = tq >= 31 ? (tq - 31) / 16 + 1 : 0; const int ntc = (2 * qt + 1 + 63) >> 6;
    const int ckmin = nvalid > 0 ? 0 : (1 << 20), ckmax = nvalid > 0 ? nvalid - 1 : (1 << 20);
    const bf16_t* KCb = KC + (size_t)(b * 2) * 256 * 64; const bf16_t* VCb = VC + (size_t)(b * 2) * 256 * 64;
    float lc = 0.f;
#pragma unroll
    for (int r = 0; r < 16; ++r) { oT[0][r] = 0.f; oT[1][r] = 0.f; }
    attn_seg<0>(lds, KCb, VCb, 64, 256 * 64, 0, ntc - 1, qr, oT, lc, ckmin, ckmax, 0u, 0u, tq, 0.f, kvh, wave, lane, r32, hi);
    lc += __shfl_xor(lc, 32); const float inv_lc = lc > 0.f ? 1.f / lc : 0.f;
    { float dummy = 0.f; attn_seg<1>(lds, KCb, VCb, 64, 256 * 64, 0, ntc - 1, qr, oT, dummy, ckmin, ckmax, 0u, 0u, tq, inv_lc, kvh, wave, lane, r32, hi); }
#pragma unroll
    for (int r = 0; r < 16; ++r) { tot[0][r] = oT[0][r] * g0; tot[1][r] = oT[1][r] * g0; oT[0][r] = 0.f; oT[1][r] = 0.f; }
    { const int pair = tid >> 3, jj = tid & 7, qq = pair & 31; const int tb = (t0 + qq) >> 6; LAS float* row = IMPA + pair * 65; float val[8];
#pragma unroll
      for (int k = 0; k < 8; ++k) { const int j = jj * 8 + k; const float v = row[j]; const bool forced = (j == 0) || (j == tb) || (j == tb - 1); val[k] = forced ? 1e4f : (j <= tb ? v : -1e4f); }
#pragma unroll
      for (int k = 0; k < 8; ++k) row[jj * 8 + k] = val[k];
      asm volatile("s_waitcnt lgkmcnt(0)" ::: "memory");
      int rank[8];
#pragma unroll
      for (int k = 0; k < 8; ++k) rank[k] = 0;
#pragma unroll 4
      for (int j2 = 0; j2 < 64; ++j2) { const float o = row[j2];
#pragma unroll
          for (int k = 0; k < 8; ++k) rank[k] += ((o > val[k]) || (o == val[k] && j2 < jj * 8 + k)) ? 1 : 0; }
      unsigned bits = 0u;
#pragma unroll
      for (int k = 0; k < 8; ++k) bits |= (rank[k] < 16) ? (1u << k) : 0u;
      unsigned lo = jj < 4 ? bits << (jj * 8) : 0u, hw = jj >= 4 ? bits << ((jj - 4) * 8) : 0u;
      lo |= __shfl_xor(lo, 1); lo |= __shfl_xor(lo, 2); lo |= __shfl_xor(lo, 4); hw |= __shfl_xor(hw, 1); hw |= __shfl_xor(hw, 2); hw |= __shfl_xor(hw, 4);
      if (jj == 0) { MASKL[pair * 2] = lo; MASKL[pair * 2 + 1] = hw; } }
    __syncthreads();
    const unsigned mlo = MASKL[(kvh * 32 + r32) * 2], mhi = MASKL[(kvh * 32 + r32) * 2 + 1];
    const int jmax = (t0 + 31) >> 6;
    const bf16_t* KVb = KV + (size_t)b * T * 768;
    float ls = 0.f;
    attn_seg<2>(lds, KVb + 256, KVb + 384, 768, 64, 0, jmax, qr, oT, ls, 0, 0, mlo, mhi, tq, 0.f, kvh, wave, lane, r32, hi);
    ls += __shfl_xor(ls, 32);
    { const float c = ls > 0.f ? g1 / ls : 0.f;
#pragma unroll
      for (int r = 0; r < 16; ++r) { tot[0][r] += oT[0][r] * c; tot[1][r] += oT[1][r] * c; oT[0][r] = 0.f; oT[1][r] = 0.f; } }
    float lw = 0.f; const int jlo = t0 >= 511 ? (t0 - 511) >> 6 : 0;
    attn_seg<3>(lds, KVb + 512, KVb + 640, 768, 64, jlo, jmax, qr, oT, lw, tq - 511, tq, 0u, 0u, tq, 0.f, kvh, wave, lane, r32, hi);
    lw += __shfl_xor(lw, 32);
    { const float c = lw > 0.f ? g2 / lw : 0.f;
#pragma unroll
      for (int r = 0; r < 16; ++r) { tot[0][r] += oT[0][r] * c; tot[1][r] += oT[1][r] * c; } }
    { float ss = 0.f;
#pragma unroll
      for (int r = 0; r < 16; ++r) ss += tot[0][r] * tot[0][r] + tot[1][r] * tot[1][r];
      ss += __shfl_xor(ss, 32); if (hi == 0) lds_fadd(SSQL + r32, ss); }
    __syncthreads();
    { const float rs = rsqrtf(SSQL[r32] * (1.f / 512.f) + 1e-6f); bf16_t* op = MIX + tok * 1024 + 512 + wave * 64 + 4 * hi;
#pragma unroll
      for (int dh = 0; dh < 2; ++dh)
#pragma unroll
          for (int a4 = 0; a4 < 4; ++a4) { u32x2 w; w.x = cvt_pk_bf16(tot[dh][4 * a4] * rs, tot[dh][4 * a4 + 1] * rs); w.y = cvt_pk_bf16(tot[dh][4 * a4 + 2] * rs, tot[dh][4 * a4 + 3] * rs); *(u32x2*)(op + dh * 32 + a4 * 8) = w; } }
    __syncthreads();
}

__device__ __forceinline__ void memattn_unit(LAS unsigned char* lds, int b, int h, int qt, const bf16_t* QM, const bf16_t* KVM, const float* qg, bf16_t* OM) {
    int tid_ = threadIdx.x; asm volatile("" : "+v"(tid_)); const int tid = tid_, lane = tid & 63, wave = __builtin_amdgcn_readfirstlane(tid >> 6), r32 = lane & 31, hi = lane >> 5;
    const size_t tok = (size_t)b * T + qt * 256 + wave * 32 + r32;
    bf16x8 qr[8];
    { float v[64]; float ss = 0.f;
#pragma unroll
      for (int d0 = 0; d0 < 8; ++d0) { const u32x4 w = *(const u32x4*)(QM + tok * 512 + h * 128 + d0 * 16 + hi * 8);
#pragma unroll
          for (int i = 0; i < 4; ++i) { const float a = __uint_as_float(w[i] << 16), c = __uint_as_float(w[i] & 0xffff0000u); v[d0 * 8 + 2 * i] = a; v[d0 * 8 + 2 * i + 1] = c; ss += a * a + c * c; } }
      ss += __shfl_xor(ss, 32); const float rs = rsqrtf(ss * (1.f / 128.f) + 1e-6f) * (0.08838834764831845f * 1.4426950408889634f);
#pragma unroll
      for (int d0 = 0; d0 < 8; ++d0) { u32x4 w; const float* gp = qg + d0 * 16 + hi * 8;
#pragma unroll
          for (int i = 0; i < 4; ++i) w[i] = cvt_pk_bf16(v[d0 * 8 + 2 * i] * rs * gp[2 * i], v[d0 * 8 + 2 * i + 1] * rs * gp[2 * i + 1]);
          qr[d0] = __builtin_bit_cast(bf16x8, w); } }
    const bf16_t* Kg = KVM + (size_t)b * 256 * 1024 + h * 128; const bf16_t* Vg = Kg + 512;
    u32x4 sk[2], sv[2];
#define M_LD(tile) do { _Pragma("unroll") for (int i = 0; i < 2; ++i) { sk[i] = *(const u32x4*)(Kg + (size_t)((tile) * 64 + lane) * 1024 + (wave * 2 + i) * 8); const int p = i * 512 + tid; \
        sv[i] = *(const u32x4*)(Vg + (size_t)((tile) * 64 + ((p & 255) >> 2)) * 1024 + (p >> 8) * 32 + (p & 3) * 8); } } while (0)
#define M_ST(so) do { _Pragma("unroll") for (int i = 0; i < 2; ++i) { *(LAS u32x4*)(lds + (so) + (wave * 2 + i) * 1024 + lane * 16) = sk[i]; *(LAS u32x4*)(lds + 32768 + (so) + (i * 512 + tid) * 16) = sv[i]; } } while (0)
    const LAS char* kbase = (const LAS char*)lds + hi * 1024 + r32 * 16;
    const LAS char* vbase = (const LAS char*)lds + 32768 + ((lane >> 4) & 1) * 32 + (lane & 3) * 8 + (4 * hi + ((lane & 15) >> 2)) * 64;
    f32x16 oT[4]; float lsum = 0.f;
#pragma unroll
    for (int dq = 0; dq < 4; ++dq)
#pragma unroll
        for (int r = 0; r < 16; ++r) oT[dq][r] = 0.f;
    M_LD(0); M_ST(0); __syncthreads();
#pragma unroll 1
    for (int tile = 0; tile < 4; ++tile) { const int so = (tile & 1) * 16384;
        if (tile < 3) M_LD(tile + 1);
        f32x16 p0, p1;
#pragma unroll
        for (int r = 0; r < 16; ++r) { p0[r] = 0.f; p1[r] = 0.f; }
#pragma unroll
        for (int d0 = 0; d0 < 8; ++d0) { const bf16x8 k0 = *(const LAS bf16x8*)(kbase + so + d0 * 2048), k1 = *(const LAS bf16x8*)(kbase + so + d0 * 2048 + 512); p0 = MFMA32(k0, qr[d0], p0); p1 = MFMA32(k1, qr[d0], p1); }
        float s = 0.f;
#pragma unroll
        for (int r = 0; r < 16; ++r) { p0[r] = __builtin_amdgcn_exp2f(p0[r]); p1[r] = __builtin_amdgcn_exp2f(p1[r]); s += p0[r] + p1[r]; }
        lsum += s;
        bf16x8 pa[4];
        { u32x4 w0, w1, w2, w3;
#pragma unroll
          for (int i = 0; i < 4; ++i) { w0[i] = cvt_pk_bf16(p0[2 * i], p0[2 * i + 1]); w1[i] = cvt_pk_bf16(p0[8 + 2 * i], p0[8 + 2 * i + 1]); w2[i] = cvt_pk_bf16(p1[2 * i], p1[2 * i + 1]); w3[i] = cvt_pk_bf16(p1[8 + 2 * i], p1[8 + 2 * i + 1]); }
          pa[0] = __builtin_bit_cast(bf16x8, w0); pa[1] = __builtin_bit_cast(bf16x8, w1); pa[2] = __builtin_bit_cast(bf16x8, w2); pa[3] = __builtin_bit_cast(bf16x8, w3); }
#pragma unroll
        for (int dq = 0; dq < 4; ++dq)
#pragma unroll
            for (int ks = 0; ks < 4; ++ks) { const s16x4 lo = vtr(vbase + so + dq * 4096 + ks * 1024), hh = vtr(vbase + so + dq * 4096 + ks * 1024 + 512); oT[dq] = MFMA32(VFRAG(lo, hh), pa[ks], oT[dq]); }
        if (tile < 3) M_ST(so ^ 16384);
        __syncthreads();
    }
#undef M_LD
#undef M_ST
    lsum += __shfl_xor(lsum, 32); const float il = 1.f / lsum; bf16_t* op = OM + tok * 512 + h * 128 + 4 * hi;
#pragma unroll
    for (int dq = 0; dq < 4; ++dq)
#pragma unroll
        for (int a4 = 0; a4 < 4; ++a4) { u32x2 w; w.x = cvt_pk_bf16(oT[dq][4 * a4] * il, oT[dq][4 * a4 + 1] * il); w.y = cvt_pk_bf16(oT[dq][4 * a4 + 2] * il, oT[dq][4 * a4 + 3] * il); *(u32x2*)(op + dq * 32 + a4 * 8) = w; }
}

#define XB_TMO      128
#define XB_XCNT(j)  (256  + 64 * (j))
#define XB_XSUB(j)  (1280 + 64 * (j))
#define XB_XGEN(j)  (2304 + 64 * (j))
#define XB_TOP      3328
#define XB_TOPGEN   3392
#define XCD_BAR_WORDS 3456
#define XB_SPIN_CAP (1u << 18)
__device__ __forceinline__ unsigned xb_ld(unsigned* p)              { return __hip_atomic_load(p, __ATOMIC_RELAXED, __HIP_MEMORY_SCOPE_AGENT); }
__device__ __forceinline__ unsigned xb_add(unsigned* p, unsigned v) { return __hip_atomic_fetch_add(p, v, __ATOMIC_RELAXED, __HIP_MEMORY_SCOPE_AGENT); }
__device__ __forceinline__ unsigned xb_xcc_id() { return (unsigned)__builtin_amdgcn_s_getreg((3 << 11) | 20) & 0xFu; }
#define XB_SPIN(cond, bar) do { unsigned _sp = 0; while (cond) { __builtin_amdgcn_s_sleep(1); \
    if ((++_sp & 255u) == 0u) { if (xb_ld(&(bar)[XB_TMO])) break; if (_sp > XB_SPIN_CAP) { atomicAdd(&(bar)[XB_TMO], 1u); break; } } } } while (0)
struct XcdBarrier { unsigned* bar; unsigned x; volatile LAS unsigned* st; };
__device__ __forceinline__ XcdBarrier xcd_barrier_post(unsigned* bar, volatile LAS unsigned* st) {
    XcdBarrier b; b.bar = bar; b.x = xb_xcc_id(); b.st = st;
    if (threadIdx.x == 0) (void)xb_add(&bar[XB_XCNT(b.x)], 1u);
    return b;
}
__device__ __forceinline__ void xcd_barrier_complete(unsigned* bar, unsigned x, unsigned& nloc, unsigned& nx) {
    const unsigned G = gridDim.x * gridDim.y * gridDim.z;
    unsigned sum, cnt, mine, sp = 0u;
    for (;;) {
        sum = 0u; cnt = 0u; mine = 0u;
#pragma unroll
        for (unsigned j = 0; j < 16; ++j) { const unsigned c = xb_ld(&bar[XB_XCNT(j)]); sum += c; cnt += (c > 0u) ? 1u : 0u; mine = (j == x) ? c : mine; }
        if (sum == G) break;
        __builtin_amdgcn_s_sleep(1);
        if ((++sp & 255u) == 0u) { if (xb_ld(&bar[XB_TMO])) break; if (sp > XB_SPIN_CAP) { atomicAdd(&bar[XB_TMO], 1u); break; } }
    }
    nloc = mine > 0u ? mine : 1u; nx = cnt > 0u ? cnt : 1u;
}
__device__ __forceinline__ void xcd_barrier(const XcdBarrier& b) {
    asm volatile("s_waitcnt vmcnt(0)" ::: "memory");
    __syncthreads();
    if (threadIdx.x == 0) {
        unsigned* bar = b.bar;
        __builtin_amdgcn_s_waitcnt(0);
        unsigned nloc = b.st[0], nx = b.st[1];
        if (nloc == 0u) { xcd_barrier_complete(bar, b.x, nloc, nx); b.st[0] = nloc; b.st[1] = nx; }
        const unsigned old = xb_add(&bar[XB_XSUB(b.x)], 1u);
        const unsigned gen = old / nloc;
        if (old + 1u == (gen + 1u) * nloc) {
            __builtin_amdgcn_fence(__ATOMIC_RELEASE, "agent");
            asm volatile("s_waitcnt vmcnt(0)" ::: "memory");
            const unsigned og = xb_add(&bar[XB_TOP], 1u);
            const unsigned tg = og / nx;
            if (og + 1u == (tg + 1u) * nx) xb_add(&bar[XB_TOPGEN], 1u);
            else XB_SPIN(xb_ld(&bar[XB_TOPGEN]) == tg, bar);
            __builtin_amdgcn_fence(__ATOMIC_ACQUIRE, "agent");
            xb_add(&bar[XB_XGEN(b.x)], 1u);
            asm volatile("s_waitcnt vmcnt(0)" ::: "memory");
        } else {
            XB_SPIN(xb_ld(&bar[XB_XGEN(b.x)]) == gen, bar);
            __builtin_amdgcn_fence(__ATOMIC_ACQUIRE, "agent");
            asm volatile("s_waitcnt vmcnt(0)" ::: "memory");
        }
    }
    __syncthreads();
}
constexpr size_t CTL_BAR_BYTE = 704 * 1024;
constexpr int LDS_ST_OFF = 147456 - 64;

constexpr int LDS_BYTES = 147456;
#ifndef MK_DBL_P
#define MK_DBL_P -1
#endif
#ifndef MK_DBL_SYNC
#define MK_DBL_SYNC 0
#endif
__global__ void __launch_bounds__(512, 2) mega(Args args) {
    extern __shared__ __attribute__((aligned(16))) unsigned char lds_raw[];
    LAS unsigned char* lds = (LAS unsigned char*)lds_raw;
    const int G = gridDim.x, bx = blockIdx.x, NGW = G * 8;
    volatile LAS unsigned* bar_st = (volatile LAS unsigned*)(lds + LDS_ST_OFF);
    if (threadIdx.x < 2) bar_st[threadIdx.x] = 0u;
    if (bx == 0 && args.ph_lo == 0) { unsigned* bw = (unsigned*)(args.ws + WS_CTL + CTL_BAR_BYTE); for (int i = threadIdx.x; i < XCD_BAR_WORDS; i += 512) __hip_atomic_store(bw + i, 0u, __ATOMIC_RELAXED, __HIP_MEMORY_SCOPE_AGENT); }
    __syncthreads();
    XcdBarrier xbar; xbar.bar = (unsigned*)(args.ws + WS_CTL + CTL_BAR_BYTE); xbar.x = 0; xbar.st = bar_st;
    if (args.ph_lo == 0) { const int tid0 = threadIdx.x, wave0 = __builtin_amdgcn_readfirstlane(tid0 >> 6); prologue(args, lds, bx * 8 + wave0, NGW, wave0, tid0 & 63); }
    for (int ph = args.ph_lo > 1 ? args.ph_lo : 1; ph < args.ph_hi; ++ph) {
        if (ph > args.ph_lo) {
            if (ph == 1) { cooperative_groups::this_grid().sync(); xbar = xcd_barrier_post(xbar.bar, bar_st); }
            else xcd_barrier(xbar); }
        unsigned char* ws = args.ws; float* xout = args.out; asm volatile("" : "+s"(ws), "+s"(xout));
        int tidp = threadIdx.x; asm volatile("" : "+v"(tidp)); const int lane = tidp & 63, wave = __builtin_amdgcn_readfirstlane(tidp >> 6), gw = bx * 8 + wave;
        float* ctl = (float*)(ws + WS_CTL); bf16_t* XB = (bf16_t*)(ws + WS_XB);
        const int l = (ph - 1) / 10, p = (ph - 1) % 10; unsigned char* wl = ws + WS_W + l * W_LAYER;
#if MK_DBL_SYNC
        for (int e_ = 0; e_ < MK_DBL_SYNC; ++e_) xcd_barrier(xbar);
#endif
#if MK_DBL_P >= 0
        for (int rep_ = 0; rep_ < ((p == MK_DBL_P) ? 2 : 1); ++rep_)
#endif
        if (p == 0) {
            pg8::Gemm g = pg8::make_gemm(XB, (const bf16_t*)(wl + W_IN), 1024); pg8::StaticOrder S; S.init(NTOK, INP, G, bx);
            pg8::EpiInProj E{(bf16_t*)(ws + WS_U), (bf16_t*)(ws + WS_V), (bf16_t*)(ws + WS_Q), (bf16_t*)(ws + WS_KV), (float*)(ws + WS_GL), ctl + (l == 0 ? 0 : 3) * NTOK};
            pg8::gemm_phase<pg8::EpiInProj, pg8::StaticOrder, true>(lds, g, S, E);
        } else if (p == 1) {
            if (bx < 16) { const int kv = bx >> 3, pm = bx & 7;
                pg8::Gemm g; g.A = (const bf16_t*)(ws + WS_KV) + kv * 128; g.Bt = (const bf16_t*)(wl + W_C1 + (size_t)kv * 256 * 2048 * 2); g.K = 2048; g.lda = 16 * 768; g.kstepA = 768 * 2; g.a_s0 = 64 * 2; g.a_s1 = (size_t)T * 768 * 2;
                pg8::OneUnit S{1, {pm, 0}};
                pg8::EpiBf16G<1> E{(bf16_t*)(ws + WS_HID) + (size_t)kv * 2048 * 256, 256, (const float*)(wl + W_B1P) + kv * 256, nullptr, 0.f};
                pg8::gemm_phase<pg8::EpiBf16G<1>, pg8::OneUnit, true>(lds, g, S, E);
            } else if (bx < 32) { const int i = bx - 16;
                pg8::Gemm g = pg8::make_gemm((const bf16_t*)(ws + WS_MEMB), (const bf16_t*)(wl + W_MKV), 1024); pg8::OneUnit S{1, {i >> 2, i & 3}};
                pg8::EpiBf16G<0> E{(bf16_t*)(ws + WS_KVM), 1024, nullptr, ctl + SSQ_MEM_OFF, 1.f / 1024.f};
                pg8::gemm_phase<pg8::EpiBf16G<0>, pg8::OneUnit, true>(lds, g, S, E);
            }
        } else if (p == 2) {
            for (int u = bx; u < 128; u += G) sgu_unit(lds, u, (const bf16_t*)(ws + WS_U), (const bf16_t*)(ws + WS_V), (const bf16_t*)(wl + W_SG), args.in[I_SGLNG] + l * 512, args.in[I_SGLNB] + l * 512, args.in[I_SGB] + l * 1024, (bf16_t*)(ws + WS_MIX));
            for (int t = gw; t < NTOK; t += NGW) tokprep_token((bf16_t*)(ws + WS_Q), (bf16_t*)(ws + WS_KV), args.in[I_QNG] + l * 64, args.in[I_KNG] + l * 192, t, lane);
            for (int r = gw; r < 2048; r += NGW) cmp2_row((const bf16_t*)(ws + WS_HID), (const bf16_t*)(wl + W_C2), args.in[I_CB2] + l * 128, args.in[I_KNG] + l * 192, (bf16_t*)(ws + WS_KC), (bf16_t*)(ws + WS_VC), r, lane);
        } else if (p == 3) {
            for (int r = gw; r < 4096; r += NGW) memk_norm_item((bf16_t*)(ws + WS_KVM), args.in[I_MKG] + l * 128, r, lane);
            for (int i = bx; i < 256; i += G) { const int b = (i & 7) >> 1, idx = (i >> 3) * 2 + (i & 1);
                attn_unit(lds, b, 127 - idx, (const bf16_t*)(ws + WS_Q), (const bf16_t*)(ws + WS_KV), (const bf16_t*)(ws + WS_KC), (const bf16_t*)(ws + WS_VC), (const float*)(ws + WS_GL), (bf16_t*)(ws + WS_MIX));
                attn_unit(lds, b, idx, (const bf16_t*)(ws + WS_Q), (const bf16_t*)(ws + WS_KV), (const bf16_t*)(ws + WS_KC), (const bf16_t*)(ws + WS_VC), (const float*)(ws + WS_GL), (bf16_t*)(ws + WS_MIX)); }
        } else if (p == 6) {
            for (int i = bx; i < 256; i += G) { const int b = (i & 7) >> 1, rest = (i >> 3) * 2 + (i & 1);
                memattn_unit(lds, b, rest >> 4, rest & 15, (const bf16_t*)(ws + WS_QM), (const bf16_t*)(ws + WS_KVM), args.in[I_MQG] + l * 128, (bf16_t*)(ws + WS_OM)); }
        } else if (p == 4) {
            pg8::Gemm g = pg8::make_gemm((const bf16_t*)(ws + WS_MIX), (const bf16_t*)(wl + W_OUT), 1024); pg8::StaticOrder S; S.init(NTOK, 1024, G, bx);
            pg8::EpiResid E{xout, XB, ctl + (l * 3 + 1) * NTOK};
            pg8::gemm_phase<pg8::EpiResid, pg8::StaticOrder, true>(lds, g, S, E);
        } else if (p == 5) {
            pg8::Gemm g = pg8::make_gemm(XB, (const bf16_t*)(wl + W_MQ), 1024); pg8::StaticOrder S; S.init(NTOK, 512, G, bx);
            pg8::EpiBf16G<0> E{(bf16_t*)(ws + WS_QM), 512, nullptr, ctl + (l * 3 + 1) * NTOK, 1.f / 1024.f};
            pg8::gemm_phase<pg8::EpiBf16G<0>, pg8::StaticOrder, true>(lds, g, S, E);
        } else if (p == 7) {
            pg8::Gemm g = pg8::make_gemm((const bf16_t*)(ws + WS_OM), (const bf16_t*)(wl + W_MO), 512); pg8::StaticOrder S; S.init(NTOK, 1024, G, bx);
            pg8::EpiResid E{xout, XB, ctl + (l * 3 + 2) * NTOK};
            pg8::gemm_phase<pg8::EpiResid, pg8::StaticOrder, true>(lds, g, S, E);
        } else if (p == 8) {
            pg8::Gemm g = pg8::make_gemm(XB, (const bf16_t*)(wl + W_FF1), 1024); pg8::StaticOrder S; S.init(NTOK, FF, G, bx);
            pg8::EpiBf16G<2> E{(bf16_t*)(ws + WS_HB), FF, nullptr, ctl + (l * 3 + 2) * NTOK, 1.f / 1024.f};
            pg8::gemm_phase<pg8::EpiBf16G<2>, pg8::StaticOrder, true>(lds, g, S, E);
        } else if (p == 9) {
            pg8::Gemm g = pg8::make_gemm((const bf16_t*)(ws + WS_HB), (const bf16_t*)(wl + W_FF2), FF); pg8::StaticOrder S; S.init(NTOK, 1024, G, bx);
            pg8::EpiResid E{xout, l == 0 ? XB : (bf16_t*)nullptr, ctl + 3 * NTOK};
            pg8::gemm_phase<pg8::EpiResid, pg8::StaticOrder, true>(lds, g, S, E);
        }
    }
}

}

#ifndef MK_FUSED
#define MK_FUSED 1
#endif
extern "C" void kernel_launch(void* const* d_in, const int* in_sizes, int n_in, void* d_out, int out_size, void* d_ws, size_t ws_size, hipStream_t stream) {
    using namespace mk;
    static int grid = 0;
    if (!grid) { (void)hipFuncSetAttribute((const void*)mega, hipFuncAttributeMaxDynamicSharedMemorySize, LDS_BYTES);
        int dev = 0, cus = 0, per_cu = 0; (void)hipGetDevice(&dev); (void)hipDeviceGetAttribute(&cus, hipDeviceAttributeMultiprocessorCount, dev);
        (void)hipOccupancyMaxActiveBlocksPerMultiprocessor(&per_cu, (const void*)mega, 512, LDS_BYTES);
        grid = cus * (per_cu < 1 ? 1 : per_cu); if (grid > 256) grid = 256; }
    Args a{}; for (int i = 0; i < 27; ++i) a.in[i] = (const float*)d_in[i]; a.out = (float*)d_out; a.ws = (unsigned char*)d_ws;
#if MK_FUSED
    a.ph_lo = 0; a.ph_hi = 21; void* kargs[] = {&a};
    (void)hipLaunchCooperativeKernel((const void*)mega, dim3(grid), dim3(512), kargs, LDS_BYTES, stream);
#else
    for (int ph = 0; ph < 21; ++ph) { a.ph_lo = ph; a.ph_hi = ph + 1; hipLaunchKernelGGL(mega, dim3(grid), dim3(512), LDS_BYTES, stream, a); }
#endif
}
```

```cpp
#include <hip/hip_runtime.h>
#include <hip/hip_cooperative_groups.h>
#include <stdint.h>
#include <math.h>

namespace pg8 {
#define PG8_LAS __attribute__((address_space(3)))
typedef unsigned short bf16_t;
typedef short bf16x8 __attribute__((ext_vector_type(8)));
typedef float f32x4 __attribute__((ext_vector_type(4)));
typedef float f32x2 __attribute__((ext_vector_type(2)));
typedef unsigned u32x4 __attribute__((ext_vector_type(4)));
typedef unsigned u32x2 __attribute__((ext_vector_type(2)));
constexpr int BM = 256, BK = 64, HALF = 128, HTB = HALF * BK * 2, STAGE_BYTES = 8 * HTB, NXCD = 8, WGM = 8;

__host__ __device__ __forceinline__ int lds_byte(int r, int c) { const int st = (r >> 4) * 2 + (c >> 5), rr = r & 15, cc = c & 31, ob = rr * 64 + cc * 2; return st * 1024 + (ob ^ (((ob >> 9) & 1) << 5)); }
__host__ __device__ __forceinline__ void stage_rc(int b, int& R, int& C) { const int st = b / 1024, sb = b % 1024, swz = sb ^ (((sb >> 9) & 1) << 5); R = (st >> 1) * 16 + swz / 64; C = (st & 1) * 32 + (swz % 64) / 2; }
__host__ __device__ __forceinline__ int perm32(int rho) { const int n = rho >> 4, i = rho & 15; return 8 * (i >> 2) + 4 * n + (i & 3); }

struct Unit { int pm, pn; };
struct Gemm { const bf16_t* A; const bf16_t* Bt; int K; int lda; int kstepA; size_t a_s0, a_s1; };
__device__ __forceinline__ Gemm make_gemm(const bf16_t* A, const bf16_t* Bt, int K) { Gemm g; g.A = A; g.Bt = Bt; g.K = K; g.lda = K; g.kstepA = BK * 2; g.a_s0 = (size_t)BM * K * 2; g.a_s1 = 2 * g.a_s0; return g; }

struct StaticOrder {
    int nM, nN, nwg, G, c;
    __device__ void init(int M, int N, int G_, int c_) { nM = M / BM; nN = N / BM; nwg = nM * nN; G = G_; c = c_; }
    __device__ bool next(int i, Unit& u) const {
        const long L = (long)i * G + c; if (L >= nwg) return false;
        int wgid = (int)L; { const int q = nwg / NXCD, r = nwg % NXCD, xcd = wgid % NXCD, off = wgid / NXCD; wgid = (xcd < r ? xcd * (q + 1) : r * (q + 1) + (xcd - r) * q) + off; }
        const int nig = WGM * nN, gid = wgid / nig, fm = gid * WGM, gsz = (nM - fm) < WGM ? (nM - fm) : WGM;
        u.pm = fm + ((wgid % nig) % gsz); u.pn = (wgid % nig) / gsz; return true;
    }
};
struct OneUnit { int has; Unit u; __device__ bool next(int i, Unit& o) const { if (i > 0 || !has) return false; o = u; return true; } };

__device__ __forceinline__ unsigned cvt_pk_bf16(float lo, float hi) { unsigned r; asm volatile("v_cvt_pk_bf16_f32 %0, %1, %2" : "=v"(r) : "v"(lo), "v"(hi)); return r; }
__device__ __forceinline__ float gelu_tanh(float x) { const float u = 0.7978845608028654f * (x + 0.044715f * x * x * x); const float e = __builtin_amdgcn_exp2f(-2.885390081777927f * u); return x * __builtin_amdgcn_rcpf(1.f + e); }

template <int ACT  > struct EpiBf16G {
    static constexpr bool PERM = true, AFTER_DRAIN = false;
    bf16_t* O; int ldc; const float* bias; const float* ssq; float inv_n;
    __device__ __forceinline__ void operator()(const f32x4 (&acc)[2][2][4][2], const Unit& u, int wr, int wc, int fr, int fq) const {
        const int row0 = u.pm * BM + wr * 64 + fr, col0 = u.pn * BM + wc * 32 + 8 * fq;
        f32x4 bv[2][2];
#pragma unroll
        for (int bj = 0; bj < 2; ++bj)
#pragma unroll
            for (int n = 0; n < 2; ++n) bv[bj][n] = bias ? *(const f32x4*)(bias + col0 + bj * HALF + 4 * n) : (f32x4){0.f, 0.f, 0.f, 0.f};
#pragma unroll
        for (int ai = 0; ai < 2; ++ai)
#pragma unroll
            for (int m = 0; m < 4; ++m) { const int row = row0 + ai * HALF + m * 16; const float rs = ssq ? rsqrtf(ssq[row] * inv_n + 1e-6f) : 1.f; bf16_t* rowp = O + (size_t)row * ldc + col0;
#pragma unroll
                for (int bj = 0; bj < 2; ++bj) { f32x4 v0 = (acc[ai][bj][m][0] + bv[bj][0]) * rs, v1 = (acc[ai][bj][m][1] + bv[bj][1]) * rs;
                    if (ACT == 1) {
#pragma unroll
                        for (int e = 0; e < 4; ++e) { v0[e] = gelu_tanh(v0[e]); v1[e] = gelu_tanh(v1[e]); } }
                    if (ACT == 2) {
#pragma unroll
                        for (int e = 0; e < 4; ++e) { float a = fmaxf(v0[e], 0.f), b = fmaxf(v1[e], 0.f); v0[e] = a * a; v1[e] = b * b; } }
                    u32x4 w; w.x = cvt_pk_bf16(v0[0], v0[1]); w.y = cvt_pk_bf16(v0[2], v0[3]); w.z = cvt_pk_bf16(v1[0], v1[1]); w.w = cvt_pk_bf16(v1[2], v1[3]);
                    *(u32x4*)(rowp + bj * HALF) = w; } }
    }
};
struct EpiInProj {
    static constexpr bool PERM = true, AFTER_DRAIN = false;
    bf16_t *U, *V, *Q, *KV; float* GL; const float* ssq;
    __device__ __forceinline__ void operator()(const f32x4 (&acc)[2][2][4][2], const Unit& u, int wr, int wc, int fr, int fq) const {
        const int row0 = u.pm * BM + wr * 64 + fr, cit0 = wc * 32 + 8 * fq; const int pn = u.pn;
        bf16_t* base; int ldc, cofs; bool act = false;
        if (pn < 2) { base = U; ldc = 512; cofs = pn * 256; act = true; } else if (pn < 4) { base = V; ldc = 512; cofs = (pn - 2) * 256; act = true; }
        else if (pn < 6) { base = Q; ldc = 512; cofs = (pn - 4) * 256; } else { base = KV; ldc = 768; cofs = (pn - 6) * 256; }
#pragma unroll
        for (int ai = 0; ai < 2; ++ai)
#pragma unroll
            for (int m = 0; m < 4; ++m) { const int row = row0 + ai * HALF + m * 16; const float rs = rsqrtf(ssq[row] * (1.f / 1024.f) + 1e-6f);
#pragma unroll
                for (int bj = 0; bj < 2; ++bj) { f32x4 v0 = acc[ai][bj][m][0] * rs, v1 = acc[ai][bj][m][1] * rs; const int cit = cit0 + bj * HALF;
                    if (pn == 9) { if (cit < 24) { *(f32x4*)(GL + (size_t)row * 24 + cit) = v0; *(f32x4*)(GL + (size_t)row * 24 + cit + 4) = v1; } }
                    else { if (act) {
#pragma unroll
                            for (int e = 0; e < 4; ++e) { v0[e] = gelu_tanh(v0[e]); v1[e] = gelu_tanh(v1[e]); } }
                        u32x4 w; w.x = cvt_pk_bf16(v0[0], v0[1]); w.y = cvt_pk_bf16(v0[2], v0[3]); w.z = cvt_pk_bf16(v1[0], v1[1]); w.w = cvt_pk_bf16(v1[2], v1[3]);
                        *(u32x4*)(base + (size_t)row * ldc + cofs + cit) = w; } } }
    }
};
struct EpiResid {
    static constexpr bool PERM = false, AFTER_DRAIN = false;
    float* X; bf16_t* XB; float* ssq;
    __device__ __forceinline__ void operator()(const f32x4 (&acc)[2][2][4][2], const Unit& u, int wr, int wc, int fr, int fq) const {
        const int col0 = u.pn * BM + wc * 32 + 4 * fq;
#pragma unroll
        for (int ai = 0; ai < 2; ++ai)
#pragma unroll
            for (int m = 0; m < 4; ++m) { const int row = u.pm * BM + ai * HALF + wr * 64 + m * 16 + fr; float sq = 0.f;
#pragma unroll
                for (int bj = 0; bj < 2; ++bj)
#pragma unroll
                    for (int n = 0; n < 2; ++n) { const size_t off = (size_t)row * 1024 + col0 + bj * HALF + n * 16; f32x4 xv = *(const f32x4*)(X + off); xv = xv + acc[ai][bj][m][n]; *(f32x4*)(X + off) = xv;
                        if (XB) { sq += (xv[0] * xv[0] + xv[1] * xv[1]) + (xv[2] * xv[2] + xv[3] * xv[3]); u32x2 w; w.x = cvt_pk_bf16(xv[0], xv[1]); w.y = cvt_pk_bf16(xv[2], xv[3]); *(u32x2*)(XB + off) = w; } }
                if (XB) { sq += __shfl_xor(sq, 16); sq += __shfl_xor(sq, 32); if (fq == 0) atomicAdd(ssq + row, sq); } }
    }
};

template <class Epi, class Sched, bool ALIGN_EPI>
__device__ __forceinline__ void gemm_phase(PG8_LAS unsigned char* lds, const Gemm g, const Sched& S, const Epi& E) {
    int tid_ = threadIdx.x; asm volatile("" : "+v"(tid_));
    const int tid = tid_, wid = __builtin_amdgcn_readfirstlane(tid >> 6), lane = tid & 63, wr = wid >> 2, wc = wid & 3, fr = lane & 15, fq = lane >> 4;
    const int K = g.K, nt = K / BK;
    unsigned voffA[2], voffB[2];
#pragma unroll
    for (int i = 0; i < 2; ++i) { int R, C; stage_rc(tid * 16 + i * 8192, R, C); const int Rb = Epi::PERM ? ((R & ~31) + perm32(R & 31)) : R;
        voffA[i] = (unsigned)(R * g.lda + C) * 2u; voffB[i] = (unsigned)(Rb * K + C) * 2u; }
    const size_t kstepA = (size_t)g.kstepA, kstepB = (size_t)(BK * 2);
    const size_t hstepA = (size_t)HALF * g.lda * 2, hstepB = (size_t)HALF * K * 2, tstepB = 2 * hstepB;
    const unsigned ldsw = (unsigned)wid * 1024u;
    const int aoff = lds_byte(wr * 64 + fr, fq * 8), boff = lds_byte(wc * 32 + fr, fq * 8);
#define PG8_ABASE(pm) ((const char*)g.A + (size_t)((pm) >> 1) * g.a_s1 + (size_t)((pm) & 1) * g.a_s0)
#define PG8_SA(b, h) (((b) * 2 + (h)) * HTB)
#define PG8_SB(b, h) ((4 + (b) * 2 + (h)) * HTB)
#define PG8_STAGE(bufoff, gbase, voff) do { _Pragma("unroll") for (int _i = 0; _i < 2; ++_i) \
        __builtin_amdgcn_global_load_lds((const unsigned*)((const char*)(gbase) + (voff)[_i]), (PG8_LAS unsigned*)(lds + (bufoff) + ldsw + _i * 8192), 16, 0, 0); } while (0)
#define PG8_LDA(dst, b, h) do { _Pragma("unroll") for (int m = 0; m < 4; ++m) _Pragma("unroll") for (int k = 0; k < 2; ++k) dst[m][k] = *(const PG8_LAS bf16x8*)(lds + PG8_SA(b, h) + aoff + m * 2048 + k * 1024); } while (0)
#define PG8_LDB(dst, b, h) do { _Pragma("unroll") for (int n = 0; n < 2; ++n) _Pragma("unroll") for (int k = 0; k < 2; ++k) dst[n][k] = *(const PG8_LAS bf16x8*)(lds + PG8_SB(b, h) + boff + n * 2048 + k * 1024); } while (0)
#define PG8_MMA(ai, bj, At, Bt) do { __builtin_amdgcn_s_setprio(1); _Pragma("unroll") for (int m = 0; m < 4; ++m) _Pragma("unroll") for (int n = 0; n < 2; ++n) _Pragma("unroll") for (int k = 0; k < 2; ++k) \
        acc[ai][bj][m][n] = __builtin_amdgcn_mfma_f32_16x16x32_bf16(Bt[n][k], At[m][k], acc[ai][bj][m][n], 0, 0, 0); __builtin_amdgcn_s_setprio(0); } while (0)
#define PG8_WAIT_V(n) asm volatile("s_waitcnt vmcnt(" #n ")" ::: "memory")
#define PG8_WAIT_L(n) asm volatile("s_waitcnt lgkmcnt(" #n ")" ::: "memory")
#define PG8_BAR __builtin_amdgcn_s_barrier()
#define PG8_SCHED __builtin_amdgcn_sched_barrier(0)
    Unit cur, nxt; int ui = 0;
    if (!S.next(0, cur)) return;
    f32x4 acc[2][2][4][2];
#pragma unroll
    for (int a = 0; a < 2; ++a)
#pragma unroll
        for (int b = 0; b < 2; ++b)
#pragma unroll
            for (int m = 0; m < 4; ++m)
#pragma unroll
                for (int n = 0; n < 2; ++n) acc[a][b][m][n] = (f32x4){0.f, 0.f, 0.f, 0.f};
    bf16x8 At[4][2], B0[2][2], B1[2][2];
    const char* cA = PG8_ABASE(cur.pm); const char* cB = (const char*)g.Bt + (size_t)cur.pn * tstepB;
    PG8_STAGE(PG8_SB(0, 0), cB, voffB); PG8_STAGE(PG8_SB(0, 1), cB + hstepB, voffB); PG8_STAGE(PG8_SA(0, 0), cA, voffA); PG8_STAGE(PG8_SA(0, 1), cA + hstepA, voffA);
    if (wr == 1) PG8_BAR;
    PG8_WAIT_V(2); PG8_BAR;
    PG8_STAGE(PG8_SB(1, 0), cB + kstepB, voffB); PG8_STAGE(PG8_SA(1, 0), cA + kstepA, voffA); PG8_STAGE(PG8_SB(1, 1), cB + hstepB + kstepB, voffB);
    PG8_WAIT_V(6); PG8_BAR;
    for (;;) {
        const bool has_next = S.next(ui + 1, nxt);
        const char* nA = has_next ? PG8_ABASE(nxt.pm) : cA; const char* nB = has_next ? (const char*)g.Bt + (size_t)nxt.pn * tstepB : cB;
        for (int t = 0; t < nt; t += 2) {
            const bool last = (t == nt - 2);
            const char* a1 = cA + (size_t)(t + 1) * kstepA;
            const char* a2 = last ? nA : cA + (size_t)(t + 2) * kstepA; const char* b2 = last ? nB : cB + (size_t)(t + 2) * kstepB;
            const char* a3 = a2 + kstepA; const char* b3 = b2 + kstepB;
            PG8_LDB(B0, 0, 0); PG8_LDB(B1, 0, 1); PG8_SCHED; PG8_LDA(At, 0, 0); PG8_STAGE(PG8_SA(1, 1), a1 + hstepA, voffA);
            PG8_WAIT_V(8); PG8_WAIT_L(0); PG8_BAR; PG8_MMA(0, 0, At, B0); PG8_MMA(0, 1, At, B1); PG8_BAR; PG8_SCHED;
            PG8_LDA(At, 0, 1); PG8_STAGE(PG8_SB(0, 0), b2, voffB); PG8_STAGE(PG8_SB(0, 1), b2 + hstepB, voffB); PG8_STAGE(PG8_SA(0, 0), a2, voffA);
            PG8_WAIT_V(8); PG8_WAIT_L(0); PG8_BAR; PG8_MMA(1, 0, At, B0); PG8_MMA(1, 1, At, B1); PG8_BAR; PG8_SCHED;
            PG8_LDB(B0, 1, 0); PG8_LDB(B1, 1, 1); PG8_SCHED; PG8_LDA(At, 1, 0); PG8_STAGE(PG8_SA(0, 1), a2 + hstepA, voffA);
            PG8_WAIT_V(8); PG8_WAIT_L(0); PG8_BAR; PG8_MMA(0, 0, At, B0); PG8_MMA(0, 1, At, B1); PG8_BAR; PG8_SCHED;
            PG8_LDA(At, 1, 1); PG8_STAGE(PG8_SB(1, 0), b3, voffB); PG8_STAGE(PG8_SB(1, 1), b3 + hstepB, voffB); PG8_STAGE(PG8_SA(1, 0), a3, voffA);
            PG8_WAIT_V(8); PG8_WAIT_L(0); PG8_BAR; PG8_MMA(1, 0, At, B0); PG8_MMA(1, 1, At, B1); PG8_BAR; PG8_SCHED;
        }
        if constexpr (ALIGN_EPI) { if (wr == 0) PG8_BAR; }
        if constexpr (!Epi::AFTER_DRAIN) { E(acc, cur, wr, wc, fr, fq); }
        if (!has_next) break;
#pragma unroll
        for (int a = 0; a < 2; ++a)
#pragma unroll
            for (int b = 0; b < 2; ++b)
#pragma unroll
                for (int m = 0; m < 4; ++m)
#pragma unroll
                    for (int n = 0; n < 2; ++n) acc[a][b][m][n] = (f32x4){0.f, 0.f, 0.f, 0.f};
        cur = nxt; cA = nA; cB = nB; ++ui;
        if constexpr (ALIGN_EPI) { if (wr == 1) PG8_BAR; }
    }
    PG8_WAIT_V(0);
    if constexpr (!ALIGN_EPI) { if (wr == 0) PG8_BAR; }
    PG8_BAR;
    if constexpr (Epi::AFTER_DRAIN) { E.fused(acc, cur, wr, wc, fr, fq, lds, wid, lane); }
#undef PG8_ABASE
#undef PG8_SA
#undef PG8_SB
#undef PG8_STAGE
#undef PG8_LDA
#undef PG8_LDB
#undef PG8_MMA
#undef PG8_WAIT_V
#undef PG8_WAIT_L
#undef PG8_BAR
#undef PG8_SCHED
}
}

#ifndef MK_PROBE_N
#define MK_PROBE_N 0
#endif
#ifndef MK_PROBE_PARTS
#define MK_PROBE_PARTS 15
#endif

namespace mk {
using pg8::bf16_t; using pg8::f32x4; using pg8::u32x4; using pg8::u32x2; using pg8::cvt_pk_bf16;
#define LAS __attribute__((address_space(3)))
constexpr int NB = 4, T = 4096, D = 1024, NTOK = NB * T, INC = 2328, INP = 2560, FF = 4096;
constexpr size_t MiB = 1u << 20;
constexpr size_t WS_CTL = 0;
constexpr size_t WS_W = 1 * MiB, W_LAYER = 30 * MiB;
constexpr size_t W_IN = 0, W_OUT = 5 * MiB, W_MQ = 7 * MiB, W_MKV = 8 * MiB, W_MO = 10 * MiB, W_FF1 = 11 * MiB, W_FF2 = 19 * MiB, W_C1 = 27 * MiB, W_C2 = 29 * MiB, W_SG = 29 * MiB + 128 * 1024, W_B1P = 29 * MiB + 512 * 1024;
constexpr size_t WS_XB = 61 * MiB;
constexpr size_t WS_OV = 93 * MiB;
constexpr size_t WS_U = WS_OV, WS_V = WS_OV + 16 * MiB, WS_Q = WS_OV + 32 * MiB, WS_KV = WS_OV + 48 * MiB, WS_MIX = WS_OV + 72 * MiB, WS_QM = WS_OV + 104 * MiB, WS_OM = WS_OV + 120 * MiB;
constexpr size_t WS_HB = WS_OV;
constexpr size_t WS_SM = 229 * MiB;
constexpr size_t WS_GL = WS_SM, WS_KC = WS_SM + 2 * MiB, WS_VC = WS_KC + 256 * 1024, WS_HID = WS_SM + 3 * MiB, WS_MASK = WS_SM + 5 * MiB, WS_MEMB = WS_SM + 6 * MiB, WS_KVM = WS_SM + 8 * MiB, WS_END = WS_SM + 10 * MiB;
static_assert(WS_END <= 256 * MiB, "ws map");
constexpr int SSQ_MEM_OFF = 6 * NTOK;

struct Args { const float* in[27]; float* out; unsigned char* ws; int ph_lo, ph_hi; };
enum { I_X = 0, I_MEM, I_NMG, I_WIN, I_SGLNG, I_SGLNB, I_SGW, I_SGB, I_QNG, I_KNG, I_CPOS, I_CW1, I_CB1, I_CW2, I_CB2, I_MOG, I_WOUT, I_NMEMG, I_MKVG, I_WMQ, I_WMKV, I_MQG, I_MKG, I_WMO, I_NFG, I_WFF1, I_WFF2 };

__device__ __forceinline__ float bf2f(unsigned short b) { return __uint_as_float((unsigned)b << 16); }
__device__ __forceinline__ float wave_sum(float v) {
#pragma unroll
    for (int o = 1; o < 64; o <<= 1) v += __shfl_xor(v, o);
    return v; }

__device__ __forceinline__ void transpose_item(const float* W, int K, int N, int Npad, const float* gain, bf16_t* WT, LAS float* scr, int item, int lane) {
    const int nblk = Npad / 32, kb = item / nblk, nb = item % nblk, k0 = 64 * kb, n0 = 32 * nb;
    const int nn = n0 + (lane & 31);
#pragma unroll 8
    for (int i = 0; i < 32; ++i) { const int kk = 2 * i + (lane >> 5); float v = 0.f; if (nn < N) { v = W[(size_t)(k0 + kk) * N + nn]; if (gain) v *= gain[k0 + kk]; } scr[kk * 33 + (lane & 31)] = v; }
    asm volatile("s_waitcnt lgkmcnt(0)" ::: "memory");
    const int c = lane & 7;
#pragma unroll
    for (int j = 0; j < 4; ++j) { const int n = (lane >> 3) + 8 * j; const LAS float* s = scr + (8 * c) * 33 + n;
        u32x4 o; o.x = cvt_pk_bf16(s[0 * 33], s[1 * 33]); o.y = cvt_pk_bf16(s[2 * 33], s[3 * 33]); o.z = cvt_pk_bf16(s[4 * 33], s[5 * 33]); o.w = cvt_pk_bf16(s[6 * 33], s[7 * 33]);
        *(u32x4*)(WT + (size_t)(n0 + n) * K + k0 + 8 * c) = o; }
    asm volatile("s_waitcnt lgkmcnt(0)" ::: "memory");
}

__device__ __forceinline__ void prologue(const Args& a, LAS unsigned char* lds, int gw, int NGW, int wave, int lane) {
    LAS float* scr = (LAS float*)(lds + wave * 16384);
    unsigned char* ws = a.ws; float* ctl = (float*)(ws + WS_CTL);
    int it0 = 0;
#define TR_MAT(Wp, K_, N_, NP_, Gp, DST) { const int cnt = ((K_) / 64) * ((NP_) / 32); for (int it = gw; it < it0 + cnt; it += NGW) { if (it >= it0) transpose_item((Wp), (K_), (N_), (NP_), (Gp), (bf16_t*)(DST), scr, it - it0, lane); } it0 += cnt; }
    for (int l = 0; l < 2; ++l) {
        unsigned char* wl = ws + WS_W + l * W_LAYER;
        TR_MAT(a.in[I_WIN] + (size_t)l * 1024 * INC, 1024, INC, INP, a.in[I_NMG] + l * 1024, wl + W_IN)
        TR_MAT(a.in[I_WOUT] + (size_t)l * 1024 * 1024, 1024, 1024, 1024, a.in[I_MOG] + l * 1024, wl + W_OUT)
        TR_MAT(a.in[I_WMQ] + (size_t)l * 1024 * 512, 1024, 512, 512, a.in[I_NMEMG] + l * 1024, wl + W_MQ)
        TR_MAT(a.in[I_WMKV] + (size_t)l * 1024 * 1024, 1024, 1024, 1024, a.in[I_MKVG] + l * 1024, wl + W_MKV)
        TR_MAT(a.in[I_WMO] + (size_t)l * 512 * 1024, 512, 1024, 1024, (const float*)nullptr, wl + W_MO)
        TR_MAT(a.in[I_WFF1] + (size_t)l * 1024 * 4096, 1024, 4096, 4096, a.in[I_NFG] + l * 1024, wl + W_FF1)
        TR_MAT(a.in[I_WFF2] + (size_t)l * 4096 * 1024, 4096, 1024, 1024, (const float*)nullptr, wl + W_FF2)
        for (int kv = 0; kv < 2; ++kv) {
            TR_MAT(a.in[I_CW1] + (size_t)(l * 2 + kv) * 2048 * 256, 2048, 256, 256, (const float*)nullptr, wl + W_C1 + (size_t)kv * 256 * 2048 * 2)
            TR_MAT(a.in[I_CW2] + (size_t)(l * 2 + kv) * 256 * 64, 256, 64, 64, (const float*)nullptr, wl + W_C2 + (size_t)kv * 64 * 256 * 2)
        }
    }
#undef TR_MAT
    { const float* x = a.in[I_X]; bf16_t* XB = (bf16_t*)(ws + WS_XB);
      for (int r = gw; r < NTOK; r += NGW) { const f32x4* xr = (const f32x4*)(x + (size_t)r * 1024) + lane; f32x4* orow = (f32x4*)(a.out + (size_t)r * 1024) + lane; unsigned long long* xb = (unsigned long long*)(XB + (size_t)r * 1024) + lane; float s = 0.f;
#pragma unroll
          for (int j = 0; j < 4; ++j) { const f32x4 v = xr[64 * j]; orow[64 * j] = v; s += (v[0] * v[0] + v[1] * v[1]) + (v[2] * v[2] + v[3] * v[3]); xb[64 * j] = (unsigned long long)cvt_pk_bf16(v[0], v[1]) | ((unsigned long long)cvt_pk_bf16(v[2], v[3]) << 32); }
          s = wave_sum(s); if (lane == 0) ctl[r] = s; if (lane >= 1 && lane <= 5) ctl[lane * NTOK + r] = 0.f; } }
    { const float* mem = a.in[I_MEM]; bf16_t* MB = (bf16_t*)(ws + WS_MEMB);
      for (int r = gw; r < 1024; r += NGW) { const f32x4* xr = (const f32x4*)(mem + (size_t)r * 1024) + lane; unsigned long long* xb = (unsigned long long*)(MB + (size_t)r * 1024) + lane; float s = 0.f;
#pragma unroll
          for (int j = 0; j < 4; ++j) { const f32x4 v = xr[64 * j]; s += (v[0] * v[0] + v[1] * v[1]) + (v[2] * v[2] + v[3] * v[3]); xb[64 * j] = (unsigned long long)cvt_pk_bf16(v[0], v[1]) | ((unsigned long long)cvt_pk_bf16(v[2], v[3]) << 32); }
          s = wave_sum(s); if (lane == 0) ctl[SSQ_MEM_OFF + r] = s; } }
    for (int it = gw; it < 16; it += NGW) { const int lk = it >> 2, j = (it & 3) * 64 + lane; const float* W1 = a.in[I_CW1] + (size_t)lk * 2048 * 256; const float* pos = a.in[I_CPOS] + (size_t)lk * 2048; float s = a.in[I_CB1][lk * 256 + j];
        for (int k = 0; k < 2048; ++k) s += pos[k] * W1[(size_t)k * 256 + j];
        ((float*)(ws + WS_W + (lk >> 1) * W_LAYER + W_B1P))[(lk & 1) * 256 + j] = s; }
    for (int it = gw; it < 2 * 8 * 128; it += NGW) { const int t = it & 127; const float* wr = a.in[I_SGW] + (size_t)it * 128; unsigned* dst = (unsigned*)(ws + WS_W + (it >> 10) * W_LAYER + W_SG) + (size_t)(it & 1023) * 64 + lane;
        float v[2];
#pragma unroll
        for (int e = 0; e < 2; ++e) { const int p = lane * 2 + e, ks = p >> 4, hh = (p >> 3) & 1, j = p & 7, sidx = 16 * ks + 8 * (j >> 2) + 4 * hh + (j & 3); v[e] = sidx <= t ? wr[sidx] : 0.f; }
        *dst = cvt_pk_bf16(v[0], v[1]); }
}

typedef float f32x16 __attribute__((ext_vector_type(16)));
typedef short s16x4 __attribute__((ext_vector_type(4)));
typedef short v4i16_t __attribute__((ext_vector_type(4)));
using pg8::bf16x8;
__device__ __forceinline__ int crow(int r, int hi) { return (r & 3) + 8 * (r >> 2) + 4 * hi; }
__device__ __forceinline__ s16x4 vtr(const LAS char* p) { return __builtin_bit_cast(s16x4, __builtin_amdgcn_ds_read_tr16_b64_v4i16((LAS v4i16_t*)p)); }
#define MFMA32(a, b, c) __builtin_amdgcn_mfma_f32_32x32x16_bf16(a, b, c, 0, 0, 0)
#define VFRAG(lo, hi) (bf16x8){lo[0], lo[1], lo[2], lo[3], hi[0], hi[1], hi[2], hi[3]}
__device__ __forceinline__ void lds_fadd(LAS float* p, float v) { (void)__hip_atomic_fetch_add(p, v, __ATOMIC_RELAXED, __HIP_MEMORY_SCOPE_WORKGROUP); }
__device__ __forceinline__ unsigned short f2bf(float f) { return (unsigned short)(cvt_pk_bf16(f, 0.f) & 0xffffu); }

__device__ __forceinline__ void tokprep_token(bf16_t* Q, bf16_t* KV, const float* qg, const float* kg, int tok, int lane) {
    { u32x4* p = (u32x4*)(Q + (size_t)tok * 512) + lane; const u32x4 w = *p; float v[8];
#pragma unroll
      for (int i = 0; i < 4; ++i) { v[2 * i] = __uint_as_float(w[i] << 16); v[2 * i + 1] = __uint_as_float(w[i] & 0xffff0000u); }
      float ss = 0.f;
#pragma unroll
      for (int i = 0; i < 8; ++i) ss += v[i] * v[i];
      ss += __shfl_xor(ss, 1); ss += __shfl_xor(ss, 2); ss += __shfl_xor(ss, 4);
      const float rs = rsqrtf(ss * (1.f / 64.f) + 1e-6f) * (0.125f * 1.4426950408889634f); const float* g = qg + (lane & 7) * 8;
      u32x4 o;
#pragma unroll
      for (int i = 0; i < 4; ++i) o[i] = cvt_pk_bf16(v[2 * i] * rs * g[2 * i], v[2 * i + 1] * rs * g[2 * i + 1]);
      *p = o; }
    if (lane < 32) { const int br = 1 + (lane >> 4); u32x4* p = (u32x4*)(KV + (size_t)tok * 768 + br * 256) + (lane & 15); const u32x4 w = *p; float v[8];
#pragma unroll
      for (int i = 0; i < 4; ++i) { v[2 * i] = __uint_as_float(w[i] << 16); v[2 * i + 1] = __uint_as_float(w[i] & 0xffff0000u); }
      float ss = 0.f;
#pragma unroll
      for (int i = 0; i < 8; ++i) ss += v[i] * v[i];
      ss += __shfl_xor(ss, 1); ss += __shfl_xor(ss, 2); ss += __shfl_xor(ss, 4);
      const float rs = rsqrtf(ss * (1.f / 64.f) + 1e-6f); const float* g = kg + br * 64 + (lane & 7) * 8;
      u32x4 o;
#pragma unroll
      for (int i = 0; i < 4; ++i) o[i] = cvt_pk_bf16(v[2 * i] * rs * g[2 * i], v[2 * i + 1] * rs * g[2 * i + 1]);
      *p = o; }
}
__device__ __forceinline__ void cmp2_row(const bf16_t* HID, const bf16_t* w2t, const float* b2, const float* kg0, bf16_t* KC, bf16_t* VC, int row, int lane) {
#pragma unroll 1
    for (int kv = 0; kv < 2; ++kv) { const u32x4* h = (const u32x4*)(HID + (size_t)kv * 2048 * 256 + (size_t)row * 256); const u32x4* w = (const u32x4*)(w2t + (size_t)kv * 64 * 256 + (size_t)lane * 256); float s = b2[kv * 64 + lane];
#pragma unroll 4
        for (int k = 0; k < 32; ++k) { const u32x4 a = h[k], b = w[k];
#pragma unroll
            for (int i = 0; i < 4; ++i) s += __uint_as_float(a[i] << 16) * __uint_as_float(b[i] << 16) + __uint_as_float(a[i] & 0xffff0000u) * __uint_as_float(b[i] & 0xffff0000u); }
        if (kv == 0) { const float ss = wave_sum(s * s); s = s * rsqrtf(ss * (1.f / 64.f) + 1e-6f) * kg0[lane]; }
        if ((row & 255) == 255) s = 0.f;
        (kv ? VC : KC)[(size_t)row * 64 + lane] = f2bf(s); }
}
__device__ __forceinline__ void memk_norm_item(bf16_t* KVM, const float* kg, int r, int lane) {
    unsigned* p = (unsigned*)(KVM + (size_t)(r >> 2) * 1024 + (r & 3) * 128) + lane; const unsigned w = *p; const float v0 = __uint_as_float(w << 16), v1 = __uint_as_float(w & 0xffff0000u);
    const float ss = wave_sum(v0 * v0 + v1 * v1); const float rs = rsqrtf(ss * (1.f / 128.f) + 1e-6f); *p = cvt_pk_bf16(v0 * rs * kg[2 * lane], v1 * rs * kg[2 * lane + 1]);
}

constexpr int SG_STAT = 0, SG_SSQ = 1024, SG_VN = 2048;
__device__ __forceinline__ void sgu_unit(LAS unsigned char* lds, int unit, const bf16_t* U, const bf16_t* Vb, const bf16_t* Wsg, const float* lng, const float* lnb, const float* sgb, bf16_t* MIX) {
    int tid_ = threadIdx.x; asm volatile("" : "+v"(tid_)); const int tid = tid_, lane = tid & 63, g = __builtin_amdgcn_readfirstlane(tid >> 6), r32 = lane & 31, hi = lane >> 5;
    const int tok0 = unit * 128;
    LAS float* STAT = (LAS float*)(lds + SG_STAT); LAS float* SSQA = (LAS float*)(lds + SG_SSQ);
    { const int tl = tid >> 2, part = tid & 3; const u32x4* p = (const u32x4*)(Vb + (size_t)(tok0 + tl) * 512 + part * 128); float s = 0.f, s2 = 0.f;
#pragma unroll 4
      for (int i = 0; i < 16; ++i) { const u32x4 w = p[i];
#pragma unroll
          for (int e = 0; e < 4; ++e) { const float a = __uint_as_float(w[e] << 16), b = __uint_as_float(w[e] & 0xffff0000u); s += a + b; s2 += a * a + b * b; } }
      s += __shfl_xor(s, 1); s += __shfl_xor(s, 2); s2 += __shfl_xor(s2, 1); s2 += __shfl_xor(s2, 2);
      if (part == 0) { const float mu = s * (1.f / 512.f); const float var = fmaxf(s2 * (1.f / 512.f) - mu * mu, 0.f); STAT[tl * 2] = mu; STAT[tl * 2 + 1] = rsqrtf(var + 1e-6f); }
      if (tid < 128) SSQA[tid] = 0.f; }
    __syncthreads();
    LAS unsigned char* VN = lds + SG_VN + g * 16384;
    { const int piece = lane & 7; float gg[8], bb[8];
#pragma unroll
      for (int i = 0; i < 8; ++i) { gg[i] = lng[g * 64 + piece * 8 + i]; bb[i] = lnb[g * 64 + piece * 8 + i]; }
#pragma unroll 4
      for (int it = 0; it < 16; ++it) { const int row = it * 8 + (lane >> 3); const u32x4 w = *(const u32x4*)(Vb + (size_t)(tok0 + row) * 512 + g * 64 + piece * 8); const float mu = STAT[row * 2], rs = STAT[row * 2 + 1]; u32x4 o;
#pragma unroll
          for (int e = 0; e < 4; ++e) { const float a = (__uint_as_float(w[e] << 16) - mu) * rs * gg[2 * e] + bb[2 * e], b = (__uint_as_float(w[e] & 0xffff0000u) - mu) * rs * gg[2 * e + 1] + bb[2 * e + 1]; o[e] = cvt_pk_bf16(a, b); }
          *(LAS u32x4*)(VN + (piece >> 2) * 8192 + row * 64 + (piece & 3) * 16) = o; } }
    asm volatile("s_waitcnt lgkmcnt(0)" ::: "memory");
    f32x16 acc[2][4];
#pragma unroll
    for (int dh = 0; dh < 2; ++dh)
#pragma unroll
        for (int mt = 0; mt < 4; ++mt)
#pragma unroll
            for (int r = 0; r < 16; ++r) acc[dh][mt][r] = 0.f;
    const LAS char* vb = (const LAS char*)VN + ((lane >> 4) & 1) * 32 + (lane & 3) * 8 + (4 * hi + ((lane & 15) >> 2)) * 64;
    const bf16_t* wrow = Wsg + ((size_t)g * 128 + r32) * 128 + 8 * hi;
#pragma unroll
    for (int ks = 0; ks < 8; ++ks) { bf16x8 vf[2];
#pragma unroll
        for (int dh = 0; dh < 2; ++dh) { const s16x4 lo = vtr(vb + dh * 8192 + ks * 1024), hh = vtr(vb + dh * 8192 + ks * 1024 + 512); vf[dh] = VFRAG(lo, hh); }
#pragma unroll
        for (int mt = 0; mt < 4; ++mt) { if (ks <= 2 * mt + 1) { const bf16x8 wf = *(const bf16x8*)(wrow + (size_t)mt * 32 * 128 + ks * 16);
                acc[0][mt] = MFMA32(vf[0], wf, acc[0][mt]); acc[1][mt] = MFMA32(vf[1], wf, acc[1][mt]); } } }
#pragma unroll
    for (int mt = 0; mt < 4; ++mt) { const int t = mt * 32 + r32; const float bias = sgb[g * 128 + t]; const bf16_t* up = U + (size_t)(tok0 + t) * 512 + g * 64 + 4 * hi; float ss = 0.f;
#pragma unroll
        for (int dh = 0; dh < 2; ++dh)
#pragma unroll
            for (int a4 = 0; a4 < 4; ++a4) { const u32x2 w = *(const u32x2*)(up + dh * 32 + a4 * 8);
                const float u0 = __uint_as_float(w.x << 16), u1 = __uint_as_float(w.x & 0xffff0000u), u2 = __uint_as_float(w.y << 16), u3 = __uint_as_float(w.y & 0xffff0000u);
                float x0 = u0 * (acc[dh][mt][4 * a4] + bias), x1 = u1 * (acc[dh][mt][4 * a4 + 1] + bias), x2 = u2 * (acc[dh][mt][4 * a4 + 2] + bias), x3 = u3 * (acc[dh][mt][4 * a4 + 3] + bias);
                acc[dh][mt][4 * a4] = x0; acc[dh][mt][4 * a4 + 1] = x1; acc[dh][mt][4 * a4 + 2] = x2; acc[dh][mt][4 * a4 + 3] = x3; ss += (x0 * x0 + x1 * x1) + (x2 * x2 + x3 * x3); }
        ss += __shfl_xor(ss, 32); if (hi == 0) lds_fadd(SSQA + t, ss); }
    __syncthreads();
#pragma unroll
    for (int mt = 0; mt < 4; ++mt) { const int t = mt * 32 + r32; const float rs = rsqrtf(SSQA[t] * (1.f / 512.f) + 1e-6f); bf16_t* op = MIX + (size_t)(tok0 + t) * 1024 + g * 64 + 4 * hi;
#pragma unroll
        for (int dh = 0; dh < 2; ++dh)
#pragma unroll
            for (int a4 = 0; a4 < 4; ++a4) { u32x2 w; w.x = cvt_pk_bf16(acc[dh][mt][4 * a4] * rs, acc[dh][mt][4 * a4 + 1] * rs); w.y = cvt_pk_bf16(acc[dh][mt][4 * a4 + 2] * rs, acc[dh][mt][4 * a4 + 3] * rs); *(u32x2*)(op + dh * 32 + a4 * 8) = w; } }
    __syncthreads();
}

constexpr int A_KB = 0, A_VB = 32768, A_IMPH = 65536, A_LINV = 132096, A_MASK = 133120, A_SSQ = 133632;
__device__ __forceinline__ void attn_cmp(LAS unsigned char* lds, const bf16_t* Kb, const bf16_t* Vb, int ntc, const bf16x8 (&qr)[4], f32x16 (&oT)[2], float& lsum,
                                         int kmin, int kmax, int kvh, int wave, int lane, int r32, int hi) {
    const int pitch = 64, hstride = 256 * 64;
    u32x4 sk0, sk1, sv0, sv1;
    const bf16_t* kthr = Kb + (size_t)lane * pitch + wave * 8; const bf16_t* vthr = Vb + (size_t)(16 * (wave & 3) + (lane >> 2)) * pitch + (wave >> 2) * 32 + (lane & 3) * 8;
    const int sdst = wave * 1024 + lane * 16;
#define A_LD(tile) do { const size_t to_ = (size_t)(tile) * 64 * pitch; sk0 = *(const u32x4*)(kthr + to_); sk1 = *(const u32x4*)(kthr + to_ + hstride); sv0 = *(const u32x4*)(vthr + to_); sv1 = *(const u32x4*)(vthr + to_ + hstride); } while (0)
#define A_ST(so) do { *(LAS u32x4*)(lds + A_KB + (so) + sdst) = sk0; *(LAS u32x4*)(lds + A_KB + (so) + 8192 + sdst) = sk1; *(LAS u32x4*)(lds + A_VB + (so) + sdst) = sv0; *(LAS u32x4*)(lds + A_VB + (so) + 8192 + sdst) = sv1; } while (0)
    const LAS char* kbase = (const LAS char*)(lds + A_KB) + kvh * 8192 + hi * 1024 + r32 * 16;
    const LAS char* vbase = (const LAS char*)(lds + A_VB) + kvh * 8192 + ((lane >> 4) & 1) * 32 + (lane & 3) * 8 + (4 * hi + ((lane & 15) >> 2)) * 64;
    LAS float* IMPH = (LAS float*)(lds + A_IMPH) + (wave * 32 + r32) * 65;
    float carry = 0.f;
    A_LD(0); A_ST(0); __syncthreads();
#pragma unroll 1
    for (int tile = 0; tile < ntc; ++tile) {
        const int so = (tile & 1) * 16384;
        if (tile + 1 < ntc) A_LD(tile + 1);
        bf16x8 kf[8];
#pragma unroll
        for (int d0 = 0; d0 < 4; ++d0) { kf[2 * d0] = *(const LAS bf16x8*)(kbase + so + d0 * 2048); kf[2 * d0 + 1] = *(const LAS bf16x8*)(kbase + so + d0 * 2048 + 512); }
        f32x16 p0, p1;
#pragma unroll
        for (int r = 0; r < 16; ++r) { p0[r] = 0.f; p1[r] = 0.f; }
#pragma unroll
        for (int d0 = 0; d0 < 4; ++d0) { p0 = MFMA32(kf[2 * d0], qr[d0], p0); p1 = MFMA32(kf[2 * d0 + 1], qr[d0], p1); }
        const int a = kmin - 64 * tile, bb = kmax - 64 * tile;
#pragma unroll
        for (int r = 0; r < 16; ++r) { p0[r] = __builtin_amdgcn_exp2f(p0[r]); p1[r] = __builtin_amdgcn_exp2f(p1[r]); }
        if (!__all(a <= 0 && bb >= 63)) { const unsigned span = (unsigned)(bb - a);
#pragma unroll
            for (int r = 0; r < 16; ++r) { const int rel = crow(r, hi); p0[r] = ((unsigned)(rel - a) <= span) ? p0[r] : 0.f; p1[r] = ((unsigned)(rel + 32 - a) <= span) ? p1[r] : 0.f; } }
        { float s = 0.f;
#pragma unroll
          for (int r = 0; r < 16; ++r) s += p0[r] + p1[r];
          lsum += s; }
        { float own[2][4], rcv[2][4];
#pragma unroll
          for (int a4 = 0; a4 < 4; ++a4) { const float h0 = 0.5f * p0[4 * a4 + 3], h1 = 0.5f * p1[4 * a4 + 3];
              own[0][a4] = (p0[4 * a4] + p0[4 * a4 + 1]) + (p0[4 * a4 + 2] + h0); own[1][a4] = (p1[4 * a4] + p1[4 * a4 + 1]) + (p1[4 * a4 + 2] + h1);
              rcv[0][a4] = __shfl_xor(h0, 32); rcv[1][a4] = __shfl_xor(h1, 32); }
#pragma unroll
          for (int h2 = 0; h2 < 2; ++h2)
#pragma unroll
              for (int a4 = 0; a4 < 4; ++a4) { const float fromprev = a4 > 0 ? rcv[h2][a4 - 1] : (h2 ? rcv[0][3] : carry);
                  IMPH[16 * tile + 8 * h2 + 2 * a4 + hi] = own[h2][a4] + (hi ? rcv[h2][a4] : fromprev); }
          carry = rcv[1][3]; }
        bf16x8 pa[4];
        { u32x4 w0, w1, w2, w3;
#pragma unroll
          for (int i = 0; i < 4; ++i) { w0[i] = cvt_pk_bf16(p0[2 * i], p0[2 * i + 1]); w1[i] = cvt_pk_bf16(p0[8 + 2 * i], p0[8 + 2 * i + 1]); w2[i] = cvt_pk_bf16(p1[2 * i], p1[2 * i + 1]); w3[i] = cvt_pk_bf16(p1[8 + 2 * i], p1[8 + 2 * i + 1]); }
          pa[0] = __builtin_bit_cast(bf16x8, w0); pa[1] = __builtin_bit_cast(bf16x8, w1); pa[2] = __builtin_bit_cast(bf16x8, w2); pa[3] = __builtin_bit_cast(bf16x8, w3); }
#pragma unroll
        for (int dh = 0; dh < 2; ++dh)
#pragma unroll
            for (int ks = 0; ks < 4; ++ks) { const s16x4 lo = vtr(vbase + so + dh * 4096 + ks * 1024), hh = vtr(vbase + so + dh * 4096 + ks * 1024 + 512); oT[dh] = MFMA32(VFRAG(lo, hh), pa[ks], oT[dh]); }
        if (tile + 1 < ntc) A_ST(so ^ 16384);
        __syncthreads();
    }
#undef A_LD
#undef A_ST
}

constexpr int A2_K = 0, A2_V = 49152, A2_SL = 16384;
#define SBAR() __builtin_amdgcn_sched_barrier(0)
#define PIN(x) asm volatile("" : "+v"(x))
#define WAIT_BAR(N) asm volatile("s_waitcnt vmcnt(" #N ") lgkmcnt(0)\n\ts_barrier" ::: "memory")
__device__ __forceinline__ void glds16(const void* g, unsigned lds_base) {
    unsigned sv; asm volatile("s_mov_b32 %0, m0\n\ts_mov_b32 m0, %2\n\ts_nop 0\n\tglobal_load_lds_dwordx4 %1, off\n\ts_mov_b32 m0, %0" : "=&s"(sv) : "v"(g), "s"(lds_base) : "memory"); }
__device__ __forceinline__ void range_mask(f32x16& c0, f32x16& c1, int a, int bb, int hi) {
    const unsigned span = (unsigned)(bb - a);
#pragma unroll
    for (int r = 0; r < 16; ++r) { const int rel = crow(r, hi); c0[r] = ((unsigned)(rel - a) <= span) ? c0[r] : -INFINITY; c1[r] = ((unsigned)(rel + 32 - a) <= span) ? c1[r] : -INFINITY; }
}
template <bool WIN>
__device__ __forceinline__ void attn_stream(LAS unsigned char* lds, const bf16_t* Kb, const bf16_t* Vb, int tlo, int NT, const bf16x8 (&qr)[4], f32x16 (&oT)[2], float& l_out,
                                            unsigned mlo, unsigned mhi, int tq, int kvh, int wave, int lane, int r32, int hi) {
    const unsigned lds0 = (unsigned)(uintptr_t)lds;
    const bf16_t* ksrc = Kb + (size_t)lane * 768 + wave * 8;
    const bf16_t* vsrc = Vb + (size_t)(16 * (wave & 3) + (lane >> 2)) * 768 + (wave >> 2) * 32 + (lane & 3) * 8;
    const unsigned kdst = lds0 + A2_K + wave * 1024, vdst = lds0 + A2_V + wave * 1024;
#define RFL(x) ((unsigned)__builtin_amdgcn_readfirstlane((int)(x)))
#define TCL(i) ((size_t)(tlo + ((i) < NT ? (i) : NT - 1)) * (64 * 768))
#define DMA_K(i, slot) do { const bf16_t* s_ = ksrc + TCL(i); glds16(s_, RFL(kdst + (slot))); glds16(s_ + 64, RFL(kdst + (slot) + 8192)); } while (0)
#define DMA_V(i, slot) do { const bf16_t* s_ = vsrc + TCL(i); glds16(s_, RFL(vdst + (slot))); glds16(s_ + 64, RFL(vdst + (slot) + 8192)); } while (0)
#define TMASK(idx_, a_, bb_, selm_) do { const int tt_ = tlo + (idx_); if (WIN) { a_ = tq - 511 - 64 * tt_; bb_ = tq - 64 * tt_; selm_ = ~0u; } \
        else { const unsigned s_ = tt_ < 32 ? (mlo >> tt_) & 1u : (mhi >> (tt_ - 32)) & 1u; a_ = -64 * tt_; bb_ = tq - 64 * tt_; selm_ = 0u - s_; } } while (0)
#define NEEDM(a_, bb_, selm_) (!__all((selm_) == 0u || ((a_) <= 0 && (bb_) >= 63)))
    const LAS char* kp0 = (const LAS char*)(lds + A2_K) + kvh * 8192 + hi * 1024 + r32 * 16;
    const LAS char* vp0 = (const LAS char*)(lds + A2_V) + kvh * 8192 + ((lane >> 4) & 1) * 32 + (lane & 3) * 8 + (4 * hi + ((lane & 15) >> 2)) * 64;
    asm volatile("s_waitcnt vmcnt(0)" ::: "memory");
    DMA_K(0, 0); DMA_V(0, 0); DMA_K(1, A2_SL); DMA_K(2, 2 * A2_SL);
    float l_reg = 0.f; f32x16 pA0, pA1, pB0, pB1; bf16x8 kf[8]; s16x4 vlo[8], vhi[8]; u32x4 pw0, pw1, pw2, pw3; unsigned selm_prev;
    const f32x16 zero16 = {0.f, 0.f, 0.f, 0.f, 0.f, 0.f, 0.f, 0.f, 0.f, 0.f, 0.f, 0.f, 0.f, 0.f, 0.f, 0.f};
    int sl_prev = 0, sl_cur = 0, sl_next = A2_SL;
#define ROT() do { sl_prev = sl_cur; sl_cur = sl_next; sl_next = (sl_next == 2 * A2_SL) ? 0 : sl_next + A2_SL; } while (0)
#define KLD(kp, d0) do { kf[2 * (d0)] = *(const LAS bf16x8*)((kp) + (d0) * 2048); kf[2 * (d0) + 1] = *(const LAS bf16x8*)((kp) + (d0) * 2048 + 512); } while (0)
    WAIT_BAR(6);
    KLD(kp0, 0); KLD(kp0, 1); KLD(kp0, 2); KLD(kp0, 3);
    pA0 = MFMA32(kf[0], qr[0], zero16); pA1 = MFMA32(kf[1], qr[0], zero16); pA0 = MFMA32(kf[2], qr[1], pA0); pA1 = MFMA32(kf[3], qr[1], pA1);
    pA0 = MFMA32(kf[4], qr[2], pA0); pA1 = MFMA32(kf[5], qr[2], pA1); pA0 = MFMA32(kf[6], qr[3], pA0); pA1 = MFMA32(kf[7], qr[3], pA1);
    { int a_, bb_; TMASK(0, a_, bb_, selm_prev); if (NEEDM(a_, bb_, selm_prev)) range_mask(pA0, pA1, a_, bb_, hi); }
#pragma unroll
    for (int r = 0; r < 16; ++r) { pA0[r] = __builtin_amdgcn_exp2f(pA0[r]); pA1[r] = __builtin_amdgcn_exp2f(pA1[r]); }
    WAIT_BAR(0);
    DMA_K(3, 0); DMA_V(1, A2_SL); ROT();
    KLD(kp0 + sl_cur, 0); KLD(kp0 + sl_cur, 1); KLD(kp0 + sl_cur, 2); KLD(kp0 + sl_cur, 3);
    WAIT_BAR(4);
#define PKW(P, i) cvt_pk_bf16(P[i], P[(i) + 1])
#define PAF(k) __builtin_bit_cast(bf16x8, pw##k)
#define VFR(i) VFRAG(vlo[i], vhi[i])
#define VRD(i) do { vlo[i] = vtr(vp_ + (((i) >> 2) * 4096 + ((i) & 3) * 1024)); vhi[i] = vtr(vp_ + (((i) >> 2) * 4096 + ((i) & 3) * 1024 + 512)); } while (0)
#define KRD(d0) do { KLD(kp0 + sl_next, d0); SBAR(); } while (0)
#define EX(v) __builtin_amdgcn_exp2f(v)
#define GAPA(MF, a0, a1, a2, a3, W0, W1, PW) do { MF; sacc += a0; sacc += a1; sacc += a2; sacc += a3; W0; W1; PIN(PW); PIN(sacc); SBAR(); } while (0)
#define GAPB(MF, X, i) do { MF; X[i] = EX(X[i]); X[(i) + 1] = EX(X[(i) + 1]); X[(i) + 2] = EX(X[(i) + 2]); X[(i) + 3] = EX(X[(i) + 3]); PIN(X); SBAR(); } while (0)
#define SELPW() do { if (!__all(selm_prev == ~0u)) { const u32x4 m_ = {selm_prev, selm_prev, selm_prev, selm_prev}; pw0 = pw0 & m_; pw1 = pw1 & m_; pw2 = pw2 & m_; pw3 = pw3 & m_; } } while (0)
#define STEP(C0, C1, P0, P1, idx) do { SBAR(); \
    const LAS char* vp_ = vp0 + sl_prev; \
    VRD(0); SBAR(); float sacc = P0[0] + P0[1]; \
                    GAPA(C0 = MFMA32(kf[0], qr[0], zero16), P0[2], P0[3], P0[4], P0[5],     pw0[0] = PKW(P0, 0),  pw0[1] = PKW(P0, 2),  pw0); \
    VRD(4); SBAR(); GAPA(C1 = MFMA32(kf[1], qr[0], zero16), P0[6], P0[7], P0[8], P0[9],     pw0[2] = PKW(P0, 4),  pw0[3] = PKW(P0, 6),  pw0); \
    VRD(1); SBAR(); GAPA(C0 = MFMA32(kf[2], qr[1], C0),     P0[10], P0[11], P0[12], P0[13], pw1[0] = PKW(P0, 8),  pw1[1] = PKW(P0, 10), pw1); \
    VRD(5); SBAR(); GAPA(C1 = MFMA32(kf[3], qr[1], C1),     P0[14], P0[15], P1[0], P1[1],   pw1[2] = PKW(P0, 12), pw1[3] = PKW(P0, 14), pw1); \
    VRD(2); SBAR(); GAPA(C0 = MFMA32(kf[4], qr[2], C0),     P1[2], P1[3], P1[4], P1[5],     pw2[0] = PKW(P1, 0),  pw2[1] = PKW(P1, 2),  pw2); \
    VRD(6); SBAR(); GAPA(C1 = MFMA32(kf[5], qr[2], C1),     P1[6], P1[7], P1[8], P1[9],     pw2[2] = PKW(P1, 4),  pw2[3] = PKW(P1, 6),  pw2); \
    VRD(3); SBAR(); GAPA(C0 = MFMA32(kf[6], qr[3], C0),     P1[10], P1[11], P1[12], P1[13], pw3[0] = PKW(P1, 8),  pw3[1] = PKW(P1, 10), pw3); \
    VRD(7); SBAR(); GAPA(C1 = MFMA32(kf[7], qr[3], C1),     P1[14], P1[15], 0.f, 0.f,       pw3[2] = PKW(P1, 12), pw3[3] = PKW(P1, 14), pw3); \
    l_reg += __uint_as_float(__float_as_uint(sacc) & selm_prev); SELPW(); \
    DMA_K((idx) + 3, sl_cur); DMA_V((idx) + 1, sl_next); \
    { int a_, bb_; unsigned selm_; TMASK(idx, a_, bb_, selm_); if (NEEDM(a_, bb_, selm_)) range_mask(C0, C1, a_, bb_, hi); selm_prev = selm_; } \
    SBAR(); \
    GAPB(oT[0] = MFMA32(VFR(0), PAF(0), oT[0]), C0, 0);            GAPB(oT[1] = MFMA32(VFR(4), PAF(0), oT[1]), C0, 4); \
    KRD(0); GAPB(oT[0] = MFMA32(VFR(1), PAF(1), oT[0]), C0, 8);    KRD(1); GAPB(oT[1] = MFMA32(VFR(5), PAF(1), oT[1]), C0, 12); \
    KRD(2); GAPB(oT[0] = MFMA32(VFR(2), PAF(2), oT[0]), C1, 0);    KRD(3); GAPB(oT[1] = MFMA32(VFR(6), PAF(2), oT[1]), C1, 4); \
    GAPB(oT[0] = MFMA32(VFR(3), PAF(3), oT[0]), C1, 8);            GAPB(oT[1] = MFMA32(VFR(7), PAF(3), oT[1]), C1, 12); \
    } while (0)
    int idx = 1;
#pragma unroll 1
    for (; idx + 1 < NT; idx += 2) {
        STEP(pB0, pB1, pA0, pA1, idx);     WAIT_BAR(4); ROT();
        STEP(pA0, pA1, pB0, pB1, idx + 1); WAIT_BAR(4); ROT();
    }
    if (idx < NT) { STEP(pB0, pB1, pA0, pA1, idx); WAIT_BAR(4); ROT(); pA0 = pB0; pA1 = pB1; }
    { float sacc = 0.f;
#pragma unroll
      for (int r = 0; r < 16; ++r) sacc += pA0[r] + pA1[r];
      l_reg += __uint_as_float(__float_as_uint(sacc) & selm_prev);
      pw0 = (u32x4){PKW(pA0, 0), PKW(pA0, 2), PKW(pA0, 4), PKW(pA0, 6)}; pw1 = (u32x4){PKW(pA0, 8), PKW(pA0, 10), PKW(pA0, 12), PKW(pA0, 14)};
      pw2 = (u32x4){PKW(pA1, 0), PKW(pA1, 2), PKW(pA1, 4), PKW(pA1, 6)}; pw3 = (u32x4){PKW(pA1, 8), PKW(pA1, 10), PKW(pA1, 12), PKW(pA1, 14)};
      SELPW();
      const LAS char* vp_ = vp0 + ((NT - 1) % 3) * A2_SL;
#pragma unroll
      for (int i = 0; i < 8; ++i) VRD(i);
      oT[0] = MFMA32(VFR(0), PAF(0), oT[0]); oT[1] = MFMA32(VFR(4), PAF(0), oT[1]); oT[0] = MFMA32(VFR(1), PAF(1), oT[0]); oT[1] = MFMA32(VFR(5), PAF(1), oT[1]);
      oT[0] = MFMA32(VFR(2), PAF(2), oT[0]); oT[1] = MFMA32(VFR(6), PAF(2), oT[1]); oT[0] = MFMA32(VFR(3), PAF(3), oT[0]); oT[1] = MFMA32(VFR(7), PAF(3), oT[1]); }
    WAIT_BAR(0);
    l_out = l_reg;
#undef RFL
#undef TCL
#undef DMA_K
#undef DMA_V
#undef TMASK
#undef NEEDM
#undef ROT
#undef KLD
#undef PKW
#undef PAF
#undef VFR
#undef VRD
#undef KRD
#undef EX
#undef GAPA
#undef GAPB
#undef SELPW
#undef STEP
}

template <int PARTS>
__device__ __forceinline__ void attn_unit(LAS unsigned char* lds, int b, int qt, const bf16_t* Q, const bf16_t* KV, const bf16_t* KC, const bf16_t* VC, const float* GL, bf16_t* MIX) {
    int tid_ = threadIdx.x; asm volatile("" : "+v"(tid_)); const int tid = tid_, lane = tid & 63, wave = __builtin_amdgcn_readfirstlane(tid >> 6), r32 = lane & 31, hi = lane >> 5, kvh = wave >> 2;
    const int t0 = qt * 32, tq = t0 + r32; const size_t tok = (size_t)b * T + tq;
    bf16x8 qr[4];
#pragma unroll
    for (int d0 = 0; d0 < 4; ++d0) qr[d0] = *(const bf16x8*)(Q + tok * 512 + wave * 64 + d0 * 16 + hi * 8);
    LAS float* IMPHA = (LAS float*)(lds + A_IMPH); LAS float* LINV = (LAS float*)(lds + A_LINV); LAS unsigned* MASKL = (LAS unsigned*)(lds + A_MASK); LAS float* SSQL = (LAS float*)(lds + A_SSQ);
    if (tid < 32) SSQL[tid] = 0.f;
    const float* glp = GL + tok * 24 + wave * 3;
    const float g0 = 1.f / (1.f + __expf(-glp[0])), g1 = 1.f / (1.f + __expf(-glp[1])), g2 = 1.f / (1.f + __expf(-glp[2]));
    f32x16 tot[2], oT[2];
    const int nvalid = tq >= 31 ? (tq - 31) / 16 + 1 : 0; const int ntc = (2 * qt + 1 + 63) >> 6;
    const int ckmin = nvalid > 0 ? 0 : (1 << 20), ckmax = nvalid > 0 ? nvalid - 1 : (1 << 20);
    const bf16_t* KCb = KC + (size_t)(b * 2) * 256 * 64; const bf16_t* VCb = VC + (size_t)(b * 2) * 256 * 64;
    float lc = 0.f;
#pragma unroll
    for (int r = 0; r < 16; ++r) { oT[0][r] = 0.f; oT[1][r] = 0.f; }
    if constexpr (PARTS & 1) attn_cmp(lds, KCb, VCb, ntc, qr, oT, lc, ckmin, ckmax, kvh, wave, lane, r32, hi);
    lc += __shfl_xor(lc, 32); const float inv_lc = lc > 0.f ? 1.f / lc : 0.f;
    if (hi == 0) LINV[wave * 32 + r32] = inv_lc;
    { const float c = g0 * inv_lc;
#pragma unroll
      for (int r = 0; r < 16; ++r) { tot[0][r] = oT[0][r] * c; tot[1][r] = oT[1][r] * c; oT[0][r] = 0.f; oT[1][r] = 0.f; } }
    __syncthreads();
    if constexpr (PARTS & 2) {
#pragma unroll 1
      for (int i = 0; i < 8; ++i) { const int pair = wave * 8 + i, kvp = pair >> 5, qq = pair & 31, j = lane; const int tb = (t0 + qq) >> 6; float v = 0.f;
#pragma unroll
          for (int g = 0; g < 4; ++g) v += IMPHA[((kvp * 4 + g) * 32 + qq) * 65 + j] * LINV[(kvp * 4 + g) * 32 + qq];
          const bool forced = (j == 0) || (j == tb) || (j == tb - 1); const float val = forced ? 1e4f : (j <= tb ? v : -1e4f);
          unsigned key = __float_as_uint(val); key ^= (key & 0x80000000u) ? 0xffffffffu : 0x80000000u; key = (key & ~63u) | (unsigned)(63 - j);
          unsigned prefix = 0u;
#pragma unroll
          for (int bit = 31; bit >= 0; --bit) { const unsigned tt = prefix | (1u << bit); const int cnt = __popcll(__ballot(key >= tt)); prefix = cnt >= 16 ? tt : prefix; }
          const unsigned long long m = __ballot(key >= prefix);
          if (lane == 0) { MASKL[pair * 2] = (unsigned)m; MASKL[pair * 2 + 1] = (unsigned)(m >> 32); } } }
    __syncthreads();
    const unsigned mlo = MASKL[(kvh * 32 + r32) * 2], mhi = MASKL[(kvh * 32 + r32) * 2 + 1];
    const int jmax = (t0 + 31) >> 6;
    const bf16_t* KVb = KV + (size_t)b * T * 768;
    unsigned totp[16];
#pragma unroll
    for (int i = 0; i < 8; ++i) { totp[i] = cvt_pk_bf16(tot[0][2 * i], tot[0][2 * i + 1]); totp[8 + i] = cvt_pk_bf16(tot[1][2 * i], tot[1][2 * i + 1]); }
    float ls = 0.f;
    if constexpr (PARTS & 4) attn_stream<false>(lds, KVb + 256, KVb + 384, 0, jmax + 1, qr, oT, ls, mlo, mhi, tq, kvh, wave, lane, r32, hi);
    ls += __shfl_xor(ls, 32);
    { const float c = ls > 0.f ? g1 / ls : 0.f;
#pragma unroll
      for (int i = 0; i < 8; ++i) { totp[i] = cvt_pk_bf16(__uint_as_float(totp[i] << 16) + oT[0][2 * i] * c, __uint_as_float(totp[i] & 0xffff0000u) + oT[0][2 * i + 1] * c);
                                    totp[8 + i] = cvt_pk_bf16(__uint_as_float(totp[8 + i] << 16) + oT[1][2 * i] * c, __uint_as_float(totp[8 + i] & 0xffff0000u) + oT[1][2 * i + 1] * c); }
#pragma unroll
      for (int r = 0; r < 16; ++r) { oT[0][r] = 0.f; oT[1][r] = 0.f; } }
    float lw = 0.f; const int jlo = t0 >= 511 ? (t0 - 511) >> 6 : 0;
    if constexpr (PARTS & 8) attn_stream<true>(lds, KVb + 512, KVb + 640, jlo, jmax - jlo + 1, qr, oT, lw, 0u, 0u, tq, kvh, wave, lane, r32, hi);
    lw += __shfl_xor(lw, 32);
    { const float c = lw > 0.f ? g2 / lw : 0.f;
#pragma unroll
      for (int i = 0; i < 8; ++i) { tot[0][2 * i] = __uint_as_float(totp[i] << 16) + oT[0][2 * i] * c; tot[0][2 * i + 1] = __uint_as_float(totp[i] & 0xffff0000u) + oT[0][2 * i + 1] * c;
                                    tot[1][2 * i] = __uint_as_float(totp[8 + i] << 16) + oT[1][2 * i] * c; tot[1][2 * i + 1] = __uint_as_float(totp[8 + i] & 0xffff0000u) + oT[1][2 * i + 1] * c; } }
    { float ss = 0.f;
#pragma unroll
      for (int r = 0; r < 16; ++r) ss += tot[0][r] * tot[0][r] + tot[1][r] * tot[1][r];
      ss += __shfl_xor(ss, 32); if (hi == 0) lds_fadd(SSQL + r32, ss); }
    __syncthreads();
    { const float rs = rsqrtf(SSQL[r32] * (1.f / 512.f) + 1e-6f); bf16_t* op = MIX + tok * 1024 + 512 + wave * 64 + 4 * hi;
#pragma unroll
      for (int dh = 0; dh < 2; ++dh)
#pragma unroll
          for (int a4 = 0; a4 < 4; ++a4) { u32x2 w; w.x = cvt_pk_bf16(tot[dh][4 * a4] * rs, tot[dh][4 * a4 + 1] * rs); w.y = cvt_pk_bf16(tot[dh][4 * a4 + 2] * rs, tot[dh][4 * a4 + 3] * rs); *(u32x2*)(op + dh * 32 + a4 * 8) = w; } }
    __syncthreads();
}

__device__ __forceinline__ void memattn_unit(LAS unsigned char* lds, int b, int h, int qt, const bf16_t* QM, const bf16_t* KVM, const float* qg, bf16_t* OM) {
    int tid_ = threadIdx.x; asm volatile("" : "+v"(tid_)); const int tid = tid_, lane = tid & 63, wave = __builtin_amdgcn_readfirstlane(tid >> 6), r32 = lane & 31, hi = lane >> 5;
    const size_t tok = (size_t)b * T + qt * 256 + wave * 32 + r32;
    bf16x8 qr[8];
    { float v[64]; float ss = 0.f;
#pragma unroll
      for (int d0 = 0; d0 < 8; ++d0) { const u32x4 w = *(const u32x4*)(QM + tok * 512 + h * 128 + d0 * 16 + hi * 8);
#pragma unroll
          for (int i = 0; i < 4; ++i) { const float a = __uint_as_float(w[i] << 16), c = __uint_as_float(w[i] & 0xffff0000u); v[d0 * 8 + 2 * i] = a; v[d0 * 8 + 2 * i + 1] = c; ss += a * a + c * c; } }
      ss += __shfl_xor(ss, 32); const float rs = rsqrtf(ss * (1.f / 128.f) + 1e-6f) * (0.08838834764831845f * 1.4426950408889634f);
#pragma unroll
      for (int d0 = 0; d0 < 8; ++d0) { u32x4 w; const float* gp = qg + d0 * 16 + hi * 8;
#pragma unroll
          for (int i = 0; i < 4; ++i) w[i] = cvt_pk_bf16(v[d0 * 8 + 2 * i] * rs * gp[2 * i], v[d0 * 8 + 2 * i + 1] * rs * gp[2 * i + 1]);
          qr[d0] = __builtin_bit_cast(bf16x8, w); } }
    const bf16_t* Kg = KVM + (size_t)b * 256 * 1024 + h * 128; const bf16_t* Vg = Kg + 512;
    u32x4 sk[2], sv[2];
#define M_LD(tile) do { _Pragma("unroll") for (int i = 0; i < 2; ++i) { sk[i] = *(const u32x4*)(Kg + (size_t)((tile) * 64 + lane) * 1024 + (wave * 2 + i) * 8); const int p = i * 512 + tid; \
        sv[i] = *(const u32x4*)(Vg + (size_t)((tile) * 64 + ((p & 255) >> 2)) * 1024 + (p >> 8) * 32 + (p & 3) * 8); } } while (0)
#define M_ST(so) do { _Pragma("unroll") for (int i = 0; i < 2; ++i) { *(LAS u32x4*)(lds + (so) + (wave * 2 + i) * 1024 + lane * 16) = sk[i]; *(LAS u32x4*)(lds + 32768 + (so) + (i * 512 + tid) * 16) = sv[i]; } } while (0)
    const LAS char* kbase = (const LAS char*)lds + hi * 1024 + r32 * 16;
    const LAS char* vbase = (const LAS char*)lds + 32768 + ((lane >> 4) & 1) * 32 + (lane & 3) * 8 + (4 * hi + ((lane & 15) >> 2)) * 64;
    f32x16 oT[4]; float lsum = 0.f;
#pragma unroll
    for (int dq = 0; dq < 4; ++dq)
#pragma unroll
        for (int r = 0; r < 16; ++r) oT[dq][r] = 0.f;
    M_LD(0); M_ST(0); __syncthreads();
#pragma unroll 1
    for (int tile = 0; tile < 4; ++tile) { const int so = (tile & 1) * 16384;
        if (tile < 3) M_LD(tile + 1);
        f32x16 p0, p1;
#pragma unroll
        for (int r = 0; r < 16; ++r) { p0[r] = 0.f; p1[r] = 0.f; }
#pragma unroll
        for (int d0 = 0; d0 < 8; ++d0) { const bf16x8 k0 = *(const LAS bf16x8*)(kbase + so + d0 * 2048), k1 = *(const LAS bf16x8*)(kbase + so + d0 * 2048 + 512); p0 = MFMA32(k0, qr[d0], p0); p1 = MFMA32(k1, qr[d0], p1); }
        float s = 0.f;
#pragma unroll
        for (int r = 0; r < 16; ++r) { p0[r] = __builtin_amdgcn_exp2f(p0[r]); p1[r] = __builtin_amdgcn_exp2f(p1[r]); s += p0[r] + p1[r]; }
        lsum += s;
        bf16x8 pa[4];
        { u32x4 w0, w1, w2, w3;
#pragma unroll
          for (int i = 0; i < 4; ++i) { w0[i] = cvt_pk_bf16(p0[2 * i], p0[2 * i + 1]); w1[i] = cvt_pk_bf16(p0[8 + 2 * i], p0[8 + 2 * i + 1]); w2[i] = cvt_pk_bf16(p1[2 * i], p1[2 * i + 1]); w3[i] = cvt_pk_bf16(p1[8 + 2 * i], p1[8 + 2 * i + 1]); }
          pa[0] = __builtin_bit_cast(bf16x8, w0); pa[1] = __builtin_bit_cast(bf16x8, w1); pa[2] = __builtin_bit_cast(bf16x8, w2); pa[3] = __builtin_bit_cast(bf16x8, w3); }
#pragma unroll
        for (int dq = 0; dq < 4; ++dq)
#pragma unroll
            for (int ks = 0; ks < 4; ++ks) { const s16x4 lo = vtr(vbase + so + dq * 4096 + ks * 1024), hh = vtr(vbase + so + dq * 4096 + ks * 1024 + 512); oT[dq] = MFMA32(VFRAG(lo, hh), pa[ks], oT[dq]); }
        if (tile < 3) M_ST(so ^ 16384);
        __syncthreads();
    }
#undef M_LD
#undef M_ST
    lsum += __shfl_xor(lsum, 32); const float il = 1.f / lsum; bf16_t* op = OM + tok * 512 + h * 128 + 4 * hi;
#pragma unroll
    for (int dq = 0; dq < 4; ++dq)
#pragma unroll
        for (int a4 = 0; a4 < 4; ++a4) { u32x2 w; w.x = cvt_pk_bf16(oT[dq][4 * a4] * il, oT[dq][4 * a4 + 1] * il); w.y = cvt_pk_bf16(oT[dq][4 * a4 + 2] * il, oT[dq][4 * a4 + 3] * il); *(u32x2*)(op + dq * 32 + a4 * 8) = w; }
}

#define XB_TMO      128
#define XB_XCNT(j)  (256  + 64 * (j))
#define XB_XSUB(j)  (1280 + 64 * (j))
#define XB_XGEN(j)  (2304 + 64 * (j))
#define XB_TOP      3328
#define XB_TOPGEN   3392
#define XCD_BAR_WORDS 3456
#define XB_SPIN_CAP (1u << 18)
__device__ __forceinline__ unsigned xb_ld(unsigned* p)              { return __hip_atomic_load(p, __ATOMIC_RELAXED, __HIP_MEMORY_SCOPE_AGENT); }
__device__ __forceinline__ unsigned xb_add(unsigned* p, unsigned v) { return __hip_atomic_fetch_add(p, v, __ATOMIC_RELAXED, __HIP_MEMORY_SCOPE_AGENT); }
__device__ __forceinline__ unsigned xb_xcc_id() { return (unsigned)__builtin_amdgcn_s_getreg((3 << 11) | 20) & 0xFu; }
#define XB_SPIN(cond, bar) do { unsigned _sp = 0; while (cond) { __builtin_amdgcn_s_sleep(1); \
    if ((++_sp & 255u) == 0u) { if (xb_ld(&(bar)[XB_TMO])) break; if (_sp > XB_SPIN_CAP) { atomicAdd(&(bar)[XB_TMO], 1u); break; } } } } while (0)
struct XcdBarrier { unsigned* bar; unsigned x; volatile LAS unsigned* st; };
__device__ __forceinline__ XcdBarrier xcd_barrier_post(unsigned* bar, volatile LAS unsigned* st) {
    XcdBarrier b; b.bar = bar; b.x = xb_xcc_id(); b.st = st;
    if (threadIdx.x == 0) (void)xb_add(&bar[XB_XCNT(b.x)], 1u);
    return b;
}
__device__ __forceinline__ void xcd_barrier_complete(unsigned* bar, unsigned x, unsigned& nloc, unsigned& nx) {
    const unsigned G = gridDim.x * gridDim.y * gridDim.z;
    unsigned sum, cnt, mine, sp = 0u;
    for (;;) {
        sum = 0u; cnt = 0u; mine = 0u;
#pragma unroll
        for (unsigned j = 0; j < 16; ++j) { const unsigned c = xb_ld(&bar[XB_XCNT(j)]); sum += c; cnt += (c > 0u) ? 1u : 0u; mine = (j == x) ? c : mine; }
        if (sum == G) break;
        __builtin_amdgcn_s_sleep(1);
        if ((++sp & 255u) == 0u) { if (xb_ld(&bar[XB_TMO])) break; if (sp > XB_SPIN_CAP) { atomicAdd(&bar[XB_TMO], 1u); break; } }
    }
    nloc = mine > 0u ? mine : 1u; nx = cnt > 0u ? cnt : 1u;
}
__device__ __forceinline__ void xcd_barrier(const XcdBarrier& b) {
    asm volatile("s_waitcnt vmcnt(0)" ::: "memory");
    __syncthreads();
    if (threadIdx.x == 0) {
        unsigned* bar = b.bar;
        __builtin_amdgcn_s_waitcnt(0);
        unsigned nloc = b.st[0], nx = b.st[1];
        if (nloc == 0u) { xcd_barrier_complete(bar, b.x, nloc, nx); b.st[0] = nloc; b.st[1] = nx; }
        const unsigned old = xb_add(&bar[XB_XSUB(b.x)], 1u);
        const unsigned gen = old / nloc;
        if (old + 1u == (gen + 1u) * nloc) {
            __builtin_amdgcn_fence(__ATOMIC_RELEASE, "agent");
            asm volatile("s_waitcnt vmcnt(0)" ::: "memory");
            const unsigned og = xb_add(&bar[XB_TOP], 1u);
            const unsigned tg = og / nx;
            if (og + 1u == (tg + 1u) * nx) xb_add(&bar[XB_TOPGEN], 1u);
            else XB_SPIN(xb_ld(&bar[XB_TOPGEN]) == tg, bar);
            __builtin_amdgcn_fence(__ATOMIC_ACQUIRE, "agent");
            xb_add(&bar[XB_XGEN(b.x)], 1u);
            asm volatile("s_waitcnt vmcnt(0)" ::: "memory");
        } else {
            XB_SPIN(xb_ld(&bar[XB_XGEN(b.x)]) == gen, bar);
            __builtin_amdgcn_fence(__ATOMIC_ACQUIRE, "agent");
            asm volatile("s_waitcnt vmcnt(0)" ::: "memory");
        }
    }
    __syncthreads();
}
constexpr size_t CTL_BAR_BYTE = 704 * 1024;
constexpr int LDS_ST_OFF = 147456 - 64;

constexpr int LDS_BYTES = 147456;
#ifndef MK_REP3
#define MK_REP3 1
#endif
#ifndef MK_REP2
#define MK_REP2 1
#endif
#ifndef MK_REP6
#define MK_REP6 1
#endif
#ifndef MK_DBL_SYNC
#define MK_DBL_SYNC 0
#endif
__global__ void __launch_bounds__(512, 2) mega(Args args) {
    extern __shared__ __attribute__((aligned(16))) unsigned char lds_raw[];
    LAS unsigned char* lds = (LAS unsigned char*)lds_raw;
    const int G = gridDim.x, bx = blockIdx.x, NGW = G * 8;
    volatile LAS unsigned* bar_st = (volatile LAS unsigned*)(lds + LDS_ST_OFF);
    if (threadIdx.x < 2) bar_st[threadIdx.x] = 0u;
    if (bx == 0 && args.ph_lo == 0) { unsigned* bw = (unsigned*)(args.ws + WS_CTL + CTL_BAR_BYTE); for (int i = threadIdx.x; i < XCD_BAR_WORDS; i += 512) __hip_atomic_store(bw + i, 0u, __ATOMIC_RELAXED, __HIP_MEMORY_SCOPE_AGENT); }
    __syncthreads();
    XcdBarrier xbar; xbar.bar = (unsigned*)(args.ws + WS_CTL + CTL_BAR_BYTE); xbar.x = 0; xbar.st = bar_st;
    if (args.ph_lo == 0) { const int tid0 = threadIdx.x, wave0 = __builtin_amdgcn_readfirstlane(tid0 >> 6); prologue(args, lds, bx * 8 + wave0, NGW, wave0, tid0 & 63); }
    for (int ph = args.ph_lo > 1 ? args.ph_lo : 1; ph < args.ph_hi; ++ph) {
        if (ph > args.ph_lo) {
            if (ph == 1) { cooperative_groups::this_grid().sync(); xbar = xcd_barrier_post(xbar.bar, bar_st); }
            else xcd_barrier(xbar); }
        unsigned char* ws = args.ws; float* xout = args.out; asm volatile("" : "+s"(ws), "+s"(xout));
        int tidp = threadIdx.x; asm volatile("" : "+v"(tidp)); const int lane = tidp & 63, wave = __builtin_amdgcn_readfirstlane(tidp >> 6), gw = bx * 8 + wave;
        float* ctl = (float*)(ws + WS_CTL); bf16_t* XB = (bf16_t*)(ws + WS_XB);
        const int l = (ph - 1) / 10, p = (ph - 1) % 10; unsigned char* wl = ws + WS_W + l * W_LAYER;
#if MK_DBL_SYNC
        for (int e_ = 0; e_ < MK_DBL_SYNC; ++e_) xcd_barrier(xbar);
#endif
        if (p == 0) {
            pg8::Gemm g = pg8::make_gemm(XB, (const bf16_t*)(wl + W_IN), 1024); pg8::StaticOrder S; S.init(NTOK, INP, G, bx);
            pg8::EpiInProj E{(bf16_t*)(ws + WS_U), (bf16_t*)(ws + WS_V), (bf16_t*)(ws + WS_Q), (bf16_t*)(ws + WS_KV), (float*)(ws + WS_GL), ctl + (l == 0 ? 0 : 3) * NTOK};
            pg8::gemm_phase<pg8::EpiInProj, pg8::StaticOrder, true>(lds, g, S, E);
        } else if (p == 1) {
            if (bx < 16) { const int kv = bx >> 3, pm = bx & 7;
                pg8::Gemm g; g.A = (const bf16_t*)(ws + WS_KV) + kv * 128; g.Bt = (const bf16_t*)(wl + W_C1 + (size_t)kv * 256 * 2048 * 2); g.K = 2048; g.lda = 16 * 768; g.kstepA = 768 * 2; g.a_s0 = 64 * 2; g.a_s1 = (size_t)T * 768 * 2;
                pg8::OneUnit S{1, {pm, 0}};
                pg8::EpiBf16G<1> E{(bf16_t*)(ws + WS_HID) + (size_t)kv * 2048 * 256, 256, (const float*)(wl + W_B1P) + kv * 256, nullptr, 0.f};
                pg8::gemm_phase<pg8::EpiBf16G<1>, pg8::OneUnit, true>(lds, g, S, E);
            } else if (bx < 32) { const int i = bx - 16;
                pg8::Gemm g = pg8::make_gemm((const bf16_t*)(ws + WS_MEMB), (const bf16_t*)(wl + W_MKV), 1024); pg8::OneUnit S{1, {i >> 2, i & 3}};
                pg8::EpiBf16G<0> E{(bf16_t*)(ws + WS_KVM), 1024, nullptr, ctl + SSQ_MEM_OFF, 1.f / 1024.f};
                pg8::gemm_phase<pg8::EpiBf16G<0>, pg8::OneUnit, true>(lds, g, S, E);
            }
        } else if (p == 2) {
            for (int u_ = bx; u_ < 128 * MK_REP2; u_ += G) sgu_unit(lds, u_ & 127, (const bf16_t*)(ws + WS_U), (const bf16_t*)(ws + WS_V), (const bf16_t*)(wl + W_SG), args.in[I_SGLNG] + l * 512, args.in[I_SGLNB] + l * 512, args.in[I_SGB] + l * 1024, (bf16_t*)(ws + WS_MIX));
            for (int t = gw; t < NTOK; t += NGW) tokprep_token((bf16_t*)(ws + WS_Q), (bf16_t*)(ws + WS_KV), args.in[I_QNG] + l * 64, args.in[I_KNG] + l * 192, t, lane);
            for (int r = gw; r < 2048; r += NGW) cmp2_row((const bf16_t*)(ws + WS_HID), (const bf16_t*)(wl + W_C2), args.in[I_CB2] + l * 128, args.in[I_KNG] + l * 192, (bf16_t*)(ws + WS_KC), (bf16_t*)(ws + WS_VC), r, lane);
        } else if (p == 3) {
            for (int r = gw; r < 4096; r += NGW) memk_norm_item((bf16_t*)(ws + WS_KVM), args.in[I_MKG] + l * 128, r, lane);
            for (int i_ = bx; i_ < 256 * MK_REP3; i_ += G) { const int i = i_ & 255, b = (i & 7) >> 1, idx = (i >> 3) * 2 + (i & 1);
                attn_unit<15>(lds, b, 127 - idx, (const bf16_t*)(ws + WS_Q), (const bf16_t*)(ws + WS_KV), (const bf16_t*)(ws + WS_KC), (const bf16_t*)(ws + WS_VC), (const float*)(ws + WS_GL), (bf16_t*)(ws + WS_MIX));
                attn_unit<15>(lds, b, idx, (const bf16_t*)(ws + WS_Q), (const bf16_t*)(ws + WS_KV), (const bf16_t*)(ws + WS_KC), (const bf16_t*)(ws + WS_VC), (const float*)(ws + WS_GL), (bf16_t*)(ws + WS_MIX)); }
        } else if (p == 6) {
            for (int i_ = bx; i_ < 256 * MK_REP6; i_ += G) { const int i = i_ & 255, b = (i & 7) >> 1, rest = (i >> 3) * 2 + (i & 1);
                memattn_unit(lds, b, rest >> 4, rest & 15, (const bf16_t*)(ws + WS_QM), (const bf16_t*)(ws + WS_KVM), args.in[I_MQG] + l * 128, (bf16_t*)(ws + WS_OM)); }
        } else if (p == 4) {
            pg8::Gemm g = pg8::make_gemm((const bf16_t*)(ws + WS_MIX), (const bf16_t*)(wl + W_OUT), 1024); pg8::StaticOrder S; S.init(NTOK, 1024, G, bx);
            pg8::EpiResid E{xout, XB, ctl + (l * 3 + 1) * NTOK};
            pg8::gemm_phase<pg8::EpiResid, pg8::StaticOrder, true>(lds, g, S, E);
        } else if (p == 5) {
            pg8::Gemm g = pg8::make_gemm(XB, (const bf16_t*)(wl + W_MQ), 1024); pg8::StaticOrder S; S.init(NTOK, 512, G, bx);
            pg8::EpiBf16G<0> E{(bf16_t*)(ws + WS_QM), 512, nullptr, ctl + (l * 3 + 1) * NTOK, 1.f / 1024.f};
            pg8::gemm_phase<pg8::EpiBf16G<0>, pg8::StaticOrder, true>(lds, g, S, E);
        } else if (p == 7) {
            pg8::Gemm g = pg8::make_gemm((const bf16_t*)(ws + WS_OM), (const bf16_t*)(wl + W_MO), 512); pg8::StaticOrder S; S.init(NTOK, 1024, G, bx);
            pg8::EpiResid E{xout, XB, ctl + (l * 3 + 2) * NTOK};
            pg8::gemm_phase<pg8::EpiResid, pg8::StaticOrder, true>(lds, g, S, E);
        } else if (p == 8) {
            pg8::Gemm g = pg8::make_gemm(XB, (const bf16_t*)(wl + W_FF1), 1024); pg8::StaticOrder S; S.init(NTOK, FF, G, bx);
            pg8::EpiBf16G<2> E{(bf16_t*)(ws + WS_HB), FF, nullptr, ctl + (l * 3 + 2) * NTOK, 1.f / 1024.f};
            pg8::gemm_phase<pg8::EpiBf16G<2>, pg8::StaticOrder, true>(lds, g, S, E);
        } else if (p == 9) {
            pg8::Gemm g = pg8::make_gemm((const bf16_t*)(ws + WS_HB), (const bf16_t*)(wl + W_FF2), FF); pg8::StaticOrder S; S.init(NTOK, 1024, G, bx);
            pg8::EpiResid E{xout, l == 0 ? XB : (bf16_t*)nullptr, ctl + 3 * NTOK};
            pg8::gemm_phase<pg8::EpiResid, pg8::StaticOrder, true>(lds, g, S, E);
        }
    }
#if MK_PROBE_N > 0
    if (args.ph_hi == 21) {
        unsigned char* ws = args.ws; unsigned char* wl = ws + WS_W + W_LAYER; float* ctl = (float*)(ws + WS_CTL);
        xcd_barrier(xbar);
        { pg8::Gemm g = pg8::make_gemm((const bf16_t*)(ws + WS_XB), (const bf16_t*)(wl + W_IN), 1024); pg8::StaticOrder S; S.init(NTOK, INP, G, bx);
          pg8::EpiInProj E{(bf16_t*)(ws + WS_U), (bf16_t*)(ws + WS_V), (bf16_t*)(ws + WS_Q), (bf16_t*)(ws + WS_KV), (float*)(ws + WS_GL), ctl + 3 * NTOK};
          pg8::gemm_phase<pg8::EpiInProj, pg8::StaticOrder, true>(lds, g, S, E); }
        xcd_barrier(xbar);
        { int tidp = threadIdx.x; asm volatile("" : "+v"(tidp)); const int lane = tidp & 63, wave = __builtin_amdgcn_readfirstlane(tidp >> 6), gw = bx * 8 + wave;
          for (int t = gw; t < NTOK; t += NGW) tokprep_token((bf16_t*)(ws + WS_Q), (bf16_t*)(ws + WS_KV), args.in[I_QNG] + 64, args.in[I_KNG] + 192, t, lane); }
        for (int e_ = 0; e_ < MK_PROBE_N; ++e_) { xcd_barrier(xbar);
            for (int i = bx; i < 256; i += G) { const int b = (i & 7) >> 1, idx = (i >> 3) * 2 + (i & 1);
                attn_unit<MK_PROBE_PARTS>(lds, b, 127 - idx, (const bf16_t*)(ws + WS_Q), (const bf16_t*)(ws + WS_KV), (const bf16_t*)(ws + WS_KC), (const bf16_t*)(ws + WS_VC), (const float*)(ws + WS_GL), (bf16_t*)(ws + WS_MIX));
                attn_unit<MK_PROBE_PARTS>(lds, b, idx, (const bf16_t*)(ws + WS_Q), (const bf16_t*)(ws + WS_KV), (const bf16_t*)(ws + WS_KC), (const bf16_t*)(ws + WS_VC), (const float*)(ws + WS_GL), (bf16_t*)(ws + WS_MIX)); } }
    }
#endif
}

}

#ifndef MK_FUSED
#define MK_FUSED 1
#endif
extern "C" void kernel_launch(void* const* d_in, const int* in_sizes, int n_in, void* d_out, int out_size, void* d_ws, size_t ws_size, hipStream_t stream) {
    using namespace mk;
    static int grid = 0;
    if (!grid) { (void)hipFuncSetAttribute((const void*)mega, hipFuncAttributeMaxDynamicSharedMemorySize, LDS_BYTES);
        int dev = 0, cus = 0, per_cu = 0; (void)hipGetDevice(&dev); (void)hipDeviceGetAttribute(&cus, hipDeviceAttributeMultiprocessorCount, dev);
        (void)hipOccupancyMaxActiveBlocksPerMultiprocessor(&per_cu, (const void*)mega, 512, LDS_BYTES);
        grid = cus * (per_cu < 1 ? 1 : per_cu); if (grid > 256) grid = 256; }
    Args a{}; for (int i = 0; i < 27; ++i) a.in[i] = (const float*)d_in[i]; a.out = (float*)d_out; a.ws = (unsigned char*)d_ws;
#if MK_FUSED
    a.ph_lo = 0; a.ph_hi = 21; void* kargs[] = {&a};
    (void)hipLaunchCooperativeKernel((const void*)mega, dim3(grid), dim3(512), kargs, LDS_BYTES, stream);
#else
    for (int ph = 0; ph < 21; ++ph) { a.ph_lo = ph; a.ph_hi = ph + 1; hipLaunchKernelGGL(mega, dim3(grid), dim3(512), LDS_BYTES, stream, a); }
#endif
}
```

```cpp
#include <hip/hip_runtime.h>
#include <hip/hip_cooperative_groups.h>
#include <stdint.h>
#include <math.h>

namespace pg8 {
#define PG8_LAS __attribute__((address_space(3)))
typedef unsigned short bf16_t;
typedef short bf16x8 __attribute__((ext_vector_type(8)));
typedef float f32x4 __attribute__((ext_vector_type(4)));
typedef float f32x2 __attribute__((ext_vector_type(2)));
typedef unsigned u32x4 __attribute__((ext_vector_type(4)));
typedef unsigned u32x2 __attribute__((ext_vector_type(2)));
constexpr int BM = 256, BK = 64, HALF = 128, HTB = HALF * BK * 2, STAGE_BYTES = 8 * HTB, NXCD = 8, WGM = 8;

__host__ __device__ __forceinline__ int lds_byte(int r, int c) { const int st = (r >> 4) * 2 + (c >> 5), rr = r & 15, cc = c & 31, ob = rr * 64 + cc * 2; return st * 1024 + (ob ^ (((ob >> 9) & 1) << 5)); }
__host__ __device__ __forceinline__ void stage_rc(int b, int& R, int& C) { const int st = b / 1024, sb = b % 1024, swz = sb ^ (((sb >> 9) & 1) << 5); R = (st >> 1) * 16 + swz / 64; C = (st & 1) * 32 + (swz % 64) / 2; }
__host__ __device__ __forceinline__ int perm32(int rho) { const int n = rho >> 4, i = rho & 15; return 8 * (i >> 2) + 4 * n + (i & 3); }

struct Unit { int pm, pn; };
struct Gemm { const bf16_t* A; const bf16_t* Bt; int K; int lda; int kstepA; size_t a_s0, a_s1; };
__device__ __forceinline__ Gemm make_gemm(const bf16_t* A, const bf16_t* Bt, int K) { Gemm g; g.A = A; g.Bt = Bt; g.K = K; g.lda = K; g.kstepA = BK * 2; g.a_s0 = (size_t)BM * K * 2; g.a_s1 = 2 * g.a_s0; return g; }

struct StaticOrder {
    int nM, nN, nwg, G, c;
    __device__ void init(int M, int N, int G_, int c_) { nM = M / BM; nN = N / BM; nwg = nM * nN; G = G_; c = c_; }
    __device__ bool next(int i, Unit& u) const {
        const long L = (long)i * G + c; if (L >= nwg) return false;
        int wgid = (int)L; { const int q = nwg / NXCD, r = nwg % NXCD, xcd = wgid % NXCD, off = wgid / NXCD; wgid = (xcd < r ? xcd * (q + 1) : r * (q + 1) + (xcd - r) * q) + off; }
        const int nig = WGM * nN, gid = wgid / nig, fm = gid * WGM, gsz = (nM - fm) < WGM ? (nM - fm) : WGM;
        u.pm = fm + ((wgid % nig) % gsz); u.pn = (wgid % nig) / gsz; return true;
    }
};
struct OneUnit { int has; Unit u; __device__ bool next(int i, Unit& o) const { if (i > 0 || !has) return false; o = u; return true; } };

__device__ __forceinline__ unsigned cvt_pk_bf16(float lo, float hi) { unsigned r; asm volatile("v_cvt_pk_bf16_f32 %0, %1, %2" : "=v"(r) : "v"(lo), "v"(hi)); return r; }
__device__ __forceinline__ float gelu_tanh(float x) { const float u = 0.7978845608028654f * (x + 0.044715f * x * x * x); const float e = __builtin_amdgcn_exp2f(-2.885390081777927f * u); return x * __builtin_amdgcn_rcpf(1.f + e); }

template <int ACT  > struct EpiBf16G {
    static constexpr bool PERM = true, AFTER_DRAIN = false;
    bf16_t* O; int ldc; const float* bias; const float* ssq; float inv_n;
    __device__ __forceinline__ void operator()(const f32x4 (&acc)[2][2][4][2], const Unit& u, int wr, int wc, int fr, int fq) const {
        const int row0 = u.pm * BM + wr * 64 + fr, col0 = u.pn * BM + wc * 32 + 8 * fq;
        f32x4 bv[2][2];
#pragma unroll
        for (int bj = 0; bj < 2; ++bj)
#pragma unroll
            for (int n = 0; n < 2; ++n) bv[bj][n] = bias ? *(const f32x4*)(bias + col0 + bj * HALF + 4 * n) : (f32x4){0.f, 0.f, 0.f, 0.f};
#pragma unroll
        for (int ai = 0; ai < 2; ++ai)
#pragma unroll
            for (int m = 0; m < 4; ++m) { const int row = row0 + ai * HALF + m * 16; const float rs = ssq ? rsqrtf(ssq[row] * inv_n + 1e-6f) : 1.f; bf16_t* rowp = O + (size_t)row * ldc + col0;
#pragma unroll
                for (int bj = 0; bj < 2; ++bj) { f32x4 v0 = (acc[ai][bj][m][0] + bv[bj][0]) * rs, v1 = (acc[ai][bj][m][1] + bv[bj][1]) * rs;
                    if (ACT == 1) {
#pragma unroll
                        for (int e = 0; e < 4; ++e) { v0[e] = gelu_tanh(v0[e]); v1[e] = gelu_tanh(v1[e]); } }
                    if (ACT == 2) {
#pragma unroll
                        for (int e = 0; e < 4; ++e) { float a = fmaxf(v0[e], 0.f), b = fmaxf(v1[e], 0.f); v0[e] = a * a; v1[e] = b * b; } }
                    u32x4 w; w.x = cvt_pk_bf16(v0[0], v0[1]); w.y = cvt_pk_bf16(v0[2], v0[3]); w.z = cvt_pk_bf16(v1[0], v1[1]); w.w = cvt_pk_bf16(v1[2], v1[3]);
                    *(u32x4*)(rowp + bj * HALF) = w; } }
    }
};
struct EpiInProj {
    static constexpr bool PERM = true, AFTER_DRAIN = false;
    bf16_t *U, *V, *Q, *KV; float* GL; const float* ssq;
    __device__ __forceinline__ void operator()(const f32x4 (&acc)[2][2][4][2], const Unit& u, int wr, int wc, int fr, int fq) const {
        const int row0 = u.pm * BM + wr * 64 + fr, cit0 = wc * 32 + 8 * fq; const int pn = u.pn;
        bf16_t* base; int ldc, cofs; bool act = false;
        if (pn < 2) { base = U; ldc = 512; cofs = pn * 256; act = true; } else if (pn < 4) { base = V; ldc = 512; cofs = (pn - 2) * 256; act = true; }
        else if (pn < 6) { base = Q; ldc = 512; cofs = (pn - 4) * 256; } else { base = KV; ldc = 768; cofs = (pn - 6) * 256; }
#pragma unroll
        for (int ai = 0; ai < 2; ++ai)
#pragma unroll
            for (int m = 0; m < 4; ++m) { const int row = row0 + ai * HALF + m * 16; const float rs = rsqrtf(ssq[row] * (1.f / 1024.f) + 1e-6f);
#pragma unroll
                for (int bj = 0; bj < 2; ++bj) { f32x4 v0 = acc[ai][bj][m][0] * rs, v1 = acc[ai][bj][m][1] * rs; const int cit = cit0 + bj * HALF;
                    if (pn == 9) { if (cit < 24) { *(f32x4*)(GL + (size_t)row * 24 + cit) = v0; *(f32x4*)(GL + (size_t)row * 24 + cit + 4) = v1; } }
                    else { if (act) {
#pragma unroll
                            for (int e = 0; e < 4; ++e) { v0[e] = gelu_tanh(v0[e]); v1[e] = gelu_tanh(v1[e]); } }
                        u32x4 w; w.x = cvt_pk_bf16(v0[0], v0[1]); w.y = cvt_pk_bf16(v0[2], v0[3]); w.z = cvt_pk_bf16(v1[0], v1[1]); w.w = cvt_pk_bf16(v1[2], v1[3]);
                        *(u32x4*)(base + (size_t)row * ldc + cofs + cit) = w; } } }
    }
};
struct EpiResid {
    static constexpr bool PERM = false, AFTER_DRAIN = false;
    float* X; bf16_t* XB; float* ssq;
    __device__ __forceinline__ void operator()(const f32x4 (&acc)[2][2][4][2], const Unit& u, int wr, int wc, int fr, int fq) const {
        const int col0 = u.pn * BM + wc * 32 + 4 * fq;
#pragma unroll
        for (int ai = 0; ai < 2; ++ai)
#pragma unroll
            for (int m = 0; m < 4; ++m) { const int row = u.pm * BM + ai * HALF + wr * 64 + m * 16 + fr; float sq = 0.f;
#pragma unroll
                for (int bj = 0; bj < 2; ++bj)
#pragma unroll
                    for (int n = 0; n < 2; ++n) { const size_t off = (size_t)row * 1024 + col0 + bj * HALF + n * 16; f32x4 xv = *(const f32x4*)(X + off); xv = xv + acc[ai][bj][m][n]; *(f32x4*)(X + off) = xv;
                        if (XB) { sq += (xv[0] * xv[0] + xv[1] * xv[1]) + (xv[2] * xv[2] + xv[3] * xv[3]); u32x2 w; w.x = cvt_pk_bf16(xv[0], xv[1]); w.y = cvt_pk_bf16(xv[2], xv[3]); *(u32x2*)(XB + off) = w; } }
                if (XB) { sq += __shfl_xor(sq, 16); sq += __shfl_xor(sq, 32); if (fq == 0) atomicAdd(ssq + row, sq); } }
    }
};

template <class Epi, class Sched, bool ALIGN_EPI>
__device__ __forceinline__ void gemm_phase(PG8_LAS unsigned char* lds, const Gemm g, const Sched& S, const Epi& E) {
    int tid_ = threadIdx.x; asm volatile("" : "+v"(tid_));
    const int tid = tid_, wid = __builtin_amdgcn_readfirstlane(tid >> 6), lane = tid & 63, wr = wid >> 2, wc = wid & 3, fr = lane & 15, fq = lane >> 4;
    const int K = g.K, nt = K / BK;
    unsigned voffA[2], voffB[2];
#pragma unroll
    for (int i = 0; i < 2; ++i) { int R, C; stage_rc(tid * 16 + i * 8192, R, C); const int Rb = Epi::PERM ? ((R & ~31) + perm32(R & 31)) : R;
        voffA[i] = (unsigned)(R * g.lda + C) * 2u; voffB[i] = (unsigned)(Rb * K + C) * 2u; }
    const size_t kstepA = (size_t)g.kstepA, kstepB = (size_t)(BK * 2);
    const size_t hstepA = (size_t)HALF * g.lda * 2, hstepB = (size_t)HALF * K * 2, tstepB = 2 * hstepB;
    const unsigned ldsw = (unsigned)wid * 1024u;
    const int aoff = lds_byte(wr * 64 + fr, fq * 8), boff = lds_byte(wc * 32 + fr, fq * 8);
#define PG8_ABASE(pm) ((const char*)g.A + (size_t)((pm) >> 1) * g.a_s1 + (size_t)((pm) & 1) * g.a_s0)
#define PG8_SA(b, h) (((b) * 2 + (h)) * HTB)
#define PG8_SB(b, h) ((4 + (b) * 2 + (h)) * HTB)
#define PG8_STAGE(bufoff, gbase, voff) do { _Pragma("unroll") for (int _i = 0; _i < 2; ++_i) \
        __builtin_amdgcn_global_load_lds((const unsigned*)((const char*)(gbase) + (voff)[_i]), (PG8_LAS unsigned*)(lds + (bufoff) + ldsw + _i * 8192), 16, 0, 0); } while (0)
#define PG8_LDA(dst, b, h) do { _Pragma("unroll") for (int m = 0; m < 4; ++m) _Pragma("unroll") for (int k = 0; k < 2; ++k) dst[m][k] = *(const PG8_LAS bf16x8*)(lds + PG8_SA(b, h) + aoff + m * 2048 + k * 1024); } while (0)
#define PG8_LDB(dst, b, h) do { _Pragma("unroll") for (int n = 0; n < 2; ++n) _Pragma("unroll") for (int k = 0; k < 2; ++k) dst[n][k] = *(const PG8_LAS bf16x8*)(lds + PG8_SB(b, h) + boff + n * 2048 + k * 1024); } while (0)
#define PG8_MMA(ai, bj, At, Bt) do { __builtin_amdgcn_s_setprio(1); _Pragma("unroll") for (int m = 0; m < 4; ++m) _Pragma("unroll") for (int n = 0; n < 2; ++n) _Pragma("unroll") for (int k = 0; k < 2; ++k) \
        acc[ai][bj][m][n] = __builtin_amdgcn_mfma_f32_16x16x32_bf16(Bt[n][k], At[m][k], acc[ai][bj][m][n], 0, 0, 0); __builtin_amdgcn_s_setprio(0); } while (0)
#define PG8_WAIT_V(n) asm volatile("s_waitcnt vmcnt(" #n ")" ::: "memory")
#define PG8_WAIT_L(n) asm volatile("s_waitcnt lgkmcnt(" #n ")" ::: "memory")
#define PG8_BAR __builtin_amdgcn_s_barrier()
#define PG8_SCHED __builtin_amdgcn_sched_barrier(0)
    Unit cur, nxt; int ui = 0;
    if (!S.next(0, cur)) return;
    f32x4 acc[2][2][4][2];
#pragma unroll
    for (int a = 0; a < 2; ++a)
#pragma unroll
        for (int b = 0; b < 2; ++b)
#pragma unroll
            for (int m = 0; m < 4; ++m)
#pragma unroll
                for (int n = 0; n < 2; ++n) acc[a][b][m][n] = (f32x4){0.f, 0.f, 0.f, 0.f};
    bf16x8 At[4][2], B0[2][2], B1[2][2];
    const char* cA = PG8_ABASE(cur.pm); const char* cB = (const char*)g.Bt + (size_t)cur.pn * tstepB;
    PG8_STAGE(PG8_SB(0, 0), cB, voffB); PG8_STAGE(PG8_SB(0, 1), cB + hstepB, voffB); PG8_STAGE(PG8_SA(0, 0), cA, voffA); PG8_STAGE(PG8_SA(0, 1), cA + hstepA, voffA);
    if (wr == 1) PG8_BAR;
    PG8_WAIT_V(2); PG8_BAR;
    PG8_STAGE(PG8_SB(1, 0), cB + kstepB, voffB); PG8_STAGE(PG8_SA(1, 0), cA + kstepA, voffA); PG8_STAGE(PG8_SB(1, 1), cB + hstepB + kstepB, voffB);
    PG8_WAIT_V(6); PG8_BAR;
    for (;;) {
        const bool has_next = S.next(ui + 1, nxt);
        const char* nA = has_next ? PG8_ABASE(nxt.pm) : cA; const char* nB = has_next ? (const char*)g.Bt + (size_t)nxt.pn * tstepB : cB;
        for (int t = 0; t < nt; t += 2) {
            const bool last = (t == nt - 2);
            const char* a1 = cA + (size_t)(t + 1) * kstepA;
            const char* a2 = last ? nA : cA + (size_t)(t + 2) * kstepA; const char* b2 = last ? nB : cB + (size_t)(t + 2) * kstepB;
            const char* a3 = a2 + kstepA; const char* b3 = b2 + kstepB;
            PG8_LDB(B0, 0, 0); PG8_LDB(B1, 0, 1); PG8_SCHED; PG8_LDA(At, 0, 0); PG8_STAGE(PG8_SA(1, 1), a1 + hstepA, voffA);
            PG8_WAIT_V(8); PG8_WAIT_L(0); PG8_BAR; PG8_MMA(0, 0, At, B0); PG8_MMA(0, 1, At, B1); PG8_BAR; PG8_SCHED;
            PG8_LDA(At, 0, 1); PG8_STAGE(PG8_SB(0, 0), b2, voffB); PG8_STAGE(PG8_SB(0, 1), b2 + hstepB, voffB); PG8_STAGE(PG8_SA(0, 0), a2, voffA);
            PG8_WAIT_V(8); PG8_WAIT_L(0); PG8_BAR; PG8_MMA(1, 0, At, B0); PG8_MMA(1, 1, At, B1); PG8_BAR; PG8_SCHED;
            PG8_LDB(B0, 1, 0); PG8_LDB(B1, 1, 1); PG8_SCHED; PG8_LDA(At, 1, 0); PG8_STAGE(PG8_SA(0, 1), a2 + hstepA, voffA);
            PG8_WAIT_V(8); PG8_WAIT_L(0); PG8_BAR; PG8_MMA(0, 0, At, B0); PG8_MMA(0, 1, At, B1); PG8_BAR; PG8_SCHED;
            PG8_LDA(At, 1, 1); PG8_STAGE(PG8_SB(1, 0), b3, voffB); PG8_STAGE(PG8_SB(1, 1), b3 + hstepB, voffB); PG8_STAGE(PG8_SA(1, 0), a3, voffA);
            PG8_WAIT_V(8); PG8_WAIT_L(0); PG8_BAR; PG8_MMA(1, 0, At, B0); PG8_MMA(1, 1, At, B1); PG8_BAR; PG8_SCHED;
        }
        if constexpr (ALIGN_EPI) { if (wr == 0) PG8_BAR; }
        if constexpr (!Epi::AFTER_DRAIN) { E(acc, cur, wr, wc, fr, fq); }
        if (!has_next) break;
#pragma unroll
        for (int a = 0; a < 2; ++a)
#pragma unroll
            for (int b = 0; b < 2; ++b)
#pragma unroll
                for (int m = 0; m < 4; ++m)
#pragma unroll
                    for (int n = 0; n < 2; ++n) acc[a][b][m][n] = (f32x4){0.f, 0.f, 0.f, 0.f};
        cur = nxt; cA = nA; cB = nB; ++ui;
        if constexpr (ALIGN_EPI) { if (wr == 1) PG8_BAR; }
    }
    PG8_WAIT_V(0);
    if constexpr (!ALIGN_EPI) { if (wr == 0) PG8_BAR; }
    PG8_BAR;
    if constexpr (Epi::AFTER_DRAIN) { E.fused(acc, cur, wr, wc, fr, fq, lds, wid, lane); }
#undef PG8_ABASE
#undef PG8_SA
#undef PG8_SB
#undef PG8_STAGE
#undef PG8_LDA
#undef PG8_LDB
#undef PG8_MMA
#undef PG8_WAIT_V
#undef PG8_WAIT_L
#undef PG8_BAR
#undef PG8_SCHED
}
}

#ifndef MK_PROBE_N
#define MK_PROBE_N 0
#endif
#ifndef MK_PROBE_PRO
#define MK_PROBE_PRO 0
#endif
#ifndef MK_PROBE_KIND
#define MK_PROBE_KIND 3
#endif
#ifndef MK_PROBE_PARTS
#define MK_PROBE_PARTS 15
#endif

namespace mk {
using pg8::bf16_t; using pg8::f32x4; using pg8::u32x4; using pg8::u32x2; using pg8::cvt_pk_bf16;
#define LAS __attribute__((address_space(3)))
constexpr int NB = 4, T = 4096, D = 1024, NTOK = NB * T, INC = 2328, INP = 2560, FF = 4096;
constexpr size_t MiB = 1u << 20;
constexpr size_t WS_CTL = 0;
constexpr size_t WS_W = 1 * MiB, W_LAYER = 30 * MiB;
constexpr size_t W_IN = 0, W_OUT = 5 * MiB, W_MQ = 7 * MiB, W_MKV = 8 * MiB, W_MO = 10 * MiB, W_FF1 = 11 * MiB, W_FF2 = 19 * MiB, W_C1 = 27 * MiB, W_C2 = 29 * MiB, W_SG = 29 * MiB + 128 * 1024, W_B1P = 29 * MiB + 512 * 1024;
constexpr size_t WS_XB = 61 * MiB;
constexpr size_t WS_OV = 93 * MiB;
constexpr size_t WS_U = WS_OV, WS_V = WS_OV + 16 * MiB, WS_Q = WS_OV + 32 * MiB, WS_KV = WS_OV + 48 * MiB, WS_MIX = WS_OV + 72 * MiB, WS_QM = WS_OV + 104 * MiB, WS_OM = WS_OV + 120 * MiB;
constexpr size_t WS_HB = WS_OV;
constexpr size_t WS_SM = 229 * MiB;
constexpr size_t WS_GL = WS_SM, WS_KC = WS_SM + 2 * MiB, WS_VC = WS_KC + 256 * 1024, WS_HID = WS_SM + 3 * MiB, WS_MASK = WS_SM + 5 * MiB, WS_MEMB = WS_SM + 6 * MiB, WS_KVM = WS_SM + 8 * MiB, WS_END = WS_SM + 10 * MiB;
static_assert(WS_END <= 256 * MiB, "ws map");
constexpr int SSQ_MEM_OFF = 6 * NTOK;

struct Args { const float* in[27]; float* out; unsigned char* ws; int ph_lo, ph_hi; };
enum { I_X = 0, I_MEM, I_NMG, I_WIN, I_SGLNG, I_SGLNB, I_SGW, I_SGB, I_QNG, I_KNG, I_CPOS, I_CW1, I_CB1, I_CW2, I_CB2, I_MOG, I_WOUT, I_NMEMG, I_MKVG, I_WMQ, I_WMKV, I_MQG, I_MKG, I_WMO, I_NFG, I_WFF1, I_WFF2 };

__device__ __forceinline__ float bf2f(unsigned short b) { return __uint_as_float((unsigned)b << 16); }
__device__ __forceinline__ float wave_sum(float v) {
#pragma unroll
    for (int o = 1; o < 64; o <<= 1) v += __shfl_xor(v, o);
    return v; }

__device__ __forceinline__ void transpose_item(const float* W, int K, int N, int Npad, const float* gain, bf16_t* WT, LAS float* scr, int item, int lane) {
    const int nblk = Npad / 32, kb = item / nblk, nb = item % nblk, k0 = 64 * kb, n0 = 32 * nb;
    const int nn = n0 + (lane & 31); const int nnc = nn < N ? nn : N - 1; const float keep = nn < N ? 1.f : 0.f;
    const float* src = W + (size_t)(k0 + (lane >> 5)) * N + nnc;
    float v[32];
#pragma unroll
    for (int i = 0; i < 32; ++i) v[i] = src[(size_t)(2 * i) * N];
#pragma unroll
    for (int i = 0; i < 32; ++i) scr[(2 * i + (lane >> 5)) * 33 + (lane & 31)] = v[i] * keep;
    asm volatile("s_waitcnt lgkmcnt(0)" ::: "memory");
    const int c = lane & 7;
    f32x4 g0 = {1.f, 1.f, 1.f, 1.f}, g1 = {1.f, 1.f, 1.f, 1.f};
    if (gain) { g0 = *(const f32x4*)(gain + k0 + 8 * c); g1 = *(const f32x4*)(gain + k0 + 8 * c + 4); }
#pragma unroll
    for (int j = 0; j < 4; ++j) { const int n = (lane >> 3) + 8 * j; const LAS float* sp = scr + (8 * c) * 33 + n;
        u32x4 o; o.x = cvt_pk_bf16(sp[0 * 33] * g0[0], sp[1 * 33] * g0[1]); o.y = cvt_pk_bf16(sp[2 * 33] * g0[2], sp[3 * 33] * g0[3]); o.z = cvt_pk_bf16(sp[4 * 33] * g1[0], sp[5 * 33] * g1[1]); o.w = cvt_pk_bf16(sp[6 * 33] * g1[2], sp[7 * 33] * g1[3]);
        *(u32x4*)(WT + (size_t)(n0 + n) * K + k0 + 8 * c) = o; }
    asm volatile("s_waitcnt lgkmcnt(0)" ::: "memory");
}

template <bool DO_X>
__device__ __forceinline__ void prologue(const Args& a, LAS unsigned char* lds, int gw, int NGW, int wave, int lane) {
    LAS float* scr = (LAS float*)(lds + wave * 16384);
    unsigned char* ws = a.ws; float* ctl = (float*)(ws + WS_CTL);
    int it0 = 0;
#define TR_MAT(Wp, K_, N_, NP_, Gp, DST) { const int cnt = ((K_) / 64) * ((NP_) / 32); for (int it = gw; it < it0 + cnt; it += NGW) { if (it >= it0) transpose_item((Wp), (K_), (N_), (NP_), (Gp), (bf16_t*)(DST), scr, it - it0, lane); } it0 += cnt; }
    for (int l = 0; l < 2; ++l) {
        unsigned char* wl = ws + WS_W + l * W_LAYER;
        TR_MAT(a.in[I_WIN] + (size_t)l * 1024 * INC, 1024, INC, INP, a.in[I_NMG] + l * 1024, wl + W_IN)
        TR_MAT(a.in[I_WOUT] + (size_t)l * 1024 * 1024, 1024, 1024, 1024, a.in[I_MOG] + l * 1024, wl + W_OUT)
        TR_MAT(a.in[I_WMQ] + (size_t)l * 1024 * 512, 1024, 512, 512, a.in[I_NMEMG] + l * 1024, wl + W_MQ)
        TR_MAT(a.in[I_WMKV] + (size_t)l * 1024 * 1024, 1024, 1024, 1024, a.in[I_MKVG] + l * 1024, wl + W_MKV)
        TR_MAT(a.in[I_WMO] + (size_t)l * 512 * 1024, 512, 1024, 1024, (const float*)nullptr, wl + W_MO)
        TR_MAT(a.in[I_WFF1] + (size_t)l * 1024 * 4096, 1024, 4096, 4096, a.in[I_NFG] + l * 1024, wl + W_FF1)
        TR_MAT(a.in[I_WFF2] + (size_t)l * 4096 * 1024, 4096, 1024, 1024, (const float*)nullptr, wl + W_FF2)
        for (int kv = 0; kv < 2; ++kv) {
            TR_MAT(a.in[I_CW1] + (size_t)(l * 2 + kv) * 2048 * 256, 2048, 256, 256, (const float*)nullptr, wl + W_C1 + (size_t)kv * 256 * 2048 * 2)
            TR_MAT(a.in[I_CW2] + (size_t)(l * 2 + kv) * 256 * 64, 256, 64, 64, (const float*)nullptr, wl + W_C2 + (size_t)kv * 64 * 256 * 2)
        }
    }
#undef TR_MAT
    if constexpr (DO_X) { const float* x = a.in[I_X]; bf16_t* XB = (bf16_t*)(ws + WS_XB);
      for (int r = gw; r < NTOK; r += NGW) { const f32x4* xr = (const f32x4*)(x + (size_t)r * 1024) + lane; f32x4* orow = (f32x4*)(a.out + (size_t)r * 1024) + lane; unsigned long long* xb = (unsigned long long*)(XB + (size_t)r * 1024) + lane; float s = 0.f;
#pragma unroll
          for (int j = 0; j < 4; ++j) { const f32x4 v = xr[64 * j]; orow[64 * j] = v; s += (v[0] * v[0] + v[1] * v[1]) + (v[2] * v[2] + v[3] * v[3]); xb[64 * j] = (unsigned long long)cvt_pk_bf16(v[0], v[1]) | ((unsigned long long)cvt_pk_bf16(v[2], v[3]) << 32); }
          s = wave_sum(s); if (lane == 0) ctl[r] = s; if (lane >= 1 && lane <= 5) ctl[lane * NTOK + r] = 0.f; } }
    if constexpr (DO_X) { const float* mem = a.in[I_MEM]; bf16_t* MB = (bf16_t*)(ws + WS_MEMB);
      for (int r = gw; r < 1024; r += NGW) { const f32x4* xr = (const f32x4*)(mem + (size_t)r * 1024) + lane; unsigned long long* xb = (unsigned long long*)(MB + (size_t)r * 1024) + lane; float s = 0.f;
#pragma unroll
          for (int j = 0; j < 4; ++j) { const f32x4 v = xr[64 * j]; s += (v[0] * v[0] + v[1] * v[1]) + (v[2] * v[2] + v[3] * v[3]); xb[64 * j] = (unsigned long long)cvt_pk_bf16(v[0], v[1]) | ((unsigned long long)cvt_pk_bf16(v[2], v[3]) << 32); }
          s = wave_sum(s); if (lane == 0) ctl[SSQ_MEM_OFF + r] = s; } }
    for (int it = gw; it < 4 * 32; it += NGW) { const int lk = it >> 5, j0 = (it & 31) * 8; const float* W1 = a.in[I_CW1] + (size_t)lk * 2048 * 256 + j0; const float* pos = a.in[I_CPOS] + (size_t)lk * 2048;
        float acc[8];
#pragma unroll
        for (int e = 0; e < 8; ++e) acc[e] = 0.f;
#pragma unroll 8
        for (int i = 0; i < 32; ++i) { const int k = i * 64 + lane; const float p = pos[k]; const f32x4 w0 = *(const f32x4*)(W1 + (size_t)k * 256), w1 = *(const f32x4*)(W1 + (size_t)k * 256 + 4);
#pragma unroll
            for (int e = 0; e < 4; ++e) { acc[e] += p * w0[e]; acc[4 + e] += p * w1[e]; } }
#pragma unroll
        for (int e = 0; e < 8; ++e) acc[e] = wave_sum(acc[e]);
        if (lane == 0) { float* dst = (float*)(ws + WS_W + (lk >> 1) * W_LAYER + W_B1P) + (lk & 1) * 256 + j0;
#pragma unroll
            for (int e = 0; e < 8; ++e) dst[e] = acc[e] + a.in[I_CB1][lk * 256 + j0 + e]; } }
    for (int it = gw; it < 2 * 8 * 128; it += NGW) { const int t = it & 127; const float* wr = a.in[I_SGW] + (size_t)it * 128; unsigned* dst = (unsigned*)(ws + WS_W + (it >> 10) * W_LAYER + W_SG) + (size_t)(it & 1023) * 64 + lane;
        float v[2];
#pragma unroll
        for (int e = 0; e < 2; ++e) { const int p = lane * 2 + e, ks = p >> 4, hh = (p >> 3) & 1, j = p & 7, sidx = 16 * ks + 8 * (j >> 2) + 4 * hh + (j & 3); v[e] = sidx <= t ? wr[sidx] : 0.f; }
        *dst = cvt_pk_bf16(v[0], v[1]); }
}

typedef float f32x16 __attribute__((ext_vector_type(16)));
typedef short s16x4 __attribute__((ext_vector_type(4)));
typedef short v4i16_t __attribute__((ext_vector_type(4)));
using pg8::bf16x8;
__device__ __forceinline__ int crow(int r, int hi) { return (r & 3) + 8 * (r >> 2) + 4 * hi; }
__device__ __forceinline__ s16x4 vtr(const LAS char* p) { return __builtin_bit_cast(s16x4, __builtin_amdgcn_ds_read_tr16_b64_v4i16((LAS v4i16_t*)p)); }
#define MFMA32(a, b, c) __builtin_amdgcn_mfma_f32_32x32x16_bf16(a, b, c, 0, 0, 0)
#define VFRAG(lo, hi) (bf16x8){lo[0], lo[1], lo[2], lo[3], hi[0], hi[1], hi[2], hi[3]}
__device__ __forceinline__ void lds_fadd(LAS float* p, float v) { (void)__hip_atomic_fetch_add(p, v, __ATOMIC_RELAXED, __HIP_MEMORY_SCOPE_WORKGROUP); }
__device__ __forceinline__ unsigned short f2bf(float f) { return (unsigned short)(cvt_pk_bf16(f, 0.f) & 0xffffu); }

__device__ __forceinline__ void tokprep_token(bf16_t* Q, bf16_t* KV, const float* qg, const float* kg, int tok, int lane) {
    { u32x4* p = (u32x4*)(Q + (size_t)tok * 512) + lane; const u32x4 w = *p; float v[8];
#pragma unroll
      for (int i = 0; i < 4; ++i) { v[2 * i] = __uint_as_float(w[i] << 16); v[2 * i + 1] = __uint_as_float(w[i] & 0xffff0000u); }
      float ss = 0.f;
#pragma unroll
      for (int i = 0; i < 8; ++i) ss += v[i] * v[i];
      ss += __shfl_xor(ss, 1); ss += __shfl_xor(ss, 2); ss += __shfl_xor(ss, 4);
      const float rs = rsqrtf(ss * (1.f / 64.f) + 1e-6f) * (0.125f * 1.4426950408889634f); const float* g = qg + (lane & 7) * 8;
      u32x4 o;
#pragma unroll
      for (int i = 0; i < 4; ++i) o[i] = cvt_pk_bf16(v[2 * i] * rs * g[2 * i], v[2 * i + 1] * rs * g[2 * i + 1]);
      *p = o; }
    if (lane < 32) { const int br = 1 + (lane >> 4); u32x4* p = (u32x4*)(KV + (size_t)tok * 768 + br * 256) + (lane & 15); const u32x4 w = *p; float v[8];
#pragma unroll
      for (int i = 0; i < 4; ++i) { v[2 * i] = __uint_as_float(w[i] << 16); v[2 * i + 1] = __uint_as_float(w[i] & 0xffff0000u); }
      float ss = 0.f;
#pragma unroll
      for (int i = 0; i < 8; ++i) ss += v[i] * v[i];
      ss += __shfl_xor(ss, 1); ss += __shfl_xor(ss, 2); ss += __shfl_xor(ss, 4);
      const float rs = rsqrtf(ss * (1.f / 64.f) + 1e-6f); const float* g = kg + br * 64 + (lane & 7) * 8;
      u32x4 o;
#pragma unroll
      for (int i = 0; i < 4; ++i) o[i] = cvt_pk_bf16(v[2 * i] * rs * g[2 * i], v[2 * i + 1] * rs * g[2 * i + 1]);
      *p = o; }
}
__device__ __forceinline__ void cmp2_row(const bf16_t* HID, const bf16_t* w2t, const float* b2, const float* kg0, bf16_t* KC, bf16_t* VC, int row, int lane) {
#pragma unroll 1
    for (int kv = 0; kv < 2; ++kv) { const u32x4* h = (const u32x4*)(HID + (size_t)kv * 2048 * 256 + (size_t)row * 256); const u32x4* w = (const u32x4*)(w2t + (size_t)kv * 64 * 256 + (size_t)lane * 256); float s = b2[kv * 64 + lane];
#pragma unroll 4
        for (int k = 0; k < 32; ++k) { const u32x4 a = h[k], b = w[k];
#pragma unroll
            for (int i = 0; i < 4; ++i) s += __uint_as_float(a[i] << 16) * __uint_as_float(b[i] << 16) + __uint_as_float(a[i] & 0xffff0000u) * __uint_as_float(b[i] & 0xffff0000u); }
        if (kv == 0) { const float ss = wave_sum(s * s); s = s * rsqrtf(ss * (1.f / 64.f) + 1e-6f) * kg0[lane]; }
        if ((row & 255) == 255) s = 0.f;
        (kv ? VC : KC)[(size_t)row * 64 + lane] = f2bf(s); }
}
__device__ __forceinline__ void memk_norm_item(bf16_t* KVM, const float* kg, int r, int lane) {
    unsigned* p = (unsigned*)(KVM + (size_t)(r >> 2) * 1024 + (r & 3) * 128) + lane; const unsigned w = *p; const float v0 = __uint_as_float(w << 16), v1 = __uint_as_float(w & 0xffff0000u);
    const float ss = wave_sum(v0 * v0 + v1 * v1); const float rs = rsqrtf(ss * (1.f / 128.f) + 1e-6f); *p = cvt_pk_bf16(v0 * rs * kg[2 * lane], v1 * rs * kg[2 * lane + 1]);
}

__device__ __forceinline__ void tokprep4(bf16_t* Q, bf16_t* KV, const float* qg, const float* kg, int t, int S, int lane) {
    u32x4 wq[4], wk[4]; const int br = 1 + ((lane >> 4) & 1);
#pragma unroll
    for (int i = 0; i < 4; ++i) { const int tt = t + i * S < NTOK ? t + i * S : NTOK - 1; wq[i] = *((const u32x4*)(Q + (size_t)tt * 512) + lane); wk[i] = *((const u32x4*)(KV + (size_t)tt * 768 + br * 256) + (lane & 15)); }
    f32x4 gq0 = *(const f32x4*)(qg + (lane & 7) * 8), gq1 = *(const f32x4*)(qg + (lane & 7) * 8 + 4), gk0 = *(const f32x4*)(kg + br * 64 + (lane & 7) * 8), gk1 = *(const f32x4*)(kg + br * 64 + (lane & 7) * 8 + 4);
#pragma unroll
    for (int i = 0; i < 4; ++i) { if (t + i * S >= NTOK) break; const int tt = t + i * S;
        { const u32x4 w = wq[i]; float v[8];
#pragma unroll
          for (int e = 0; e < 4; ++e) { v[2 * e] = __uint_as_float(w[e] << 16); v[2 * e + 1] = __uint_as_float(w[e] & 0xffff0000u); }
          float ss = 0.f;
#pragma unroll
          for (int e = 0; e < 8; ++e) ss += v[e] * v[e];
          ss += __shfl_xor(ss, 1); ss += __shfl_xor(ss, 2); ss += __shfl_xor(ss, 4);
          const float rs = rsqrtf(ss * (1.f / 64.f) + 1e-6f) * (0.125f * 1.4426950408889634f);
          u32x4 o; o[0] = cvt_pk_bf16(v[0] * rs * gq0[0], v[1] * rs * gq0[1]); o[1] = cvt_pk_bf16(v[2] * rs * gq0[2], v[3] * rs * gq0[3]); o[2] = cvt_pk_bf16(v[4] * rs * gq1[0], v[5] * rs * gq1[1]); o[3] = cvt_pk_bf16(v[6] * rs * gq1[2], v[7] * rs * gq1[3]);
          *((u32x4*)(Q + (size_t)tt * 512) + lane) = o; }
        { const u32x4 w = wk[i]; float v[8];
#pragma unroll
          for (int e = 0; e < 4; ++e) { v[2 * e] = __uint_as_float(w[e] << 16); v[2 * e + 1] = __uint_as_float(w[e] & 0xffff0000u); }
          float ss = 0.f;
#pragma unroll
          for (int e = 0; e < 8; ++e) ss += v[e] * v[e];
          ss += __shfl_xor(ss, 1); ss += __shfl_xor(ss, 2); ss += __shfl_xor(ss, 4);
          const float rs = rsqrtf(ss * (1.f / 64.f) + 1e-6f);
          u32x4 o; o[0] = cvt_pk_bf16(v[0] * rs * gk0[0], v[1] * rs * gk0[1]); o[1] = cvt_pk_bf16(v[2] * rs * gk0[2], v[3] * rs * gk0[3]); o[2] = cvt_pk_bf16(v[4] * rs * gk1[0], v[5] * rs * gk1[1]); o[3] = cvt_pk_bf16(v[6] * rs * gk1[2], v[7] * rs * gk1[3]);
          if (lane < 32) *((u32x4*)(KV + (size_t)tt * 768 + br * 256) + (lane & 15)) = o; } }
}
__device__ __forceinline__ void cmp2_tile(const bf16_t* HIDt, const bf16_t* w2t, const float* b2, const float* kg0, bf16_t* OUT) {
    int tid_ = threadIdx.x; asm volatile("" : "+v"(tid_)); const int lane = tid_ & 63, wave = __builtin_amdgcn_readfirstlane(tid_ >> 6), r32 = lane & 31, hi = lane >> 5; const int row = wave * 32 + r32;
    f32x16 acc[2];
#pragma unroll
    for (int r = 0; r < 16; ++r) { acc[0][r] = 0.f; acc[1][r] = 0.f; }
#pragma unroll 4
    for (int ks = 0; ks < 16; ++ks) { const bf16x8 bfr = *(const bf16x8*)(HIDt + (size_t)row * 256 + ks * 16 + hi * 8);
        const bf16x8 a0 = *(const bf16x8*)(w2t + (size_t)r32 * 256 + ks * 16 + hi * 8), a1 = *(const bf16x8*)(w2t + (size_t)(32 + r32) * 256 + ks * 16 + hi * 8);
        acc[0] = MFMA32(a0, bfr, acc[0]); acc[1] = MFMA32(a1, bfr, acc[1]); }
    float ss = 0.f;
#pragma unroll
    for (int h = 0; h < 2; ++h)
#pragma unroll
        for (int r = 0; r < 16; ++r) { const float v = acc[h][r] + b2[32 * h + crow(r, hi)]; acc[h][r] = v; ss += v * v; }
    if (kg0) { ss += __shfl_xor(ss, 32); const float rs = rsqrtf(ss * (1.f / 64.f) + 1e-6f);
#pragma unroll
        for (int h = 0; h < 2; ++h)
#pragma unroll
            for (int r = 0; r < 16; ++r) acc[h][r] *= rs * kg0[32 * h + crow(r, hi)]; }
    const float keep = row == 255 ? 0.f : 1.f;
#pragma unroll
    for (int h = 0; h < 2; ++h)
#pragma unroll
        for (int a4 = 0; a4 < 4; ++a4) { u32x2 w; w.x = cvt_pk_bf16(acc[h][4 * a4] * keep, acc[h][4 * a4 + 1] * keep); w.y = cvt_pk_bf16(acc[h][4 * a4 + 2] * keep, acc[h][4 * a4 + 3] * keep); *(u32x2*)(OUT + (size_t)row * 64 + 32 * h + 8 * a4 + 4 * hi) = w; }
}

constexpr int SG_STAT = 0, SG_SSQ = 1024, SG_VN = 2048;
__device__ __forceinline__ void sgu_unit(LAS unsigned char* lds, int unit, const bf16_t* U, const bf16_t* Vb, const bf16_t* Wsg, const float* lng, const float* lnb, const float* sgb, bf16_t* MIX) {
    int tid_ = threadIdx.x; asm volatile("" : "+v"(tid_)); const int tid = tid_, lane = tid & 63, g = __builtin_amdgcn_readfirstlane(tid >> 6), r32 = lane & 31, hi = lane >> 5;
    const int tok0 = unit * 128;
    LAS float* STAT = (LAS float*)(lds + SG_STAT); LAS float* SSQA = (LAS float*)(lds + SG_SSQ);
    { const int tl = tid >> 2, part = tid & 3; const u32x4* p = (const u32x4*)(Vb + (size_t)(tok0 + tl) * 512 + part * 128); float s = 0.f, s2 = 0.f;
#pragma unroll 4
      for (int i = 0; i < 16; ++i) { const u32x4 w = p[i];
#pragma unroll
          for (int e = 0; e < 4; ++e) { const float a = __uint_as_float(w[e] << 16), b = __uint_as_float(w[e] & 0xffff0000u); s += a + b; s2 += a * a + b * b; } }
      s += __shfl_xor(s, 1); s += __shfl_xor(s, 2); s2 += __shfl_xor(s2, 1); s2 += __shfl_xor(s2, 2);
      if (part == 0) { const float mu = s * (1.f / 512.f); const float var = fmaxf(s2 * (1.f / 512.f) - mu * mu, 0.f); STAT[tl * 2] = mu; STAT[tl * 2 + 1] = rsqrtf(var + 1e-6f); }
      if (tid < 128) SSQA[tid] = 0.f; }
    __syncthreads();
    LAS unsigned char* VN = lds + SG_VN + g * 16384;
    { const int piece = lane & 7; float gg[8], bb[8];
#pragma unroll
      for (int i = 0; i < 8; ++i) { gg[i] = lng[g * 64 + piece * 8 + i]; bb[i] = lnb[g * 64 + piece * 8 + i]; }
#pragma unroll 4
      for (int it = 0; it < 16; ++it) { const int row = it * 8 + (lane >> 3); const u32x4 w = *(const u32x4*)(Vb + (size_t)(tok0 + row) * 512 + g * 64 + piece * 8); const float mu = STAT[row * 2], rs = STAT[row * 2 + 1]; u32x4 o;
#pragma unroll
          for (int e = 0; e < 4; ++e) { const float a = (__uint_as_float(w[e] << 16) - mu) * rs * gg[2 * e] + bb[2 * e], b = (__uint_as_float(w[e] & 0xffff0000u) - mu) * rs * gg[2 * e + 1] + bb[2 * e + 1]; o[e] = cvt_pk_bf16(a, b); }
          *(LAS u32x4*)(VN + (piece >> 2) * 8192 + row * 64 + (piece & 3) * 16) = o; } }
    asm volatile("s_waitcnt lgkmcnt(0)" ::: "memory");
    f32x16 acc[2][4];
#pragma unroll
    for (int dh = 0; dh < 2; ++dh)
#pragma unroll
        for (int mt = 0; mt < 4; ++mt)
#pragma unroll
            for (int r = 0; r < 16; ++r) acc[dh][mt][r] = 0.f;
    const LAS char* vb = (const LAS char*)VN + ((lane >> 4) & 1) * 32 + (lane & 3) * 8 + (4 * hi + ((lane & 15) >> 2)) * 64;
    const bf16_t* wrow = Wsg + ((size_t)g * 128 + r32) * 128 + 8 * hi;
#pragma unroll
    for (int ks = 0; ks < 8; ++ks) { bf16x8 vf[2];
#pragma unroll
        for (int dh = 0; dh < 2; ++dh) { const s16x4 lo = vtr(vb + dh * 8192 + ks * 1024), hh = vtr(vb + dh * 8192 + ks * 1024 + 512); vf[dh] = VFRAG(lo, hh); }
#pragma unroll
        for (int mt = 0; mt < 4; ++mt) { if (ks <= 2 * mt + 1) { const bf16x8 wf = *(const bf16x8*)(wrow + (size_t)mt * 32 * 128 + ks * 16);
                acc[0][mt] = MFMA32(vf[0], wf, acc[0][mt]); acc[1][mt] = MFMA32(vf[1], wf, acc[1][mt]); } } }
#pragma unroll
    for (int mt = 0; mt < 4; ++mt) { const int t = mt * 32 + r32; const float bias = sgb[g * 128 + t]; const bf16_t* up = U + (size_t)(tok0 + t) * 512 + g * 64 + 4 * hi; float ss = 0.f;
#pragma unroll
        for (int dh = 0; dh < 2; ++dh)
#pragma unroll
            for (int a4 = 0; a4 < 4; ++a4) { const u32x2 w = *(const u32x2*)(up + dh * 32 + a4 * 8);
                const float u0 = __uint_as_float(w.x << 16), u1 = __uint_as_float(w.x & 0xffff0000u), u2 = __uint_as_float(w.y << 16), u3 = __uint_as_float(w.y & 0xffff0000u);
                float x0 = u0 * (acc[dh][mt][4 * a4] + bias), x1 = u1 * (acc[dh][mt][4 * a4 + 1] + bias), x2 = u2 * (acc[dh][mt][4 * a4 + 2] + bias), x3 = u3 * (acc[dh][mt][4 * a4 + 3] + bias);
                acc[dh][mt][4 * a4] = x0; acc[dh][mt][4 * a4 + 1] = x1; acc[dh][mt][4 * a4 + 2] = x2; acc[dh][mt][4 * a4 + 3] = x3; ss += (x0 * x0 + x1 * x1) + (x2 * x2 + x3 * x3); }
        ss += __shfl_xor(ss, 32); if (hi == 0) lds_fadd(SSQA + t, ss); }
    __syncthreads();
#pragma unroll
    for (int mt = 0; mt < 4; ++mt) { const int t = mt * 32 + r32; const float rs = rsqrtf(SSQA[t] * (1.f / 512.f) + 1e-6f); bf16_t* op = MIX + (size_t)(tok0 + t) * 1024 + g * 64 + 4 * hi;
#pragma unroll
        for (int dh = 0; dh < 2; ++dh)
#pragma unroll
            for (int a4 = 0; a4 < 4; ++a4) { u32x2 w; w.x = cvt_pk_bf16(acc[dh][mt][4 * a4] * rs, acc[dh][mt][4 * a4 + 1] * rs); w.y = cvt_pk_bf16(acc[dh][mt][4 * a4 + 2] * rs, acc[dh][mt][4 * a4 + 3] * rs); *(u32x2*)(op + dh * 32 + a4 * 8) = w; } }
    __syncthreads();
}

constexpr int A_KB = 0, A_VB = 32768, A_IMPH = 65536, A_LINV = 132096, A_MASK = 133120, A_SSQ = 133632;
__device__ __forceinline__ void attn_cmp(LAS unsigned char* lds, const bf16_t* Kb, const bf16_t* Vb, int ntc, const bf16x8 (&qr)[4], f32x16 (&oT)[2], float& lsum,
                                         int kmin, int kmax, int kvh, int wave, int lane, int r32, int hi) {
    const int pitch = 64, hstride = 256 * 64;
    u32x4 sk0, sk1, sv0, sv1;
    const bf16_t* kthr = Kb + (size_t)lane * pitch + wave * 8; const bf16_t* vthr = Vb + (size_t)(16 * (wave & 3) + (lane >> 2)) * pitch + (wave >> 2) * 32 + (lane & 3) * 8;
    const int sdst = wave * 1024 + lane * 16;
#define A_LD(tile) do { const size_t to_ = (size_t)(tile) * 64 * pitch; sk0 = *(const u32x4*)(kthr + to_); sk1 = *(const u32x4*)(kthr + to_ + hstride); sv0 = *(const u32x4*)(vthr + to_); sv1 = *(const u32x4*)(vthr + to_ + hstride); } while (0)
#define A_ST(so) do { *(LAS u32x4*)(lds + A_KB + (so) + sdst) = sk0; *(LAS u32x4*)(lds + A_KB + (so) + 8192 + sdst) = sk1; *(LAS u32x4*)(lds + A_VB + (so) + sdst) = sv0; *(LAS u32x4*)(lds + A_VB + (so) + 8192 + sdst) = sv1; } while (0)
    const LAS char* kbase = (const LAS char*)(lds + A_KB) + kvh * 8192 + hi * 1024 + r32 * 16;
    const LAS char* vbase = (const LAS char*)(lds + A_VB) + kvh * 8192 + ((lane >> 4) & 1) * 32 + (lane & 3) * 8 + (4 * hi + ((lane & 15) >> 2)) * 64;
    LAS float* IMPH = (LAS float*)(lds + A_IMPH) + (wave * 32 + r32) * 65;
    float carry = 0.f;
    A_LD(0); A_ST(0); __syncthreads();
#pragma unroll 1
    for (int tile = 0; tile < ntc; ++tile) {
        const int so = (tile & 1) * 16384;
        if (tile + 1 < ntc) A_LD(tile + 1);
        bf16x8 kf[8];
#pragma unroll
        for (int d0 = 0; d0 < 4; ++d0) { kf[2 * d0] = *(const LAS bf16x8*)(kbase + so + d0 * 2048); kf[2 * d0 + 1] = *(const LAS bf16x8*)(kbase + so + d0 * 2048 + 512); }
        f32x16 p0, p1;
#pragma unroll
        for (int r = 0; r < 16; ++r) { p0[r] = 0.f; p1[r] = 0.f; }
#pragma unroll
        for (int d0 = 0; d0 < 4; ++d0) { p0 = MFMA32(kf[2 * d0], qr[d0], p0); p1 = MFMA32(kf[2 * d0 + 1], qr[d0], p1); }
        const int a = kmin - 64 * tile, bb = kmax - 64 * tile;
#pragma unroll
        for (int r = 0; r < 16; ++r) { p0[r] = __builtin_amdgcn_exp2f(p0[r]); p1[r] = __builtin_amdgcn_exp2f(p1[r]); }
        if (!__all(a <= 0 && bb >= 63)) { const unsigned span = (unsigned)(bb - a);
#pragma unroll
            for (int r = 0; r < 16; ++r) { const int rel = crow(r, hi); p0[r] = ((unsigned)(rel - a) <= span) ? p0[r] : 0.f; p1[r] = ((unsigned)(rel + 32 - a) <= span) ? p1[r] : 0.f; } }
        { float s = 0.f;
#pragma unroll
          for (int r = 0; r < 16; ++r) s += p0[r] + p1[r];
          lsum += s; }
        { float own[2][4], rcv[2][4];
#pragma unroll
          for (int a4 = 0; a4 < 4; ++a4) { const float h0 = 0.5f * p0[4 * a4 + 3], h1 = 0.5f * p1[4 * a4 + 3];
              own[0][a4] = (p0[4 * a4] + p0[4 * a4 + 1]) + (p0[4 * a4 + 2] + h0); own[1][a4] = (p1[4 * a4] + p1[4 * a4 + 1]) + (p1[4 * a4 + 2] + h1);
              rcv[0][a4] = __shfl_xor(h0, 32); rcv[1][a4] = __shfl_xor(h1, 32); }
#pragma unroll
          for (int h2 = 0; h2 < 2; ++h2)
#pragma unroll
              for (int a4 = 0; a4 < 4; ++a4) { const float fromprev = a4 > 0 ? rcv[h2][a4 - 1] : (h2 ? rcv[0][3] : carry);
                  IMPH[16 * tile + 8 * h2 + 2 * a4 + hi] = own[h2][a4] + (hi ? rcv[h2][a4] : fromprev); }
          carry = rcv[1][3]; }
        bf16x8 pa[4];
        { u32x4 w0, w1, w2, w3;
#pragma unroll
          for (int i = 0; i < 4; ++i) { w0[i] = cvt_pk_bf16(p0[2 * i], p0[2 * i + 1]); w1[i] = cvt_pk_bf16(p0[8 + 2 * i], p0[8 + 2 * i + 1]); w2[i] = cvt_pk_bf16(p1[2 * i], p1[2 * i + 1]); w3[i] = cvt_pk_bf16(p1[8 + 2 * i], p1[8 + 2 * i + 1]); }
          pa[0] = __builtin_bit_cast(bf16x8, w0); pa[1] = __builtin_bit_cast(bf16x8, w1); pa[2] = __builtin_bit_cast(bf16x8, w2); pa[3] = __builtin_bit_cast(bf16x8, w3); }
#pragma unroll
        for (int dh = 0; dh < 2; ++dh)
#pragma unroll
            for (int ks = 0; ks < 4; ++ks) { const s16x4 lo = vtr(vbase + so + dh * 4096 + ks * 1024), hh = vtr(vbase + so + dh * 4096 + ks * 1024 + 512); oT[dh] = MFMA32(VFRAG(lo, hh), pa[ks], oT[dh]); }
        if (tile + 1 < ntc) A_ST(so ^ 16384);
        __syncthreads();
    }
#undef A_LD
#undef A_ST
}

constexpr int A2_K = 0, A2_V = 49152, A2_SL = 16384;
#define SBAR() __builtin_amdgcn_sched_barrier(0)
#define PIN(x) asm volatile("" : "+v"(x))
#define WAIT_BAR(N) asm volatile("s_waitcnt vmcnt(" #N ") lgkmcnt(0)\n\ts_barrier" ::: "memory")
__device__ __forceinline__ void glds16(const void* g, unsigned lds_base) {
    unsigned sv; asm volatile("s_mov_b32 %0, m0\n\ts_mov_b32 m0, %2\n\ts_nop 0\n\tglobal_load_lds_dwordx4 %1, off\n\ts_mov_b32 m0, %0" : "=&s"(sv) : "v"(g), "s"(lds_base) : "memory"); }
__device__ __forceinline__ void range_mask(f32x16& c0, f32x16& c1, int a, int bb, int hi) {
    const unsigned span = (unsigned)(bb - a);
#pragma unroll
    for (int r = 0; r < 16; ++r) { const int rel = crow(r, hi); c0[r] = ((unsigned)(rel - a) <= span) ? c0[r] : -INFINITY; c1[r] = ((unsigned)(rel + 32 - a) <= span) ? c1[r] : -INFINITY; }
}
template <bool WIN>
__device__ __forceinline__ void attn_stream(LAS unsigned char* lds, const bf16_t* Kb, const bf16_t* Vb, int tlo, int NT, const bf16x8 (&qr)[4], f32x16 (&oT)[2], float& l_out,
                                            unsigned mlo, unsigned mhi, int tq, int kvh, int wave, int lane, int r32, int hi) {
    const unsigned lds0 = (unsigned)(uintptr_t)lds;
    const bf16_t* ksrc = Kb + (size_t)lane * 768 + wave * 8;
    const bf16_t* vsrc = Vb + (size_t)(16 * (wave & 3) + (lane >> 2)) * 768 + (wave >> 2) * 32 + (lane & 3) * 8;
    const unsigned kdst = lds0 + A2_K + wave * 1024, vdst = lds0 + A2_V + wave * 1024;
#define RFL(x) ((unsigned)__builtin_amdgcn_readfirstlane((int)(x)))
#define TCL(i) ((size_t)(tlo + ((i) < NT ? (i) : NT - 1)) * (64 * 768))
#define DMA_K(i, slot) do { const bf16_t* s_ = ksrc + TCL(i); glds16(s_, RFL(kdst + (slot))); glds16(s_ + 64, RFL(kdst + (slot) + 8192)); } while (0)
#define DMA_V(i, slot) do { const bf16_t* s_ = vsrc + TCL(i); glds16(s_, RFL(vdst + (slot))); glds16(s_ + 64, RFL(vdst + (slot) + 8192)); } while (0)
#define TMASK(idx_, a_, bb_, selm_) do { const int tt_ = tlo + (idx_); if (WIN) { a_ = tq - 511 - 64 * tt_; bb_ = tq - 64 * tt_; selm_ = ~0u; } \
        else { const unsigned s_ = tt_ < 32 ? (mlo >> tt_) & 1u : (mhi >> (tt_ - 32)) & 1u; a_ = -64 * tt_; bb_ = tq - 64 * tt_; selm_ = 0u - s_; } } while (0)
#define NEEDM(a_, bb_, selm_) (!__all((selm_) == 0u || ((a_) <= 0 && (bb_) >= 63)))
    const LAS char* kp0 = (const LAS char*)(lds + A2_K) + kvh * 8192 + hi * 1024 + r32 * 16;
    const LAS char* vp0 = (const LAS char*)(lds + A2_V) + kvh * 8192 + ((lane >> 4) & 1) * 32 + (lane & 3) * 8 + (4 * hi + ((lane & 15) >> 2)) * 64;
    asm volatile("s_waitcnt vmcnt(0)" ::: "memory");
    DMA_K(0, 0); DMA_V(0, 0); DMA_K(1, A2_SL); DMA_K(2, 2 * A2_SL);
    float l_reg = 0.f; f32x16 pA0, pA1, pB0, pB1; bf16x8 kf[8]; s16x4 vlo[8], vhi[8]; u32x4 pw0, pw1, pw2, pw3; unsigned selm_prev;
    const f32x16 zero16 = {0.f, 0.f, 0.f, 0.f, 0.f, 0.f, 0.f, 0.f, 0.f, 0.f, 0.f, 0.f, 0.f, 0.f, 0.f, 0.f};
    int sl_prev = 0, sl_cur = 0, sl_next = A2_SL;
#define ROT() do { sl_prev = sl_cur; sl_cur = sl_next; sl_next = (sl_next == 2 * A2_SL) ? 0 : sl_next + A2_SL; } while (0)
#define KLD(kp, d0) do { kf[2 * (d0)] = *(const LAS bf16x8*)((kp) + (d0) * 2048); kf[2 * (d0) + 1] = *(const LAS bf16x8*)((kp) + (d0) * 2048 + 512); } while (0)
    WAIT_BAR(6);
    KLD(kp0, 0); KLD(kp0, 1); KLD(kp0, 2); KLD(kp0, 3);
    pA0 = MFMA32(kf[0], qr[0], zero16); pA1 = MFMA32(kf[1], qr[0], zero16); pA0 = MFMA32(kf[2], qr[1], pA0); pA1 = MFMA32(kf[3], qr[1], pA1);
    pA0 = MFMA32(kf[4], qr[2], pA0); pA1 = MFMA32(kf[5], qr[2], pA1); pA0 = MFMA32(kf[6], qr[3], pA0); pA1 = MFMA32(kf[7], qr[3], pA1);
    { int a_, bb_; TMASK(0, a_, bb_, selm_prev); if (NEEDM(a_, bb_, selm_prev)) range_mask(pA0, pA1, a_, bb_, hi); }
#pragma unroll
    for (int r = 0; r < 16; ++r) { pA0[r] = __builtin_amdgcn_exp2f(pA0[r]); pA1[r] = __builtin_amdgcn_exp2f(pA1[r]); }
    WAIT_BAR(0);
    DMA_K(3, 0); DMA_V(1, A2_SL); ROT();
    KLD(kp0 + sl_cur, 0); KLD(kp0 + sl_cur, 1); KLD(kp0 + sl_cur, 2); KLD(kp0 + sl_cur, 3);
    WAIT_BAR(4);
#define PKW(P, i) cvt_pk_bf16(P[i], P[(i) + 1])
#define PAF(k) __builtin_bit_cast(bf16x8, pw##k)
#define VFR(i) VFRAG(vlo[i], vhi[i])
#define VRD(i) do { vlo[i] = vtr(vp_ + (((i) >> 2) * 4096 + ((i) & 3) * 1024)); vhi[i] = vtr(vp_ + (((i) >> 2) * 4096 + ((i) & 3) * 1024 + 512)); } while (0)
#define KRD(d0) do { KLD(kp0 + sl_next, d0); SBAR(); } while (0)
#define EX(v) __builtin_amdgcn_exp2f(v)
#define GAPA(MF, a0, a1, a2, a3, W0, W1, PW) do { MF; sacc += a0; sacc += a1; sacc += a2; sacc += a3; W0; W1; PIN(PW); PIN(sacc); SBAR(); } while (0)
#define GAPB(MF, X, i) do { MF; X[i] = EX(X[i]); X[(i) + 1] = EX(X[(i) + 1]); X[(i) + 2] = EX(X[(i) + 2]); X[(i) + 3] = EX(X[(i) + 3]); PIN(X); SBAR(); } while (0)
#define SELPW() do { if (!__all(selm_prev == ~0u)) { const u32x4 m_ = {selm_prev, selm_prev, selm_prev, selm_prev}; pw0 = pw0 & m_; pw1 = pw1 & m_; pw2 = pw2 & m_; pw3 = pw3 & m_; } } while (0)
#define STEP(C0, C1, P0, P1, idx) do { SBAR(); \
    const LAS char* vp_ = vp0 + sl_prev; \
    VRD(0); SBAR(); float sacc = P0[0] + P0[1]; \
                    GAPA(C0 = MFMA32(kf[0], qr[0], zero16), P0[2], P0[3], P0[4], P0[5],     pw0[0] = PKW(P0, 0),  pw0[1] = PKW(P0, 2),  pw0); \
    VRD(4); SBAR(); GAPA(C1 = MFMA32(kf[1], qr[0], zero16), P0[6], P0[7], P0[8], P0[9],     pw0[2] = PKW(P0, 4),  pw0[3] = PKW(P0, 6),  pw0); \
    VRD(1); SBAR(); GAPA(C0 = MFMA32(kf[2], qr[1], C0),     P0[10], P0[11], P0[12], P0[13], pw1[0] = PKW(P0, 8),  pw1[1] = PKW(P0, 10), pw1); \
    VRD(5); SBAR(); GAPA(C1 = MFMA32(kf[3], qr[1], C1),     P0[14], P0[15], P1[0], P1[1],   pw1[2] = PKW(P0, 12), pw1[3] = PKW(P0, 14), pw1); \
    VRD(2); SBAR(); GAPA(C0 = MFMA32(kf[4], qr[2], C0),     P1[2], P1[3], P1[4], P1[5],     pw2[0] = PKW(P1, 0),  pw2[1] = PKW(P1, 2),  pw2); \
    VRD(6); SBAR(); GAPA(C1 = MFMA32(kf[5], qr[2], C1),     P1[6], P1[7], P1[8], P1[9],     pw2[2] = PKW(P1, 4),  pw2[3] = PKW(P1, 6),  pw2); \
    VRD(3); SBAR(); GAPA(C0 = MFMA32(kf[6], qr[3], C0),     P1[10], P1[11], P1[12], P1[13], pw3[0] = PKW(P1, 8),  pw3[1] = PKW(P1, 10), pw3); \
    VRD(7); SBAR(); GAPA(C1 = MFMA32(kf[7], qr[3], C1),     P1[14], P1[15], 0.f, 0.f,       pw3[2] = PKW(P1, 12), pw3[3] = PKW(P1, 14), pw3); \
    l_reg += __uint_as_float(__float_as_uint(sacc) & selm_prev); SELPW(); \
    DMA_K((idx) + 3, sl_cur); DMA_V((idx) + 1, sl_next); \
    { int a_, bb_; unsigned selm_; TMASK(idx, a_, bb_, selm_); if (NEEDM(a_, bb_, selm_)) range_mask(C0, C1, a_, bb_, hi); selm_prev = selm_; } \
    SBAR(); \
    GAPB(oT[0] = MFMA32(VFR(0), PAF(0), oT[0]), C0, 0);            GAPB(oT[1] = MFMA32(VFR(4), PAF(0), oT[1]), C0, 4); \
    KRD(0); GAPB(oT[0] = MFMA32(VFR(1), PAF(1), oT[0]), C0, 8);    KRD(1); GAPB(oT[1] = MFMA32(VFR(5), PAF(1), oT[1]), C0, 12); \
    KRD(2); GAPB(oT[0] = MFMA32(VFR(2), PAF(2), oT[0]), C1, 0);    KRD(3); GAPB(oT[1] = MFMA32(VFR(6), PAF(2), oT[1]), C1, 4); \
    GAPB(oT[0] = MFMA32(VFR(3), PAF(3), oT[0]), C1, 8);            GAPB(oT[1] = MFMA32(VFR(7), PAF(3), oT[1]), C1, 12); \
    } while (0)
    int idx = 1;
#pragma unroll 1
    for (; idx + 1 < NT; idx += 2) {
        STEP(pB0, pB1, pA0, pA1, idx);     WAIT_BAR(4); ROT();
        STEP(pA0, pA1, pB0, pB1, idx + 1); WAIT_BAR(4); ROT();
    }
    if (idx < NT) { STEP(pB0, pB1, pA0, pA1, idx); WAIT_BAR(4); ROT(); pA0 = pB0; pA1 = pB1; }
    { float sacc = 0.f;
#pragma unroll
      for (int r = 0; r < 16; ++r) sacc += pA0[r] + pA1[r];
      l_reg += __uint_as_float(__float_as_uint(sacc) & selm_prev);
      pw0 = (u32x4){PKW(pA0, 0), PKW(pA0, 2), PKW(pA0, 4), PKW(pA0, 6)}; pw1 = (u32x4){PKW(pA0, 8), PKW(pA0, 10), PKW(pA0, 12), PKW(pA0, 14)};
      pw2 = (u32x4){PKW(pA1, 0), PKW(pA1, 2), PKW(pA1, 4), PKW(pA1, 6)}; pw3 = (u32x4){PKW(pA1, 8), PKW(pA1, 10), PKW(pA1, 12), PKW(pA1, 14)};
      SELPW();
      const LAS char* vp_ = vp0 + ((NT - 1) % 3) * A2_SL;
#pragma unroll
      for (int i = 0; i < 8; ++i) VRD(i);
      oT[0] = MFMA32(VFR(0), PAF(0), oT[0]); oT[1] = MFMA32(VFR(4), PAF(0), oT[1]); oT[0] = MFMA32(VFR(1), PAF(1), oT[0]); oT[1] = MFMA32(VFR(5), PAF(1), oT[1]);
      oT[0] = MFMA32(VFR(2), PAF(2), oT[0]); oT[1] = MFMA32(VFR(6), PAF(2), oT[1]); oT[0] = MFMA32(VFR(3), PAF(3), oT[0]); oT[1] = MFMA32(VFR(7), PAF(3), oT[1]); }
    WAIT_BAR(0);
    l_out = l_reg;
#undef RFL
#undef TCL
#undef DMA_K
#undef DMA_V
#undef TMASK
#undef NEEDM
#undef ROT
#undef KLD
#undef PKW
#undef PAF
#undef VFR
#undef VRD
#undef KRD
#undef EX
#undef GAPA
#undef GAPB
#undef SELPW
#undef STEP
}

template <int PARTS>
__device__ __forceinline__ void attn_unit(LAS unsigned char* lds, int b, int qt, const bf16_t* Q, const bf16_t* KV, const bf16_t* KC, const bf16_t* VC, const float* GL, bf16_t* MIX) {
    int tid_ = threadIdx.x; asm volatile("" : "+v"(tid_)); const int tid = tid_, lane = tid & 63, wave = __builtin_amdgcn_readfirstlane(tid >> 6), r32 = lane & 31, hi = lane >> 5, kvh = wave >> 2;
    const int t0 = qt * 32, tq = t0 + r32; const size_t tok = (size_t)b * T + tq;
    bf16x8 qr[4];
#pragma unroll
    for (int d0 = 0; d0 < 4; ++d0) qr[d0] = *(const bf16x8*)(Q + tok * 512 + wave * 64 + d0 * 16 + hi * 8);
    LAS float* IMPHA = (LAS float*)(lds + A_IMPH); LAS float* LINV = (LAS float*)(lds + A_LINV); LAS unsigned* MASKL = (LAS unsigned*)(lds + A_MASK); LAS float* SSQL = (LAS float*)(lds + A_SSQ);
    if (tid < 32) SSQL[tid] = 0.f;
    const float* glp = GL + tok * 24 + wave * 3;
    const float g0 = 1.f / (1.f + __expf(-glp[0])), g1 = 1.f / (1.f + __expf(-glp[1])), g2 = 1.f / (1.f + __expf(-glp[2]));
    f32x16 tot[2], oT[2];
    const int nvalid = tq >= 31 ? (tq - 31) / 16 + 1 : 0; const int ntc = (2 * qt + 1 + 63) >> 6;
    const int ckmin = nvalid > 0 ? 0 : (1 << 20), ckmax = nvalid > 0 ? nvalid - 1 : (1 << 20);
    const bf16_t* KCb = KC + (size_t)(b * 2) * 256 * 64; const bf16_t* VCb = VC + (size_t)(b * 2) * 256 * 64;
    float lc = 0.f;
#pragma unroll
    for (int r = 0; r < 16; ++r) { oT[0][r] = 0.f; oT[1][r] = 0.f; }
    if constexpr (PARTS & 1) attn_cmp(lds, KCb, VCb, ntc, qr, oT, lc, ckmin, ckmax, kvh, wave, lane, r32, hi);
    lc += __shfl_xor(lc, 32); const float inv_lc = lc > 0.f ? 1.f / lc : 0.f;
    if (hi == 0) LINV[wave * 32 + r32] = inv_lc;
    { const float c = g0 * inv_lc;
#pragma unroll
      for (int r = 0; r < 16; ++r) { tot[0][r] = oT[0][r] * c; tot[1][r] = oT[1][r] * c; oT[0][r] = 0.f; oT[1][r] = 0.f; } }
    __syncthreads();
    if constexpr (PARTS & 2) {
#pragma unroll 1
      for (int i = 0; i < 8; ++i) { const int pair = wave * 8 + i, kvp = pair >> 5, qq = pair & 31, j = lane; const int tb = (t0 + qq) >> 6; float v = 0.f;
#pragma unroll
          for (int g = 0; g < 4; ++g) v += IMPHA[((kvp * 4 + g) * 32 + qq) * 65 + j] * LINV[(kvp * 4 + g) * 32 + qq];
          const bool forced = (j == 0) || (j == tb) || (j == tb - 1); const float val = forced ? 1e4f : (j <= tb ? v : -1e4f);
          unsigned key = __float_as_uint(val); key ^= (key & 0x80000000u) ? 0xffffffffu : 0x80000000u; key = (key & ~63u) | (unsigned)(63 - j);
          unsigned prefix = 0u;
#pragma unroll
          for (int bit = 31; bit >= 0; --bit) { const unsigned tt = prefix | (1u << bit); const int cnt = __popcll(__ballot(key >= tt)); prefix = cnt >= 16 ? tt : prefix; }
          const unsigned long long m = __ballot(key >= prefix);
          if (lane == 0) { MASKL[pair * 2] = (unsigned)m; MASKL[pair * 2 + 1] = (unsigned)(m >> 32); } } }
    __syncthreads();
    const unsigned mlo = MASKL[(kvh * 32 + r32) * 2], mhi = MASKL[(kvh * 32 + r32) * 2 + 1];
    const int jmax = (t0 + 31) >> 6;
    const bf16_t* KVb = KV + (size_t)b * T * 768;
    unsigned totp[16];
#pragma unroll
    for (int i = 0; i < 8; ++i) { totp[i] = cvt_pk_bf16(tot[0][2 * i], tot[0][2 * i + 1]); totp[8 + i] = cvt_pk_bf16(tot[1][2 * i], tot[1][2 * i + 1]); }
    float ls = 0.f;
    if constexpr (PARTS & 4) attn_stream<false>(lds, KVb + 256, KVb + 384, 0, jmax + 1, qr, oT, ls, mlo, mhi, tq, kvh, wave, lane, r32, hi);
    ls += __shfl_xor(ls, 32);
    { const float c = ls > 0.f ? g1 / ls : 0.f;
#pragma unroll
      for (int i = 0; i < 8; ++i) { totp[i] = cvt_pk_bf16(__uint_as_float(totp[i] << 16) + oT[0][2 * i] * c, __uint_as_float(totp[i] & 0xffff0000u) + oT[0][2 * i + 1] * c);
                                    totp[8 + i] = cvt_pk_bf16(__uint_as_float(totp[8 + i] << 16) + oT[1][2 * i] * c, __uint_as_float(totp[8 + i] & 0xffff0000u) + oT[1][2 * i + 1] * c); }
#pragma unroll
      for (int r = 0; r < 16; ++r) { oT[0][r] = 0.f; oT[1][r] = 0.f; } }
    float lw = 0.f; const int jlo = t0 >= 511 ? (t0 - 511) >> 6 : 0;
    if constexpr (PARTS & 8) attn_stream<true>(lds, KVb + 512, KVb + 640, jlo, jmax - jlo + 1, qr, oT, lw, 0u, 0u, tq, kvh, wave, lane, r32, hi);
    lw += __shfl_xor(lw, 32);
    { const float c = lw > 0.f ? g2 / lw : 0.f;
#pragma unroll
      for (int i = 0; i < 8; ++i) { tot[0][2 * i] = __uint_as_float(totp[i] << 16) + oT[0][2 * i] * c; tot[0][2 * i + 1] = __uint_as_float(totp[i] & 0xffff0000u) + oT[0][2 * i + 1] * c;
                                    tot[1][2 * i] = __uint_as_float(totp[8 + i] << 16) + oT[1][2 * i] * c; tot[1][2 * i + 1] = __uint_as_float(totp[8 + i] & 0xffff0000u) + oT[1][2 * i + 1] * c; } }
    { float ss = 0.f;
#pragma unroll
      for (int r = 0; r < 16; ++r) ss += tot[0][r] * tot[0][r] + tot[1][r] * tot[1][r];
      ss += __shfl_xor(ss, 32); if (hi == 0) lds_fadd(SSQL + r32, ss); }
    __syncthreads();
    { const float rs = rsqrtf(SSQL[r32] * (1.f / 512.f) + 1e-6f); bf16_t* op = MIX + tok * 1024 + 512 + wave * 64 + 4 * hi;
#pragma unroll
      for (int dh = 0; dh < 2; ++dh)
#pragma unroll
          for (int a4 = 0; a4 < 4; ++a4) { u32x2 w; w.x = cvt_pk_bf16(tot[dh][4 * a4] * rs, tot[dh][4 * a4 + 1] * rs); w.y = cvt_pk_bf16(tot[dh][4 * a4 + 2] * rs, tot[dh][4 * a4 + 3] * rs); *(u32x2*)(op + dh * 32 + a4 * 8) = w; } }
    __syncthreads();
}

__device__ __forceinline__ void memattn_unit(LAS unsigned char* lds, int b, int h, int qt, const bf16_t* QM, const bf16_t* KVM, const float* qg, bf16_t* OM) {
    int tid_ = threadIdx.x; asm volatile("" : "+v"(tid_)); const int tid = tid_, lane = tid & 63, wave = __builtin_amdgcn_readfirstlane(tid >> 6), r32 = lane & 31, hi = lane >> 5;
    const size_t tok = (size_t)b * T + qt * 256 + wave * 32 + r32;
    bf16x8 qr[8];
    { float v[64]; float ss = 0.f;
#pragma unroll
      for (int d0 = 0; d0 < 8; ++d0) { const u32x4 w = *(const u32x4*)(QM + tok * 512 + h * 128 + d0 * 16 + hi * 8);
#pragma unroll
          for (int i = 0; i < 4; ++i) { const float a = __uint_as_float(w[i] << 16), c = __uint_as_float(w[i] & 0xffff0000u); v[d0 * 8 + 2 * i] = a; v[d0 * 8 + 2 * i + 1] = c; ss += a * a + c * c; } }
      ss += __shfl_xor(ss, 32); const float rs = rsqrtf(ss * (1.f / 128.f) + 1e-6f) * (0.08838834764831845f * 1.4426950408889634f);
#pragma unroll
      for (int d0 = 0; d0 < 8; ++d0) { u32x4 w; const float* gp = qg + d0 * 16 + hi * 8;
#pragma unroll
          for (int i = 0; i < 4; ++i) w[i] = cvt_pk_bf16(v[d0 * 8 + 2 * i] * rs * gp[2 * i], v[d0 * 8 + 2 * i + 1] * rs * gp[2 * i + 1]);
          qr[d0] = __builtin_bit_cast(bf16x8, w); } }
    const bf16_t* Kg = KVM + (size_t)b * 256 * 1024 + h * 128; const bf16_t* Vg = Kg + 512;
    u32x4 sk[2], sv[2];
#define M_LD(tile) do { _Pragma("unroll") for (int i = 0; i < 2; ++i) { sk[i] = *(const u32x4*)(Kg + (size_t)((tile) * 64 + lane) * 1024 + (wave * 2 + i) * 8); const int p = i * 512 + tid; \
        sv[i] = *(const u32x4*)(Vg + (size_t)((tile) * 64 + ((p & 255) >> 2)) * 1024 + (p >> 8) * 32 + (p & 3) * 8); } } while (0)
#define M_ST(so) do { _Pragma("unroll") for (int i = 0; i < 2; ++i) { *(LAS u32x4*)(lds + (so) + (wave * 2 + i) * 1024 + lane * 16) = sk[i]; *(LAS u32x4*)(lds + 32768 + (so) + (i * 512 + tid) * 16) = sv[i]; } } while (0)
    const LAS char* kbase = (const LAS char*)lds + hi * 1024 + r32 * 16;
    const LAS char* vbase = (const LAS char*)lds + 32768 + ((lane >> 4) & 1) * 32 + (lane & 3) * 8 + (4 * hi + ((lane & 15) >> 2)) * 64;
    f32x16 oT[4]; float lsum = 0.f;
#pragma unroll
    for (int dq = 0; dq < 4; ++dq)
#pragma unroll
        for (int r = 0; r < 16; ++r) oT[dq][r] = 0.f;
    M_LD(0); M_ST(0); __syncthreads();
#pragma unroll 1
    for (int tile = 0; tile < 4; ++tile) { const int so = (tile & 1) * 16384;
        if (tile < 3) M_LD(tile + 1);
        f32x16 p0, p1;
#pragma unroll
        for (int r = 0; r < 16; ++r) { p0[r] = 0.f; p1[r] = 0.f; }
#pragma unroll
        for (int d0 = 0; d0 < 8; ++d0) { const bf16x8 k0 = *(const LAS bf16x8*)(kbase + so + d0 * 2048), k1 = *(const LAS bf16x8*)(kbase + so + d0 * 2048 + 512); p0 = MFMA32(k0, qr[d0], p0); p1 = MFMA32(k1, qr[d0], p1); }
        float s = 0.f;
#pragma unroll
        for (int r = 0; r < 16; ++r) { p0[r] = __builtin_amdgcn_exp2f(p0[r]); p1[r] = __builtin_amdgcn_exp2f(p1[r]); s += p0[r] + p1[r]; }
        lsum += s;
        bf16x8 pa[4];
        { u32x4 w0, w1, w2, w3;
#pragma unroll
          for (int i = 0; i < 4; ++i) { w0[i] = cvt_pk_bf16(p0[2 * i], p0[2 * i + 1]); w1[i] = cvt_pk_bf16(p0[8 + 2 * i], p0[8 + 2 * i + 1]); w2[i] = cvt_pk_bf16(p1[2 * i], p1[2 * i + 1]); w3[i] = cvt_pk_bf16(p1[8 + 2 * i], p1[8 + 2 * i + 1]); }
          pa[0] = __builtin_bit_cast(bf16x8, w0); pa[1] = __builtin_bit_cast(bf16x8, w1); pa[2] = __builtin_bit_cast(bf16x8, w2); pa[3] = __builtin_bit_cast(bf16x8, w3); }
#pragma unroll
        for (int dq = 0; dq < 4; ++dq)
#pragma unroll
            for (int ks = 0; ks < 4; ++ks) { const s16x4 lo = vtr(vbase + so + dq * 4096 + ks * 1024), hh = vtr(vbase + so + dq * 4096 + ks * 1024 + 512); oT[dq] = MFMA32(VFRAG(lo, hh), pa[ks], oT[dq]); }
        if (tile < 3) M_ST(so ^ 16384);
        __syncthreads();
    }
#undef M_LD
#undef M_ST
    lsum += __shfl_xor(lsum, 32); const float il = 1.f / lsum; bf16_t* op = OM + tok * 512 + h * 128 + 4 * hi;
#pragma unroll
    for (int dq = 0; dq < 4; ++dq)
#pragma unroll
        for (int a4 = 0; a4 < 4; ++a4) { u32x2 w; w.x = cvt_pk_bf16(oT[dq][4 * a4] * il, oT[dq][4 * a4 + 1] * il); w.y = cvt_pk_bf16(oT[dq][4 * a4 + 2] * il, oT[dq][4 * a4 + 3] * il); *(u32x2*)(op + dq * 32 + a4 * 8) = w; }
}

#define XB_TMO      128
#define XB_XCNT(j)  (256  + 64 * (j))
#define XB_XSUB(j)  (1280 + 64 * (j))
#define XB_XGEN(j)  (2304 + 64 * (j))
#define XB_TOP      3328
#define XB_TOPGEN   3392
#define XCD_BAR_WORDS 3456
#define XB_SPIN_CAP (1u << 18)
__device__ __forceinline__ unsigned xb_ld(unsigned* p)              { return __hip_atomic_load(p, __ATOMIC_RELAXED, __HIP_MEMORY_SCOPE_AGENT); }
__device__ __forceinline__ unsigned xb_add(unsigned* p, unsigned v) { return __hip_atomic_fetch_add(p, v, __ATOMIC_RELAXED, __HIP_MEMORY_SCOPE_AGENT); }
__device__ __forceinline__ unsigned xb_xcc_id() { return (unsigned)__builtin_amdgcn_s_getreg((3 << 11) | 20) & 0xFu; }
#define XB_SPIN(cond, bar) do { unsigned _sp = 0; while (cond) { __builtin_amdgcn_s_sleep(1); \
    if ((++_sp & 255u) == 0u) { if (xb_ld(&(bar)[XB_TMO])) break; if (_sp > XB_SPIN_CAP) { atomicAdd(&(bar)[XB_TMO], 1u); break; } } } } while (0)
struct XcdBarrier { unsigned* bar; unsigned x; volatile LAS unsigned* st; };
__device__ __forceinline__ XcdBarrier xcd_barrier_post(unsigned* bar, volatile LAS unsigned* st) {
    XcdBarrier b; b.bar = bar; b.x = xb_xcc_id(); b.st = st;
    if (threadIdx.x == 0) (void)xb_add(&bar[XB_XCNT(b.x)], 1u);
    return b;
}
__device__ __forceinline__ void xcd_barrier_complete(unsigned* bar, unsigned x, unsigned& nloc, unsigned& nx) {
    const unsigned G = gridDim.x * gridDim.y * gridDim.z;
    unsigned sum, cnt, mine, sp = 0u;
    for (;;) {
        sum = 0u; cnt = 0u; mine = 0u;
#pragma unroll
        for (unsigned j = 0; j < 16; ++j) { const unsigned c = xb_ld(&bar[XB_XCNT(j)]); sum += c; cnt += (c > 0u) ? 1u : 0u; mine = (j == x) ? c : mine; }
        if (sum == G) break;
        __builtin_amdgcn_s_sleep(1);
        if ((++sp & 255u) == 0u) { if (xb_ld(&bar[XB_TMO])) break; if (sp > XB_SPIN_CAP) { atomicAdd(&bar[XB_TMO], 1u); break; } }
    }
    nloc = mine > 0u ? mine : 1u; nx = cnt > 0u ? cnt : 1u;
}
__device__ __forceinline__ void xcd_barrier(const XcdBarrier& b) {
    asm volatile("s_waitcnt vmcnt(0)" ::: "memory");
    __syncthreads();
    if (threadIdx.x == 0) {
        unsigned* bar = b.bar;
        __builtin_amdgcn_s_waitcnt(0);
        unsigned nloc = b.st[0], nx = b.st[1];
        if (nloc == 0u) { xcd_barrier_complete(bar, b.x, nloc, nx); b.st[0] = nloc; b.st[1] = nx; }
        const unsigned old = xb_add(&bar[XB_XSUB(b.x)], 1u);
        const unsigned gen = old / nloc;
        if (old + 1u == (gen + 1u) * nloc) {
            __builtin_amdgcn_fence(__ATOMIC_RELEASE, "agent");
            asm volatile("s_waitcnt vmcnt(0)" ::: "memory");
            const unsigned og = xb_add(&bar[XB_TOP], 1u);
            const unsigned tg = og / nx;
            if (og + 1u == (tg + 1u) * nx) xb_add(&bar[XB_TOPGEN], 1u);
            else XB_SPIN(xb_ld(&bar[XB_TOPGEN]) == tg, bar);
            __builtin_amdgcn_fence(__ATOMIC_ACQUIRE, "agent");
            xb_add(&bar[XB_XGEN(b.x)], 1u);
            asm volatile("s_waitcnt vmcnt(0)" ::: "memory");
        } else {
            XB_SPIN(xb_ld(&bar[XB_XGEN(b.x)]) == gen, bar);
            __builtin_amdgcn_fence(__ATOMIC_ACQUIRE, "agent");
            asm volatile("s_waitcnt vmcnt(0)" ::: "memory");
        }
    }
    __syncthreads();
}
constexpr size_t CTL_BAR_BYTE = 704 * 1024;
constexpr int LDS_ST_OFF = 147456 - 64;

constexpr int LDS_BYTES = 147456;
#ifndef MK_REP3
#define MK_REP3 1
#endif
#ifndef MK_REP2
#define MK_REP2 1
#endif
#ifndef MK_REP6
#define MK_REP6 1
#endif
#ifndef MK_DBL_SYNC
#define MK_DBL_SYNC 0
#endif
__global__ void __launch_bounds__(512, 2) mega(Args args) {
    extern __shared__ __attribute__((aligned(16))) unsigned char lds_raw[];
    LAS unsigned char* lds = (LAS unsigned char*)lds_raw;
    const int G = gridDim.x, bx = blockIdx.x, NGW = G * 8;
    volatile LAS unsigned* bar_st = (volatile LAS unsigned*)(lds + LDS_ST_OFF);
    if (threadIdx.x < 2) bar_st[threadIdx.x] = 0u;
    if (bx == 0 && args.ph_lo == 0) { unsigned* bw = (unsigned*)(args.ws + WS_CTL + CTL_BAR_BYTE); for (int i = threadIdx.x; i < XCD_BAR_WORDS; i += 512) __hip_atomic_store(bw + i, 0u, __ATOMIC_RELAXED, __HIP_MEMORY_SCOPE_AGENT); }
    __syncthreads();
    XcdBarrier xbar; xbar.bar = (unsigned*)(args.ws + WS_CTL + CTL_BAR_BYTE); xbar.x = 0; xbar.st = bar_st;
    if (args.ph_lo == 0) { const int tid0 = threadIdx.x, wave0 = __builtin_amdgcn_readfirstlane(tid0 >> 6); for (int e_ = 0; e_ < 1 + MK_PROBE_PRO; ++e_) prologue<true>(args, lds, bx * 8 + wave0, NGW, wave0, tid0 & 63); }
    for (int ph = args.ph_lo > 1 ? args.ph_lo : 1; ph < args.ph_hi; ++ph) {
        if ((ph - 1) % 10 == 2) continue;
        if (ph > args.ph_lo) {
            if (ph == 1) { cooperative_groups::this_grid().sync(); xbar = xcd_barrier_post(xbar.bar, bar_st); }
            else xcd_barrier(xbar); }
        unsigned char* ws = args.ws; float* xout = args.out; asm volatile("" : "+s"(ws), "+s"(xout));
        int tidp = threadIdx.x; asm volatile("" : "+v"(tidp)); const int lane = tidp & 63, wave = __builtin_amdgcn_readfirstlane(tidp >> 6), gw = bx * 8 + wave;
        float* ctl = (float*)(ws + WS_CTL); bf16_t* XB = (bf16_t*)(ws + WS_XB);
        const int l = (ph - 1) / 10, p = (ph - 1) % 10; unsigned char* wl = ws + WS_W + l * W_LAYER;
#if MK_DBL_SYNC
        for (int e_ = 0; e_ < MK_DBL_SYNC; ++e_) xcd_barrier(xbar);
#endif
        if (p == 0) {
            pg8::Gemm g = pg8::make_gemm(XB, (const bf16_t*)(wl + W_IN), 1024); pg8::StaticOrder S; S.init(NTOK, INP, G, bx);
            pg8::EpiInProj E{(bf16_t*)(ws + WS_U), (bf16_t*)(ws + WS_V), (bf16_t*)(ws + WS_Q), (bf16_t*)(ws + WS_KV), (float*)(ws + WS_GL), ctl + (l == 0 ? 0 : 3) * NTOK};
            pg8::gemm_phase<pg8::EpiInProj, pg8::StaticOrder, true>(lds, g, S, E);
        } else if (p == 1) {
          for (int vb = bx; vb < 256; vb += G) {
            if (vb < 16) { const int kv = vb >> 3, pm = vb & 7;
                pg8::Gemm g; g.A = (const bf16_t*)(ws + WS_KV) + kv * 128; g.Bt = (const bf16_t*)(wl + W_C1 + (size_t)kv * 256 * 2048 * 2); g.K = 2048; g.lda = 16 * 768; g.kstepA = 768 * 2; g.a_s0 = 64 * 2; g.a_s1 = (size_t)T * 768 * 2;
                pg8::OneUnit S{1, {pm, 0}};
                bf16_t* hid = (bf16_t*)(ws + WS_HID) + (size_t)kv * 2048 * 256;
                pg8::EpiBf16G<1> E{hid, 256, (const float*)(wl + W_B1P) + kv * 256, nullptr, 0.f};
                pg8::gemm_phase<pg8::EpiBf16G<1>, pg8::OneUnit, true>(lds, g, S, E);
                asm volatile("s_waitcnt vmcnt(0)" ::: "memory"); __syncthreads();
                cmp2_tile(hid + (size_t)pm * 256 * 256, (const bf16_t*)(wl + W_C2) + (size_t)kv * 64 * 256, args.in[I_CB2] + l * 128 + kv * 64, kv == 0 ? args.in[I_KNG] + l * 192 : (const float*)nullptr,
                          (bf16_t*)(ws + (kv ? WS_VC : WS_KC)) + (size_t)pm * 256 * 64);
            } else if (vb < 32) { const int i = vb - 16;
                pg8::Gemm g = pg8::make_gemm((const bf16_t*)(ws + WS_MEMB), (const bf16_t*)(wl + W_MKV), 1024); pg8::OneUnit S{1, {i >> 2, i & 3}};
                pg8::EpiBf16G<0> E{(bf16_t*)(ws + WS_KVM), 1024, nullptr, ctl + SSQ_MEM_OFF, 1.f / 1024.f};
                pg8::gemm_phase<pg8::EpiBf16G<0>, pg8::OneUnit, true>(lds, g, S, E);
            } else if (vb < 160) {
                sgu_unit(lds, vb - 32, (const bf16_t*)(ws + WS_U), (const bf16_t*)(ws + WS_V), (const bf16_t*)(wl + W_SG), args.in[I_SGLNG] + l * 512, args.in[I_SGLNB] + l * 512, args.in[I_SGB] + l * 1024, (bf16_t*)(ws + WS_MIX));
            } else {
                for (int t = (vb - 160) * 8 + wave; t < NTOK; t += 4 * 768) tokprep4((bf16_t*)(ws + WS_Q), (bf16_t*)(ws + WS_KV), args.in[I_QNG] + l * 64, args.in[I_KNG] + l * 192, t, 768, lane);
            } }
        } else if (p == 3) {
            for (int r = gw; r < 4096; r += NGW) memk_norm_item((bf16_t*)(ws + WS_KVM), args.in[I_MKG] + l * 128, r, lane);
            for (int i_ = bx; i_ < 256 * MK_REP3; i_ += G) { const int i = i_ & 255, b = (i & 7) >> 1, idx = (i >> 3) * 2 + (i & 1);
                attn_unit<15>(lds, b, 127 - idx, (const bf16_t*)(ws + WS_Q), (const bf16_t*)(ws + WS_KV), (const bf16_t*)(ws + WS_KC), (const bf16_t*)(ws + WS_VC), (const float*)(ws + WS_GL), (bf16_t*)(ws + WS_MIX));
                attn_unit<15>(lds, b, idx, (const bf16_t*)(ws + WS_Q), (const bf16_t*)(ws + WS_KV), (const bf16_t*)(ws + WS_KC), (const bf16_t*)(ws + WS_VC), (const float*)(ws + WS_GL), (bf16_t*)(ws + WS_MIX)); }
        } else if (p == 6) {
            for (int i_ = bx; i_ < 256 * MK_REP6; i_ += G) { const int i = i_ & 255, b = (i & 7) >> 1, rest = (i >> 3) * 2 + (i & 1);
                memattn_unit(lds, b, rest >> 4, rest & 15, (const bf16_t*)(ws + WS_QM), (const bf16_t*)(ws + WS_KVM), args.in[I_MQG] + l * 128, (bf16_t*)(ws + WS_OM)); }
        } else if (p == 4) {
            pg8::Gemm g = pg8::make_gemm((const bf16_t*)(ws + WS_MIX), (const bf16_t*)(wl + W_OUT), 1024); pg8::StaticOrder S; S.init(NTOK, 1024, G, bx);
            pg8::EpiResid E{xout, XB, ctl + (l * 3 + 1) * NTOK};
            pg8::gemm_phase<pg8::EpiResid, pg8::StaticOrder, true>(lds, g, S, E);
        } else if (p == 5) {
            pg8::Gemm g = pg8::make_gemm(XB, (const bf16_t*)(wl + W_MQ), 1024); pg8::StaticOrder S; S.init(NTOK, 512, G, bx);
            pg8::EpiBf16G<0> E{(bf16_t*)(ws + WS_QM), 512, nullptr, ctl + (l * 3 + 1) * NTOK, 1.f / 1024.f};
            pg8::gemm_phase<pg8::EpiBf16G<0>, pg8::StaticOrder, true>(lds, g, S, E);
        } else if (p == 7) {
            pg8::Gemm g = pg8::make_gemm((const bf16_t*)(ws + WS_OM), (const bf16_t*)(wl + W_MO), 512); pg8::StaticOrder S; S.init(NTOK, 1024, G, bx);
            pg8::EpiResid E{xout, XB, ctl + (l * 3 + 2) * NTOK};
            pg8::gemm_phase<pg8::EpiResid, pg8::StaticOrder, true>(lds, g, S, E);
        } else if (p == 8) {
            pg8::Gemm g = pg8::make_gemm(XB, (const bf16_t*)(wl + W_FF1), 1024); pg8::StaticOrder S; S.init(NTOK, FF, G, bx);
            pg8::EpiBf16G<2> E{(bf16_t*)(ws + WS_HB), FF, nullptr, ctl + (l * 3 + 2) * NTOK, 1.f / 1024.f};
            pg8::gemm_phase<pg8::EpiBf16G<2>, pg8::StaticOrder, true>(lds, g, S, E);
        } else if (p == 9) {
            pg8::Gemm g = pg8::make_gemm((const bf16_t*)(ws + WS_HB), (const bf16_t*)(wl + W_FF2), FF); pg8::StaticOrder S; S.init(NTOK, 1024, G, bx);
            pg8::EpiResid E{xout, l == 0 ? XB : (bf16_t*)nullptr, ctl + 3 * NTOK};
            pg8::gemm_phase<pg8::EpiResid, pg8::StaticOrder, true>(lds, g, S, E);
        }
    }
#if MK_PROBE_N > 0
    if (args.ph_hi == 21) {
        unsigned char* ws = args.ws; unsigned char* wl = ws + WS_W + W_LAYER; float* ctl = (float*)(ws + WS_CTL);
        xcd_barrier(xbar);
        { pg8::Gemm g = pg8::make_gemm((const bf16_t*)(ws + WS_XB), (const bf16_t*)(wl + W_IN), 1024); pg8::StaticOrder S; S.init(NTOK, INP, G, bx);
          pg8::EpiInProj E{(bf16_t*)(ws + WS_U), (bf16_t*)(ws + WS_V), (bf16_t*)(ws + WS_Q), (bf16_t*)(ws + WS_KV), (float*)(ws + WS_GL), ctl + 3 * NTOK};
          pg8::gemm_phase<pg8::EpiInProj, pg8::StaticOrder, true>(lds, g, S, E); }
        xcd_barrier(xbar);
        { int tidp = threadIdx.x; asm volatile("" : "+v"(tidp)); const int lane = tidp & 63, wave = __builtin_amdgcn_readfirstlane(tidp >> 6), gw = bx * 8 + wave;
          for (int t = gw; t < NTOK; t += NGW) tokprep_token((bf16_t*)(ws + WS_Q), (bf16_t*)(ws + WS_KV), args.in[I_QNG] + 64, args.in[I_KNG] + 192, t, lane); }
        for (int e_ = 0; e_ < MK_PROBE_N; ++e_) { xcd_barrier(xbar);
            int tidp = threadIdx.x; asm volatile("" : "+v"(tidp)); const int lane = tidp & 63, wave = __builtin_amdgcn_readfirstlane(tidp >> 6), gw = bx * 8 + wave; (void)lane; (void)gw;
#if MK_PROBE_KIND == 3
            for (int i = bx; i < 256; i += G) { const int b = (i & 7) >> 1, idx = (i >> 3) * 2 + (i & 1);
                attn_unit<MK_PROBE_PARTS>(lds, b, 127 - idx, (const bf16_t*)(ws + WS_Q), (const bf16_t*)(ws + WS_KV), (const bf16_t*)(ws + WS_KC), (const bf16_t*)(ws + WS_VC), (const float*)(ws + WS_GL), (bf16_t*)(ws + WS_MIX));
                attn_unit<MK_PROBE_PARTS>(lds, b, idx, (const bf16_t*)(ws + WS_Q), (const bf16_t*)(ws + WS_KV), (const bf16_t*)(ws + WS_KC), (const bf16_t*)(ws + WS_VC), (const float*)(ws + WS_GL), (bf16_t*)(ws + WS_MIX)); }
#elif MK_PROBE_KIND == 0
            { pg8::Gemm g = pg8::make_gemm((const bf16_t*)(ws + WS_XB), (const bf16_t*)(wl + W_IN), 1024); pg8::StaticOrder S; S.init(NTOK, INP, G, bx);
              pg8::EpiInProj E{(bf16_t*)(ws + WS_U), (bf16_t*)(ws + WS_V), (bf16_t*)(ws + WS_Q), (bf16_t*)(ws + WS_KV), (float*)(ws + WS_GL), ctl + 3 * NTOK};
              pg8::gemm_phase<pg8::EpiInProj, pg8::StaticOrder, true>(lds, g, S, E); }
#elif MK_PROBE_KIND == 8
            { pg8::Gemm g = pg8::make_gemm((const bf16_t*)(ws + WS_XB), (const bf16_t*)(wl + W_FF1), 1024); pg8::StaticOrder S; S.init(NTOK, FF, G, bx);
              pg8::EpiBf16G<2> E{(bf16_t*)(ws + WS_HB), FF, nullptr, ctl + 5 * NTOK, 1.f / 1024.f};
              pg8::gemm_phase<pg8::EpiBf16G<2>, pg8::StaticOrder, true>(lds, g, S, E); }
#elif MK_PROBE_KIND == 5
            { pg8::Gemm g = pg8::make_gemm((const bf16_t*)(ws + WS_XB), (const bf16_t*)(wl + W_MQ), 1024); pg8::StaticOrder S; S.init(NTOK, 512, G, bx);
              pg8::EpiBf16G<0> E{(bf16_t*)(ws + WS_QM), 512, nullptr, ctl + 4 * NTOK, 1.f / 1024.f};
              pg8::gemm_phase<pg8::EpiBf16G<0>, pg8::StaticOrder, true>(lds, g, S, E); }
#elif MK_PROBE_KIND == 1
            if (bx < 16) { const int kv = bx >> 3, pm = bx & 7;
                pg8::Gemm g; g.A = (const bf16_t*)(ws + WS_KV) + kv * 128; g.Bt = (const bf16_t*)(wl + W_C1 + (size_t)kv * 256 * 2048 * 2); g.K = 2048; g.lda = 16 * 768; g.kstepA = 768 * 2; g.a_s0 = 64 * 2; g.a_s1 = (size_t)T * 768 * 2;
                pg8::OneUnit S{1, {pm, 0}};
                pg8::EpiBf16G<1> E{(bf16_t*)(ws + WS_HID) + (size_t)kv * 2048 * 256, 256, (const float*)(wl + W_B1P) + kv * 256, nullptr, 0.f};
                pg8::gemm_phase<pg8::EpiBf16G<1>, pg8::OneUnit, true>(lds, g, S, E);
            } else if (bx < 32) { const int i = bx - 16;
                pg8::Gemm g = pg8::make_gemm((const bf16_t*)(ws + WS_MEMB), (const bf16_t*)(wl + W_MKV), 1024); pg8::OneUnit S{1, {i >> 2, i & 3}};
                pg8::EpiBf16G<0> E{(bf16_t*)(ws + WS_KVM), 1024, nullptr, ctl + SSQ_MEM_OFF, 1.f / 1024.f};
                pg8::gemm_phase<pg8::EpiBf16G<0>, pg8::OneUnit, true>(lds, g, S, E); }
#elif MK_PROBE_KIND == 2
            for (int u = bx; u < 128; u += G) sgu_unit(lds, u, (const bf16_t*)(ws + WS_U), (const bf16_t*)(ws + WS_V), (const bf16_t*)(wl + W_SG), args.in[I_SGLNG] + 512, args.in[I_SGLNB] + 512, args.in[I_SGB] + 1024, (bf16_t*)(ws + WS_MIX));
            for (int t = gw; t < NTOK; t += NGW) tokprep_token((bf16_t*)(ws + WS_Q), (bf16_t*)(ws + WS_KV), args.in[I_QNG] + 64, args.in[I_KNG] + 192, t, lane);
            for (int r = gw; r < 2048; r += NGW) cmp2_row((const bf16_t*)(ws + WS_HID), (const bf16_t*)(wl + W_C2), args.in[I_CB2] + 128, args.in[I_KNG] + 192, (bf16_t*)(ws + WS_KC), (bf16_t*)(ws + WS_VC), r, lane);
#elif MK_PROBE_KIND == 100
            prologue<false>(args, lds, gw, NGW, wave, lane);
#elif MK_PROBE_KIND == 6
            for (int i = bx; i < 256; i += G) { const int b = (i & 7) >> 1, rest = (i >> 3) * 2 + (i & 1);
                memattn_unit(lds, b, rest >> 4, rest & 15, (const bf16_t*)(ws + WS_QM), (const bf16_t*)(ws + WS_KVM), args.in[I_MQG] + 128, (bf16_t*)(ws + WS_OM)); }
#endif
        }
    }
#endif
}

}

#ifndef MK_FUSED
#define MK_FUSED 1
#endif
extern "C" void kernel_launch(void* const* d_in, const int* in_sizes, int n_in, void* d_out, int out_size, void* d_ws, size_t ws_size, hipStream_t stream) {
    using namespace mk;
    static int grid = 0;
    if (!grid) { (void)hipFuncSetAttribute((const void*)mega, hipFuncAttributeMaxDynamicSharedMemorySize, LDS_BYTES);
        int dev = 0, cus = 0, per_cu = 0; (void)hipGetDevice(&dev); (void)hipDeviceGetAttribute(&cus, hipDeviceAttributeMultiprocessorCount, dev);
        (void)hipOccupancyMaxActiveBlocksPerMultiprocessor(&per_cu, (const void*)mega, 512, LDS_BYTES);
        grid = cus * (per_cu < 1 ? 1 : per_cu); if (grid > 256) grid = 256; }
    Args a{}; for (int i = 0; i < 27; ++i) a.in[i] = (const float*)d_in[i]; a.out = (float*)d_out; a.ws = (unsigned char*)d_ws;
#if MK_FUSED
    a.ph_lo = 0; a.ph_hi = 21; void* kargs[] = {&a};
    (void)hipLaunchCooperativeKernel((const void*)mega, dim3(grid), dim3(512), kargs, LDS_BYTES, stream);
#else
    for (int ph = 0; ph < 21; ++ph) { a.ph_lo = ph; a.ph_hi = ph + 1; hipLaunchKernelGGL(mega, dim3(grid), dim3(512), LDS_BYTES, stream, a); }
#endif
}
```

```cpp
#include <hip/hip_runtime.h>
#include <hip/hip_cooperative_groups.h>
#include <stdint.h>
#include <math.h>

namespace pg8 {
#define PG8_LAS __attribute__((address_space(3)))
typedef unsigned short bf16_t;
typedef short bf16x8 __attribute__((ext_vector_type(8)));
typedef float f32x4 __attribute__((ext_vector_type(4)));
typedef float f32x2 __attribute__((ext_vector_type(2)));
typedef unsigned u32x4 __attribute__((ext_vector_type(4)));
typedef unsigned u32x2 __attribute__((ext_vector_type(2)));
constexpr int BM = 256, BK = 64, HALF = 128, HTB = HALF * BK * 2, STAGE_BYTES = 8 * HTB, NXCD = 8, WGM = 8;

__host__ __device__ __forceinline__ int lds_byte(int r, int c) { const int st = (r >> 4) * 2 + (c >> 5), rr = r & 15, cc = c & 31, ob = rr * 64 + cc * 2; return st * 1024 + (ob ^ (((ob >> 9) & 1) << 5)); }
__host__ __device__ __forceinline__ void stage_rc(int b, int& R, int& C) { const int st = b / 1024, sb = b % 1024, swz = sb ^ (((sb >> 9) & 1) << 5); R = (st >> 1) * 16 + swz / 64; C = (st & 1) * 32 + (swz % 64) / 2; }
__host__ __device__ __forceinline__ int perm32(int rho) { const int n = rho >> 4, i = rho & 15; return 8 * (i >> 2) + 4 * n + (i & 3); }

struct Unit { int pm, pn; };
struct Gemm { const bf16_t* A; const bf16_t* Bt; int K; int lda; int kstepA; size_t a_s0, a_s1; };
__device__ __forceinline__ Gemm make_gemm(const bf16_t* A, const bf16_t* Bt, int K) { Gemm g; g.A = A; g.Bt = Bt; g.K = K; g.lda = K; g.kstepA = BK * 2; g.a_s0 = (size_t)BM * K * 2; g.a_s1 = 2 * g.a_s0; return g; }

struct StaticOrder {
    int nM, nN, nwg, G, c;
    __device__ void init(int M, int N, int G_, int c_) { nM = M / BM; nN = N / BM; nwg = nM * nN; G = G_; c = c_; }
    __device__ bool next(int i, Unit& u) const {
        const long L = (long)i * G + c; if (L >= nwg) return false;
        int wgid = (int)L; { const int q = nwg / NXCD, r = nwg % NXCD, xcd = wgid % NXCD, off = wgid / NXCD; wgid = (xcd < r ? xcd * (q + 1) : r * (q + 1) + (xcd - r) * q) + off; }
        const int nig = WGM * nN, gid = wgid / nig, fm = gid * WGM, gsz = (nM - fm) < WGM ? (nM - fm) : WGM;
        u.pm = fm + ((wgid % nig) % gsz); u.pn = (wgid % nig) / gsz; return true;
    }
};
struct OneUnit { int has; Unit u; __device__ bool next(int i, Unit& o) const { if (i > 0 || !has) return false; o = u; return true; } };

__device__ __forceinline__ unsigned cvt_pk_bf16(float lo, float hi) { unsigned r; asm volatile("v_cvt_pk_bf16_f32 %0, %1, %2" : "=v"(r) : "v"(lo), "v"(hi)); return r; }
__device__ __forceinline__ float gelu_tanh(float x) { const float u = 0.7978845608028654f * (x + 0.044715f * x * x * x); const float e = __builtin_amdgcn_exp2f(-2.885390081777927f * u); return x * __builtin_amdgcn_rcpf(1.f + e); }

__device__ __forceinline__ float ssq16(const float* p) { const f32x4 a = ((const f32x4*)p)[0], b = ((const f32x4*)p)[1], c = ((const f32x4*)p)[2], d = ((const f32x4*)p)[3];
    return (((a[0] + a[1]) + (a[2] + a[3])) + ((b[0] + b[1]) + (b[2] + b[3]))) + (((c[0] + c[1]) + (c[2] + c[3])) + ((d[0] + d[1]) + (d[2] + d[3]))); }
template <int ACT  > struct EpiBf16G {
    static constexpr bool PERM = true, AFTER_DRAIN = false;
    bf16_t* O; int ldc; const float* bias; const float* ssq; float inv_n; int nparts;
    __device__ __forceinline__ void operator()(const f32x4 (&acc)[2][2][4][2], const Unit& u, int wr, int wc, int fr, int fq) const {
        const int row0 = u.pm * BM + wr * 64 + fr, col0 = u.pn * BM + wc * 32 + 8 * fq;
        f32x4 bv[2][2];
#pragma unroll
        for (int bj = 0; bj < 2; ++bj)
#pragma unroll
            for (int n = 0; n < 2; ++n) bv[bj][n] = bias ? *(const f32x4*)(bias + col0 + bj * HALF + 4 * n) : (f32x4){0.f, 0.f, 0.f, 0.f};
#pragma unroll
        for (int ai = 0; ai < 2; ++ai)
#pragma unroll
            for (int m = 0; m < 4; ++m) { const int row = row0 + ai * HALF + m * 16; const float rs = ssq ? rsqrtf((nparts == 16 ? ssq16(ssq + (size_t)row * 16) : ssq[row]) * inv_n + 1e-6f) : 1.f; bf16_t* rowp = O + (size_t)row * ldc + col0;
#pragma unroll
                for (int bj = 0; bj < 2; ++bj) { f32x4 v0 = (acc[ai][bj][m][0] + bv[bj][0]) * rs, v1 = (acc[ai][bj][m][1] + bv[bj][1]) * rs;
                    if (ACT == 1) {
#pragma unroll
                        for (int e = 0; e < 4; ++e) { v0[e] = gelu_tanh(v0[e]); v1[e] = gelu_tanh(v1[e]); } }
                    if (ACT == 2) {
#pragma unroll
                        for (int e = 0; e < 4; ++e) { float a = fmaxf(v0[e], 0.f), b = fmaxf(v1[e], 0.f); v0[e] = a * a; v1[e] = b * b; } }
                    u32x4 w; w.x = cvt_pk_bf16(v0[0], v0[1]); w.y = cvt_pk_bf16(v0[2], v0[3]); w.z = cvt_pk_bf16(v1[0], v1[1]); w.w = cvt_pk_bf16(v1[2], v1[3]);
                    *(u32x4*)(rowp + bj * HALF) = w; } }
    }
};
struct EpiInProj {
    static constexpr bool PERM = true, AFTER_DRAIN = false;
    bf16_t *U, *V, *Q, *KV; float* GL; const float* ssq;
    __device__ __forceinline__ void operator()(const f32x4 (&acc)[2][2][4][2], const Unit& u, int wr, int wc, int fr, int fq) const {
        const int row0 = u.pm * BM + wr * 64 + fr, cit0 = wc * 32 + 8 * fq; const int pn = u.pn;
        bf16_t* base; int ldc, cofs; bool act = false;
        if (pn < 2) { base = U; ldc = 512; cofs = pn * 256; act = true; } else if (pn < 4) { base = V; ldc = 512; cofs = (pn - 2) * 256; act = true; }
        else if (pn < 6) { base = Q; ldc = 512; cofs = (pn - 4) * 256; } else { base = KV; ldc = 768; cofs = (pn - 6) * 256; }
#pragma unroll
        for (int ai = 0; ai < 2; ++ai)
#pragma unroll
            for (int m = 0; m < 4; ++m) { const int row = row0 + ai * HALF + m * 16; const float rs = rsqrtf(ssq16(ssq + (size_t)row * 16) * (1.f / 1024.f) + 1e-6f);
#pragma unroll
                for (int bj = 0; bj < 2; ++bj) { f32x4 v0 = acc[ai][bj][m][0] * rs, v1 = acc[ai][bj][m][1] * rs; const int cit = cit0 + bj * HALF;
                    if (pn == 9) { if (cit < 24) { *(f32x4*)(GL + (size_t)row * 24 + cit) = v0; *(f32x4*)(GL + (size_t)row * 24 + cit + 4) = v1; } }
                    else { if (act) {
#pragma unroll
                            for (int e = 0; e < 4; ++e) { v0[e] = gelu_tanh(v0[e]); v1[e] = gelu_tanh(v1[e]); } }
                        u32x4 w; w.x = cvt_pk_bf16(v0[0], v0[1]); w.y = cvt_pk_bf16(v0[2], v0[3]); w.z = cvt_pk_bf16(v1[0], v1[1]); w.w = cvt_pk_bf16(v1[2], v1[3]);
                        *(u32x4*)(base + (size_t)row * ldc + cofs + cit) = w; } } }
    }
};
struct EpiResid {
    static constexpr bool PERM = false, AFTER_DRAIN = false;
    float* XF; bf16_t* XB; float* ssq;
    __device__ __forceinline__ void operator()(const f32x4 (&acc)[2][2][4][2], const Unit& u, int wr, int wc, int fr, int fq) const {
        const int col0 = u.pn * BM + wc * 32 + 4 * fq;
#pragma unroll
        for (int ai = 0; ai < 2; ++ai)
#pragma unroll
            for (int m = 0; m < 4; ++m) { const int row = u.pm * BM + ai * HALF + wr * 64 + m * 16 + fr; float sq = 0.f;
#pragma unroll
                for (int bj = 0; bj < 2; ++bj)
#pragma unroll
                    for (int n = 0; n < 2; ++n) { const size_t off = (size_t)row * 1024 + col0 + bj * HALF + n * 16; const u32x2 xw = *(const u32x2*)(XB + off);
                        f32x4 xv; xv[0] = __uint_as_float(xw.x << 16); xv[1] = __uint_as_float(xw.x & 0xffff0000u); xv[2] = __uint_as_float(xw.y << 16); xv[3] = __uint_as_float(xw.y & 0xffff0000u);
                        xv = xv + acc[ai][bj][m][n];
                        if (XF) *(f32x4*)(XF + off) = xv;
                        else { sq += (xv[0] * xv[0] + xv[1] * xv[1]) + (xv[2] * xv[2] + xv[3] * xv[3]); u32x2 w; w.x = cvt_pk_bf16(xv[0], xv[1]); w.y = cvt_pk_bf16(xv[2], xv[3]); *(u32x2*)(XB + off) = w; } }
                if (!XF) { sq += __shfl_xor(sq, 16); sq += __shfl_xor(sq, 32); if (fq == 0) ssq[(size_t)row * 16 + u.pn * 4 + wc] = sq; } }
    }
};

template <class Epi, class Sched, bool ALIGN_EPI>
__device__ __forceinline__ void gemm_phase(PG8_LAS unsigned char* lds, const Gemm g, const Sched& S, const Epi& E) {
    int tid_ = threadIdx.x; asm volatile("" : "+v"(tid_));
    const int tid = tid_, wid = __builtin_amdgcn_readfirstlane(tid >> 6), lane = tid & 63, wr = wid >> 2, wc = wid & 3, fr = lane & 15, fq = lane >> 4;
    const int K = g.K, nt = K / BK;
    unsigned voffA[2], voffB[2];
#pragma unroll
    for (int i = 0; i < 2; ++i) { int R, C; stage_rc(tid * 16 + i * 8192, R, C); const int Rb = Epi::PERM ? ((R & ~31) + perm32(R & 31)) : R;
        voffA[i] = (unsigned)(R * g.lda + C) * 2u; voffB[i] = (unsigned)(Rb * K + C) * 2u; }
    const size_t kstepA = (size_t)g.kstepA, kstepB = (size_t)(BK * 2);
    const size_t hstepA = (size_t)HALF * g.lda * 2, hstepB = (size_t)HALF * K * 2, tstepB = 2 * hstepB;
    const unsigned ldsw = (unsigned)wid * 1024u;
    const int aoff = lds_byte(wr * 64 + fr, fq * 8), boff = lds_byte(wc * 32 + fr, fq * 8);
#define PG8_ABASE(pm) ((const char*)g.A + (size_t)((pm) >> 1) * g.a_s1 + (size_t)((pm) & 1) * g.a_s0)
#define PG8_SA(b, h) (((b) * 2 + (h)) * HTB)
#define PG8_SB(b, h) ((4 + (b) * 2 + (h)) * HTB)
#define PG8_STAGE(bufoff, gbase, voff) do { _Pragma("unroll") for (int _i = 0; _i < 2; ++_i) \
        __builtin_amdgcn_global_load_lds((const unsigned*)((const char*)(gbase) + (voff)[_i]), (PG8_LAS unsigned*)(lds + (bufoff) + ldsw + _i * 8192), 16, 0, 0); } while (0)
#define PG8_LDA(dst, b, h) do { _Pragma("unroll") for (int m = 0; m < 4; ++m) _Pragma("unroll") for (int k = 0; k < 2; ++k) dst[m][k] = *(const PG8_LAS bf16x8*)(lds + PG8_SA(b, h) + aoff + m * 2048 + k * 1024); } while (0)
#define PG8_LDB(dst, b, h) do { _Pragma("unroll") for (int n = 0; n < 2; ++n) _Pragma("unroll") for (int k = 0; k < 2; ++k) dst[n][k] = *(const PG8_LAS bf16x8*)(lds + PG8_SB(b, h) + boff + n * 2048 + k * 1024); } while (0)
#define PG8_MMA(ai, bj, At, Bt) do { __builtin_amdgcn_s_setprio(1); _Pragma("unroll") for (int m = 0; m < 4; ++m) _Pragma("unroll") for (int n = 0; n < 2; ++n) _Pragma("unroll") for (int k = 0; k < 2; ++k) \
        acc[ai][bj][m][n] = __builtin_amdgcn_mfma_f32_16x16x32_bf16(Bt[n][k], At[m][k], acc[ai][bj][m][n], 0, 0, 0); __builtin_amdgcn_s_setprio(0); } while (0)
#define PG8_WAIT_V(n) asm volatile("s_waitcnt vmcnt(" #n ")" ::: "memory")
#define PG8_WAIT_L(n) asm volatile("s_waitcnt lgkmcnt(" #n ")" ::: "memory")
#define PG8_BAR __builtin_amdgcn_s_barrier()
#define PG8_SCHED __builtin_amdgcn_sched_barrier(0)
    Unit cur, nxt; int ui = 0;
    if (!S.next(0, cur)) return;
    f32x4 acc[2][2][4][2];
#pragma unroll
    for (int a = 0; a < 2; ++a)
#pragma unroll
        for (int b = 0; b < 2; ++b)
#pragma unroll
            for (int m = 0; m < 4; ++m)
#pragma unroll
                for (int n = 0; n < 2; ++n) acc[a][b][m][n] = (f32x4){0.f, 0.f, 0.f, 0.f};
    bf16x8 At[4][2], B0[2][2], B1[2][2];
    const char* cA = PG8_ABASE(cur.pm); const char* cB = (const char*)g.Bt + (size_t)cur.pn * tstepB;
    PG8_STAGE(PG8_SB(0, 0), cB, voffB); PG8_STAGE(PG8_SB(0, 1), cB + hstepB, voffB); PG8_STAGE(PG8_SA(0, 0), cA, voffA); PG8_STAGE(PG8_SA(0, 1), cA + hstepA, voffA);
    if (wr == 1) PG8_BAR;
    PG8_WAIT_V(2); PG8_BAR;
    PG8_STAGE(PG8_SB(1, 0), cB + kstepB, voffB); PG8_STAGE(PG8_SA(1, 0), cA + kstepA, voffA); PG8_STAGE(PG8_SB(1, 1), cB + hstepB + kstepB, voffB);
    PG8_WAIT_V(6); PG8_BAR;
    for (;;) {
        const bool has_next = S.next(ui + 1, nxt);
        const char* nA = has_next ? PG8_ABASE(nxt.pm) : cA; const char* nB = has_next ? (const char*)g.Bt + (size_t)nxt.pn * tstepB : cB;
        for (int t = 0; t < nt; t += 2) {
            const bool last = (t == nt - 2);
            const char* a1 = cA + (size_t)(t + 1) * kstepA;
            const char* a2 = last ? nA : cA + (size_t)(t + 2) * kstepA; const char* b2 = last ? nB : cB + (size_t)(t + 2) * kstepB;
            const char* a3 = a2 + kstepA; const char* b3 = b2 + kstepB;
            PG8_LDB(B0, 0, 0); PG8_LDB(B1, 0, 1); PG8_SCHED; PG8_LDA(At, 0, 0); PG8_STAGE(PG8_SA(1, 1), a1 + hstepA, voffA);
            PG8_WAIT_V(8); PG8_WAIT_L(0); PG8_BAR; PG8_MMA(0, 0, At, B0); PG8_MMA(0, 1, At, B1); PG8_BAR; PG8_SCHED;
            PG8_LDA(At, 0, 1); PG8_STAGE(PG8_SB(0, 0), b2, voffB); PG8_STAGE(PG8_SB(0, 1), b2 + hstepB, voffB); PG8_STAGE(PG8_SA(0, 0), a2, voffA);
            PG8_WAIT_V(8); PG8_WAIT_L(0); PG8_BAR; PG8_MMA(1, 0, At, B0); PG8_MMA(1, 1, At, B1); PG8_BAR; PG8_SCHED;
            PG8_LDB(B0, 1, 0); PG8_LDB(B1, 1, 1); PG8_SCHED; PG8_LDA(At, 1, 0); PG8_STAGE(PG8_SA(0, 1), a2 + hstepA, voffA);
            PG8_WAIT_V(8); PG8_WAIT_L(0); PG8_BAR; PG8_MMA(0, 0, At, B0); PG8_MMA(0, 1, At, B1); PG8_BAR; PG8_SCHED;
            PG8_LDA(At, 1, 1); PG8_STAGE(PG8_SB(1, 0), b3, voffB); PG8_STAGE(PG8_SB(1, 1), b3 + hstepB, voffB); PG8_STAGE(PG8_SA(1, 0), a3, voffA);
            PG8_WAIT_V(8); PG8_WAIT_L(0); PG8_BAR; PG8_MMA(1, 0, At, B0); PG8_MMA(1, 1, At, B1); PG8_BAR; PG8_SCHED;
        }
        if constexpr (ALIGN_EPI) { if (wr == 0) PG8_BAR; }
        if constexpr (!Epi::AFTER_DRAIN) { E(acc, cur, wr, wc, fr, fq); }
        if (!has_next) break;
#pragma unroll
        for (int a = 0; a < 2; ++a)
#pragma unroll
            for (int b = 0; b < 2; ++b)
#pragma unroll
                for (int m = 0; m < 4; ++m)
#pragma unroll
                    for (int n = 0; n < 2; ++n) acc[a][b][m][n] = (f32x4){0.f, 0.f, 0.f, 0.f};
        cur = nxt; cA = nA; cB = nB; ++ui;
        if constexpr (ALIGN_EPI) { if (wr == 1) PG8_BAR; }
    }
    PG8_WAIT_V(0);
    if constexpr (!ALIGN_EPI) { if (wr == 0) PG8_BAR; }
    PG8_BAR;
    if constexpr (Epi::AFTER_DRAIN) { E.fused(acc, cur, wr, wc, fr, fq, lds, wid, lane); }
#undef PG8_ABASE
#undef PG8_SA
#undef PG8_SB
#undef PG8_STAGE
#undef PG8_LDA
#undef PG8_LDB
#undef PG8_MMA
#undef PG8_WAIT_V
#undef PG8_WAIT_L
#undef PG8_BAR
#undef PG8_SCHED
}
}

#ifndef MK_PROBE_N
#define MK_PROBE_N 0
#endif
#ifndef MK_PROBE_PRO
#define MK_PROBE_PRO 0
#endif
#ifndef MK_PROBE_KIND
#define MK_PROBE_KIND 3
#endif
#ifndef MK_PROBE_PARTS
#define MK_PROBE_PARTS 15
#endif

namespace mk {
using pg8::bf16_t; using pg8::f32x4; using pg8::u32x4; using pg8::u32x2; using pg8::cvt_pk_bf16;
#define LAS __attribute__((address_space(3)))
constexpr int NB = 4, T = 4096, D = 1024, NTOK = NB * T, INC = 2328, INP = 2560, FF = 4096;
constexpr size_t MiB = 1u << 20;
constexpr size_t WS_CTL = 0;
constexpr size_t WS_W = 1 * MiB, W_LAYER = 30 * MiB;
constexpr size_t W_IN = 0, W_OUT = 5 * MiB, W_MQ = 7 * MiB, W_MKV = 8 * MiB, W_MO = 10 * MiB, W_FF1 = 11 * MiB, W_FF2 = 19 * MiB, W_C1 = 27 * MiB, W_C2 = 29 * MiB, W_SG = 29 * MiB + 128 * 1024, W_B1P = 29 * MiB + 512 * 1024;
constexpr size_t WS_XB = 61 * MiB;
constexpr size_t WS_OV = 93 * MiB;
constexpr size_t WS_U = WS_OV, WS_V = WS_OV + 16 * MiB, WS_Q = WS_OV + 32 * MiB, WS_KV = WS_OV + 48 * MiB, WS_MIX = WS_OV + 72 * MiB, WS_QM = WS_OV + 104 * MiB, WS_OM = WS_OV + 120 * MiB;
constexpr size_t WS_HB = WS_OV;
constexpr size_t WS_SM = 229 * MiB;
constexpr size_t WS_GL = WS_SM, WS_KC = WS_SM + 2 * MiB, WS_VC = WS_KC + 256 * 1024, WS_HID = WS_SM + 3 * MiB, WS_MASK = WS_SM + 5 * MiB, WS_MEMB = WS_SM + 6 * MiB, WS_KVM = WS_SM + 8 * MiB, WS_END = WS_SM + 10 * MiB;
constexpr size_t WS_SSQP = 240 * MiB;
static_assert(WS_END <= WS_SSQP && WS_SSQP + 6 * MiB <= 256 * MiB, "ws map");
constexpr int SSQ_MEM_OFF = 6 * NTOK;

struct Args { const float* in[27]; float* out; unsigned char* ws; int ph_lo, ph_hi; };
enum { I_X = 0, I_MEM, I_NMG, I_WIN, I_SGLNG, I_SGLNB, I_SGW, I_SGB, I_QNG, I_KNG, I_CPOS, I_CW1, I_CB1, I_CW2, I_CB2, I_MOG, I_WOUT, I_NMEMG, I_MKVG, I_WMQ, I_WMKV, I_MQG, I_MKG, I_WMO, I_NFG, I_WFF1, I_WFF2 };

__device__ __forceinline__ float bf2f(unsigned short b) { return __uint_as_float((unsigned)b << 16); }
__device__ __forceinline__ float wave_sum(float v) {
#pragma unroll
    for (int o = 1; o < 64; o <<= 1) v += __shfl_xor(v, o);
    return v; }

__device__ __forceinline__ void transpose_item(const float* W, int K, int N, int Npad, const float* gain, bf16_t* WT, LAS float* scr, int item, int lane) {
    const int nblk = Npad / 32, kb = item / nblk, nb = item % nblk, k0 = 64 * kb, n0 = 32 * nb;
    const int nn = n0 + (lane & 31); const int nnc = nn < N ? nn : N - 1; const float keep = nn < N ? 1.f : 0.f;
    const float* src = W + (size_t)(k0 + (lane >> 5)) * N + nnc;
    float v[32];
#pragma unroll
    for (int i = 0; i < 32; ++i) v[i] = src[(size_t)(2 * i) * N];
#pragma unroll
    for (int i = 0; i < 32; ++i) scr[(2 * i + (lane >> 5)) * 33 + (lane & 31)] = v[i] * keep;
    asm volatile("s_waitcnt lgkmcnt(0)" ::: "memory");
    const int c = lane & 7;
    f32x4 g0 = {1.f, 1.f, 1.f, 1.f}, g1 = {1.f, 1.f, 1.f, 1.f};
    if (gain) { g0 = *(const f32x4*)(gain + k0 + 8 * c); g1 = *(const f32x4*)(gain + k0 + 8 * c + 4); }
#pragma unroll
    for (int j = 0; j < 4; ++j) { const int n = (lane >> 3) + 8 * j; const LAS float* sp = scr + (8 * c) * 33 + n;
        u32x4 o; o.x = cvt_pk_bf16(sp[0 * 33] * g0[0], sp[1 * 33] * g0[1]); o.y = cvt_pk_bf16(sp[2 * 33] * g0[2], sp[3 * 33] * g0[3]); o.z = cvt_pk_bf16(sp[4 * 33] * g1[0], sp[5 * 33] * g1[1]); o.w = cvt_pk_bf16(sp[6 * 33] * g1[2], sp[7 * 33] * g1[3]);
        *(u32x4*)(WT + (size_t)(n0 + n) * K + k0 + 8 * c) = o; }
    asm volatile("s_waitcnt lgkmcnt(0)" ::: "memory");
}

template <bool DO_X>
__device__ __forceinline__ void prologue(const Args& a, LAS unsigned char* lds, int gw, int NGW, int wave, int lane) {
    LAS float* scr = (LAS float*)(lds + wave * 16384);
    unsigned char* ws = a.ws; float* ctl = (float*)(ws + WS_CTL);
    int it0 = 0;
#define TR_MAT(Wp, K_, N_, NP_, Gp, DST) { const int cnt = ((K_) / 64) * ((NP_) / 32); for (int it = gw; it < it0 + cnt; it += NGW) { if (it >= it0) transpose_item((Wp), (K_), (N_), (NP_), (Gp), (bf16_t*)(DST), scr, it - it0, lane); } it0 += cnt; }
    for (int l = 0; l < 2; ++l) {
        unsigned char* wl = ws + WS_W + l * W_LAYER;
        TR_MAT(a.in[I_WIN] + (size_t)l * 1024 * INC, 1024, INC, INP, a.in[I_NMG] + l * 1024, wl + W_IN)
        TR_MAT(a.in[I_WOUT] + (size_t)l * 1024 * 1024, 1024, 1024, 1024, a.in[I_MOG] + l * 1024, wl + W_OUT)
        TR_MAT(a.in[I_WMQ] + (size_t)l * 1024 * 512, 1024, 512, 512, a.in[I_NMEMG] + l * 1024, wl + W_MQ)
        TR_MAT(a.in[I_WMKV] + (size_t)l * 1024 * 1024, 1024, 1024, 1024, a.in[I_MKVG] + l * 1024, wl + W_MKV)
        TR_MAT(a.in[I_WMO] + (size_t)l * 512 * 1024, 512, 1024, 1024, (const float*)nullptr, wl + W_MO)
        TR_MAT(a.in[I_WFF1] + (size_t)l * 1024 * 4096, 1024, 4096, 4096, a.in[I_NFG] + l * 1024, wl + W_FF1)
        TR_MAT(a.in[I_WFF2] + (size_t)l * 4096 * 1024, 4096, 1024, 1024, (const float*)nullptr, wl + W_FF2)
        for (int kv = 0; kv < 2; ++kv) {
            TR_MAT(a.in[I_CW1] + (size_t)(l * 2 + kv) * 2048 * 256, 2048, 256, 256, (const float*)nullptr, wl + W_C1 + (size_t)kv * 256 * 2048 * 2)
            TR_MAT(a.in[I_CW2] + (size_t)(l * 2 + kv) * 256 * 64, 256, 64, 64, (const float*)nullptr, wl + W_C2 + (size_t)kv * 64 * 256 * 2)
        }
    }
#undef TR_MAT
    if constexpr (DO_X) { const float* x = a.in[I_X]; bf16_t* XB = (bf16_t*)(ws + WS_XB);
      for (int r = gw; r < NTOK; r += NGW) { const f32x4* xr = (const f32x4*)(x + (size_t)r * 1024) + lane; unsigned long long* xb = (unsigned long long*)(XB + (size_t)r * 1024) + lane; float s = 0.f;
#pragma unroll
          for (int j = 0; j < 4; ++j) { const f32x4 v = xr[64 * j]; s += (v[0] * v[0] + v[1] * v[1]) + (v[2] * v[2] + v[3] * v[3]); xb[64 * j] = (unsigned long long)cvt_pk_bf16(v[0], v[1]) | ((unsigned long long)cvt_pk_bf16(v[2], v[3]) << 32); }
          s = wave_sum(s); if (lane < 16) ((float*)(ws + WS_SSQP))[(size_t)r * 16 + lane] = lane == 0 ? s : 0.f; } }
    if constexpr (DO_X) { const float* mem = a.in[I_MEM]; bf16_t* MB = (bf16_t*)(ws + WS_MEMB);
      for (int r = gw; r < 1024; r += NGW) { const f32x4* xr = (const f32x4*)(mem + (size_t)r * 1024) + lane; unsigned long long* xb = (unsigned long long*)(MB + (size_t)r * 1024) + lane; float s = 0.f;
#pragma unroll
          for (int j = 0; j < 4; ++j) { const f32x4 v = xr[64 * j]; s += (v[0] * v[0] + v[1] * v[1]) + (v[2] * v[2] + v[3] * v[3]); xb[64 * j] = (unsigned long long)cvt_pk_bf16(v[0], v[1]) | ((unsigned long long)cvt_pk_bf16(v[2], v[3]) << 32); }
          s = wave_sum(s); if (lane == 0) ctl[SSQ_MEM_OFF + r] = s; } }
    for (int it = gw; it < 4 * 32; it += NGW) { const int lk = it >> 5, j0 = (it & 31) * 8; const float* W1 = a.in[I_CW1] + (size_t)lk * 2048 * 256 + j0; const float* pos = a.in[I_CPOS] + (size_t)lk * 2048;
        float acc[8];
#pragma unroll
        for (int e = 0; e < 8; ++e) acc[e] = 0.f;
#pragma unroll 8
        for (int i = 0; i < 32; ++i) { const int k = i * 64 + lane; const float p = pos[k]; const f32x4 w0 = *(const f32x4*)(W1 + (size_t)k * 256), w1 = *(const f32x4*)(W1 + (size_t)k * 256 + 4);
#pragma unroll
            for (int e = 0; e < 4; ++e) { acc[e] += p * w0[e]; acc[4 + e] += p * w1[e]; } }
#pragma unroll
        for (int e = 0; e < 8; ++e) acc[e] = wave_sum(acc[e]);
        if (lane == 0) { float* dst = (float*)(ws + WS_W + (lk >> 1) * W_LAYER + W_B1P) + (lk & 1) * 256 + j0;
#pragma unroll
            for (int e = 0; e < 8; ++e) dst[e] = acc[e] + a.in[I_CB1][lk * 256 + j0 + e]; } }
    for (int it = gw; it < 2 * 8 * 128; it += NGW) { const int t = it & 127; const float* wr = a.in[I_SGW] + (size_t)it * 128; unsigned* dst = (unsigned*)(ws + WS_W + (it >> 10) * W_LAYER + W_SG) + (size_t)(it & 1023) * 64 + lane;
        float v[2];
#pragma unroll
        for (int e = 0; e < 2; ++e) { const int p = lane * 2 + e, ks = p >> 4, hh = (p >> 3) & 1, j = p & 7, sidx = 16 * ks + 8 * (j >> 2) + 4 * hh + (j & 3); v[e] = sidx <= t ? wr[sidx] : 0.f; }
        *dst = cvt_pk_bf16(v[0], v[1]); }
}

typedef float f32x16 __attribute__((ext_vector_type(16)));
typedef short s16x4 __attribute__((ext_vector_type(4)));
typedef short v4i16_t __attribute__((ext_vector_type(4)));
using pg8::bf16x8;
__device__ __forceinline__ int crow(int r, int hi) { return (r & 3) + 8 * (r >> 2) + 4 * hi; }
__device__ __forceinline__ s16x4 vtr(const LAS char* p) { return __builtin_bit_cast(s16x4, __builtin_amdgcn_ds_read_tr16_b64_v4i16((LAS v4i16_t*)p)); }
#define MFMA32(a, b, c) __builtin_amdgcn_mfma_f32_32x32x16_bf16(a, b, c, 0, 0, 0)
#define VFRAG(lo, hi) (bf16x8){lo[0], lo[1], lo[2], lo[3], hi[0], hi[1], hi[2], hi[3]}
__device__ __forceinline__ void lds_fadd(LAS float* p, float v) { (void)__hip_atomic_fetch_add(p, v, __ATOMIC_RELAXED, __HIP_MEMORY_SCOPE_WORKGROUP); }
__device__ __forceinline__ unsigned short f2bf(float f) { return (unsigned short)(cvt_pk_bf16(f, 0.f) & 0xffffu); }

__device__ __forceinline__ void tokprep_token(bf16_t* Q, bf16_t* KV, const float* qg, const float* kg, int tok, int lane) {
    { u32x4* p = (u32x4*)(Q + (size_t)tok * 512) + lane; const u32x4 w = *p; float v[8];
#pragma unroll
      for (int i = 0; i < 4; ++i) { v[2 * i] = __uint_as_float(w[i] << 16); v[2 * i + 1] = __uint_as_float(w[i] & 0xffff0000u); }
      float ss = 0.f;
#pragma unroll
      for (int i = 0; i < 8; ++i) ss += v[i] * v[i];
      ss += __shfl_xor(ss, 1); ss += __shfl_xor(ss, 2); ss += __shfl_xor(ss, 4);
      const float rs = rsqrtf(ss * (1.f / 64.f) + 1e-6f) * (0.125f * 1.4426950408889634f); const float* g = qg + (lane & 7) * 8;
      u32x4 o;
#pragma unroll
      for (int i = 0; i < 4; ++i) o[i] = cvt_pk_bf16(v[2 * i] * rs * g[2 * i], v[2 * i + 1] * rs * g[2 * i + 1]);
      *p = o; }
    if (lane < 32) { const int br = 1 + (lane >> 4); u32x4* p = (u32x4*)(KV + (size_t)tok * 768 + br * 256) + (lane & 15); const u32x4 w = *p; float v[8];
#pragma unroll
      for (int i = 0; i < 4; ++i) { v[2 * i] = __uint_as_float(w[i] << 16); v[2 * i + 1] = __uint_as_float(w[i] & 0xffff0000u); }
      float ss = 0.f;
#pragma unroll
      for (int i = 0; i < 8; ++i) ss += v[i] * v[i];
      ss += __shfl_xor(ss, 1); ss += __shfl_xor(ss, 2); ss += __shfl_xor(ss, 4);
      const float rs = rsqrtf(ss * (1.f / 64.f) + 1e-6f); const float* g = kg + br * 64 + (lane & 7) * 8;
      u32x4 o;
#pragma unroll
      for (int i = 0; i < 4; ++i) o[i] = cvt_pk_bf16(v[2 * i] * rs * g[2 * i], v[2 * i + 1] * rs * g[2 * i + 1]);
      *p = o; }
}
__device__ __forceinline__ void cmp2_row(const bf16_t* HID, const bf16_t* w2t, const float* b2, const float* kg0, bf16_t* KC, bf16_t* VC, int row, int lane) {
#pragma unroll 1
    for (int kv = 0; kv < 2; ++kv) { const u32x4* h = (const u32x4*)(HID + (size_t)kv * 2048 * 256 + (size_t)row * 256); const u32x4* w = (const u32x4*)(w2t + (size_t)kv * 64 * 256 + (size_t)lane * 256); float s = b2[kv * 64 + lane];
#pragma unroll 4
        for (int k = 0; k < 32; ++k) { const u32x4 a = h[k], b = w[k];
#pragma unroll
            for (int i = 0; i < 4; ++i) s += __uint_as_float(a[i] << 16) * __uint_as_float(b[i] << 16) + __uint_as_float(a[i] & 0xffff0000u) * __uint_as_float(b[i] & 0xffff0000u); }
        if (kv == 0) { const float ss = wave_sum(s * s); s = s * rsqrtf(ss * (1.f / 64.f) + 1e-6f) * kg0[lane]; }
        if ((row & 255) == 255) s = 0.f;
        (kv ? VC : KC)[(size_t)row * 64 + lane] = f2bf(s); }
}
__device__ __forceinline__ void memk_norm_item(bf16_t* KVM, const float* kg, int r, int lane) {
    unsigned* p = (unsigned*)(KVM + (size_t)(r >> 2) * 1024 + (r & 3) * 128) + lane; const unsigned w = *p; const float v0 = __uint_as_float(w << 16), v1 = __uint_as_float(w & 0xffff0000u);
    const float ss = wave_sum(v0 * v0 + v1 * v1); const float rs = rsqrtf(ss * (1.f / 128.f) + 1e-6f); *p = cvt_pk_bf16(v0 * rs * kg[2 * lane], v1 * rs * kg[2 * lane + 1]);
}

__device__ __forceinline__ void tokprep4(bf16_t* Q, bf16_t* KV, const float* qg, const float* kg, int t, int S, int lane) {
    u32x4 wq[4], wk[4]; const int br = 1 + ((lane >> 4) & 1);
#pragma unroll
    for (int i = 0; i < 4; ++i) { const int tt = t + i * S < NTOK ? t + i * S : NTOK - 1; wq[i] = *((const u32x4*)(Q + (size_t)tt * 512) + lane); wk[i] = *((const u32x4*)(KV + (size_t)tt * 768 + br * 256) + (lane & 15)); }
    f32x4 gq0 = *(const f32x4*)(qg + (lane & 7) * 8), gq1 = *(const f32x4*)(qg + (lane & 7) * 8 + 4), gk0 = *(const f32x4*)(kg + br * 64 + (lane & 7) * 8), gk1 = *(const f32x4*)(kg + br * 64 + (lane & 7) * 8 + 4);
#pragma unroll
    for (int i = 0; i < 4; ++i) { if (t + i * S >= NTOK) break; const int tt = t + i * S;
        { const u32x4 w = wq[i]; float v[8];
#pragma unroll
          for (int e = 0; e < 4; ++e) { v[2 * e] = __uint_as_float(w[e] << 16); v[2 * e + 1] = __uint_as_float(w[e] & 0xffff0000u); }
          float ss = 0.f;
#pragma unroll
          for (int e = 0; e < 8; ++e) ss += v[e] * v[e];
          ss += __shfl_xor(ss, 1); ss += __shfl_xor(ss, 2); ss += __shfl_xor(ss, 4);
          const float rs = rsqrtf(ss * (1.f / 64.f) + 1e-6f) * (0.125f * 1.4426950408889634f);
          u32x4 o; o[0] = cvt_pk_bf16(v[0] * rs * gq0[0], v[1] * rs * gq0[1]); o[1] = cvt_pk_bf16(v[2] * rs * gq0[2], v[3] * rs * gq0[3]); o[2] = cvt_pk_bf16(v[4] * rs * gq1[0], v[5] * rs * gq1[1]); o[3] = cvt_pk_bf16(v[6] * rs * gq1[2], v[7] * rs * gq1[3]);
          *((u32x4*)(Q + (size_t)tt * 512) + lane) = o; }
        { const u32x4 w = wk[i]; float v[8];
#pragma unroll
          for (int e = 0; e < 4; ++e) { v[2 * e] = __uint_as_float(w[e] << 16); v[2 * e + 1] = __uint_as_float(w[e] & 0xffff0000u); }
          float ss = 0.f;
#pragma unroll
          for (int e = 0; e < 8; ++e) ss += v[e] * v[e];
          ss += __shfl_xor(ss, 1); ss += __shfl_xor(ss, 2); ss += __shfl_xor(ss, 4);
          const float rs = rsqrtf(ss * (1.f / 64.f) + 1e-6f);
          u32x4 o; o[0] = cvt_pk_bf16(v[0] * rs * gk0[0], v[1] * rs * gk0[1]); o[1] = cvt_pk_bf16(v[2] * rs * gk0[2], v[3] * rs * gk0[3]); o[2] = cvt_pk_bf16(v[4] * rs * gk1[0], v[5] * rs * gk1[1]); o[3] = cvt_pk_bf16(v[6] * rs * gk1[2], v[7] * rs * gk1[3]);
          if (lane < 32) *((u32x4*)(KV + (size_t)tt * 768 + br * 256) + (lane & 15)) = o; } }
}
__device__ __forceinline__ void cmp2_tile(const bf16_t* HIDt, const bf16_t* w2t, const float* b2, const float* kg0, bf16_t* OUT) {
    int tid_ = threadIdx.x; asm volatile("" : "+v"(tid_)); const int lane = tid_ & 63, wave = __builtin_amdgcn_readfirstlane(tid_ >> 6), r32 = lane & 31, hi = lane >> 5; const int row = wave * 32 + r32;
    f32x16 acc[2];
#pragma unroll
    for (int r = 0; r < 16; ++r) { acc[0][r] = 0.f; acc[1][r] = 0.f; }
#pragma unroll 4
    for (int ks = 0; ks < 16; ++ks) { const bf16x8 bfr = *(const bf16x8*)(HIDt + (size_t)row * 256 + ks * 16 + hi * 8);
        const bf16x8 a0 = *(const bf16x8*)(w2t + (size_t)r32 * 256 + ks * 16 + hi * 8), a1 = *(const bf16x8*)(w2t + (size_t)(32 + r32) * 256 + ks * 16 + hi * 8);
        acc[0] = MFMA32(a0, bfr, acc[0]); acc[1] = MFMA32(a1, bfr, acc[1]); }
    float ss = 0.f;
#pragma unroll
    for (int h = 0; h < 2; ++h)
#pragma unroll
        for (int r = 0; r < 16; ++r) { const float v = acc[h][r] + b2[32 * h + crow(r, hi)]; acc[h][r] = v; ss += v * v; }
    if (kg0) { ss += __shfl_xor(ss, 32); const float rs = rsqrtf(ss * (1.f / 64.f) + 1e-6f);
#pragma unroll
        for (int h = 0; h < 2; ++h)
#pragma unroll
            for (int r = 0; r < 16; ++r) acc[h][r] *= rs * kg0[32 * h + crow(r, hi)]; }
    const float keep = row == 255 ? 0.f : 1.f;
#pragma unroll
    for (int h = 0; h < 2; ++h)
#pragma unroll
        for (int a4 = 0; a4 < 4; ++a4) { u32x2 w; w.x = cvt_pk_bf16(acc[h][4 * a4] * keep, acc[h][4 * a4 + 1] * keep); w.y = cvt_pk_bf16(acc[h][4 * a4 + 2] * keep, acc[h][4 * a4 + 3] * keep); *(u32x2*)(OUT + (size_t)row * 64 + 32 * h + 8 * a4 + 4 * hi) = w; }
}

constexpr int SG_STAT = 0, SG_SSQ = 1024, SG_VN = 5120;
__device__ __forceinline__ void sgu_unit(LAS unsigned char* lds, int unit, const bf16_t* U, const bf16_t* Vb, const bf16_t* Wsg, const float* lng, const float* lnb, const float* sgb, bf16_t* MIX) {
    int tid_ = threadIdx.x; asm volatile("" : "+v"(tid_)); const int tid = tid_, lane = tid & 63, g = __builtin_amdgcn_readfirstlane(tid >> 6), r32 = lane & 31, hi = lane >> 5;
    const int tok0 = unit * 128;
    LAS float* STAT = (LAS float*)(lds + SG_STAT); LAS float* SSQA = (LAS float*)(lds + SG_SSQ);
    { const int tl = tid >> 2, part = tid & 3; const u32x4* p = (const u32x4*)(Vb + (size_t)(tok0 + tl) * 512 + part * 128); float s = 0.f, s2 = 0.f;
#pragma unroll 4
      for (int i = 0; i < 16; ++i) { const u32x4 w = p[i];
#pragma unroll
          for (int e = 0; e < 4; ++e) { const float a = __uint_as_float(w[e] << 16), b = __uint_as_float(w[e] & 0xffff0000u); s += a + b; s2 += a * a + b * b; } }
      s += __shfl_xor(s, 1); s += __shfl_xor(s, 2); s2 += __shfl_xor(s2, 1); s2 += __shfl_xor(s2, 2);
      if (part == 0) { const float mu = s * (1.f / 512.f); const float var = fmaxf(s2 * (1.f / 512.f) - mu * mu, 0.f); STAT[tl * 2] = mu; STAT[tl * 2 + 1] = rsqrtf(var + 1e-6f); }
      }
    __syncthreads();
    LAS unsigned char* VN = lds + SG_VN + g * 16384;
    { const int piece = lane & 7; float gg[8], bb[8];
#pragma unroll
      for (int i = 0; i < 8; ++i) { gg[i] = lng[g * 64 + piece * 8 + i]; bb[i] = lnb[g * 64 + piece * 8 + i]; }
#pragma unroll 4
      for (int it = 0; it < 16; ++it) { const int row = it * 8 + (lane >> 3); const u32x4 w = *(const u32x4*)(Vb + (size_t)(tok0 + row) * 512 + g * 64 + piece * 8); const float mu = STAT[row * 2], rs = STAT[row * 2 + 1]; u32x4 o;
#pragma unroll
          for (int e = 0; e < 4; ++e) { const float a = (__uint_as_float(w[e] << 16) - mu) * rs * gg[2 * e] + bb[2 * e], b = (__uint_as_float(w[e] & 0xffff0000u) - mu) * rs * gg[2 * e + 1] + bb[2 * e + 1]; o[e] = cvt_pk_bf16(a, b); }
          *(LAS u32x4*)(VN + (piece >> 2) * 8192 + row * 64 + (piece & 3) * 16) = o; } }
    asm volatile("s_waitcnt lgkmcnt(0)" ::: "memory");
    f32x16 acc[2][4];
#pragma unroll
    for (int dh = 0; dh < 2; ++dh)
#pragma unroll
        for (int mt = 0; mt < 4; ++mt)
#pragma unroll
            for (int r = 0; r < 16; ++r) acc[dh][mt][r] = 0.f;
    const LAS char* vb = (const LAS char*)VN + ((lane >> 4) & 1) * 32 + (lane & 3) * 8 + (4 * hi + ((lane & 15) >> 2)) * 64;
    const bf16_t* wrow = Wsg + ((size_t)g * 128 + r32) * 128 + 8 * hi;
#pragma unroll
    for (int ks = 0; ks < 8; ++ks) { bf16x8 vf[2];
#pragma unroll
        for (int dh = 0; dh < 2; ++dh) { const s16x4 lo = vtr(vb + dh * 8192 + ks * 1024), hh = vtr(vb + dh * 8192 + ks * 1024 + 512); vf[dh] = VFRAG(lo, hh); }
#pragma unroll
        for (int mt = 0; mt < 4; ++mt) { if (ks <= 2 * mt + 1) { const bf16x8 wf = *(const bf16x8*)(wrow + (size_t)mt * 32 * 128 + ks * 16);
                acc[0][mt] = MFMA32(vf[0], wf, acc[0][mt]); acc[1][mt] = MFMA32(vf[1], wf, acc[1][mt]); } } }
#pragma unroll
    for (int mt = 0; mt < 4; ++mt) { const int t = mt * 32 + r32; const float bias = sgb[g * 128 + t]; const bf16_t* up = U + (size_t)(tok0 + t) * 512 + g * 64 + 4 * hi; float ss = 0.f;
#pragma unroll
        for (int dh = 0; dh < 2; ++dh)
#pragma unroll
            for (int a4 = 0; a4 < 4; ++a4) { const u32x2 w = *(const u32x2*)(up + dh * 32 + a4 * 8);
                const float u0 = __uint_as_float(w.x << 16), u1 = __uint_as_float(w.x & 0xffff0000u), u2 = __uint_as_float(w.y << 16), u3 = __uint_as_float(w.y & 0xffff0000u);
                float x0 = u0 * (acc[dh][mt][4 * a4] + bias), x1 = u1 * (acc[dh][mt][4 * a4 + 1] + bias), x2 = u2 * (acc[dh][mt][4 * a4 + 2] + bias), x3 = u3 * (acc[dh][mt][4 * a4 + 3] + bias);
                acc[dh][mt][4 * a4] = x0; acc[dh][mt][4 * a4 + 1] = x1; acc[dh][mt][4 * a4 + 2] = x2; acc[dh][mt][4 * a4 + 3] = x3; ss += (x0 * x0 + x1 * x1) + (x2 * x2 + x3 * x3); }
        ss += __shfl_xor(ss, 32); if (hi == 0) SSQA[g * 128 + t] = ss; }
    __syncthreads();
#pragma unroll
    for (int mt = 0; mt < 4; ++mt) { const int t = mt * 32 + r32; float sa = 0.f;
#pragma unroll
        for (int w8 = 0; w8 < 8; ++w8) sa += SSQA[w8 * 128 + t];
        const float rs = rsqrtf(sa * (1.f / 512.f) + 1e-6f); bf16_t* op = MIX + (size_t)(tok0 + t) * 1024 + g * 64 + 4 * hi;
#pragma unroll
        for (int dh = 0; dh < 2; ++dh)
#pragma unroll
            for (int a4 = 0; a4 < 4; ++a4) { u32x2 w; w.x = cvt_pk_bf16(acc[dh][mt][4 * a4] * rs, acc[dh][mt][4 * a4 + 1] * rs); w.y = cvt_pk_bf16(acc[dh][mt][4 * a4 + 2] * rs, acc[dh][mt][4 * a4 + 3] * rs); *(u32x2*)(op + dh * 32 + a4 * 8) = w; } }
    __syncthreads();
}

constexpr int A_KB = 0, A_VB = 32768, A_IMPH = 65536, A_LINV = 132096, A_MASK = 133120, A_SSQ = 133632  ;
__device__ __forceinline__ void attn_cmp(LAS unsigned char* lds, const bf16_t* Kb, const bf16_t* Vb, int ntc, const bf16x8 (&qr)[4], f32x16 (&oT)[2], float& lsum,
                                         int kmin, int kmax, int kvh, int wave, int lane, int r32, int hi) {
    const int pitch = 64, hstride = 256 * 64;
    u32x4 sk0, sk1, sv0, sv1;
    const bf16_t* kthr = Kb + (size_t)lane * pitch + wave * 8; const bf16_t* vthr = Vb + (size_t)(16 * (wave & 3) + (lane >> 2)) * pitch + (wave >> 2) * 32 + (lane & 3) * 8;
    const int sdst = wave * 1024 + lane * 16;
#define A_LD(tile) do { const size_t to_ = (size_t)(tile) * 64 * pitch; sk0 = *(const u32x4*)(kthr + to_); sk1 = *(const u32x4*)(kthr + to_ + hstride); sv0 = *(const u32x4*)(vthr + to_); sv1 = *(const u32x4*)(vthr + to_ + hstride); } while (0)
#define A_ST(so) do { *(LAS u32x4*)(lds + A_KB + (so) + sdst) = sk0; *(LAS u32x4*)(lds + A_KB + (so) + 8192 + sdst) = sk1; *(LAS u32x4*)(lds + A_VB + (so) + sdst) = sv0; *(LAS u32x4*)(lds + A_VB + (so) + 8192 + sdst) = sv1; } while (0)
    const LAS char* kbase = (const LAS char*)(lds + A_KB) + kvh * 8192 + hi * 1024 + r32 * 16;
    const LAS char* vbase = (const LAS char*)(lds + A_VB) + kvh * 8192 + ((lane >> 4) & 1) * 32 + (lane & 3) * 8 + (4 * hi + ((lane & 15) >> 2)) * 64;
    LAS float* IMPH = (LAS float*)(lds + A_IMPH) + (wave * 32 + r32) * 65;
    float carry = 0.f;
    A_LD(0); A_ST(0); __syncthreads();
#pragma unroll 1
    for (int tile = 0; tile < ntc; ++tile) {
        const int so = (tile & 1) * 16384;
        if (tile + 1 < ntc) A_LD(tile + 1);
        bf16x8 kf[8];
#pragma unroll
        for (int d0 = 0; d0 < 4; ++d0) { kf[2 * d0] = *(const LAS bf16x8*)(kbase + so + d0 * 2048); kf[2 * d0 + 1] = *(const LAS bf16x8*)(kbase + so + d0 * 2048 + 512); }
        f32x16 p0, p1;
#pragma unroll
        for (int r = 0; r < 16; ++r) { p0[r] = 0.f; p1[r] = 0.f; }
#pragma unroll
        for (int d0 = 0; d0 < 4; ++d0) { p0 = MFMA32(kf[2 * d0], qr[d0], p0); p1 = MFMA32(kf[2 * d0 + 1], qr[d0], p1); }
        const int a = kmin - 64 * tile, bb = kmax - 64 * tile;
#pragma unroll
        for (int r = 0; r < 16; ++r) { p0[r] = __builtin_amdgcn_exp2f(p0[r]); p1[r] = __builtin_amdgcn_exp2f(p1[r]); }
        if (!__all(a <= 0 && bb >= 63)) { const unsigned span = (unsigned)(bb - a);
#pragma unroll
            for (int r = 0; r < 16; ++r) { const int rel = crow(r, hi); p0[r] = ((unsigned)(rel - a) <= span) ? p0[r] : 0.f; p1[r] = ((unsigned)(rel + 32 - a) <= span) ? p1[r] : 0.f; } }
        { float s = 0.f;
#pragma unroll
          for (int r = 0; r < 16; ++r) s += p0[r] + p1[r];
          lsum += s; }
        { float own[2][4], rcv[2][4];
#pragma unroll
          for (int a4 = 0; a4 < 4; ++a4) { const float h0 = 0.5f * p0[4 * a4 + 3], h1 = 0.5f * p1[4 * a4 + 3];
              own[0][a4] = (p0[4 * a4] + p0[4 * a4 + 1]) + (p0[4 * a4 + 2] + h0); own[1][a4] = (p1[4 * a4] + p1[4 * a4 + 1]) + (p1[4 * a4 + 2] + h1);
              rcv[0][a4] = __shfl_xor(h0, 32); rcv[1][a4] = __shfl_xor(h1, 32); }
#pragma unroll
          for (int h2 = 0; h2 < 2; ++h2)
#pragma unroll
              for (int a4 = 0; a4 < 4; ++a4) { const float fromprev = a4 > 0 ? rcv[h2][a4 - 1] : (h2 ? rcv[0][3] : carry);
                  IMPH[16 * tile + 8 * h2 + 2 * a4 + hi] = own[h2][a4] + (hi ? rcv[h2][a4] : fromprev); }
          carry = rcv[1][3]; }
        bf16x8 pa[4];
        { u32x4 w0, w1, w2, w3;
#pragma unroll
          for (int i = 0; i < 4; ++i) { w0[i] = cvt_pk_bf16(p0[2 * i], p0[2 * i + 1]); w1[i] = cvt_pk_bf16(p0[8 + 2 * i], p0[8 + 2 * i + 1]); w2[i] = cvt_pk_bf16(p1[2 * i], p1[2 * i + 1]); w3[i] = cvt_pk_bf16(p1[8 + 2 * i], p1[8 + 2 * i + 1]); }
          pa[0] = __builtin_bit_cast(bf16x8, w0); pa[1] = __builtin_bit_cast(bf16x8, w1); pa[2] = __builtin_bit_cast(bf16x8, w2); pa[3] = __builtin_bit_cast(bf16x8, w3); }
#pragma unroll
        for (int dh = 0; dh < 2; ++dh)
#pragma unroll
            for (int ks = 0; ks < 4; ++ks) { const s16x4 lo = vtr(vbase + so + dh * 4096 + ks * 1024), hh = vtr(vbase + so + dh * 4096 + ks * 1024 + 512); oT[dh] = MFMA32(VFRAG(lo, hh), pa[ks], oT[dh]); }
        if (tile + 1 < ntc) A_ST(so ^ 16384);
        __syncthreads();
    }
#undef A_LD
#undef A_ST
}

constexpr int A2_K = 0, A2_V = 49152, A2_SL = 16384;
#define SBAR() __builtin_amdgcn_sched_barrier(0)
#define PIN(x) asm volatile("" : "+v"(x))
#define WAIT_BAR(N) asm volatile("s_waitcnt vmcnt(" #N ") lgkmcnt(0)\n\ts_barrier" ::: "memory")
__device__ __forceinline__ void glds16(const void* g, unsigned lds_base) {
    unsigned sv; asm volatile("s_mov_b32 %0, m0\n\ts_mov_b32 m0, %2\n\ts_nop 0\n\tglobal_load_lds_dwordx4 %1, off\n\ts_mov_b32 m0, %0" : "=&s"(sv) : "v"(g), "s"(lds_base) : "memory"); }
__device__ __forceinline__ void range_mask(f32x16& c0, f32x16& c1, int a, int bb, int hi) {
    const unsigned span = (unsigned)(bb - a);
#pragma unroll
    for (int r = 0; r < 16; ++r) { const int rel = crow(r, hi); c0[r] = ((unsigned)(rel - a) <= span) ? c0[r] : -INFINITY; c1[r] = ((unsigned)(rel + 32 - a) <= span) ? c1[r] : -INFINITY; }
}
template <bool WIN>
__device__ __forceinline__ void attn_stream(LAS unsigned char* lds, const bf16_t* Kb, const bf16_t* Vb, int tlo, int NT, const bf16x8 (&qr)[4], f32x16 (&oT)[2], float& l_out,
                                            unsigned mlo, unsigned mhi, int tq, int kvh, int wave, int lane, int r32, int hi) {
    const unsigned lds0 = (unsigned)(uintptr_t)lds;
    const bf16_t* ksrc = Kb + (size_t)lane * 768 + wave * 8;
    const bf16_t* vsrc = Vb + (size_t)(16 * (wave & 3) + (lane >> 2)) * 768 + (wave >> 2) * 32 + (lane & 3) * 8;
    const unsigned kdst = lds0 + A2_K + wave * 1024, vdst = lds0 + A2_V + wave * 1024;
#define RFL(x) ((unsigned)__builtin_amdgcn_readfirstlane((int)(x)))
#define TCL(i) ((size_t)(tlo + ((i) < NT ? (i) : NT - 1)) * (64 * 768))
#define DMA_K(i, slot) do { const bf16_t* s_ = ksrc + TCL(i); glds16(s_, RFL(kdst + (slot))); glds16(s_ + 64, RFL(kdst + (slot) + 8192)); } while (0)
#define DMA_V(i, slot) do { const bf16_t* s_ = vsrc + TCL(i); glds16(s_, RFL(vdst + (slot))); glds16(s_ + 64, RFL(vdst + (slot) + 8192)); } while (0)
#define TMASK(idx_, a_, bb_, selm_) do { const int tt_ = tlo + (idx_); if (WIN) { a_ = tq - 511 - 64 * tt_; bb_ = tq - 64 * tt_; selm_ = ~0u; } \
        else { const unsigned s_ = tt_ < 32 ? (mlo >> tt_) & 1u : (mhi >> (tt_ - 32)) & 1u; a_ = -64 * tt_; bb_ = tq - 64 * tt_; selm_ = 0u - s_; } } while (0)
#define NEEDM(a_, bb_, selm_) (!__all((selm_) == 0u || ((a_) <= 0 && (bb_) >= 63)))
    const LAS char* kp0 = (const LAS char*)(lds + A2_K) + kvh * 8192 + hi * 1024 + r32 * 16;
    const LAS char* vp0 = (const LAS char*)(lds + A2_V) + kvh * 8192 + ((lane >> 4) & 1) * 32 + (lane & 3) * 8 + (4 * hi + ((lane & 15) >> 2)) * 64;
    asm volatile("s_waitcnt vmcnt(0)" ::: "memory");
    DMA_K(0, 0); DMA_V(0, 0); DMA_K(1, A2_SL); DMA_K(2, 2 * A2_SL);
    float l_reg = 0.f; f32x16 pA0, pA1, pB0, pB1; bf16x8 kf[8]; s16x4 vlo[8], vhi[8]; u32x4 pw0, pw1, pw2, pw3; unsigned selm_prev;
    const f32x16 zero16 = {0.f, 0.f, 0.f, 0.f, 0.f, 0.f, 0.f, 0.f, 0.f, 0.f, 0.f, 0.f, 0.f, 0.f, 0.f, 0.f};
    int sl_prev = 0, sl_cur = 0, sl_next = A2_SL;
#define ROT() do { sl_prev = sl_cur; sl_cur = sl_next; sl_next = (sl_next == 2 * A2_SL) ? 0 : sl_next + A2_SL; } while (0)
#define KLD(kp, d0) do { kf[2 * (d0)] = *(const LAS bf16x8*)((kp) + (d0) * 2048); kf[2 * (d0) + 1] = *(const LAS bf16x8*)((kp) + (d0) * 2048 + 512); } while (0)
    WAIT_BAR(6);
    KLD(kp0, 0); KLD(kp0, 1); KLD(kp0, 2); KLD(kp0, 3);
    pA0 = MFMA32(kf[0], qr[0], zero16); pA1 = MFMA32(kf[1], qr[0], zero16); pA0 = MFMA32(kf[2], qr[1], pA0); pA1 = MFMA32(kf[3], qr[1], pA1);
    pA0 = MFMA32(kf[4], qr[2], pA0); pA1 = MFMA32(kf[5], qr[2], pA1); pA0 = MFMA32(kf[6], qr[3], pA0); pA1 = MFMA32(kf[7], qr[3], pA1);
    { int a_, bb_; TMASK(0, a_, bb_, selm_prev); if (NEEDM(a_, bb_, selm_prev)) range_mask(pA0, pA1, a_, bb_, hi); }
#pragma unroll
    for (int r = 0; r < 16; ++r) { pA0[r] = __builtin_amdgcn_exp2f(pA0[r]); pA1[r] = __builtin_amdgcn_exp2f(pA1[r]); }
    WAIT_BAR(0);
    DMA_K(3, 0); DMA_V(1, A2_SL); ROT();
    KLD(kp0 + sl_cur, 0); KLD(kp0 + sl_cur, 1); KLD(kp0 + sl_cur, 2); KLD(kp0 + sl_cur, 3);
    WAIT_BAR(4);
#define PKW(P, i) cvt_pk_bf16(P[i], P[(i) + 1])
#define PAF(k) __builtin_bit_cast(bf16x8, pw##k)
#define VFR(i) VFRAG(vlo[i], vhi[i])
#define VRD(i) do { vlo[i] = vtr(vp_ + (((i) >> 2) * 4096 + ((i) & 3) * 1024)); vhi[i] = vtr(vp_ + (((i) >> 2) * 4096 + ((i) & 3) * 1024 + 512)); } while (0)
#define KRD(d0) do { KLD(kp0 + sl_next, d0); SBAR(); } while (0)
#define EX(v) __builtin_amdgcn_exp2f(v)
#define GAPA(MF, a0, a1, a2, a3, W0, W1, PW) do { MF; sacc += a0; sacc += a1; sacc += a2; sacc += a3; W0; W1; PIN(PW); PIN(sacc); SBAR(); } while (0)
#define GAPB(MF, X, i) do { MF; X[i] = EX(X[i]); X[(i) + 1] = EX(X[(i) + 1]); X[(i) + 2] = EX(X[(i) + 2]); X[(i) + 3] = EX(X[(i) + 3]); PIN(X); SBAR(); } while (0)
#define SELPW() do { if (!__all(selm_prev == ~0u)) { const u32x4 m_ = {selm_prev, selm_prev, selm_prev, selm_prev}; pw0 = pw0 & m_; pw1 = pw1 & m_; pw2 = pw2 & m_; pw3 = pw3 & m_; } } while (0)
#define STEP(C0, C1, P0, P1, idx) do { SBAR(); \
    const LAS char* vp_ = vp0 + sl_prev; \
    VRD(0); SBAR(); float sacc = P0[0] + P0[1]; \
                    GAPA(C0 = MFMA32(kf[0], qr[0], zero16), P0[2], P0[3], P0[4], P0[5],     pw0[0] = PKW(P0, 0),  pw0[1] = PKW(P0, 2),  pw0); \
    VRD(4); SBAR(); GAPA(C1 = MFMA32(kf[1], qr[0], zero16), P0[6], P0[7], P0[8], P0[9],     pw0[2] = PKW(P0, 4),  pw0[3] = PKW(P0, 6),  pw0); \
    VRD(1); SBAR(); GAPA(C0 = MFMA32(kf[2], qr[1], C0),     P0[10], P0[11], P0[12], P0[13], pw1[0] = PKW(P0, 8),  pw1[1] = PKW(P0, 10), pw1); \
    VRD(5); SBAR(); GAPA(C1 = MFMA32(kf[3], qr[1], C1),     P0[14], P0[15], P1[0], P1[1],   pw1[2] = PKW(P0, 12), pw1[3] = PKW(P0, 14), pw1); \
    VRD(2); SBAR(); GAPA(C0 = MFMA32(kf[4], qr[2], C0),     P1[2], P1[3], P1[4], P1[5],     pw2[0] = PKW(P1, 0),  pw2[1] = PKW(P1, 2),  pw2); \
    VRD(6); SBAR(); GAPA(C1 = MFMA32(kf[5], qr[2], C1),     P1[6], P1[7], P1[8], P1[9],     pw2[2] = PKW(P1, 4),  pw2[3] = PKW(P1, 6),  pw2); \
    VRD(3); SBAR(); GAPA(C0 = MFMA32(kf[6], qr[3], C0),     P1[10], P1[11], P1[12], P1[13], pw3[0] = PKW(P1, 8),  pw3[1] = PKW(P1, 10), pw3); \
    VRD(7); SBAR(); GAPA(C1 = MFMA32(kf[7], qr[3], C1),     P1[14], P1[15], 0.f, 0.f,       pw3[2] = PKW(P1, 12), pw3[3] = PKW(P1, 14), pw3); \
    l_reg += __uint_as_float(__float_as_uint(sacc) & selm_prev); SELPW(); \
    DMA_K((idx) + 3, sl_cur); DMA_V((idx) + 1, sl_next); \
    { int a_, bb_; unsigned selm_; TMASK(idx, a_, bb_, selm_); if (NEEDM(a_, bb_, selm_)) range_mask(C0, C1, a_, bb_, hi); selm_prev = selm_; } \
    SBAR(); \
    GAPB(oT[0] = MFMA32(VFR(0), PAF(0), oT[0]), C0, 0);            GAPB(oT[1] = MFMA32(VFR(4), PAF(0), oT[1]), C0, 4); \
    KRD(0); GAPB(oT[0] = MFMA32(VFR(1), PAF(1), oT[0]), C0, 8);    KRD(1); GAPB(oT[1] = MFMA32(VFR(5), PAF(1), oT[1]), C0, 12); \
    KRD(2); GAPB(oT[0] = MFMA32(VFR(2), PAF(2), oT[0]), C1, 0);    KRD(3); GAPB(oT[1] = MFMA32(VFR(6), PAF(2), oT[1]), C1, 4); \
    GAPB(oT[0] = MFMA32(VFR(3), PAF(3), oT[0]), C1, 8);            GAPB(oT[1] = MFMA32(VFR(7), PAF(3), oT[1]), C1, 12); \
    } while (0)
    int idx = 1;
#pragma unroll 1
    for (; idx + 1 < NT; idx += 2) {
        STEP(pB0, pB1, pA0, pA1, idx);     WAIT_BAR(4); ROT();
        STEP(pA0, pA1, pB0, pB1, idx + 1); WAIT_BAR(4); ROT();
    }
    if (idx < NT) { STEP(pB0, pB1, pA0, pA1, idx); WAIT_BAR(4); ROT(); pA0 = pB0; pA1 = pB1; }
    { float sacc = 0.f;
#pragma unroll
      for (int r = 0; r < 16; ++r) sacc += pA0[r] + pA1[r];
      l_reg += __uint_as_float(__float_as_uint(sacc) & selm_prev);
      pw0 = (u32x4){PKW(pA0, 0), PKW(pA0, 2), PKW(pA0, 4), PKW(pA0, 6)}; pw1 = (u32x4){PKW(pA0, 8), PKW(pA0, 10), PKW(pA0, 12), PKW(pA0, 14)};
      pw2 = (u32x4){PKW(pA1, 0), PKW(pA1, 2), PKW(pA1, 4), PKW(pA1, 6)}; pw3 = (u32x4){PKW(pA1, 8), PKW(pA1, 10), PKW(pA1, 12), PKW(pA1, 14)};
      SELPW();
      const LAS char* vp_ = vp0 + ((NT - 1) % 3) * A2_SL;
#pragma unroll
      for (int i = 0; i < 8; ++i) VRD(i);
      oT[0] = MFMA32(VFR(0), PAF(0), oT[0]); oT[1] = MFMA32(VFR(4), PAF(0), oT[1]); oT[0] = MFMA32(VFR(1), PAF(1), oT[0]); oT[1] = MFMA32(VFR(5), PAF(1), oT[1]);
      oT[0] = MFMA32(VFR(2), PAF(2), oT[0]); oT[1] = MFMA32(VFR(6), PAF(2), oT[1]); oT[0] = MFMA32(VFR(3), PAF(3), oT[0]); oT[1] = MFMA32(VFR(7), PAF(3), oT[1]); }
    WAIT_BAR(0);
    l_out = l_reg;
#undef RFL
#undef TCL
#undef DMA_K
#undef DMA_V
#undef TMASK
#undef NEEDM
#undef ROT
#undef KLD
#undef PKW
#undef PAF
#undef VFR
#undef VRD
#undef KRD
#undef EX
#undef GAPA
#undef GAPB
#undef SELPW
#undef STEP
}

template <int PARTS>
__device__ __forceinline__ void attn_unit(LAS unsigned char* lds, int b, int qt, const bf16_t* Q, const bf16_t* KV, const bf16_t* KC, const bf16_t* VC, const float* GL, bf16_t* MIX) {
    int tid_ = threadIdx.x; asm volatile("" : "+v"(tid_)); const int tid = tid_, lane = tid & 63, wave = __builtin_amdgcn_readfirstlane(tid >> 6), r32 = lane & 31, hi = lane >> 5, kvh = wave >> 2;
    const int t0 = qt * 32, tq = t0 + r32; const size_t tok = (size_t)b * T + tq;
    bf16x8 qr[4];
#pragma unroll
    for (int d0 = 0; d0 < 4; ++d0) qr[d0] = *(const bf16x8*)(Q + tok * 512 + wave * 64 + d0 * 16 + hi * 8);
    LAS float* IMPHA = (LAS float*)(lds + A_IMPH); LAS float* LINV = (LAS float*)(lds + A_LINV); LAS unsigned* MASKL = (LAS unsigned*)(lds + A_MASK); LAS float* SSQL = (LAS float*)(lds + A_SSQ);
    const float* glp = GL + tok * 24 + wave * 3;
    const float g0 = 1.f / (1.f + __expf(-glp[0])), g1 = 1.f / (1.f + __expf(-glp[1])), g2 = 1.f / (1.f + __expf(-glp[2]));
    f32x16 tot[2], oT[2];
    const int nvalid = tq >= 31 ? (tq - 31) / 16 + 1 : 0; const int ntc = (2 * qt + 1 + 63) >> 6;
    const int ckmin = nvalid > 0 ? 0 : (1 << 20), ckmax = nvalid > 0 ? nvalid - 1 : (1 << 20);
    const bf16_t* KCb = KC + (size_t)(b * 2) * 256 * 64; const bf16_t* VCb = VC + (size_t)(b * 2) * 256 * 64;
    float lc = 0.f;
#pragma unroll
    for (int r = 0; r < 16; ++r) { oT[0][r] = 0.f; oT[1][r] = 0.f; }
    if constexpr (PARTS & 1) attn_cmp(lds, KCb, VCb, ntc, qr, oT, lc, ckmin, ckmax, kvh, wave, lane, r32, hi);
    lc += __shfl_xor(lc, 32); const float inv_lc = lc > 0.f ? 1.f / lc : 0.f;
    if (hi == 0) LINV[wave * 32 + r32] = inv_lc;
    { const float c = g0 * inv_lc;
#pragma unroll
      for (int r = 0; r < 16; ++r) { tot[0][r] = oT[0][r] * c; tot[1][r] = oT[1][r] * c; oT[0][r] = 0.f; oT[1][r] = 0.f; } }
    __syncthreads();
    if constexpr (PARTS & 2) {
#pragma unroll 1
      for (int i = 0; i < 8; ++i) { const int pair = wave * 8 + i, kvp = pair >> 5, qq = pair & 31, j = lane; const int tb = (t0 + qq) >> 6; float v = 0.f;
#pragma unroll
          for (int g = 0; g < 4; ++g) v += IMPHA[((kvp * 4 + g) * 32 + qq) * 65 + j] * LINV[(kvp * 4 + g) * 32 + qq];
          const bool forced = (j == 0) || (j == tb) || (j == tb - 1); const float val = forced ? 1e4f : (j <= tb ? v : -1e4f);
          unsigned key = __float_as_uint(val); key ^= (key & 0x80000000u) ? 0xffffffffu : 0x80000000u; key = (key & ~63u) | (unsigned)(63 - j);
          unsigned prefix = 0u;
#pragma unroll
          for (int bit = 31; bit >= 0; --bit) { const unsigned tt = prefix | (1u << bit); const int cnt = __popcll(__ballot(key >= tt)); prefix = cnt >= 16 ? tt : prefix; }
          const unsigned long long m = __ballot(key >= prefix);
          if (lane == 0) { MASKL[pair * 2] = (unsigned)m; MASKL[pair * 2 + 1] = (unsigned)(m >> 32); } } }
    __syncthreads();
    const unsigned mlo = MASKL[(kvh * 32 + r32) * 2], mhi = MASKL[(kvh * 32 + r32) * 2 + 1];
    const int jmax = (t0 + 31) >> 6;
    const bf16_t* KVb = KV + (size_t)b * T * 768;
    unsigned totp[16];
#pragma unroll
    for (int i = 0; i < 8; ++i) { totp[i] = cvt_pk_bf16(tot[0][2 * i], tot[0][2 * i + 1]); totp[8 + i] = cvt_pk_bf16(tot[1][2 * i], tot[1][2 * i + 1]); }
    float ls = 0.f;
    if constexpr (PARTS & 4) attn_stream<false>(lds, KVb + 256, KVb + 384, 0, jmax + 1, qr, oT, ls, mlo, mhi, tq, kvh, wave, lane, r32, hi);
    ls += __shfl_xor(ls, 32);
    { const float c = ls > 0.f ? g1 / ls : 0.f;
#pragma unroll
      for (int i = 0; i < 8; ++i) { totp[i] = cvt_pk_bf16(__uint_as_float(totp[i] << 16) + oT[0][2 * i] * c, __uint_as_float(totp[i] & 0xffff0000u) + oT[0][2 * i + 1] * c);
                                    totp[8 + i] = cvt_pk_bf16(__uint_as_float(totp[8 + i] << 16) + oT[1][2 * i] * c, __uint_as_float(totp[8 + i] & 0xffff0000u) + oT[1][2 * i + 1] * c); }
#pragma unroll
      for (int r = 0; r < 16; ++r) { oT[0][r] = 0.f; oT[1][r] = 0.f; } }
    float lw = 0.f; const int jlo = t0 >= 511 ? (t0 - 511) >> 6 : 0;
    if constexpr (PARTS & 8) attn_stream<true>(lds, KVb + 512, KVb + 640, jlo, jmax - jlo + 1, qr, oT, lw, 0u, 0u, tq, kvh, wave, lane, r32, hi);
    lw += __shfl_xor(lw, 32);
    { const float c = lw > 0.f ? g2 / lw : 0.f;
#pragma unroll
      for (int i = 0; i < 8; ++i) { tot[0][2 * i] = __uint_as_float(totp[i] << 16) + oT[0][2 * i] * c; tot[0][2 * i + 1] = __uint_as_float(totp[i] & 0xffff0000u) + oT[0][2 * i + 1] * c;
                                    tot[1][2 * i] = __uint_as_float(totp[8 + i] << 16) + oT[1][2 * i] * c; tot[1][2 * i + 1] = __uint_as_float(totp[8 + i] & 0xffff0000u) + oT[1][2 * i + 1] * c; } }
    { float ss = 0.f;
#pragma unroll
      for (int r = 0; r < 16; ++r) ss += tot[0][r] * tot[0][r] + tot[1][r] * tot[1][r];
      ss += __shfl_xor(ss, 32); if (hi == 0) SSQL[wave * 32 + r32] = ss; }
    __syncthreads();
    { float sa = 0.f;
#pragma unroll
      for (int w8 = 0; w8 < 8; ++w8) sa += SSQL[w8 * 32 + r32];
      const float rs = rsqrtf(sa * (1.f / 512.f) + 1e-6f); bf16_t* op = MIX + tok * 1024 + 512 + wave * 64 + 4 * hi;
#pragma unroll
      for (int dh = 0; dh < 2; ++dh)
#pragma unroll
          for (int a4 = 0; a4 < 4; ++a4) { u32x2 w; w.x = cvt_pk_bf16(tot[dh][4 * a4] * rs, tot[dh][4 * a4 + 1] * rs); w.y = cvt_pk_bf16(tot[dh][4 * a4 + 2] * rs, tot[dh][4 * a4 + 3] * rs); *(u32x2*)(op + dh * 32 + a4 * 8) = w; } }
    __syncthreads();
}

__device__ __forceinline__ void memattn_unit(LAS unsigned char* lds, int b, int h, int qt, const bf16_t* QM, const bf16_t* KVM, const float* qg, bf16_t* OM) {
    int tid_ = threadIdx.x; asm volatile("" : "+v"(tid_)); const int tid = tid_, lane = tid & 63, wave = __builtin_amdgcn_readfirstlane(tid >> 6), r32 = lane & 31, hi = lane >> 5;
    const size_t tok = (size_t)b * T + qt * 256 + wave * 32 + r32;
    bf16x8 qr[8];
    { float v[64]; float ss = 0.f;
#pragma unroll
      for (int d0 = 0; d0 < 8; ++d0) { const u32x4 w = *(const u32x4*)(QM + tok * 512 + h * 128 + d0 * 16 + hi * 8);
#pragma unroll
          for (int i = 0; i < 4; ++i) { const float a = __uint_as_float(w[i] << 16), c = __uint_as_float(w[i] & 0xffff0000u); v[d0 * 8 + 2 * i] = a; v[d0 * 8 + 2 * i + 1] = c; ss += a * a + c * c; } }
      ss += __shfl_xor(ss, 32); const float rs = rsqrtf(ss * (1.f / 128.f) + 1e-6f) * (0.08838834764831845f * 1.4426950408889634f);
#pragma unroll
      for (int d0 = 0; d0 < 8; ++d0) { u32x4 w; const float* gp = qg + d0 * 16 + hi * 8;
#pragma unroll
          for (int i = 0; i < 4; ++i) w[i] = cvt_pk_bf16(v[d0 * 8 + 2 * i] * rs * gp[2 * i], v[d0 * 8 + 2 * i + 1] * rs * gp[2 * i + 1]);
          qr[d0] = __builtin_bit_cast(bf16x8, w); } }
    const bf16_t* Kg = KVM + (size_t)b * 256 * 1024 + h * 128; const bf16_t* Vg = Kg + 512;
    u32x4 sk[2], sv[2];
#define M_LD(tile) do { _Pragma("unroll") for (int i = 0; i < 2; ++i) { sk[i] = *(const u32x4*)(Kg + (size_t)((tile) * 64 + lane) * 1024 + (wave * 2 + i) * 8); const int p = i * 512 + tid; \
        sv[i] = *(const u32x4*)(Vg + (size_t)((tile) * 64 + ((p & 255) >> 2)) * 1024 + (p >> 8) * 32 + (p & 3) * 8); } } while (0)
#define M_ST(so) do { _Pragma("unroll") for (int i = 0; i < 2; ++i) { *(LAS u32x4*)(lds + (so) + (wave * 2 + i) * 1024 + lane * 16) = sk[i]; *(LAS u32x4*)(lds + 32768 + (so) + (i * 512 + tid) * 16) = sv[i]; } } while (0)
    const LAS char* kbase = (const LAS char*)lds + hi * 1024 + r32 * 16;
    const LAS char* vbase = (const LAS char*)lds + 32768 + ((lane >> 4) & 1) * 32 + (lane & 3) * 8 + (4 * hi + ((lane & 15) >> 2)) * 64;
    f32x16 oT[4]; float lsum = 0.f;
#pragma unroll
    for (int dq = 0; dq < 4; ++dq)
#pragma unroll
        for (int r = 0; r < 16; ++r) oT[dq][r] = 0.f;
    M_LD(0); M_ST(0); __syncthreads();
#pragma unroll 1
    for (int tile = 0; tile < 4; ++tile) { const int so = (tile & 1) * 16384;
        if (tile < 3) M_LD(tile + 1);
        f32x16 p0, p1;
#pragma unroll
        for (int r = 0; r < 16; ++r) { p0[r] = 0.f; p1[r] = 0.f; }
#pragma unroll
        for (int d0 = 0; d0 < 8; ++d0) { const bf16x8 k0 = *(const LAS bf16x8*)(kbase + so + d0 * 2048), k1 = *(const LAS bf16x8*)(kbase + so + d0 * 2048 + 512); p0 = MFMA32(k0, qr[d0], p0); p1 = MFMA32(k1, qr[d0], p1); }
        float s = 0.f;
#pragma unroll
        for (int r = 0; r < 16; ++r) { p0[r] = __builtin_amdgcn_exp2f(p0[r]); p1[r] = __builtin_amdgcn_exp2f(p1[r]); s += p0[r] + p1[r]; }
        lsum += s;
        bf16x8 pa[4];
        { u32x4 w0, w1, w2, w3;
#pragma unroll
          for (int i = 0; i < 4; ++i) { w0[i] = cvt_pk_bf16(p0[2 * i], p0[2 * i + 1]); w1[i] = cvt_pk_bf16(p0[8 + 2 * i], p0[8 + 2 * i + 1]); w2[i] = cvt_pk_bf16(p1[2 * i], p1[2 * i + 1]); w3[i] = cvt_pk_bf16(p1[8 + 2 * i], p1[8 + 2 * i + 1]); }
          pa[0] = __builtin_bit_cast(bf16x8, w0); pa[1] = __builtin_bit_cast(bf16x8, w1); pa[2] = __builtin_bit_cast(bf16x8, w2); pa[3] = __builtin_bit_cast(bf16x8, w3); }
#pragma unroll
        for (int dq = 0; dq < 4; ++dq)
#pragma unroll
            for (int ks = 0; ks < 4; ++ks) { const s16x4 lo = vtr(vbase + so + dq * 4096 + ks * 1024), hh = vtr(vbase + so + dq * 4096 + ks * 1024 + 512); oT[dq] = MFMA32(VFRAG(lo, hh), pa[ks], oT[dq]); }
        if (tile < 3) M_ST(so ^ 16384);
        __syncthreads();
    }
#undef M_LD
#undef M_ST
    lsum += __shfl_xor(lsum, 32); const float il = 1.f / lsum; bf16_t* op = OM + tok * 512 + h * 128 + 4 * hi;
#pragma unroll
    for (int dq = 0; dq < 4; ++dq)
#pragma unroll
        for (int a4 = 0; a4 < 4; ++a4) { u32x2 w; w.x = cvt_pk_bf16(oT[dq][4 * a4] * il, oT[dq][4 * a4 + 1] * il); w.y = cvt_pk_bf16(oT[dq][4 * a4 + 2] * il, oT[dq][4 * a4 + 3] * il); *(u32x2*)(op + dq * 32 + a4 * 8) = w; }
}

#define XB_TMO      128
#define XB_XCNT(j)  (256  + 64 * (j))
#define XB_XSUB(j)  (1280 + 64 * (j))
#define XB_XGEN(j)  (2304 + 64 * (j))
#define XB_TOP      3328
#define XB_TOPGEN   3392
#define XCD_BAR_WORDS 3456
#define XB_SPIN_CAP (1u << 18)
__device__ __forceinline__ unsigned xb_ld(unsigned* p)              { return __hip_atomic_load(p, __ATOMIC_RELAXED, __HIP_MEMORY_SCOPE_AGENT); }
__device__ __forceinline__ unsigned xb_add(unsigned* p, unsigned v) { return __hip_atomic_fetch_add(p, v, __ATOMIC_RELAXED, __HIP_MEMORY_SCOPE_AGENT); }
__device__ __forceinline__ unsigned xb_xcc_id() { return (unsigned)__builtin_amdgcn_s_getreg((3 << 11) | 20) & 0xFu; }
#define XB_SPIN(cond, bar) do { unsigned _sp = 0; while (cond) { __builtin_amdgcn_s_sleep(1); \
    if ((++_sp & 255u) == 0u) { if (xb_ld(&(bar)[XB_TMO])) break; if (_sp > XB_SPIN_CAP) { atomicAdd(&(bar)[XB_TMO], 1u); break; } } } } while (0)
struct XcdBarrier { unsigned* bar; unsigned x; volatile LAS unsigned* st; };
__device__ __forceinline__ XcdBarrier xcd_barrier_post(unsigned* bar, volatile LAS unsigned* st) {
    XcdBarrier b; b.bar = bar; b.x = xb_xcc_id(); b.st = st;
    if (threadIdx.x == 0) (void)xb_add(&bar[XB_XCNT(b.x)], 1u);
    return b;
}
__device__ __forceinline__ void xcd_barrier_complete(unsigned* bar, unsigned x, unsigned& nloc, unsigned& nx) {
    const unsigned G = gridDim.x * gridDim.y * gridDim.z;
    unsigned sum, cnt, mine, sp = 0u;
    for (;;) {
        sum = 0u; cnt = 0u; mine = 0u;
#pragma unroll
        for (unsigned j = 0; j < 16; ++j) { const unsigned c = xb_ld(&bar[XB_XCNT(j)]); sum += c; cnt += (c > 0u) ? 1u : 0u; mine = (j == x) ? c : mine; }
        if (sum == G) break;
        __builtin_amdgcn_s_sleep(1);
        if ((++sp & 255u) == 0u) { if (xb_ld(&bar[XB_TMO])) break; if (sp > XB_SPIN_CAP) { atomicAdd(&bar[XB_TMO], 1u); break; } }
    }
    nloc = mine > 0u ? mine : 1u; nx = cnt > 0u ? cnt : 1u;
}
__device__ __forceinline__ void xcd_barrier(const XcdBarrier& b) {
    asm volatile("s_waitcnt vmcnt(0)" ::: "memory");
    __syncthreads();
    if (threadIdx.x == 0) {
        unsigned* bar = b.bar;
        __builtin_amdgcn_s_waitcnt(0);
        unsigned nloc = b.st[0], nx = b.st[1];
        if (nloc == 0u) { xcd_barrier_complete(bar, b.x, nloc, nx); b.st[0] = nloc; b.st[1] = nx; }
        const unsigned old = xb_add(&bar[XB_XSUB(b.x)], 1u);
        const unsigned gen = old / nloc;
        if (old + 1u == (gen + 1u) * nloc) {
            __builtin_amdgcn_fence(__ATOMIC_RELEASE, "agent");
            asm volatile("s_waitcnt vmcnt(0)" ::: "memory");
            const unsigned og = xb_add(&bar[XB_TOP], 1u);
            const unsigned tg = og / nx;
            if (og + 1u == (tg + 1u) * nx) xb_add(&bar[XB_TOPGEN], 1u);
            else XB_SPIN(xb_ld(&bar[XB_TOPGEN]) == tg, bar);
            __builtin_amdgcn_fence(__ATOMIC_ACQUIRE, "agent");
            xb_add(&bar[XB_XGEN(b.x)], 1u);
            asm volatile("s_waitcnt vmcnt(0)" ::: "memory");
        } else {
            XB_SPIN(xb_ld(&bar[XB_XGEN(b.x)]) == gen, bar);
            __builtin_amdgcn_fence(__ATOMIC_ACQUIRE, "agent");
            asm volatile("s_waitcnt vmcnt(0)" ::: "memory");
        }
    }
    __syncthreads();
}
constexpr size_t CTL_BAR_BYTE = 704 * 1024;
constexpr int LDS_ST_OFF = 147456 - 64;

constexpr int LDS_BYTES = 147456;
#ifndef MK_REP3
#define MK_REP3 1
#endif
#ifndef MK_REP2
#define MK_REP2 1
#endif
#ifndef MK_REP6
#define MK_REP6 1
#endif
#ifndef MK_DBL_SYNC
#define MK_DBL_SYNC 0
#endif
__global__ void __launch_bounds__(512, 2) mega(Args args) {
    extern __shared__ __attribute__((aligned(16))) unsigned char lds_raw[];
    LAS unsigned char* lds = (LAS unsigned char*)lds_raw;
    const int G = gridDim.x, bx = blockIdx.x, NGW = G * 8;
    volatile LAS unsigned* bar_st = (volatile LAS unsigned*)(lds + LDS_ST_OFF);
    if (threadIdx.x < 2) bar_st[threadIdx.x] = 0u;
    if (bx == 0 && args.ph_lo == 0) { unsigned* bw = (unsigned*)(args.ws + WS_CTL + CTL_BAR_BYTE); for (int i = threadIdx.x; i < XCD_BAR_WORDS; i += 512) __hip_atomic_store(bw + i, 0u, __ATOMIC_RELAXED, __HIP_MEMORY_SCOPE_AGENT); }
    __syncthreads();
    XcdBarrier xbar; xbar.bar = (unsigned*)(args.ws + WS_CTL + CTL_BAR_BYTE); xbar.x = 0; xbar.st = bar_st;
    if (args.ph_lo == 0) { const int tid0 = threadIdx.x, wave0 = __builtin_amdgcn_readfirstlane(tid0 >> 6); for (int e_ = 0; e_ < 1 + MK_PROBE_PRO; ++e_) prologue<true>(args, lds, bx * 8 + wave0, NGW, wave0, tid0 & 63); }
    for (int ph = args.ph_lo > 1 ? args.ph_lo : 1; ph < args.ph_hi; ++ph) {
        if ((ph - 1) % 10 == 2) continue;
        if (ph > args.ph_lo) {
            if (ph == 1) { cooperative_groups::this_grid().sync(); xbar = xcd_barrier_post(xbar.bar, bar_st); }
            else xcd_barrier(xbar); }
        unsigned char* ws = args.ws; float* xout = args.out; asm volatile("" : "+s"(ws), "+s"(xout));
        int tidp = threadIdx.x; asm volatile("" : "+v"(tidp)); const int lane = tidp & 63, wave = __builtin_amdgcn_readfirstlane(tidp >> 6), gw = bx * 8 + wave;
        float* ctl = (float*)(ws + WS_CTL); bf16_t* XB = (bf16_t*)(ws + WS_XB); float* ssqp = (float*)(ws + WS_SSQP);
        const int l = (ph - 1) / 10, p = (ph - 1) % 10; unsigned char* wl = ws + WS_W + l * W_LAYER;
#if MK_DBL_SYNC
        for (int e_ = 0; e_ < MK_DBL_SYNC; ++e_) xcd_barrier(xbar);
#endif
        if (p == 0) {
            pg8::Gemm g = pg8::make_gemm(XB, (const bf16_t*)(wl + W_IN), 1024); pg8::StaticOrder S; S.init(NTOK, INP, G, bx);
            pg8::EpiInProj E{(bf16_t*)(ws + WS_U), (bf16_t*)(ws + WS_V), (bf16_t*)(ws + WS_Q), (bf16_t*)(ws + WS_KV), (float*)(ws + WS_GL), ssqp + (size_t)(l == 0 ? 0 : 3) * NTOK * 16};
            pg8::gemm_phase<pg8::EpiInProj, pg8::StaticOrder, true>(lds, g, S, E);
        } else if (p == 1) {
          for (int vb = bx; vb < 256; vb += G) {
            if (vb < 16) { const int kv = vb >> 3, pm = vb & 7;
                pg8::Gemm g; g.A = (const bf16_t*)(ws + WS_KV) + kv * 128; g.Bt = (const bf16_t*)(wl + W_C1 + (size_t)kv * 256 * 2048 * 2); g.K = 2048; g.lda = 16 * 768; g.kstepA = 768 * 2; g.a_s0 = 64 * 2; g.a_s1 = (size_t)T * 768 * 2;
                pg8::OneUnit S{1, {pm, 0}};
                bf16_t* hid = (bf16_t*)(ws + WS_HID) + (size_t)kv * 2048 * 256;
                pg8::EpiBf16G<1> E{hid, 256, (const float*)(wl + W_B1P) + kv * 256, nullptr, 0.f, 1};
                pg8::gemm_phase<pg8::EpiBf16G<1>, pg8::OneUnit, true>(lds, g, S, E);
                asm volatile("s_waitcnt vmcnt(0)" ::: "memory"); __syncthreads();
                cmp2_tile(hid + (size_t)pm * 256 * 256, (const bf16_t*)(wl + W_C2) + (size_t)kv * 64 * 256, args.in[I_CB2] + l * 128 + kv * 64, kv == 0 ? args.in[I_KNG] + l * 192 : (const float*)nullptr,
                          (bf16_t*)(ws + (kv ? WS_VC : WS_KC)) + (size_t)pm * 256 * 64);
            } else if (vb < 32) { const int i = vb - 16;
                pg8::Gemm g = pg8::make_gemm((const bf16_t*)(ws + WS_MEMB), (const bf16_t*)(wl + W_MKV), 1024); pg8::OneUnit S{1, {i >> 2, i & 3}};
                pg8::EpiBf16G<0> E{(bf16_t*)(ws + WS_KVM), 1024, nullptr, ctl + SSQ_MEM_OFF, 1.f / 1024.f, 1};
                pg8::gemm_phase<pg8::EpiBf16G<0>, pg8::OneUnit, true>(lds, g, S, E);
            } else if (vb < 160) {
                sgu_unit(lds, vb - 32, (const bf16_t*)(ws + WS_U), (const bf16_t*)(ws + WS_V), (const bf16_t*)(wl + W_SG), args.in[I_SGLNG] + l * 512, args.in[I_SGLNB] + l * 512, args.in[I_SGB] + l * 1024, (bf16_t*)(ws + WS_MIX));
            } else {
                for (int t = (vb - 160) * 8 + wave; t < NTOK; t += 4 * 768) tokprep4((bf16_t*)(ws + WS_Q), (bf16_t*)(ws + WS_KV), args.in[I_QNG] + l * 64, args.in[I_KNG] + l * 192, t, 768, lane);
            } }
        } else if (p == 3) {
            for (int r = gw; r < 4096; r += NGW) memk_norm_item((bf16_t*)(ws + WS_KVM), args.in[I_MKG] + l * 128, r, lane);
            for (int i_ = bx; i_ < 256 * MK_REP3; i_ += G) { const int i = i_ & 255, b = (i & 7) >> 1, idx = (i >> 3) * 2 + (i & 1);
                attn_unit<15>(lds, b, 127 - idx, (const bf16_t*)(ws + WS_Q), (const bf16_t*)(ws + WS_KV), (const bf16_t*)(ws + WS_KC), (const bf16_t*)(ws + WS_VC), (const float*)(ws + WS_GL), (bf16_t*)(ws + WS_MIX));
                attn_unit<15>(lds, b, idx, (const bf16_t*)(ws + WS_Q), (const bf16_t*)(ws + WS_KV), (const bf16_t*)(ws + WS_KC), (const bf16_t*)(ws + WS_VC), (const float*)(ws + WS_GL), (bf16_t*)(ws + WS_MIX)); }
        } else if (p == 6) {
            for (int i_ = bx; i_ < 256 * MK_REP6; i_ += G) { const int i = i_ & 255, b = (i & 7) >> 1, rest = (i >> 3) * 2 + (i & 1);
                memattn_unit(lds, b, rest >> 4, rest & 15, (const bf16_t*)(ws + WS_QM), (const bf16_t*)(ws + WS_KVM), args.in[I_MQG] + l * 128, (bf16_t*)(ws + WS_OM)); }
        } else if (p == 4) {
            pg8::Gemm g = pg8::make_gemm((const bf16_t*)(ws + WS_MIX), (const bf16_t*)(wl + W_OUT), 1024); pg8::StaticOrder S; S.init(NTOK, 1024, G, bx);
            pg8::EpiResid E{nullptr, XB, ssqp + (size_t)(l * 3 + 1) * NTOK * 16};
            pg8::gemm_phase<pg8::EpiResid, pg8::StaticOrder, true>(lds, g, S, E);
        } else if (p == 5) {
            pg8::Gemm g = pg8::make_gemm(XB, (const bf16_t*)(wl + W_MQ), 1024); pg8::StaticOrder S; S.init(NTOK, 512, G, bx);
            pg8::EpiBf16G<0> E{(bf16_t*)(ws + WS_QM), 512, nullptr, ssqp + (size_t)(l * 3 + 1) * NTOK * 16, 1.f / 1024.f, 16};
            pg8::gemm_phase<pg8::EpiBf16G<0>, pg8::StaticOrder, true>(lds, g, S, E);
        } else if (p == 7) {
            pg8::Gemm g = pg8::make_gemm((const bf16_t*)(ws + WS_OM), (const bf16_t*)(wl + W_MO), 512); pg8::StaticOrder S; S.init(NTOK, 1024, G, bx);
            pg8::EpiResid E{nullptr, XB, ssqp + (size_t)(l * 3 + 2) * NTOK * 16};
            pg8::gemm_phase<pg8::EpiResid, pg8::StaticOrder, true>(lds, g, S, E);
        } else if (p == 8) {
            pg8::Gemm g = pg8::make_gemm(XB, (const bf16_t*)(wl + W_FF1), 1024); pg8::StaticOrder S; S.init(NTOK, FF, G, bx);
            pg8::EpiBf16G<2> E{(bf16_t*)(ws + WS_HB), FF, nullptr, ssqp + (size_t)(l * 3 + 2) * NTOK * 16, 1.f / 1024.f, 16};
            pg8::gemm_phase<pg8::EpiBf16G<2>, pg8::StaticOrder, true>(lds, g, S, E);
        } else if (p == 9) {
            pg8::Gemm g = pg8::make_gemm((const bf16_t*)(ws + WS_HB), (const bf16_t*)(wl + W_FF2), FF); pg8::StaticOrder S; S.init(NTOK, 1024, G, bx);
            pg8::EpiResid E{l == 0 ? (float*)nullptr : xout, XB, ssqp + (size_t)3 * NTOK * 16};
            pg8::gemm_phase<pg8::EpiResid, pg8::StaticOrder, true>(lds, g, S, E);
        }
    }
#if MK_PROBE_N > 0
    if (args.ph_hi == 21) {
        unsigned char* ws = args.ws; unsigned char* wl = ws + WS_W + W_LAYER; float* ctl = (float*)(ws + WS_CTL); float* ssqp = (float*)(ws + WS_SSQP); (void)ctl;
        xcd_barrier(xbar);
        { pg8::Gemm g = pg8::make_gemm((const bf16_t*)(ws + WS_XB), (const bf16_t*)(wl + W_IN), 1024); pg8::StaticOrder S; S.init(NTOK, INP, G, bx);
          pg8::EpiInProj E{(bf16_t*)(ws + WS_U), (bf16_t*)(ws + WS_V), (bf16_t*)(ws + WS_Q), (bf16_t*)(ws + WS_KV), (float*)(ws + WS_GL), ssqp + (size_t)3 * NTOK * 16};
          pg8::gemm_phase<pg8::EpiInProj, pg8::StaticOrder, true>(lds, g, S, E); }
        xcd_barrier(xbar);
        { int tidp = threadIdx.x; asm volatile("" : "+v"(tidp)); const int lane = tidp & 63, wave = __builtin_amdgcn_readfirstlane(tidp >> 6), gw = bx * 8 + wave;
          for (int t = gw; t < NTOK; t += NGW) tokprep_token((bf16_t*)(ws + WS_Q), (bf16_t*)(ws + WS_KV), args.in[I_QNG] + 64, args.in[I_KNG] + 192, t, lane); }
        for (int e_ = 0; e_ < MK_PROBE_N; ++e_) { xcd_barrier(xbar);
            int tidp = threadIdx.x; asm volatile("" : "+v"(tidp)); const int lane = tidp & 63, wave = __builtin_amdgcn_readfirstlane(tidp >> 6), gw = bx * 8 + wave; (void)lane; (void)gw;
#if MK_PROBE_KIND == 3
            for (int i = bx; i < 256; i += G) { const int b = (i & 7) >> 1, idx = (i >> 3) * 2 + (i & 1);
                attn_unit<MK_PROBE_PARTS>(lds, b, 127 - idx, (const bf16_t*)(ws + WS_Q), (const bf16_t*)(ws + WS_KV), (const bf16_t*)(ws + WS_KC), (const bf16_t*)(ws + WS_VC), (const float*)(ws + WS_GL), (bf16_t*)(ws + WS_MIX));
                attn_unit<MK_PROBE_PARTS>(lds, b, idx, (const bf16_t*)(ws + WS_Q), (const bf16_t*)(ws + WS_KV), (const bf16_t*)(ws + WS_KC), (const bf16_t*)(ws + WS_VC), (const float*)(ws + WS_GL), (bf16_t*)(ws + WS_MIX)); }
#elif MK_PROBE_KIND == 0
            { pg8::Gemm g = pg8::make_gemm((const bf16_t*)(ws + WS_XB), (const bf16_t*)(wl + W_IN), 1024); pg8::StaticOrder S; S.init(NTOK, INP, G, bx);
              pg8::EpiInProj E{(bf16_t*)(ws + WS_U), (bf16_t*)(ws + WS_V), (bf16_t*)(ws + WS_Q), (bf16_t*)(ws + WS_KV), (float*)(ws + WS_GL), ssqp + (size_t)3 * NTOK * 16};
              pg8::gemm_phase<pg8::EpiInProj, pg8::StaticOrder, true>(lds, g, S, E); }
#elif MK_PROBE_KIND == 8
            { pg8::Gemm g = pg8::make_gemm((const bf16_t*)(ws + WS_XB), (const bf16_t*)(wl + W_FF1), 1024); pg8::StaticOrder S; S.init(NTOK, FF, G, bx);
              pg8::EpiBf16G<2> E{(bf16_t*)(ws + WS_HB), FF, nullptr, ssqp + (size_t)5 * NTOK * 16, 1.f / 1024.f, 16};
              pg8::gemm_phase<pg8::EpiBf16G<2>, pg8::StaticOrder, true>(lds, g, S, E); }
#elif MK_PROBE_KIND == 5
            { pg8::Gemm g = pg8::make_gemm((const bf16_t*)(ws + WS_XB), (const bf16_t*)(wl + W_MQ), 1024); pg8::StaticOrder S; S.init(NTOK, 512, G, bx);
              pg8::EpiBf16G<0> E{(bf16_t*)(ws + WS_QM), 512, nullptr, ssqp + (size_t)4 * NTOK * 16, 1.f / 1024.f, 16};
              pg8::gemm_phase<pg8::EpiBf16G<0>, pg8::StaticOrder, true>(lds, g, S, E); }
#elif MK_PROBE_KIND == 1
            if (bx < 16) { const int kv = bx >> 3, pm = bx & 7;
                pg8::Gemm g; g.A = (const bf16_t*)(ws + WS_KV) + kv * 128; g.Bt = (const bf16_t*)(wl + W_C1 + (size_t)kv * 256 * 2048 * 2); g.K = 2048; g.lda = 16 * 768; g.kstepA = 768 * 2; g.a_s0 = 64 * 2; g.a_s1 = (size_t)T * 768 * 2;
                pg8::OneUnit S{1, {pm, 0}};
                pg8::EpiBf16G<1> E{(bf16_t*)(ws + WS_HID) + (size_t)kv * 2048 * 256, 256, (const float*)(wl + W_B1P) + kv * 256, nullptr, 0.f, 1};
                pg8::gemm_phase<pg8::EpiBf16G<1>, pg8::OneUnit, true>(lds, g, S, E);
            } else if (bx < 32) { const int i = bx - 16;
                pg8::Gemm g = pg8::make_gemm((const bf16_t*)(ws + WS_MEMB), (const bf16_t*)(wl + W_MKV), 1024); pg8::OneUnit S{1, {i >> 2, i & 3}};
                pg8::EpiBf16G<0> E{(bf16_t*)(ws + WS_KVM), 1024, nullptr, ctl + SSQ_MEM_OFF, 1.f / 1024.f, 1};
                pg8::gemm_phase<pg8::EpiBf16G<0>, pg8::OneUnit, true>(lds, g, S, E); }
#elif MK_PROBE_KIND == 2
            for (int u = bx; u < 128; u += G) sgu_unit(lds, u, (const bf16_t*)(ws + WS_U), (const bf16_t*)(ws + WS_V), (const bf16_t*)(wl + W_SG), args.in[I_SGLNG] + 512, args.in[I_SGLNB] + 512, args.in[I_SGB] + 1024, (bf16_t*)(ws + WS_MIX));
            for (int t = gw; t < NTOK; t += NGW) tokprep_token((bf16_t*)(ws + WS_Q), (bf16_t*)(ws + WS_KV), args.in[I_QNG] + 64, args.in[I_KNG] + 192, t, lane);
            for (int r = gw; r < 2048; r += NGW) cmp2_row((const bf16_t*)(ws + WS_HID), (const bf16_t*)(wl + W_C2), args.in[I_CB2] + 128, args.in[I_KNG] + 192, (bf16_t*)(ws + WS_KC), (bf16_t*)(ws + WS_VC), r, lane);
#elif MK_PROBE_KIND == 4
            { pg8::Gemm g = pg8::make_gemm((const bf16_t*)(ws + WS_MIX), (const bf16_t*)(wl + W_OUT), 1024); pg8::StaticOrder S; S.init(NTOK, 1024, G, bx);
              pg8::EpiResid E{nullptr, (bf16_t*)(ws + WS_XB), ssqp + (size_t)2 * NTOK * 16};
              pg8::gemm_phase<pg8::EpiResid, pg8::StaticOrder, true>(lds, g, S, E); }
#elif MK_PROBE_KIND == 7
            { pg8::Gemm g = pg8::make_gemm((const bf16_t*)(ws + WS_OM), (const bf16_t*)(wl + W_MO), 512); pg8::StaticOrder S; S.init(NTOK, 1024, G, bx);
              pg8::EpiResid E{nullptr, (bf16_t*)(ws + WS_XB), ssqp + (size_t)2 * NTOK * 16};
              pg8::gemm_phase<pg8::EpiResid, pg8::StaticOrder, true>(lds, g, S, E); }
#elif MK_PROBE_KIND == 9
            { pg8::Gemm g = pg8::make_gemm((const bf16_t*)(ws + WS_HB), (const bf16_t*)(wl + W_FF2), FF); pg8::StaticOrder S; S.init(NTOK, 1024, G, bx);
              pg8::EpiResid E{nullptr, (bf16_t*)(ws + WS_XB), ssqp + (size_t)2 * NTOK * 16};
              pg8::gemm_phase<pg8::EpiResid, pg8::StaticOrder, true>(lds, g, S, E); }
#elif MK_PROBE_KIND == 100
            prologue<false>(args, lds, gw, NGW, wave, lane);
#elif MK_PROBE_KIND == 6
            for (int i = bx; i < 256; i += G) { const int b = (i & 7) >> 1, rest = (i >> 3) * 2 + (i & 1);
                memattn_unit(lds, b, rest >> 4, rest & 15, (const bf16_t*)(ws + WS_QM), (const bf16_t*)(ws + WS_KVM), args.in[I_MQG] + 128, (bf16_t*)(ws + WS_OM)); }
#endif
        }
    }
#endif
}

}

#ifndef MK_FUSED
#define MK_FUSED 1
#endif
extern "C" void kernel_launch(void* const* d_in, const int* in_sizes, int n_in, void* d_out, int out_size, void* d_ws, size_t ws_size, hipStream_t stream) {
    using namespace mk;
    static int grid = 0;
    if (!grid) { (void)hipFuncSetAttribute((const void*)mega, hipFuncAttributeMaxDynamicSharedMemorySize, LDS_BYTES);
        int dev = 0, cus = 0, per_cu = 0; (void)hipGetDevice(&dev); (void)hipDeviceGetAttribute(&cus, hipDeviceAttributeMultiprocessorCount, dev);
        (void)hipOccupancyMaxActiveBlocksPerMultiprocessor(&per_cu, (const void*)mega, 512, LDS_BYTES);
        grid = cus * (per_cu < 1 ? 1 : per_cu); if (grid > 256) grid = 256; }
    Args a{}; for (int i = 0; i < 27; ++i) a.in[i] = (const float*)d_in[i]; a.out = (float*)d_out; a.ws = (unsigned char*)d_ws;
#if MK_FUSED
    a.ph_lo = 0; a.ph_hi = 21; void* kargs[] = {&a};
    (void)hipLaunchCooperativeKernel((const void*)mega, dim3(grid), dim3(512), kargs, LDS_BYTES, stream);
#else
    for (int ph = 0; ph < 21; ++ph) { a.ph_lo = ph; a.ph_hi = ph + 1; hipLaunchKernelGGL(mega, dim3(grid), dim3(512), LDS_BYTES, stream, a); }
#endif
}
```

```cpp
#include <hip/hip_runtime.h>
#include <hip/hip_cooperative_groups.h>
#include <stdint.h>
#include <math.h>

namespace pg8 {
#define PG8_LAS __attribute__((address_space(3)))
typedef unsigned short bf16_t;
typedef short bf16x8 __attribute__((ext_vector_type(8)));
typedef float f32x4 __attribute__((ext_vector_type(4)));
typedef float f32x2 __attribute__((ext_vector_type(2)));
typedef unsigned u32x4 __attribute__((ext_vector_type(4)));
typedef unsigned u32x2 __attribute__((ext_vector_type(2)));
constexpr int BM = 256, BK = 64, HALF = 128, HTB = HALF * BK * 2, STAGE_BYTES = 8 * HTB, NXCD = 8, WGM = 8;

__host__ __device__ __forceinline__ int lds_byte(int r, int c) { const int st = (r >> 4) * 2 + (c >> 5), rr = r & 15, cc = c & 31, ob = rr * 64 + cc * 2; return st * 1024 + (ob ^ (((ob >> 9) & 1) << 5)); }
__host__ __device__ __forceinline__ void stage_rc(int b, int& R, int& C) { const int st = b / 1024, sb = b % 1024, swz = sb ^ (((sb >> 9) & 1) << 5); R = (st >> 1) * 16 + swz / 64; C = (st & 1) * 32 + (swz % 64) / 2; }
__host__ __device__ __forceinline__ int perm32(int rho) { const int n = rho >> 4, i = rho & 15; return 8 * (i >> 2) + 4 * n + (i & 3); }

struct Unit { int pm, pn; };
struct Gemm { const bf16_t* A; const bf16_t* Bt; int K; int lda; int kstepA; size_t a_s0, a_s1; };
__device__ __forceinline__ Gemm make_gemm(const bf16_t* A, const bf16_t* Bt, int K) { Gemm g; g.A = A; g.Bt = Bt; g.K = K; g.lda = K; g.kstepA = BK * 2; g.a_s0 = (size_t)BM * K * 2; g.a_s1 = 2 * g.a_s0; return g; }

struct StaticOrder {
    int nM, nN, nwg, G, c;
    __device__ void init(int M, int N, int G_, int c_) { nM = M / BM; nN = N / BM; nwg = nM * nN; G = G_; c = c_; }
    __device__ bool next(int i, Unit& u) const {
        const long L = (long)i * G + c; if (L >= nwg) return false;
        int wgid = (int)L; { const int q = nwg / NXCD, r = nwg % NXCD, xcd = wgid % NXCD, off = wgid / NXCD; wgid = (xcd < r ? xcd * (q + 1) : r * (q + 1) + (xcd - r) * q) + off; }
        const int nig = WGM * nN, gid = wgid / nig, fm = gid * WGM, gsz = (nM - fm) < WGM ? (nM - fm) : WGM;
        u.pm = fm + ((wgid % nig) % gsz); u.pn = (wgid % nig) / gsz; return true;
    }
};
struct OneUnit { int has; Unit u; __device__ bool next(int i, Unit& o) const { if (i > 0 || !has) return false; o = u; return true; } };

__device__ __forceinline__ unsigned cvt_pk_bf16(float lo, float hi) { unsigned r; asm volatile("v_cvt_pk_bf16_f32 %0, %1, %2" : "=v"(r) : "v"(lo), "v"(hi)); return r; }
__device__ __forceinline__ float gelu_tanh(float x) { const float u = 0.7978845608028654f * (x + 0.044715f * x * x * x); const float e = __builtin_amdgcn_exp2f(-2.885390081777927f * u); return x * __builtin_amdgcn_rcpf(1.f + e); }

__device__ __forceinline__ float ssq16(const float* p) { const f32x4 a = ((const f32x4*)p)[0], b = ((const f32x4*)p)[1], c = ((const f32x4*)p)[2], d = ((const f32x4*)p)[3];
    return (((a[0] + a[1]) + (a[2] + a[3])) + ((b[0] + b[1]) + (b[2] + b[3]))) + (((c[0] + c[1]) + (c[2] + c[3])) + ((d[0] + d[1]) + (d[2] + d[3]))); }
template <int ACT  > struct EpiBf16G {
    static constexpr bool PERM = true, AFTER_DRAIN = false;
    bf16_t* O; int ldc; const float* bias; const float* ssq; float inv_n; int nparts;
    __device__ __forceinline__ void operator()(const f32x4 (&acc)[2][2][4][2], const Unit& u, int wr, int wc, int fr, int fq) const {
        const int row0 = u.pm * BM + wr * 64 + fr, col0 = u.pn * BM + wc * 32 + 8 * fq;
        f32x4 bv[2][2];
#pragma unroll
        for (int bj = 0; bj < 2; ++bj)
#pragma unroll
            for (int n = 0; n < 2; ++n) bv[bj][n] = bias ? *(const f32x4*)(bias + col0 + bj * HALF + 4 * n) : (f32x4){0.f, 0.f, 0.f, 0.f};
        float rsv[2] = {1.f, 1.f};
        if (ssq) {
#pragma unroll
            for (int ai = 0; ai < 2; ++ai) { const int rr = row0 + ai * HALF + fq * 16; rsv[ai] = rsqrtf((nparts == 16 ? ssq16(ssq + (size_t)rr * 16) : ssq[rr]) * inv_n + 1e-6f); } }
#pragma unroll
        for (int ai = 0; ai < 2; ++ai)
#pragma unroll
            for (int m = 0; m < 4; ++m) { const int row = row0 + ai * HALF + m * 16; const float rs = __shfl(rsv[ai], fr + 16 * m); bf16_t* rowp = O + (size_t)row * ldc + col0;
#pragma unroll
                for (int bj = 0; bj < 2; ++bj) { f32x4 v0 = (acc[ai][bj][m][0] + bv[bj][0]) * rs, v1 = (acc[ai][bj][m][1] + bv[bj][1]) * rs;
                    if (ACT == 1) {
#pragma unroll
                        for (int e = 0; e < 4; ++e) { v0[e] = gelu_tanh(v0[e]); v1[e] = gelu_tanh(v1[e]); } }
                    if (ACT == 2) {
#pragma unroll
                        for (int e = 0; e < 4; ++e) { float a = fmaxf(v0[e], 0.f), b = fmaxf(v1[e], 0.f); v0[e] = a * a; v1[e] = b * b; } }
                    u32x4 w; w.x = cvt_pk_bf16(v0[0], v0[1]); w.y = cvt_pk_bf16(v0[2], v0[3]); w.z = cvt_pk_bf16(v1[0], v1[1]); w.w = cvt_pk_bf16(v1[2], v1[3]);
                    *(u32x4*)(rowp + bj * HALF) = w; } }
    }
};
struct EpiInProj {
    static constexpr bool PERM = true, AFTER_DRAIN = false;
    bf16_t *U, *V, *Q, *KV; float* GL; const float* ssq;
    __device__ __forceinline__ void operator()(const f32x4 (&acc)[2][2][4][2], const Unit& u, int wr, int wc, int fr, int fq) const {
        const int row0 = u.pm * BM + wr * 64 + fr, cit0 = wc * 32 + 8 * fq; const int pn = u.pn;
        bf16_t* base; int ldc, cofs; bool act = false;
        if (pn < 2) { base = U; ldc = 512; cofs = pn * 256; act = true; } else if (pn < 4) { base = V; ldc = 512; cofs = (pn - 2) * 256; act = true; }
        else if (pn < 6) { base = Q; ldc = 512; cofs = (pn - 4) * 256; } else { base = KV; ldc = 768; cofs = (pn - 6) * 256; }
        float rsv[2];
#pragma unroll
        for (int ai = 0; ai < 2; ++ai) rsv[ai] = rsqrtf(ssq16(ssq + (size_t)(row0 + ai * HALF + fq * 16) * 16) * (1.f / 1024.f) + 1e-6f);
#pragma unroll
        for (int ai = 0; ai < 2; ++ai)
#pragma unroll
            for (int m = 0; m < 4; ++m) { const int row = row0 + ai * HALF + m * 16; const float rs = __shfl(rsv[ai], fr + 16 * m);
#pragma unroll
                for (int bj = 0; bj < 2; ++bj) { f32x4 v0 = acc[ai][bj][m][0] * rs, v1 = acc[ai][bj][m][1] * rs; const int cit = cit0 + bj * HALF;
                    if (pn == 9) { if (cit < 24) { *(f32x4*)(GL + (size_t)row * 24 + cit) = v0; *(f32x4*)(GL + (size_t)row * 24 + cit + 4) = v1; } }
                    else { if (act) {
#pragma unroll
                            for (int e = 0; e < 4; ++e) { v0[e] = gelu_tanh(v0[e]); v1[e] = gelu_tanh(v1[e]); } }
                        u32x4 w; w.x = cvt_pk_bf16(v0[0], v0[1]); w.y = cvt_pk_bf16(v0[2], v0[3]); w.z = cvt_pk_bf16(v1[0], v1[1]); w.w = cvt_pk_bf16(v1[2], v1[3]);
                        *(u32x4*)(base + (size_t)row * ldc + cofs + cit) = w; } } }
    }
};
struct EpiResid {
    static constexpr bool PERM = false, AFTER_DRAIN = false;
    float* XF; bf16_t* XB; float* ssq;
    __device__ __forceinline__ void operator()(const f32x4 (&acc)[2][2][4][2], const Unit& u, int wr, int wc, int fr, int fq) const {
        const int col0 = u.pn * BM + wc * 32 + 4 * fq;
#pragma unroll
        for (int ai = 0; ai < 2; ++ai)
#pragma unroll
            for (int m = 0; m < 4; ++m) { const int row = u.pm * BM + ai * HALF + wr * 64 + m * 16 + fr; float sq = 0.f;
#pragma unroll
                for (int bj = 0; bj < 2; ++bj)
#pragma unroll
                    for (int n = 0; n < 2; ++n) { const size_t off = (size_t)row * 1024 + col0 + bj * HALF + n * 16; const u32x2 xw = *(const u32x2*)(XB + off);
                        f32x4 xv; xv[0] = __uint_as_float(xw.x << 16); xv[1] = __uint_as_float(xw.x & 0xffff0000u); xv[2] = __uint_as_float(xw.y << 16); xv[3] = __uint_as_float(xw.y & 0xffff0000u);
                        xv = xv + acc[ai][bj][m][n];
                        if (XF) *(f32x4*)(XF + off) = xv;
                        else { sq += (xv[0] * xv[0] + xv[1] * xv[1]) + (xv[2] * xv[2] + xv[3] * xv[3]); u32x2 w; w.x = cvt_pk_bf16(xv[0], xv[1]); w.y = cvt_pk_bf16(xv[2], xv[3]); *(u32x2*)(XB + off) = w; } }
                if (!XF) { sq += __shfl_xor(sq, 16); sq += __shfl_xor(sq, 32); if (fq == 0) ssq[(size_t)row * 16 + u.pn * 4 + wc] = sq; } }
    }
};

template <class Epi, class Sched, bool ALIGN_EPI>
__device__ __forceinline__ void gemm_phase(PG8_LAS unsigned char* lds, const Gemm g, const Sched& S, const Epi& E) {
    int tid_ = threadIdx.x; asm volatile("" : "+v"(tid_));
    const int tid = tid_, wid = __builtin_amdgcn_readfirstlane(tid >> 6), lane = tid & 63, wr = wid >> 2, wc = wid & 3, fr = lane & 15, fq = lane >> 4;
    const int K = g.K, nt = K / BK;
    unsigned voffA[2], voffB[2];
#pragma unroll
    for (int i = 0; i < 2; ++i) { int R, C; stage_rc(tid * 16 + i * 8192, R, C); const int Rb = Epi::PERM ? ((R & ~31) + perm32(R & 31)) : R;
        voffA[i] = (unsigned)(R * g.lda + C) * 2u; voffB[i] = (unsigned)(Rb * K + C) * 2u; }
    const size_t kstepA = (size_t)g.kstepA, kstepB = (size_t)(BK * 2);
    const size_t hstepA = (size_t)HALF * g.lda * 2, hstepB = (size_t)HALF * K * 2, tstepB = 2 * hstepB;
    const unsigned ldsw = (unsigned)wid * 1024u;
    const int aoff = lds_byte(wr * 64 + fr, fq * 8), boff = lds_byte(wc * 32 + fr, fq * 8);
#define PG8_ABASE(pm) ((const char*)g.A + (size_t)((pm) >> 1) * g.a_s1 + (size_t)((pm) & 1) * g.a_s0)
#define PG8_SA(b, h) (((b) * 2 + (h)) * HTB)
#define PG8_SB(b, h) ((4 + (b) * 2 + (h)) * HTB)
#define PG8_STAGE(bufoff, gbase, voff) do { _Pragma("unroll") for (int _i = 0; _i < 2; ++_i) \
        __builtin_amdgcn_global_load_lds((const unsigned*)((const char*)(gbase) + (voff)[_i]), (PG8_LAS unsigned*)(lds + (bufoff) + ldsw + _i * 8192), 16, 0, 0); } while (0)
#define PG8_LDA(dst, b, h) do { _Pragma("unroll") for (int m = 0; m < 4; ++m) _Pragma("unroll") for (int k = 0; k < 2; ++k) dst[m][k] = *(const PG8_LAS bf16x8*)(lds + PG8_SA(b, h) + aoff + m * 2048 + k * 1024); } while (0)
#define PG8_LDB(dst, b, h) do { _Pragma("unroll") for (int n = 0; n < 2; ++n) _Pragma("unroll") for (int k = 0; k < 2; ++k) dst[n][k] = *(const PG8_LAS bf16x8*)(lds + PG8_SB(b, h) + boff + n * 2048 + k * 1024); } while (0)
#define PG8_MMA(ai, bj, At, Bt) do { __builtin_amdgcn_s_setprio(1); _Pragma("unroll") for (int m = 0; m < 4; ++m) _Pragma("unroll") for (int n = 0; n < 2; ++n) _Pragma("unroll") for (int k = 0; k < 2; ++k) \
        acc[ai][bj][m][n] = __builtin_amdgcn_mfma_f32_16x16x32_bf16(Bt[n][k], At[m][k], acc[ai][bj][m][n], 0, 0, 0); __builtin_amdgcn_s_setprio(0); } while (0)
#define PG8_WAIT_V(n) asm volatile("s_waitcnt vmcnt(" #n ")" ::: "memory")
#define PG8_WAIT_L(n) asm volatile("s_waitcnt lgkmcnt(" #n ")" ::: "memory")
#define PG8_BAR __builtin_amdgcn_s_barrier()
#define PG8_SCHED __builtin_amdgcn_sched_barrier(0)
    Unit cur, nxt; int ui = 0;
    if (!S.next(0, cur)) return;
    f32x4 acc[2][2][4][2];
#pragma unroll
    for (int a = 0; a < 2; ++a)
#pragma unroll
        for (int b = 0; b < 2; ++b)
#pragma unroll
            for (int m = 0; m < 4; ++m)
#pragma unroll
                for (int n = 0; n < 2; ++n) acc[a][b][m][n] = (f32x4){0.f, 0.f, 0.f, 0.f};
    bf16x8 At[4][2], B0[2][2], B1[2][2];
    const char* cA = PG8_ABASE(cur.pm); const char* cB = (const char*)g.Bt + (size_t)cur.pn * tstepB;
    PG8_STAGE(PG8_SB(0, 0), cB, voffB); PG8_STAGE(PG8_SB(0, 1), cB + hstepB, voffB); PG8_STAGE(PG8_SA(0, 0), cA, voffA); PG8_STAGE(PG8_SA(0, 1), cA + hstepA, voffA);
    if (wr == 1) PG8_BAR;
    PG8_WAIT_V(2); PG8_BAR;
    PG8_STAGE(PG8_SB(1, 0), cB + kstepB, voffB); PG8_STAGE(PG8_SA(1, 0), cA + kstepA, voffA); PG8_STAGE(PG8_SB(1, 1), cB + hstepB + kstepB, voffB);
    PG8_WAIT_V(6); PG8_BAR;
    for (;;) {
        const bool has_next = S.next(ui + 1, nxt);
        const char* nA = has_next ? PG8_ABASE(nxt.pm) : cA; const char* nB = has_next ? (const char*)g.Bt + (size_t)nxt.pn * tstepB : cB;
        for (int t = 0; t < nt; t += 2) {
            const bool last = (t == nt - 2);
            const char* a1 = cA + (size_t)(t + 1) * kstepA;
            const char* a2 = last ? nA : cA + (size_t)(t + 2) * kstepA; const char* b2 = last ? nB : cB + (size_t)(t + 2) * kstepB;
            const char* a3 = a2 + kstepA; const char* b3 = b2 + kstepB;
            PG8_LDB(B0, 0, 0); PG8_LDB(B1, 0, 1); PG8_SCHED; PG8_LDA(At, 0, 0); PG8_STAGE(PG8_SA(1, 1), a1 + hstepA, voffA);
            PG8_WAIT_V(8); PG8_WAIT_L(0); PG8_BAR; PG8_MMA(0, 0, At, B0); PG8_MMA(0, 1, At, B1); PG8_BAR; PG8_SCHED;
            PG8_LDA(At, 0, 1); PG8_STAGE(PG8_SB(0, 0), b2, voffB); PG8_STAGE(PG8_SB(0, 1), b2 + hstepB, voffB); PG8_STAGE(PG8_SA(0, 0), a2, voffA);
            PG8_WAIT_V(8); PG8_WAIT_L(0); PG8_BAR; PG8_MMA(1, 0, At, B0); PG8_MMA(1, 1, At, B1); PG8_BAR; PG8_SCHED;
            PG8_LDB(B0, 1, 0); PG8_LDB(B1, 1, 1); PG8_SCHED; PG8_LDA(At, 1, 0); PG8_STAGE(PG8_SA(0, 1), a2 + hstepA, voffA);
            PG8_WAIT_V(8); PG8_WAIT_L(0); PG8_BAR; PG8_MMA(0, 0, At, B0); PG8_MMA(0, 1, At, B1); PG8_BAR; PG8_SCHED;
            PG8_LDA(At, 1, 1); PG8_STAGE(PG8_SB(1, 0), b3, voffB); PG8_STAGE(PG8_SB(1, 1), b3 + hstepB, voffB); PG8_STAGE(PG8_SA(1, 0), a3, voffA);
            PG8_WAIT_V(8); PG8_WAIT_L(0); PG8_BAR; PG8_MMA(1, 0, At, B0); PG8_MMA(1, 1, At, B1); PG8_BAR; PG8_SCHED;
        }
        if constexpr (ALIGN_EPI) { if (wr == 0) PG8_BAR; }
        if constexpr (!Epi::AFTER_DRAIN) { E(acc, cur, wr, wc, fr, fq); }
        if (!has_next) break;
#pragma unroll
        for (int a = 0; a < 2; ++a)
#pragma unroll
            for (int b = 0; b < 2; ++b)
#pragma unroll
                for (int m = 0; m < 4; ++m)
#pragma unroll
                    for (int n = 0; n < 2; ++n) acc[a][b][m][n] = (f32x4){0.f, 0.f, 0.f, 0.f};
        cur = nxt; cA = nA; cB = nB; ++ui;
        if constexpr (ALIGN_EPI) { if (wr == 1) PG8_BAR; }
    }
    PG8_WAIT_V(0);
    if constexpr (!ALIGN_EPI) { if (wr == 0) PG8_BAR; }
    PG8_BAR;
    if constexpr (Epi::AFTER_DRAIN) { E.fused(acc, cur, wr, wc, fr, fq, lds, wid, lane); }
#undef PG8_ABASE
#undef PG8_SA
#undef PG8_SB
#undef PG8_STAGE
#undef PG8_LDA
#undef PG8_LDB
#undef PG8_MMA
#undef PG8_WAIT_V
#undef PG8_WAIT_L
#undef PG8_BAR
#undef PG8_SCHED
}
}

#ifndef MK_PROBE_N
#define MK_PROBE_N 0
#endif
#ifndef MK_PROBE_PRO
#define MK_PROBE_PRO 0
#endif
#ifndef MK_PROBE_KIND
#define MK_PROBE_KIND 3
#endif
#ifndef MK_PROBE_PARTS
#define MK_PROBE_PARTS 15
#endif

namespace mk {
using pg8::bf16_t; using pg8::f32x4; using pg8::u32x4; using pg8::u32x2; using pg8::cvt_pk_bf16;
#define LAS __attribute__((address_space(3)))
constexpr int NB = 4, T = 4096, D = 1024, NTOK = NB * T, INC = 2328, INP = 2560, FF = 4096;
constexpr size_t MiB = 1u << 20;
constexpr size_t WS_CTL = 0;
constexpr size_t WS_W = 1 * MiB, W_LAYER = 30 * MiB;
constexpr size_t W_IN = 0, W_OUT = 5 * MiB, W_MQ = 7 * MiB, W_MKV = 8 * MiB, W_MO = 10 * MiB, W_FF1 = 11 * MiB, W_FF2 = 19 * MiB, W_C1 = 27 * MiB, W_C2 = 29 * MiB, W_SG = 29 * MiB + 128 * 1024, W_B1P = 29 * MiB + 512 * 1024;
constexpr size_t WS_XB = 61 * MiB;
constexpr size_t WS_OV = 93 * MiB;
constexpr size_t WS_U = WS_OV, WS_V = WS_OV + 16 * MiB, WS_Q = WS_OV + 32 * MiB, WS_KV = WS_OV + 48 * MiB, WS_MIX = WS_OV + 72 * MiB, WS_QM = WS_OV + 104 * MiB, WS_OM = WS_OV + 120 * MiB;
constexpr size_t WS_HB = WS_OV;
constexpr size_t WS_SM = 229 * MiB;
constexpr size_t WS_GL = WS_SM, WS_KC = WS_SM + 2 * MiB, WS_VC = WS_KC + 256 * 1024, WS_HID = WS_SM + 3 * MiB, WS_MASK = WS_SM + 5 * MiB, WS_MEMB = WS_SM + 6 * MiB, WS_KVM = WS_SM + 8 * MiB, WS_END = WS_SM + 10 * MiB;
constexpr size_t WS_SSQP = 240 * MiB;
static_assert(WS_END <= WS_SSQP && WS_SSQP + 6 * MiB <= 256 * MiB, "ws map");
constexpr int SSQ_MEM_OFF = 6 * NTOK;

struct Args { const float* in[27]; float* out; unsigned char* ws; int ph_lo, ph_hi; };
enum { I_X = 0, I_MEM, I_NMG, I_WIN, I_SGLNG, I_SGLNB, I_SGW, I_SGB, I_QNG, I_KNG, I_CPOS, I_CW1, I_CB1, I_CW2, I_CB2, I_MOG, I_WOUT, I_NMEMG, I_MKVG, I_WMQ, I_WMKV, I_MQG, I_MKG, I_WMO, I_NFG, I_WFF1, I_WFF2 };

__device__ __forceinline__ float bf2f(unsigned short b) { return __uint_as_float((unsigned)b << 16); }
__device__ __forceinline__ float wave_sum(float v) {
#pragma unroll
    for (int o = 1; o < 64; o <<= 1) v += __shfl_xor(v, o);
    return v; }

__device__ __forceinline__ void transpose_item(const float* W, int K, int N, int Npad, const float* gain, bf16_t* WT, LAS float* scr, int item, int lane) {
    const int nblk = Npad / 32, kb = item / nblk, nb = item % nblk, k0 = 64 * kb, n0 = 32 * nb;
    const int nn = n0 + (lane & 31); const int nnc = nn < N ? nn : N - 1; const float keep = nn < N ? 1.f : 0.f;
    const float* src = W + (size_t)(k0 + (lane >> 5)) * N + nnc;
    float v[32];
#pragma unroll
    for (int i = 0; i < 32; ++i) v[i] = src[(size_t)(2 * i) * N];
#pragma unroll
    for (int i = 0; i < 32; ++i) scr[(2 * i + (lane >> 5)) * 33 + (lane & 31)] = v[i] * keep;
    asm volatile("s_waitcnt lgkmcnt(0)" ::: "memory");
    const int c = lane & 7;
    f32x4 g0 = {1.f, 1.f, 1.f, 1.f}, g1 = {1.f, 1.f, 1.f, 1.f};
    if (gain) { g0 = *(const f32x4*)(gain + k0 + 8 * c); g1 = *(const f32x4*)(gain + k0 + 8 * c + 4); }
#pragma unroll
    for (int j = 0; j < 4; ++j) { const int n = (lane >> 3) + 8 * j; const LAS float* sp = scr + (8 * c) * 33 + n;
        u32x4 o; o.x = cvt_pk_bf16(sp[0 * 33] * g0[0], sp[1 * 33] * g0[1]); o.y = cvt_pk_bf16(sp[2 * 33] * g0[2], sp[3 * 33] * g0[3]); o.z = cvt_pk_bf16(sp[4 * 33] * g1[0], sp[5 * 33] * g1[1]); o.w = cvt_pk_bf16(sp[6 * 33] * g1[2], sp[7 * 33] * g1[3]);
        *(u32x4*)(WT + (size_t)(n0 + n) * K + k0 + 8 * c) = o; }
    asm volatile("s_waitcnt lgkmcnt(0)" ::: "memory");
}

template <bool DO_X>
__device__ __forceinline__ void prologue(const Args& a, LAS unsigned char* lds, int gw, int NGW, int wave, int lane) {
    LAS float* scr = (LAS float*)(lds + wave * 16384);
    unsigned char* ws = a.ws; float* ctl = (float*)(ws + WS_CTL);
    int it0 = 0;
#define TR_MAT(Wp, K_, N_, NP_, Gp, DST) { const int cnt = ((K_) / 64) * ((NP_) / 32); for (int it = gw; it < it0 + cnt; it += NGW) { if (it >= it0) transpose_item((Wp), (K_), (N_), (NP_), (Gp), (bf16_t*)(DST), scr, it - it0, lane); } it0 += cnt; }
    for (int l = 0; l < 2; ++l) {
        unsigned char* wl = ws + WS_W + l * W_LAYER;
        TR_MAT(a.in[I_WIN] + (size_t)l * 1024 * INC, 1024, INC, INP, a.in[I_NMG] + l * 1024, wl + W_IN)
        TR_MAT(a.in[I_WOUT] + (size_t)l * 1024 * 1024, 1024, 1024, 1024, a.in[I_MOG] + l * 1024, wl + W_OUT)
        TR_MAT(a.in[I_WMQ] + (size_t)l * 1024 * 512, 1024, 512, 512, a.in[I_NMEMG] + l * 1024, wl + W_MQ)
        TR_MAT(a.in[I_WMKV] + (size_t)l * 1024 * 1024, 1024, 1024, 1024, a.in[I_MKVG] + l * 1024, wl + W_MKV)
        TR_MAT(a.in[I_WMO] + (size_t)l * 512 * 1024, 512, 1024, 1024, (const float*)nullptr, wl + W_MO)
        TR_MAT(a.in[I_WFF1] + (size_t)l * 1024 * 4096, 1024, 4096, 4096, a.in[I_NFG] + l * 1024, wl + W_FF1)
        TR_MAT(a.in[I_WFF2] + (size_t)l * 4096 * 1024, 4096, 1024, 1024, (const float*)nullptr, wl + W_FF2)
        for (int kv = 0; kv < 2; ++kv) {
            TR_MAT(a.in[I_CW1] + (size_t)(l * 2 + kv) * 2048 * 256, 2048, 256, 256, (const float*)nullptr, wl + W_C1 + (size_t)kv * 256 * 2048 * 2)
            TR_MAT(a.in[I_CW2] + (size_t)(l * 2 + kv) * 256 * 64, 256, 64, 64, (const float*)nullptr, wl + W_C2 + (size_t)kv * 64 * 256 * 2)
        }
    }
#undef TR_MAT
    if constexpr (DO_X) { const float* x = a.in[I_X]; bf16_t* XB = (bf16_t*)(ws + WS_XB);
      for (int r = gw; r < NTOK; r += NGW) { const f32x4* xr = (const f32x4*)(x + (size_t)r * 1024) + lane; unsigned long long* xb = (unsigned long long*)(XB + (size_t)r * 1024) + lane; float s = 0.f;
#pragma unroll
          for (int j = 0; j < 4; ++j) { const f32x4 v = xr[64 * j]; s += (v[0] * v[0] + v[1] * v[1]) + (v[2] * v[2] + v[3] * v[3]); xb[64 * j] = (unsigned long long)cvt_pk_bf16(v[0], v[1]) | ((unsigned long long)cvt_pk_bf16(v[2], v[3]) << 32); }
          s = wave_sum(s); if (lane < 16) ((float*)(ws + WS_SSQP))[(size_t)r * 16 + lane] = lane == 0 ? s : 0.f; } }
    if constexpr (DO_X) { const float* mem = a.in[I_MEM]; bf16_t* MB = (bf16_t*)(ws + WS_MEMB);
      for (int r = gw; r < 1024; r += NGW) { const f32x4* xr = (const f32x4*)(mem + (size_t)r * 1024) + lane; unsigned long long* xb = (unsigned long long*)(MB + (size_t)r * 1024) + lane; float s = 0.f;
#pragma unroll
          for (int j = 0; j < 4; ++j) { const f32x4 v = xr[64 * j]; s += (v[0] * v[0] + v[1] * v[1]) + (v[2] * v[2] + v[3] * v[3]); xb[64 * j] = (unsigned long long)cvt_pk_bf16(v[0], v[1]) | ((unsigned long long)cvt_pk_bf16(v[2], v[3]) << 32); }
          s = wave_sum(s); if (lane == 0) ctl[SSQ_MEM_OFF + r] = s; } }
    for (int it = gw; it < 4 * 32; it += NGW) { const int lk = it >> 5, j0 = (it & 31) * 8; const float* W1 = a.in[I_CW1] + (size_t)lk * 2048 * 256 + j0; const float* pos = a.in[I_CPOS] + (size_t)lk * 2048;
        float acc[8];
#pragma unroll
        for (int e = 0; e < 8; ++e) acc[e] = 0.f;
#pragma unroll 8
        for (int i = 0; i < 32; ++i) { const int k = i * 64 + lane; const float p = pos[k]; const f32x4 w0 = *(const f32x4*)(W1 + (size_t)k * 256), w1 = *(const f32x4*)(W1 + (size_t)k * 256 + 4);
#pragma unroll
            for (int e = 0; e < 4; ++e) { acc[e] += p * w0[e]; acc[4 + e] += p * w1[e]; } }
#pragma unroll
        for (int e = 0; e < 8; ++e) acc[e] = wave_sum(acc[e]);
        if (lane == 0) { float* dst = (float*)(ws + WS_W + (lk >> 1) * W_LAYER + W_B1P) + (lk & 1) * 256 + j0;
#pragma unroll
            for (int e = 0; e < 8; ++e) dst[e] = acc[e] + a.in[I_CB1][lk * 256 + j0 + e]; } }
    for (int it = gw; it < 2 * 8 * 128; it += NGW) { const int t = it & 127; const float* wr = a.in[I_SGW] + (size_t)it * 128; unsigned* dst = (unsigned*)(ws + WS_W + (it >> 10) * W_LAYER + W_SG) + (size_t)(it & 1023) * 64 + lane;
        float v[2];
#pragma unroll
        for (int e = 0; e < 2; ++e) { const int p = lane * 2 + e, ks = p >> 4, hh = (p >> 3) & 1, j = p & 7, sidx = 16 * ks + 8 * (j >> 2) + 4 * hh + (j & 3); v[e] = sidx <= t ? wr[sidx] : 0.f; }
        *dst = cvt_pk_bf16(v[0], v[1]); }
}

typedef float f32x16 __attribute__((ext_vector_type(16)));
typedef short s16x4 __attribute__((ext_vector_type(4)));
typedef short v4i16_t __attribute__((ext_vector_type(4)));
using pg8::bf16x8;
__device__ __forceinline__ int crow(int r, int hi) { return (r & 3) + 8 * (r >> 2) + 4 * hi; }
__device__ __forceinline__ s16x4 vtr(const LAS char* p) { return __builtin_bit_cast(s16x4, __builtin_amdgcn_ds_read_tr16_b64_v4i16((LAS v4i16_t*)p)); }
#define MFMA32(a, b, c) __builtin_amdgcn_mfma_f32_32x32x16_bf16(a, b, c, 0, 0, 0)
#define VFRAG(lo, hi) (bf16x8){lo[0], lo[1], lo[2], lo[3], hi[0], hi[1], hi[2], hi[3]}
__device__ __forceinline__ void lds_fadd(LAS float* p, float v) { (void)__hip_atomic_fetch_add(p, v, __ATOMIC_RELAXED, __HIP_MEMORY_SCOPE_WORKGROUP); }
__device__ __forceinline__ unsigned short f2bf(float f) { return (unsigned short)(cvt_pk_bf16(f, 0.f) & 0xffffu); }

__device__ __forceinline__ void tokprep_token(bf16_t* Q, bf16_t* KV, const float* qg, const float* kg, int tok, int lane) {
    { u32x4* p = (u32x4*)(Q + (size_t)tok * 512) + lane; const u32x4 w = *p; float v[8];
#pragma unroll
      for (int i = 0; i < 4; ++i) { v[2 * i] = __uint_as_float(w[i] << 16); v[2 * i + 1] = __uint_as_float(w[i] & 0xffff0000u); }
      float ss = 0.f;
#pragma unroll
      for (int i = 0; i < 8; ++i) ss += v[i] * v[i];
      ss += __shfl_xor(ss, 1); ss += __shfl_xor(ss, 2); ss += __shfl_xor(ss, 4);
      const float rs = rsqrtf(ss * (1.f / 64.f) + 1e-6f) * (0.125f * 1.4426950408889634f); const float* g = qg + (lane & 7) * 8;
      u32x4 o;
#pragma unroll
      for (int i = 0; i < 4; ++i) o[i] = cvt_pk_bf16(v[2 * i] * rs * g[2 * i], v[2 * i + 1] * rs * g[2 * i + 1]);
      *p = o; }
    if (lane < 32) { const int br = 1 + (lane >> 4); u32x4* p = (u32x4*)(KV + (size_t)tok * 768 + br * 256) + (lane & 15); const u32x4 w = *p; float v[8];
#pragma unroll
      for (int i = 0; i < 4; ++i) { v[2 * i] = __uint_as_float(w[i] << 16); v[2 * i + 1] = __uint_as_float(w[i] & 0xffff0000u); }
      float ss = 0.f;
#pragma unroll
      for (int i = 0; i < 8; ++i) ss += v[i] * v[i];
      ss += __shfl_xor(ss, 1); ss += __shfl_xor(ss, 2); ss += __shfl_xor(ss, 4);
      const float rs = rsqrtf(ss * (1.f / 64.f) + 1e-6f); const float* g = kg + br * 64 + (lane & 7) * 8;
      u32x4 o;
#pragma unroll
      for (int i = 0; i < 4; ++i) o[i] = cvt_pk_bf16(v[2 * i] * rs * g[2 * i], v[2 * i + 1] * rs * g[2 * i + 1]);
      *p = o; }
}
__device__ __forceinline__ void cmp2_row(const bf16_t* HID, const bf16_t* w2t, const float* b2, const float* kg0, bf16_t* KC, bf16_t* VC, int row, int lane) {
#pragma unroll 1
    for (int kv = 0; kv < 2; ++kv) { const u32x4* h = (const u32x4*)(HID + (size_t)kv * 2048 * 256 + (size_t)row * 256); const u32x4* w = (const u32x4*)(w2t + (size_t)kv * 64 * 256 + (size_t)lane * 256); float s = b2[kv * 64 + lane];
#pragma unroll 4
        for (int k = 0; k < 32; ++k) { const u32x4 a = h[k], b = w[k];
#pragma unroll
            for (int i = 0; i < 4; ++i) s += __uint_as_float(a[i] << 16) * __uint_as_float(b[i] << 16) + __uint_as_float(a[i] & 0xffff0000u) * __uint_as_float(b[i] & 0xffff0000u); }
        if (kv == 0) { const float ss = wave_sum(s * s); s = s * rsqrtf(ss * (1.f / 64.f) + 1e-6f) * kg0[lane]; }
        if ((row & 255) == 255) s = 0.f;
        (kv ? VC : KC)[(size_t)row * 64 + lane] = f2bf(s); }
}
__device__ __forceinline__ void memk_norm_item(bf16_t* KVM, const float* kg, int r, int lane) {
    unsigned* p = (unsigned*)(KVM + (size_t)(r >> 2) * 1024 + (r & 3) * 128) + lane; const unsigned w = *p; const float v0 = __uint_as_float(w << 16), v1 = __uint_as_float(w & 0xffff0000u);
    const float ss = wave_sum(v0 * v0 + v1 * v1); const float rs = rsqrtf(ss * (1.f / 128.f) + 1e-6f); *p = cvt_pk_bf16(v0 * rs * kg[2 * lane], v1 * rs * kg[2 * lane + 1]);
}

__device__ __forceinline__ void tokprep4(bf16_t* Q, bf16_t* KV, const float* qg, const float* kg, int t, int S, int lane) {
    u32x4 wq[4], wk[4]; const int br = 1 + ((lane >> 4) & 1);
#pragma unroll
    for (int i = 0; i < 4; ++i) { const int tt = t + i * S < NTOK ? t + i * S : NTOK - 1; wq[i] = *((const u32x4*)(Q + (size_t)tt * 512) + lane); wk[i] = *((const u32x4*)(KV + (size_t)tt * 768 + br * 256) + (lane & 15)); }
    f32x4 gq0 = *(const f32x4*)(qg + (lane & 7) * 8), gq1 = *(const f32x4*)(qg + (lane & 7) * 8 + 4), gk0 = *(const f32x4*)(kg + br * 64 + (lane & 7) * 8), gk1 = *(const f32x4*)(kg + br * 64 + (lane & 7) * 8 + 4);
#pragma unroll
    for (int i = 0; i < 4; ++i) { if (t + i * S >= NTOK) break; const int tt = t + i * S;
        { const u32x4 w = wq[i]; float v[8];
#pragma unroll
          for (int e = 0; e < 4; ++e) { v[2 * e] = __uint_as_float(w[e] << 16); v[2 * e + 1] = __uint_as_float(w[e] & 0xffff0000u); }
          float ss = 0.f;
#pragma unroll
          for (int e = 0; e < 8; ++e) ss += v[e] * v[e];
          ss += __shfl_xor(ss, 1); ss += __shfl_xor(ss, 2); ss += __shfl_xor(ss, 4);
          const float rs = rsqrtf(ss * (1.f / 64.f) + 1e-6f) * (0.125f * 1.4426950408889634f);
          u32x4 o; o[0] = cvt_pk_bf16(v[0] * rs * gq0[0], v[1] * rs * gq0[1]); o[1] = cvt_pk_bf16(v[2] * rs * gq0[2], v[3] * rs * gq0[3]); o[2] = cvt_pk_bf16(v[4] * rs * gq1[0], v[5] * rs * gq1[1]); o[3] = cvt_pk_bf16(v[6] * rs * gq1[2], v[7] * rs * gq1[3]);
          *((u32x4*)(Q + (size_t)tt * 512) + lane) = o; }
        { const u32x4 w = wk[i]; float v[8];
#pragma unroll
          for (int e = 0; e < 4; ++e) { v[2 * e] = __uint_as_float(w[e] << 16); v[2 * e + 1] = __uint_as_float(w[e] & 0xffff0000u); }
          float ss = 0.f;
#pragma unroll
          for (int e = 0; e < 8; ++e) ss += v[e] * v[e];
          ss += __shfl_xor(ss, 1); ss += __shfl_xor(ss, 2); ss += __shfl_xor(ss, 4);
          const float rs = rsqrtf(ss * (1.f / 64.f) + 1e-6f);
          u32x4 o; o[0] = cvt_pk_bf16(v[0] * rs * gk0[0], v[1] * rs * gk0[1]); o[1] = cvt_pk_bf16(v[2] * rs * gk0[2], v[3] * rs * gk0[3]); o[2] = cvt_pk_bf16(v[4] * rs * gk1[0], v[5] * rs * gk1[1]); o[3] = cvt_pk_bf16(v[6] * rs * gk1[2], v[7] * rs * gk1[3]);
          if (lane < 32) *((u32x4*)(KV + (size_t)tt * 768 + br * 256) + (lane & 15)) = o; } }
}
__device__ __forceinline__ void cmp2_tile(const bf16_t* HIDt, const bf16_t* w2t, const float* b2, const float* kg0, bf16_t* OUT) {
    int tid_ = threadIdx.x; asm volatile("" : "+v"(tid_)); const int lane = tid_ & 63, wave = __builtin_amdgcn_readfirstlane(tid_ >> 6), r32 = lane & 31, hi = lane >> 5; const int row = wave * 32 + r32;
    f32x16 acc[2];
#pragma unroll
    for (int r = 0; r < 16; ++r) { acc[0][r] = 0.f; acc[1][r] = 0.f; }
    bf16x8 bfr[16];
#pragma unroll
    for (int ks = 0; ks < 16; ++ks) bfr[ks] = *(const bf16x8*)(HIDt + (size_t)row * 256 + ks * 16 + hi * 8);
#pragma unroll
    for (int ks = 0; ks < 16; ++ks) { const bf16x8 a0 = *(const bf16x8*)(w2t + (size_t)r32 * 256 + ks * 16 + hi * 8), a1 = *(const bf16x8*)(w2t + (size_t)(32 + r32) * 256 + ks * 16 + hi * 8);
        acc[0] = MFMA32(a0, bfr[ks], acc[0]); acc[1] = MFMA32(a1, bfr[ks], acc[1]); }
    float ss = 0.f;
#pragma unroll
    for (int h = 0; h < 2; ++h)
#pragma unroll
        for (int r = 0; r < 16; ++r) { const float v = acc[h][r] + b2[32 * h + crow(r, hi)]; acc[h][r] = v; ss += v * v; }
    if (kg0) { ss += __shfl_xor(ss, 32); const float rs = rsqrtf(ss * (1.f / 64.f) + 1e-6f);
#pragma unroll
        for (int h = 0; h < 2; ++h)
#pragma unroll
            for (int r = 0; r < 16; ++r) acc[h][r] *= rs * kg0[32 * h + crow(r, hi)]; }
    const float keep = row == 255 ? 0.f : 1.f;
#pragma unroll
    for (int h = 0; h < 2; ++h)
#pragma unroll
        for (int a4 = 0; a4 < 4; ++a4) { u32x2 w; w.x = cvt_pk_bf16(acc[h][4 * a4] * keep, acc[h][4 * a4 + 1] * keep); w.y = cvt_pk_bf16(acc[h][4 * a4 + 2] * keep, acc[h][4 * a4 + 3] * keep); *(u32x2*)(OUT + (size_t)row * 64 + 32 * h + 8 * a4 + 4 * hi) = w; }
}

constexpr int SG_STAT = 0, SG_SSQ = 1024, SG_VN = 5120;
__device__ __forceinline__ void sgu_unit(LAS unsigned char* lds, int unit, const bf16_t* U, const bf16_t* Vb, const bf16_t* Wsg, const float* lng, const float* lnb, const float* sgb, bf16_t* MIX) {
    int tid_ = threadIdx.x; asm volatile("" : "+v"(tid_)); const int tid = tid_, lane = tid & 63, g = __builtin_amdgcn_readfirstlane(tid >> 6), r32 = lane & 31, hi = lane >> 5;
    const int tok0 = unit * 128;
    LAS float* STAT = (LAS float*)(lds + SG_STAT); LAS float* SSQA = (LAS float*)(lds + SG_SSQ);
    { const int tl = tid >> 2, part = tid & 3; const u32x4* p = (const u32x4*)(Vb + (size_t)(tok0 + tl) * 512 + part * 128); float s = 0.f, s2 = 0.f;
#pragma unroll 4
      for (int i = 0; i < 16; ++i) { const u32x4 w = p[i];
#pragma unroll
          for (int e = 0; e < 4; ++e) { const float a = __uint_as_float(w[e] << 16), b = __uint_as_float(w[e] & 0xffff0000u); s += a + b; s2 += a * a + b * b; } }
      s += __shfl_xor(s, 1); s += __shfl_xor(s, 2); s2 += __shfl_xor(s2, 1); s2 += __shfl_xor(s2, 2);
      if (part == 0) { const float mu = s * (1.f / 512.f); const float var = fmaxf(s2 * (1.f / 512.f) - mu * mu, 0.f); STAT[tl * 2] = mu; STAT[tl * 2 + 1] = rsqrtf(var + 1e-6f); }
      }
    __syncthreads();
    LAS unsigned char* VN = lds + SG_VN + g * 16384;
    { const int piece = lane & 7; float gg[8], bb[8];
#pragma unroll
      for (int i = 0; i < 8; ++i) { gg[i] = lng[g * 64 + piece * 8 + i]; bb[i] = lnb[g * 64 + piece * 8 + i]; }
#pragma unroll 4
      for (int it = 0; it < 16; ++it) { const int row = it * 8 + (lane >> 3); const u32x4 w = *(const u32x4*)(Vb + (size_t)(tok0 + row) * 512 + g * 64 + piece * 8); const float mu = STAT[row * 2], rs = STAT[row * 2 + 1]; u32x4 o;
#pragma unroll
          for (int e = 0; e < 4; ++e) { const float a = (__uint_as_float(w[e] << 16) - mu) * rs * gg[2 * e] + bb[2 * e], b = (__uint_as_float(w[e] & 0xffff0000u) - mu) * rs * gg[2 * e + 1] + bb[2 * e + 1]; o[e] = cvt_pk_bf16(a, b); }
          *(LAS u32x4*)(VN + (piece >> 2) * 8192 + row * 64 + (piece & 3) * 16) = o; } }
    asm volatile("s_waitcnt lgkmcnt(0)" ::: "memory");
    f32x16 acc[2][4];
#pragma unroll
    for (int dh = 0; dh < 2; ++dh)
#pragma unroll
        for (int mt = 0; mt < 4; ++mt)
#pragma unroll
            for (int r = 0; r < 16; ++r) acc[dh][mt][r] = 0.f;
    const LAS char* vb = (const LAS char*)VN + ((lane >> 4) & 1) * 32 + (lane & 3) * 8 + (4 * hi + ((lane & 15) >> 2)) * 64;
    const bf16_t* wrow = Wsg + ((size_t)g * 128 + r32) * 128 + 8 * hi;
#pragma unroll
    for (int ks = 0; ks < 8; ++ks) { bf16x8 vf[2];
#pragma unroll
        for (int dh = 0; dh < 2; ++dh) { const s16x4 lo = vtr(vb + dh * 8192 + ks * 1024), hh = vtr(vb + dh * 8192 + ks * 1024 + 512); vf[dh] = VFRAG(lo, hh); }
#pragma unroll
        for (int mt = 0; mt < 4; ++mt) { if (ks <= 2 * mt + 1) { const bf16x8 wf = *(const bf16x8*)(wrow + (size_t)mt * 32 * 128 + ks * 16);
                acc[0][mt] = MFMA32(vf[0], wf, acc[0][mt]); acc[1][mt] = MFMA32(vf[1], wf, acc[1][mt]); } } }
#pragma unroll
    for (int mt = 0; mt < 4; ++mt) { const int t = mt * 32 + r32; const float bias = sgb[g * 128 + t]; const bf16_t* up = U + (size_t)(tok0 + t) * 512 + g * 64 + 4 * hi; float ss = 0.f;
#pragma unroll
        for (int dh = 0; dh < 2; ++dh)
#pragma unroll
            for (int a4 = 0; a4 < 4; ++a4) { const u32x2 w = *(const u32x2*)(up + dh * 32 + a4 * 8);
                const float u0 = __uint_as_float(w.x << 16), u1 = __uint_as_float(w.x & 0xffff0000u), u2 = __uint_as_float(w.y << 16), u3 = __uint_as_float(w.y & 0xffff0000u);
                float x0 = u0 * (acc[dh][mt][4 * a4] + bias), x1 = u1 * (acc[dh][mt][4 * a4 + 1] + bias), x2 = u2 * (acc[dh][mt][4 * a4 + 2] + bias), x3 = u3 * (acc[dh][mt][4 * a4 + 3] + bias);
                acc[dh][mt][4 * a4] = x0; acc[dh][mt][4 * a4 + 1] = x1; acc[dh][mt][4 * a4 + 2] = x2; acc[dh][mt][4 * a4 + 3] = x3; ss += (x0 * x0 + x1 * x1) + (x2 * x2 + x3 * x3); }
        ss += __shfl_xor(ss, 32); if (hi == 0) SSQA[g * 128 + t] = ss; }
    __syncthreads();
#pragma unroll
    for (int mt = 0; mt < 4; ++mt) { const int t = mt * 32 + r32; float sa = 0.f;
#pragma unroll
        for (int w8 = 0; w8 < 8; ++w8) sa += SSQA[w8 * 128 + t];
        const float rs = rsqrtf(sa * (1.f / 512.f) + 1e-6f); bf16_t* op = MIX + (size_t)(tok0 + t) * 1024 + g * 64 + 4 * hi;
#pragma unroll
        for (int dh = 0; dh < 2; ++dh)
#pragma unroll
            for (int a4 = 0; a4 < 4; ++a4) { u32x2 w; w.x = cvt_pk_bf16(acc[dh][mt][4 * a4] * rs, acc[dh][mt][4 * a4 + 1] * rs); w.y = cvt_pk_bf16(acc[dh][mt][4 * a4 + 2] * rs, acc[dh][mt][4 * a4 + 3] * rs); *(u32x2*)(op + dh * 32 + a4 * 8) = w; } }
    __syncthreads();
}

constexpr int A_KB = 0, A_VB = 32768, A_IMPH = 65536, A_LINV = 132096, A_MASK = 133120, A_SSQ = 133632  ;
__device__ __forceinline__ void attn_cmp(LAS unsigned char* lds, const bf16_t* Kb, const bf16_t* Vb, int ntc, const bf16x8 (&qr)[4], f32x16 (&oT)[2], float& lsum,
                                         int kmin, int kmax, int kvh, int wave, int lane, int r32, int hi) {
    const int pitch = 64, hstride = 256 * 64;
    u32x4 sk0, sk1, sv0, sv1;
    const bf16_t* kthr = Kb + (size_t)lane * pitch + wave * 8; const bf16_t* vthr = Vb + (size_t)(16 * (wave & 3) + (lane >> 2)) * pitch + (wave >> 2) * 32 + (lane & 3) * 8;
    const int sdst = wave * 1024 + lane * 16;
#define A_LD(tile) do { const size_t to_ = (size_t)(tile) * 64 * pitch; sk0 = *(const u32x4*)(kthr + to_); sk1 = *(const u32x4*)(kthr + to_ + hstride); sv0 = *(const u32x4*)(vthr + to_); sv1 = *(const u32x4*)(vthr + to_ + hstride); } while (0)
#define A_ST(so) do { *(LAS u32x4*)(lds + A_KB + (so) + sdst) = sk0; *(LAS u32x4*)(lds + A_KB + (so) + 8192 + sdst) = sk1; *(LAS u32x4*)(lds + A_VB + (so) + sdst) = sv0; *(LAS u32x4*)(lds + A_VB + (so) + 8192 + sdst) = sv1; } while (0)
    const LAS char* kbase = (const LAS char*)(lds + A_KB) + kvh * 8192 + hi * 1024 + r32 * 16;
    const LAS char* vbase = (const LAS char*)(lds + A_VB) + kvh * 8192 + ((lane >> 4) & 1) * 32 + (lane & 3) * 8 + (4 * hi + ((lane & 15) >> 2)) * 64;
    LAS float* IMPH = (LAS float*)(lds + A_IMPH) + (wave * 32 + r32) * 65;
    float carry = 0.f;
    A_LD(0); A_ST(0); __syncthreads();
#pragma unroll 1
    for (int tile = 0; tile < ntc; ++tile) {
        const int so = (tile & 1) * 16384;
        if (tile + 1 < ntc) A_LD(tile + 1);
        bf16x8 kf[8];
#pragma unroll
        for (int d0 = 0; d0 < 4; ++d0) { kf[2 * d0] = *(const LAS bf16x8*)(kbase + so + d0 * 2048); kf[2 * d0 + 1] = *(const LAS bf16x8*)(kbase + so + d0 * 2048 + 512); }
        f32x16 p0, p1;
#pragma unroll
        for (int r = 0; r < 16; ++r) { p0[r] = 0.f; p1[r] = 0.f; }
#pragma unroll
        for (int d0 = 0; d0 < 4; ++d0) { p0 = MFMA32(kf[2 * d0], qr[d0], p0); p1 = MFMA32(kf[2 * d0 + 1], qr[d0], p1); }
        const int a = kmin - 64 * tile, bb = kmax - 64 * tile;
#pragma unroll
        for (int r = 0; r < 16; ++r) { p0[r] = __builtin_amdgcn_exp2f(p0[r]); p1[r] = __builtin_amdgcn_exp2f(p1[r]); }
        if (!__all(a <= 0 && bb >= 63)) { const unsigned span = (unsigned)(bb - a);
#pragma unroll
            for (int r = 0; r < 16; ++r) { const int rel = crow(r, hi); p0[r] = ((unsigned)(rel - a) <= span) ? p0[r] : 0.f; p1[r] = ((unsigned)(rel + 32 - a) <= span) ? p1[r] : 0.f; } }
        { float s = 0.f;
#pragma unroll
          for (int r = 0; r < 16; ++r) s += p0[r] + p1[r];
          lsum += s; }
        { float own[2][4], rcv[2][4];
#pragma unroll
          for (int a4 = 0; a4 < 4; ++a4) { const float h0 = 0.5f * p0[4 * a4 + 3], h1 = 0.5f * p1[4 * a4 + 3];
              own[0][a4] = (p0[4 * a4] + p0[4 * a4 + 1]) + (p0[4 * a4 + 2] + h0); own[1][a4] = (p1[4 * a4] + p1[4 * a4 + 1]) + (p1[4 * a4 + 2] + h1);
              rcv[0][a4] = __shfl_xor(h0, 32); rcv[1][a4] = __shfl_xor(h1, 32); }
#pragma unroll
          for (int h2 = 0; h2 < 2; ++h2)
#pragma unroll
              for (int a4 = 0; a4 < 4; ++a4) { const float fromprev = a4 > 0 ? rcv[h2][a4 - 1] : (h2 ? rcv[0][3] : carry);
                  IMPH[16 * tile + 8 * h2 + 2 * a4 + hi] = own[h2][a4] + (hi ? rcv[h2][a4] : fromprev); }
          carry = rcv[1][3]; }
        bf16x8 pa[4];
        { u32x4 w0, w1, w2, w3;
#pragma unroll
          for (int i = 0; i < 4; ++i) { w0[i] = cvt_pk_bf16(p0[2 * i], p0[2 * i + 1]); w1[i] = cvt_pk_bf16(p0[8 + 2 * i], p0[8 + 2 * i + 1]); w2[i] = cvt_pk_bf16(p1[2 * i], p1[2 * i + 1]); w3[i] = cvt_pk_bf16(p1[8 + 2 * i], p1[8 + 2 * i + 1]); }
          pa[0] = __builtin_bit_cast(bf16x8, w0); pa[1] = __builtin_bit_cast(bf16x8, w1); pa[2] = __builtin_bit_cast(bf16x8, w2); pa[3] = __builtin_bit_cast(bf16x8, w3); }
#pragma unroll
        for (int dh = 0; dh < 2; ++dh)
#pragma unroll
            for (int ks = 0; ks < 4; ++ks) { const s16x4 lo = vtr(vbase + so + dh * 4096 + ks * 1024), hh = vtr(vbase + so + dh * 4096 + ks * 1024 + 512); oT[dh] = MFMA32(VFRAG(lo, hh), pa[ks], oT[dh]); }
        if (tile + 1 < ntc) A_ST(so ^ 16384);
        __syncthreads();
    }
#undef A_LD
#undef A_ST
}

constexpr int A2_K = 0, A2_V = 49152, A2_SL = 16384;
#define SBAR() __builtin_amdgcn_sched_barrier(0)
#define PIN(x) asm volatile("" : "+v"(x))
#define WAIT_BAR(N) asm volatile("s_waitcnt vmcnt(" #N ") lgkmcnt(0)\n\ts_barrier" ::: "memory")
__device__ __forceinline__ void glds16(const void* g, unsigned lds_base) {
    unsigned sv; asm volatile("s_mov_b32 %0, m0\n\ts_mov_b32 m0, %2\n\ts_nop 0\n\tglobal_load_lds_dwordx4 %1, off\n\ts_mov_b32 m0, %0" : "=&s"(sv) : "v"(g), "s"(lds_base) : "memory"); }
__device__ __forceinline__ void range_mask(f32x16& c0, f32x16& c1, int a, int bb, int hi) {
    const unsigned span = (unsigned)(bb - a);
#pragma unroll
    for (int r = 0; r < 16; ++r) { const int rel = crow(r, hi); c0[r] = ((unsigned)(rel - a) <= span) ? c0[r] : -INFINITY; c1[r] = ((unsigned)(rel + 32 - a) <= span) ? c1[r] : -INFINITY; }
}
template <bool WIN>
__device__ __forceinline__ void attn_stream(LAS unsigned char* lds, const bf16_t* Kb, const bf16_t* Vb, int tlo, int NT, const bf16x8 (&qr)[4], f32x16 (&oT)[2], float& l_out,
                                            unsigned mlo, unsigned mhi, int tq, int kvh, int wave, int lane, int r32, int hi) {
    const unsigned lds0 = (unsigned)(uintptr_t)lds;
    const bf16_t* ksrc = Kb + (size_t)lane * 768 + wave * 8;
    const bf16_t* vsrc = Vb + (size_t)(16 * (wave & 3) + (lane >> 2)) * 768 + (wave >> 2) * 32 + (lane & 3) * 8;
    const unsigned kdst = lds0 + A2_K + wave * 1024, vdst = lds0 + A2_V + wave * 1024;
#define RFL(x) ((unsigned)__builtin_amdgcn_readfirstlane((int)(x)))
#define TCL(i) ((size_t)(tlo + ((i) < NT ? (i) : NT - 1)) * (64 * 768))
#define DMA_K(i, slot) do { const bf16_t* s_ = ksrc + TCL(i); glds16(s_, RFL(kdst + (slot))); glds16(s_ + 64, RFL(kdst + (slot) + 8192)); } while (0)
#define DMA_V(i, slot) do { const bf16_t* s_ = vsrc + TCL(i); glds16(s_, RFL(vdst + (slot))); glds16(s_ + 64, RFL(vdst + (slot) + 8192)); } while (0)
#define TMASK(idx_, a_, bb_, selm_) do { const int tt_ = tlo + (idx_); if (WIN) { a_ = tq - 511 - 64 * tt_; bb_ = tq - 64 * tt_; selm_ = ~0u; } \
        else { const unsigned s_ = tt_ < 32 ? (mlo >> tt_) & 1u : (mhi >> (tt_ - 32)) & 1u; a_ = -64 * tt_; bb_ = tq - 64 * tt_; selm_ = 0u - s_; } } while (0)
#define NEEDM(a_, bb_, selm_) (!__all((selm_) == 0u || ((a_) <= 0 && (bb_) >= 63)))
    const LAS char* kp0 = (const LAS char*)(lds + A2_K) + kvh * 8192 + hi * 1024 + r32 * 16;
    const LAS char* vp0 = (const LAS char*)(lds + A2_V) + kvh * 8192 + ((lane >> 4) & 1) * 32 + (lane & 3) * 8 + (4 * hi + ((lane & 15) >> 2)) * 64;
    asm volatile("s_waitcnt vmcnt(0)" ::: "memory");
    DMA_K(0, 0); DMA_V(0, 0); DMA_K(1, A2_SL); DMA_K(2, 2 * A2_SL);
    float l_reg = 0.f; f32x16 pA0, pA1, pB0, pB1; bf16x8 kf[8]; s16x4 vlo[8], vhi[8]; u32x4 pw0, pw1, pw2, pw3; unsigned selm_prev;
    const f32x16 zero16 = {0.f, 0.f, 0.f, 0.f, 0.f, 0.f, 0.f, 0.f, 0.f, 0.f, 0.f, 0.f, 0.f, 0.f, 0.f, 0.f};
    int sl_prev = 0, sl_cur = 0, sl_next = A2_SL;
#define ROT() do { sl_prev = sl_cur; sl_cur = sl_next; sl_next = (sl_next == 2 * A2_SL) ? 0 : sl_next + A2_SL; } while (0)
#define KLD(kp, d0) do { kf[2 * (d0)] = *(const LAS bf16x8*)((kp) + (d0) * 2048); kf[2 * (d0) + 1] = *(const LAS bf16x8*)((kp) + (d0) * 2048 + 512); } while (0)
    WAIT_BAR(6);
    KLD(kp0, 0); KLD(kp0, 1); KLD(kp0, 2); KLD(kp0, 3);
    pA0 = MFMA32(kf[0], qr[0], zero16); pA1 = MFMA32(kf[1], qr[0], zero16); pA0 = MFMA32(kf[2], qr[1], pA0); pA1 = MFMA32(kf[3], qr[1], pA1);
    pA0 = MFMA32(kf[4], qr[2], pA0); pA1 = MFMA32(kf[5], qr[2], pA1); pA0 = MFMA32(kf[6], qr[3], pA0); pA1 = MFMA32(kf[7], qr[3], pA1);
    { int a_, bb_; TMASK(0, a_, bb_, selm_prev); if (NEEDM(a_, bb_, selm_prev)) range_mask(pA0, pA1, a_, bb_, hi); }
#pragma unroll
    for (int r = 0; r < 16; ++r) { pA0[r] = __builtin_amdgcn_exp2f(pA0[r]); pA1[r] = __builtin_amdgcn_exp2f(pA1[r]); }
    WAIT_BAR(0);
    DMA_K(3, 0); DMA_V(1, A2_SL); ROT();
    KLD(kp0 + sl_cur, 0); KLD(kp0 + sl_cur, 1); KLD(kp0 + sl_cur, 2); KLD(kp0 + sl_cur, 3);
    WAIT_BAR(4);
#define PKW(P, i) cvt_pk_bf16(P[i], P[(i) + 1])
#define PAF(k) __builtin_bit_cast(bf16x8, pw##k)
#define VFR(i) VFRAG(vlo[i], vhi[i])
#define VRD(i) do { vlo[i] = vtr(vp_ + (((i) >> 2) * 4096 + ((i) & 3) * 1024)); vhi[i] = vtr(vp_ + (((i) >> 2) * 4096 + ((i) & 3) * 1024 + 512)); } while (0)
#define KRD(d0) do { KLD(kp0 + sl_next, d0); SBAR(); } while (0)
#define EX(v) __builtin_amdgcn_exp2f(v)
#define GAPA(MF, a0, a1, a2, a3, W0, W1, PW) do { MF; sacc += a0; sacc += a1; sacc += a2; sacc += a3; W0; W1; PIN(PW); PIN(sacc); SBAR(); } while (0)
#define GAPB(MF, X, i) do { MF; X[i] = EX(X[i]); X[(i) + 1] = EX(X[(i) + 1]); X[(i) + 2] = EX(X[(i) + 2]); X[(i) + 3] = EX(X[(i) + 3]); PIN(X); SBAR(); } while (0)
#define SELPW() do { if (!__all(selm_prev == ~0u)) { const u32x4 m_ = {selm_prev, selm_prev, selm_prev, selm_prev}; pw0 = pw0 & m_; pw1 = pw1 & m_; pw2 = pw2 & m_; pw3 = pw3 & m_; } } while (0)
#define STEP(C0, C1, P0, P1, idx) do { SBAR(); \
    const LAS char* vp_ = vp0 + sl_prev; \
    VRD(0); SBAR(); float sacc = P0[0] + P0[1]; \
                    GAPA(C0 = MFMA32(kf[0], qr[0], zero16), P0[2], P0[3], P0[4], P0[5],     pw0[0] = PKW(P0, 0),  pw0[1] = PKW(P0, 2),  pw0); \
    VRD(4); SBAR(); GAPA(C1 = MFMA32(kf[1], qr[0], zero16), P0[6], P0[7], P0[8], P0[9],     pw0[2] = PKW(P0, 4),  pw0[3] = PKW(P0, 6),  pw0); \
    VRD(1); SBAR(); GAPA(C0 = MFMA32(kf[2], qr[1], C0),     P0[10], P0[11], P0[12], P0[13], pw1[0] = PKW(P0, 8),  pw1[1] = PKW(P0, 10), pw1); \
    VRD(5); SBAR(); GAPA(C1 = MFMA32(kf[3], qr[1], C1),     P0[14], P0[15], P1[0], P1[1],   pw1[2] = PKW(P0, 12), pw1[3] = PKW(P0, 14), pw1); \
    VRD(2); SBAR(); GAPA(C0 = MFMA32(kf[4], qr[2], C0),     P1[2], P1[3], P1[4], P1[5],     pw2[0] = PKW(P1, 0),  pw2[1] = PKW(P1, 2),  pw2); \
    VRD(6); SBAR(); GAPA(C1 = MFMA32(kf[5], qr[2], C1),     P1[6], P1[7], P1[8], P1[9],     pw2[2] = PKW(P1, 4),  pw2[3] = PKW(P1, 6),  pw2); \
    VRD(3); SBAR(); GAPA(C0 = MFMA32(kf[6], qr[3], C0),     P1[10], P1[11], P1[12], P1[13], pw3[0] = PKW(P1, 8),  pw3[1] = PKW(P1, 10), pw3); \
    VRD(7); SBAR(); GAPA(C1 = MFMA32(kf[7], qr[3], C1),     P1[14], P1[15], 0.f, 0.f,       pw3[2] = PKW(P1, 12), pw3[3] = PKW(P1, 14), pw3); \
    l_reg += __uint_as_float(__float_as_uint(sacc) & selm_prev); SELPW(); \
    DMA_K((idx) + 3, sl_cur); DMA_V((idx) + 1, sl_next); \
    { int a_, bb_; unsigned selm_; TMASK(idx, a_, bb_, selm_); if (NEEDM(a_, bb_, selm_)) range_mask(C0, C1, a_, bb_, hi); selm_prev = selm_; } \
    SBAR(); \
    GAPB(oT[0] = MFMA32(VFR(0), PAF(0), oT[0]), C0, 0);            GAPB(oT[1] = MFMA32(VFR(4), PAF(0), oT[1]), C0, 4); \
    KRD(0); GAPB(oT[0] = MFMA32(VFR(1), PAF(1), oT[0]), C0, 8);    KRD(1); GAPB(oT[1] = MFMA32(VFR(5), PAF(1), oT[1]), C0, 12); \
    KRD(2); GAPB(oT[0] = MFMA32(VFR(2), PAF(2), oT[0]), C1, 0);    KRD(3); GAPB(oT[1] = MFMA32(VFR(6), PAF(2), oT[1]), C1, 4); \
    GAPB(oT[0] = MFMA32(VFR(3), PAF(3), oT[0]), C1, 8);            GAPB(oT[1] = MFMA32(VFR(7), PAF(3), oT[1]), C1, 12); \
    } while (0)
    int idx = 1;
#pragma unroll 1
    for (; idx + 1 < NT; idx += 2) {
        STEP(pB0, pB1, pA0, pA1, idx);     WAIT_BAR(4); ROT();
        STEP(pA0, pA1, pB0, pB1, idx + 1); WAIT_BAR(4); ROT();
    }
    if (idx < NT) { STEP(pB0, pB1, pA0, pA1, idx); WAIT_BAR(4); ROT(); pA0 = pB0; pA1 = pB1; }
    { float sacc = 0.f;
#pragma unroll
      for (int r = 0; r < 16; ++r) sacc += pA0[r] + pA1[r];
      l_reg += __uint_as_float(__float_as_uint(sacc) & selm_prev);
      pw0 = (u32x4){PKW(pA0, 0), PKW(pA0, 2), PKW(pA0, 4), PKW(pA0, 6)}; pw1 = (u32x4){PKW(pA0, 8), PKW(pA0, 10), PKW(pA0, 12), PKW(pA0, 14)};
      pw2 = (u32x4){PKW(pA1, 0), PKW(pA1, 2), PKW(pA1, 4), PKW(pA1, 6)}; pw3 = (u32x4){PKW(pA1, 8), PKW(pA1, 10), PKW(pA1, 12), PKW(pA1, 14)};
      SELPW();
      const LAS char* vp_ = vp0 + ((NT - 1) % 3) * A2_SL;
#pragma unroll
      for (int i = 0; i < 8; ++i) VRD(i);
      oT[0] = MFMA32(VFR(0), PAF(0), oT[0]); oT[1] = MFMA32(VFR(4), PAF(0), oT[1]); oT[0] = MFMA32(VFR(1), PAF(1), oT[0]); oT[1] = MFMA32(VFR(5), PAF(1), oT[1]);
      oT[0] = MFMA32(VFR(2), PAF(2), oT[0]); oT[1] = MFMA32(VFR(6), PAF(2), oT[1]); oT[0] = MFMA32(VFR(3), PAF(3), oT[0]); oT[1] = MFMA32(VFR(7), PAF(3), oT[1]); }
    WAIT_BAR(0);
    l_out = l_reg;
#undef RFL
#undef TCL
#undef DMA_K
#undef DMA_V
#undef TMASK
#undef NEEDM
#undef ROT
#undef KLD
#undef PKW
#undef PAF
#undef VFR
#undef VRD
#undef KRD
#undef EX
#undef GAPA
#undef GAPB
#undef SELPW
#undef STEP
}

template <int PARTS>
__device__ __forceinline__ void attn_unit(LAS unsigned char* lds, int b, int qt, const bf16_t* Q, const bf16_t* KV, const bf16_t* KC, const bf16_t* VC, const float* GL, bf16_t* MIX) {
    int tid_ = threadIdx.x; asm volatile("" : "+v"(tid_)); const int tid = tid_, lane = tid & 63, wave = __builtin_amdgcn_readfirstlane(tid >> 6), r32 = lane & 31, hi = lane >> 5, kvh = wave >> 2;
    const int t0 = qt * 32, tq = t0 + r32; const size_t tok = (size_t)b * T + tq;
    bf16x8 qr[4];
#pragma unroll
    for (int d0 = 0; d0 < 4; ++d0) qr[d0] = *(const bf16x8*)(Q + tok * 512 + wave * 64 + d0 * 16 + hi * 8);
    LAS float* IMPHA = (LAS float*)(lds + A_IMPH); LAS float* LINV = (LAS float*)(lds + A_LINV); LAS unsigned* MASKL = (LAS unsigned*)(lds + A_MASK); LAS float* SSQL = (LAS float*)(lds + A_SSQ);
    const float* glp = GL + tok * 24 + wave * 3;
    const float g0 = 1.f / (1.f + __expf(-glp[0])), g1 = 1.f / (1.f + __expf(-glp[1])), g2 = 1.f / (1.f + __expf(-glp[2]));
    f32x16 tot[2], oT[2];
    const int nvalid = tq >= 31 ? (tq - 31) / 16 + 1 : 0; const int ntc = (2 * qt + 1 + 63) >> 6;
    const int ckmin = nvalid > 0 ? 0 : (1 << 20), ckmax = nvalid > 0 ? nvalid - 1 : (1 << 20);
    const bf16_t* KCb = KC + (size_t)(b * 2) * 256 * 64; const bf16_t* VCb = VC + (size_t)(b * 2) * 256 * 64;
    float lc = 0.f;
#pragma unroll
    for (int r = 0; r < 16; ++r) { oT[0][r] = 0.f; oT[1][r] = 0.f; }
    if constexpr (PARTS & 1) attn_cmp(lds, KCb, VCb, ntc, qr, oT, lc, ckmin, ckmax, kvh, wave, lane, r32, hi);
    lc += __shfl_xor(lc, 32); const float inv_lc = lc > 0.f ? 1.f / lc : 0.f;
    if (hi == 0) LINV[wave * 32 + r32] = inv_lc;
    { const float c = g0 * inv_lc;
#pragma unroll
      for (int r = 0; r < 16; ++r) { tot[0][r] = oT[0][r] * c; tot[1][r] = oT[1][r] * c; oT[0][r] = 0.f; oT[1][r] = 0.f; } }
    __syncthreads();
    if constexpr (PARTS & 2) {
#pragma unroll 1
      for (int i = 0; i < 8; ++i) { const int pair = wave * 8 + i, kvp = pair >> 5, qq = pair & 31, j = lane; const int tb = (t0 + qq) >> 6; float v = 0.f;
#pragma unroll
          for (int g = 0; g < 4; ++g) v += IMPHA[((kvp * 4 + g) * 32 + qq) * 65 + j] * LINV[(kvp * 4 + g) * 32 + qq];
          const bool forced = (j == 0) || (j == tb) || (j == tb - 1); const float val = forced ? 1e4f : (j <= tb ? v : -1e4f);
          unsigned key = __float_as_uint(val); key ^= (key & 0x80000000u) ? 0xffffffffu : 0x80000000u; key = (key & ~63u) | (unsigned)(63 - j);
          unsigned prefix = 0u;
#pragma unroll
          for (int bit = 31; bit >= 0; --bit) { const unsigned tt = prefix | (1u << bit); const int cnt = __popcll(__ballot(key >= tt)); prefix = cnt >= 16 ? tt : prefix; }
          const unsigned long long m = __ballot(key >= prefix);
          if (lane == 0) { MASKL[pair * 2] = (unsigned)m; MASKL[pair * 2 + 1] = (unsigned)(m >> 32); } } }
    __syncthreads();
    const unsigned mlo = MASKL[(kvh * 32 + r32) * 2], mhi = MASKL[(kvh * 32 + r32) * 2 + 1];
    const int jmax = (t0 + 31) >> 6;
    const bf16_t* KVb = KV + (size_t)b * T * 768;
    unsigned totp[16];
#pragma unroll
    for (int i = 0; i < 8; ++i) { totp[i] = cvt_pk_bf16(tot[0][2 * i], tot[0][2 * i + 1]); totp[8 + i] = cvt_pk_bf16(tot[1][2 * i], tot[1][2 * i + 1]); }
    float ls = 0.f;
    if constexpr (PARTS & 4) attn_stream<false>(lds, KVb + 256, KVb + 384, 0, jmax + 1, qr, oT, ls, mlo, mhi, tq, kvh, wave, lane, r32, hi);
    ls += __shfl_xor(ls, 32);
    { const float c = ls > 0.f ? g1 / ls : 0.f;
#pragma unroll
      for (int i = 0; i < 8; ++i) { totp[i] = cvt_pk_bf16(__uint_as_float(totp[i] << 16) + oT[0][2 * i] * c, __uint_as_float(totp[i] & 0xffff0000u) + oT[0][2 * i + 1] * c);
                                    totp[8 + i] = cvt_pk_bf16(__uint_as_float(totp[8 + i] << 16) + oT[1][2 * i] * c, __uint_as_float(totp[8 + i] & 0xffff0000u) + oT[1][2 * i + 1] * c); }
#pragma unroll
      for (int r = 0; r < 16; ++r) { oT[0][r] = 0.f; oT[1][r] = 0.f; } }
    float lw = 0.f; const int jlo = t0 >= 511 ? (t0 - 511) >> 6 : 0;
    if constexpr (PARTS & 8) attn_stream<true>(lds, KVb + 512, KVb + 640, jlo, jmax - jlo + 1, qr, oT, lw, 0u, 0u, tq, kvh, wave, lane, r32, hi);
    lw += __shfl_xor(lw, 32);
    { const float c = lw > 0.f ? g2 / lw : 0.f;
#pragma unroll
      for (int i = 0; i < 8; ++i) { tot[0][2 * i] = __uint_as_float(totp[i] << 16) + oT[0][2 * i] * c; tot[0][2 * i + 1] = __uint_as_float(totp[i] & 0xffff0000u) + oT[0][2 * i + 1] * c;
                                    tot[1][2 * i] = __uint_as_float(totp[8 + i] << 16) + oT[1][2 * i] * c; tot[1][2 * i + 1] = __uint_as_float(totp[8 + i] & 0xffff0000u) + oT[1][2 * i + 1] * c; } }
    { float ss = 0.f;
#pragma unroll
      for (int r = 0; r < 16; ++r) ss += tot[0][r] * tot[0][r] + tot[1][r] * tot[1][r];
      ss += __shfl_xor(ss, 32); if (hi == 0) SSQL[wave * 32 + r32] = ss; }
    __syncthreads();
    { float sa = 0.f;
#pragma unroll
      for (int w8 = 0; w8 < 8; ++w8) sa += SSQL[w8 * 32 + r32];
      const float rs = rsqrtf(sa * (1.f / 512.f) + 1e-6f); bf16_t* op = MIX + tok * 1024 + 512 + wave * 64 + 4 * hi;
#pragma unroll
      for (int dh = 0; dh < 2; ++dh)
#pragma unroll
          for (int a4 = 0; a4 < 4; ++a4) { u32x2 w; w.x = cvt_pk_bf16(tot[dh][4 * a4] * rs, tot[dh][4 * a4 + 1] * rs); w.y = cvt_pk_bf16(tot[dh][4 * a4 + 2] * rs, tot[dh][4 * a4 + 3] * rs); *(u32x2*)(op + dh * 32 + a4 * 8) = w; } }
    __syncthreads();
}

__device__ __forceinline__ void memattn_unit(LAS unsigned char* lds, int b, int h, int qt, const bf16_t* QM, const bf16_t* KVM, const float* qg, bf16_t* OM) {
    int tid_ = threadIdx.x; asm volatile("" : "+v"(tid_)); const int tid = tid_, lane = tid & 63, wave = __builtin_amdgcn_readfirstlane(tid >> 6), r32 = lane & 31, hi = lane >> 5;
    const size_t tok = (size_t)b * T + qt * 256 + wave * 32 + r32;
    bf16x8 qr[8];
    { float v[64]; float ss = 0.f;
#pragma unroll
      for (int d0 = 0; d0 < 8; ++d0) { const u32x4 w = *(const u32x4*)(QM + tok * 512 + h * 128 + d0 * 16 + hi * 8);
#pragma unroll
          for (int i = 0; i < 4; ++i) { const float a = __uint_as_float(w[i] << 16), c = __uint_as_float(w[i] & 0xffff0000u); v[d0 * 8 + 2 * i] = a; v[d0 * 8 + 2 * i + 1] = c; ss += a * a + c * c; } }
      ss += __shfl_xor(ss, 32); const float rs = rsqrtf(ss * (1.f / 128.f) + 1e-6f) * (0.08838834764831845f * 1.4426950408889634f);
#pragma unroll
      for (int d0 = 0; d0 < 8; ++d0) { u32x4 w; const float* gp = qg + d0 * 16 + hi * 8;
#pragma unroll
          for (int i = 0; i < 4; ++i) w[i] = cvt_pk_bf16(v[d0 * 8 + 2 * i] * rs * gp[2 * i], v[d0 * 8 + 2 * i + 1] * rs * gp[2 * i + 1]);
          qr[d0] = __builtin_bit_cast(bf16x8, w); } }
    const bf16_t* Kg = KVM + (size_t)b * 256 * 1024 + h * 128; const bf16_t* Vg = Kg + 512;
    u32x4 sk[2], sv[2];
#define M_LD(tile) do { _Pragma("unroll") for (int i = 0; i < 2; ++i) { sk[i] = *(const u32x4*)(Kg + (size_t)((tile) * 64 + lane) * 1024 + (wave * 2 + i) * 8); const int p = i * 512 + tid; \
        sv[i] = *(const u32x4*)(Vg + (size_t)((tile) * 64 + ((p & 255) >> 2)) * 1024 + (p >> 8) * 32 + (p & 3) * 8); } } while (0)
#define M_ST(so) do { _Pragma("unroll") for (int i = 0; i < 2; ++i) { *(LAS u32x4*)(lds + (so) + (wave * 2 + i) * 1024 + lane * 16) = sk[i]; *(LAS u32x4*)(lds + 32768 + (so) + (i * 512 + tid) * 16) = sv[i]; } } while (0)
    const LAS char* kbase = (const LAS char*)lds + hi * 1024 + r32 * 16;
    const LAS char* vbase = (const LAS char*)lds + 32768 + ((lane >> 4) & 1) * 32 + (lane & 3) * 8 + (4 * hi + ((lane & 15) >> 2)) * 64;
    f32x16 oT[4]; float lsum = 0.f;
#pragma unroll
    for (int dq = 0; dq < 4; ++dq)
#pragma unroll
        for (int r = 0; r < 16; ++r) oT[dq][r] = 0.f;
    M_LD(0); M_ST(0); __syncthreads();
#pragma unroll 1
    for (int tile = 0; tile < 4; ++tile) { const int so = (tile & 1) * 16384;
        if (tile < 3) M_LD(tile + 1);
        f32x16 p0, p1;
#pragma unroll
        for (int r = 0; r < 16; ++r) { p0[r] = 0.f; p1[r] = 0.f; }
#pragma unroll
        for (int d0 = 0; d0 < 8; ++d0) { const bf16x8 k0 = *(const LAS bf16x8*)(kbase + so + d0 * 2048), k1 = *(const LAS bf16x8*)(kbase + so + d0 * 2048 + 512); p0 = MFMA32(k0, qr[d0], p0); p1 = MFMA32(k1, qr[d0], p1); }
        float s = 0.f;
#pragma unroll
        for (int r = 0; r < 16; ++r) { p0[r] = __builtin_amdgcn_exp2f(p0[r]); p1[r] = __builtin_amdgcn_exp2f(p1[r]); s += p0[r] + p1[r]; }
        lsum += s;
        bf16x8 pa[4];
        { u32x4 w0, w1, w2, w3;
#pragma unroll
          for (int i = 0; i < 4; ++i) { w0[i] = cvt_pk_bf16(p0[2 * i], p0[2 * i + 1]); w1[i] = cvt_pk_bf16(p0[8 + 2 * i], p0[8 + 2 * i + 1]); w2[i] = cvt_pk_bf16(p1[2 * i], p1[2 * i + 1]); w3[i] = cvt_pk_bf16(p1[8 + 2 * i], p1[8 + 2 * i + 1]); }
          pa[0] = __builtin_bit_cast(bf16x8, w0); pa[1] = __builtin_bit_cast(bf16x8, w1); pa[2] = __builtin_bit_cast(bf16x8, w2); pa[3] = __builtin_bit_cast(bf16x8, w3); }
#pragma unroll
        for (int dq = 0; dq < 4; ++dq)
#pragma unroll
            for (int ks = 0; ks < 4; ++ks) { const s16x4 lo = vtr(vbase + so + dq * 4096 + ks * 1024), hh = vtr(vbase + so + dq * 4096 + ks * 1024 + 512); oT[dq] = MFMA32(VFRAG(lo, hh), pa[ks], oT[dq]); }
        if (tile < 3) M_ST(so ^ 16384);
        __syncthreads();
    }
#undef M_LD
#undef M_ST
    lsum += __shfl_xor(lsum, 32); const float il = 1.f / lsum; bf16_t* op = OM + tok * 512 + h * 128 + 4 * hi;
#pragma unroll
    for (int dq = 0; dq < 4; ++dq)
#pragma unroll
        for (int a4 = 0; a4 < 4; ++a4) { u32x2 w; w.x = cvt_pk_bf16(oT[dq][4 * a4] * il, oT[dq][4 * a4 + 1] * il); w.y = cvt_pk_bf16(oT[dq][4 * a4 + 2] * il, oT[dq][4 * a4 + 3] * il); *(u32x2*)(op + dq * 32 + a4 * 8) = w; }
}

#define XB_TMO      128
#define XB_XCNT(j)  (256  + 64 * (j))
#define XB_XSUB(j)  (1280 + 64 * (j))
#define XB_XGEN(j)  (2304 + 64 * (j))
#define XB_TOP      3328
#define XB_TOPGEN   3392
#define XCD_BAR_WORDS 3456
#define XB_SPIN_CAP (1u << 18)
__device__ __forceinline__ unsigned xb_ld(unsigned* p)              { return __hip_atomic_load(p, __ATOMIC_RELAXED, __HIP_MEMORY_SCOPE_AGENT); }
__device__ __forceinline__ unsigned xb_add(unsigned* p, unsigned v) { return __hip_atomic_fetch_add(p, v, __ATOMIC_RELAXED, __HIP_MEMORY_SCOPE_AGENT); }
__device__ __forceinline__ unsigned xb_xcc_id() { return (unsigned)__builtin_amdgcn_s_getreg((3 << 11) | 20) & 0xFu; }
#define XB_SPIN(cond, bar) do { unsigned _sp = 0; while (cond) { __builtin_amdgcn_s_sleep(1); \
    if ((++_sp & 255u) == 0u) { if (xb_ld(&(bar)[XB_TMO])) break; if (_sp > XB_SPIN_CAP) { atomicAdd(&(bar)[XB_TMO], 1u); break; } } } } while (0)
struct XcdBarrier { unsigned* bar; unsigned x; volatile LAS unsigned* st; };
__device__ __forceinline__ XcdBarrier xcd_barrier_post(unsigned* bar, volatile LAS unsigned* st) {
    XcdBarrier b; b.bar = bar; b.x = xb_xcc_id(); b.st = st;
    if (threadIdx.x == 0) (void)xb_add(&bar[XB_XCNT(b.x)], 1u);
    return b;
}
__device__ __forceinline__ void xcd_barrier_complete(unsigned* bar, unsigned x, unsigned& nloc, unsigned& nx) {
    const unsigned G = gridDim.x * gridDim.y * gridDim.z;
    unsigned sum, cnt, mine, sp = 0u;
    for (;;) {
        sum = 0u; cnt = 0u; mine = 0u;
#pragma unroll
        for (unsigned j = 0; j < 16; ++j) { const unsigned c = xb_ld(&bar[XB_XCNT(j)]); sum += c; cnt += (c > 0u) ? 1u : 0u; mine = (j == x) ? c : mine; }
        if (sum == G) break;
        __builtin_amdgcn_s_sleep(1);
        if ((++sp & 255u) == 0u) { if (xb_ld(&bar[XB_TMO])) break; if (sp > XB_SPIN_CAP) { atomicAdd(&bar[XB_TMO], 1u); break; } }
    }
    nloc = mine > 0u ? mine : 1u; nx = cnt > 0u ? cnt : 1u;
}
__device__ __forceinline__ void xcd_barrier(const XcdBarrier& b) {
    asm volatile("s_waitcnt vmcnt(0)" ::: "memory");
    __syncthreads();
    if (threadIdx.x == 0) {
        unsigned* bar = b.bar;
        __builtin_amdgcn_s_waitcnt(0);
        unsigned nloc = b.st[0], nx = b.st[1];
        if (nloc == 0u) { xcd_barrier_complete(bar, b.x, nloc, nx); b.st[0] = nloc; b.st[1] = nx; }
        const unsigned old = xb_add(&bar[XB_XSUB(b.x)], 1u);
        const unsigned gen = old / nloc;
        if (old + 1u == (gen + 1u) * nloc) {
            __builtin_amdgcn_fence(__ATOMIC_RELEASE, "agent");
            asm volatile("s_waitcnt vmcnt(0)" ::: "memory");
            const unsigned og = xb_add(&bar[XB_TOP], 1u);
            const unsigned tg = og / nx;
            if (og + 1u == (tg + 1u) * nx) xb_add(&bar[XB_TOPGEN], 1u);
            else XB_SPIN(xb_ld(&bar[XB_TOPGEN]) == tg, bar);
            __builtin_amdgcn_fence(__ATOMIC_ACQUIRE, "agent");
            xb_add(&bar[XB_XGEN(b.x)], 1u);
            asm volatile("s_waitcnt vmcnt(0)" ::: "memory");
        } else {
            XB_SPIN(xb_ld(&bar[XB_XGEN(b.x)]) == gen, bar);
            __builtin_amdgcn_fence(__ATOMIC_ACQUIRE, "agent");
            asm volatile("s_waitcnt vmcnt(0)" ::: "memory");
        }
    }
    __syncthreads();
}
constexpr size_t CTL_BAR_BYTE = 704 * 1024;
constexpr int LDS_ST_OFF = 147456 - 64;

template <bool PROBE>
__device__ __forceinline__ void do_phase(const int p, const int l, const Args& args, LAS unsigned char* lds, const int G, const int bx, const int NGW) {
    unsigned char* ws = args.ws; float* xout = args.out; asm volatile("" : "+s"(ws), "+s"(xout));
    int tidp = threadIdx.x; asm volatile("" : "+v"(tidp)); const int lane = tidp & 63, wave = __builtin_amdgcn_readfirstlane(tidp >> 6), gw = bx * 8 + wave; (void)lane; (void)gw; (void)NGW;
    float* ctl = (float*)(ws + WS_CTL); bf16_t* XB = (bf16_t*)(ws + WS_XB); float* ssqp = (float*)(ws + WS_SSQP);
    unsigned char* wl = ws + WS_W + l * W_LAYER;
    if (p == 0) {
        pg8::Gemm g = pg8::make_gemm(XB, (const bf16_t*)(wl + W_IN), 1024); pg8::StaticOrder S; S.init(NTOK, INP, G, bx);
        pg8::EpiInProj E{(bf16_t*)(ws + WS_U), (bf16_t*)(ws + WS_V), (bf16_t*)(ws + WS_Q), (bf16_t*)(ws + WS_KV), (float*)(ws + WS_GL), ssqp + (size_t)(l == 0 ? 0 : 3) * NTOK * 16};
        pg8::gemm_phase<pg8::EpiInProj, pg8::StaticOrder, true>(lds, g, S, E);
    } else if (p == 1) {
      for (int vb = bx; vb < 256; vb += G) {
        if (vb < 16) { const int kv = vb >> 3, pm = vb & 7;
            pg8::Gemm g; g.A = (const bf16_t*)(ws + WS_KV) + kv * 128; g.Bt = (const bf16_t*)(wl + W_C1 + (size_t)kv * 256 * 2048 * 2); g.K = 2048; g.lda = 16 * 768; g.kstepA = 768 * 2; g.a_s0 = 64 * 2; g.a_s1 = (size_t)T * 768 * 2;
            pg8::OneUnit S{1, {pm, 0}};
            bf16_t* hid = (bf16_t*)(ws + WS_HID) + (size_t)kv * 2048 * 256;
            pg8::EpiBf16G<1> E{hid, 256, (const float*)(wl + W_B1P) + kv * 256, nullptr, 0.f, 1};
            pg8::gemm_phase<pg8::EpiBf16G<1>, pg8::OneUnit, true>(lds, g, S, E);
            asm volatile("s_waitcnt vmcnt(0)" ::: "memory"); __syncthreads();
            cmp2_tile(hid + (size_t)pm * 256 * 256, (const bf16_t*)(wl + W_C2) + (size_t)kv * 64 * 256, args.in[I_CB2] + l * 128 + kv * 64, kv == 0 ? args.in[I_KNG] + l * 192 : (const float*)nullptr,
                      (bf16_t*)(ws + (kv ? WS_VC : WS_KC)) + (size_t)pm * 256 * 64);
        } else if (vb < 32) { const int i = vb - 16;
            pg8::Gemm g = pg8::make_gemm((const bf16_t*)(ws + WS_MEMB), (const bf16_t*)(wl + W_MKV), 1024); pg8::OneUnit S{1, {i >> 2, i & 3}};
            pg8::EpiBf16G<0> E{(bf16_t*)(ws + WS_KVM), 1024, nullptr, ctl + SSQ_MEM_OFF, 1.f / 1024.f, 1};
            pg8::gemm_phase<pg8::EpiBf16G<0>, pg8::OneUnit, true>(lds, g, S, E);
        } else if (vb < 160) {
            sgu_unit(lds, vb - 32, (const bf16_t*)(ws + WS_U), (const bf16_t*)(ws + WS_V), (const bf16_t*)(wl + W_SG), args.in[I_SGLNG] + l * 512, args.in[I_SGLNB] + l * 512, args.in[I_SGB] + l * 1024, (bf16_t*)(ws + WS_MIX));
        } else {
            for (int t = (vb - 160) * 8 + wave; t < NTOK; t += 4 * 768) tokprep4((bf16_t*)(ws + WS_Q), (bf16_t*)(ws + WS_KV), args.in[I_QNG] + l * 64, args.in[I_KNG] + l * 192, t, 768, lane);
        } }
    } else if (p == 3) {
        for (int r = gw; r < 4096; r += NGW) memk_norm_item((bf16_t*)(ws + WS_KVM), args.in[I_MKG] + l * 128, r, lane);
        for (int i = bx; i < 256; i += G) { const int b = (i & 7) >> 1, idx = (i >> 3) * 2 + (i & 1);
            attn_unit<15>(lds, b, 127 - idx, (const bf16_t*)(ws + WS_Q), (const bf16_t*)(ws + WS_KV), (const bf16_t*)(ws + WS_KC), (const bf16_t*)(ws + WS_VC), (const float*)(ws + WS_GL), (bf16_t*)(ws + WS_MIX));
            attn_unit<15>(lds, b, idx, (const bf16_t*)(ws + WS_Q), (const bf16_t*)(ws + WS_KV), (const bf16_t*)(ws + WS_KC), (const bf16_t*)(ws + WS_VC), (const float*)(ws + WS_GL), (bf16_t*)(ws + WS_MIX)); }
    } else if (p == 6) {
        for (int i = bx; i < 256; i += G) { const int b = (i & 7) >> 1, rest = (i >> 3) * 2 + (i & 1);
            memattn_unit(lds, b, rest >> 4, rest & 15, (const bf16_t*)(ws + WS_QM), (const bf16_t*)(ws + WS_KVM), args.in[I_MQG] + l * 128, (bf16_t*)(ws + WS_OM)); }
    } else if (p == 4) {
        pg8::Gemm g = pg8::make_gemm((const bf16_t*)(ws + WS_MIX), (const bf16_t*)(wl + W_OUT), 1024); pg8::StaticOrder S; S.init(NTOK, 1024, G, bx);
        pg8::EpiResid E{nullptr, XB, ssqp + (size_t)(PROBE ? 1 : l * 3 + 1) * NTOK * 16};
        pg8::gemm_phase<pg8::EpiResid, pg8::StaticOrder, true>(lds, g, S, E);
    } else if (p == 5) {
        pg8::Gemm g = pg8::make_gemm(XB, (const bf16_t*)(wl + W_MQ), 1024); pg8::StaticOrder S; S.init(NTOK, 512, G, bx);
        pg8::EpiBf16G<0> E{(bf16_t*)(ws + WS_QM), 512, nullptr, ssqp + (size_t)(l * 3 + 1) * NTOK * 16, 1.f / 1024.f, 16};
        pg8::gemm_phase<pg8::EpiBf16G<0>, pg8::StaticOrder, true>(lds, g, S, E);
    } else if (p == 7) {
        pg8::Gemm g = pg8::make_gemm((const bf16_t*)(ws + WS_OM), (const bf16_t*)(wl + W_MO), 512); pg8::StaticOrder S; S.init(NTOK, 1024, G, bx);
        pg8::EpiResid E{nullptr, XB, ssqp + (size_t)(PROBE ? 1 : l * 3 + 2) * NTOK * 16};
        pg8::gemm_phase<pg8::EpiResid, pg8::StaticOrder, true>(lds, g, S, E);
    } else if (p == 8) {
        pg8::Gemm g = pg8::make_gemm(XB, (const bf16_t*)(wl + W_FF1), 1024); pg8::StaticOrder S; S.init(NTOK, FF, G, bx);
        pg8::EpiBf16G<2> E{(bf16_t*)(ws + WS_HB), FF, nullptr, ssqp + (size_t)(l * 3 + 2) * NTOK * 16, 1.f / 1024.f, 16};
        pg8::gemm_phase<pg8::EpiBf16G<2>, pg8::StaticOrder, true>(lds, g, S, E);
    } else if (p == 9) {
        pg8::Gemm g = pg8::make_gemm((const bf16_t*)(ws + WS_HB), (const bf16_t*)(wl + W_FF2), FF); pg8::StaticOrder S; S.init(NTOK, 1024, G, bx);
        pg8::EpiResid E{(l == 0 || PROBE) ? (float*)nullptr : xout, XB, ssqp + (size_t)(PROBE ? 1 : 3) * NTOK * 16};
        pg8::gemm_phase<pg8::EpiResid, pg8::StaticOrder, true>(lds, g, S, E);
    }
}

constexpr int LDS_BYTES = 147456;
__global__ void __launch_bounds__(512, 2) mega(Args args) {
    extern __shared__ __attribute__((aligned(16))) unsigned char lds_raw[];
    LAS unsigned char* lds = (LAS unsigned char*)lds_raw;
    const int G = gridDim.x, bx = blockIdx.x, NGW = G * 8;
    volatile LAS unsigned* bar_st = (volatile LAS unsigned*)(lds + LDS_ST_OFF);
    if (threadIdx.x < 2) bar_st[threadIdx.x] = 0u;
    __syncthreads();
    XcdBarrier xbar = xcd_barrier_post((unsigned*)(args.ws + WS_CTL + CTL_BAR_BYTE), bar_st);
    if (args.ph_hi < 0) cooperative_groups::this_grid().sync();
    if (args.ph_lo == 0) { const int tid0 = threadIdx.x, wave0 = __builtin_amdgcn_readfirstlane(tid0 >> 6); for (int e_ = 0; e_ < 1 + MK_PROBE_PRO; ++e_) prologue<true>(args, lds, bx * 8 + wave0, NGW, wave0, tid0 & 63); }
    for (int ph = args.ph_lo > 1 ? args.ph_lo : 1; ph < args.ph_hi; ++ph) {
        if ((ph - 1) % 10 == 2) continue;
        if (ph > args.ph_lo) {
            xcd_barrier(xbar); }
        do_phase<false>((ph - 1) % 10, (ph - 1) / 10, args, lds, G, bx, NGW);
    }
#if MK_PROBE_N > 0
    if (args.ph_hi == 21) {
        xcd_barrier(xbar); do_phase<true>(0, 1, args, lds, G, bx, NGW);
        xcd_barrier(xbar); do_phase<true>(1, 1, args, lds, G, bx, NGW);
        for (int e_ = 0; e_ < MK_PROBE_N; ++e_) { xcd_barrier(xbar);
#if MK_PROBE_KIND == 100
            { int tidp = threadIdx.x; asm volatile("" : "+v"(tidp)); prologue<false>(args, lds, bx * 8 + __builtin_amdgcn_readfirstlane(tidp >> 6), NGW, __builtin_amdgcn_readfirstlane(tidp >> 6), tidp & 63); }
#elif MK_PROBE_KIND == 33
            for (int i = bx; i < 256; i += G) { const int b = (i & 7) >> 1, idx = (i >> 3) * 2 + (i & 1); unsigned char* ws = args.ws;
                attn_unit<MK_PROBE_PARTS>(lds, b, 127 - idx, (const bf16_t*)(ws + WS_Q), (const bf16_t*)(ws + WS_KV), (const bf16_t*)(ws + WS_KC), (const bf16_t*)(ws + WS_VC), (const float*)(ws + WS_GL), (bf16_t*)(ws + WS_MIX));
                attn_unit<MK_PROBE_PARTS>(lds, b, idx, (const bf16_t*)(ws + WS_Q), (const bf16_t*)(ws + WS_KV), (const bf16_t*)(ws + WS_KC), (const bf16_t*)(ws + WS_VC), (const float*)(ws + WS_GL), (bf16_t*)(ws + WS_MIX)); }
#elif MK_PROBE_KIND != 99
            do_phase<true>(MK_PROBE_KIND, 1, args, lds, G, bx, NGW);
#endif
        }
    }
#endif
}

}

#ifndef MK_FUSED
#define MK_FUSED 1
#endif
extern "C" void kernel_launch(void* const* d_in, const int* in_sizes, int n_in, void* d_out, int out_size, void* d_ws, size_t ws_size, hipStream_t stream) {
    using namespace mk;
    static int grid = 0;
    if (!grid) { (void)hipFuncSetAttribute((const void*)mega, hipFuncAttributeMaxDynamicSharedMemorySize, LDS_BYTES);
        int dev = 0, cus = 0, per_cu = 0; (void)hipGetDevice(&dev); (void)hipDeviceGetAttribute(&cus, hipDeviceAttributeMultiprocessorCount, dev);
        (void)hipOccupancyMaxActiveBlocksPerMultiprocessor(&per_cu, (const void*)mega, 512, LDS_BYTES);
        grid = cus * (per_cu < 1 ? 1 : per_cu); if (grid > 256) grid = 256; }
    Args a{}; for (int i = 0; i < 27; ++i) a.in[i] = (const float*)d_in[i]; a.out = (float*)d_out; a.ws = (unsigned char*)d_ws;
#if MK_FUSED
    (void)hipMemsetAsync((unsigned char*)d_ws + WS_CTL + CTL_BAR_BYTE, 0, XCD_BAR_WORDS * 4, stream);
    a.ph_lo = 0; a.ph_hi = 21; void* kargs[] = {&a};
    (void)hipLaunchCooperativeKernel((const void*)mega, dim3(grid), dim3(512), kargs, LDS_BYTES, stream);
#else
    for (int ph = 0; ph < 21; ++ph) { a.ph_lo = ph; a.ph_hi = ph + 1; hipLaunchKernelGGL(mega, dim3(grid), dim3(512), LDS_BYTES, stream, a); }
#endif
}
```

```cpp
#include <hip/hip_runtime.h>
#include <hip/hip_cooperative_groups.h>
#include <stdint.h>
#include <math.h>

namespace pg8 {
#define PG8_LAS __attribute__((address_space(3)))
typedef unsigned short bf16_t;
typedef short bf16x8 __attribute__((ext_vector_type(8)));
typedef float f32x4 __attribute__((ext_vector_type(4)));
typedef float f32x2 __attribute__((ext_vector_type(2)));
typedef unsigned u32x4 __attribute__((ext_vector_type(4)));
typedef unsigned u32x2 __attribute__((ext_vector_type(2)));
constexpr int BM = 256, BK = 64, HALF = 128, HTB = HALF * BK * 2, STAGE_BYTES = 8 * HTB, NXCD = 8, WGM = 8;

__host__ __device__ __forceinline__ int lds_byte(int r, int c) { const int st = (r >> 4) * 2 + (c >> 5), rr = r & 15, cc = c & 31, ob = rr * 64 + cc * 2; return st * 1024 + (ob ^ (((ob >> 9) & 1) << 5)); }
__host__ __device__ __forceinline__ void stage_rc(int b, int& R, int& C) { const int st = b / 1024, sb = b % 1024, swz = sb ^ (((sb >> 9) & 1) << 5); R = (st >> 1) * 16 + swz / 64; C = (st & 1) * 32 + (swz % 64) / 2; }
__host__ __device__ __forceinline__ int perm32(int rho) { const int n = rho >> 4, i = rho & 15; return 8 * (i >> 2) + 4 * n + (i & 3); }

struct Unit { int pm, pn; };
struct Gemm { const bf16_t* A; const bf16_t* Bt; int K; int lda; int kstepA; size_t a_s0, a_s1; };
__device__ __forceinline__ Gemm make_gemm(const bf16_t* A, const bf16_t* Bt, int K) { Gemm g; g.A = A; g.Bt = Bt; g.K = K; g.lda = K; g.kstepA = BK * 2; g.a_s0 = (size_t)BM * K * 2; g.a_s1 = 2 * g.a_s0; return g; }

struct StaticOrder {
    int nM, nN, nwg, G, c;
    __device__ void init(int M, int N, int G_, int c_) { nM = M / BM; nN = N / BM; nwg = nM * nN; G = G_; c = c_; }
    __device__ bool next(int i, Unit& u) const {
        const long L = (long)i * G + c; if (L >= nwg) return false;
        int wgid = (int)L; { const int q = nwg / NXCD, r = nwg % NXCD, xcd = wgid % NXCD, off = wgid / NXCD; wgid = (xcd < r ? xcd * (q + 1) : r * (q + 1) + (xcd - r) * q) + off; }
        const int nig = WGM * nN, gid = wgid / nig, fm = gid * WGM, gsz = (nM - fm) < WGM ? (nM - fm) : WGM;
        u.pm = fm + ((wgid % nig) % gsz); u.pn = (wgid % nig) / gsz; return true;
    }
};
struct OneUnit { int has; Unit u; __device__ bool next(int i, Unit& o) const { if (i > 0 || !has) return false; o = u; return true; } };

__device__ __forceinline__ unsigned cvt_pk_bf16(float lo, float hi) { unsigned r; asm volatile("v_cvt_pk_bf16_f32 %0, %1, %2" : "=v"(r) : "v"(lo), "v"(hi)); return r; }
__device__ __forceinline__ float gelu_tanh(float x) { const float u = 0.7978845608028654f * (x + 0.044715f * x * x * x); const float e = __builtin_amdgcn_exp2f(-2.885390081777927f * u); return x * __builtin_amdgcn_rcpf(1.f + e); }

__device__ __forceinline__ float ssq16(const float* p) { const f32x4 a = ((const f32x4*)p)[0], b = ((const f32x4*)p)[1], c = ((const f32x4*)p)[2], d = ((const f32x4*)p)[3];
    return (((a[0] + a[1]) + (a[2] + a[3])) + ((b[0] + b[1]) + (b[2] + b[3]))) + (((c[0] + c[1]) + (c[2] + c[3])) + ((d[0] + d[1]) + (d[2] + d[3]))); }
template <int ACT  > struct EpiBf16G {
    static constexpr bool PERM = true, AFTER_DRAIN = false;
    bf16_t* O; int ldc; const float* bias; const float* ssq; float inv_n; int nparts;
    __device__ __forceinline__ void operator()(const f32x4 (&acc)[2][2][4][2], const Unit& u, int wr, int wc, int fr, int fq) const {
        const int row0 = u.pm * BM + wr * 64 + fr, col0 = u.pn * BM + wc * 32 + 8 * fq;
        f32x4 bv[2][2];
#pragma unroll
        for (int bj = 0; bj < 2; ++bj)
#pragma unroll
            for (int n = 0; n < 2; ++n) bv[bj][n] = bias ? *(const f32x4*)(bias + col0 + bj * HALF + 4 * n) : (f32x4){0.f, 0.f, 0.f, 0.f};
        float rsv[2] = {1.f, 1.f};
        if (ssq) {
#pragma unroll
            for (int ai = 0; ai < 2; ++ai) { const int rr = row0 + ai * HALF + fq * 16; rsv[ai] = rsqrtf((nparts == 16 ? ssq16(ssq + (size_t)rr * 16) : ssq[rr]) * inv_n + 1e-6f); } }
#pragma unroll
        for (int ai = 0; ai < 2; ++ai)
#pragma unroll
            for (int m = 0; m < 4; ++m) { const int row = row0 + ai * HALF + m * 16; const float rs = __shfl(rsv[ai], fr + 16 * m); bf16_t* rowp = O + (size_t)row * ldc + col0;
#pragma unroll
                for (int bj = 0; bj < 2; ++bj) { f32x4 v0 = (acc[ai][bj][m][0] + bv[bj][0]) * rs, v1 = (acc[ai][bj][m][1] + bv[bj][1]) * rs;
                    if (ACT == 1) {
#pragma unroll
                        for (int e = 0; e < 4; ++e) { v0[e] = gelu_tanh(v0[e]); v1[e] = gelu_tanh(v1[e]); } }
                    if (ACT == 2) {
#pragma unroll
                        for (int e = 0; e < 4; ++e) { float a = fmaxf(v0[e], 0.f), b = fmaxf(v1[e], 0.f); v0[e] = a * a; v1[e] = b * b; } }
                    u32x4 w; w.x = cvt_pk_bf16(v0[0], v0[1]); w.y = cvt_pk_bf16(v0[2], v0[3]); w.z = cvt_pk_bf16(v1[0], v1[1]); w.w = cvt_pk_bf16(v1[2], v1[3]);
                    *(u32x4*)(rowp + bj * HALF) = w; } }
    }
};
struct EpiInProj {
    static constexpr bool PERM = true, AFTER_DRAIN = false;
    bf16_t *U, *V, *Q, *KV; float* GL; const float* ssq;
    __device__ __forceinline__ void operator()(const f32x4 (&acc)[2][2][4][2], const Unit& u, int wr, int wc, int fr, int fq) const {
        const int row0 = u.pm * BM + wr * 64 + fr, cit0 = wc * 32 + 8 * fq; const int pn = u.pn;
        bf16_t* base; int ldc, cofs; bool act = false;
        if (pn < 2) { base = U; ldc = 512; cofs = pn * 256; act = true; } else if (pn < 4) { base = V; ldc = 512; cofs = (pn - 2) * 256; act = true; }
        else if (pn < 6) { base = Q; ldc = 512; cofs = (pn - 4) * 256; } else { base = KV; ldc = 768; cofs = (pn - 6) * 256; }
        float rsv[2];
#pragma unroll
        for (int ai = 0; ai < 2; ++ai) rsv[ai] = rsqrtf(ssq16(ssq + (size_t)(row0 + ai * HALF + fq * 16) * 16) * (1.f / 1024.f) + 1e-6f);
#pragma unroll
        for (int ai = 0; ai < 2; ++ai)
#pragma unroll
            for (int m = 0; m < 4; ++m) { const int row = row0 + ai * HALF + m * 16; const float rs = __shfl(rsv[ai], fr + 16 * m);
#pragma unroll
                for (int bj = 0; bj < 2; ++bj) { f32x4 v0 = acc[ai][bj][m][0] * rs, v1 = acc[ai][bj][m][1] * rs; const int cit = cit0 + bj * HALF;
                    if (pn == 9) { if (cit < 24) { *(f32x4*)(GL + (size_t)row * 24 + cit) = v0; *(f32x4*)(GL + (size_t)row * 24 + cit + 4) = v1; } }
                    else { if (act) {
#pragma unroll
                            for (int e = 0; e < 4; ++e) { v0[e] = gelu_tanh(v0[e]); v1[e] = gelu_tanh(v1[e]); } }
                        u32x4 w; w.x = cvt_pk_bf16(v0[0], v0[1]); w.y = cvt_pk_bf16(v0[2], v0[3]); w.z = cvt_pk_bf16(v1[0], v1[1]); w.w = cvt_pk_bf16(v1[2], v1[3]);
                        *(u32x4*)(base + (size_t)row * ldc + cofs + cit) = w; } } }
    }
};
struct EpiResid {
    static constexpr bool PERM = false, AFTER_DRAIN = false;
    float* XF; bf16_t* XB; float* ssq;
    __device__ __forceinline__ void operator()(const f32x4 (&acc)[2][2][4][2], const Unit& u, int wr, int wc, int fr, int fq) const {
        const int col0 = u.pn * BM + wc * 32 + 4 * fq;
#pragma unroll
        for (int ai = 0; ai < 2; ++ai)
#pragma unroll
            for (int m = 0; m < 4; ++m) { const int row = u.pm * BM + ai * HALF + wr * 64 + m * 16 + fr; float sq = 0.f;
#pragma unroll
                for (int bj = 0; bj < 2; ++bj)
#pragma unroll
                    for (int n = 0; n < 2; ++n) { const size_t off = (size_t)row * 1024 + col0 + bj * HALF + n * 16; const u32x2 xw = *(const u32x2*)(XB + off);
                        f32x4 xv; xv[0] = __uint_as_float(xw.x << 16); xv[1] = __uint_as_float(xw.x & 0xffff0000u); xv[2] = __uint_as_float(xw.y << 16); xv[3] = __uint_as_float(xw.y & 0xffff0000u);
                        xv = xv + acc[ai][bj][m][n];
                        if (XF) *(f32x4*)(XF + off) = xv;
                        else { sq += (xv[0] * xv[0] + xv[1] * xv[1]) + (xv[2] * xv[2] + xv[3] * xv[3]); u32x2 w; w.x = cvt_pk_bf16(xv[0], xv[1]); w.y = cvt_pk_bf16(xv[2], xv[3]); *(u32x2*)(XB + off) = w; } }
                if (!XF) { sq += __shfl_xor(sq, 16); sq += __shfl_xor(sq, 32); if (fq == 0) ssq[(size_t)row * 16 + u.pn * 4 + wc] = sq; } }
    }
};

template <class Epi, class Sched, bool ALIGN_EPI>
__device__ __forceinline__ void gemm_phase(PG8_LAS unsigned char* lds, const Gemm g, const Sched& S, const Epi& E) {
    int tid_ = threadIdx.x; asm volatile("" : "+v"(tid_));
    const int tid = tid_, wid = __builtin_amdgcn_readfirstlane(tid >> 6), lane = tid & 63, wr = wid >> 2, wc = wid & 3, fr = lane & 15, fq = lane >> 4;
    const int K = g.K, nt = K / BK;
    unsigned voffA[2], voffB[2];
#pragma unroll
    for (int i = 0; i < 2; ++i) { int R, C; stage_rc(tid * 16 + i * 8192, R, C); const int Rb = Epi::PERM ? ((R & ~31) + perm32(R & 31)) : R;
        voffA[i] = (unsigned)(R * g.lda + C) * 2u; voffB[i] = (unsigned)(Rb * K + C) * 2u; }
    const size_t kstepA = (size_t)g.kstepA, kstepB = (size_t)(BK * 2);
    const size_t hstepA = (size_t)HALF * g.lda * 2, hstepB = (size_t)HALF * K * 2, tstepB = 2 * hstepB;
    const unsigned ldsw = (unsigned)wid * 1024u;
    const int aoff = lds_byte(wr * 64 + fr, fq * 8), boff = lds_byte(wc * 32 + fr, fq * 8);
#define PG8_ABASE(pm) ((const char*)g.A + (size_t)((pm) >> 1) * g.a_s1 + (size_t)((pm) & 1) * g.a_s0)
#define PG8_SA(b, h) (((b) * 2 + (h)) * HTB)
#define PG8_SB(b, h) ((4 + (b) * 2 + (h)) * HTB)
#define PG8_STAGE(bufoff, gbase, voff) do { _Pragma("unroll") for (int _i = 0; _i < 2; ++_i) \
        __builtin_amdgcn_global_load_lds((const unsigned*)((const char*)(gbase) + (voff)[_i]), (PG8_LAS unsigned*)(lds + (bufoff) + ldsw + _i * 8192), 16, 0, 0); } while (0)
#define PG8_LDA(dst, b, h) do { _Pragma("unroll") for (int m = 0; m < 4; ++m) _Pragma("unroll") for (int k = 0; k < 2; ++k) dst[m][k] = *(const PG8_LAS bf16x8*)(lds + PG8_SA(b, h) + aoff + m * 2048 + k * 1024); } while (0)
#define PG8_LDB(dst, b, h) do { _Pragma("unroll") for (int n = 0; n < 2; ++n) _Pragma("unroll") for (int k = 0; k < 2; ++k) dst[n][k] = *(const PG8_LAS bf16x8*)(lds + PG8_SB(b, h) + boff + n * 2048 + k * 1024); } while (0)
#define PG8_MMA(ai, bj, At, Bt) do { __builtin_amdgcn_s_setprio(1); _Pragma("unroll") for (int m = 0; m < 4; ++m) _Pragma("unroll") for (int n = 0; n < 2; ++n) _Pragma("unroll") for (int k = 0; k < 2; ++k) \
        acc[ai][bj][m][n] = __builtin_amdgcn_mfma_f32_16x16x32_bf16(Bt[n][k], At[m][k], acc[ai][bj][m][n], 0, 0, 0); __builtin_amdgcn_s_setprio(0); } while (0)
#define PG8_WAIT_V(n) asm volatile("s_waitcnt vmcnt(" #n ")" ::: "memory")
#define PG8_WAIT_L(n) asm volatile("s_waitcnt lgkmcnt(" #n ")" ::: "memory")
#define PG8_BAR __builtin_amdgcn_s_barrier()
#define PG8_SCHED __builtin_amdgcn_sched_barrier(0)
    Unit cur, nxt; int ui = 0;
    if (!S.next(0, cur)) return;
    f32x4 acc[2][2][4][2];
#pragma unroll
    for (int a = 0; a < 2; ++a)
#pragma unroll
        for (int b = 0; b < 2; ++b)
#pragma unroll
            for (int m = 0; m < 4; ++m)
#pragma unroll
                for (int n = 0; n < 2; ++n) acc[a][b][m][n] = (f32x4){0.f, 0.f, 0.f, 0.f};
    bf16x8 At[4][2], B0[2][2], B1[2][2];
    const char* cA = PG8_ABASE(cur.pm); const char* cB = (const char*)g.Bt + (size_t)cur.pn * tstepB;
    PG8_STAGE(PG8_SB(0, 0), cB, voffB); PG8_STAGE(PG8_SB(0, 1), cB + hstepB, voffB); PG8_STAGE(PG8_SA(0, 0), cA, voffA); PG8_STAGE(PG8_SA(0, 1), cA + hstepA, voffA);
    if (wr == 1) PG8_BAR;
    PG8_WAIT_V(2); PG8_BAR;
    PG8_STAGE(PG8_SB(1, 0), cB + kstepB, voffB); PG8_STAGE(PG8_SA(1, 0), cA + kstepA, voffA); PG8_STAGE(PG8_SB(1, 1), cB + hstepB + kstepB, voffB);
    PG8_WAIT_V(6); PG8_BAR;
    for (;;) {
        const bool has_next = S.next(ui + 1, nxt);
        const char* nA = has_next ? PG8_ABASE(nxt.pm) : cA; const char* nB = has_next ? (const char*)g.Bt + (size_t)nxt.pn * tstepB : cB;
        for (int t = 0; t < nt; t += 2) {
            const bool last = (t == nt - 2);
            const char* a1 = cA + (size_t)(t + 1) * kstepA;
            const char* a2 = last ? nA : cA + (size_t)(t + 2) * kstepA; const char* b2 = last ? nB : cB + (size_t)(t + 2) * kstepB;
            const char* a3 = a2 + kstepA; const char* b3 = b2 + kstepB;
            PG8_LDB(B0, 0, 0); PG8_LDB(B1, 0, 1); PG8_SCHED; PG8_LDA(At, 0, 0); PG8_STAGE(PG8_SA(1, 1), a1 + hstepA, voffA);
            PG8_WAIT_V(8); PG8_WAIT_L(0); PG8_BAR; PG8_MMA(0, 0, At, B0); PG8_MMA(0, 1, At, B1); PG8_BAR; PG8_SCHED;
            PG8_LDA(At, 0, 1); PG8_STAGE(PG8_SB(0, 0), b2, voffB); PG8_STAGE(PG8_SB(0, 1), b2 + hstepB, voffB); PG8_STAGE(PG8_SA(0, 0), a2, voffA);
            PG8_WAIT_V(8); PG8_WAIT_L(0); PG8_BAR; PG8_MMA(1, 0, At, B0); PG8_MMA(1, 1, At, B1); PG8_BAR; PG8_SCHED;
            PG8_LDB(B0, 1, 0); PG8_LDB(B1, 1, 1); PG8_SCHED; PG8_LDA(At, 1, 0); PG8_STAGE(PG8_SA(0, 1), a2 + hstepA, voffA);
            PG8_WAIT_V(8); PG8_WAIT_L(0); PG8_BAR; PG8_MMA(0, 0, At, B0); PG8_MMA(0, 1, At, B1); PG8_BAR; PG8_SCHED;
            PG8_LDA(At, 1, 1); PG8_STAGE(PG8_SB(1, 0), b3, voffB); PG8_STAGE(PG8_SB(1, 1), b3 + hstepB, voffB); PG8_STAGE(PG8_SA(1, 0), a3, voffA);
            PG8_WAIT_V(8); PG8_WAIT_L(0); PG8_BAR; PG8_MMA(1, 0, At, B0); PG8_MMA(1, 1, At, B1); PG8_BAR; PG8_SCHED;
        }
        if constexpr (ALIGN_EPI) { if (wr == 0) PG8_BAR; }
        if constexpr (!Epi::AFTER_DRAIN) { E(acc, cur, wr, wc, fr, fq); }
        if (!has_next) break;
#pragma unroll
        for (int a = 0; a < 2; ++a)
#pragma unroll
            for (int b = 0; b < 2; ++b)
#pragma unroll
                for (int m = 0; m < 4; ++m)
#pragma unroll
                    for (int n = 0; n < 2; ++n) acc[a][b][m][n] = (f32x4){0.f, 0.f, 0.f, 0.f};
        cur = nxt; cA = nA; cB = nB; ++ui;
        if constexpr (ALIGN_EPI) { if (wr == 1) PG8_BAR; }
    }
    PG8_WAIT_V(0);
    if constexpr (!ALIGN_EPI) { if (wr == 0) PG8_BAR; }
    PG8_BAR;
    if constexpr (Epi::AFTER_DRAIN) { E.fused(acc, cur, wr, wc, fr, fq, lds, wid, lane); }
#undef PG8_ABASE
#undef PG8_SA
#undef PG8_SB
#undef PG8_STAGE
#undef PG8_LDA
#undef PG8_LDB
#undef PG8_MMA
#undef PG8_WAIT_V
#undef PG8_WAIT_L
#undef PG8_BAR
#undef PG8_SCHED
}
}

#ifndef MK_PROBE_N
#define MK_PROBE_N 0
#endif
#ifndef MK_PROBE_PRO
#define MK_PROBE_PRO 0
#endif
#ifndef MK_PROBE_KIND
#define MK_PROBE_KIND 3
#endif
#ifndef MK_PROBE_PARTS
#define MK_PROBE_PARTS 15
#endif

namespace mk {
using pg8::bf16_t; using pg8::f32x4; using pg8::u32x4; using pg8::u32x2; using pg8::cvt_pk_bf16;
#define LAS __attribute__((address_space(3)))
constexpr int NB = 4, T = 4096, D = 1024, NTOK = NB * T, INC = 2328, INP = 2560, FF = 4096;
constexpr size_t MiB = 1u << 20;
constexpr size_t WS_CTL = 0;
constexpr size_t WS_W = 1 * MiB, W_LAYER = 30 * MiB;
constexpr size_t W_IN = 0, W_OUT = 5 * MiB, W_MQ = 7 * MiB, W_MKV = 8 * MiB, W_MO = 10 * MiB, W_FF1 = 11 * MiB, W_FF2 = 19 * MiB, W_C1 = 27 * MiB, W_C2 = 29 * MiB, W_SG = 29 * MiB + 128 * 1024, W_B1P = 29 * MiB + 512 * 1024;
constexpr size_t WS_XB = 61 * MiB;
constexpr size_t WS_OV = 93 * MiB;
constexpr size_t WS_U = WS_OV, WS_V = WS_OV + 16 * MiB, WS_Q = WS_OV + 32 * MiB, WS_KV = WS_OV + 48 * MiB, WS_MIX = WS_OV + 72 * MiB, WS_QM = WS_OV + 104 * MiB, WS_OM = WS_OV + 120 * MiB;
constexpr size_t WS_HB = WS_OV;
constexpr size_t WS_SM = 229 * MiB;
constexpr size_t WS_GL = WS_SM, WS_KC = WS_SM + 2 * MiB, WS_VC = WS_KC + 256 * 1024, WS_HID = WS_SM + 3 * MiB, WS_MASK = WS_SM + 5 * MiB, WS_MEMB = WS_SM + 6 * MiB, WS_KVM = WS_SM + 8 * MiB, WS_END = WS_SM + 10 * MiB;
constexpr size_t WS_SSQP = 240 * MiB;
static_assert(WS_END <= WS_SSQP && WS_SSQP + 6 * MiB <= 256 * MiB, "ws map");
constexpr int SSQ_MEM_OFF = 6 * NTOK;

struct Args { const float* in[27]; float* out; unsigned char* ws; int ph_lo, ph_hi; };
enum { I_X = 0, I_MEM, I_NMG, I_WIN, I_SGLNG, I_SGLNB, I_SGW, I_SGB, I_QNG, I_KNG, I_CPOS, I_CW1, I_CB1, I_CW2, I_CB2, I_MOG, I_WOUT, I_NMEMG, I_MKVG, I_WMQ, I_WMKV, I_MQG, I_MKG, I_WMO, I_NFG, I_WFF1, I_WFF2 };

__device__ __forceinline__ float bf2f(unsigned short b) { return __uint_as_float((unsigned)b << 16); }
__device__ __forceinline__ float wave_sum(float v) {
#pragma unroll
    for (int o = 1; o < 64; o <<= 1) v += __shfl_xor(v, o);
    return v; }

__device__ __forceinline__ void transpose_item(const float* W, int K, int N, int Npad, const float* gain, bf16_t* WT, LAS float* scr, int item, int lane) {
    const int nblk = Npad / 32, kb = item / nblk, nb = item % nblk, k0 = 64 * kb, n0 = 32 * nb;
    const int nn = n0 + (lane & 31); const int nnc = nn < N ? nn : N - 1; const float keep = nn < N ? 1.f : 0.f;
    const float* src = W + (size_t)(k0 + (lane >> 5)) * N + nnc;
    float v[32];
#pragma unroll
    for (int i = 0; i < 32; ++i) v[i] = src[(size_t)(2 * i) * N];
#pragma unroll
    for (int i = 0; i < 32; ++i) scr[(2 * i + (lane >> 5)) * 33 + (lane & 31)] = v[i] * keep;
    asm volatile("s_waitcnt lgkmcnt(0)" ::: "memory");
    const int c = lane & 7;
    f32x4 g0 = {1.f, 1.f, 1.f, 1.f}, g1 = {1.f, 1.f, 1.f, 1.f};
    if (gain) { g0 = *(const f32x4*)(gain + k0 + 8 * c); g1 = *(const f32x4*)(gain + k0 + 8 * c + 4); }
#pragma unroll
    for (int j = 0; j < 4; ++j) { const int n = (lane >> 3) + 8 * j; const LAS float* sp = scr + (8 * c) * 33 + n;
        u32x4 o; o.x = cvt_pk_bf16(sp[0 * 33] * g0[0], sp[1 * 33] * g0[1]); o.y = cvt_pk_bf16(sp[2 * 33] * g0[2], sp[3 * 33] * g0[3]); o.z = cvt_pk_bf16(sp[4 * 33] * g1[0], sp[5 * 33] * g1[1]); o.w = cvt_pk_bf16(sp[6 * 33] * g1[2], sp[7 * 33] * g1[3]);
        *(u32x4*)(WT + (size_t)(n0 + n) * K + k0 + 8 * c) = o; }
    asm volatile("s_waitcnt lgkmcnt(0)" ::: "memory");
}

constexpr int CV_IN = 16 * 80, CV_OUT = 16 * 32, CV_MQ = 16 * 16, CV_MKV = 16 * 32, CV_MO = 8 * 32, CV_FF1 = 16 * 128, CV_FF2 = 64 * 32, CV_C1 = 32 * 8, CV_C2 = 4 * 2;
constexpr int CV_TR = CV_IN + CV_OUT + CV_MQ + CV_MKV + CV_MO + CV_FF1 + CV_FF2 + 2 * CV_C1 + 2 * CV_C2, CV_B1 = 64, CV_SG = 1024, CONV_ITEMS = CV_TR + CV_B1 + CV_SG;
__device__ __forceinline__ void convert_layer(const Args& a, int l, int it_lo, int it_hi, int gwl, int ngwl, LAS float* scr, int lane_) {
    unsigned char* ws = a.ws; unsigned char* wl = ws + WS_W + l * W_LAYER;
#pragma unroll 1
    for (int it = it_lo + gwl; it < it_hi; it += ngwl) {
        int r = it; int lane = lane_; asm volatile("" : "+v"(lane));
        if (r < CV_IN) { transpose_item(a.in[I_WIN] + (size_t)l * 1024 * INC, 1024, INC, INP, a.in[I_NMG] + l * 1024, (bf16_t*)(wl + W_IN), scr, r, lane); continue; } r -= CV_IN;
        if (r < CV_OUT) { transpose_item(a.in[I_WOUT] + (size_t)l * 1024 * 1024, 1024, 1024, 1024, a.in[I_MOG] + l * 1024, (bf16_t*)(wl + W_OUT), scr, r, lane); continue; } r -= CV_OUT;
        if (r < CV_MQ) { transpose_item(a.in[I_WMQ] + (size_t)l * 1024 * 512, 1024, 512, 512, a.in[I_NMEMG] + l * 1024, (bf16_t*)(wl + W_MQ), scr, r, lane); continue; } r -= CV_MQ;
        if (r < CV_MKV) { transpose_item(a.in[I_WMKV] + (size_t)l * 1024 * 1024, 1024, 1024, 1024, a.in[I_MKVG] + l * 1024, (bf16_t*)(wl + W_MKV), scr, r, lane); continue; } r -= CV_MKV;
        if (r < CV_MO) { transpose_item(a.in[I_WMO] + (size_t)l * 512 * 1024, 512, 1024, 1024, (const float*)nullptr, (bf16_t*)(wl + W_MO), scr, r, lane); continue; } r -= CV_MO;
        if (r < CV_FF1) { transpose_item(a.in[I_WFF1] + (size_t)l * 1024 * 4096, 1024, 4096, 4096, a.in[I_NFG] + l * 1024, (bf16_t*)(wl + W_FF1), scr, r, lane); continue; } r -= CV_FF1;
        if (r < CV_FF2) { transpose_item(a.in[I_WFF2] + (size_t)l * 4096 * 1024, 4096, 1024, 1024, (const float*)nullptr, (bf16_t*)(wl + W_FF2), scr, r, lane); continue; } r -= CV_FF2;
        if (r < 2 * CV_C1) { const int kv = r / CV_C1; transpose_item(a.in[I_CW1] + (size_t)(l * 2 + kv) * 2048 * 256, 2048, 256, 256, (const float*)nullptr, (bf16_t*)(wl + W_C1 + (size_t)kv * 256 * 2048 * 2), scr, r % CV_C1, lane); continue; } r -= 2 * CV_C1;
        if (r < 2 * CV_C2) { const int kv = r / CV_C2; transpose_item(a.in[I_CW2] + (size_t)(l * 2 + kv) * 256 * 64, 256, 64, 64, (const float*)nullptr, (bf16_t*)(wl + W_C2 + (size_t)kv * 64 * 256 * 2), scr, r % CV_C2, lane); continue; } r -= 2 * CV_C2;
        if (r < CV_B1) {
            const int lk = l * 2 + (r >> 5), j0 = (r & 31) * 8; const float* W1 = a.in[I_CW1] + (size_t)lk * 2048 * 256 + j0; const float* pos = a.in[I_CPOS] + (size_t)lk * 2048;
            float acc[8];
#pragma unroll
            for (int e = 0; e < 8; ++e) acc[e] = 0.f;
#pragma unroll 8
            for (int i = 0; i < 32; ++i) { const int k = i * 64 + lane; const float p = pos[k]; const f32x4 w0 = *(const f32x4*)(W1 + (size_t)k * 256), w1 = *(const f32x4*)(W1 + (size_t)k * 256 + 4);
#pragma unroll
                for (int e = 0; e < 4; ++e) { acc[e] += p * w0[e]; acc[4 + e] += p * w1[e]; } }
#pragma unroll
            for (int e = 0; e < 8; ++e) acc[e] = wave_sum(acc[e]);
            if (lane == 0) { float* dst = (float*)(wl + W_B1P) + (lk & 1) * 256 + j0;
#pragma unroll
                for (int e = 0; e < 8; ++e) dst[e] = acc[e] + a.in[I_CB1][lk * 256 + j0 + e]; }
            continue; } r -= CV_B1;
        {
            const int t = r & 127; const float* wr = a.in[I_SGW] + ((size_t)l * 1024 + r) * 128; unsigned* dst = (unsigned*)(wl + W_SG) + (size_t)r * 64 + lane; float v[2];
#pragma unroll
            for (int e = 0; e < 2; ++e) { const int p = lane * 2 + e, ks = p >> 4, hh = (p >> 3) & 1, j = p & 7, sidx = 16 * ks + 8 * (j >> 2) + 4 * hh + (j & 3); v[e] = wr[sidx <= t ? sidx : t]; v[e] = sidx <= t ? v[e] : 0.f; }
            *dst = cvt_pk_bf16(v[0], v[1]); }
    }
}
constexpr int CONV_SPLIT = CONV_ITEMS / 2;
__device__ __forceinline__ void prologue(const Args& a, LAS unsigned char* lds, int gw, int NGW, int wave, int lane) {
    LAS float* scr = (LAS float*)(lds + wave * 16384);
    unsigned char* ws = a.ws; float* ctl = (float*)(ws + WS_CTL);
    convert_layer(a, 0, 0, CONV_ITEMS, gw, NGW, scr, lane);
    { const float* x = a.in[I_X]; bf16_t* XB = (bf16_t*)(ws + WS_XB);
      for (int r = gw; r < NTOK; r += NGW) { const f32x4* xr = (const f32x4*)(x + (size_t)r * 1024) + lane; unsigned long long* xb = (unsigned long long*)(XB + (size_t)r * 1024) + lane; float s = 0.f;
#pragma unroll
          for (int j = 0; j < 4; ++j) { const f32x4 v = xr[64 * j]; s += (v[0] * v[0] + v[1] * v[1]) + (v[2] * v[2] + v[3] * v[3]); xb[64 * j] = (unsigned long long)cvt_pk_bf16(v[0], v[1]) | ((unsigned long long)cvt_pk_bf16(v[2], v[3]) << 32); }
          s = wave_sum(s); if (lane < 16) ((float*)(ws + WS_SSQP))[(size_t)r * 16 + lane] = lane == 0 ? s : 0.f; } }
    { const float* mem = a.in[I_MEM]; bf16_t* MB = (bf16_t*)(ws + WS_MEMB);
      for (int r = gw; r < 1024; r += NGW) { const f32x4* xr = (const f32x4*)(mem + (size_t)r * 1024) + lane; unsigned long long* xb = (unsigned long long*)(MB + (size_t)r * 1024) + lane; float s = 0.f;
#pragma unroll
          for (int j = 0; j < 4; ++j) { const f32x4 v = xr[64 * j]; s += (v[0] * v[0] + v[1] * v[1]) + (v[2] * v[2] + v[3] * v[3]); xb[64 * j] = (unsigned long long)cvt_pk_bf16(v[0], v[1]) | ((unsigned long long)cvt_pk_bf16(v[2], v[3]) << 32); }
          s = wave_sum(s); if (lane == 0) ctl[SSQ_MEM_OFF + r] = s; } }
}

typedef float f32x16 __attribute__((ext_vector_type(16)));
typedef short s16x4 __attribute__((ext_vector_type(4)));
typedef short v4i16_t __attribute__((ext_vector_type(4)));
using pg8::bf16x8;
__device__ __forceinline__ int crow(int r, int hi) { return (r & 3) + 8 * (r >> 2) + 4 * hi; }
__device__ __forceinline__ s16x4 vtr(const LAS char* p) { return __builtin_bit_cast(s16x4, __builtin_amdgcn_ds_read_tr16_b64_v4i16((LAS v4i16_t*)p)); }
#define MFMA32(a, b, c) __builtin_amdgcn_mfma_f32_32x32x16_bf16(a, b, c, 0, 0, 0)
#define VFRAG(lo, hi) (bf16x8){lo[0], lo[1], lo[2], lo[3], hi[0], hi[1], hi[2], hi[3]}
__device__ __forceinline__ void lds_fadd(LAS float* p, float v) { (void)__hip_atomic_fetch_add(p, v, __ATOMIC_RELAXED, __HIP_MEMORY_SCOPE_WORKGROUP); }
__device__ __forceinline__ unsigned short f2bf(float f) { return (unsigned short)(cvt_pk_bf16(f, 0.f) & 0xffffu); }

__device__ __forceinline__ void tokprep_token(bf16_t* Q, bf16_t* KV, const float* qg, const float* kg, int tok, int lane) {
    { u32x4* p = (u32x4*)(Q + (size_t)tok * 512) + lane; const u32x4 w = *p; float v[8];
#pragma unroll
      for (int i = 0; i < 4; ++i) { v[2 * i] = __uint_as_float(w[i] << 16); v[2 * i + 1] = __uint_as_float(w[i] & 0xffff0000u); }
      float ss = 0.f;
#pragma unroll
      for (int i = 0; i < 8; ++i) ss += v[i] * v[i];
      ss += __shfl_xor(ss, 1); ss += __shfl_xor(ss, 2); ss += __shfl_xor(ss, 4);
      const float rs = rsqrtf(ss * (1.f / 64.f) + 1e-6f) * (0.125f * 1.4426950408889634f); const float* g = qg + (lane & 7) * 8;
      u32x4 o;
#pragma unroll
      for (int i = 0; i < 4; ++i) o[i] = cvt_pk_bf16(v[2 * i] * rs * g[2 * i], v[2 * i + 1] * rs * g[2 * i + 1]);
      *p = o; }
    if (lane < 32) { const int br = 1 + (lane >> 4); u32x4* p = (u32x4*)(KV + (size_t)tok * 768 + br * 256) + (lane & 15); const u32x4 w = *p; float v[8];
#pragma unroll
      for (int i = 0; i < 4; ++i) { v[2 * i] = __uint_as_float(w[i] << 16); v[2 * i + 1] = __uint_as_float(w[i] & 0xffff0000u); }
      float ss = 0.f;
#pragma unroll
      for (int i = 0; i < 8; ++i) ss += v[i] * v[i];
      ss += __shfl_xor(ss, 1); ss += __shfl_xor(ss, 2); ss += __shfl_xor(ss, 4);
      const float rs = rsqrtf(ss * (1.f / 64.f) + 1e-6f); const float* g = kg + br * 64 + (lane & 7) * 8;
      u32x4 o;
#pragma unroll
      for (int i = 0; i < 4; ++i) o[i] = cvt_pk_bf16(v[2 * i] * rs * g[2 * i], v[2 * i + 1] * rs * g[2 * i + 1]);
      *p = o; }
}
__device__ __forceinline__ void cmp2_row(const bf16_t* HID, const bf16_t* w2t, const float* b2, const float* kg0, bf16_t* KC, bf16_t* VC, int row, int lane) {
#pragma unroll 1
    for (int kv = 0; kv < 2; ++kv) { const u32x4* h = (const u32x4*)(HID + (size_t)kv * 2048 * 256 + (size_t)row * 256); const u32x4* w = (const u32x4*)(w2t + (size_t)kv * 64 * 256 + (size_t)lane * 256); float s = b2[kv * 64 + lane];
#pragma unroll 4
        for (int k = 0; k < 32; ++k) { const u32x4 a = h[k], b = w[k];
#pragma unroll
            for (int i = 0; i < 4; ++i) s += __uint_as_float(a[i] << 16) * __uint_as_float(b[i] << 16) + __uint_as_float(a[i] & 0xffff0000u) * __uint_as_float(b[i] & 0xffff0000u); }
        if (kv == 0) { const float ss = wave_sum(s * s); s = s * rsqrtf(ss * (1.f / 64.f) + 1e-6f) * kg0[lane]; }
        if ((row & 255) == 255) s = 0.f;
        (kv ? VC : KC)[(size_t)row * 64 + lane] = f2bf(s); }
}
__device__ __forceinline__ void memk_norm_item(bf16_t* KVM, const float* kg, int r, int lane) {
    unsigned* p = (unsigned*)(KVM + (size_t)(r >> 2) * 1024 + (r & 3) * 128) + lane; const unsigned w = *p; const float v0 = __uint_as_float(w << 16), v1 = __uint_as_float(w & 0xffff0000u);
    const float ss = wave_sum(v0 * v0 + v1 * v1); const float rs = rsqrtf(ss * (1.f / 128.f) + 1e-6f); *p = cvt_pk_bf16(v0 * rs * kg[2 * lane], v1 * rs * kg[2 * lane + 1]);
}

__device__ __forceinline__ void tokprep4(bf16_t* Q, bf16_t* KV, const float* qg, const float* kg, int t, int S, int lane) {
    u32x4 wq[4], wk[4]; const int br = 1 + ((lane >> 4) & 1);
#pragma unroll
    for (int i = 0; i < 4; ++i) { const int tt = t + i * S < NTOK ? t + i * S : NTOK - 1; wq[i] = *((const u32x4*)(Q + (size_t)tt * 512) + lane); wk[i] = *((const u32x4*)(KV + (size_t)tt * 768 + br * 256) + (lane & 15)); }
    f32x4 gq0 = *(const f32x4*)(qg + (lane & 7) * 8), gq1 = *(const f32x4*)(qg + (lane & 7) * 8 + 4), gk0 = *(const f32x4*)(kg + br * 64 + (lane & 7) * 8), gk1 = *(const f32x4*)(kg + br * 64 + (lane & 7) * 8 + 4);
#pragma unroll
    for (int i = 0; i < 4; ++i) { if (t + i * S >= NTOK) break; const int tt = t + i * S;
        { const u32x4 w = wq[i]; float v[8];
#pragma unroll
          for (int e = 0; e < 4; ++e) { v[2 * e] = __uint_as_float(w[e] << 16); v[2 * e + 1] = __uint_as_float(w[e] & 0xffff0000u); }
          float ss = 0.f;
#pragma unroll
          for (int e = 0; e < 8; ++e) ss += v[e] * v[e];
          ss += __shfl_xor(ss, 1); ss += __shfl_xor(ss, 2); ss += __shfl_xor(ss, 4);
          const float rs = rsqrtf(ss * (1.f / 64.f) + 1e-6f) * (0.125f * 1.4426950408889634f);
          u32x4 o; o[0] = cvt_pk_bf16(v[0] * rs * gq0[0], v[1] * rs * gq0[1]); o[1] = cvt_pk_bf16(v[2] * rs * gq0[2], v[3] * rs * gq0[3]); o[2] = cvt_pk_bf16(v[4] * rs * gq1[0], v[5] * rs * gq1[1]); o[3] = cvt_pk_bf16(v[6] * rs * gq1[2], v[7] * rs * gq1[3]);
          *((u32x4*)(Q + (size_t)tt * 512) + lane) = o; }
        { const u32x4 w = wk[i]; float v[8];
#pragma unroll
          for (int e = 0; e < 4; ++e) { v[2 * e] = __uint_as_float(w[e] << 16); v[2 * e + 1] = __uint_as_float(w[e] & 0xffff0000u); }
          float ss = 0.f;
#pragma unroll
          for (int e = 0; e < 8; ++e) ss += v[e] * v[e];
          ss += __shfl_xor(ss, 1); ss += __shfl_xor(ss, 2); ss += __shfl_xor(ss, 4);
          const float rs = rsqrtf(ss * (1.f / 64.f) + 1e-6f);
          u32x4 o; o[0] = cvt_pk_bf16(v[0] * rs * gk0[0], v[1] * rs * gk0[1]); o[1] = cvt_pk_bf16(v[2] * rs * gk0[2], v[3] * rs * gk0[3]); o[2] = cvt_pk_bf16(v[4] * rs * gk1[0], v[5] * rs * gk1[1]); o[3] = cvt_pk_bf16(v[6] * rs * gk1[2], v[7] * rs * gk1[3]);
          if (lane < 32) *((u32x4*)(KV + (size_t)tt * 768 + br * 256) + (lane & 15)) = o; } }
}
__device__ __forceinline__ void cmp2_tile(const bf16_t* HIDt, const bf16_t* w2t, const float* b2, const float* kg0, bf16_t* OUT) {
    int tid_ = threadIdx.x; asm volatile("" : "+v"(tid_)); const int lane = tid_ & 63, wave = __builtin_amdgcn_readfirstlane(tid_ >> 6), r32 = lane & 31, hi = lane >> 5; const int row = wave * 32 + r32;
    f32x16 acc[2];
#pragma unroll
    for (int r = 0; r < 16; ++r) { acc[0][r] = 0.f; acc[1][r] = 0.f; }
    bf16x8 bfr[16];
#pragma unroll
    for (int ks = 0; ks < 16; ++ks) bfr[ks] = *(const bf16x8*)(HIDt + (size_t)row * 256 + ks * 16 + hi * 8);
#pragma unroll
    for (int ks = 0; ks < 16; ++ks) { const bf16x8 a0 = *(const bf16x8*)(w2t + (size_t)r32 * 256 + ks * 16 + hi * 8), a1 = *(const bf16x8*)(w2t + (size_t)(32 + r32) * 256 + ks * 16 + hi * 8);
        acc[0] = MFMA32(a0, bfr[ks], acc[0]); acc[1] = MFMA32(a1, bfr[ks], acc[1]); }
    float ss = 0.f;
#pragma unroll
    for (int h = 0; h < 2; ++h)
#pragma unroll
        for (int r = 0; r < 16; ++r) { const float v = acc[h][r] + b2[32 * h + crow(r, hi)]; acc[h][r] = v; ss += v * v; }
    if (kg0) { ss += __shfl_xor(ss, 32); const float rs = rsqrtf(ss * (1.f / 64.f) + 1e-6f);
#pragma unroll
        for (int h = 0; h < 2; ++h)
#pragma unroll
            for (int r = 0; r < 16; ++r) acc[h][r] *= rs * kg0[32 * h + crow(r, hi)]; }
    const float keep = row == 255 ? 0.f : 1.f;
#pragma unroll
    for (int h = 0; h < 2; ++h)
#pragma unroll
        for (int a4 = 0; a4 < 4; ++a4) { u32x2 w; w.x = cvt_pk_bf16(acc[h][4 * a4] * keep, acc[h][4 * a4 + 1] * keep); w.y = cvt_pk_bf16(acc[h][4 * a4 + 2] * keep, acc[h][4 * a4 + 3] * keep); *(u32x2*)(OUT + (size_t)row * 64 + 32 * h + 8 * a4 + 4 * hi) = w; }
}

constexpr int SG_STAT = 0, SG_SSQ = 1024, SG_VN = 5120;
__device__ __forceinline__ void sgu_unit(LAS unsigned char* lds, int unit, const bf16_t* U, const bf16_t* Vb, const bf16_t* Wsg, const float* lng, const float* lnb, const float* sgb, bf16_t* MIX) {
    int tid_ = threadIdx.x; asm volatile("" : "+v"(tid_)); const int tid = tid_, lane = tid & 63, g = __builtin_amdgcn_readfirstlane(tid >> 6), r32 = lane & 31, hi = lane >> 5;
    const int tok0 = unit * 128;
    LAS float* STAT = (LAS float*)(lds + SG_STAT); LAS float* SSQA = (LAS float*)(lds + SG_SSQ);
    { const int tl = tid >> 2, part = tid & 3; const u32x4* p = (const u32x4*)(Vb + (size_t)(tok0 + tl) * 512 + part * 128); float s = 0.f, s2 = 0.f;
#pragma unroll 4
      for (int i = 0; i < 16; ++i) { const u32x4 w = p[i];
#pragma unroll
          for (int e = 0; e < 4; ++e) { const float a = __uint_as_float(w[e] << 16), b = __uint_as_float(w[e] & 0xffff0000u); s += a + b; s2 += a * a + b * b; } }
      s += __shfl_xor(s, 1); s += __shfl_xor(s, 2); s2 += __shfl_xor(s2, 1); s2 += __shfl_xor(s2, 2);
      if (part == 0) { const float mu = s * (1.f / 512.f); const float var = fmaxf(s2 * (1.f / 512.f) - mu * mu, 0.f); STAT[tl * 2] = mu; STAT[tl * 2 + 1] = rsqrtf(var + 1e-6f); }
      }
    __syncthreads();
    LAS unsigned char* VN = lds + SG_VN + g * 16384;
    { const int piece = lane & 7; float gg[8], bb[8];
#pragma unroll
      for (int i = 0; i < 8; ++i) { gg[i] = lng[g * 64 + piece * 8 + i]; bb[i] = lnb[g * 64 + piece * 8 + i]; }
#pragma unroll 4
      for (int it = 0; it < 16; ++it) { const int row = it * 8 + (lane >> 3); const u32x4 w = *(const u32x4*)(Vb + (size_t)(tok0 + row) * 512 + g * 64 + piece * 8); const float mu = STAT[row * 2], rs = STAT[row * 2 + 1]; u32x4 o;
#pragma unroll
          for (int e = 0; e < 4; ++e) { const float a = (__uint_as_float(w[e] << 16) - mu) * rs * gg[2 * e] + bb[2 * e], b = (__uint_as_float(w[e] & 0xffff0000u) - mu) * rs * gg[2 * e + 1] + bb[2 * e + 1]; o[e] = cvt_pk_bf16(a, b); }
          *(LAS u32x4*)(VN + (piece >> 2) * 8192 + row * 64 + (piece & 3) * 16) = o; } }
    asm volatile("s_waitcnt lgkmcnt(0)" ::: "memory");
    f32x16 acc[2][4];
#pragma unroll
    for (int dh = 0; dh < 2; ++dh)
#pragma unroll
        for (int mt = 0; mt < 4; ++mt)
#pragma unroll
            for (int r = 0; r < 16; ++r) acc[dh][mt][r] = 0.f;
    const LAS char* vb = (const LAS char*)VN + ((lane >> 4) & 1) * 32 + (lane & 3) * 8 + (4 * hi + ((lane & 15) >> 2)) * 64;
    const bf16_t* wrow = Wsg + ((size_t)g * 128 + r32) * 128 + 8 * hi;
#pragma unroll
    for (int ks = 0; ks < 8; ++ks) { bf16x8 vf[2];
#pragma unroll
        for (int dh = 0; dh < 2; ++dh) { const s16x4 lo = vtr(vb + dh * 8192 + ks * 1024), hh = vtr(vb + dh * 8192 + ks * 1024 + 512); vf[dh] = VFRAG(lo, hh); }
#pragma unroll
        for (int mt = 0; mt < 4; ++mt) { if (ks <= 2 * mt + 1) { const bf16x8 wf = *(const bf16x8*)(wrow + (size_t)mt * 32 * 128 + ks * 16);
                acc[0][mt] = MFMA32(vf[0], wf, acc[0][mt]); acc[1][mt] = MFMA32(vf[1], wf, acc[1][mt]); } } }
#pragma unroll
    for (int mt = 0; mt < 4; ++mt) { const int t = mt * 32 + r32; const float bias = sgb[g * 128 + t]; const bf16_t* up = U + (size_t)(tok0 + t) * 512 + g * 64 + 4 * hi; float ss = 0.f;
#pragma unroll
        for (int dh = 0; dh < 2; ++dh)
#pragma unroll
            for (int a4 = 0; a4 < 4; ++a4) { const u32x2 w = *(const u32x2*)(up + dh * 32 + a4 * 8);
                const float u0 = __uint_as_float(w.x << 16), u1 = __uint_as_float(w.x & 0xffff0000u), u2 = __uint_as_float(w.y << 16), u3 = __uint_as_float(w.y & 0xffff0000u);
                float x0 = u0 * (acc[dh][mt][4 * a4] + bias), x1 = u1 * (acc[dh][mt][4 * a4 + 1] + bias), x2 = u2 * (acc[dh][mt][4 * a4 + 2] + bias), x3 = u3 * (acc[dh][mt][4 * a4 + 3] + bias);
                acc[dh][mt][4 * a4] = x0; acc[dh][mt][4 * a4 + 1] = x1; acc[dh][mt][4 * a4 + 2] = x2; acc[dh][mt][4 * a4 + 3] = x3; ss += (x0 * x0 + x1 * x1) + (x2 * x2 + x3 * x3); }
        ss += __shfl_xor(ss, 32); if (hi == 0) SSQA[g * 128 + t] = ss; }
    __syncthreads();
#pragma unroll
    for (int mt = 0; mt < 4; ++mt) { const int t = mt * 32 + r32; float sa = 0.f;
#pragma unroll
        for (int w8 = 0; w8 < 8; ++w8) sa += SSQA[w8 * 128 + t];
        const float rs = rsqrtf(sa * (1.f / 512.f) + 1e-6f); bf16_t* op = MIX + (size_t)(tok0 + t) * 1024 + g * 64 + 4 * hi;
#pragma unroll
        for (int dh = 0; dh < 2; ++dh)
#pragma unroll
            for (int a4 = 0; a4 < 4; ++a4) { u32x2 w; w.x = cvt_pk_bf16(acc[dh][mt][4 * a4] * rs, acc[dh][mt][4 * a4 + 1] * rs); w.y = cvt_pk_bf16(acc[dh][mt][4 * a4 + 2] * rs, acc[dh][mt][4 * a4 + 3] * rs); *(u32x2*)(op + dh * 32 + a4 * 8) = w; } }
    __syncthreads();
}

constexpr int A_KB = 0, A_VB = 32768, A_IMPH = 65536, A_LINV = 132096, A_MASK = 133120, A_SSQ = 133632  ;
__device__ __forceinline__ void attn_cmp(LAS unsigned char* lds, const bf16_t* Kb, const bf16_t* Vb, int ntc, const bf16x8 (&qr)[4], f32x16 (&oT)[2], float& lsum,
                                         int kmin, int kmax, int kvh, int wave, int lane, int r32, int hi) {
    const int pitch = 64, hstride = 256 * 64;
    u32x4 sk0, sk1, sv0, sv1;
    const bf16_t* kthr = Kb + (size_t)lane * pitch + wave * 8; const bf16_t* vthr = Vb + (size_t)(16 * (wave & 3) + (lane >> 2)) * pitch + (wave >> 2) * 32 + (lane & 3) * 8;
    const int sdst = wave * 1024 + lane * 16;
#define A_LD(tile) do { const size_t to_ = (size_t)(tile) * 64 * pitch; sk0 = *(const u32x4*)(kthr + to_); sk1 = *(const u32x4*)(kthr + to_ + hstride); sv0 = *(const u32x4*)(vthr + to_); sv1 = *(const u32x4*)(vthr + to_ + hstride); } while (0)
#define A_ST(so) do { *(LAS u32x4*)(lds + A_KB + (so) + sdst) = sk0; *(LAS u32x4*)(lds + A_KB + (so) + 8192 + sdst) = sk1; *(LAS u32x4*)(lds + A_VB + (so) + sdst) = sv0; *(LAS u32x4*)(lds + A_VB + (so) + 8192 + sdst) = sv1; } while (0)
    const LAS char* kbase = (const LAS char*)(lds + A_KB) + kvh * 8192 + hi * 1024 + r32 * 16;
    const LAS char* vbase = (const LAS char*)(lds + A_VB) + kvh * 8192 + ((lane >> 4) & 1) * 32 + (lane & 3) * 8 + (4 * hi + ((lane & 15) >> 2)) * 64;
    LAS float* IMPH = (LAS float*)(lds + A_IMPH) + (wave * 32 + r32) * 65;
    float carry = 0.f;
    A_LD(0); A_ST(0); __syncthreads();
#pragma unroll 1
    for (int tile = 0; tile < ntc; ++tile) {
        const int so = (tile & 1) * 16384;
        if (tile + 1 < ntc) A_LD(tile + 1);
        bf16x8 kf[8];
#pragma unroll
        for (int d0 = 0; d0 < 4; ++d0) { kf[2 * d0] = *(const LAS bf16x8*)(kbase + so + d0 * 2048); kf[2 * d0 + 1] = *(const LAS bf16x8*)(kbase + so + d0 * 2048 + 512); }
        f32x16 p0, p1;
#pragma unroll
        for (int r = 0; r < 16; ++r) { p0[r] = 0.f; p1[r] = 0.f; }
#pragma unroll
        for (int d0 = 0; d0 < 4; ++d0) { p0 = MFMA32(kf[2 * d0], qr[d0], p0); p1 = MFMA32(kf[2 * d0 + 1], qr[d0], p1); }
        const int a = kmin - 64 * tile, bb = kmax - 64 * tile;
#pragma unroll
        for (int r = 0; r < 16; ++r) { p0[r] = __builtin_amdgcn_exp2f(p0[r]); p1[r] = __builtin_amdgcn_exp2f(p1[r]); }
        if (!__all(a <= 0 && bb >= 63)) { const unsigned span = (unsigned)(bb - a);
#pragma unroll
            for (int r = 0; r < 16; ++r) { const int rel = crow(r, hi); p0[r] = ((unsigned)(rel - a) <= span) ? p0[r] : 0.f; p1[r] = ((unsigned)(rel + 32 - a) <= span) ? p1[r] : 0.f; } }
        { float s = 0.f;
#pragma unroll
          for (int r = 0; r < 16; ++r) s += p0[r] + p1[r];
          lsum += s; }
        { float own[2][4], rcv[2][4];
#pragma unroll
          for (int a4 = 0; a4 < 4; ++a4) { const float h0 = 0.5f * p0[4 * a4 + 3], h1 = 0.5f * p1[4 * a4 + 3];
              own[0][a4] = (p0[4 * a4] + p0[4 * a4 + 1]) + (p0[4 * a4 + 2] + h0); own[1][a4] = (p1[4 * a4] + p1[4 * a4 + 1]) + (p1[4 * a4 + 2] + h1);
              rcv[0][a4] = __shfl_xor(h0, 32); rcv[1][a4] = __shfl_xor(h1, 32); }
#pragma unroll
          for (int h2 = 0; h2 < 2; ++h2)
#pragma unroll
              for (int a4 = 0; a4 < 4; ++a4) { const float fromprev = a4 > 0 ? rcv[h2][a4 - 1] : (h2 ? rcv[0][3] : carry);
                  IMPH[16 * tile + 8 * h2 + 2 * a4 + hi] = own[h2][a4] + (hi ? rcv[h2][a4] : fromprev); }
          carry = rcv[1][3]; }
        bf16x8 pa[4];
        { u32x4 w0, w1, w2, w3;
#pragma unroll
          for (int i = 0; i < 4; ++i) { w0[i] = cvt_pk_bf16(p0[2 * i], p0[2 * i + 1]); w1[i] = cvt_pk_bf16(p0[8 + 2 * i], p0[8 + 2 * i + 1]); w2[i] = cvt_pk_bf16(p1[2 * i], p1[2 * i + 1]); w3[i] = cvt_pk_bf16(p1[8 + 2 * i], p1[8 + 2 * i + 1]); }
          pa[0] = __builtin_bit_cast(bf16x8, w0); pa[1] = __builtin_bit_cast(bf16x8, w1); pa[2] = __builtin_bit_cast(bf16x8, w2); pa[3] = __builtin_bit_cast(bf16x8, w3); }
#pragma unroll
        for (int dh = 0; dh < 2; ++dh)
#pragma unroll
            for (int ks = 0; ks < 4; ++ks) { const s16x4 lo = vtr(vbase + so + dh * 4096 + ks * 1024), hh = vtr(vbase + so + dh * 4096 + ks * 1024 + 512); oT[dh] = MFMA32(VFRAG(lo, hh), pa[ks], oT[dh]); }
        if (tile + 1 < ntc) A_ST(so ^ 16384);
        __syncthreads();
    }
#undef A_LD
#undef A_ST
}

constexpr int A2_K = 0, A2_V = 49152, A2_SL = 16384;
#define SBAR() __builtin_amdgcn_sched_barrier(0)
#define PIN(x) asm volatile("" : "+v"(x))
#define WAIT_BAR(N) asm volatile("s_waitcnt vmcnt(" #N ") lgkmcnt(0)\n\ts_barrier" ::: "memory")
__device__ __forceinline__ void glds16(const void* g, unsigned lds_base) {
    unsigned sv; asm volatile("s_mov_b32 %0, m0\n\ts_mov_b32 m0, %2\n\ts_nop 0\n\tglobal_load_lds_dwordx4 %1, off\n\ts_mov_b32 m0, %0" : "=&s"(sv) : "v"(g), "s"(lds_base) : "memory"); }
__device__ __forceinline__ void range_mask(f32x16& c0, f32x16& c1, int a, int bb, int hi) {
    const unsigned span = (unsigned)(bb - a);
#pragma unroll
    for (int r = 0; r < 16; ++r) { const int rel = crow(r, hi); c0[r] = ((unsigned)(rel - a) <= span) ? c0[r] : -INFINITY; c1[r] = ((unsigned)(rel + 32 - a) <= span) ? c1[r] : -INFINITY; }
}
template <bool WIN>
__device__ __forceinline__ void attn_stream(LAS unsigned char* lds, const bf16_t* Kb, const bf16_t* Vb, int tlo, int NT, const bf16x8 (&qr)[4], f32x16 (&oT)[2], float& l_out,
                                            unsigned mlo, unsigned mhi, int tq, int kvh, int wave, int lane, int r32, int hi) {
    const unsigned lds0 = (unsigned)(uintptr_t)lds;
    const bf16_t* ksrc = Kb + (size_t)lane * 768 + wave * 8;
    const bf16_t* vsrc = Vb + (size_t)(16 * (wave & 3) + (lane >> 2)) * 768 + (wave >> 2) * 32 + (lane & 3) * 8;
    const unsigned kdst = lds0 + A2_K + wave * 1024, vdst = lds0 + A2_V + wave * 1024;
#define RFL(x) ((unsigned)__builtin_amdgcn_readfirstlane((int)(x)))
#define TCL(i) ((size_t)(tlo + ((i) < NT ? (i) : NT - 1)) * (64 * 768))
#define DMA_K(i, slot) do { const bf16_t* s_ = ksrc + TCL(i); glds16(s_, RFL(kdst + (slot))); glds16(s_ + 64, RFL(kdst + (slot) + 8192)); } while (0)
#define DMA_V(i, slot) do { const bf16_t* s_ = vsrc + TCL(i); glds16(s_, RFL(vdst + (slot))); glds16(s_ + 64, RFL(vdst + (slot) + 8192)); } while (0)
#define TMASK(idx_, a_, bb_, selm_) do { const int tt_ = tlo + (idx_); if (WIN) { a_ = tq - 511 - 64 * tt_; bb_ = tq - 64 * tt_; selm_ = ~0u; } \
        else { const unsigned s_ = tt_ < 32 ? (mlo >> tt_) & 1u : (mhi >> (tt_ - 32)) & 1u; a_ = -64 * tt_; bb_ = tq - 64 * tt_; selm_ = 0u - s_; } } while (0)
#define NEEDM(a_, bb_, selm_) (!__all((selm_) == 0u || ((a_) <= 0 && (bb_) >= 63)))
    const LAS char* kp0 = (const LAS char*)(lds + A2_K) + kvh * 8192 + hi * 1024 + r32 * 16;
    const LAS char* vp0 = (const LAS char*)(lds + A2_V) + kvh * 8192 + ((lane >> 4) & 1) * 32 + (lane & 3) * 8 + (4 * hi + ((lane & 15) >> 2)) * 64;
    asm volatile("s_waitcnt vmcnt(0)" ::: "memory");
    DMA_K(0, 0); DMA_V(0, 0); DMA_K(1, A2_SL); DMA_K(2, 2 * A2_SL);
    float l_reg = 0.f; f32x16 pA0, pA1, pB0, pB1; bf16x8 kf[8]; s16x4 vlo[8], vhi[8]; u32x4 pw0, pw1, pw2, pw3; unsigned selm_prev;
    const f32x16 zero16 = {0.f, 0.f, 0.f, 0.f, 0.f, 0.f, 0.f, 0.f, 0.f, 0.f, 0.f, 0.f, 0.f, 0.f, 0.f, 0.f};
    int sl_prev = 0, sl_cur = 0, sl_next = A2_SL;
#define ROT() do { sl_prev = sl_cur; sl_cur = sl_next; sl_next = (sl_next == 2 * A2_SL) ? 0 : sl_next + A2_SL; } while (0)
#define KLD(kp, d0) do { kf[2 * (d0)] = *(const LAS bf16x8*)((kp) + (d0) * 2048); kf[2 * (d0) + 1] = *(const LAS bf16x8*)((kp) + (d0) * 2048 + 512); } while (0)
    WAIT_BAR(6);
    KLD(kp0, 0); KLD(kp0, 1); KLD(kp0, 2); KLD(kp0, 3);
    pA0 = MFMA32(kf[0], qr[0], zero16); pA1 = MFMA32(kf[1], qr[0], zero16); pA0 = MFMA32(kf[2], qr[1], pA0); pA1 = MFMA32(kf[3], qr[1], pA1);
    pA0 = MFMA32(kf[4], qr[2], pA0); pA1 = MFMA32(kf[5], qr[2], pA1); pA0 = MFMA32(kf[6], qr[3], pA0); pA1 = MFMA32(kf[7], qr[3], pA1);
    { int a_, bb_; TMASK(0, a_, bb_, selm_prev); if (NEEDM(a_, bb_, selm_prev)) range_mask(pA0, pA1, a_, bb_, hi); }
#pragma unroll
    for (int r = 0; r < 16; ++r) { pA0[r] = __builtin_amdgcn_exp2f(pA0[r]); pA1[r] = __builtin_amdgcn_exp2f(pA1[r]); }
    WAIT_BAR(0);
    DMA_K(3, 0); DMA_V(1, A2_SL); ROT();
    KLD(kp0 + sl_cur, 0); KLD(kp0 + sl_cur, 1); KLD(kp0 + sl_cur, 2); KLD(kp0 + sl_cur, 3);
    WAIT_BAR(4);
#define PKW(P, i) cvt_pk_bf16(P[i], P[(i) + 1])
#define PAF(k) __builtin_bit_cast(bf16x8, pw##k)
#define VFR(i) VFRAG(vlo[i], vhi[i])
#define VRD(i) do { vlo[i] = vtr(vp_ + (((i) >> 2) * 4096 + ((i) & 3) * 1024)); vhi[i] = vtr(vp_ + (((i) >> 2) * 4096 + ((i) & 3) * 1024 + 512)); } while (0)
#define KRD(d0) do { KLD(kp0 + sl_next, d0); SBAR(); } while (0)
#define EX(v) __builtin_amdgcn_exp2f(v)
#define GAPA(MF, a0, a1, a2, a3, W0, W1, PW) do { MF; sacc += a0; sacc += a1; sacc += a2; sacc += a3; W0; W1; PIN(PW); PIN(sacc); SBAR(); } while (0)
#define GAPB(MF, X, i) do { MF; X[i] = EX(X[i]); X[(i) + 1] = EX(X[(i) + 1]); X[(i) + 2] = EX(X[(i) + 2]); X[(i) + 3] = EX(X[(i) + 3]); PIN(X); SBAR(); } while (0)
#define SELPW() do { if (!__all(selm_prev == ~0u)) { const u32x4 m_ = {selm_prev, selm_prev, selm_prev, selm_prev}; pw0 = pw0 & m_; pw1 = pw1 & m_; pw2 = pw2 & m_; pw3 = pw3 & m_; } } while (0)
#define STEP(C0, C1, P0, P1, idx) do { SBAR(); \
    const LAS char* vp_ = vp0 + sl_prev; \
    VRD(0); SBAR(); float sacc = P0[0] + P0[1]; \
                    GAPA(C0 = MFMA32(kf[0], qr[0], zero16), P0[2], P0[3], P0[4], P0[5],     pw0[0] = PKW(P0, 0),  pw0[1] = PKW(P0, 2),  pw0); \
    VRD(4); SBAR(); GAPA(C1 = MFMA32(kf[1], qr[0], zero16), P0[6], P0[7], P0[8], P0[9],     pw0[2] = PKW(P0, 4),  pw0[3] = PKW(P0, 6),  pw0); \
    VRD(1); SBAR(); GAPA(C0 = MFMA32(kf[2], qr[1], C0),     P0[10], P0[11], P0[12], P0[13], pw1[0] = PKW(P0, 8),  pw1[1] = PKW(P0, 10), pw1); \
    VRD(5); SBAR(); GAPA(C1 = MFMA32(kf[3], qr[1], C1),     P0[14], P0[15], P1[0], P1[1],   pw1[2] = PKW(P0, 12), pw1[3] = PKW(P0, 14), pw1); \
    VRD(2); SBAR(); GAPA(C0 = MFMA32(kf[4], qr[2], C0),     P1[2], P1[3], P1[4], P1[5],     pw2[0] = PKW(P1, 0),  pw2[1] = PKW(P1, 2),  pw2); \
    VRD(6); SBAR(); GAPA(C1 = MFMA32(kf[5], qr[2], C1),     P1[6], P1[7], P1[8], P1[9],     pw2[2] = PKW(P1, 4),  pw2[3] = PKW(P1, 6),  pw2); \
    VRD(3); SBAR(); GAPA(C0 = MFMA32(kf[6], qr[3], C0),     P1[10], P1[11], P1[12], P1[13], pw3[0] = PKW(P1, 8),  pw3[1] = PKW(P1, 10), pw3); \
    VRD(7); SBAR(); GAPA(C1 = MFMA32(kf[7], qr[3], C1),     P1[14], P1[15], 0.f, 0.f,       pw3[2] = PKW(P1, 12), pw3[3] = PKW(P1, 14), pw3); \
    l_reg += __uint_as_float(__float_as_uint(sacc) & selm_prev); SELPW(); \
    DMA_K((idx) + 3, sl_cur); DMA_V((idx) + 1, sl_next); \
    { int a_, bb_; unsigned selm_; TMASK(idx, a_, bb_, selm_); if (NEEDM(a_, bb_, selm_)) range_mask(C0, C1, a_, bb_, hi); selm_prev = selm_; } \
    SBAR(); \
    GAPB(oT[0] = MFMA32(VFR(0), PAF(0), oT[0]), C0, 0);            GAPB(oT[1] = MFMA32(VFR(4), PAF(0), oT[1]), C0, 4); \
    KRD(0); GAPB(oT[0] = MFMA32(VFR(1), PAF(1), oT[0]), C0, 8);    KRD(1); GAPB(oT[1] = MFMA32(VFR(5), PAF(1), oT[1]), C0, 12); \
    KRD(2); GAPB(oT[0] = MFMA32(VFR(2), PAF(2), oT[0]), C1, 0);    KRD(3); GAPB(oT[1] = MFMA32(VFR(6), PAF(2), oT[1]), C1, 4); \
    GAPB(oT[0] = MFMA32(VFR(3), PAF(3), oT[0]), C1, 8);            GAPB(oT[1] = MFMA32(VFR(7), PAF(3), oT[1]), C1, 12); \
    } while (0)
    int idx = 1;
#pragma unroll 1
    for (; idx + 1 < NT; idx += 2) {
        STEP(pB0, pB1, pA0, pA1, idx);     WAIT_BAR(4); ROT();
        STEP(pA0, pA1, pB0, pB1, idx + 1); WAIT_BAR(4); ROT();
    }
    if (idx < NT) { STEP(pB0, pB1, pA0, pA1, idx); WAIT_BAR(4); ROT(); pA0 = pB0; pA1 = pB1; }
    { float sacc = 0.f;
#pragma unroll
      for (int r = 0; r < 16; ++r) sacc += pA0[r] + pA1[r];
      l_reg += __uint_as_float(__float_as_uint(sacc) & selm_prev);
      pw0 = (u32x4){PKW(pA0, 0), PKW(pA0, 2), PKW(pA0, 4), PKW(pA0, 6)}; pw1 = (u32x4){PKW(pA0, 8), PKW(pA0, 10), PKW(pA0, 12), PKW(pA0, 14)};
      pw2 = (u32x4){PKW(pA1, 0), PKW(pA1, 2), PKW(pA1, 4), PKW(pA1, 6)}; pw3 = (u32x4){PKW(pA1, 8), PKW(pA1, 10), PKW(pA1, 12), PKW(pA1, 14)};
      SELPW();
      const LAS char* vp_ = vp0 + ((NT - 1) % 3) * A2_SL;
#pragma unroll
      for (int i = 0; i < 8; ++i) VRD(i);
      oT[0] = MFMA32(VFR(0), PAF(0), oT[0]); oT[1] = MFMA32(VFR(4), PAF(0), oT[1]); oT[0] = MFMA32(VFR(1), PAF(1), oT[0]); oT[1] = MFMA32(VFR(5), PAF(1), oT[1]);
      oT[0] = MFMA32(VFR(2), PAF(2), oT[0]); oT[1] = MFMA32(VFR(6), PAF(2), oT[1]); oT[0] = MFMA32(VFR(3), PAF(3), oT[0]); oT[1] = MFMA32(VFR(7), PAF(3), oT[1]); }
    WAIT_BAR(0);
    l_out = l_reg;
#undef RFL
#undef TCL
#undef DMA_K
#undef DMA_V
#undef TMASK
#undef NEEDM
#undef ROT
#undef KLD
#undef PKW
#undef PAF
#undef VFR
#undef VRD
#undef KRD
#undef EX
#undef GAPA
#undef GAPB
#undef SELPW
#undef STEP
}

template <int PARTS>
__device__ __forceinline__ void attn_unit(LAS unsigned char* lds, int b, int qt, const bf16_t* Q, const bf16_t* KV, const bf16_t* KC, const bf16_t* VC, const float* GL, bf16_t* MIX) {
    int tid_ = threadIdx.x; asm volatile("" : "+v"(tid_)); const int tid = tid_, lane = tid & 63, wave = __builtin_amdgcn_readfirstlane(tid >> 6), r32 = lane & 31, hi = lane >> 5, kvh = wave >> 2;
    const int t0 = qt * 32, tq = t0 + r32; const size_t tok = (size_t)b * T + tq;
    bf16x8 qr[4];
#pragma unroll
    for (int d0 = 0; d0 < 4; ++d0) qr[d0] = *(const bf16x8*)(Q + tok * 512 + wave * 64 + d0 * 16 + hi * 8);
    LAS float* IMPHA = (LAS float*)(lds + A_IMPH); LAS float* LINV = (LAS float*)(lds + A_LINV); LAS unsigned* MASKL = (LAS unsigned*)(lds + A_MASK); LAS float* SSQL = (LAS float*)(lds + A_SSQ);
    const float* glp = GL + tok * 24 + wave * 3;
    const float g0 = 1.f / (1.f + __expf(-glp[0])), g1 = 1.f / (1.f + __expf(-glp[1])), g2 = 1.f / (1.f + __expf(-glp[2]));
    f32x16 tot[2], oT[2];
    const int nvalid = tq >= 31 ? (tq - 31) / 16 + 1 : 0; const int ntc = (2 * qt + 1 + 63) >> 6;
    const int ckmin = nvalid > 0 ? 0 : (1 << 20), ckmax = nvalid > 0 ? nvalid - 1 : (1 << 20);
    const bf16_t* KCb = KC + (size_t)(b * 2) * 256 * 64; const bf16_t* VCb = VC + (size_t)(b * 2) * 256 * 64;
    float lc = 0.f;
#pragma unroll
    for (int r = 0; r < 16; ++r) { oT[0][r] = 0.f; oT[1][r] = 0.f; }
    if constexpr (PARTS & 1) attn_cmp(lds, KCb, VCb, ntc, qr, oT, lc, ckmin, ckmax, kvh, wave, lane, r32, hi);
    lc += __shfl_xor(lc, 32); const float inv_lc = lc > 0.f ? 1.f / lc : 0.f;
    if (hi == 0) LINV[wave * 32 + r32] = inv_lc;
    { const float c = g0 * inv_lc;
#pragma unroll
      for (int r = 0; r < 16; ++r) { tot[0][r] = oT[0][r] * c; tot[1][r] = oT[1][r] * c; oT[0][r] = 0.f; oT[1][r] = 0.f; } }
    __syncthreads();
    if constexpr (PARTS & 2) {
#pragma unroll 1
      for (int i = 0; i < 8; ++i) { const int pair = wave * 8 + i, kvp = pair >> 5, qq = pair & 31, j = lane; const int tb = (t0 + qq) >> 6; float v = 0.f;
#pragma unroll
          for (int g = 0; g < 4; ++g) v += IMPHA[((kvp * 4 + g) * 32 + qq) * 65 + j] * LINV[(kvp * 4 + g) * 32 + qq];
          const bool forced = (j == 0) || (j == tb) || (j == tb - 1); const float val = forced ? 1e4f : (j <= tb ? v : -1e4f);
          unsigned key = __float_as_uint(val); key ^= (key & 0x80000000u) ? 0xffffffffu : 0x80000000u; key = (key & ~63u) | (unsigned)(63 - j);
          unsigned prefix = 0u;
#pragma unroll
          for (int bit = 31; bit >= 0; --bit) { const unsigned tt = prefix | (1u << bit); const int cnt = __popcll(__ballot(key >= tt)); prefix = cnt >= 16 ? tt : prefix; }
          const unsigned long long m = __ballot(key >= prefix);
          if (lane == 0) { MASKL[pair * 2] = (unsigned)m; MASKL[pair * 2 + 1] = (unsigned)(m >> 32); } } }
    __syncthreads();
    const unsigned mlo = MASKL[(kvh * 32 + r32) * 2], mhi = MASKL[(kvh * 32 + r32) * 2 + 1];
    const int jmax = (t0 + 31) >> 6;
    const bf16_t* KVb = KV + (size_t)b * T * 768;
    unsigned totp[16];
#pragma unroll
    for (int i = 0; i < 8; ++i) { totp[i] = cvt_pk_bf16(tot[0][2 * i], tot[0][2 * i + 1]); totp[8 + i] = cvt_pk_bf16(tot[1][2 * i], tot[1][2 * i + 1]); }
    float ls = 0.f;
    if constexpr (PARTS & 4) attn_stream<false>(lds, KVb + 256, KVb + 384, 0, jmax + 1, qr, oT, ls, mlo, mhi, tq, kvh, wave, lane, r32, hi);
    ls += __shfl_xor(ls, 32);
    { const float c = ls > 0.f ? g1 / ls : 0.f;
#pragma unroll
      for (int i = 0; i < 8; ++i) { totp[i] = cvt_pk_bf16(__uint_as_float(totp[i] << 16) + oT[0][2 * i] * c, __uint_as_float(totp[i] & 0xffff0000u) + oT[0][2 * i + 1] * c);
                                    totp[8 + i] = cvt_pk_bf16(__uint_as_float(totp[8 + i] << 16) + oT[1][2 * i] * c, __uint_as_float(totp[8 + i] & 0xffff0000u) + oT[1][2 * i + 1] * c); }
#pragma unroll
      for (int r = 0; r < 16; ++r) { oT[0][r] = 0.f; oT[1][r] = 0.f; } }
    float lw = 0.f; const int jlo = t0 >= 511 ? (t0 - 511) >> 6 : 0;
    if constexpr (PARTS & 8) attn_stream<true>(lds, KVb + 512, KVb + 640, jlo, jmax - jlo + 1, qr, oT, lw, 0u, 0u, tq, kvh, wave, lane, r32, hi);
    lw += __shfl_xor(lw, 32);
    { const float c = lw > 0.f ? g2 / lw : 0.f;
#pragma unroll
      for (int i = 0; i < 8; ++i) { tot[0][2 * i] = __uint_as_float(totp[i] << 16) + oT[0][2 * i] * c; tot[0][2 * i + 1] = __uint_as_float(totp[i] & 0xffff0000u) + oT[0][2 * i + 1] * c;
                                    tot[1][2 * i] = __uint_as_float(totp[8 + i] << 16) + oT[1][2 * i] * c; tot[1][2 * i + 1] = __uint_as_float(totp[8 + i] & 0xffff0000u) + oT[1][2 * i + 1] * c; } }
    { float ss = 0.f;
#pragma unroll
      for (int r = 0; r < 16; ++r) ss += tot[0][r] * tot[0][r] + tot[1][r] * tot[1][r];
      ss += __shfl_xor(ss, 32); if (hi == 0) SSQL[wave * 32 + r32] = ss; }
    __syncthreads();
    { float sa = 0.f;
#pragma unroll
      for (int w8 = 0; w8 < 8; ++w8) sa += SSQL[w8 * 32 + r32];
      const float rs = rsqrtf(sa * (1.f / 512.f) + 1e-6f); bf16_t* op = MIX + tok * 1024 + 512 + wave * 64 + 4 * hi;
#pragma unroll
      for (int dh = 0; dh < 2; ++dh)
#pragma unroll
          for (int a4 = 0; a4 < 4; ++a4) { u32x2 w; w.x = cvt_pk_bf16(tot[dh][4 * a4] * rs, tot[dh][4 * a4 + 1] * rs); w.y = cvt_pk_bf16(tot[dh][4 * a4 + 2] * rs, tot[dh][4 * a4 + 3] * rs); *(u32x2*)(op + dh * 32 + a4 * 8) = w; } }
    __syncthreads();
}

__device__ __forceinline__ void memattn_unit(LAS unsigned char* lds, int b, int h, int qt, const bf16_t* QM, const bf16_t* KVM, const float* qg, bf16_t* OM) {
    int tid_ = threadIdx.x; asm volatile("" : "+v"(tid_)); const int tid = tid_, lane = tid & 63, wave = __builtin_amdgcn_readfirstlane(tid >> 6), r32 = lane & 31, hi = lane >> 5;
    const size_t tok = (size_t)b * T + qt * 256 + wave * 32 + r32;
    bf16x8 qr[8];
    { float v[64]; float ss = 0.f;
#pragma unroll
      for (int d0 = 0; d0 < 8; ++d0) { const u32x4 w = *(const u32x4*)(QM + tok * 512 + h * 128 + d0 * 16 + hi * 8);
#pragma unroll
          for (int i = 0; i < 4; ++i) { const float a = __uint_as_float(w[i] << 16), c = __uint_as_float(w[i] & 0xffff0000u); v[d0 * 8 + 2 * i] = a; v[d0 * 8 + 2 * i + 1] = c; ss += a * a + c * c; } }
      ss += __shfl_xor(ss, 32); const float rs = rsqrtf(ss * (1.f / 128.f) + 1e-6f) * (0.08838834764831845f * 1.4426950408889634f);
#pragma unroll
      for (int d0 = 0; d0 < 8; ++d0) { u32x4 w; const float* gp = qg + d0 * 16 + hi * 8;
#pragma unroll
          for (int i = 0; i < 4; ++i) w[i] = cvt_pk_bf16(v[d0 * 8 + 2 * i] * rs * gp[2 * i], v[d0 * 8 + 2 * i + 1] * rs * gp[2 * i + 1]);
          qr[d0] = __builtin_bit_cast(bf16x8, w); } }
    const bf16_t* Kg = KVM + (size_t)b * 256 * 1024 + h * 128; const bf16_t* Vg = Kg + 512;
    u32x4 sk[2], sv[2];
#define M_LD(tile) do { _Pragma("unroll") for (int i = 0; i < 2; ++i) { sk[i] = *(const u32x4*)(Kg + (size_t)((tile) * 64 + lane) * 1024 + (wave * 2 + i) * 8); const int p = i * 512 + tid; \
        sv[i] = *(const u32x4*)(Vg + (size_t)((tile) * 64 + ((p & 255) >> 2)) * 1024 + (p >> 8) * 32 + (p & 3) * 8); } } while (0)
#define M_ST(so) do { _Pragma("unroll") for (int i = 0; i < 2; ++i) { *(LAS u32x4*)(lds + (so) + (wave * 2 + i) * 1024 + lane * 16) = sk[i]; *(LAS u32x4*)(lds + 32768 + (so) + (i * 512 + tid) * 16) = sv[i]; } } while (0)
    const LAS char* kbase = (const LAS char*)lds + hi * 1024 + r32 * 16;
    const LAS char* vbase = (const LAS char*)lds + 32768 + ((lane >> 4) & 1) * 32 + (lane & 3) * 8 + (4 * hi + ((lane & 15) >> 2)) * 64;
    f32x16 oT[4]; float lsum = 0.f;
#pragma unroll
    for (int dq = 0; dq < 4; ++dq)
#pragma unroll
        for (int r = 0; r < 16; ++r) oT[dq][r] = 0.f;
    M_LD(0); M_ST(0); __syncthreads();
#pragma unroll 1
    for (int tile = 0; tile < 4; ++tile) { const int so = (tile & 1) * 16384;
        if (tile < 3) M_LD(tile + 1);
        f32x16 p0, p1;
#pragma unroll
        for (int r = 0; r < 16; ++r) { p0[r] = 0.f; p1[r] = 0.f; }
#pragma unroll
        for (int d0 = 0; d0 < 8; ++d0) { const bf16x8 k0 = *(const LAS bf16x8*)(kbase + so + d0 * 2048), k1 = *(const LAS bf16x8*)(kbase + so + d0 * 2048 + 512); p0 = MFMA32(k0, qr[d0], p0); p1 = MFMA32(k1, qr[d0], p1); }
        float s = 0.f;
#pragma unroll
        for (int r = 0; r < 16; ++r) { p0[r] = __builtin_amdgcn_exp2f(p0[r]); p1[r] = __builtin_amdgcn_exp2f(p1[r]); s += p0[r] + p1[r]; }
        lsum += s;
        bf16x8 pa[4];
        { u32x4 w0, w1, w2, w3;
#pragma unroll
          for (int i = 0; i < 4; ++i) { w0[i] = cvt_pk_bf16(p0[2 * i], p0[2 * i + 1]); w1[i] = cvt_pk_bf16(p0[8 + 2 * i], p0[8 + 2 * i + 1]); w2[i] = cvt_pk_bf16(p1[2 * i], p1[2 * i + 1]); w3[i] = cvt_pk_bf16(p1[8 + 2 * i], p1[8 + 2 * i + 1]); }
          pa[0] = __builtin_bit_cast(bf16x8, w0); pa[1] = __builtin_bit_cast(bf16x8, w1); pa[2] = __builtin_bit_cast(bf16x8, w2); pa[3] = __builtin_bit_cast(bf16x8, w3); }
#pragma unroll
        for (int dq = 0; dq < 4; ++dq)
#pragma unroll
            for (int ks = 0; ks < 4; ++ks) { const s16x4 lo = vtr(vbase + so + dq * 4096 + ks * 1024), hh = vtr(vbase + so + dq * 4096 + ks * 1024 + 512); oT[dq] = MFMA32(VFRAG(lo, hh), pa[ks], oT[dq]); }
        if (tile < 3) M_ST(so ^ 16384);
        __syncthreads();
    }
#undef M_LD
#undef M_ST
    lsum += __shfl_xor(lsum, 32); const float il = 1.f / lsum; bf16_t* op = OM + tok * 512 + h * 128 + 4 * hi;
#pragma unroll
    for (int dq = 0; dq < 4; ++dq)
#pragma unroll
        for (int a4 = 0; a4 < 4; ++a4) { u32x2 w; w.x = cvt_pk_bf16(oT[dq][4 * a4] * il, oT[dq][4 * a4 + 1] * il); w.y = cvt_pk_bf16(oT[dq][4 * a4 + 2] * il, oT[dq][4 * a4 + 3] * il); *(u32x2*)(op + dq * 32 + a4 * 8) = w; }
}

#define XB_TMO      128
#define XB_XCNT(j)  (256  + 64 * (j))
#define XB_XSUB(j)  (1280 + 64 * (j))
#define XB_XGEN(j)  (2304 + 64 * (j))
#define XB_TOP      3328
#define XB_TOPGEN   3392
#define XCD_BAR_WORDS 3456
#define XB_SPIN_CAP (1u << 18)
__device__ __forceinline__ unsigned xb_ld(unsigned* p)              { return __hip_atomic_load(p, __ATOMIC_RELAXED, __HIP_MEMORY_SCOPE_AGENT); }
__device__ __forceinline__ unsigned xb_add(unsigned* p, unsigned v) { return __hip_atomic_fetch_add(p, v, __ATOMIC_RELAXED, __HIP_MEMORY_SCOPE_AGENT); }
__device__ __forceinline__ unsigned xb_xcc_id() { return (unsigned)__builtin_amdgcn_s_getreg((3 << 11) | 20) & 0xFu; }
#define XB_SPIN(cond, bar) do { unsigned _sp = 0; while (cond) { __builtin_amdgcn_s_sleep(1); \
    if ((++_sp & 255u) == 0u) { if (xb_ld(&(bar)[XB_TMO])) break; if (_sp > XB_SPIN_CAP) { atomicAdd(&(bar)[XB_TMO], 1u); break; } } } } while (0)
struct XcdBarrier { unsigned* bar; unsigned x; volatile LAS unsigned* st; };
__device__ __forceinline__ XcdBarrier xcd_barrier_post(unsigned* bar, volatile LAS unsigned* st) {
    XcdBarrier b; b.bar = bar; b.x = xb_xcc_id(); b.st = st;
    if (threadIdx.x == 0) (void)xb_add(&bar[XB_XCNT(b.x)], 1u);
    return b;
}
__device__ __forceinline__ void xcd_barrier_complete(unsigned* bar, unsigned x, unsigned& nloc, unsigned& nx) {
    const unsigned G = gridDim.x * gridDim.y * gridDim.z;
    unsigned sum, cnt, mine, sp = 0u;
    for (;;) {
        sum = 0u; cnt = 0u; mine = 0u;
#pragma unroll
        for (unsigned j = 0; j < 16; ++j) { const unsigned c = xb_ld(&bar[XB_XCNT(j)]); sum += c; cnt += (c > 0u) ? 1u : 0u; mine = (j == x) ? c : mine; }
        if (sum == G) break;
        __builtin_amdgcn_s_sleep(1);
        if ((++sp & 255u) == 0u) { if (xb_ld(&bar[XB_TMO])) break; if (sp > XB_SPIN_CAP) { atomicAdd(&bar[XB_TMO], 1u); break; } }
    }
    nloc = mine > 0u ? mine : 1u; nx = cnt > 0u ? cnt : 1u;
}
__device__ __forceinline__ void xcd_barrier(const XcdBarrier& b) {
    asm volatile("s_waitcnt vmcnt(0)" ::: "memory");
    __syncthreads();
    if (threadIdx.x == 0) {
        unsigned* bar = b.bar;
        __builtin_amdgcn_s_waitcnt(0);
        unsigned nloc = b.st[0], nx = b.st[1];
        if (nloc == 0u) { xcd_barrier_complete(bar, b.x, nloc, nx); b.st[0] = nloc; b.st[1] = nx; }
        const unsigned old = xb_add(&bar[XB_XSUB(b.x)], 1u);
        const unsigned gen = old / nloc;
        if (old + 1u == (gen + 1u) * nloc) {
            __builtin_amdgcn_fence(__ATOMIC_RELEASE, "agent");
            asm volatile("s_waitcnt vmcnt(0)" ::: "memory");
            const unsigned og = xb_add(&bar[XB_TOP], 1u);
            const unsigned tg = og / nx;
            if (og + 1u == (tg + 1u) * nx) xb_add(&bar[XB_TOPGEN], 1u);
            else XB_SPIN(xb_ld(&bar[XB_TOPGEN]) == tg, bar);
            __builtin_amdgcn_fence(__ATOMIC_ACQUIRE, "agent");
            xb_add(&bar[XB_XGEN(b.x)], 1u);
            asm volatile("s_waitcnt vmcnt(0)" ::: "memory");
        } else {
            XB_SPIN(xb_ld(&bar[XB_XGEN(b.x)]) == gen, bar);
            __builtin_amdgcn_fence(__ATOMIC_ACQUIRE, "agent");
            asm volatile("s_waitcnt vmcnt(0)" ::: "memory");
        }
    }
    __syncthreads();
}
constexpr size_t CTL_BAR_BYTE = 704 * 1024;
constexpr int LDS_ST_OFF = 147456 - 64;

template <bool PROBE>
__device__ __forceinline__ void do_phase(const int p, const int l, const Args& args, LAS unsigned char* lds, const int G, const int bx, const int NGW) {
    unsigned char* ws = args.ws; float* xout = args.out; asm volatile("" : "+s"(ws), "+s"(xout));
    int tidp = threadIdx.x; asm volatile("" : "+v"(tidp)); const int lane = tidp & 63, wave = __builtin_amdgcn_readfirstlane(tidp >> 6), gw = bx * 8 + wave; (void)lane; (void)gw; (void)NGW;
    float* ctl = (float*)(ws + WS_CTL); bf16_t* XB = (bf16_t*)(ws + WS_XB); float* ssqp = (float*)(ws + WS_SSQP);
    unsigned char* wl = ws + WS_W + l * W_LAYER;
    if (p == 0) {
        pg8::Gemm g = pg8::make_gemm(XB, (const bf16_t*)(wl + W_IN), 1024); pg8::StaticOrder S; S.init(NTOK, INP, G, bx);
        pg8::EpiInProj E{(bf16_t*)(ws + WS_U), (bf16_t*)(ws + WS_V), (bf16_t*)(ws + WS_Q), (bf16_t*)(ws + WS_KV), (float*)(ws + WS_GL), ssqp + (size_t)(l == 0 ? 0 : 3) * NTOK * 16};
        pg8::gemm_phase<pg8::EpiInProj, pg8::StaticOrder, true>(lds, g, S, E);
    } else if (p == 1) {
      for (int vb = bx; vb < 256; vb += G) {
        if (vb < 16) { const int kv = vb >> 3, pm = vb & 7;
            pg8::Gemm g; g.A = (const bf16_t*)(ws + WS_KV) + kv * 128; g.Bt = (const bf16_t*)(wl + W_C1 + (size_t)kv * 256 * 2048 * 2); g.K = 2048; g.lda = 16 * 768; g.kstepA = 768 * 2; g.a_s0 = 64 * 2; g.a_s1 = (size_t)T * 768 * 2;
            pg8::OneUnit S{1, {pm, 0}};
            bf16_t* hid = (bf16_t*)(ws + WS_HID) + (size_t)kv * 2048 * 256;
            pg8::EpiBf16G<1> E{hid, 256, (const float*)(wl + W_B1P) + kv * 256, nullptr, 0.f, 1};
            pg8::gemm_phase<pg8::EpiBf16G<1>, pg8::OneUnit, true>(lds, g, S, E);
            asm volatile("s_waitcnt vmcnt(0)" ::: "memory"); __syncthreads();
            cmp2_tile(hid + (size_t)pm * 256 * 256, (const bf16_t*)(wl + W_C2) + (size_t)kv * 64 * 256, args.in[I_CB2] + l * 128 + kv * 64, kv == 0 ? args.in[I_KNG] + l * 192 : (const float*)nullptr,
                      (bf16_t*)(ws + (kv ? WS_VC : WS_KC)) + (size_t)pm * 256 * 64);
        } else if (vb < 32) { const int i = vb - 16;
            pg8::Gemm g = pg8::make_gemm((const bf16_t*)(ws + WS_MEMB), (const bf16_t*)(wl + W_MKV), 1024); pg8::OneUnit S{1, {i >> 2, i & 3}};
            pg8::EpiBf16G<0> E{(bf16_t*)(ws + WS_KVM), 1024, nullptr, ctl + SSQ_MEM_OFF, 1.f / 1024.f, 1};
            pg8::gemm_phase<pg8::EpiBf16G<0>, pg8::OneUnit, true>(lds, g, S, E);
        } else if (vb < 160) {
            sgu_unit(lds, vb - 32, (const bf16_t*)(ws + WS_U), (const bf16_t*)(ws + WS_V), (const bf16_t*)(wl + W_SG), args.in[I_SGLNG] + l * 512, args.in[I_SGLNB] + l * 512, args.in[I_SGB] + l * 1024, (bf16_t*)(ws + WS_MIX));
        } else {
            for (int t = (vb - 160) * 8 + wave; t < NTOK; t += 4 * 768) tokprep4((bf16_t*)(ws + WS_Q), (bf16_t*)(ws + WS_KV), args.in[I_QNG] + l * 64, args.in[I_KNG] + l * 192, t, 768, lane);
            if (l == 0 && !PROBE) convert_layer(args, 1, 0, CONV_SPLIT, (vb - 160) * 8 + wave, 96 * 8, (LAS float*)(lds + wave * 16384), lane);
        } }
    } else if (p == 3) {
        for (int r = gw; r < 4096; r += NGW) memk_norm_item((bf16_t*)(ws + WS_KVM), args.in[I_MKG] + l * 128, r, lane);
        for (int i = bx; i < 256; i += G) { const int b = (i & 7) >> 1, idx = (i >> 3) * 2 + (i & 1);
            attn_unit<15>(lds, b, 127 - idx, (const bf16_t*)(ws + WS_Q), (const bf16_t*)(ws + WS_KV), (const bf16_t*)(ws + WS_KC), (const bf16_t*)(ws + WS_VC), (const float*)(ws + WS_GL), (bf16_t*)(ws + WS_MIX));
            attn_unit<15>(lds, b, idx, (const bf16_t*)(ws + WS_Q), (const bf16_t*)(ws + WS_KV), (const bf16_t*)(ws + WS_KC), (const bf16_t*)(ws + WS_VC), (const float*)(ws + WS_GL), (bf16_t*)(ws + WS_MIX)); }
    } else if (p == 6) {
        for (int i = bx; i < 256; i += G) { const int b = (i & 7) >> 1, rest = (i >> 3) * 2 + (i & 1);
            memattn_unit(lds, b, rest >> 4, rest & 15, (const bf16_t*)(ws + WS_QM), (const bf16_t*)(ws + WS_KVM), args.in[I_MQG] + l * 128, (bf16_t*)(ws + WS_OM)); }
    } else if (p == 4) {
        pg8::Gemm g = pg8::make_gemm((const bf16_t*)(ws + WS_MIX), (const bf16_t*)(wl + W_OUT), 1024); pg8::StaticOrder S; S.init(NTOK, 1024, G, bx);
        pg8::EpiResid E{nullptr, XB, ssqp + (size_t)(PROBE ? 1 : l * 3 + 1) * NTOK * 16};
        pg8::gemm_phase<pg8::EpiResid, pg8::StaticOrder, true>(lds, g, S, E);
    } else if (p == 5) {
        pg8::Gemm g = pg8::make_gemm(XB, (const bf16_t*)(wl + W_MQ), 1024); pg8::StaticOrder S; S.init(NTOK, 512, G, bx);
        pg8::EpiBf16G<0> E{(bf16_t*)(ws + WS_QM), 512, nullptr, ssqp + (size_t)(l * 3 + 1) * NTOK * 16, 1.f / 1024.f, 16};
        pg8::gemm_phase<pg8::EpiBf16G<0>, pg8::StaticOrder, true>(lds, g, S, E);
        if (l == 0 && !PROBE) { const int nidle = G > 128 ? G - 128 : 0;
            if (nidle == 0) convert_layer(args, 1, CONV_SPLIT, CONV_ITEMS, gw, NGW, (LAS float*)(lds + wave * 16384), lane);
            else if (bx >= 128) convert_layer(args, 1, CONV_SPLIT, CONV_ITEMS, (bx - 128) * 8 + wave, nidle * 8, (LAS float*)(lds + wave * 16384), lane); }
    } else if (p == 7) {
        pg8::Gemm g = pg8::make_gemm((const bf16_t*)(ws + WS_OM), (const bf16_t*)(wl + W_MO), 512); pg8::StaticOrder S; S.init(NTOK, 1024, G, bx);
        pg8::EpiResid E{nullptr, XB, ssqp + (size_t)(PROBE ? 1 : l * 3 + 2) * NTOK * 16};
        pg8::gemm_phase<pg8::EpiResid, pg8::StaticOrder, true>(lds, g, S, E);
    } else if (p == 8) {
        pg8::Gemm g = pg8::make_gemm(XB, (const bf16_t*)(wl + W_FF1), 1024); pg8::StaticOrder S; S.init(NTOK, FF, G, bx);
        pg8::EpiBf16G<2> E{(bf16_t*)(ws + WS_HB), FF, nullptr, ssqp + (size_t)(l * 3 + 2) * NTOK * 16, 1.f / 1024.f, 16};
        pg8::gemm_phase<pg8::EpiBf16G<2>, pg8::StaticOrder, true>(lds, g, S, E);
    } else if (p == 9) {
        pg8::Gemm g = pg8::make_gemm((const bf16_t*)(ws + WS_HB), (const bf16_t*)(wl + W_FF2), FF); pg8::StaticOrder S; S.init(NTOK, 1024, G, bx);
        pg8::EpiResid E{(l == 0 || PROBE) ? (float*)nullptr : xout, XB, ssqp + (size_t)(PROBE ? 1 : 3) * NTOK * 16};
        pg8::gemm_phase<pg8::EpiResid, pg8::StaticOrder, true>(lds, g, S, E);
    }
}

constexpr int LDS_BYTES = 147456;
__global__ void __launch_bounds__(512, 2) mega(Args args) {
    extern __shared__ __attribute__((aligned(16))) unsigned char lds_raw[];
    LAS unsigned char* lds = (LAS unsigned char*)lds_raw;
    const int G = gridDim.x, bx = blockIdx.x, NGW = G * 8;
    volatile LAS unsigned* bar_st = (volatile LAS unsigned*)(lds + LDS_ST_OFF);
    if (threadIdx.x < 2) bar_st[threadIdx.x] = 0u;
    __syncthreads();
    XcdBarrier xbar = xcd_barrier_post((unsigned*)(args.ws + WS_CTL + CTL_BAR_BYTE), bar_st);
    if (args.ph_hi < 0) cooperative_groups::this_grid().sync();
    if (args.ph_lo == 0) { const int tid0 = threadIdx.x, wave0 = __builtin_amdgcn_readfirstlane(tid0 >> 6); for (int e_ = 0; e_ < 1 + MK_PROBE_PRO; ++e_) prologue(args, lds, bx * 8 + wave0, NGW, wave0, tid0 & 63); }
    for (int ph = args.ph_lo > 1 ? args.ph_lo : 1; ph < args.ph_hi; ++ph) {
        if ((ph - 1) % 10 == 2) continue;
        if (ph > args.ph_lo) {
            xcd_barrier(xbar); }
        do_phase<false>((ph - 1) % 10, (ph - 1) / 10, args, lds, G, bx, NGW);
    }
#if MK_PROBE_N > 0
    if (args.ph_hi == 21) {
        xcd_barrier(xbar); do_phase<true>(0, 1, args, lds, G, bx, NGW);
        xcd_barrier(xbar); do_phase<true>(1, 1, args, lds, G, bx, NGW);
        for (int e_ = 0; e_ < MK_PROBE_N; ++e_) { xcd_barrier(xbar);
#if MK_PROBE_KIND == 100
            { int tidp = threadIdx.x; asm volatile("" : "+v"(tidp)); const int w_ = __builtin_amdgcn_readfirstlane(tidp >> 6); convert_layer(args, 1, 0, CONV_ITEMS, bx * 8 + w_, NGW, (LAS float*)(lds + w_ * 16384), tidp & 63); }
#elif MK_PROBE_KIND == 33
            for (int i = bx; i < 256; i += G) { const int b = (i & 7) >> 1, idx = (i >> 3) * 2 + (i & 1); unsigned char* ws = args.ws;
                attn_unit<MK_PROBE_PARTS>(lds, b, 127 - idx, (const bf16_t*)(ws + WS_Q), (const bf16_t*)(ws + WS_KV), (const bf16_t*)(ws + WS_KC), (const bf16_t*)(ws + WS_VC), (const float*)(ws + WS_GL), (bf16_t*)(ws + WS_MIX));
                attn_unit<MK_PROBE_PARTS>(lds, b, idx, (const bf16_t*)(ws + WS_Q), (const bf16_t*)(ws + WS_KV), (const bf16_t*)(ws + WS_KC), (const bf16_t*)(ws + WS_VC), (const float*)(ws + WS_GL), (bf16_t*)(ws + WS_MIX)); }
#elif MK_PROBE_KIND != 99
            do_phase<true>(MK_PROBE_KIND, 1, args, lds, G, bx, NGW);
#endif
        }
    }
#endif
}

}

#ifndef MK_FUSED
#define MK_FUSED 1
#endif
extern "C" void kernel_launch(void* const* d_in, const int* in_sizes, int n_in, void* d_out, int out_size, void* d_ws, size_t ws_size, hipStream_t stream) {
    using namespace mk;
    static int grid = 0;
    if (!grid) { (void)hipFuncSetAttribute((const void*)mega, hipFuncAttributeMaxDynamicSharedMemorySize, LDS_BYTES);
        int dev = 0, cus = 0, per_cu = 0; (void)hipGetDevice(&dev); (void)hipDeviceGetAttribute(&cus, hipDeviceAttributeMultiprocessorCount, dev);
        (void)hipOccupancyMaxActiveBlocksPerMultiprocessor(&per_cu, (const void*)mega, 512, LDS_BYTES);
        grid = cus * (per_cu < 1 ? 1 : per_cu); if (grid > 256) grid = 256; }
    Args a{}; for (int i = 0; i < 27; ++i) a.in[i] = (const float*)d_in[i]; a.out = (float*)d_out; a.ws = (unsigned char*)d_ws;
#if MK_FUSED
    (void)hipMemsetAsync((unsigned char*)d_ws + WS_CTL + CTL_BAR_BYTE, 0, XCD_BAR_WORDS * 4, stream);
    a.ph_lo = 0; a.ph_hi = 21; void* kargs[] = {&a};
    (void)hipLaunchCooperativeKernel((const void*)mega, dim3(grid), dim3(512), kargs, LDS_BYTES, stream);
#else
    for (int ph = 0; ph < 21; ++ph) { a.ph_lo = ph; a.ph_hi = ph + 1; hipLaunchKernelGGL(mega, dim3(grid), dim3(512), LDS_BYTES, stream, a); }
#endif
}
```

```cpp
#include <hip/hip_runtime.h>
#include <hip/hip_cooperative_groups.h>
#include <stdint.h>
#include <math.h>

namespace pg8 {
#define PG8_LAS __attribute__((address_space(3)))
typedef unsigned short bf16_t;
typedef short bf16x8 __attribute__((ext_vector_type(8)));
typedef float f32x4 __attribute__((ext_vector_type(4)));
typedef float f32x2 __attribute__((ext_vector_type(2)));
typedef unsigned u32x4 __attribute__((ext_vector_type(4)));
typedef unsigned u32x2 __attribute__((ext_vector_type(2)));
constexpr int BM = 256, BK = 64, HALF = 128, HTB = HALF * BK * 2, STAGE_BYTES = 8 * HTB, NXCD = 8, WGM = 8;

__host__ __device__ __forceinline__ int lds_byte(int r, int c) { const int st = (r >> 4) * 2 + (c >> 5), rr = r & 15, cc = c & 31, ob = rr * 64 + cc * 2; return st * 1024 + (ob ^ (((ob >> 9) & 1) << 5)); }
__host__ __device__ __forceinline__ void stage_rc(int b, int& R, int& C) { const int st = b / 1024, sb = b % 1024, swz = sb ^ (((sb >> 9) & 1) << 5); R = (st >> 1) * 16 + swz / 64; C = (st & 1) * 32 + (swz % 64) / 2; }
__host__ __device__ __forceinline__ int perm32(int rho) { const int n = rho >> 4, i = rho & 15; return 8 * (i >> 2) + 4 * n + (i & 3); }

struct Unit { int pm, pn; };
struct Gemm { const bf16_t* A; const bf16_t* Bt; int K; int lda; int kstepA; size_t a_s0, a_s1; };
__device__ __forceinline__ Gemm make_gemm(const bf16_t* A, const bf16_t* Bt, int K) { Gemm g; g.A = A; g.Bt = Bt; g.K = K; g.lda = K; g.kstepA = BK * 2; g.a_s0 = (size_t)BM * K * 2; g.a_s1 = 2 * g.a_s0; return g; }

struct StaticOrder {
    int nM, nN, nwg, G, c;
    __device__ void init(int M, int N, int G_, int c_) { nM = M / BM; nN = N / BM; nwg = nM * nN; G = G_; c = c_; }
    __device__ bool next(int i, Unit& u) const {
        const long L = (long)i * G + c; if (L >= nwg) return false;
        int wgid = (int)L; { const int q = nwg / NXCD, r = nwg % NXCD, xcd = wgid % NXCD, off = wgid / NXCD; wgid = (xcd < r ? xcd * (q + 1) : r * (q + 1) + (xcd - r) * q) + off; }
        const int nig = WGM * nN, gid = wgid / nig, fm = gid * WGM, gsz = (nM - fm) < WGM ? (nM - fm) : WGM;
        u.pm = fm + ((wgid % nig) % gsz); u.pn = (wgid % nig) / gsz; return true;
    }
};
struct OneUnit { int has; Unit u; __device__ bool next(int i, Unit& o) const { if (i > 0 || !has) return false; o = u; return true; } };

__device__ __forceinline__ unsigned cvt_pk_bf16(float lo, float hi) { unsigned r; asm volatile("v_cvt_pk_bf16_f32 %0, %1, %2" : "=v"(r) : "v"(lo), "v"(hi)); return r; }
__device__ __forceinline__ float gelu_tanh(float x) { const float u = 0.7978845608028654f * (x + 0.044715f * x * x * x); const float e = __builtin_amdgcn_exp2f(-2.885390081777927f * u); return x * __builtin_amdgcn_rcpf(1.f + e); }

__device__ __forceinline__ float ssq16(const float* p) { const f32x4 a = ((const f32x4*)p)[0], b = ((const f32x4*)p)[1], c = ((const f32x4*)p)[2], d = ((const f32x4*)p)[3];
    return (((a[0] + a[1]) + (a[2] + a[3])) + ((b[0] + b[1]) + (b[2] + b[3]))) + (((c[0] + c[1]) + (c[2] + c[3])) + ((d[0] + d[1]) + (d[2] + d[3]))); }
template <int ACT  > struct EpiBf16G {
    static constexpr bool PERM = true, AFTER_DRAIN = false;
    bf16_t* O; int ldc; const float* bias; const float* ssq; float inv_n; int nparts;
    __device__ __forceinline__ void operator()(const f32x4 (&acc)[2][2][4][2], const Unit& u, int wr, int wc, int fr, int fq) const {
        const int row0 = u.pm * BM + wr * 64 + fr, col0 = u.pn * BM + wc * 32 + 8 * fq;
        f32x4 bv[2][2];
#pragma unroll
        for (int bj = 0; bj < 2; ++bj)
#pragma unroll
            for (int n = 0; n < 2; ++n) bv[bj][n] = bias ? *(const f32x4*)(bias + col0 + bj * HALF + 4 * n) : (f32x4){0.f, 0.f, 0.f, 0.f};
        float rsv[2] = {1.f, 1.f};
        if (ssq) {
#pragma unroll
            for (int ai = 0; ai < 2; ++ai) { const int rr = row0 + ai * HALF + fq * 16; rsv[ai] = rsqrtf((nparts == 16 ? ssq16(ssq + (size_t)rr * 16) : ssq[rr]) * inv_n + 1e-6f); } }
#pragma unroll
        for (int ai = 0; ai < 2; ++ai)
#pragma unroll
            for (int m = 0; m < 4; ++m) { const int row = row0 + ai * HALF + m * 16; const float rs = __shfl(rsv[ai], fr + 16 * m); bf16_t* rowp = O + (size_t)row * ldc + col0;
#pragma unroll
                for (int bj = 0; bj < 2; ++bj) { f32x4 v0 = (acc[ai][bj][m][0] + bv[bj][0]) * rs, v1 = (acc[ai][bj][m][1] + bv[bj][1]) * rs;
                    if (ACT == 1) {
#pragma unroll
                        for (int e = 0; e < 4; ++e) { v0[e] = gelu_tanh(v0[e]); v1[e] = gelu_tanh(v1[e]); } }
                    if (ACT == 2) {
#pragma unroll
                        for (int e = 0; e < 4; ++e) { float a = fmaxf(v0[e], 0.f), b = fmaxf(v1[e], 0.f); v0[e] = a * a; v1[e] = b * b; } }
                    u32x4 w; w.x = cvt_pk_bf16(v0[0], v0[1]); w.y = cvt_pk_bf16(v0[2], v0[3]); w.z = cvt_pk_bf16(v1[0], v1[1]); w.w = cvt_pk_bf16(v1[2], v1[3]);
                    *(u32x4*)(rowp + bj * HALF) = w; } }
    }
};
struct EpiInProj {
    static constexpr bool PERM = true, AFTER_DRAIN = false;
    bf16_t *U, *V, *Q, *KV; float* GL; const float* ssq;
    __device__ __forceinline__ void operator()(const f32x4 (&acc)[2][2][4][2], const Unit& u, int wr, int wc, int fr, int fq) const {
        const int row0 = u.pm * BM + wr * 64 + fr, cit0 = wc * 32 + 8 * fq; const int pn = u.pn;
        bf16_t* base; int ldc, cofs; bool act = false;
        if (pn < 2) { base = U; ldc = 512; cofs = pn * 256; act = true; } else if (pn < 4) { base = V; ldc = 512; cofs = (pn - 2) * 256; act = true; }
        else if (pn < 6) { base = Q; ldc = 512; cofs = (pn - 4) * 256; } else { base = KV; ldc = 768; cofs = (pn - 6) * 256; }
        float rsv[2];
#pragma unroll
        for (int ai = 0; ai < 2; ++ai) rsv[ai] = rsqrtf(ssq16(ssq + (size_t)(row0 + ai * HALF + fq * 16) * 16) * (1.f / 1024.f) + 1e-6f);
#pragma unroll
        for (int ai = 0; ai < 2; ++ai)
#pragma unroll
            for (int m = 0; m < 4; ++m) { const int row = row0 + ai * HALF + m * 16; const float rs = __shfl(rsv[ai], fr + 16 * m);
#pragma unroll
                for (int bj = 0; bj < 2; ++bj) { f32x4 v0 = acc[ai][bj][m][0] * rs, v1 = acc[ai][bj][m][1] * rs; const int cit = cit0 + bj * HALF;
                    if (pn == 9) { if (cit < 24) { *(f32x4*)(GL + (size_t)row * 24 + cit) = v0; *(f32x4*)(GL + (size_t)row * 24 + cit + 4) = v1; } }
                    else { if (act) {
#pragma unroll
                            for (int e = 0; e < 4; ++e) { v0[e] = gelu_tanh(v0[e]); v1[e] = gelu_tanh(v1[e]); } }
                        u32x4 w; w.x = cvt_pk_bf16(v0[0], v0[1]); w.y = cvt_pk_bf16(v0[2], v0[3]); w.z = cvt_pk_bf16(v1[0], v1[1]); w.w = cvt_pk_bf16(v1[2], v1[3]);
                        *(u32x4*)(base + (size_t)row * ldc + cofs + cit) = w; } } }
    }
};
struct EpiResid {
    static constexpr bool PERM = false, AFTER_DRAIN = false;
    float* XF; bf16_t* XB; float* ssq;
    __device__ __forceinline__ void operator()(const f32x4 (&acc)[2][2][4][2], const Unit& u, int wr, int wc, int fr, int fq) const {
        const int col0 = u.pn * BM + wc * 32 + 4 * fq;
#pragma unroll
        for (int ai = 0; ai < 2; ++ai)
#pragma unroll
            for (int m = 0; m < 4; ++m) { const int row = u.pm * BM + ai * HALF + wr * 64 + m * 16 + fr; float sq = 0.f;
#pragma unroll
                for (int bj = 0; bj < 2; ++bj)
#pragma unroll
                    for (int n = 0; n < 2; ++n) { const size_t off = (size_t)row * 1024 + col0 + bj * HALF + n * 16; const u32x2 xw = *(const u32x2*)(XB + off);
                        f32x4 xv; xv[0] = __uint_as_float(xw.x << 16); xv[1] = __uint_as_float(xw.x & 0xffff0000u); xv[2] = __uint_as_float(xw.y << 16); xv[3] = __uint_as_float(xw.y & 0xffff0000u);
                        xv = xv + acc[ai][bj][m][n];
                        if (XF) *(f32x4*)(XF + off) = xv;
                        else { sq += (xv[0] * xv[0] + xv[1] * xv[1]) + (xv[2] * xv[2] + xv[3] * xv[3]); u32x2 w; w.x = cvt_pk_bf16(xv[0], xv[1]); w.y = cvt_pk_bf16(xv[2], xv[3]); *(u32x2*)(XB + off) = w; } }
                if (!XF) { sq += __shfl_xor(sq, 16); sq += __shfl_xor(sq, 32); if (fq == 0) ssq[(size_t)row * 16 + u.pn * 4 + wc] = sq; } }
    }
};

template <class Epi, class Sched, bool ALIGN_EPI>
__device__ __forceinline__ void gemm_phase(PG8_LAS unsigned char* lds, const Gemm g, const Sched& S, const Epi& E) {
    int tid_ = threadIdx.x; asm volatile("" : "+v"(tid_));
    const int tid = tid_, wid = __builtin_amdgcn_readfirstlane(tid >> 6), lane = tid & 63, wr = wid >> 2, wc = wid & 3, fr = lane & 15, fq = lane >> 4;
    const int K = g.K, nt = K / BK;
    unsigned voffA[2], voffB[2];
#pragma unroll
    for (int i = 0; i < 2; ++i) { int R, C; stage_rc(tid * 16 + i * 8192, R, C); const int Rb = Epi::PERM ? ((R & ~31) + perm32(R & 31)) : R;
        voffA[i] = (unsigned)(R * g.lda + C) * 2u; voffB[i] = (unsigned)(Rb * K + C) * 2u; }
    const size_t kstepA = (size_t)g.kstepA, kstepB = (size_t)(BK * 2);
    const size_t hstepA = (size_t)HALF * g.lda * 2, hstepB = (size_t)HALF * K * 2, tstepB = 2 * hstepB;
    const unsigned ldsw = (unsigned)wid * 1024u;
    const int aoff = lds_byte(wr * 64 + fr, fq * 8), boff = lds_byte(wc * 32 + fr, fq * 8);
#define PG8_ABASE(pm) ((const char*)g.A + (size_t)((pm) >> 1) * g.a_s1 + (size_t)((pm) & 1) * g.a_s0)
#define PG8_SA(b, h) (((b) * 2 + (h)) * HTB)
#define PG8_SB(b, h) ((4 + (b) * 2 + (h)) * HTB)
#define PG8_STAGE(bufoff, gbase, voff) do { _Pragma("unroll") for (int _i = 0; _i < 2; ++_i) \
        __builtin_amdgcn_global_load_lds((const unsigned*)((const char*)(gbase) + (voff)[_i]), (PG8_LAS unsigned*)(lds + (bufoff) + ldsw + _i * 8192), 16, 0, 0); } while (0)
#define PG8_LDA(dst, b, h) do { _Pragma("unroll") for (int m = 0; m < 4; ++m) _Pragma("unroll") for (int k = 0; k < 2; ++k) dst[m][k] = *(const PG8_LAS bf16x8*)(lds + PG8_SA(b, h) + aoff + m * 2048 + k * 1024); } while (0)
#define PG8_LDB(dst, b, h) do { _Pragma("unroll") for (int n = 0; n < 2; ++n) _Pragma("unroll") for (int k = 0; k < 2; ++k) dst[n][k] = *(const PG8_LAS bf16x8*)(lds + PG8_SB(b, h) + boff + n * 2048 + k * 1024); } while (0)
#define PG8_MMA(ai, bj, At, Bt) do { __builtin_amdgcn_s_setprio(1); _Pragma("unroll") for (int m = 0; m < 4; ++m) _Pragma("unroll") for (int n = 0; n < 2; ++n) _Pragma("unroll") for (int k = 0; k < 2; ++k) \
        acc[ai][bj][m][n] = __builtin_amdgcn_mfma_f32_16x16x32_bf16(Bt[n][k], At[m][k], acc[ai][bj][m][n], 0, 0, 0); __builtin_amdgcn_s_setprio(0); } while (0)
#define PG8_WAIT_V(n) asm volatile("s_waitcnt vmcnt(" #n ")" ::: "memory")
#define PG8_WAIT_L(n) asm volatile("s_waitcnt lgkmcnt(" #n ")" ::: "memory")
#define PG8_BAR __builtin_amdgcn_s_barrier()
#define PG8_SCHED __builtin_amdgcn_sched_barrier(0)
    Unit cur, nxt; int ui = 0;
    if (!S.next(0, cur)) return;
    f32x4 acc[2][2][4][2];
#pragma unroll
    for (int a = 0; a < 2; ++a)
#pragma unroll
        for (int b = 0; b < 2; ++b)
#pragma unroll
            for (int m = 0; m < 4; ++m)
#pragma unroll
                for (int n = 0; n < 2; ++n) acc[a][b][m][n] = (f32x4){0.f, 0.f, 0.f, 0.f};
    bf16x8 At[4][2], B0[2][2], B1[2][2];
    const char* cA = PG8_ABASE(cur.pm); const char* cB = (const char*)g.Bt + (size_t)cur.pn * tstepB;
    PG8_STAGE(PG8_SB(0, 0), cB, voffB); PG8_STAGE(PG8_SB(0, 1), cB + hstepB, voffB); PG8_STAGE(PG8_SA(0, 0), cA, voffA); PG8_STAGE(PG8_SA(0, 1), cA + hstepA, voffA);
    if (wr == 1) PG8_BAR;
    PG8_WAIT_V(2); PG8_BAR;
    PG8_STAGE(PG8_SB(1, 0), cB + kstepB, voffB); PG8_STAGE(PG8_SA(1, 0), cA + kstepA, voffA); PG8_STAGE(PG8_SB(1, 1), cB + hstepB + kstepB, voffB);
    PG8_WAIT_V(6); PG8_BAR;
    for (;;) {
        const bool has_next = S.next(ui + 1, nxt);
        const char* nA = has_next ? PG8_ABASE(nxt.pm) : cA; const char* nB = has_next ? (const char*)g.Bt + (size_t)nxt.pn * tstepB : cB;
        for (int t = 0; t < nt; t += 2) {
            const bool last = (t == nt - 2);
            const char* a1 = cA + (size_t)(t + 1) * kstepA;
            const char* a2 = last ? nA : cA + (size_t)(t + 2) * kstepA; const char* b2 = last ? nB : cB + (size_t)(t + 2) * kstepB;
            const char* a3 = a2 + kstepA; const char* b3 = b2 + kstepB;
            PG8_LDB(B0, 0, 0); PG8_LDB(B1, 0, 1); PG8_SCHED; PG8_LDA(At, 0, 0); PG8_STAGE(PG8_SA(1, 1), a1 + hstepA, voffA);
            PG8_WAIT_V(8); PG8_WAIT_L(0); PG8_BAR; PG8_MMA(0, 0, At, B0); PG8_MMA(0, 1, At, B1); PG8_BAR; PG8_SCHED;
            PG8_LDA(At, 0, 1); PG8_STAGE(PG8_SB(0, 0), b2, voffB); PG8_STAGE(PG8_SB(0, 1), b2 + hstepB, voffB); PG8_STAGE(PG8_SA(0, 0), a2, voffA);
            PG8_WAIT_V(8); PG8_WAIT_L(0); PG8_BAR; PG8_MMA(1, 0, At, B0); PG8_MMA(1, 1, At, B1); PG8_BAR; PG8_SCHED;
            PG8_LDB(B0, 1, 0); PG8_LDB(B1, 1, 1); PG8_SCHED; PG8_LDA(At, 1, 0); PG8_STAGE(PG8_SA(0, 1), a2 + hstepA, voffA);
            PG8_WAIT_V(8); PG8_WAIT_L(0); PG8_BAR; PG8_MMA(0, 0, At, B0); PG8_MMA(0, 1, At, B1); PG8_BAR; PG8_SCHED;
            PG8_LDA(At, 1, 1); PG8_STAGE(PG8_SB(1, 0), b3, voffB); PG8_STAGE(PG8_SB(1, 1), b3 + hstepB, voffB); PG8_STAGE(PG8_SA(1, 0), a3, voffA);
            PG8_WAIT_V(8); PG8_WAIT_L(0); PG8_BAR; PG8_MMA(1, 0, At, B0); PG8_MMA(1, 1, At, B1); PG8_BAR; PG8_SCHED;
        }
        if constexpr (ALIGN_EPI) { if (wr == 0) PG8_BAR; }
        if constexpr (!Epi::AFTER_DRAIN) { E(acc, cur, wr, wc, fr, fq); }
        if (!has_next) break;
#pragma unroll
        for (int a = 0; a < 2; ++a)
#pragma unroll
            for (int b = 0; b < 2; ++b)
#pragma unroll
                for (int m = 0; m < 4; ++m)
#pragma unroll
                    for (int n = 0; n < 2; ++n) acc[a][b][m][n] = (f32x4){0.f, 0.f, 0.f, 0.f};
        cur = nxt; cA = nA; cB = nB; ++ui;
        if constexpr (ALIGN_EPI) { if (wr == 1) PG8_BAR; }
    }
    PG8_WAIT_V(0);
    if constexpr (!ALIGN_EPI) { if (wr == 0) PG8_BAR; }
    PG8_BAR;
    if constexpr (Epi::AFTER_DRAIN) { E.fused(acc, cur, wr, wc, fr, fq, lds, wid, lane); }
#undef PG8_ABASE
#undef PG8_SA
#undef PG8_SB
#undef PG8_STAGE
#undef PG8_LDA
#undef PG8_LDB
#undef PG8_MMA
#undef PG8_WAIT_V
#undef PG8_WAIT_L
#undef PG8_BAR
#undef PG8_SCHED
}
}

#ifndef MK_PROBE_N
#define MK_PROBE_N 0
#endif
#ifndef MK_P1_ROLES
#define MK_P1_ROLES 15
#endif
#ifndef MK_PROBE_PRO
#define MK_PROBE_PRO 0
#endif
#ifndef MK_PROBE_KIND
#define MK_PROBE_KIND 3
#endif
#ifndef MK_PROBE_PARTS
#define MK_PROBE_PARTS 15
#endif

namespace mk {
using pg8::bf16_t; using pg8::f32x4; using pg8::u32x4; using pg8::u32x2; using pg8::cvt_pk_bf16;
#define LAS __attribute__((address_space(3)))
constexpr int NB = 4, T = 4096, D = 1024, NTOK = NB * T, INC = 2328, INP = 2560, FF = 4096;
constexpr size_t MiB = 1u << 20;
constexpr size_t WS_CTL = 0;
constexpr size_t WS_W = 1 * MiB, W_LAYER = 30 * MiB;
constexpr size_t W_IN = 0, W_OUT = 5 * MiB, W_MQ = 7 * MiB, W_MKV = 8 * MiB, W_MO = 10 * MiB, W_FF1 = 11 * MiB, W_FF2 = 19 * MiB, W_C1 = 27 * MiB, W_C2 = 29 * MiB, W_SG = 29 * MiB + 128 * 1024, W_B1P = 29 * MiB + 512 * 1024;
constexpr size_t WS_XB = 61 * MiB;
constexpr size_t WS_OV = 93 * MiB;
constexpr size_t WS_U = WS_OV, WS_V = WS_OV + 16 * MiB, WS_Q = WS_OV + 32 * MiB, WS_KV = WS_OV + 48 * MiB, WS_MIX = WS_OV + 72 * MiB, WS_QM = WS_OV + 104 * MiB, WS_OM = WS_OV + 120 * MiB;
constexpr size_t WS_HB = WS_OV;
constexpr size_t WS_SM = 229 * MiB;
constexpr size_t WS_GL = WS_SM, WS_KC = WS_SM + 2 * MiB, WS_VC = WS_KC + 256 * 1024, WS_HID = WS_SM + 3 * MiB, WS_MASK = WS_SM + 5 * MiB, WS_MEMB = WS_SM + 6 * MiB, WS_KVM = WS_SM + 8 * MiB, WS_END = WS_SM + 10 * MiB;
constexpr size_t WS_SSQP = 240 * MiB;
static_assert(WS_END <= WS_SSQP && WS_SSQP + 6 * MiB <= 256 * MiB, "ws map");
constexpr int SSQ_MEM_OFF = 6 * NTOK;

struct Args { const float* in[27]; float* out; unsigned char* ws; int ph_lo, ph_hi; };
enum { I_X = 0, I_MEM, I_NMG, I_WIN, I_SGLNG, I_SGLNB, I_SGW, I_SGB, I_QNG, I_KNG, I_CPOS, I_CW1, I_CB1, I_CW2, I_CB2, I_MOG, I_WOUT, I_NMEMG, I_MKVG, I_WMQ, I_WMKV, I_MQG, I_MKG, I_WMO, I_NFG, I_WFF1, I_WFF2 };

__device__ __forceinline__ float bf2f(unsigned short b) { return __uint_as_float((unsigned)b << 16); }
__device__ __forceinline__ float wave_sum(float v) {
#pragma unroll
    for (int o = 1; o < 64; o <<= 1) v += __shfl_xor(v, o);
    return v; }

__device__ __forceinline__ void transpose_item(const float* W, int K, int N, int Npad, const float* gain, bf16_t* WT, LAS float* scr, int item, int lane, int ld = 0) {
    if (ld == 0) ld = N;
    const int nblk = Npad / 32, kb = item / nblk, nb = item % nblk, k0 = 64 * kb, n0 = 32 * nb;
    const int nn = n0 + (lane & 31); const int nnc = nn < N ? nn : N - 1; const float keep = nn < N ? 1.f : 0.f;
    const float* src = W + (size_t)(k0 + (lane >> 5)) * ld + nnc;
    float v[32];
#pragma unroll
    for (int i = 0; i < 32; ++i) v[i] = src[(size_t)(2 * i) * ld];
#pragma unroll
    for (int i = 0; i < 32; ++i) scr[(2 * i + (lane >> 5)) * 33 + (lane & 31)] = v[i] * keep;
    asm volatile("s_waitcnt lgkmcnt(0)" ::: "memory");
    const int c = lane & 7;
    f32x4 g0 = {1.f, 1.f, 1.f, 1.f}, g1 = {1.f, 1.f, 1.f, 1.f};
    if (gain) { g0 = *(const f32x4*)(gain + k0 + 8 * c); g1 = *(const f32x4*)(gain + k0 + 8 * c + 4); }
#pragma unroll
    for (int j = 0; j < 4; ++j) { const int n = (lane >> 3) + 8 * j; const LAS float* sp = scr + (8 * c) * 33 + n;
        u32x4 o; o.x = cvt_pk_bf16(sp[0 * 33] * g0[0], sp[1 * 33] * g0[1]); o.y = cvt_pk_bf16(sp[2 * 33] * g0[2], sp[3 * 33] * g0[3]); o.z = cvt_pk_bf16(sp[4 * 33] * g1[0], sp[5 * 33] * g1[1]); o.w = cvt_pk_bf16(sp[6 * 33] * g1[2], sp[7 * 33] * g1[3]);
        *(u32x4*)(WT + (size_t)(n0 + n) * K + k0 + 8 * c) = o; }
    asm volatile("s_waitcnt lgkmcnt(0)" ::: "memory");
}

constexpr int CV_IN = 16 * 80, CV_OUT = 16 * 32, CV_MQ = 16 * 16, CV_MKV = 16 * 32, CV_MO = 8 * 32, CV_FF1 = 16 * 128, CV_FF2 = 64 * 32, CV_C1 = 32 * 8, CV_C2 = 4 * 2;
constexpr int CV_TR = CV_IN + CV_OUT + CV_MQ + CV_MKV + CV_MO + CV_FF1 + CV_FF2 + 2 * CV_C1 + 2 * CV_C2, CV_B1 = 64, CV_SG = 1024, CONV_ITEMS = CV_TR + CV_B1 + CV_SG;
__device__ __forceinline__ void convert_layer(const Args& a, int l, int it_lo, int it_hi, int gwl, int ngwl, LAS float* scr, int lane_) {
    unsigned char* ws = a.ws; unsigned char* wl = ws + WS_W + l * W_LAYER;
#pragma unroll 1
    for (int it = it_lo + gwl; it < it_hi; it += ngwl) {
        int r = it; int lane = lane_; asm volatile("" : "+v"(lane));
        if (r < CV_IN) { transpose_item(a.in[I_WIN] + (size_t)l * 1024 * INC, 1024, INC, INP, a.in[I_NMG] + l * 1024, (bf16_t*)(wl + W_IN), scr, r, lane); continue; } r -= CV_IN;
        if (r < CV_OUT) { transpose_item(a.in[I_WOUT] + (size_t)l * 1024 * 1024, 1024, 1024, 1024, a.in[I_MOG] + l * 1024, (bf16_t*)(wl + W_OUT), scr, r, lane); continue; } r -= CV_OUT;
        if (r < CV_MQ) { transpose_item(a.in[I_WMQ] + (size_t)l * 1024 * 512, 1024, 512, 512, a.in[I_NMEMG] + l * 1024, (bf16_t*)(wl + W_MQ), scr, r, lane); continue; } r -= CV_MQ;
        if (r < CV_MKV) { transpose_item(a.in[I_WMKV] + (size_t)l * 1024 * 1024, 1024, 1024, 1024, a.in[I_MKVG] + l * 1024, (bf16_t*)(wl + W_MKV), scr, r, lane); continue; } r -= CV_MKV;
        if (r < CV_MO) { transpose_item(a.in[I_WMO] + (size_t)l * 512 * 1024, 512, 1024, 1024, (const float*)nullptr, (bf16_t*)(wl + W_MO), scr, r, lane); continue; } r -= CV_MO;
        if (r < CV_FF1) { transpose_item(a.in[I_WFF1] + (size_t)l * 1024 * 4096, 1024, 4096, 4096, a.in[I_NFG] + l * 1024, (bf16_t*)(wl + W_FF1), scr, r, lane); continue; } r -= CV_FF1;
        if (r < CV_FF2) { transpose_item(a.in[I_WFF2] + (size_t)l * 4096 * 1024, 4096, 1024, 1024, (const float*)nullptr, (bf16_t*)(wl + W_FF2), scr, r, lane); continue; } r -= CV_FF2;
        if (r < 2 * CV_C1) {
            const int kv = r / CV_C1, r2 = r % CV_C1, sub = r2 >> 6, half = sub >> 1, tb = sub & 1;
            transpose_item(a.in[I_CW1] + (size_t)(l * 2 + kv) * 2048 * 256 + (size_t)tb * 1024 * 256 + half * 128, 1024, 128, 128, (const float*)nullptr,
                           (bf16_t*)(wl + W_C1 + (size_t)kv * 512 * 1024 * 2) + (size_t)(half * 256 + tb * 128) * 1024, scr, r2 & 63, lane, 256); continue; } r -= 2 * CV_C1;
        if (r < 2 * CV_C2) { const int kv = r / CV_C2; transpose_item(a.in[I_CW2] + (size_t)(l * 2 + kv) * 256 * 64, 256, 64, 64, (const float*)nullptr, (bf16_t*)(wl + W_C2 + (size_t)kv * 64 * 256 * 2), scr, r % CV_C2, lane); continue; } r -= 2 * CV_C2;
        if (r < CV_B1) {
            const int lk = l * 2 + (r >> 5), j0 = (r & 31) * 8; const float* W1 = a.in[I_CW1] + (size_t)lk * 2048 * 256 + j0; const float* pos = a.in[I_CPOS] + (size_t)lk * 2048;
            float acc[8];
#pragma unroll
            for (int e = 0; e < 8; ++e) acc[e] = 0.f;
#pragma unroll 8
            for (int i = 0; i < 32; ++i) { const int k = i * 64 + lane; const float p = pos[k]; const f32x4 w0 = *(const f32x4*)(W1 + (size_t)k * 256), w1 = *(const f32x4*)(W1 + (size_t)k * 256 + 4);
#pragma unroll
                for (int e = 0; e < 4; ++e) { acc[e] += p * w0[e]; acc[4 + e] += p * w1[e]; } }
#pragma unroll
            for (int e = 0; e < 8; ++e) acc[e] = wave_sum(acc[e]);
            if (lane == 0) { float* dst = (float*)(wl + W_B1P) + (lk & 1) * 256 + j0;
#pragma unroll
                for (int e = 0; e < 8; ++e) dst[e] = acc[e] + a.in[I_CB1][lk * 256 + j0 + e]; }
            continue; } r -= CV_B1;
        {
            const int t = r & 127; const float* wr = a.in[I_SGW] + ((size_t)l * 1024 + r) * 128; unsigned* dst = (unsigned*)(wl + W_SG) + (size_t)r * 64 + lane; float v[2];
#pragma unroll
            for (int e = 0; e < 2; ++e) { const int p = lane * 2 + e, ks = p >> 4, hh = (p >> 3) & 1, j = p & 7, sidx = 16 * ks + 8 * (j >> 2) + 4 * hh + (j & 3); v[e] = wr[sidx <= t ? sidx : t]; v[e] = sidx <= t ? v[e] : 0.f; }
            *dst = cvt_pk_bf16(v[0], v[1]); }
    }
}
constexpr int CONV_SPLIT = CONV_ITEMS / 2;
__device__ __forceinline__ void prologue(const Args& a, LAS unsigned char* lds, int gw, int NGW, int wave, int lane) {
    LAS float* scr = (LAS float*)(lds + wave * 16384);
    unsigned char* ws = a.ws; float* ctl = (float*)(ws + WS_CTL);
    convert_layer(a, 0, 0, CONV_ITEMS, gw, NGW, scr, lane);
    { const float* x = a.in[I_X]; bf16_t* XB = (bf16_t*)(ws + WS_XB);
      for (int r = gw; r < NTOK; r += NGW) { const f32x4* xr = (const f32x4*)(x + (size_t)r * 1024) + lane; unsigned long long* xb = (unsigned long long*)(XB + (size_t)r * 1024) + lane; float s = 0.f;
#pragma unroll
          for (int j = 0; j < 4; ++j) { const f32x4 v = xr[64 * j]; s += (v[0] * v[0] + v[1] * v[1]) + (v[2] * v[2] + v[3] * v[3]); xb[64 * j] = (unsigned long long)cvt_pk_bf16(v[0], v[1]) | ((unsigned long long)cvt_pk_bf16(v[2], v[3]) << 32); }
          s = wave_sum(s); if (lane < 16) ((float*)(ws + WS_SSQP))[(size_t)r * 16 + lane] = lane == 0 ? s : 0.f; } }
    { const float* mem = a.in[I_MEM]; bf16_t* MB = (bf16_t*)(ws + WS_MEMB);
      for (int r = gw; r < 1024; r += NGW) { const f32x4* xr = (const f32x4*)(mem + (size_t)r * 1024) + lane; unsigned long long* xb = (unsigned long long*)(MB + (size_t)r * 1024) + lane; float s = 0.f;
#pragma unroll
          for (int j = 0; j < 4; ++j) { const f32x4 v = xr[64 * j]; s += (v[0] * v[0] + v[1] * v[1]) + (v[2] * v[2] + v[3] * v[3]); xb[64 * j] = (unsigned long long)cvt_pk_bf16(v[0], v[1]) | ((unsigned long long)cvt_pk_bf16(v[2], v[3]) << 32); }
          s = wave_sum(s); if (lane == 0) ctl[SSQ_MEM_OFF + r] = s; } }
}

typedef float f32x16 __attribute__((ext_vector_type(16)));
typedef short s16x4 __attribute__((ext_vector_type(4)));
typedef short v4i16_t __attribute__((ext_vector_type(4)));
using pg8::bf16x8;
__device__ __forceinline__ int crow(int r, int hi) { return (r & 3) + 8 * (r >> 2) + 4 * hi; }
__device__ __forceinline__ s16x4 vtr(const LAS char* p) { return __builtin_bit_cast(s16x4, __builtin_amdgcn_ds_read_tr16_b64_v4i16((LAS v4i16_t*)p)); }
#define MFMA32(a, b, c) __builtin_amdgcn_mfma_f32_32x32x16_bf16(a, b, c, 0, 0, 0)
#define VFRAG(lo, hi) (bf16x8){lo[0], lo[1], lo[2], lo[3], hi[0], hi[1], hi[2], hi[3]}
__device__ __forceinline__ void lds_fadd(LAS float* p, float v) { (void)__hip_atomic_fetch_add(p, v, __ATOMIC_RELAXED, __HIP_MEMORY_SCOPE_WORKGROUP); }
__device__ __forceinline__ unsigned short f2bf(float f) { return (unsigned short)(cvt_pk_bf16(f, 0.f) & 0xffffu); }

__device__ __forceinline__ void tokprep_token(bf16_t* Q, bf16_t* KV, const float* qg, const float* kg, int tok, int lane) {
    { u32x4* p = (u32x4*)(Q + (size_t)tok * 512) + lane; const u32x4 w = *p; float v[8];
#pragma unroll
      for (int i = 0; i < 4; ++i) { v[2 * i] = __uint_as_float(w[i] << 16); v[2 * i + 1] = __uint_as_float(w[i] & 0xffff0000u); }
      float ss = 0.f;
#pragma unroll
      for (int i = 0; i < 8; ++i) ss += v[i] * v[i];
      ss += __shfl_xor(ss, 1); ss += __shfl_xor(ss, 2); ss += __shfl_xor(ss, 4);
      const float rs = rsqrtf(ss * (1.f / 64.f) + 1e-6f) * (0.125f * 1.4426950408889634f); const float* g = qg + (lane & 7) * 8;
      u32x4 o;
#pragma unroll
      for (int i = 0; i < 4; ++i) o[i] = cvt_pk_bf16(v[2 * i] * rs * g[2 * i], v[2 * i + 1] * rs * g[2 * i + 1]);
      *p = o; }
    if (lane < 32) { const int br = 1 + (lane >> 4); u32x4* p = (u32x4*)(KV + (size_t)tok * 768 + br * 256) + (lane & 15); const u32x4 w = *p; float v[8];
#pragma unroll
      for (int i = 0; i < 4; ++i) { v[2 * i] = __uint_as_float(w[i] << 16); v[2 * i + 1] = __uint_as_float(w[i] & 0xffff0000u); }
      float ss = 0.f;
#pragma unroll
      for (int i = 0; i < 8; ++i) ss += v[i] * v[i];
      ss += __shfl_xor(ss, 1); ss += __shfl_xor(ss, 2); ss += __shfl_xor(ss, 4);
      const float rs = rsqrtf(ss * (1.f / 64.f) + 1e-6f); const float* g = kg + br * 64 + (lane & 7) * 8;
      u32x4 o;
#pragma unroll
      for (int i = 0; i < 4; ++i) o[i] = cvt_pk_bf16(v[2 * i] * rs * g[2 * i], v[2 * i + 1] * rs * g[2 * i + 1]);
      *p = o; }
}
__device__ __forceinline__ void cmp2_row(const bf16_t* HID, const bf16_t* w2t, const float* b2, const float* kg0, bf16_t* KC, bf16_t* VC, int row, int lane) {
#pragma unroll 1
    for (int kv = 0; kv < 2; ++kv) { const u32x4* h = (const u32x4*)(HID + (size_t)kv * 2048 * 256 + (size_t)row * 256); const u32x4* w = (const u32x4*)(w2t + (size_t)kv * 64 * 256 + (size_t)lane * 256); float s = b2[kv * 64 + lane];
#pragma unroll 4
        for (int k = 0; k < 32; ++k) { const u32x4 a = h[k], b = w[k];
#pragma unroll
            for (int i = 0; i < 4; ++i) s += __uint_as_float(a[i] << 16) * __uint_as_float(b[i] << 16) + __uint_as_float(a[i] & 0xffff0000u) * __uint_as_float(b[i] & 0xffff0000u); }
        if (kv == 0) { const float ss = wave_sum(s * s); s = s * rsqrtf(ss * (1.f / 64.f) + 1e-6f) * kg0[lane]; }
        if ((row & 255) == 255) s = 0.f;
        (kv ? VC : KC)[(size_t)row * 64 + lane] = f2bf(s); }
}
__device__ __forceinline__ void memk_norm_item(bf16_t* KVM, const float* kg, int r, int lane) {
    unsigned* p = (unsigned*)(KVM + (size_t)(r >> 2) * 1024 + (r & 3) * 128) + lane; const unsigned w = *p; const float v0 = __uint_as_float(w << 16), v1 = __uint_as_float(w & 0xffff0000u);
    const float ss = wave_sum(v0 * v0 + v1 * v1); const float rs = rsqrtf(ss * (1.f / 128.f) + 1e-6f); *p = cvt_pk_bf16(v0 * rs * kg[2 * lane], v1 * rs * kg[2 * lane + 1]);
}

__device__ __forceinline__ void tokprep4(bf16_t* Q, bf16_t* KV, const float* qg, const float* kg, int t, int S, int lane) {
    u32x4 wq[4], wk[4]; const int br = 1 + ((lane >> 4) & 1);
#pragma unroll
    for (int i = 0; i < 4; ++i) { const int tt = t + i * S < NTOK ? t + i * S : NTOK - 1; wq[i] = *((const u32x4*)(Q + (size_t)tt * 512) + lane); wk[i] = *((const u32x4*)(KV + (size_t)tt * 768 + br * 256) + (lane & 15)); }
    f32x4 gq0 = *(const f32x4*)(qg + (lane & 7) * 8), gq1 = *(const f32x4*)(qg + (lane & 7) * 8 + 4), gk0 = *(const f32x4*)(kg + br * 64 + (lane & 7) * 8), gk1 = *(const f32x4*)(kg + br * 64 + (lane & 7) * 8 + 4);
#pragma unroll
    for (int i = 0; i < 4; ++i) { if (t + i * S >= NTOK) break; const int tt = t + i * S;
        { const u32x4 w = wq[i]; float v[8];
#pragma unroll
          for (int e = 0; e < 4; ++e) { v[2 * e] = __uint_as_float(w[e] << 16); v[2 * e + 1] = __uint_as_float(w[e] & 0xffff0000u); }
          float ss = 0.f;
#pragma unroll
          for (int e = 0; e < 8; ++e) ss += v[e] * v[e];
          ss += __shfl_xor(ss, 1); ss += __shfl_xor(ss, 2); ss += __shfl_xor(ss, 4);
          const float rs = rsqrtf(ss * (1.f / 64.f) + 1e-6f) * (0.125f * 1.4426950408889634f);
          u32x4 o; o[0] = cvt_pk_bf16(v[0] * rs * gq0[0], v[1] * rs * gq0[1]); o[1] = cvt_pk_bf16(v[2] * rs * gq0[2], v[3] * rs * gq0[3]); o[2] = cvt_pk_bf16(v[4] * rs * gq1[0], v[5] * rs * gq1[1]); o[3] = cvt_pk_bf16(v[6] * rs * gq1[2], v[7] * rs * gq1[3]);
          *((u32x4*)(Q + (size_t)tt * 512) + lane) = o; }
        { const u32x4 w = wk[i]; float v[8];
#pragma unroll
          for (int e = 0; e < 4; ++e) { v[2 * e] = __uint_as_float(w[e] << 16); v[2 * e + 1] = __uint_as_float(w[e] & 0xffff0000u); }
          float ss = 0.f;
#pragma unroll
          for (int e = 0; e < 8; ++e) ss += v[e] * v[e];
          ss += __shfl_xor(ss, 1); ss += __shfl_xor(ss, 2); ss += __shfl_xor(ss, 4);
          const float rs = rsqrtf(ss * (1.f / 64.f) + 1e-6f);
          u32x4 o; o[0] = cvt_pk_bf16(v[0] * rs * gk0[0], v[1] * rs * gk0[1]); o[1] = cvt_pk_bf16(v[2] * rs * gk0[2], v[3] * rs * gk0[3]); o[2] = cvt_pk_bf16(v[4] * rs * gk1[0], v[5] * rs * gk1[1]); o[3] = cvt_pk_bf16(v[6] * rs * gk1[2], v[7] * rs * gk1[3]);
          if (lane < 32) *((u32x4*)(KV + (size_t)tt * 768 + br * 256) + (lane & 15)) = o; } }
}
__device__ __forceinline__ void cmp2_tile(const bf16_t* HIDt, const bf16_t* w2t, const float* b2, const float* kg0, bf16_t* OUT) {
    int tid_ = threadIdx.x; asm volatile("" : "+v"(tid_)); const int lane = tid_ & 63, wave = __builtin_amdgcn_readfirstlane(tid_ >> 6), r32 = lane & 31, hi = lane >> 5; const int row = wave * 32 + r32;
    f32x16 acc[2];
#pragma unroll
    for (int r = 0; r < 16; ++r) { acc[0][r] = 0.f; acc[1][r] = 0.f; }
    bf16x8 bfr[16], a0[8], a1[8];
#pragma unroll
    for (int ks = 0; ks < 16; ++ks) bfr[ks] = *(const bf16x8*)(HIDt + (size_t)row * 256 + ks * 16 + hi * 8);
#pragma unroll
    for (int half = 0; half < 2; ++half) {
#pragma unroll
        for (int k8 = 0; k8 < 8; ++k8) { const int ks = half * 8 + k8; a0[k8] = *(const bf16x8*)(w2t + (size_t)r32 * 256 + ks * 16 + hi * 8); a1[k8] = *(const bf16x8*)(w2t + (size_t)(32 + r32) * 256 + ks * 16 + hi * 8); }
#pragma unroll
        for (int k8 = 0; k8 < 8; ++k8) { acc[0] = MFMA32(a0[k8], bfr[half * 8 + k8], acc[0]); acc[1] = MFMA32(a1[k8], bfr[half * 8 + k8], acc[1]); } }
    float bv[2][16], gv[2][16];
#pragma unroll
    for (int h = 0; h < 2; ++h)
#pragma unroll
        for (int r = 0; r < 16; ++r) { bv[h][r] = b2[32 * h + crow(r, hi)]; gv[h][r] = kg0 ? kg0[32 * h + crow(r, hi)] : 1.f; }
    float ss = 0.f;
#pragma unroll
    for (int h = 0; h < 2; ++h)
#pragma unroll
        for (int r = 0; r < 16; ++r) { const float v = acc[h][r] + bv[h][r]; acc[h][r] = v; ss += v * v; }
    if (kg0) { ss += __shfl_xor(ss, 32); const float rs = rsqrtf(ss * (1.f / 64.f) + 1e-6f);
#pragma unroll
        for (int h = 0; h < 2; ++h)
#pragma unroll
            for (int r = 0; r < 16; ++r) acc[h][r] *= rs * gv[h][r]; }
    const float keep = row == 255 ? 0.f : 1.f;
#pragma unroll
    for (int h = 0; h < 2; ++h)
#pragma unroll
        for (int a4 = 0; a4 < 4; ++a4) { u32x2 w; w.x = cvt_pk_bf16(acc[h][4 * a4] * keep, acc[h][4 * a4 + 1] * keep); w.y = cvt_pk_bf16(acc[h][4 * a4 + 2] * keep, acc[h][4 * a4 + 3] * keep); *(u32x2*)(OUT + (size_t)row * 64 + 32 * h + 8 * a4 + 4 * hi) = w; }
}

constexpr int SG_STAT = 0, SG_SSQ = 1024, SG_VN = 5120;
__device__ __forceinline__ void sgu_unit(LAS unsigned char* lds, int unit, const bf16_t* U, const bf16_t* Vb, const bf16_t* Wsg, const float* lng, const float* lnb, const float* sgb, bf16_t* MIX) {
    int tid_ = threadIdx.x; asm volatile("" : "+v"(tid_)); const int tid = tid_, lane = tid & 63, g = __builtin_amdgcn_readfirstlane(tid >> 6), r32 = lane & 31, hi = lane >> 5;
    const int tok0 = unit * 128;
    LAS float* STAT = (LAS float*)(lds + SG_STAT); LAS float* SSQA = (LAS float*)(lds + SG_SSQ);
    { const int tl = tid >> 2, part = tid & 3; const u32x4* p = (const u32x4*)(Vb + (size_t)(tok0 + tl) * 512 + part * 128); float s = 0.f, s2 = 0.f;
#pragma unroll 4
      for (int i = 0; i < 16; ++i) { const u32x4 w = p[i];
#pragma unroll
          for (int e = 0; e < 4; ++e) { const float a = __uint_as_float(w[e] << 16), b = __uint_as_float(w[e] & 0xffff0000u); s += a + b; s2 += a * a + b * b; } }
      s += __shfl_xor(s, 1); s += __shfl_xor(s, 2); s2 += __shfl_xor(s2, 1); s2 += __shfl_xor(s2, 2);
      if (part == 0) { const float mu = s * (1.f / 512.f); const float var = fmaxf(s2 * (1.f / 512.f) - mu * mu, 0.f); STAT[tl * 2] = mu; STAT[tl * 2 + 1] = rsqrtf(var + 1e-6f); }
      }
    __syncthreads();
    LAS unsigned char* VN = lds + SG_VN + g * 16384;
    { const int piece = lane & 7; float gg[8], bb[8];
#pragma unroll
      for (int i = 0; i < 8; ++i) { gg[i] = lng[g * 64 + piece * 8 + i]; bb[i] = lnb[g * 64 + piece * 8 + i]; }
      u32x4 wv[16];
#pragma unroll
      for (int it = 0; it < 16; ++it) wv[it] = *(const u32x4*)(Vb + (size_t)(tok0 + it * 8 + (lane >> 3)) * 512 + g * 64 + piece * 8);
#pragma unroll
      for (int it = 0; it < 16; ++it) { const int row = it * 8 + (lane >> 3); const u32x4 w = wv[it]; const float mu = STAT[row * 2], rs = STAT[row * 2 + 1]; u32x4 o;
#pragma unroll
          for (int e = 0; e < 4; ++e) { const float a = (__uint_as_float(w[e] << 16) - mu) * rs * gg[2 * e] + bb[2 * e], b = (__uint_as_float(w[e] & 0xffff0000u) - mu) * rs * gg[2 * e + 1] + bb[2 * e + 1]; o[e] = cvt_pk_bf16(a, b); }
          *(LAS u32x4*)(VN + (piece >> 2) * 8192 + row * 64 + (piece & 3) * 16) = o; } }
    asm volatile("s_waitcnt lgkmcnt(0)" ::: "memory");
    f32x16 acc[2][4];
#pragma unroll
    for (int dh = 0; dh < 2; ++dh)
#pragma unroll
        for (int mt = 0; mt < 4; ++mt)
#pragma unroll
            for (int r = 0; r < 16; ++r) acc[dh][mt][r] = 0.f;
    const LAS char* vb = (const LAS char*)VN + ((lane >> 4) & 1) * 32 + (lane & 3) * 8 + (4 * hi + ((lane & 15) >> 2)) * 64;
    const bf16_t* wrow = Wsg + ((size_t)g * 128 + r32) * 128 + 8 * hi;
    bf16x8 wf[2][4];
#pragma unroll
    for (int mt = 0; mt < 4; ++mt) wf[0][mt] = *(const bf16x8*)(wrow + (size_t)mt * 32 * 128);
#pragma unroll
    for (int ks = 0; ks < 8; ++ks) { bf16x8 vf[2];
        if (ks < 7) {
#pragma unroll
            for (int mt = 0; mt < 4; ++mt) if (ks + 1 <= 2 * mt + 1) wf[(ks + 1) & 1][mt] = *(const bf16x8*)(wrow + (size_t)mt * 32 * 128 + (ks + 1) * 16); }
#pragma unroll
        for (int dh = 0; dh < 2; ++dh) { const s16x4 lo = vtr(vb + dh * 8192 + ks * 1024), hh = vtr(vb + dh * 8192 + ks * 1024 + 512); vf[dh] = VFRAG(lo, hh); }
#pragma unroll
        for (int mt = 0; mt < 4; ++mt) { if (ks <= 2 * mt + 1) { acc[0][mt] = MFMA32(vf[0], wf[ks & 1][mt], acc[0][mt]); acc[1][mt] = MFMA32(vf[1], wf[ks & 1][mt], acc[1][mt]); } } }
#pragma unroll
    for (int mt = 0; mt < 4; ++mt) { const int t = mt * 32 + r32; const float bias = sgb[g * 128 + t]; const bf16_t* up = U + (size_t)(tok0 + t) * 512 + g * 64 + 4 * hi; float ss = 0.f;
#pragma unroll
        for (int dh = 0; dh < 2; ++dh)
#pragma unroll
            for (int a4 = 0; a4 < 4; ++a4) { const u32x2 w = *(const u32x2*)(up + dh * 32 + a4 * 8);
                const float u0 = __uint_as_float(w.x << 16), u1 = __uint_as_float(w.x & 0xffff0000u), u2 = __uint_as_float(w.y << 16), u3 = __uint_as_float(w.y & 0xffff0000u);
                float x0 = u0 * (acc[dh][mt][4 * a4] + bias), x1 = u1 * (acc[dh][mt][4 * a4 + 1] + bias), x2 = u2 * (acc[dh][mt][4 * a4 + 2] + bias), x3 = u3 * (acc[dh][mt][4 * a4 + 3] + bias);
                acc[dh][mt][4 * a4] = x0; acc[dh][mt][4 * a4 + 1] = x1; acc[dh][mt][4 * a4 + 2] = x2; acc[dh][mt][4 * a4 + 3] = x3; ss += (x0 * x0 + x1 * x1) + (x2 * x2 + x3 * x3); }
        ss += __shfl_xor(ss, 32); if (hi == 0) SSQA[g * 128 + t] = ss; }
    __syncthreads();
#pragma unroll
    for (int mt = 0; mt < 4; ++mt) { const int t = mt * 32 + r32; float sa = 0.f;
#pragma unroll
        for (int w8 = 0; w8 < 8; ++w8) sa += SSQA[w8 * 128 + t];
        const float rs = rsqrtf(sa * (1.f / 512.f) + 1e-6f); bf16_t* op = MIX + (size_t)(tok0 + t) * 1024 + g * 64 + 4 * hi;
#pragma unroll
        for (int dh = 0; dh < 2; ++dh)
#pragma unroll
            for (int a4 = 0; a4 < 4; ++a4) { u32x2 w; w.x = cvt_pk_bf16(acc[dh][mt][4 * a4] * rs, acc[dh][mt][4 * a4 + 1] * rs); w.y = cvt_pk_bf16(acc[dh][mt][4 * a4 + 2] * rs, acc[dh][mt][4 * a4 + 3] * rs); *(u32x2*)(op + dh * 32 + a4 * 8) = w; } }
    __syncthreads();
}

constexpr int A_KB = 0, A_VB = 32768, A_IMPH = 65536, A_LINV = 132096, A_MASK = 133120, A_SSQ = 133632  ;
__device__ __forceinline__ void attn_cmp(LAS unsigned char* lds, const bf16_t* Kb, const bf16_t* Vb, int ntc, const bf16x8 (&qr)[4], f32x16 (&oT)[2], float& lsum,
                                         int kmin, int kmax, int kvh, int wave, int lane, int r32, int hi) {
    const int pitch = 64, hstride = 256 * 64;
    u32x4 sk0, sk1, sv0, sv1;
    const bf16_t* kthr = Kb + (size_t)lane * pitch + wave * 8; const bf16_t* vthr = Vb + (size_t)(16 * (wave & 3) + (lane >> 2)) * pitch + (wave >> 2) * 32 + (lane & 3) * 8;
    const int sdst = wave * 1024 + lane * 16;
#define A_LD(tile) do { const size_t to_ = (size_t)(tile) * 64 * pitch; sk0 = *(const u32x4*)(kthr + to_); sk1 = *(const u32x4*)(kthr + to_ + hstride); sv0 = *(const u32x4*)(vthr + to_); sv1 = *(const u32x4*)(vthr + to_ + hstride); } while (0)
#define A_ST(so) do { *(LAS u32x4*)(lds + A_KB + (so) + sdst) = sk0; *(LAS u32x4*)(lds + A_KB + (so) + 8192 + sdst) = sk1; *(LAS u32x4*)(lds + A_VB + (so) + sdst) = sv0; *(LAS u32x4*)(lds + A_VB + (so) + 8192 + sdst) = sv1; } while (0)
    const LAS char* kbase = (const LAS char*)(lds + A_KB) + kvh * 8192 + hi * 1024 + r32 * 16;
    const LAS char* vbase = (const LAS char*)(lds + A_VB) + kvh * 8192 + ((lane >> 4) & 1) * 32 + (lane & 3) * 8 + (4 * hi + ((lane & 15) >> 2)) * 64;
    LAS float* IMPH = (LAS float*)(lds + A_IMPH) + (wave * 32 + r32) * 65;
    float carry = 0.f;
    A_LD(0); A_ST(0); __syncthreads();
#pragma unroll 1
    for (int tile = 0; tile < ntc; ++tile) {
        const int so = (tile & 1) * 16384;
        if (tile + 1 < ntc) A_LD(tile + 1);
        bf16x8 kf[8];
#pragma unroll
        for (int d0 = 0; d0 < 4; ++d0) { kf[2 * d0] = *(const LAS bf16x8*)(kbase + so + d0 * 2048); kf[2 * d0 + 1] = *(const LAS bf16x8*)(kbase + so + d0 * 2048 + 512); }
        f32x16 p0, p1;
#pragma unroll
        for (int r = 0; r < 16; ++r) { p0[r] = 0.f; p1[r] = 0.f; }
#pragma unroll
        for (int d0 = 0; d0 < 4; ++d0) { p0 = MFMA32(kf[2 * d0], qr[d0], p0); p1 = MFMA32(kf[2 * d0 + 1], qr[d0], p1); }
        const int a = kmin - 64 * tile, bb = kmax - 64 * tile;
#pragma unroll
        for (int r = 0; r < 16; ++r) { p0[r] = __builtin_amdgcn_exp2f(p0[r]); p1[r] = __builtin_amdgcn_exp2f(p1[r]); }
        if (!__all(a <= 0 && bb >= 63)) { const unsigned span = (unsigned)(bb - a);
#pragma unroll
            for (int r = 0; r < 16; ++r) { const int rel = crow(r, hi); p0[r] = ((unsigned)(rel - a) <= span) ? p0[r] : 0.f; p1[r] = ((unsigned)(rel + 32 - a) <= span) ? p1[r] : 0.f; } }
        { float s = 0.f;
#pragma unroll
          for (int r = 0; r < 16; ++r) s += p0[r] + p1[r];
          lsum += s; }
        { float own[2][4], rcv[2][4];
#pragma unroll
          for (int a4 = 0; a4 < 4; ++a4) { const float h0 = 0.5f * p0[4 * a4 + 3], h1 = 0.5f * p1[4 * a4 + 3];
              own[0][a4] = (p0[4 * a4] + p0[4 * a4 + 1]) + (p0[4 * a4 + 2] + h0); own[1][a4] = (p1[4 * a4] + p1[4 * a4 + 1]) + (p1[4 * a4 + 2] + h1);
              rcv[0][a4] = __shfl_xor(h0, 32); rcv[1][a4] = __shfl_xor(h1, 32); }
#pragma unroll
          for (int h2 = 0; h2 < 2; ++h2)
#pragma unroll
              for (int a4 = 0; a4 < 4; ++a4) { const float fromprev = a4 > 0 ? rcv[h2][a4 - 1] : (h2 ? rcv[0][3] : carry);
                  IMPH[16 * tile + 8 * h2 + 2 * a4 + hi] = own[h2][a4] + (hi ? rcv[h2][a4] : fromprev); }
          carry = rcv[1][3]; }
        bf16x8 pa[4];
        { u32x4 w0, w1, w2, w3;
#pragma unroll
          for (int i = 0; i < 4; ++i) { w0[i] = cvt_pk_bf16(p0[2 * i], p0[2 * i + 1]); w1[i] = cvt_pk_bf16(p0[8 + 2 * i], p0[8 + 2 * i + 1]); w2[i] = cvt_pk_bf16(p1[2 * i], p1[2 * i + 1]); w3[i] = cvt_pk_bf16(p1[8 + 2 * i], p1[8 + 2 * i + 1]); }
          pa[0] = __builtin_bit_cast(bf16x8, w0); pa[1] = __builtin_bit_cast(bf16x8, w1); pa[2] = __builtin_bit_cast(bf16x8, w2); pa[3] = __builtin_bit_cast(bf16x8, w3); }
#pragma unroll
        for (int dh = 0; dh < 2; ++dh)
#pragma unroll
            for (int ks = 0; ks < 4; ++ks) { const s16x4 lo = vtr(vbase + so + dh * 4096 + ks * 1024), hh = vtr(vbase + so + dh * 4096 + ks * 1024 + 512); oT[dh] = MFMA32(VFRAG(lo, hh), pa[ks], oT[dh]); }
        if (tile + 1 < ntc) A_ST(so ^ 16384);
        __syncthreads();
    }
#undef A_LD
#undef A_ST
}

constexpr int A2_K = 0, A2_V = 49152, A2_SL = 16384;
#define SBAR() __builtin_amdgcn_sched_barrier(0)
#define PIN(x) asm volatile("" : "+v"(x))
#define WAIT_BAR(N) asm volatile("s_waitcnt vmcnt(" #N ") lgkmcnt(0)\n\ts_barrier" ::: "memory")
__device__ __forceinline__ void glds16(const void* g, unsigned lds_base) {
    unsigned sv; asm volatile("s_mov_b32 %0, m0\n\ts_mov_b32 m0, %2\n\ts_nop 0\n\tglobal_load_lds_dwordx4 %1, off\n\ts_mov_b32 m0, %0" : "=&s"(sv) : "v"(g), "s"(lds_base) : "memory"); }
__device__ __forceinline__ void range_mask(f32x16& c0, f32x16& c1, int a, int bb, int hi) {
    const unsigned span = (unsigned)(bb - a);
#pragma unroll
    for (int r = 0; r < 16; ++r) { const int rel = crow(r, hi); c0[r] = ((unsigned)(rel - a) <= span) ? c0[r] : -INFINITY; c1[r] = ((unsigned)(rel + 32 - a) <= span) ? c1[r] : -INFINITY; }
}
template <bool WIN>
__device__ __forceinline__ void attn_stream(LAS unsigned char* lds, const bf16_t* Kb, const bf16_t* Vb, int tlo, int NT, const bf16x8 (&qr)[4], f32x16 (&oT)[2], float& l_out,
                                            unsigned mlo, unsigned mhi, int tq, int kvh, int wave, int lane, int r32, int hi) {
    const unsigned lds0 = (unsigned)(uintptr_t)lds;
    const bf16_t* ksrc = Kb + (size_t)lane * 768 + wave * 8;
    const bf16_t* vsrc = Vb + (size_t)(16 * (wave & 3) + (lane >> 2)) * 768 + (wave >> 2) * 32 + (lane & 3) * 8;
    const unsigned kdst = lds0 + A2_K + wave * 1024, vdst = lds0 + A2_V + wave * 1024;
#define RFL(x) ((unsigned)__builtin_amdgcn_readfirstlane((int)(x)))
#define TCL(i) ((size_t)(tlo + ((i) < NT ? (i) : NT - 1)) * (64 * 768))
#define DMA_K(i, slot) do { const bf16_t* s_ = ksrc + TCL(i); glds16(s_, RFL(kdst + (slot))); glds16(s_ + 64, RFL(kdst + (slot) + 8192)); } while (0)
#define DMA_V(i, slot) do { const bf16_t* s_ = vsrc + TCL(i); glds16(s_, RFL(vdst + (slot))); glds16(s_ + 64, RFL(vdst + (slot) + 8192)); } while (0)
#define TMASK(idx_, a_, bb_, selm_) do { const int tt_ = tlo + (idx_); if (WIN) { a_ = tq - 511 - 64 * tt_; bb_ = tq - 64 * tt_; selm_ = ~0u; } \
        else { const unsigned s_ = tt_ < 32 ? (mlo >> tt_) & 1u : (mhi >> (tt_ - 32)) & 1u; a_ = -64 * tt_; bb_ = tq - 64 * tt_; selm_ = 0u - s_; } } while (0)
#define NEEDM(a_, bb_, selm_) (!__all((selm_) == 0u || ((a_) <= 0 && (bb_) >= 63)))
    const LAS char* kp0 = (const LAS char*)(lds + A2_K) + kvh * 8192 + hi * 1024 + r32 * 16;
    const LAS char* vp0 = (const LAS char*)(lds + A2_V) + kvh * 8192 + ((lane >> 4) & 1) * 32 + (lane & 3) * 8 + (4 * hi + ((lane & 15) >> 2)) * 64;
    asm volatile("s_waitcnt vmcnt(0)" ::: "memory");
    DMA_K(0, 0); DMA_V(0, 0); DMA_K(1, A2_SL); DMA_K(2, 2 * A2_SL);
    float l_reg = 0.f; f32x16 pA0, pA1, pB0, pB1; bf16x8 kf[8]; s16x4 vlo[8], vhi[8]; u32x4 pw0, pw1, pw2, pw3; unsigned selm_prev;
    const f32x16 zero16 = {0.f, 0.f, 0.f, 0.f, 0.f, 0.f, 0.f, 0.f, 0.f, 0.f, 0.f, 0.f, 0.f, 0.f, 0.f, 0.f};
    int sl_prev = 0, sl_cur = 0, sl_next = A2_SL;
#define ROT() do { sl_prev = sl_cur; sl_cur = sl_next; sl_next = (sl_next == 2 * A2_SL) ? 0 : sl_next + A2_SL; } while (0)
#define KLD(kp, d0) do { kf[2 * (d0)] = *(const LAS bf16x8*)((kp) + (d0) * 2048); kf[2 * (d0) + 1] = *(const LAS bf16x8*)((kp) + (d0) * 2048 + 512); } while (0)
    WAIT_BAR(6);
    KLD(kp0, 0); KLD(kp0, 1); KLD(kp0, 2); KLD(kp0, 3);
    pA0 = MFMA32(kf[0], qr[0], zero16); pA1 = MFMA32(kf[1], qr[0], zero16); pA0 = MFMA32(kf[2], qr[1], pA0); pA1 = MFMA32(kf[3], qr[1], pA1);
    pA0 = MFMA32(kf[4], qr[2], pA0); pA1 = MFMA32(kf[5], qr[2], pA1); pA0 = MFMA32(kf[6], qr[3], pA0); pA1 = MFMA32(kf[7], qr[3], pA1);
    { int a_, bb_; TMASK(0, a_, bb_, selm_prev); if (NEEDM(a_, bb_, selm_prev)) range_mask(pA0, pA1, a_, bb_, hi); }
#pragma unroll
    for (int r = 0; r < 16; ++r) { pA0[r] = __builtin_amdgcn_exp2f(pA0[r]); pA1[r] = __builtin_amdgcn_exp2f(pA1[r]); }
    WAIT_BAR(0);
    DMA_K(3, 0); DMA_V(1, A2_SL); ROT();
    KLD(kp0 + sl_cur, 0); KLD(kp0 + sl_cur, 1); KLD(kp0 + sl_cur, 2); KLD(kp0 + sl_cur, 3);
    WAIT_BAR(4);
#define PKW(P, i) cvt_pk_bf16(P[i], P[(i) + 1])
#define PAF(k) __builtin_bit_cast(bf16x8, pw##k)
#define VFR(i) VFRAG(vlo[i], vhi[i])
#define VRD(i) do { vlo[i] = vtr(vp_ + (((i) >> 2) * 4096 + ((i) & 3) * 1024)); vhi[i] = vtr(vp_ + (((i) >> 2) * 4096 + ((i) & 3) * 1024 + 512)); } while (0)
#define KRD(d0) do { KLD(kp0 + sl_next, d0); SBAR(); } while (0)
#define EX(v) __builtin_amdgcn_exp2f(v)
#define GAPA(MF, a0, a1, a2, a3, W0, W1, PW) do { MF; sacc += a0; sacc += a1; sacc += a2; sacc += a3; W0; W1; PIN(PW); PIN(sacc); SBAR(); } while (0)
#define GAPB(MF, X, i) do { MF; X[i] = EX(X[i]); X[(i) + 1] = EX(X[(i) + 1]); X[(i) + 2] = EX(X[(i) + 2]); X[(i) + 3] = EX(X[(i) + 3]); PIN(X); SBAR(); } while (0)
#define SELPW() do { if (!__all(selm_prev == ~0u)) { const u32x4 m_ = {selm_prev, selm_prev, selm_prev, selm_prev}; pw0 = pw0 & m_; pw1 = pw1 & m_; pw2 = pw2 & m_; pw3 = pw3 & m_; } } while (0)
#define STEP(C0, C1, P0, P1, idx) do { SBAR(); \
    const LAS char* vp_ = vp0 + sl_prev; \
    VRD(0); SBAR(); float sacc = P0[0] + P0[1]; \
                    GAPA(C0 = MFMA32(kf[0], qr[0], zero16), P0[2], P0[3], P0[4], P0[5],     pw0[0] = PKW(P0, 0),  pw0[1] = PKW(P0, 2),  pw0); \
    VRD(4); SBAR(); GAPA(C1 = MFMA32(kf[1], qr[0], zero16), P0[6], P0[7], P0[8], P0[9],     pw0[2] = PKW(P0, 4),  pw0[3] = PKW(P0, 6),  pw0); \
    VRD(1); SBAR(); GAPA(C0 = MFMA32(kf[2], qr[1], C0),     P0[10], P0[11], P0[12], P0[13], pw1[0] = PKW(P0, 8),  pw1[1] = PKW(P0, 10), pw1); \
    VRD(5); SBAR(); GAPA(C1 = MFMA32(kf[3], qr[1], C1),     P0[14], P0[15], P1[0], P1[1],   pw1[2] = PKW(P0, 12), pw1[3] = PKW(P0, 14), pw1); \
    VRD(2); SBAR(); GAPA(C0 = MFMA32(kf[4], qr[2], C0),     P1[2], P1[3], P1[4], P1[5],     pw2[0] = PKW(P1, 0),  pw2[1] = PKW(P1, 2),  pw2); \
    VRD(6); SBAR(); GAPA(C1 = MFMA32(kf[5], qr[2], C1),     P1[6], P1[7], P1[8], P1[9],     pw2[2] = PKW(P1, 4),  pw2[3] = PKW(P1, 6),  pw2); \
    VRD(3); SBAR(); GAPA(C0 = MFMA32(kf[6], qr[3], C0),     P1[10], P1[11], P1[12], P1[13], pw3[0] = PKW(P1, 8),  pw3[1] = PKW(P1, 10), pw3); \
    VRD(7); SBAR(); GAPA(C1 = MFMA32(kf[7], qr[3], C1),     P1[14], P1[15], 0.f, 0.f,       pw3[2] = PKW(P1, 12), pw3[3] = PKW(P1, 14), pw3); \
    l_reg += __uint_as_float(__float_as_uint(sacc) & selm_prev); SELPW(); \
    DMA_K((idx) + 3, sl_cur); DMA_V((idx) + 1, sl_next); \
    { int a_, bb_; unsigned selm_; TMASK(idx, a_, bb_, selm_); if (NEEDM(a_, bb_, selm_)) range_mask(C0, C1, a_, bb_, hi); selm_prev = selm_; } \
    SBAR(); \
    GAPB(oT[0] = MFMA32(VFR(0), PAF(0), oT[0]), C0, 0);            GAPB(oT[1] = MFMA32(VFR(4), PAF(0), oT[1]), C0, 4); \
    KRD(0); GAPB(oT[0] = MFMA32(VFR(1), PAF(1), oT[0]), C0, 8);    KRD(1); GAPB(oT[1] = MFMA32(VFR(5), PAF(1), oT[1]), C0, 12); \
    KRD(2); GAPB(oT[0] = MFMA32(VFR(2), PAF(2), oT[0]), C1, 0);    KRD(3); GAPB(oT[1] = MFMA32(VFR(6), PAF(2), oT[1]), C1, 4); \
    GAPB(oT[0] = MFMA32(VFR(3), PAF(3), oT[0]), C1, 8);            GAPB(oT[1] = MFMA32(VFR(7), PAF(3), oT[1]), C1, 12); \
    } while (0)
    int idx = 1;
#pragma unroll 1
    for (; idx + 1 < NT; idx += 2) {
        STEP(pB0, pB1, pA0, pA1, idx);     WAIT_BAR(4); ROT();
        STEP(pA0, pA1, pB0, pB1, idx + 1); WAIT_BAR(4); ROT();
    }
    if (idx < NT) { STEP(pB0, pB1, pA0, pA1, idx); WAIT_BAR(4); ROT(); pA0 = pB0; pA1 = pB1; }
    { float sacc = 0.f;
#pragma unroll
      for (int r = 0; r < 16; ++r) sacc += pA0[r] + pA1[r];
      l_reg += __uint_as_float(__float_as_uint(sacc) & selm_prev);
      pw0 = (u32x4){PKW(pA0, 0), PKW(pA0, 2), PKW(pA0, 4), PKW(pA0, 6)}; pw1 = (u32x4){PKW(pA0, 8), PKW(pA0, 10), PKW(pA0, 12), PKW(pA0, 14)};
      pw2 = (u32x4){PKW(pA1, 0), PKW(pA1, 2), PKW(pA1, 4), PKW(pA1, 6)}; pw3 = (u32x4){PKW(pA1, 8), PKW(pA1, 10), PKW(pA1, 12), PKW(pA1, 14)};
      SELPW();
      const LAS char* vp_ = vp0 + ((NT - 1) % 3) * A2_SL;
#pragma unroll
      for (int i = 0; i < 8; ++i) VRD(i);
      oT[0] = MFMA32(VFR(0), PAF(0), oT[0]); oT[1] = MFMA32(VFR(4), PAF(0), oT[1]); oT[0] = MFMA32(VFR(1), PAF(1), oT[0]); oT[1] = MFMA32(VFR(5), PAF(1), oT[1]);
      oT[0] = MFMA32(VFR(2), PAF(2), oT[0]); oT[1] = MFMA32(VFR(6), PAF(2), oT[1]); oT[0] = MFMA32(VFR(3), PAF(3), oT[0]); oT[1] = MFMA32(VFR(7), PAF(3), oT[1]); }
    WAIT_BAR(0);
    l_out = l_reg;
#undef RFL
#undef TCL
#undef DMA_K
#undef DMA_V
#undef TMASK
#undef NEEDM
#undef ROT
#undef KLD
#undef PKW
#undef PAF
#undef VFR
#undef VRD
#undef KRD
#undef EX
#undef GAPA
#undef GAPB
#undef SELPW
#undef STEP
}

template <int PARTS>
__device__ __forceinline__ void attn_unit(LAS unsigned char* lds, int b, int qt, const bf16_t* Q, const bf16_t* KV, const bf16_t* KC, const bf16_t* VC, const float* GL, bf16_t* MIX) {
    int tid_ = threadIdx.x; asm volatile("" : "+v"(tid_)); const int tid = tid_, lane = tid & 63, wave = __builtin_amdgcn_readfirstlane(tid >> 6), r32 = lane & 31, hi = lane >> 5, kvh = wave >> 2;
    const int t0 = qt * 32, tq = t0 + r32; const size_t tok = (size_t)b * T + tq;
    bf16x8 qr[4];
#pragma unroll
    for (int d0 = 0; d0 < 4; ++d0) qr[d0] = *(const bf16x8*)(Q + tok * 512 + wave * 64 + d0 * 16 + hi * 8);
    LAS float* IMPHA = (LAS float*)(lds + A_IMPH); LAS float* LINV = (LAS float*)(lds + A_LINV); LAS unsigned* MASKL = (LAS unsigned*)(lds + A_MASK); LAS float* SSQL = (LAS float*)(lds + A_SSQ);
    const float* glp = GL + tok * 24 + wave * 3;
    const float g0 = 1.f / (1.f + __expf(-glp[0])), g1 = 1.f / (1.f + __expf(-glp[1])), g2 = 1.f / (1.f + __expf(-glp[2]));
    f32x16 tot[2], oT[2];
    const int nvalid = tq >= 31 ? (tq - 31) / 16 + 1 : 0; const int ntc = (2 * qt + 1 + 63) >> 6;
    const int ckmin = nvalid > 0 ? 0 : (1 << 20), ckmax = nvalid > 0 ? nvalid - 1 : (1 << 20);
    const bf16_t* KCb = KC + (size_t)(b * 2) * 256 * 64; const bf16_t* VCb = VC + (size_t)(b * 2) * 256 * 64;
    float lc = 0.f;
#pragma unroll
    for (int r = 0; r < 16; ++r) { oT[0][r] = 0.f; oT[1][r] = 0.f; }
    if constexpr (PARTS & 1) attn_cmp(lds, KCb, VCb, ntc, qr, oT, lc, ckmin, ckmax, kvh, wave, lane, r32, hi);
    lc += __shfl_xor(lc, 32); const float inv_lc = lc > 0.f ? 1.f / lc : 0.f;
    if (hi == 0) LINV[wave * 32 + r32] = inv_lc;
    { const float c = g0 * inv_lc;
#pragma unroll
      for (int r = 0; r < 16; ++r) { tot[0][r] = oT[0][r] * c; tot[1][r] = oT[1][r] * c; oT[0][r] = 0.f; oT[1][r] = 0.f; } }
    __syncthreads();
    if constexpr (PARTS & 2) {
#pragma unroll 1
      for (int i = 0; i < 8; ++i) { const int pair = wave * 8 + i, kvp = pair >> 5, qq = pair & 31, j = lane; const int tb = (t0 + qq) >> 6; float v = 0.f;
#pragma unroll
          for (int g = 0; g < 4; ++g) v += IMPHA[((kvp * 4 + g) * 32 + qq) * 65 + j] * LINV[(kvp * 4 + g) * 32 + qq];
          const bool forced = (j == 0) || (j == tb) || (j == tb - 1); const float val = forced ? 1e4f : (j <= tb ? v : -1e4f);
          unsigned key = __float_as_uint(val); key ^= (key & 0x80000000u) ? 0xffffffffu : 0x80000000u; key = (key & ~63u) | (unsigned)(63 - j);
          unsigned prefix = 0u;
#pragma unroll
          for (int bit = 31; bit >= 0; --bit) { const unsigned tt = prefix | (1u << bit); const int cnt = __popcll(__ballot(key >= tt)); prefix = cnt >= 16 ? tt : prefix; }
          const unsigned long long m = __ballot(key >= prefix);
          if (lane == 0) { MASKL[pair * 2] = (unsigned)m; MASKL[pair * 2 + 1] = (unsigned)(m >> 32); } } }
    __syncthreads();
    const unsigned mlo = MASKL[(kvh * 32 + r32) * 2], mhi = MASKL[(kvh * 32 + r32) * 2 + 1];
    const int jmax = (t0 + 31) >> 6;
    const bf16_t* KVb = KV + (size_t)b * T * 768;
    unsigned totp[16];
#pragma unroll
    for (int i = 0; i < 8; ++i) { totp[i] = cvt_pk_bf16(tot[0][2 * i], tot[0][2 * i + 1]); totp[8 + i] = cvt_pk_bf16(tot[1][2 * i], tot[1][2 * i + 1]); }
    float ls = 0.f;
    if constexpr (PARTS & 4) attn_stream<false>(lds, KVb + 256, KVb + 384, 0, jmax + 1, qr, oT, ls, mlo, mhi, tq, kvh, wave, lane, r32, hi);
    ls += __shfl_xor(ls, 32);
    { const float c = ls > 0.f ? g1 / ls : 0.f;
#pragma unroll
      for (int i = 0; i < 8; ++i) { totp[i] = cvt_pk_bf16(__uint_as_float(totp[i] << 16) + oT[0][2 * i] * c, __uint_as_float(totp[i] & 0xffff0000u) + oT[0][2 * i + 1] * c);
                                    totp[8 + i] = cvt_pk_bf16(__uint_as_float(totp[8 + i] << 16) + oT[1][2 * i] * c, __uint_as_float(totp[8 + i] & 0xffff0000u) + oT[1][2 * i + 1] * c); }
#pragma unroll
      for (int r = 0; r < 16; ++r) { oT[0][r] = 0.f; oT[1][r] = 0.f; } }
    float lw = 0.f; const int jlo = t0 >= 511 ? (t0 - 511) >> 6 : 0;
    if constexpr (PARTS & 8) attn_stream<true>(lds, KVb + 512, KVb + 640, jlo, jmax - jlo + 1, qr, oT, lw, 0u, 0u, tq, kvh, wave, lane, r32, hi);
    lw += __shfl_xor(lw, 32);
    { const float c = lw > 0.f ? g2 / lw : 0.f;
#pragma unroll
      for (int i = 0; i < 8; ++i) { tot[0][2 * i] = __uint_as_float(totp[i] << 16) + oT[0][2 * i] * c; tot[0][2 * i + 1] = __uint_as_float(totp[i] & 0xffff0000u) + oT[0][2 * i + 1] * c;
                                    tot[1][2 * i] = __uint_as_float(totp[8 + i] << 16) + oT[1][2 * i] * c; tot[1][2 * i + 1] = __uint_as_float(totp[8 + i] & 0xffff0000u) + oT[1][2 * i + 1] * c; } }
    { float ss = 0.f;
#pragma unroll
      for (int r = 0; r < 16; ++r) ss += tot[0][r] * tot[0][r] + tot[1][r] * tot[1][r];
      ss += __shfl_xor(ss, 32); if (hi == 0) SSQL[wave * 32 + r32] = ss; }
    __syncthreads();
    { float sa = 0.f;
#pragma unroll
      for (int w8 = 0; w8 < 8; ++w8) sa += SSQL[w8 * 32 + r32];
      const float rs = rsqrtf(sa * (1.f / 512.f) + 1e-6f); bf16_t* op = MIX + tok * 1024 + 512 + wave * 64 + 4 * hi;
#pragma unroll
      for (int dh = 0; dh < 2; ++dh)
#pragma unroll
          for (int a4 = 0; a4 < 4; ++a4) { u32x2 w; w.x = cvt_pk_bf16(tot[dh][4 * a4] * rs, tot[dh][4 * a4 + 1] * rs); w.y = cvt_pk_bf16(tot[dh][4 * a4 + 2] * rs, tot[dh][4 * a4 + 3] * rs); *(u32x2*)(op + dh * 32 + a4 * 8) = w; } }
    __syncthreads();
}

__device__ __forceinline__ void memattn_unit(LAS unsigned char* lds, int b, int h, int qt, const bf16_t* QM, const bf16_t* KVM, const float* qg, bf16_t* OM) {
    int tid_ = threadIdx.x; asm volatile("" : "+v"(tid_)); const int tid = tid_, lane = tid & 63, wave = __builtin_amdgcn_readfirstlane(tid >> 6), r32 = lane & 31, hi = lane >> 5;
    const size_t tok = (size_t)b * T + qt * 256 + wave * 32 + r32;
    bf16x8 qr[8];
    { float v[64]; float ss = 0.f;
#pragma unroll
      for (int d0 = 0; d0 < 8; ++d0) { const u32x4 w = *(const u32x4*)(QM + tok * 512 + h * 128 + d0 * 16 + hi * 8);
#pragma unroll
          for (int i = 0; i < 4; ++i) { const float a = __uint_as_float(w[i] << 16), c = __uint_as_float(w[i] & 0xffff0000u); v[d0 * 8 + 2 * i] = a; v[d0 * 8 + 2 * i + 1] = c; ss += a * a + c * c; } }
      ss += __shfl_xor(ss, 32); const float rs = rsqrtf(ss * (1.f / 128.f) + 1e-6f) * (0.08838834764831845f * 1.4426950408889634f);
#pragma unroll
      for (int d0 = 0; d0 < 8; ++d0) { u32x4 w; const float* gp = qg + d0 * 16 + hi * 8;
#pragma unroll
          for (int i = 0; i < 4; ++i) w[i] = cvt_pk_bf16(v[d0 * 8 + 2 * i] * rs * gp[2 * i], v[d0 * 8 + 2 * i + 1] * rs * gp[2 * i + 1]);
          qr[d0] = __builtin_bit_cast(bf16x8, w); } }
    const bf16_t* Kg = KVM + (size_t)b * 256 * 1024 + h * 128; const bf16_t* Vg = Kg + 512;
    u32x4 sk[2], sv[2];
#define M_LD(tile) do { _Pragma("unroll") for (int i = 0; i < 2; ++i) { sk[i] = *(const u32x4*)(Kg + (size_t)((tile) * 64 + lane) * 1024 + (wave * 2 + i) * 8); const int p = i * 512 + tid; \
        sv[i] = *(const u32x4*)(Vg + (size_t)((tile) * 64 + ((p & 255) >> 2)) * 1024 + (p >> 8) * 32 + (p & 3) * 8); } } while (0)
#define M_ST(so) do { _Pragma("unroll") for (int i = 0; i < 2; ++i) { *(LAS u32x4*)(lds + (so) + (wave * 2 + i) * 1024 + lane * 16) = sk[i]; *(LAS u32x4*)(lds + 32768 + (so) + (i * 512 + tid) * 16) = sv[i]; } } while (0)
    const LAS char* kbase = (const LAS char*)lds + hi * 1024 + r32 * 16;
    const LAS char* vbase = (const LAS char*)lds + 32768 + ((lane >> 4) & 1) * 32 + (lane & 3) * 8 + (4 * hi + ((lane & 15) >> 2)) * 64;
    f32x16 oT[4]; float lsum = 0.f;
#pragma unroll
    for (int dq = 0; dq < 4; ++dq)
#pragma unroll
        for (int r = 0; r < 16; ++r) oT[dq][r] = 0.f;
    M_LD(0); M_ST(0); __syncthreads();
#pragma unroll 1
    for (int tile = 0; tile < 4; ++tile) { const int so = (tile & 1) * 16384;
        if (tile < 3) M_LD(tile + 1);
        f32x16 p0, p1;
#pragma unroll
        for (int r = 0; r < 16; ++r) { p0[r] = 0.f; p1[r] = 0.f; }
#pragma unroll
        for (int d0 = 0; d0 < 8; ++d0) { const bf16x8 k0 = *(const LAS bf16x8*)(kbase + so + d0 * 2048), k1 = *(const LAS bf16x8*)(kbase + so + d0 * 2048 + 512); p0 = MFMA32(k0, qr[d0], p0); p1 = MFMA32(k1, qr[d0], p1); }
        float s = 0.f;
#pragma unroll
        for (int r = 0; r < 16; ++r) { p0[r] = __builtin_amdgcn_exp2f(p0[r]); p1[r] = __builtin_amdgcn_exp2f(p1[r]); s += p0[r] + p1[r]; }
        lsum += s;
        bf16x8 pa[4];
        { u32x4 w0, w1, w2, w3;
#pragma unroll
          for (int i = 0; i < 4; ++i) { w0[i] = cvt_pk_bf16(p0[2 * i], p0[2 * i + 1]); w1[i] = cvt_pk_bf16(p0[8 + 2 * i], p0[8 + 2 * i + 1]); w2[i] = cvt_pk_bf16(p1[2 * i], p1[2 * i + 1]); w3[i] = cvt_pk_bf16(p1[8 + 2 * i], p1[8 + 2 * i + 1]); }
          pa[0] = __builtin_bit_cast(bf16x8, w0); pa[1] = __builtin_bit_cast(bf16x8, w1); pa[2] = __builtin_bit_cast(bf16x8, w2); pa[3] = __builtin_bit_cast(bf16x8, w3); }
#pragma unroll
        for (int dq = 0; dq < 4; ++dq)
#pragma unroll
            for (int ks = 0; ks < 4; ++ks) { const s16x4 lo = vtr(vbase + so + dq * 4096 + ks * 1024), hh = vtr(vbase + so + dq * 4096 + ks * 1024 + 512); oT[dq] = MFMA32(VFRAG(lo, hh), pa[ks], oT[dq]); }
        if (tile < 3) M_ST(so ^ 16384);
        __syncthreads();
    }
#undef M_LD
#undef M_ST
    lsum += __shfl_xor(lsum, 32); const float il = 1.f / lsum; bf16_t* op = OM + tok * 512 + h * 128 + 4 * hi;
#pragma unroll
    for (int dq = 0; dq < 4; ++dq)
#pragma unroll
        for (int a4 = 0; a4 < 4; ++a4) { u32x2 w; w.x = cvt_pk_bf16(oT[dq][4 * a4] * il, oT[dq][4 * a4 + 1] * il); w.y = cvt_pk_bf16(oT[dq][4 * a4 + 2] * il, oT[dq][4 * a4 + 3] * il); *(u32x2*)(op + dq * 32 + a4 * 8) = w; }
}

#define XB_TMO      128
#define XB_XCNT(j)  (256  + 64 * (j))
#define XB_XSUB(j)  (1280 + 64 * (j))
#define XB_XGEN(j)  (2304 + 64 * (j))
#define XB_TOP      3328
#define XB_TOPGEN   3392
#define XCD_BAR_WORDS 3456
#define XB_SPIN_CAP (1u << 18)
__device__ __forceinline__ unsigned xb_ld(unsigned* p)              { return __hip_atomic_load(p, __ATOMIC_RELAXED, __HIP_MEMORY_SCOPE_AGENT); }
__device__ __forceinline__ unsigned xb_add(unsigned* p, unsigned v) { return __hip_atomic_fetch_add(p, v, __ATOMIC_RELAXED, __HIP_MEMORY_SCOPE_AGENT); }
__device__ __forceinline__ unsigned xb_xcc_id() { return (unsigned)__builtin_amdgcn_s_getreg((3 << 11) | 20) & 0xFu; }
#define XB_SPIN(cond, bar) do { unsigned _sp = 0; while (cond) { __builtin_amdgcn_s_sleep(1); \
    if ((++_sp & 255u) == 0u) { if (xb_ld(&(bar)[XB_TMO])) break; if (_sp > XB_SPIN_CAP) { atomicAdd(&(bar)[XB_TMO], 1u); break; } } } } while (0)
struct XcdBarrier { unsigned* bar; unsigned x; volatile LAS unsigned* st; };
__device__ __forceinline__ XcdBarrier xcd_barrier_post(unsigned* bar, volatile LAS unsigned* st) {
    XcdBarrier b; b.bar = bar; b.x = xb_xcc_id(); b.st = st;
    if (threadIdx.x == 0) (void)xb_add(&bar[XB_XCNT(b.x)], 1u);
    return b;
}
__device__ __forceinline__ void xcd_barrier_complete(unsigned* bar, unsigned x, unsigned& nloc, unsigned& nx) {
    const unsigned G = gridDim.x * gridDim.y * gridDim.z;
    unsigned sum, cnt, mine, sp = 0u;
    for (;;) {
        sum = 0u; cnt = 0u; mine = 0u;
#pragma unroll
        for (unsigned j = 0; j < 16; ++j) { const unsigned c = xb_ld(&bar[XB_XCNT(j)]); sum += c; cnt += (c > 0u) ? 1u : 0u; mine = (j == x) ? c : mine; }
        if (sum == G) break;
        __builtin_amdgcn_s_sleep(1);
        if ((++sp & 255u) == 0u) { if (xb_ld(&bar[XB_TMO])) break; if (sp > XB_SPIN_CAP) { atomicAdd(&bar[XB_TMO], 1u); break; } }
    }
    nloc = mine > 0u ? mine : 1u; nx = cnt > 0u ? cnt : 1u;
}
__device__ __forceinline__ void xcd_barrier(const XcdBarrier& b) {
    asm volatile("s_waitcnt vmcnt(0)" ::: "memory");
    __syncthreads();
    if (threadIdx.x == 0) {
        unsigned* bar = b.bar;
        __builtin_amdgcn_s_waitcnt(0);
        unsigned nloc = b.st[0], nx = b.st[1];
        if (nloc == 0u) { xcd_barrier_complete(bar, b.x, nloc, nx); b.st[0] = nloc; b.st[1] = nx; }
        const unsigned old = xb_add(&bar[XB_XSUB(b.x)], 1u);
        const unsigned gen = old / nloc;
        if (old + 1u == (gen + 1u) * nloc) {
            __builtin_amdgcn_fence(__ATOMIC_RELEASE, "agent");
            asm volatile("s_waitcnt vmcnt(0)" ::: "memory");
            const unsigned og = xb_add(&bar[XB_TOP], 1u);
            const unsigned tg = og / nx;
            if (og + 1u == (tg + 1u) * nx) xb_add(&bar[XB_TOPGEN], 1u);
            else XB_SPIN(xb_ld(&bar[XB_TOPGEN]) == tg, bar);
            __builtin_amdgcn_fence(__ATOMIC_ACQUIRE, "agent");
            xb_add(&bar[XB_XGEN(b.x)], 1u);
            asm volatile("s_waitcnt vmcnt(0)" ::: "memory");
        } else {
            XB_SPIN(xb_ld(&bar[XB_XGEN(b.x)]) == gen, bar);
            __builtin_amdgcn_fence(__ATOMIC_ACQUIRE, "agent");
            asm volatile("s_waitcnt vmcnt(0)" ::: "memory");
        }
    }
    __syncthreads();
}
constexpr size_t CTL_BAR_BYTE = 704 * 1024;
constexpr size_t CTL_FLAG_BYTE = 720 * 1024;
constexpr int LDS_ST_OFF = 147456 - 64;

struct EpiCmp {
    static constexpr bool PERM = false, AFTER_DRAIN = true;
    const float* b1p; const bf16_t* w2t; const float* b2; const float* kg0; bf16_t* OUT; float* PART; unsigned* flag; unsigned epoch; int half;
    __device__ __forceinline__ void fused(f32x4 (&acc)[2][2][4][2], const pg8::Unit&, int wr, int wc, int fr, int fq, LAS unsigned char* lds, int wid, int lane) const {
        LAS float* PB = (LAS float*)lds;
        LAS unsigned char* HB = lds;
#pragma unroll
        for (int ai = 0; ai < 2; ++ai)
#pragma unroll
            for (int m = 0; m < 4; ++m) { const int row = ai * 128 + wr * 64 + m * 16 + fr;
#pragma unroll
                for (int n = 0; n < 2; ++n) *(LAS f32x4*)(PB + row * 132 + wc * 32 + n * 16 + 4 * fq) = acc[ai][1][m][n]; }
        __syncthreads();
        u32x2 hv[2][4][2];
#pragma unroll
        for (int ai = 0; ai < 2; ++ai)
#pragma unroll
            for (int m = 0; m < 4; ++m) { const int row = ai * 128 + wr * 64 + m * 16 + fr;
#pragma unroll
                for (int n = 0; n < 2; ++n) { const int col = wc * 32 + n * 16 + 4 * fq; f32x4 pb = {0.f, 0.f, 0.f, 0.f}; if (row < 255) pb = *(const LAS f32x4*)(PB + (row + 1) * 132 + col);
                    const f32x4 bb = *(const f32x4*)(b1p + half * 128 + col); const f32x4 v = acc[ai][0][m][n] + pb + bb;
                    hv[ai][m][n].x = cvt_pk_bf16(pg8::gelu_tanh(v[0]), pg8::gelu_tanh(v[1])); hv[ai][m][n].y = cvt_pk_bf16(pg8::gelu_tanh(v[2]), pg8::gelu_tanh(v[3])); } }
        __syncthreads();
#pragma unroll
        for (int ai = 0; ai < 2; ++ai)
#pragma unroll
            for (int m = 0; m < 4; ++m) { const int row = ai * 128 + wr * 64 + m * 16 + fr;
#pragma unroll
                for (int n = 0; n < 2; ++n) *(LAS u32x2*)(HB + row * 272 + (wc * 32 + n * 16 + 4 * fq) * 2) = hv[ai][m][n]; }
        __syncthreads();
        const int r32 = lane & 31, hi = lane >> 5, row = wid * 32 + r32;
        bf16x8 a0[8], a1[8], bf[8];
#pragma unroll
        for (int ks = 0; ks < 8; ++ks) { a0[ks] = *(const bf16x8*)(w2t + (size_t)r32 * 256 + half * 128 + ks * 16 + hi * 8); a1[ks] = *(const bf16x8*)(w2t + (size_t)(32 + r32) * 256 + half * 128 + ks * 16 + hi * 8);
            bf[ks] = *(const LAS bf16x8*)(HB + row * 272 + (ks * 16 + hi * 8) * 2); }
        f32x16 o2[2];
#pragma unroll
        for (int r = 0; r < 16; ++r) { o2[0][r] = 0.f; o2[1][r] = 0.f; }
#pragma unroll
        for (int ks = 0; ks < 8; ++ks) { o2[0] = MFMA32(a0[ks], bf[ks], o2[0]); o2[1] = MFMA32(a1[ks], bf[ks], o2[1]); }
        float* pp = PART + (size_t)row * 64 + 4 * hi;
        if (half == 1) {
#pragma unroll
            for (int h = 0; h < 2; ++h)
#pragma unroll
                for (int a4 = 0; a4 < 4; ++a4) *(f32x4*)(pp + 32 * h + 8 * a4) = (f32x4){o2[h][4 * a4], o2[h][4 * a4 + 1], o2[h][4 * a4 + 2], o2[h][4 * a4 + 3]};
            asm volatile("s_waitcnt vmcnt(0)" ::: "memory"); __syncthreads();
            if (threadIdx.x == 0) { __builtin_amdgcn_fence(__ATOMIC_RELEASE, "agent"); asm volatile("s_waitcnt vmcnt(0)" ::: "memory"); __hip_atomic_store(flag, epoch, __ATOMIC_RELAXED, __HIP_MEMORY_SCOPE_AGENT); }
            return; }
        if (wid == 0) { unsigned sp = 0;
            while ((unsigned)__builtin_amdgcn_readfirstlane(__hip_atomic_load(flag, __ATOMIC_RELAXED, __HIP_MEMORY_SCOPE_AGENT)) < epoch) { __builtin_amdgcn_s_sleep(2); if (++sp > (1u << 22)) break; }
            __builtin_amdgcn_fence(__ATOMIC_ACQUIRE, "agent"); asm volatile("s_waitcnt vmcnt(0)" ::: "memory"); }
        __syncthreads();
        float ss = 0.f;
#pragma unroll
        for (int h = 0; h < 2; ++h)
#pragma unroll
            for (int a4 = 0; a4 < 4; ++a4) { const f32x4 pv = *(const f32x4*)(pp + 32 * h + 8 * a4); const f32x4 bv = *(const f32x4*)(b2 + 32 * h + 8 * a4 + 4 * hi);
#pragma unroll
                for (int e = 0; e < 4; ++e) { const float v = o2[h][4 * a4 + e] + pv[e] + bv[e]; o2[h][4 * a4 + e] = v; ss += v * v; } }
        if (kg0) { ss += __shfl_xor(ss, 32); const float rs = rsqrtf(ss * (1.f / 64.f) + 1e-6f);
#pragma unroll
            for (int h = 0; h < 2; ++h)
#pragma unroll
                for (int a4 = 0; a4 < 4; ++a4) { const f32x4 gv = *(const f32x4*)(kg0 + 32 * h + 8 * a4 + 4 * hi);
#pragma unroll
                    for (int e = 0; e < 4; ++e) o2[h][4 * a4 + e] *= rs * gv[e]; } }
        const float keep = row == 255 ? 0.f : 1.f;
#pragma unroll
        for (int h = 0; h < 2; ++h)
#pragma unroll
            for (int a4 = 0; a4 < 4; ++a4) { u32x2 w; w.x = cvt_pk_bf16(o2[h][4 * a4] * keep, o2[h][4 * a4 + 1] * keep); w.y = cvt_pk_bf16(o2[h][4 * a4 + 2] * keep, o2[h][4 * a4 + 3] * keep); *(u32x2*)(OUT + (size_t)row * 64 + 32 * h + 8 * a4 + 4 * hi) = w; }
    }
};

template <bool PROBE>
__device__ __forceinline__ void do_phase(const int p, const int l, const Args& args, LAS unsigned char* lds, const int G, const int bx, const int NGW) {
    unsigned char* ws = args.ws; float* xout = args.out; asm volatile("" : "+s"(ws), "+s"(xout));
    int tidp = threadIdx.x; asm volatile("" : "+v"(tidp)); const int lane = tidp & 63, wave = __builtin_amdgcn_readfirstlane(tidp >> 6), gw = bx * 8 + wave; (void)lane; (void)gw; (void)NGW;
    float* ctl = (float*)(ws + WS_CTL); bf16_t* XB = (bf16_t*)(ws + WS_XB); float* ssqp = (float*)(ws + WS_SSQP);
    unsigned char* wl = ws + WS_W + l * W_LAYER;
    if (p == 0) {
        pg8::Gemm g = pg8::make_gemm(XB, (const bf16_t*)(wl + W_IN), 1024); pg8::StaticOrder S; S.init(NTOK, INP, G, bx);
        pg8::EpiInProj E{(bf16_t*)(ws + WS_U), (bf16_t*)(ws + WS_V), (bf16_t*)(ws + WS_Q), (bf16_t*)(ws + WS_KV), (float*)(ws + WS_GL), ssqp + (size_t)(l == 0 ? 0 : 3) * NTOK * 16};
        pg8::gemm_phase<pg8::EpiInProj, pg8::StaticOrder, true>(lds, g, S, E);
    } else if (p == 1) {
      for (int vb = bx; vb < 256; vb += G) {
        if (PROBE && !((MK_P1_ROLES >> (vb < 32 ? 0 : vb < 48 ? 1 : vb < 176 ? 2 : 3)) & 1)) continue;
        if (vb < 32) { const int kv = vb >> 4, pm = (vb >> 1) & 7, half = vb & 1;
            pg8::Gemm g; g.A = (const bf16_t*)(ws + WS_KV) + kv * 128; g.Bt = (const bf16_t*)(wl + W_C1 + (size_t)kv * 512 * 1024 * 2); g.K = 1024; g.lda = 16 * 768; g.kstepA = 768 * 2; g.a_s0 = 64 * 2; g.a_s1 = (size_t)T * 768 * 2;
            pg8::OneUnit S{1, {pm, half}};
            EpiCmp E{(const float*)(wl + W_B1P) + kv * 256, (const bf16_t*)(wl + W_C2) + (size_t)kv * 64 * 256, args.in[I_CB2] + l * 128 + kv * 64, kv == 0 ? args.in[I_KNG] + l * 192 : (const float*)nullptr,
                     (bf16_t*)(ws + (kv ? WS_VC : WS_KC)) + (size_t)pm * 256 * 64, (float*)(ws + WS_HID) + (size_t)(kv * 8 + pm) * 256 * 64, (unsigned*)(ws + WS_CTL + CTL_FLAG_BYTE) + (kv * 8 + pm) * 64, (unsigned)(l + 1), half};
            pg8::gemm_phase<EpiCmp, pg8::OneUnit, false>(lds, g, S, E);
        } else if (vb < 48) { const int i = vb - 32;
            pg8::Gemm g = pg8::make_gemm((const bf16_t*)(ws + WS_MEMB), (const bf16_t*)(wl + W_MKV), 1024); pg8::OneUnit S{1, {i >> 2, i & 3}};
            pg8::EpiBf16G<0> E{(bf16_t*)(ws + WS_KVM), 1024, nullptr, ctl + SSQ_MEM_OFF, 1.f / 1024.f, 1};
            pg8::gemm_phase<pg8::EpiBf16G<0>, pg8::OneUnit, true>(lds, g, S, E);
        } else if (vb < 176) {
            sgu_unit(lds, vb - 48, (const bf16_t*)(ws + WS_U), (const bf16_t*)(ws + WS_V), (const bf16_t*)(wl + W_SG), args.in[I_SGLNG] + l * 512, args.in[I_SGLNB] + l * 512, args.in[I_SGB] + l * 1024, (bf16_t*)(ws + WS_MIX));
        } else {
            for (int t = (vb - 176) * 8 + wave; t < NTOK; t += 4 * 640) tokprep4((bf16_t*)(ws + WS_Q), (bf16_t*)(ws + WS_KV), args.in[I_QNG] + l * 64, args.in[I_KNG] + l * 192, t, 640, lane);
            if (l == 0 && !PROBE) convert_layer(args, 1, 0, CONV_SPLIT, (vb - 176) * 8 + wave, 80 * 8, (LAS float*)(lds + wave * 16384), lane);
        } }
    } else if (p == 3) {
        for (int r = gw; r < 4096; r += NGW) memk_norm_item((bf16_t*)(ws + WS_KVM), args.in[I_MKG] + l * 128, r, lane);
        for (int i = bx; i < 256; i += G) { const int b = (i & 7) >> 1, idx = (i >> 3) * 2 + (i & 1);
            attn_unit<15>(lds, b, 127 - idx, (const bf16_t*)(ws + WS_Q), (const bf16_t*)(ws + WS_KV), (const bf16_t*)(ws + WS_KC), (const bf16_t*)(ws + WS_VC), (const float*)(ws + WS_GL), (bf16_t*)(ws + WS_MIX));
            attn_unit<15>(lds, b, idx, (const bf16_t*)(ws + WS_Q), (const bf16_t*)(ws + WS_KV), (const bf16_t*)(ws + WS_KC), (const bf16_t*)(ws + WS_VC), (const float*)(ws + WS_GL), (bf16_t*)(ws + WS_MIX)); }
    } else if (p == 6) {
        for (int i = bx; i < 256; i += G) { const int b = (i & 7) >> 1, rest = (i >> 3) * 2 + (i & 1);
            memattn_unit(lds, b, rest >> 4, rest & 15, (const bf16_t*)(ws + WS_QM), (const bf16_t*)(ws + WS_KVM), args.in[I_MQG] + l * 128, (bf16_t*)(ws + WS_OM)); }
    } else if (p == 4) {
        pg8::Gemm g = pg8::make_gemm((const bf16_t*)(ws + WS_MIX), (const bf16_t*)(wl + W_OUT), 1024); pg8::StaticOrder S; S.init(NTOK, 1024, G, bx);
        pg8::EpiResid E{nullptr, XB, ssqp + (size_t)(PROBE ? 1 : l * 3 + 1) * NTOK * 16};
        pg8::gemm_phase<pg8::EpiResid, pg8::StaticOrder, true>(lds, g, S, E);
    } else if (p == 5) {
        pg8::Gemm g = pg8::make_gemm(XB, (const bf16_t*)(wl + W_MQ), 1024); pg8::StaticOrder S; S.init(NTOK, 512, G, bx);
        pg8::EpiBf16G<0> E{(bf16_t*)(ws + WS_QM), 512, nullptr, ssqp + (size_t)(l * 3 + 1) * NTOK * 16, 1.f / 1024.f, 16};
        pg8::gemm_phase<pg8::EpiBf16G<0>, pg8::StaticOrder, true>(lds, g, S, E);
        if (l == 0 && !PROBE) { const int nidle = G > 128 ? G - 128 : 0;
            if (nidle == 0) convert_layer(args, 1, CONV_SPLIT, CONV_ITEMS, gw, NGW, (LAS float*)(lds + wave * 16384), lane);
            else if (bx >= 128) convert_layer(args, 1, CONV_SPLIT, CONV_ITEMS, (bx - 128) * 8 + wave, nidle * 8, (LAS float*)(lds + wave * 16384), lane); }
    } else if (p == 7) {
        pg8::Gemm g = pg8::make_gemm((const bf16_t*)(ws + WS_OM), (const bf16_t*)(wl + W_MO), 512); pg8::StaticOrder S; S.init(NTOK, 1024, G, bx);
        pg8::EpiResid E{nullptr, XB, ssqp + (size_t)(PROBE ? 1 : l * 3 + 2) * NTOK * 16};
        pg8::gemm_phase<pg8::EpiResid, pg8::StaticOrder, true>(lds, g, S, E);
    } else if (p == 8) {
        pg8::Gemm g = pg8::make_gemm(XB, (const bf16_t*)(wl + W_FF1), 1024); pg8::StaticOrder S; S.init(NTOK, FF, G, bx);
        pg8::EpiBf16G<2> E{(bf16_t*)(ws + WS_HB), FF, nullptr, ssqp + (size_t)(l * 3 + 2) * NTOK * 16, 1.f / 1024.f, 16};
        pg8::gemm_phase<pg8::EpiBf16G<2>, pg8::StaticOrder, true>(lds, g, S, E);
    } else if (p == 9) {
        pg8::Gemm g = pg8::make_gemm((const bf16_t*)(ws + WS_HB), (const bf16_t*)(wl + W_FF2), FF); pg8::StaticOrder S; S.init(NTOK, 1024, G, bx);
        pg8::EpiResid E{(l == 0 || PROBE) ? (float*)nullptr : xout, XB, ssqp + (size_t)(PROBE ? 1 : 3) * NTOK * 16};
        pg8::gemm_phase<pg8::EpiResid, pg8::StaticOrder, true>(lds, g, S, E);
    }
}

constexpr int LDS_BYTES = 147456;
__global__ void __launch_bounds__(512, 2) mega(Args args) {
    extern __shared__ __attribute__((aligned(16))) unsigned char lds_raw[];
    LAS unsigned char* lds = (LAS unsigned char*)lds_raw;
    const int G = gridDim.x, bx = blockIdx.x, NGW = G * 8;
    volatile LAS unsigned* bar_st = (volatile LAS unsigned*)(lds + LDS_ST_OFF);
    if (threadIdx.x < 2) bar_st[threadIdx.x] = 0u;
    __syncthreads();
    XcdBarrier xbar = xcd_barrier_post((unsigned*)(args.ws + WS_CTL + CTL_BAR_BYTE), bar_st);
    if (args.ph_hi < 0) cooperative_groups::this_grid().sync();
    if (args.ph_lo == 0) { const int tid0 = threadIdx.x, wave0 = __builtin_amdgcn_readfirstlane(tid0 >> 6); for (int e_ = 0; e_ < 1 + MK_PROBE_PRO; ++e_) prologue(args, lds, bx * 8 + wave0, NGW, wave0, tid0 & 63); }
    for (int ph = args.ph_lo > 1 ? args.ph_lo : 1; ph < args.ph_hi; ++ph) {
        if ((ph - 1) % 10 == 2) continue;
        if (ph > args.ph_lo) {
            xcd_barrier(xbar); }
        do_phase<false>((ph - 1) % 10, (ph - 1) / 10, args, lds, G, bx, NGW);
    }
#if MK_PROBE_N > 0
    if (args.ph_hi == 21) {
        xcd_barrier(xbar); do_phase<true>(0, 1, args, lds, G, bx, NGW);
        xcd_barrier(xbar); do_phase<true>(1, 1, args, lds, G, bx, NGW);
        for (int e_ = 0; e_ < MK_PROBE_N; ++e_) { xcd_barrier(xbar);
#if MK_PROBE_KIND == 100
            { int tidp = threadIdx.x; asm volatile("" : "+v"(tidp)); const int w_ = __builtin_amdgcn_readfirstlane(tidp >> 6); convert_layer(args, 1, 0, CONV_ITEMS, bx * 8 + w_, NGW, (LAS float*)(lds + w_ * 16384), tidp & 63); }
#elif MK_PROBE_KIND == 33
            for (int i = bx; i < 256; i += G) { const int b = (i & 7) >> 1, idx = (i >> 3) * 2 + (i & 1); unsigned char* ws = args.ws;
                attn_unit<MK_PROBE_PARTS>(lds, b, 127 - idx, (const bf16_t*)(ws + WS_Q), (const bf16_t*)(ws + WS_KV), (const bf16_t*)(ws + WS_KC), (const bf16_t*)(ws + WS_VC), (const float*)(ws + WS_GL), (bf16_t*)(ws + WS_MIX));
                attn_unit<MK_PROBE_PARTS>(lds, b, idx, (const bf16_t*)(ws + WS_Q), (const bf16_t*)(ws + WS_KV), (const bf16_t*)(ws + WS_KC), (const bf16_t*)(ws + WS_VC), (const float*)(ws + WS_GL), (bf16_t*)(ws + WS_MIX)); }
#elif MK_PROBE_KIND != 99
            do_phase<true>(MK_PROBE_KIND, 1, args, lds, G, bx, NGW);
#endif
        }
    }
#endif
}

}

#ifndef MK_FUSED
#define MK_FUSED 1
#endif
extern "C" void kernel_launch(void* const* d_in, const int* in_sizes, int n_in, void* d_out, int out_size, void* d_ws, size_t ws_size, hipStream_t stream) {
    using namespace mk;
    static int grid = 0;
    if (!grid) { (void)hipFuncSetAttribute((const void*)mega, hipFuncAttributeMaxDynamicSharedMemorySize, LDS_BYTES);
        int dev = 0, cus = 0, per_cu = 0; (void)hipGetDevice(&dev); (void)hipDeviceGetAttribute(&cus, hipDeviceAttributeMultiprocessorCount, dev);
        (void)hipOccupancyMaxActiveBlocksPerMultiprocessor(&per_cu, (const void*)mega, 512, LDS_BYTES);
        grid = cus * (per_cu < 1 ? 1 : per_cu); if (grid > 256) grid = 256; }
    Args a{}; for (int i = 0; i < 27; ++i) a.in[i] = (const float*)d_in[i]; a.out = (float*)d_out; a.ws = (unsigned char*)d_ws;
#if MK_FUSED
    (void)hipMemsetAsync((unsigned char*)d_ws + WS_CTL + CTL_BAR_BYTE, 0, 20 * 1024, stream);
    a.ph_lo = 0; a.ph_hi = 21; void* kargs[] = {&a};
    (void)hipLaunchCooperativeKernel((const void*)mega, dim3(grid), dim3(512), kargs, LDS_BYTES, stream);
#else
    for (int ph = 0; ph < 21; ++ph) { a.ph_lo = ph; a.ph_hi = ph + 1; hipLaunchKernelGGL(mega, dim3(grid), dim3(512), LDS_BYTES, stream, a); }
#endif
}
```

```cpp
#include <hip/hip_runtime.h>
#include <hip/hip_cooperative_groups.h>
#include <stdint.h>
#include <math.h>

namespace pg8 {
#define PG8_LAS __attribute__((address_space(3)))
typedef unsigned short bf16_t;
typedef short bf16x8 __attribute__((ext_vector_type(8)));
typedef float f32x4 __attribute__((ext_vector_type(4)));
typedef float f32x2 __attribute__((ext_vector_type(2)));
typedef unsigned u32x4 __attribute__((ext_vector_type(4)));
typedef unsigned u32x2 __attribute__((ext_vector_type(2)));
constexpr int BM = 256, BK = 64, HALF = 128, HTB = HALF * BK * 2, STAGE_BYTES = 8 * HTB, NXCD = 8, WGM = 8;

__host__ __device__ __forceinline__ int lds_byte(int r, int c) { const int st = (r >> 4) * 2 + (c >> 5), rr = r & 15, cc = c & 31, ob = rr * 64 + cc * 2; return st * 1024 + (ob ^ (((ob >> 9) & 1) << 5)); }
__host__ __device__ __forceinline__ void stage_rc(int b, int& R, int& C) { const int st = b / 1024, sb = b % 1024, swz = sb ^ (((sb >> 9) & 1) << 5); R = (st >> 1) * 16 + swz / 64; C = (st & 1) * 32 + (swz % 64) / 2; }
__host__ __device__ __forceinline__ int perm32(int rho) { const int n = rho >> 4, i = rho & 15; return 8 * (i >> 2) + 4 * n + (i & 3); }

struct Unit { int pm, pn; };
struct Gemm { const bf16_t* A; const bf16_t* Bt; int K; int lda; int kstepA; size_t a_s0, a_s1; };
__device__ __forceinline__ Gemm make_gemm(const bf16_t* A, const bf16_t* Bt, int K) { Gemm g; g.A = A; g.Bt = Bt; g.K = K; g.lda = K; g.kstepA = BK * 2; g.a_s0 = (size_t)BM * K * 2; g.a_s1 = 2 * g.a_s0; return g; }

struct StaticOrder {
    int nM, nN, nwg, G, c;
    __device__ void init(int M, int N, int G_, int c_) { nM = M / BM; nN = N / BM; nwg = nM * nN; G = G_; c = c_; }
    __device__ bool next(int i, Unit& u) const {
        const long L = (long)i * G + c; if (L >= nwg) return false;
        int wgid = (int)L; { const int q = nwg / NXCD, r = nwg % NXCD, xcd = wgid % NXCD, off = wgid / NXCD; wgid = (xcd < r ? xcd * (q + 1) : r * (q + 1) + (xcd - r) * q) + off; }
        const int nig = WGM * nN, gid = wgid / nig, fm = gid * WGM, gsz = (nM - fm) < WGM ? (nM - fm) : WGM;
        u.pm = fm + ((wgid % nig) % gsz); u.pn = (wgid % nig) / gsz; return true;
    }
};
struct OneUnit { int has; Unit u; __device__ bool next(int i, Unit& o) const { if (i > 0 || !has) return false; o = u; return true; } };

__device__ __forceinline__ unsigned cvt_pk_bf16(float lo, float hi) { unsigned r; asm volatile("v_cvt_pk_bf16_f32 %0, %1, %2" : "=v"(r) : "v"(lo), "v"(hi)); return r; }
__device__ __forceinline__ float gelu_tanh(float x) { const float u = 0.7978845608028654f * (x + 0.044715f * x * x * x); const float e = __builtin_amdgcn_exp2f(-2.885390081777927f * u); return x * __builtin_amdgcn_rcpf(1.f + e); }

__device__ __forceinline__ float ssq16(const float* p) { const f32x4 a = ((const f32x4*)p)[0], b = ((const f32x4*)p)[1], c = ((const f32x4*)p)[2], d = ((const f32x4*)p)[3];
    return (((a[0] + a[1]) + (a[2] + a[3])) + ((b[0] + b[1]) + (b[2] + b[3]))) + (((c[0] + c[1]) + (c[2] + c[3])) + ((d[0] + d[1]) + (d[2] + d[3]))); }
template <int ACT  > struct EpiBf16G {
    static constexpr bool PERM = true, AFTER_DRAIN = false;
    bf16_t* O; int ldc; const float* bias; const float* ssq; float inv_n; int nparts;
    __device__ __forceinline__ void operator()(const f32x4 (&acc)[2][2][4][2], const Unit& u, int wr, int wc, int fr, int fq) const {
        const int row0 = u.pm * BM + wr * 64 + fr, col0 = u.pn * BM + wc * 32 + 8 * fq;
        f32x4 bv[2][2];
#pragma unroll
        for (int bj = 0; bj < 2; ++bj)
#pragma unroll
            for (int n = 0; n < 2; ++n) bv[bj][n] = bias ? *(const f32x4*)(bias + col0 + bj * HALF + 4 * n) : (f32x4){0.f, 0.f, 0.f, 0.f};
        float rsv[2] = {1.f, 1.f};
        if (ssq) {
#pragma unroll
            for (int ai = 0; ai < 2; ++ai) { const int rr = row0 + ai * HALF + fq * 16; rsv[ai] = rsqrtf((nparts == 16 ? ssq16(ssq + (size_t)rr * 16) : ssq[rr]) * inv_n + 1e-6f); } }
#pragma unroll
        for (int ai = 0; ai < 2; ++ai)
#pragma unroll
            for (int m = 0; m < 4; ++m) { const int row = row0 + ai * HALF + m * 16; const float rs = __shfl(rsv[ai], fr + 16 * m); bf16_t* rowp = O + (size_t)row * ldc + col0;
#pragma unroll
                for (int bj = 0; bj < 2; ++bj) { f32x4 v0 = (acc[ai][bj][m][0] + bv[bj][0]) * rs, v1 = (acc[ai][bj][m][1] + bv[bj][1]) * rs;
                    if (ACT == 1) {
#pragma unroll
                        for (int e = 0; e < 4; ++e) { v0[e] = gelu_tanh(v0[e]); v1[e] = gelu_tanh(v1[e]); } }
                    if (ACT == 2) {
#pragma unroll
                        for (int e = 0; e < 4; ++e) { float a = fmaxf(v0[e], 0.f), b = fmaxf(v1[e], 0.f); v0[e] = a * a; v1[e] = b * b; } }
                    u32x4 w; w.x = cvt_pk_bf16(v0[0], v0[1]); w.y = cvt_pk_bf16(v0[2], v0[3]); w.z = cvt_pk_bf16(v1[0], v1[1]); w.w = cvt_pk_bf16(v1[2], v1[3]);
                    *(u32x4*)(rowp + bj * HALF) = w; } }
    }
};
struct EpiInProj {
    static constexpr bool PERM = true, AFTER_DRAIN = false;
    bf16_t *U, *V, *Q, *KV; float* GL; const float* ssq;
    __device__ __forceinline__ void operator()(const f32x4 (&acc)[2][2][4][2], const Unit& u, int wr, int wc, int fr, int fq) const {
        const int row0 = u.pm * BM + wr * 64 + fr, cit0 = wc * 32 + 8 * fq; const int pn = u.pn;
        bf16_t* base; int ldc, cofs; bool act = false;
        if (pn < 2) { base = U; ldc = 512; cofs = pn * 256; act = true; } else if (pn < 4) { base = V; ldc = 512; cofs = (pn - 2) * 256; act = true; }
        else if (pn < 6) { base = Q; ldc = 512; cofs = (pn - 4) * 256; } else { base = KV; ldc = 768; cofs = (pn - 6) * 256; }
        float rsv[2];
#pragma unroll
        for (int ai = 0; ai < 2; ++ai) rsv[ai] = rsqrtf(ssq16(ssq + (size_t)(row0 + ai * HALF + fq * 16) * 16) * (1.f / 1024.f) + 1e-6f);
#pragma unroll
        for (int ai = 0; ai < 2; ++ai)
#pragma unroll
            for (int m = 0; m < 4; ++m) { const int row = row0 + ai * HALF + m * 16; const float rs = __shfl(rsv[ai], fr + 16 * m);
#pragma unroll
                for (int bj = 0; bj < 2; ++bj) { f32x4 v0 = acc[ai][bj][m][0] * rs, v1 = acc[ai][bj][m][1] * rs; const int cit = cit0 + bj * HALF;
                    if (pn == 9) { if (cit < 24) { *(f32x4*)(GL + (size_t)row * 24 + cit) = v0; *(f32x4*)(GL + (size_t)row * 24 + cit + 4) = v1; } }
                    else { if (act) {
#pragma unroll
                            for (int e = 0; e < 4; ++e) { v0[e] = gelu_tanh(v0[e]); v1[e] = gelu_tanh(v1[e]); } }
                        u32x4 w; w.x = cvt_pk_bf16(v0[0], v0[1]); w.y = cvt_pk_bf16(v0[2], v0[3]); w.z = cvt_pk_bf16(v1[0], v1[1]); w.w = cvt_pk_bf16(v1[2], v1[3]);
                        *(u32x4*)(base + (size_t)row * ldc + cofs + cit) = w; } } }
    }
};
struct EpiResid {
    static constexpr bool PERM = false, AFTER_DRAIN = false;
    float* XF; bf16_t* XB; float* ssq;
    __device__ __forceinline__ void operator()(const f32x4 (&acc)[2][2][4][2], const Unit& u, int wr, int wc, int fr, int fq) const {
        const int col0 = u.pn * BM + wc * 32 + 4 * fq;
#pragma unroll
        for (int ai = 0; ai < 2; ++ai)
#pragma unroll
            for (int m = 0; m < 4; ++m) { const int row = u.pm * BM + ai * HALF + wr * 64 + m * 16 + fr; float sq = 0.f;
#pragma unroll
                for (int bj = 0; bj < 2; ++bj)
#pragma unroll
                    for (int n = 0; n < 2; ++n) { const size_t off = (size_t)row * 1024 + col0 + bj * HALF + n * 16; const u32x2 xw = *(const u32x2*)(XB + off);
                        f32x4 xv; xv[0] = __uint_as_float(xw.x << 16); xv[1] = __uint_as_float(xw.x & 0xffff0000u); xv[2] = __uint_as_float(xw.y << 16); xv[3] = __uint_as_float(xw.y & 0xffff0000u);
                        xv = xv + acc[ai][bj][m][n];
                        if (XF) *(f32x4*)(XF + off) = xv;
                        else { sq += (xv[0] * xv[0] + xv[1] * xv[1]) + (xv[2] * xv[2] + xv[3] * xv[3]); u32x2 w; w.x = cvt_pk_bf16(xv[0], xv[1]); w.y = cvt_pk_bf16(xv[2], xv[3]); *(u32x2*)(XB + off) = w; } }
                if (!XF) { sq += __shfl_xor(sq, 16); sq += __shfl_xor(sq, 32); if (fq == 0) ssq[(size_t)row * 16 + u.pn * 4 + wc] = sq; } }
    }
};

template <class Epi, class Sched, bool ALIGN_EPI>
__device__ __forceinline__ void gemm_phase(PG8_LAS unsigned char* lds, const Gemm g, const Sched& S, const Epi& E) {
    int tid_ = threadIdx.x; asm volatile("" : "+v"(tid_));
    const int tid = tid_, wid = __builtin_amdgcn_readfirstlane(tid >> 6), lane = tid & 63, wr = wid >> 2, wc = wid & 3, fr = lane & 15, fq = lane >> 4;
    const int K = g.K, nt = K / BK;
    unsigned voffA[2], voffB[2];
#pragma unroll
    for (int i = 0; i < 2; ++i) { int R, C; stage_rc(tid * 16 + i * 8192, R, C); const int Rb = Epi::PERM ? ((R & ~31) + perm32(R & 31)) : R;
        voffA[i] = (unsigned)(R * g.lda + C) * 2u; voffB[i] = (unsigned)(Rb * K + C) * 2u; }
    const size_t kstepA = (size_t)g.kstepA, kstepB = (size_t)(BK * 2);
    const size_t hstepA = (size_t)HALF * g.lda * 2, hstepB = (size_t)HALF * K * 2, tstepB = 2 * hstepB;
    const unsigned ldsw = (unsigned)wid * 1024u;
    const int aoff = lds_byte(wr * 64 + fr, fq * 8), boff = lds_byte(wc * 32 + fr, fq * 8);
#define PG8_ABASE(pm) ((const char*)g.A + (size_t)((pm) >> 1) * g.a_s1 + (size_t)((pm) & 1) * g.a_s0)
#define PG8_SA(b, h) (((b) * 2 + (h)) * HTB)
#define PG8_SB(b, h) ((4 + (b) * 2 + (h)) * HTB)
#define PG8_STAGE(bufoff, gbase, voff) do { _Pragma("unroll") for (int _i = 0; _i < 2; ++_i) \
        __builtin_amdgcn_global_load_lds((const unsigned*)((const char*)(gbase) + (voff)[_i]), (PG8_LAS unsigned*)(lds + (bufoff) + ldsw + _i * 8192), 16, 0, 0); } while (0)
#define PG8_LDA(dst, b, h) do { _Pragma("unroll") for (int m = 0; m < 4; ++m) _Pragma("unroll") for (int k = 0; k < 2; ++k) dst[m][k] = *(const PG8_LAS bf16x8*)(lds + PG8_SA(b, h) + aoff + m * 2048 + k * 1024); } while (0)
#define PG8_LDB(dst, b, h) do { _Pragma("unroll") for (int n = 0; n < 2; ++n) _Pragma("unroll") for (int k = 0; k < 2; ++k) dst[n][k] = *(const PG8_LAS bf16x8*)(lds + PG8_SB(b, h) + boff + n * 2048 + k * 1024); } while (0)
#define PG8_MMA(ai, bj, At, Bt) do { __builtin_amdgcn_s_setprio(1); _Pragma("unroll") for (int m = 0; m < 4; ++m) _Pragma("unroll") for (int n = 0; n < 2; ++n) _Pragma("unroll") for (int k = 0; k < 2; ++k) \
        acc[ai][bj][m][n] = __builtin_amdgcn_mfma_f32_16x16x32_bf16(Bt[n][k], At[m][k], acc[ai][bj][m][n], 0, 0, 0); __builtin_amdgcn_s_setprio(0); } while (0)
#define PG8_WAIT_V(n) asm volatile("s_waitcnt vmcnt(" #n ")" ::: "memory")
#define PG8_WAIT_L(n) asm volatile("s_waitcnt lgkmcnt(" #n ")" ::: "memory")
#define PG8_BAR __builtin_amdgcn_s_barrier()
#define PG8_SCHED __builtin_amdgcn_sched_barrier(0)
    Unit cur, nxt; int ui = 0;
    if (!S.next(0, cur)) return;
    f32x4 acc[2][2][4][2];
#pragma unroll
    for (int a = 0; a < 2; ++a)
#pragma unroll
        for (int b = 0; b < 2; ++b)
#pragma unroll
            for (int m = 0; m < 4; ++m)
#pragma unroll
                for (int n = 0; n < 2; ++n) acc[a][b][m][n] = (f32x4){0.f, 0.f, 0.f, 0.f};
    bf16x8 At[4][2], B0[2][2], B1[2][2];
    const char* cA = PG8_ABASE(cur.pm); const char* cB = (const char*)g.Bt + (size_t)cur.pn * tstepB;
    PG8_STAGE(PG8_SB(0, 0), cB, voffB); PG8_STAGE(PG8_SB(0, 1), cB + hstepB, voffB); PG8_STAGE(PG8_SA(0, 0), cA, voffA); PG8_STAGE(PG8_SA(0, 1), cA + hstepA, voffA);
    if (wr == 1) PG8_BAR;
    PG8_WAIT_V(2); PG8_BAR;
    PG8_STAGE(PG8_SB(1, 0), cB + kstepB, voffB); PG8_STAGE(PG8_SA(1, 0), cA + kstepA, voffA); PG8_STAGE(PG8_SB(1, 1), cB + hstepB + kstepB, voffB);
    PG8_WAIT_V(6); PG8_BAR;
    for (;;) {
        const bool has_next = S.next(ui + 1, nxt);
        const char* nA = has_next ? PG8_ABASE(nxt.pm) : cA; const char* nB = has_next ? (const char*)g.Bt + (size_t)nxt.pn * tstepB : cB;
        for (int t = 0; t < nt; t += 2) {
            const bool last = (t == nt - 2);
            const char* a1 = cA + (size_t)(t + 1) * kstepA;
            const char* a2 = last ? nA : cA + (size_t)(t + 2) * kstepA; const char* b2 = last ? nB : cB + (size_t)(t + 2) * kstepB;
            const char* a3 = a2 + kstepA; const char* b3 = b2 + kstepB;
            PG8_LDB(B0, 0, 0); PG8_LDB(B1, 0, 1); PG8_SCHED; PG8_LDA(At, 0, 0); PG8_STAGE(PG8_SA(1, 1), a1 + hstepA, voffA);
            PG8_WAIT_V(8); PG8_WAIT_L(0); PG8_BAR; PG8_MMA(0, 0, At, B0); PG8_MMA(0, 1, At, B1); PG8_BAR; PG8_SCHED;
            PG8_LDA(At, 0, 1); PG8_STAGE(PG8_SB(0, 0), b2, voffB); PG8_STAGE(PG8_SB(0, 1), b2 + hstepB, voffB); PG8_STAGE(PG8_SA(0, 0), a2, voffA);
            PG8_WAIT_V(8); PG8_WAIT_L(0); PG8_BAR; PG8_MMA(1, 0, At, B0); PG8_MMA(1, 1, At, B1); PG8_BAR; PG8_SCHED;
            PG8_LDB(B0, 1, 0); PG8_LDB(B1, 1, 1); PG8_SCHED; PG8_LDA(At, 1, 0); PG8_STAGE(PG8_SA(0, 1), a2 + hstepA, voffA);
            PG8_WAIT_V(8); PG8_WAIT_L(0); PG8_BAR; PG8_MMA(0, 0, At, B0); PG8_MMA(0, 1, At, B1); PG8_BAR; PG8_SCHED;
            PG8_LDA(At, 1, 1); PG8_STAGE(PG8_SB(1, 0), b3, voffB); PG8_STAGE(PG8_SB(1, 1), b3 + hstepB, voffB); PG8_STAGE(PG8_SA(1, 0), a3, voffA);
            PG8_WAIT_V(8); PG8_WAIT_L(0); PG8_BAR; PG8_MMA(1, 0, At, B0); PG8_MMA(1, 1, At, B1); PG8_BAR; PG8_SCHED;
        }
        if constexpr (ALIGN_EPI) { if (wr == 0) PG8_BAR; }
        if constexpr (!Epi::AFTER_DRAIN) { E(acc, cur, wr, wc, fr, fq); }
        if (!has_next) break;
#pragma unroll
        for (int a = 0; a < 2; ++a)
#pragma unroll
            for (int b = 0; b < 2; ++b)
#pragma unroll
                for (int m = 0; m < 4; ++m)
#pragma unroll
                    for (int n = 0; n < 2; ++n) acc[a][b][m][n] = (f32x4){0.f, 0.f, 0.f, 0.f};
        cur = nxt; cA = nA; cB = nB; ++ui;
        if constexpr (ALIGN_EPI) { if (wr == 1) PG8_BAR; }
    }
    PG8_WAIT_V(0);
    if constexpr (!ALIGN_EPI) { if (wr == 0) PG8_BAR; }
    PG8_BAR;
    if constexpr (Epi::AFTER_DRAIN) { E.fused(acc, cur, wr, wc, fr, fq, lds, wid, lane); }
#undef PG8_ABASE
#undef PG8_SA
#undef PG8_SB
#undef PG8_STAGE
#undef PG8_LDA
#undef PG8_LDB
#undef PG8_MMA
#undef PG8_WAIT_V
#undef PG8_WAIT_L
#undef PG8_BAR
#undef PG8_SCHED
}
}

#ifndef MK_PROBE_N
#define MK_PROBE_N 0
#endif
#ifndef MK_P1_ROLES
#define MK_P1_ROLES 15
#endif
#ifndef MK_PROBE_PRO
#define MK_PROBE_PRO 0
#endif
#ifndef MK_PROBE_KIND
#define MK_PROBE_KIND 3
#endif
#ifndef MK_PROBE_PARTS
#define MK_PROBE_PARTS 15
#endif

namespace mk {
using pg8::bf16_t; using pg8::f32x4; using pg8::u32x4; using pg8::u32x2; using pg8::cvt_pk_bf16;
#define LAS __attribute__((address_space(3)))
constexpr int NB = 4, T = 4096, D = 1024, NTOK = NB * T, INC = 2328, INP = 2560, FF = 4096;
constexpr size_t MiB = 1u << 20;
constexpr size_t WS_CTL = 0;
constexpr size_t WS_W = 1 * MiB, W_LAYER = 30 * MiB;
constexpr size_t W_IN = 0, W_OUT = 5 * MiB, W_MQ = 7 * MiB, W_MKV = 8 * MiB, W_MO = 10 * MiB, W_FF1 = 11 * MiB, W_FF2 = 19 * MiB, W_C1 = 27 * MiB, W_C2 = 29 * MiB, W_SG = 29 * MiB + 128 * 1024, W_B1P = 29 * MiB + 512 * 1024;
constexpr size_t WS_XB = 61 * MiB;
constexpr size_t WS_OV = 93 * MiB;
constexpr size_t WS_U = WS_OV, WS_V = WS_OV + 16 * MiB, WS_Q = WS_OV + 32 * MiB, WS_KV = WS_OV + 48 * MiB, WS_MIX = WS_OV + 72 * MiB, WS_QM = WS_OV + 104 * MiB, WS_OM = WS_OV + 120 * MiB;
constexpr size_t WS_HB = WS_OV;
constexpr size_t WS_SM = 229 * MiB;
constexpr size_t WS_GL = WS_SM, WS_KC = WS_SM + 2 * MiB, WS_VC = WS_KC + 256 * 1024, WS_HID = WS_SM + 3 * MiB, WS_MASK = WS_SM + 5 * MiB, WS_MEMB = WS_SM + 6 * MiB, WS_KVM = WS_SM + 8 * MiB, WS_END = WS_SM + 10 * MiB;
constexpr size_t WS_SSQP = 240 * MiB;
static_assert(WS_END <= WS_SSQP && WS_SSQP + 6 * MiB <= 256 * MiB, "ws map");
constexpr int SSQ_MEM_OFF = 6 * NTOK;

struct Args { const float* in[27]; float* out; unsigned char* ws; int ph_lo, ph_hi; };
enum { I_X = 0, I_MEM, I_NMG, I_WIN, I_SGLNG, I_SGLNB, I_SGW, I_SGB, I_QNG, I_KNG, I_CPOS, I_CW1, I_CB1, I_CW2, I_CB2, I_MOG, I_WOUT, I_NMEMG, I_MKVG, I_WMQ, I_WMKV, I_MQG, I_MKG, I_WMO, I_NFG, I_WFF1, I_WFF2 };

__device__ __forceinline__ float bf2f(unsigned short b) { return __uint_as_float((unsigned)b << 16); }
__device__ __forceinline__ float wave_sum(float v) {
#pragma unroll
    for (int o = 1; o < 64; o <<= 1) v += __shfl_xor(v, o);
    return v; }

__device__ __forceinline__ void transpose_item(const float* W, int K, int N, int Npad, const float* gain, bf16_t* WT, LAS float* scr, int item, int lane, int ld = 0) {
    if (ld == 0) ld = N;
    const int nblk = Npad / 32, kb = item / nblk, nb = item % nblk, k0 = 64 * kb, n0 = 32 * nb;
    const int nn = n0 + (lane & 31); const int nnc = nn < N ? nn : N - 1; const float keep = nn < N ? 1.f : 0.f;
    const float* src = W + (size_t)(k0 + (lane >> 5)) * ld + nnc;
    float v[32];
#pragma unroll
    for (int i = 0; i < 32; ++i) v[i] = src[(size_t)(2 * i) * ld];
#pragma unroll
    for (int i = 0; i < 32; ++i) scr[(2 * i + (lane >> 5)) * 33 + (lane & 31)] = v[i] * keep;
    asm volatile("s_waitcnt lgkmcnt(0)" ::: "memory");
    const int c = lane & 7;
    f32x4 g0 = {1.f, 1.f, 1.f, 1.f}, g1 = {1.f, 1.f, 1.f, 1.f};
    if (gain) { g0 = *(const f32x4*)(gain + k0 + 8 * c); g1 = *(const f32x4*)(gain + k0 + 8 * c + 4); }
#pragma unroll
    for (int j = 0; j < 4; ++j) { const int n = (lane >> 3) + 8 * j; const LAS float* sp = scr + (8 * c) * 33 + n;
        u32x4 o; o.x = cvt_pk_bf16(sp[0 * 33] * g0[0], sp[1 * 33] * g0[1]); o.y = cvt_pk_bf16(sp[2 * 33] * g0[2], sp[3 * 33] * g0[3]); o.z = cvt_pk_bf16(sp[4 * 33] * g1[0], sp[5 * 33] * g1[1]); o.w = cvt_pk_bf16(sp[6 * 33] * g1[2], sp[7 * 33] * g1[3]);
        *(u32x4*)(WT + (size_t)(n0 + n) * K + k0 + 8 * c) = o; }
    asm volatile("s_waitcnt lgkmcnt(0)" ::: "memory");
}

constexpr int CV_IN = 16 * 80, CV_OUT = 16 * 32, CV_MQ = 16 * 16, CV_MKV = 16 * 32, CV_MO = 8 * 32, CV_FF1 = 16 * 128, CV_FF2 = 64 * 32, CV_C1 = 32 * 8, CV_C2 = 4 * 2;
constexpr int CV_TR = CV_IN + CV_OUT + CV_MQ + CV_MKV + CV_MO + CV_FF1 + CV_FF2 + 2 * CV_C1 + 2 * CV_C2, CV_B1 = 64, CV_SG = 1024, CONV_ITEMS = CV_TR + CV_B1 + CV_SG;
__device__ __forceinline__ void convert_layer(const Args& a, int l, int it_lo, int it_hi, int gwl, int ngwl, LAS float* scr, int lane_) {
    unsigned char* ws = a.ws; unsigned char* wl = ws + WS_W + l * W_LAYER;
#pragma unroll 1
    for (int it = it_lo + gwl; it < it_hi; it += ngwl) {
        int r = it; int lane = lane_; asm volatile("" : "+v"(lane));
        if (r < CV_IN) { transpose_item(a.in[I_WIN] + (size_t)l * 1024 * INC, 1024, INC, INP, a.in[I_NMG] + l * 1024, (bf16_t*)(wl + W_IN), scr, r, lane); continue; } r -= CV_IN;
        if (r < CV_OUT) { transpose_item(a.in[I_WOUT] + (size_t)l * 1024 * 1024, 1024, 1024, 1024, a.in[I_MOG] + l * 1024, (bf16_t*)(wl + W_OUT), scr, r, lane); continue; } r -= CV_OUT;
        if (r < CV_MQ) { transpose_item(a.in[I_WMQ] + (size_t)l * 1024 * 512, 1024, 512, 512, a.in[I_NMEMG] + l * 1024, (bf16_t*)(wl + W_MQ), scr, r, lane); continue; } r -= CV_MQ;
        if (r < CV_MKV) { transpose_item(a.in[I_WMKV] + (size_t)l * 1024 * 1024, 1024, 1024, 1024, a.in[I_MKVG] + l * 1024, (bf16_t*)(wl + W_MKV), scr, r, lane); continue; } r -= CV_MKV;
        if (r < CV_MO) { transpose_item(a.in[I_WMO] + (size_t)l * 512 * 1024, 512, 1024, 1024, (const float*)nullptr, (bf16_t*)(wl + W_MO), scr, r, lane); continue; } r -= CV_MO;
        if (r < CV_FF1) { transpose_item(a.in[I_WFF1] + (size_t)l * 1024 * 4096, 1024, 4096, 4096, a.in[I_NFG] + l * 1024, (bf16_t*)(wl + W_FF1), scr, r, lane); continue; } r -= CV_FF1;
        if (r < CV_FF2) { transpose_item(a.in[I_WFF2] + (size_t)l * 4096 * 1024, 4096, 1024, 1024, (const float*)nullptr, (bf16_t*)(wl + W_FF2), scr, r, lane); continue; } r -= CV_FF2;
        if (r < 2 * CV_C1) {
            const int kv = r / CV_C1, r2 = r % CV_C1, sub = r2 >> 6, half = sub >> 1, tb = sub & 1;
            transpose_item(a.in[I_CW1] + (size_t)(l * 2 + kv) * 2048 * 256 + (size_t)tb * 1024 * 256 + half * 128, 1024, 128, 128, (const float*)nullptr,
                           (bf16_t*)(wl + W_C1 + (size_t)kv * 512 * 1024 * 2) + (size_t)(half * 256 + tb * 128) * 1024, scr, r2 & 63, lane, 256); continue; } r -= 2 * CV_C1;
        if (r < 2 * CV_C2) { const int kv = r / CV_C2; transpose_item(a.in[I_CW2] + (size_t)(l * 2 + kv) * 256 * 64, 256, 64, 64, (const float*)nullptr, (bf16_t*)(wl + W_C2 + (size_t)kv * 64 * 256 * 2), scr, r % CV_C2, lane); continue; } r -= 2 * CV_C2;
        if (r < CV_B1) {
            const int lk = l * 2 + (r >> 5), j0 = (r & 31) * 8; const float* W1 = a.in[I_CW1] + (size_t)lk * 2048 * 256 + j0; const float* pos = a.in[I_CPOS] + (size_t)lk * 2048;
            float acc[8];
#pragma unroll
            for (int e = 0; e < 8; ++e) acc[e] = 0.f;
#pragma unroll 8
            for (int i = 0; i < 32; ++i) { const int k = i * 64 + lane; const float p = pos[k]; const f32x4 w0 = *(const f32x4*)(W1 + (size_t)k * 256), w1 = *(const f32x4*)(W1 + (size_t)k * 256 + 4);
#pragma unroll
                for (int e = 0; e < 4; ++e) { acc[e] += p * w0[e]; acc[4 + e] += p * w1[e]; } }
#pragma unroll
            for (int e = 0; e < 8; ++e) acc[e] = wave_sum(acc[e]);
            if (lane == 0) { float* dst = (float*)(wl + W_B1P) + (lk & 1) * 256 + j0;
#pragma unroll
                for (int e = 0; e < 8; ++e) dst[e] = acc[e] + a.in[I_CB1][lk * 256 + j0 + e]; }
            continue; } r -= CV_B1;
        {
            const int t = r & 127; const float* wr = a.in[I_SGW] + ((size_t)l * 1024 + r) * 128; unsigned* dst = (unsigned*)(wl + W_SG) + (size_t)r * 64 + lane; float v[2];
#pragma unroll
            for (int e = 0; e < 2; ++e) { const int p = lane * 2 + e, ks = p >> 4, hh = (p >> 3) & 1, j = p & 7, sidx = 16 * ks + 8 * (j >> 2) + 4 * hh + (j & 3); v[e] = wr[sidx <= t ? sidx : t]; v[e] = sidx <= t ? v[e] : 0.f; }
            *dst = cvt_pk_bf16(v[0], v[1]); }
    }
}
constexpr int CONV_SPLIT = 3000;
__device__ __forceinline__ void prologue(const Args& a, LAS unsigned char* lds, int gw, int NGW, int wave, int lane) {
    LAS float* scr = (LAS float*)(lds + wave * 16384);
    unsigned char* ws = a.ws; float* ctl = (float*)(ws + WS_CTL);
    convert_layer(a, 0, 0, NGW == 2048 ? CV_IN : CONV_ITEMS, gw, NGW, scr, lane);
    { const float* x = a.in[I_X]; bf16_t* XB = (bf16_t*)(ws + WS_XB);
      for (int r = gw; r < NTOK; r += NGW) { const f32x4* xr = (const f32x4*)(x + (size_t)r * 1024) + lane; unsigned long long* xb = (unsigned long long*)(XB + (size_t)r * 1024) + lane; float s = 0.f;
#pragma unroll
          for (int j = 0; j < 4; ++j) { const f32x4 v = xr[64 * j]; s += (v[0] * v[0] + v[1] * v[1]) + (v[2] * v[2] + v[3] * v[3]); xb[64 * j] = (unsigned long long)cvt_pk_bf16(v[0], v[1]) | ((unsigned long long)cvt_pk_bf16(v[2], v[3]) << 32); }
          s = wave_sum(s); if (lane < 16) ((float*)(ws + WS_SSQP))[(size_t)r * 16 + lane] = lane == 0 ? s : 0.f; } }
    { const float* mem = a.in[I_MEM]; bf16_t* MB = (bf16_t*)(ws + WS_MEMB);
      for (int r = gw; r < 1024; r += NGW) { const f32x4* xr = (const f32x4*)(mem + (size_t)r * 1024) + lane; unsigned long long* xb = (unsigned long long*)(MB + (size_t)r * 1024) + lane; float s = 0.f;
#pragma unroll
          for (int j = 0; j < 4; ++j) { const f32x4 v = xr[64 * j]; s += (v[0] * v[0] + v[1] * v[1]) + (v[2] * v[2] + v[3] * v[3]); xb[64 * j] = (unsigned long long)cvt_pk_bf16(v[0], v[1]) | ((unsigned long long)cvt_pk_bf16(v[2], v[3]) << 32); }
          s = wave_sum(s); if (lane == 0) ctl[SSQ_MEM_OFF + r] = s; } }
}

typedef float f32x16 __attribute__((ext_vector_type(16)));
typedef short s16x4 __attribute__((ext_vector_type(4)));
typedef short v4i16_t __attribute__((ext_vector_type(4)));
using pg8::bf16x8;
__device__ __forceinline__ int crow(int r, int hi) { return (r & 3) + 8 * (r >> 2) + 4 * hi; }
__device__ __forceinline__ s16x4 vtr(const LAS char* p) { return __builtin_bit_cast(s16x4, __builtin_amdgcn_ds_read_tr16_b64_v4i16((LAS v4i16_t*)p)); }
#define MFMA32(a, b, c) __builtin_amdgcn_mfma_f32_32x32x16_bf16(a, b, c, 0, 0, 0)
#define VFRAG(lo, hi) (bf16x8){lo[0], lo[1], lo[2], lo[3], hi[0], hi[1], hi[2], hi[3]}
__device__ __forceinline__ void lds_fadd(LAS float* p, float v) { (void)__hip_atomic_fetch_add(p, v, __ATOMIC_RELAXED, __HIP_MEMORY_SCOPE_WORKGROUP); }
__device__ __forceinline__ unsigned short f2bf(float f) { return (unsigned short)(cvt_pk_bf16(f, 0.f) & 0xffffu); }

__device__ __forceinline__ void tokprep_token(bf16_t* Q, bf16_t* KV, const float* qg, const float* kg, int tok, int lane) {
    { u32x4* p = (u32x4*)(Q + (size_t)tok * 512) + lane; const u32x4 w = *p; float v[8];
#pragma unroll
      for (int i = 0; i < 4; ++i) { v[2 * i] = __uint_as_float(w[i] << 16); v[2 * i + 1] = __uint_as_float(w[i] & 0xffff0000u); }
      float ss = 0.f;
#pragma unroll
      for (int i = 0; i < 8; ++i) ss += v[i] * v[i];
      ss += __shfl_xor(ss, 1); ss += __shfl_xor(ss, 2); ss += __shfl_xor(ss, 4);
      const float rs = rsqrtf(ss * (1.f / 64.f) + 1e-6f) * (0.125f * 1.4426950408889634f); const float* g = qg + (lane & 7) * 8;
      u32x4 o;
#pragma unroll
      for (int i = 0; i < 4; ++i) o[i] = cvt_pk_bf16(v[2 * i] * rs * g[2 * i], v[2 * i + 1] * rs * g[2 * i + 1]);
      *p = o; }
    if (lane < 32) { const int br = 1 + (lane >> 4); u32x4* p = (u32x4*)(KV + (size_t)tok * 768 + br * 256) + (lane & 15); const u32x4 w = *p; float v[8];
#pragma unroll
      for (int i = 0; i < 4; ++i) { v[2 * i] = __uint_as_float(w[i] << 16); v[2 * i + 1] = __uint_as_float(w[i] & 0xffff0000u); }
      float ss = 0.f;
#pragma unroll
      for (int i = 0; i < 8; ++i) ss += v[i] * v[i];
      ss += __shfl_xor(ss, 1); ss += __shfl_xor(ss, 2); ss += __shfl_xor(ss, 4);
      const float rs = rsqrtf(ss * (1.f / 64.f) + 1e-6f); const float* g = kg + br * 64 + (lane & 7) * 8;
      u32x4 o;
#pragma unroll
      for (int i = 0; i < 4; ++i) o[i] = cvt_pk_bf16(v[2 * i] * rs * g[2 * i], v[2 * i + 1] * rs * g[2 * i + 1]);
      *p = o; }
}
__device__ __forceinline__ void cmp2_row(const bf16_t* HID, const bf16_t* w2t, const float* b2, const float* kg0, bf16_t* KC, bf16_t* VC, int row, int lane) {
#pragma unroll 1
    for (int kv = 0; kv < 2; ++kv) { const u32x4* h = (const u32x4*)(HID + (size_t)kv * 2048 * 256 + (size_t)row * 256); const u32x4* w = (const u32x4*)(w2t + (size_t)kv * 64 * 256 + (size_t)lane * 256); float s = b2[kv * 64 + lane];
#pragma unroll 4
        for (int k = 0; k < 32; ++k) { const u32x4 a = h[k], b = w[k];
#pragma unroll
            for (int i = 0; i < 4; ++i) s += __uint_as_float(a[i] << 16) * __uint_as_float(b[i] << 16) + __uint_as_float(a[i] & 0xffff0000u) * __uint_as_float(b[i] & 0xffff0000u); }
        if (kv == 0) { const float ss = wave_sum(s * s); s = s * rsqrtf(ss * (1.f / 64.f) + 1e-6f) * kg0[lane]; }
        if ((row & 255) == 255) s = 0.f;
        (kv ? VC : KC)[(size_t)row * 64 + lane] = f2bf(s); }
}
__device__ __forceinline__ void memk_norm_item(bf16_t* KVM, const float* kg, int r, int lane) {
    unsigned* p = (unsigned*)(KVM + (size_t)(r >> 2) * 1024 + (r & 3) * 128) + lane; const unsigned w = *p; const float v0 = __uint_as_float(w << 16), v1 = __uint_as_float(w & 0xffff0000u);
    const float ss = wave_sum(v0 * v0 + v1 * v1); const float rs = rsqrtf(ss * (1.f / 128.f) + 1e-6f); *p = cvt_pk_bf16(v0 * rs * kg[2 * lane], v1 * rs * kg[2 * lane + 1]);
}

__device__ __forceinline__ void tokprep4(bf16_t* Q, bf16_t* KV, const float* qg, const float* kg, int t, int S, int lane) {
    u32x4 wq[4], wk[4]; const int br = 1 + ((lane >> 4) & 1);
#pragma unroll
    for (int i = 0; i < 4; ++i) { const int tt = t + i * S < NTOK ? t + i * S : NTOK - 1; wq[i] = *((const u32x4*)(Q + (size_t)tt * 512) + lane); wk[i] = *((const u32x4*)(KV + (size_t)tt * 768 + br * 256) + (lane & 15)); }
    f32x4 gq0 = *(const f32x4*)(qg + (lane & 7) * 8), gq1 = *(const f32x4*)(qg + (lane & 7) * 8 + 4), gk0 = *(const f32x4*)(kg + br * 64 + (lane & 7) * 8), gk1 = *(const f32x4*)(kg + br * 64 + (lane & 7) * 8 + 4);
#pragma unroll
    for (int i = 0; i < 4; ++i) { if (t + i * S >= NTOK) break; const int tt = t + i * S;
        { const u32x4 w = wq[i]; float v[8];
#pragma unroll
          for (int e = 0; e < 4; ++e) { v[2 * e] = __uint_as_float(w[e] << 16); v[2 * e + 1] = __uint_as_float(w[e] & 0xffff0000u); }
          float ss = 0.f;
#pragma unroll
          for (int e = 0; e < 8; ++e) ss += v[e] * v[e];
          ss += __shfl_xor(ss, 1); ss += __shfl_xor(ss, 2); ss += __shfl_xor(ss, 4);
          const float rs = rsqrtf(ss * (1.f / 64.f) + 1e-6f) * (0.125f * 1.4426950408889634f);
          u32x4 o; o[0] = cvt_pk_bf16(v[0] * rs * gq0[0], v[1] * rs * gq0[1]); o[1] = cvt_pk_bf16(v[2] * rs * gq0[2], v[3] * rs * gq0[3]); o[2] = cvt_pk_bf16(v[4] * rs * gq1[0], v[5] * rs * gq1[1]); o[3] = cvt_pk_bf16(v[6] * rs * gq1[2], v[7] * rs * gq1[3]);
          *((u32x4*)(Q + (size_t)tt * 512) + lane) = o; }
        { const u32x4 w = wk[i]; float v[8];
#pragma unroll
          for (int e = 0; e < 4; ++e) { v[2 * e] = __uint_as_float(w[e] << 16); v[2 * e + 1] = __uint_as_float(w[e] & 0xffff0000u); }
          float ss = 0.f;
#pragma unroll
          for (int e = 0; e < 8; ++e) ss += v[e] * v[e];
          ss += __shfl_xor(ss, 1); ss += __shfl_xor(ss, 2); ss += __shfl_xor(ss, 4);
          const float rs = rsqrtf(ss * (1.f / 64.f) + 1e-6f);
          u32x4 o; o[0] = cvt_pk_bf16(v[0] * rs * gk0[0], v[1] * rs * gk0[1]); o[1] = cvt_pk_bf16(v[2] * rs * gk0[2], v[3] * rs * gk0[3]); o[2] = cvt_pk_bf16(v[4] * rs * gk1[0], v[5] * rs * gk1[1]); o[3] = cvt_pk_bf16(v[6] * rs * gk1[2], v[7] * rs * gk1[3]);
          if (lane < 32) *((u32x4*)(KV + (size_t)tt * 768 + br * 256) + (lane & 15)) = o; } }
}
__device__ __forceinline__ void cmp2_tile(const bf16_t* HIDt, const bf16_t* w2t, const float* b2, const float* kg0, bf16_t* OUT) {
    int tid_ = threadIdx.x; asm volatile("" : "+v"(tid_)); const int lane = tid_ & 63, wave = __builtin_amdgcn_readfirstlane(tid_ >> 6), r32 = lane & 31, hi = lane >> 5; const int row = wave * 32 + r32;
    f32x16 acc[2];
#pragma unroll
    for (int r = 0; r < 16; ++r) { acc[0][r] = 0.f; acc[1][r] = 0.f; }
    bf16x8 bfr[16], a0[8], a1[8];
#pragma unroll
    for (int ks = 0; ks < 16; ++ks) bfr[ks] = *(const bf16x8*)(HIDt + (size_t)row * 256 + ks * 16 + hi * 8);
#pragma unroll
    for (int half = 0; half < 2; ++half) {
#pragma unroll
        for (int k8 = 0; k8 < 8; ++k8) { const int ks = half * 8 + k8; a0[k8] = *(const bf16x8*)(w2t + (size_t)r32 * 256 + ks * 16 + hi * 8); a1[k8] = *(const bf16x8*)(w2t + (size_t)(32 + r32) * 256 + ks * 16 + hi * 8); }
#pragma unroll
        for (int k8 = 0; k8 < 8; ++k8) { acc[0] = MFMA32(a0[k8], bfr[half * 8 + k8], acc[0]); acc[1] = MFMA32(a1[k8], bfr[half * 8 + k8], acc[1]); } }
    float bv[2][16], gv[2][16];
#pragma unroll
    for (int h = 0; h < 2; ++h)
#pragma unroll
        for (int r = 0; r < 16; ++r) { bv[h][r] = b2[32 * h + crow(r, hi)]; gv[h][r] = kg0 ? kg0[32 * h + crow(r, hi)] : 1.f; }
    float ss = 0.f;
#pragma unroll
    for (int h = 0; h < 2; ++h)
#pragma unroll
        for (int r = 0; r < 16; ++r) { const float v = acc[h][r] + bv[h][r]; acc[h][r] = v; ss += v * v; }
    if (kg0) { ss += __shfl_xor(ss, 32); const float rs = rsqrtf(ss * (1.f / 64.f) + 1e-6f);
#pragma unroll
        for (int h = 0; h < 2; ++h)
#pragma unroll
            for (int r = 0; r < 16; ++r) acc[h][r] *= rs * gv[h][r]; }
    const float keep = row == 255 ? 0.f : 1.f;
#pragma unroll
    for (int h = 0; h < 2; ++h)
#pragma unroll
        for (int a4 = 0; a4 < 4; ++a4) { u32x2 w; w.x = cvt_pk_bf16(acc[h][4 * a4] * keep, acc[h][4 * a4 + 1] * keep); w.y = cvt_pk_bf16(acc[h][4 * a4 + 2] * keep, acc[h][4 * a4 + 3] * keep); *(u32x2*)(OUT + (size_t)row * 64 + 32 * h + 8 * a4 + 4 * hi) = w; }
}

constexpr int SG_STAT = 0, SG_SSQ = 1024, SG_VN = 5120;
__device__ __forceinline__ void sgu_unit(LAS unsigned char* lds, int unit, const bf16_t* U, const bf16_t* Vb, const bf16_t* Wsg, const float* lng, const float* lnb, const float* sgb, bf16_t* MIX) {
    int tid_ = threadIdx.x; asm volatile("" : "+v"(tid_)); const int tid = tid_, lane = tid & 63, g = __builtin_amdgcn_readfirstlane(tid >> 6), r32 = lane & 31, hi = lane >> 5;
    const int tok0 = unit * 128;
    LAS float* STAT = (LAS float*)(lds + SG_STAT); LAS float* SSQA = (LAS float*)(lds + SG_SSQ);
    { const int tl = tid >> 2, part = tid & 3; const u32x4* p = (const u32x4*)(Vb + (size_t)(tok0 + tl) * 512 + part * 128); float s = 0.f, s2 = 0.f; u32x4 wl_[16];
#pragma unroll
      for (int i = 0; i < 16; ++i) wl_[i] = p[i];
#pragma unroll
      for (int i = 0; i < 16; ++i) { const u32x4 w = wl_[i];
#pragma unroll
          for (int e = 0; e < 4; ++e) { const float a = __uint_as_float(w[e] << 16), b = __uint_as_float(w[e] & 0xffff0000u); s += a + b; s2 += a * a + b * b; } }
      s += __shfl_xor(s, 1); s += __shfl_xor(s, 2); s2 += __shfl_xor(s2, 1); s2 += __shfl_xor(s2, 2);
      if (part == 0) { const float mu = s * (1.f / 512.f); const float var = fmaxf(s2 * (1.f / 512.f) - mu * mu, 0.f); STAT[tl * 2] = mu; STAT[tl * 2 + 1] = rsqrtf(var + 1e-6f); }
      }
    __syncthreads();
    LAS unsigned char* VN = lds + SG_VN + g * 16384;
    { const int piece = lane & 7; float gg[8], bb[8];
#pragma unroll
      for (int i = 0; i < 8; ++i) { gg[i] = lng[g * 64 + piece * 8 + i]; bb[i] = lnb[g * 64 + piece * 8 + i]; }
      u32x4 wv[16];
#pragma unroll
      for (int it = 0; it < 16; ++it) wv[it] = *(const u32x4*)(Vb + (size_t)(tok0 + it * 8 + (lane >> 3)) * 512 + g * 64 + piece * 8);
#pragma unroll
      for (int it = 0; it < 16; ++it) { const int row = it * 8 + (lane >> 3); const u32x4 w = wv[it]; const float mu = STAT[row * 2], rs = STAT[row * 2 + 1]; u32x4 o;
#pragma unroll
          for (int e = 0; e < 4; ++e) { const float a = (__uint_as_float(w[e] << 16) - mu) * rs * gg[2 * e] + bb[2 * e], b = (__uint_as_float(w[e] & 0xffff0000u) - mu) * rs * gg[2 * e + 1] + bb[2 * e + 1]; o[e] = cvt_pk_bf16(a, b); }
          *(LAS u32x4*)(VN + (piece >> 2) * 8192 + row * 64 + (piece & 3) * 16) = o; } }
    asm volatile("s_waitcnt lgkmcnt(0)" ::: "memory");
    f32x16 acc[2][4];
#pragma unroll
    for (int dh = 0; dh < 2; ++dh)
#pragma unroll
        for (int mt = 0; mt < 4; ++mt)
#pragma unroll
            for (int r = 0; r < 16; ++r) acc[dh][mt][r] = 0.f;
    const LAS char* vb = (const LAS char*)VN + ((lane >> 4) & 1) * 32 + (lane & 3) * 8 + (4 * hi + ((lane & 15) >> 2)) * 64;
    const bf16_t* wrow = Wsg + ((size_t)g * 128 + r32) * 128 + 8 * hi;
    bf16x8 wf[2][4];
#pragma unroll
    for (int mt = 0; mt < 4; ++mt) wf[0][mt] = *(const bf16x8*)(wrow + (size_t)mt * 32 * 128);
#pragma unroll
    for (int ks = 0; ks < 8; ++ks) { bf16x8 vf[2];
        if (ks < 7) {
#pragma unroll
            for (int mt = 0; mt < 4; ++mt) if (ks + 1 <= 2 * mt + 1) wf[(ks + 1) & 1][mt] = *(const bf16x8*)(wrow + (size_t)mt * 32 * 128 + (ks + 1) * 16); }
#pragma unroll
        for (int dh = 0; dh < 2; ++dh) { const s16x4 lo = vtr(vb + dh * 8192 + ks * 1024), hh = vtr(vb + dh * 8192 + ks * 1024 + 512); vf[dh] = VFRAG(lo, hh); }
#pragma unroll
        for (int mt = 0; mt < 4; ++mt) { if (ks <= 2 * mt + 1) { acc[0][mt] = MFMA32(vf[0], wf[ks & 1][mt], acc[0][mt]); acc[1][mt] = MFMA32(vf[1], wf[ks & 1][mt], acc[1][mt]); } } }
    u32x2 uu[2][8];
    { const bf16_t* up = U + (size_t)(tok0 + r32) * 512 + g * 64 + 4 * hi;
#pragma unroll
      for (int q = 0; q < 8; ++q) uu[0][q] = *(const u32x2*)(up + (q >> 2) * 32 + (q & 3) * 8); }
#pragma unroll
    for (int mt = 0; mt < 4; ++mt) { const int t = mt * 32 + r32; const float bias = sgb[g * 128 + t]; float ss = 0.f;
        if (mt < 3) { const bf16_t* upn = U + (size_t)(tok0 + t + 32) * 512 + g * 64 + 4 * hi;
#pragma unroll
            for (int q = 0; q < 8; ++q) uu[(mt + 1) & 1][q] = *(const u32x2*)(upn + (q >> 2) * 32 + (q & 3) * 8); }
#pragma unroll
        for (int dh = 0; dh < 2; ++dh)
#pragma unroll
            for (int a4 = 0; a4 < 4; ++a4) { const u32x2 w = uu[mt & 1][dh * 4 + a4];
                const float u0 = __uint_as_float(w.x << 16), u1 = __uint_as_float(w.x & 0xffff0000u), u2 = __uint_as_float(w.y << 16), u3 = __uint_as_float(w.y & 0xffff0000u);
                float x0 = u0 * (acc[dh][mt][4 * a4] + bias), x1 = u1 * (acc[dh][mt][4 * a4 + 1] + bias), x2 = u2 * (acc[dh][mt][4 * a4 + 2] + bias), x3 = u3 * (acc[dh][mt][4 * a4 + 3] + bias);
                acc[dh][mt][4 * a4] = x0; acc[dh][mt][4 * a4 + 1] = x1; acc[dh][mt][4 * a4 + 2] = x2; acc[dh][mt][4 * a4 + 3] = x3; ss += (x0 * x0 + x1 * x1) + (x2 * x2 + x3 * x3); }
        ss += __shfl_xor(ss, 32); if (hi == 0) SSQA[g * 128 + t] = ss; }
    __syncthreads();
#pragma unroll
    for (int mt = 0; mt < 4; ++mt) { const int t = mt * 32 + r32; float sa = 0.f;
#pragma unroll
        for (int w8 = 0; w8 < 8; ++w8) sa += SSQA[w8 * 128 + t];
        const float rs = rsqrtf(sa * (1.f / 512.f) + 1e-6f); bf16_t* op = MIX + (size_t)(tok0 + t) * 1024 + g * 64 + 4 * hi;
#pragma unroll
        for (int dh = 0; dh < 2; ++dh)
#pragma unroll
            for (int a4 = 0; a4 < 4; ++a4) { u32x2 w; w.x = cvt_pk_bf16(acc[dh][mt][4 * a4] * rs, acc[dh][mt][4 * a4 + 1] * rs); w.y = cvt_pk_bf16(acc[dh][mt][4 * a4 + 2] * rs, acc[dh][mt][4 * a4 + 3] * rs); *(u32x2*)(op + dh * 32 + a4 * 8) = w; } }
    __syncthreads();
}

constexpr int A_KB = 0, A_VB = 32768, A_IMPH = 65536, A_LINV = 132096, A_MASK = 133120, A_SSQ = 133632  ;
__device__ __forceinline__ void attn_cmp(LAS unsigned char* lds, const bf16_t* Kb, const bf16_t* Vb, int ntc, const bf16x8 (&qr)[4], f32x16 (&oT)[2], float& lsum,
                                         int kmin, int kmax, int kvh, int wave, int lane, int r32, int hi) {
    const int pitch = 64, hstride = 256 * 64;
    u32x4 sk0, sk1, sv0, sv1;
    const bf16_t* kthr = Kb + (size_t)lane * pitch + wave * 8; const bf16_t* vthr = Vb + (size_t)(16 * (wave & 3) + (lane >> 2)) * pitch + (wave >> 2) * 32 + (lane & 3) * 8;
    const int sdst = wave * 1024 + lane * 16;
#define A_LD(tile) do { const size_t to_ = (size_t)(tile) * 64 * pitch; sk0 = *(const u32x4*)(kthr + to_); sk1 = *(const u32x4*)(kthr + to_ + hstride); sv0 = *(const u32x4*)(vthr + to_); sv1 = *(const u32x4*)(vthr + to_ + hstride); } while (0)
#define A_ST(so) do { *(LAS u32x4*)(lds + A_KB + (so) + sdst) = sk0; *(LAS u32x4*)(lds + A_KB + (so) + 8192 + sdst) = sk1; *(LAS u32x4*)(lds + A_VB + (so) + sdst) = sv0; *(LAS u32x4*)(lds + A_VB + (so) + 8192 + sdst) = sv1; } while (0)
    const LAS char* kbase = (const LAS char*)(lds + A_KB) + kvh * 8192 + hi * 1024 + r32 * 16;
    const LAS char* vbase = (const LAS char*)(lds + A_VB) + kvh * 8192 + ((lane >> 4) & 1) * 32 + (lane & 3) * 8 + (4 * hi + ((lane & 15) >> 2)) * 64;
    LAS float* IMPH = (LAS float*)(lds + A_IMPH) + (wave * 32 + r32) * 65;
    float carry = 0.f;
    A_LD(0); A_ST(0); __syncthreads();
#pragma unroll 1
    for (int tile = 0; tile < ntc; ++tile) {
        const int so = (tile & 1) * 16384;
        if (tile + 1 < ntc) A_LD(tile + 1);
        bf16x8 kf[8];
#pragma unroll
        for (int d0 = 0; d0 < 4; ++d0) { kf[2 * d0] = *(const LAS bf16x8*)(kbase + so + d0 * 2048); kf[2 * d0 + 1] = *(const LAS bf16x8*)(kbase + so + d0 * 2048 + 512); }
        f32x16 p0, p1;
#pragma unroll
        for (int r = 0; r < 16; ++r) { p0[r] = 0.f; p1[r] = 0.f; }
#pragma unroll
        for (int d0 = 0; d0 < 4; ++d0) { p0 = MFMA32(kf[2 * d0], qr[d0], p0); p1 = MFMA32(kf[2 * d0 + 1], qr[d0], p1); }
        const int a = kmin - 64 * tile, bb = kmax - 64 * tile;
#pragma unroll
        for (int r = 0; r < 16; ++r) { p0[r] = __builtin_amdgcn_exp2f(p0[r]); p1[r] = __builtin_amdgcn_exp2f(p1[r]); }
        if (!__all(a <= 0 && bb >= 63)) { const unsigned span = (unsigned)(bb - a);
#pragma unroll
            for (int r = 0; r < 16; ++r) { const int rel = crow(r, hi); p0[r] = ((unsigned)(rel - a) <= span) ? p0[r] : 0.f; p1[r] = ((unsigned)(rel + 32 - a) <= span) ? p1[r] : 0.f; } }
        { float s = 0.f;
#pragma unroll
          for (int r = 0; r < 16; ++r) s += p0[r] + p1[r];
          lsum += s; }
        { float own[2][4], rcv[2][4];
#pragma unroll
          for (int a4 = 0; a4 < 4; ++a4) { const float h0 = 0.5f * p0[4 * a4 + 3], h1 = 0.5f * p1[4 * a4 + 3];
              own[0][a4] = (p0[4 * a4] + p0[4 * a4 + 1]) + (p0[4 * a4 + 2] + h0); own[1][a4] = (p1[4 * a4] + p1[4 * a4 + 1]) + (p1[4 * a4 + 2] + h1);
              rcv[0][a4] = __shfl_xor(h0, 32); rcv[1][a4] = __shfl_xor(h1, 32); }
#pragma unroll
          for (int h2 = 0; h2 < 2; ++h2)
#pragma unroll
              for (int a4 = 0; a4 < 4; ++a4) { const float fromprev = a4 > 0 ? rcv[h2][a4 - 1] : (h2 ? rcv[0][3] : carry);
                  IMPH[16 * tile + 8 * h2 + 2 * a4 + hi] = own[h2][a4] + (hi ? rcv[h2][a4] : fromprev); }
          carry = rcv[1][3]; }
        bf16x8 pa[4];
        { u32x4 w0, w1, w2, w3;
#pragma unroll
          for (int i = 0; i < 4; ++i) { w0[i] = cvt_pk_bf16(p0[2 * i], p0[2 * i + 1]); w1[i] = cvt_pk_bf16(p0[8 + 2 * i], p0[8 + 2 * i + 1]); w2[i] = cvt_pk_bf16(p1[2 * i], p1[2 * i + 1]); w3[i] = cvt_pk_bf16(p1[8 + 2 * i], p1[8 + 2 * i + 1]); }
          pa[0] = __builtin_bit_cast(bf16x8, w0); pa[1] = __builtin_bit_cast(bf16x8, w1); pa[2] = __builtin_bit_cast(bf16x8, w2); pa[3] = __builtin_bit_cast(bf16x8, w3); }
#pragma unroll
        for (int dh = 0; dh < 2; ++dh)
#pragma unroll
            for (int ks = 0; ks < 4; ++ks) { const s16x4 lo = vtr(vbase + so + dh * 4096 + ks * 1024), hh = vtr(vbase + so + dh * 4096 + ks * 1024 + 512); oT[dh] = MFMA32(VFRAG(lo, hh), pa[ks], oT[dh]); }
        if (tile + 1 < ntc) A_ST(so ^ 16384);
        __syncthreads();
    }
#undef A_LD
#undef A_ST
}

constexpr int A2_K = 0, A2_V = 49152, A2_SL = 16384;
#define SBAR() __builtin_amdgcn_sched_barrier(0)
#define PIN(x) asm volatile("" : "+v"(x))
#define WAIT_BAR(N) asm volatile("s_waitcnt vmcnt(" #N ") lgkmcnt(0)\n\ts_barrier" ::: "memory")
__device__ __forceinline__ void glds16(const void* g, unsigned lds_base) {
    unsigned sv; asm volatile("s_mov_b32 %0, m0\n\ts_mov_b32 m0, %2\n\ts_nop 0\n\tglobal_load_lds_dwordx4 %1, off\n\ts_mov_b32 m0, %0" : "=&s"(sv) : "v"(g), "s"(lds_base) : "memory"); }
__device__ __forceinline__ void range_mask(f32x16& c0, f32x16& c1, int a, int bb, int hi) {
    const unsigned span = (unsigned)(bb - a);
#pragma unroll
    for (int r = 0; r < 16; ++r) { const int rel = crow(r, hi); c0[r] = ((unsigned)(rel - a) <= span) ? c0[r] : -INFINITY; c1[r] = ((unsigned)(rel + 32 - a) <= span) ? c1[r] : -INFINITY; }
}
template <bool WIN>
__device__ __forceinline__ void attn_stream(LAS unsigned char* lds, const bf16_t* Kb, const bf16_t* Vb, int tlo, int NT, const bf16x8 (&qr)[4], f32x16 (&oT)[2], float& l_out,
                                            unsigned mlo, unsigned mhi, int tq, int kvh, int wave, int lane, int r32, int hi) {
    const unsigned lds0 = (unsigned)(uintptr_t)lds;
    const bf16_t* ksrc = Kb + (size_t)lane * 768 + wave * 8;
    const bf16_t* vsrc = Vb + (size_t)(16 * (wave & 3) + (lane >> 2)) * 768 + (wave >> 2) * 32 + (lane & 3) * 8;
    const unsigned kdst = lds0 + A2_K + wave * 1024, vdst = lds0 + A2_V + wave * 1024;
#define RFL(x) ((unsigned)__builtin_amdgcn_readfirstlane((int)(x)))
#define TCL(i) ((size_t)(tlo + ((i) < NT ? (i) : NT - 1)) * (64 * 768))
#define DMA_K(i, slot) do { const bf16_t* s_ = ksrc + TCL(i); glds16(s_, RFL(kdst + (slot))); glds16(s_ + 64, RFL(kdst + (slot) + 8192)); } while (0)
#define DMA_V(i, slot) do { const bf16_t* s_ = vsrc + TCL(i); glds16(s_, RFL(vdst + (slot))); glds16(s_ + 64, RFL(vdst + (slot) + 8192)); } while (0)
#define TMASK(idx_, a_, bb_, selm_) do { const int tt_ = tlo + (idx_); if (WIN) { a_ = tq - 511 - 64 * tt_; bb_ = tq - 64 * tt_; selm_ = ~0u; } \
        else { const unsigned s_ = tt_ < 32 ? (mlo >> tt_) & 1u : (mhi >> (tt_ - 32)) & 1u; a_ = -64 * tt_; bb_ = tq - 64 * tt_; selm_ = 0u - s_; } } while (0)
#define NEEDM(a_, bb_, selm_) (!__all((selm_) == 0u || ((a_) <= 0 && (bb_) >= 63)))
    const LAS char* kp0 = (const LAS char*)(lds + A2_K) + kvh * 8192 + hi * 1024 + r32 * 16;
    const LAS char* vp0 = (const LAS char*)(lds + A2_V) + kvh * 8192 + ((lane >> 4) & 1) * 32 + (lane & 3) * 8 + (4 * hi + ((lane & 15) >> 2)) * 64;
    asm volatile("s_waitcnt vmcnt(0)" ::: "memory");
    DMA_K(0, 0); DMA_V(0, 0); DMA_K(1, A2_SL); DMA_K(2, 2 * A2_SL);
    float l_reg = 0.f; f32x16 pA0, pA1, pB0, pB1; bf16x8 kf[8]; s16x4 vlo[8], vhi[8]; u32x4 pw0, pw1, pw2, pw3; unsigned selm_prev;
    const f32x16 zero16 = {0.f, 0.f, 0.f, 0.f, 0.f, 0.f, 0.f, 0.f, 0.f, 0.f, 0.f, 0.f, 0.f, 0.f, 0.f, 0.f};
    int sl_prev = 0, sl_cur = 0, sl_next = A2_SL;
#define ROT() do { sl_prev = sl_cur; sl_cur = sl_next; sl_next = (sl_next == 2 * A2_SL) ? 0 : sl_next + A2_SL; } while (0)
#define KLD(kp, d0) do { kf[2 * (d0)] = *(const LAS bf16x8*)((kp) + (d0) * 2048); kf[2 * (d0) + 1] = *(const LAS bf16x8*)((kp) + (d0) * 2048 + 512); } while (0)
    WAIT_BAR(6);
    KLD(kp0, 0); KLD(kp0, 1); KLD(kp0, 2); KLD(kp0, 3);
    pA0 = MFMA32(kf[0], qr[0], zero16); pA1 = MFMA32(kf[1], qr[0], zero16); pA0 = MFMA32(kf[2], qr[1], pA0); pA1 = MFMA32(kf[3], qr[1], pA1);
    pA0 = MFMA32(kf[4], qr[2], pA0); pA1 = MFMA32(kf[5], qr[2], pA1); pA0 = MFMA32(kf[6], qr[3], pA0); pA1 = MFMA32(kf[7], qr[3], pA1);
    { int a_, bb_; TMASK(0, a_, bb_, selm_prev); if (NEEDM(a_, bb_, selm_prev)) range_mask(pA0, pA1, a_, bb_, hi); }
#pragma unroll
    for (int r = 0; r < 16; ++r) { pA0[r] = __builtin_amdgcn_exp2f(pA0[r]); pA1[r] = __builtin_amdgcn_exp2f(pA1[r]); }
    WAIT_BAR(0);
    DMA_K(3, 0); DMA_V(1, A2_SL); ROT();
    KLD(kp0 + sl_cur, 0); KLD(kp0 + sl_cur, 1); KLD(kp0 + sl_cur, 2); KLD(kp0 + sl_cur, 3);
    WAIT_BAR(4);
#define PKW(P, i) cvt_pk_bf16(P[i], P[(i) + 1])
#define PAF(k) __builtin_bit_cast(bf16x8, pw##k)
#define VFR(i) VFRAG(vlo[i], vhi[i])
#define VRD(i) do { vlo[i] = vtr(vp_ + (((i) >> 2) * 4096 + ((i) & 3) * 1024)); vhi[i] = vtr(vp_ + (((i) >> 2) * 4096 + ((i) & 3) * 1024 + 512)); } while (0)
#define KRD(d0) do { KLD(kp0 + sl_next, d0); SBAR(); } while (0)
#define EX(v) __builtin_amdgcn_exp2f(v)
#define GAPA(MF, a0, a1, a2, a3, W0, W1, PW) do { MF; sacc += a0; sacc += a1; sacc += a2; sacc += a3; W0; W1; PIN(PW); PIN(sacc); SBAR(); } while (0)
#define GAPB(MF, X, i) do { MF; X[i] = EX(X[i]); X[(i) + 1] = EX(X[(i) + 1]); X[(i) + 2] = EX(X[(i) + 2]); X[(i) + 3] = EX(X[(i) + 3]); PIN(X); SBAR(); } while (0)
#define SELPW() do { if (!__all(selm_prev == ~0u)) { const u32x4 m_ = {selm_prev, selm_prev, selm_prev, selm_prev}; pw0 = pw0 & m_; pw1 = pw1 & m_; pw2 = pw2 & m_; pw3 = pw3 & m_; } } while (0)
#define STEP(C0, C1, P0, P1, idx) do { SBAR(); \
    const LAS char* vp_ = vp0 + sl_prev; \
    VRD(0); SBAR(); float sacc = P0[0] + P0[1]; \
                    GAPA(C0 = MFMA32(kf[0], qr[0], zero16), P0[2], P0[3], P0[4], P0[5],     pw0[0] = PKW(P0, 0),  pw0[1] = PKW(P0, 2),  pw0); \
    VRD(4); SBAR(); GAPA(C1 = MFMA32(kf[1], qr[0], zero16), P0[6], P0[7], P0[8], P0[9],     pw0[2] = PKW(P0, 4),  pw0[3] = PKW(P0, 6),  pw0); \
    VRD(1); SBAR(); GAPA(C0 = MFMA32(kf[2], qr[1], C0),     P0[10], P0[11], P0[12], P0[13], pw1[0] = PKW(P0, 8),  pw1[1] = PKW(P0, 10), pw1); \
    VRD(5); SBAR(); GAPA(C1 = MFMA32(kf[3], qr[1], C1),     P0[14], P0[15], P1[0], P1[1],   pw1[2] = PKW(P0, 12), pw1[3] = PKW(P0, 14), pw1); \
    VRD(2); SBAR(); GAPA(C0 = MFMA32(kf[4], qr[2], C0),     P1[2], P1[3], P1[4], P1[5],     pw2[0] = PKW(P1, 0),  pw2[1] = PKW(P1, 2),  pw2); \
    VRD(6); SBAR(); GAPA(C1 = MFMA32(kf[5], qr[2], C1),     P1[6], P1[7], P1[8], P1[9],     pw2[2] = PKW(P1, 4),  pw2[3] = PKW(P1, 6),  pw2); \
    VRD(3); SBAR(); GAPA(C0 = MFMA32(kf[6], qr[3], C0),     P1[10], P1[11], P1[12], P1[13], pw3[0] = PKW(P1, 8),  pw3[1] = PKW(P1, 10), pw3); \
    VRD(7); SBAR(); GAPA(C1 = MFMA32(kf[7], qr[3], C1),     P1[14], P1[15], 0.f, 0.f,       pw3[2] = PKW(P1, 12), pw3[3] = PKW(P1, 14), pw3); \
    l_reg += __uint_as_float(__float_as_uint(sacc) & selm_prev); SELPW(); \
    DMA_K((idx) + 3, sl_cur); DMA_V((idx) + 1, sl_next); \
    { int a_, bb_; unsigned selm_; TMASK(idx, a_, bb_, selm_); if (NEEDM(a_, bb_, selm_)) range_mask(C0, C1, a_, bb_, hi); selm_prev = selm_; } \
    SBAR(); \
    GAPB(oT[0] = MFMA32(VFR(0), PAF(0), oT[0]), C0, 0);            GAPB(oT[1] = MFMA32(VFR(4), PAF(0), oT[1]), C0, 4); \
    KRD(0); GAPB(oT[0] = MFMA32(VFR(1), PAF(1), oT[0]), C0, 8);    KRD(1); GAPB(oT[1] = MFMA32(VFR(5), PAF(1), oT[1]), C0, 12); \
    KRD(2); GAPB(oT[0] = MFMA32(VFR(2), PAF(2), oT[0]), C1, 0);    KRD(3); GAPB(oT[1] = MFMA32(VFR(6), PAF(2), oT[1]), C1, 4); \
    GAPB(oT[0] = MFMA32(VFR(3), PAF(3), oT[0]), C1, 8);            GAPB(oT[1] = MFMA32(VFR(7), PAF(3), oT[1]), C1, 12); \
    } while (0)
    int idx = 1;
#pragma unroll 1
    for (; idx + 1 < NT; idx += 2) {
        STEP(pB0, pB1, pA0, pA1, idx);     WAIT_BAR(4); ROT();
        STEP(pA0, pA1, pB0, pB1, idx + 1); WAIT_BAR(4); ROT();
    }
    if (idx < NT) { STEP(pB0, pB1, pA0, pA1, idx); WAIT_BAR(4); ROT(); pA0 = pB0; pA1 = pB1; }
    { float sacc = 0.f;
#pragma unroll
      for (int r = 0; r < 16; ++r) sacc += pA0[r] + pA1[r];
      l_reg += __uint_as_float(__float_as_uint(sacc) & selm_prev);
      pw0 = (u32x4){PKW(pA0, 0), PKW(pA0, 2), PKW(pA0, 4), PKW(pA0, 6)}; pw1 = (u32x4){PKW(pA0, 8), PKW(pA0, 10), PKW(pA0, 12), PKW(pA0, 14)};
      pw2 = (u32x4){PKW(pA1, 0), PKW(pA1, 2), PKW(pA1, 4), PKW(pA1, 6)}; pw3 = (u32x4){PKW(pA1, 8), PKW(pA1, 10), PKW(pA1, 12), PKW(pA1, 14)};
      SELPW();
      const LAS char* vp_ = vp0 + ((NT - 1) % 3) * A2_SL;
#pragma unroll
      for (int i = 0; i < 8; ++i) VRD(i);
      oT[0] = MFMA32(VFR(0), PAF(0), oT[0]); oT[1] = MFMA32(VFR(4), PAF(0), oT[1]); oT[0] = MFMA32(VFR(1), PAF(1), oT[0]); oT[1] = MFMA32(VFR(5), PAF(1), oT[1]);
      oT[0] = MFMA32(VFR(2), PAF(2), oT[0]); oT[1] = MFMA32(VFR(6), PAF(2), oT[1]); oT[0] = MFMA32(VFR(3), PAF(3), oT[0]); oT[1] = MFMA32(VFR(7), PAF(3), oT[1]); }
    WAIT_BAR(0);
    l_out = l_reg;
#undef RFL
#undef TCL
#undef DMA_K
#undef DMA_V
#undef TMASK
#undef NEEDM
#undef ROT
#undef KLD
#undef PKW
#undef PAF
#undef VFR
#undef VRD
#undef KRD
#undef EX
#undef GAPA
#undef GAPB
#undef SELPW
#undef STEP
}

template <int PARTS>
__device__ __forceinline__ void attn_unit(LAS unsigned char* lds, int b, int qt, const bf16_t* Q, const bf16_t* KV, const bf16_t* KC, const bf16_t* VC, const float* GL, bf16_t* MIX) {
    int tid_ = threadIdx.x; asm volatile("" : "+v"(tid_)); const int tid = tid_, lane = tid & 63, wave = __builtin_amdgcn_readfirstlane(tid >> 6), r32 = lane & 31, hi = lane >> 5, kvh = wave >> 2;
    const int t0 = qt * 32, tq = t0 + r32; const size_t tok = (size_t)b * T + tq;
    bf16x8 qr[4];
#pragma unroll
    for (int d0 = 0; d0 < 4; ++d0) qr[d0] = *(const bf16x8*)(Q + tok * 512 + wave * 64 + d0 * 16 + hi * 8);
    LAS float* IMPHA = (LAS float*)(lds + A_IMPH); LAS float* LINV = (LAS float*)(lds + A_LINV); LAS unsigned* MASKL = (LAS unsigned*)(lds + A_MASK); LAS float* SSQL = (LAS float*)(lds + A_SSQ);
    const float* glp = GL + tok * 24 + wave * 3;
    const float g0 = 1.f / (1.f + __expf(-glp[0])), g1 = 1.f / (1.f + __expf(-glp[1])), g2 = 1.f / (1.f + __expf(-glp[2]));
    f32x16 tot[2], oT[2];
    const int nvalid = tq >= 31 ? (tq - 31) / 16 + 1 : 0; const int ntc = (2 * qt + 1 + 63) >> 6;
    const int ckmin = nvalid > 0 ? 0 : (1 << 20), ckmax = nvalid > 0 ? nvalid - 1 : (1 << 20);
    const bf16_t* KCb = KC + (size_t)(b * 2) * 256 * 64; const bf16_t* VCb = VC + (size_t)(b * 2) * 256 * 64;
    float lc = 0.f;
#pragma unroll
    for (int r = 0; r < 16; ++r) { oT[0][r] = 0.f; oT[1][r] = 0.f; }
    if constexpr (PARTS & 1) attn_cmp(lds, KCb, VCb, ntc, qr, oT, lc, ckmin, ckmax, kvh, wave, lane, r32, hi);
    lc += __shfl_xor(lc, 32); const float inv_lc = lc > 0.f ? 1.f / lc : 0.f;
    if (hi == 0) LINV[wave * 32 + r32] = inv_lc;
    { const float c = g0 * inv_lc;
#pragma unroll
      for (int r = 0; r < 16; ++r) { tot[0][r] = oT[0][r] * c; tot[1][r] = oT[1][r] * c; oT[0][r] = 0.f; oT[1][r] = 0.f; } }
    __syncthreads();
    if constexpr (PARTS & 2) {
      unsigned key[8], srt[8];
#pragma unroll
      for (int i = 0; i < 8; ++i) { const int pair = wave * 8 + i, kvp = pair >> 5, qq = pair & 31, j = lane; const int tb = (t0 + qq) >> 6; float v = 0.f;
#pragma unroll
          for (int g = 0; g < 4; ++g) v += IMPHA[((kvp * 4 + g) * 32 + qq) * 65 + j] * LINV[(kvp * 4 + g) * 32 + qq];
          const bool forced = (j == 0) || (j == tb) || (j == tb - 1); const float val = forced ? 1e4f : (j <= tb ? v : -1e4f);
          unsigned k = __float_as_uint(val); k ^= (k & 0x80000000u) ? 0xffffffffu : 0x80000000u; key[i] = (k & ~63u) | (unsigned)(63 - j); srt[i] = key[i]; }
#define TK_STAGE(K_, J_) do { const bool keepmax_ = (((lane & (K_)) == 0) == ((lane & (J_)) == 0)); \
        _Pragma("unroll") for (int i = 0; i < 8; ++i) { const unsigned o_ = (J_) == 32 ? (unsigned)__shfl_xor((int)srt[i], 32) : (unsigned)__builtin_amdgcn_ds_swizzle((int)srt[i], 0x1f | ((J_) << 10)); \
            const unsigned mx_ = srt[i] > o_ ? srt[i] : o_, mn_ = srt[i] > o_ ? o_ : srt[i]; srt[i] = keepmax_ ? mx_ : mn_; } } while (0)
      TK_STAGE(2, 1);
      TK_STAGE(4, 2); TK_STAGE(4, 1);
      TK_STAGE(8, 4); TK_STAGE(8, 2); TK_STAGE(8, 1);
      TK_STAGE(16, 8); TK_STAGE(16, 4); TK_STAGE(16, 2); TK_STAGE(16, 1);
      TK_STAGE(32, 16); TK_STAGE(32, 8); TK_STAGE(32, 4); TK_STAGE(32, 2); TK_STAGE(32, 1);
      TK_STAGE(64, 32); TK_STAGE(64, 16); TK_STAGE(64, 8); TK_STAGE(64, 4); TK_STAGE(64, 2); TK_STAGE(64, 1);
#undef TK_STAGE
#pragma unroll
      for (int i = 0; i < 8; ++i) { const unsigned thr = (unsigned)__builtin_amdgcn_readlane((int)srt[i], 15);
          const unsigned long long m = __ballot(key[i] >= thr); if (lane == 0) { MASKL[(wave * 8 + i) * 2] = (unsigned)m; MASKL[(wave * 8 + i) * 2 + 1] = (unsigned)(m >> 32); } } }
    __syncthreads();
    const unsigned mlo = MASKL[(kvh * 32 + r32) * 2], mhi = MASKL[(kvh * 32 + r32) * 2 + 1];
    const int jmax = (t0 + 31) >> 6;
    const bf16_t* KVb = KV + (size_t)b * T * 768;
    unsigned totp[16];
#pragma unroll
    for (int i = 0; i < 8; ++i) { totp[i] = cvt_pk_bf16(tot[0][2 * i], tot[0][2 * i + 1]); totp[8 + i] = cvt_pk_bf16(tot[1][2 * i], tot[1][2 * i + 1]); }
    float ls = 0.f;
    if constexpr (PARTS & 4) attn_stream<false>(lds, KVb + 256, KVb + 384, 0, jmax + 1, qr, oT, ls, mlo, mhi, tq, kvh, wave, lane, r32, hi);
    ls += __shfl_xor(ls, 32);
    { const float c = ls > 0.f ? g1 / ls : 0.f;
#pragma unroll
      for (int i = 0; i < 8; ++i) { totp[i] = cvt_pk_bf16(__uint_as_float(totp[i] << 16) + oT[0][2 * i] * c, __uint_as_float(totp[i] & 0xffff0000u) + oT[0][2 * i + 1] * c);
                                    totp[8 + i] = cvt_pk_bf16(__uint_as_float(totp[8 + i] << 16) + oT[1][2 * i] * c, __uint_as_float(totp[8 + i] & 0xffff0000u) + oT[1][2 * i + 1] * c); }
#pragma unroll
      for (int r = 0; r < 16; ++r) { oT[0][r] = 0.f; oT[1][r] = 0.f; } }
    float lw = 0.f; const int jlo = t0 >= 511 ? (t0 - 511) >> 6 : 0;
    if constexpr (PARTS & 8) attn_stream<true>(lds, KVb + 512, KVb + 640, jlo, jmax - jlo + 1, qr, oT, lw, 0u, 0u, tq, kvh, wave, lane, r32, hi);
    lw += __shfl_xor(lw, 32);
    { const float c = lw > 0.f ? g2 / lw : 0.f;
#pragma unroll
      for (int i = 0; i < 8; ++i) { tot[0][2 * i] = __uint_as_float(totp[i] << 16) + oT[0][2 * i] * c; tot[0][2 * i + 1] = __uint_as_float(totp[i] & 0xffff0000u) + oT[0][2 * i + 1] * c;
                                    tot[1][2 * i] = __uint_as_float(totp[8 + i] << 16) + oT[1][2 * i] * c; tot[1][2 * i + 1] = __uint_as_float(totp[8 + i] & 0xffff0000u) + oT[1][2 * i + 1] * c; } }
    { float ss = 0.f;
#pragma unroll
      for (int r = 0; r < 16; ++r) ss += tot[0][r] * tot[0][r] + tot[1][r] * tot[1][r];
      ss += __shfl_xor(ss, 32); if (hi == 0) SSQL[wave * 32 + r32] = ss; }
    __syncthreads();
    { float sa = 0.f;
#pragma unroll
      for (int w8 = 0; w8 < 8; ++w8) sa += SSQL[w8 * 32 + r32];
      const float rs = rsqrtf(sa * (1.f / 512.f) + 1e-6f); bf16_t* op = MIX + tok * 1024 + 512 + wave * 64 + 4 * hi;
#pragma unroll
      for (int dh = 0; dh < 2; ++dh)
#pragma unroll
          for (int a4 = 0; a4 < 4; ++a4) { u32x2 w; w.x = cvt_pk_bf16(tot[dh][4 * a4] * rs, tot[dh][4 * a4 + 1] * rs); w.y = cvt_pk_bf16(tot[dh][4 * a4 + 2] * rs, tot[dh][4 * a4 + 3] * rs); *(u32x2*)(op + dh * 32 + a4 * 8) = w; } }
    __syncthreads();
}

__device__ __forceinline__ void memattn_unit(LAS unsigned char* lds, int b, int h, int qt, const bf16_t* QM, const bf16_t* KVM, const float* qg, bf16_t* OM) {
    int tid_ = threadIdx.x; asm volatile("" : "+v"(tid_)); const int tid = tid_, lane = tid & 63, wave = __builtin_amdgcn_readfirstlane(tid >> 6), r32 = lane & 31, hi = lane >> 5;
    const size_t tok = (size_t)b * T + qt * 256 + wave * 32 + r32;
    bf16x8 qr[8];
    { float v[64]; float ss = 0.f;
#pragma unroll
      for (int d0 = 0; d0 < 8; ++d0) { const u32x4 w = *(const u32x4*)(QM + tok * 512 + h * 128 + d0 * 16 + hi * 8);
#pragma unroll
          for (int i = 0; i < 4; ++i) { const float a = __uint_as_float(w[i] << 16), c = __uint_as_float(w[i] & 0xffff0000u); v[d0 * 8 + 2 * i] = a; v[d0 * 8 + 2 * i + 1] = c; ss += a * a + c * c; } }
      ss += __shfl_xor(ss, 32); const float rs = rsqrtf(ss * (1.f / 128.f) + 1e-6f) * (0.08838834764831845f * 1.4426950408889634f);
#pragma unroll
      for (int d0 = 0; d0 < 8; ++d0) { u32x4 w; const float* gp = qg + d0 * 16 + hi * 8;
#pragma unroll
          for (int i = 0; i < 4; ++i) w[i] = cvt_pk_bf16(v[d0 * 8 + 2 * i] * rs * gp[2 * i], v[d0 * 8 + 2 * i + 1] * rs * gp[2 * i + 1]);
          qr[d0] = __builtin_bit_cast(bf16x8, w); } }
    const bf16_t* Kg = KVM + (size_t)b * 256 * 1024 + h * 128; const bf16_t* Vg = Kg + 512;
    u32x4 sk[2], sv[2];
#define M_LD(tile) do { _Pragma("unroll") for (int i = 0; i < 2; ++i) { sk[i] = *(const u32x4*)(Kg + (size_t)((tile) * 64 + lane) * 1024 + (wave * 2 + i) * 8); const int p = i * 512 + tid; \
        sv[i] = *(const u32x4*)(Vg + (size_t)((tile) * 64 + ((p & 255) >> 2)) * 1024 + (p >> 8) * 32 + (p & 3) * 8); } } while (0)
#define M_ST(so) do { _Pragma("unroll") for (int i = 0; i < 2; ++i) { *(LAS u32x4*)(lds + (so) + (wave * 2 + i) * 1024 + lane * 16) = sk[i]; *(LAS u32x4*)(lds + 32768 + (so) + (i * 512 + tid) * 16) = sv[i]; } } while (0)
    const LAS char* kbase = (const LAS char*)lds + hi * 1024 + r32 * 16;
    const LAS char* vbase = (const LAS char*)lds + 32768 + ((lane >> 4) & 1) * 32 + (lane & 3) * 8 + (4 * hi + ((lane & 15) >> 2)) * 64;
    f32x16 oT[4]; float lsum = 0.f;
#pragma unroll
    for (int dq = 0; dq < 4; ++dq)
#pragma unroll
        for (int r = 0; r < 16; ++r) oT[dq][r] = 0.f;
    M_LD(0); M_ST(0); __syncthreads();
#pragma unroll 1
    for (int tile = 0; tile < 4; ++tile) { const int so = (tile & 1) * 16384;
        if (tile < 3) M_LD(tile + 1);
        f32x16 p0, p1;
#pragma unroll
        for (int r = 0; r < 16; ++r) { p0[r] = 0.f; p1[r] = 0.f; }
#pragma unroll
        for (int d0 = 0; d0 < 8; ++d0) { const bf16x8 k0 = *(const LAS bf16x8*)(kbase + so + d0 * 2048), k1 = *(const LAS bf16x8*)(kbase + so + d0 * 2048 + 512); p0 = MFMA32(k0, qr[d0], p0); p1 = MFMA32(k1, qr[d0], p1); }
        float s = 0.f;
#pragma unroll
        for (int r = 0; r < 16; ++r) { p0[r] = __builtin_amdgcn_exp2f(p0[r]); p1[r] = __builtin_amdgcn_exp2f(p1[r]); s += p0[r] + p1[r]; }
        lsum += s;
        bf16x8 pa[4];
        { u32x4 w0, w1, w2, w3;
#pragma unroll
          for (int i = 0; i < 4; ++i) { w0[i] = cvt_pk_bf16(p0[2 * i], p0[2 * i + 1]); w1[i] = cvt_pk_bf16(p0[8 + 2 * i], p0[8 + 2 * i + 1]); w2[i] = cvt_pk_bf16(p1[2 * i], p1[2 * i + 1]); w3[i] = cvt_pk_bf16(p1[8 + 2 * i], p1[8 + 2 * i + 1]); }
          pa[0] = __builtin_bit_cast(bf16x8, w0); pa[1] = __builtin_bit_cast(bf16x8, w1); pa[2] = __builtin_bit_cast(bf16x8, w2); pa[3] = __builtin_bit_cast(bf16x8, w3); }
#pragma unroll
        for (int dq = 0; dq < 4; ++dq)
#pragma unroll
            for (int ks = 0; ks < 4; ++ks) { const s16x4 lo = vtr(vbase + so + dq * 4096 + ks * 1024), hh = vtr(vbase + so + dq * 4096 + ks * 1024 + 512); oT[dq] = MFMA32(VFRAG(lo, hh), pa[ks], oT[dq]); }
        if (tile < 3) M_ST(so ^ 16384);
        __syncthreads();
    }
#undef M_LD
#undef M_ST
    lsum += __shfl_xor(lsum, 32); const float il = 1.f / lsum; bf16_t* op = OM + tok * 512 + h * 128 + 4 * hi;
#pragma unroll
    for (int dq = 0; dq < 4; ++dq)
#pragma unroll
        for (int a4 = 0; a4 < 4; ++a4) { u32x2 w; w.x = cvt_pk_bf16(oT[dq][4 * a4] * il, oT[dq][4 * a4 + 1] * il); w.y = cvt_pk_bf16(oT[dq][4 * a4 + 2] * il, oT[dq][4 * a4 + 3] * il); *(u32x2*)(op + dq * 32 + a4 * 8) = w; }
}

#define XB_TMO      128
#define XB_XCNT(j)  (256  + 64 * (j))
#define XB_XSUB(j)  (1280 + 64 * (j))
#define XB_XGEN(j)  (2304 + 64 * (j))
#define XB_TOP      3328
#define XB_TOPGEN   3392
#define XCD_BAR_WORDS 3456
#define XB_SPIN_CAP (1u << 18)
__device__ __forceinline__ unsigned xb_ld(unsigned* p)              { return __hip_atomic_load(p, __ATOMIC_RELAXED, __HIP_MEMORY_SCOPE_AGENT); }
__device__ __forceinline__ unsigned xb_add(unsigned* p, unsigned v) { return __hip_atomic_fetch_add(p, v, __ATOMIC_RELAXED, __HIP_MEMORY_SCOPE_AGENT); }
__device__ __forceinline__ unsigned xb_xcc_id() { return (unsigned)__builtin_amdgcn_s_getreg((3 << 11) | 20) & 0xFu; }
#define XB_SPIN(cond, bar) do { unsigned _sp = 0; while (cond) { __builtin_amdgcn_s_sleep(1); \
    if ((++_sp & 255u) == 0u) { if (xb_ld(&(bar)[XB_TMO])) break; if (_sp > XB_SPIN_CAP) { atomicAdd(&(bar)[XB_TMO], 1u); break; } } } } while (0)
struct XcdBarrier { unsigned* bar; unsigned x; volatile LAS unsigned* st; };
__device__ __forceinline__ XcdBarrier xcd_barrier_post(unsigned* bar, volatile LAS unsigned* st) {
    XcdBarrier b; b.bar = bar; b.x = xb_xcc_id(); b.st = st;
    if (threadIdx.x == 0) (void)xb_add(&bar[XB_XCNT(b.x)], 1u);
    return b;
}
__device__ __forceinline__ void xcd_barrier_complete(unsigned* bar, unsigned x, unsigned& nloc, unsigned& nx) {
    const unsigned G = gridDim.x * gridDim.y * gridDim.z;
    unsigned sum, cnt, mine, sp = 0u;
    for (;;) {
        sum = 0u; cnt = 0u; mine = 0u;
#pragma unroll
        for (unsigned j = 0; j < 16; ++j) { const unsigned c = xb_ld(&bar[XB_XCNT(j)]); sum += c; cnt += (c > 0u) ? 1u : 0u; mine = (j == x) ? c : mine; }
        if (sum == G) break;
        __builtin_amdgcn_s_sleep(1);
        if ((++sp & 255u) == 0u) { if (xb_ld(&bar[XB_TMO])) break; if (sp > XB_SPIN_CAP) { atomicAdd(&bar[XB_TMO], 1u); break; } }
    }
    nloc = mine > 0u ? mine : 1u; nx = cnt > 0u ? cnt : 1u;
}
__device__ __forceinline__ void xcd_barrier(const XcdBarrier& b) {
    asm volatile("s_waitcnt vmcnt(0)" ::: "memory");
    __syncthreads();
    if (threadIdx.x == 0) {
        unsigned* bar = b.bar;
        __builtin_amdgcn_s_waitcnt(0);
        unsigned nloc = b.st[0], nx = b.st[1];
        if (nloc == 0u) { xcd_barrier_complete(bar, b.x, nloc, nx); b.st[0] = nloc; b.st[1] = nx; }
        const unsigned old = xb_add(&bar[XB_XSUB(b.x)], 1u);
        const unsigned gen = old / nloc;
        if (old + 1u == (gen + 1u) * nloc) {
            __builtin_amdgcn_fence(__ATOMIC_RELEASE, "agent");
            asm volatile("s_waitcnt vmcnt(0)" ::: "memory");
            const unsigned og = xb_add(&bar[XB_TOP], 1u);
            const unsigned tg = og / nx;
            if (og + 1u == (tg + 1u) * nx) xb_add(&bar[XB_TOPGEN], 1u);
            else XB_SPIN(xb_ld(&bar[XB_TOPGEN]) == tg, bar);
            __builtin_amdgcn_fence(__ATOMIC_ACQUIRE, "agent");
            xb_add(&bar[XB_XGEN(b.x)], 1u);
            asm volatile("s_waitcnt vmcnt(0)" ::: "memory");
        } else {
            XB_SPIN(xb_ld(&bar[XB_XGEN(b.x)]) == gen, bar);
            __builtin_amdgcn_fence(__ATOMIC_ACQUIRE, "agent");
            asm volatile("s_waitcnt vmcnt(0)" ::: "memory");
        }
    }
    __syncthreads();
}
constexpr size_t CTL_BAR_BYTE = 704 * 1024;
constexpr size_t CTL_FLAG_BYTE = 720 * 1024;
constexpr int LDS_ST_OFF = 147456 - 64;

struct EpiCmp {
    static constexpr bool PERM = false, AFTER_DRAIN = true;
    const float* b1p; const bf16_t* w2t; const float* b2; const float* kg0; bf16_t* OUT; float* PART; unsigned* flag; unsigned epoch; int half;
    __device__ __forceinline__ void fused(f32x4 (&acc)[2][2][4][2], const pg8::Unit&, int wr, int wc, int fr, int fq, LAS unsigned char* lds, int wid, int lane) const {
        unsigned ep = epoch; asm volatile("" : "+s"(ep));
        LAS float* PB = (LAS float*)lds;
        LAS unsigned char* HB = lds;
#pragma unroll
        for (int ai = 0; ai < 2; ++ai)
#pragma unroll
            for (int m = 0; m < 4; ++m) { const int row = ai * 128 + wr * 64 + m * 16 + fr;
#pragma unroll
                for (int n = 0; n < 2; ++n) *(LAS f32x4*)(PB + row * 132 + wc * 32 + n * 16 + 4 * fq) = acc[ai][1][m][n]; }
        __syncthreads();
        u32x2 hv[2][4][2];
#pragma unroll
        for (int ai = 0; ai < 2; ++ai)
#pragma unroll
            for (int m = 0; m < 4; ++m) { const int row = ai * 128 + wr * 64 + m * 16 + fr;
#pragma unroll
                for (int n = 0; n < 2; ++n) { const int col = wc * 32 + n * 16 + 4 * fq; f32x4 pb = {0.f, 0.f, 0.f, 0.f}; if (row < 255) pb = *(const LAS f32x4*)(PB + (row + 1) * 132 + col);
                    const f32x4 bb = *(const f32x4*)(b1p + half * 128 + col); const f32x4 v = acc[ai][0][m][n] + pb + bb;
                    hv[ai][m][n].x = cvt_pk_bf16(pg8::gelu_tanh(v[0]), pg8::gelu_tanh(v[1])); hv[ai][m][n].y = cvt_pk_bf16(pg8::gelu_tanh(v[2]), pg8::gelu_tanh(v[3])); } }
        __syncthreads();
#pragma unroll
        for (int ai = 0; ai < 2; ++ai)
#pragma unroll
            for (int m = 0; m < 4; ++m) { const int row = ai * 128 + wr * 64 + m * 16 + fr;
#pragma unroll
                for (int n = 0; n < 2; ++n) *(LAS u32x2*)(HB + row * 272 + (wc * 32 + n * 16 + 4 * fq) * 2) = hv[ai][m][n]; }
        __syncthreads();
        const int r32 = lane & 31, hi = lane >> 5, row = wid * 32 + r32;
        bf16x8 a0[8], a1[8], bf[8];
#pragma unroll
        for (int ks = 0; ks < 8; ++ks) { a0[ks] = *(const bf16x8*)(w2t + (size_t)r32 * 256 + half * 128 + ks * 16 + hi * 8); a1[ks] = *(const bf16x8*)(w2t + (size_t)(32 + r32) * 256 + half * 128 + ks * 16 + hi * 8);
            bf[ks] = *(const LAS bf16x8*)(HB + row * 272 + (ks * 16 + hi * 8) * 2); }
        f32x16 o2[2];
#pragma unroll
        for (int r = 0; r < 16; ++r) { o2[0][r] = 0.f; o2[1][r] = 0.f; }
#pragma unroll
        for (int ks = 0; ks < 8; ++ks) { o2[0] = MFMA32(a0[ks], bf[ks], o2[0]); o2[1] = MFMA32(a1[ks], bf[ks], o2[1]); }
        float* pp = PART + (size_t)row * 64 + 4 * hi;
        if (half == 1) {
#pragma unroll
            for (int h = 0; h < 2; ++h)
#pragma unroll
                for (int a4 = 0; a4 < 4; ++a4) *(f32x4*)(pp + 32 * h + 8 * a4) = (f32x4){o2[h][4 * a4], o2[h][4 * a4 + 1], o2[h][4 * a4 + 2], o2[h][4 * a4 + 3]};
            asm volatile("s_waitcnt vmcnt(0)" ::: "memory"); __syncthreads();
            if (threadIdx.x == 0) { __builtin_amdgcn_fence(__ATOMIC_RELEASE, "agent"); asm volatile("s_waitcnt vmcnt(0)" ::: "memory"); __hip_atomic_store(flag, ep, __ATOMIC_RELAXED, __HIP_MEMORY_SCOPE_AGENT); }
            return; }
        if (wid == 0) { unsigned sp = 0;
            while ((unsigned)__builtin_amdgcn_readfirstlane(__hip_atomic_load(flag, __ATOMIC_RELAXED, __HIP_MEMORY_SCOPE_AGENT)) < ep) { __builtin_amdgcn_s_sleep(2); if (++sp > (1u << 22)) break; }
            __builtin_amdgcn_fence(__ATOMIC_ACQUIRE, "agent"); asm volatile("s_waitcnt vmcnt(0)" ::: "memory"); }
        __syncthreads();
        float ss = 0.f;
#pragma unroll
        for (int h = 0; h < 2; ++h)
#pragma unroll
            for (int a4 = 0; a4 < 4; ++a4) { const f32x4 pv = *(const f32x4*)(pp + 32 * h + 8 * a4); const f32x4 bv = *(const f32x4*)(b2 + 32 * h + 8 * a4 + 4 * hi);
#pragma unroll
                for (int e = 0; e < 4; ++e) { const float v = o2[h][4 * a4 + e] + pv[e] + bv[e]; o2[h][4 * a4 + e] = v; ss += v * v; } }
        if (kg0) { ss += __shfl_xor(ss, 32); const float rs = rsqrtf(ss * (1.f / 64.f) + 1e-6f);
#pragma unroll
            for (int h = 0; h < 2; ++h)
#pragma unroll
                for (int a4 = 0; a4 < 4; ++a4) { const f32x4 gv = *(const f32x4*)(kg0 + 32 * h + 8 * a4 + 4 * hi);
#pragma unroll
                    for (int e = 0; e < 4; ++e) o2[h][4 * a4 + e] *= rs * gv[e]; } }
        const float keep = row == 255 ? 0.f : 1.f;
#pragma unroll
        for (int h = 0; h < 2; ++h)
#pragma unroll
            for (int a4 = 0; a4 < 4; ++a4) { u32x2 w; w.x = cvt_pk_bf16(o2[h][4 * a4] * keep, o2[h][4 * a4 + 1] * keep); w.y = cvt_pk_bf16(o2[h][4 * a4 + 2] * keep, o2[h][4 * a4 + 3] * keep); *(u32x2*)(OUT + (size_t)row * 64 + 32 * h + 8 * a4 + 4 * hi) = w; }
    }
};

template <bool PROBE>
__device__ __forceinline__ void do_phase(const int p, const int l, const Args& args, LAS unsigned char* lds, const int G, const int bx, const int NGW) {
    unsigned char* ws = args.ws; float* xout = args.out; asm volatile("" : "+s"(ws), "+s"(xout));
    int tidp = threadIdx.x; asm volatile("" : "+v"(tidp)); const int lane = tidp & 63, wave = __builtin_amdgcn_readfirstlane(tidp >> 6), gw = bx * 8 + wave; (void)lane; (void)gw; (void)NGW;
    float* ctl = (float*)(ws + WS_CTL); bf16_t* XB = (bf16_t*)(ws + WS_XB); float* ssqp = (float*)(ws + WS_SSQP);
    unsigned char* wl = ws + WS_W + l * W_LAYER;
    if (p == 0) {
        pg8::Gemm g = pg8::make_gemm(XB, (const bf16_t*)(wl + W_IN), 1024); pg8::StaticOrder S; S.init(NTOK, INP, G, bx);
        pg8::EpiInProj E{(bf16_t*)(ws + WS_U), (bf16_t*)(ws + WS_V), (bf16_t*)(ws + WS_Q), (bf16_t*)(ws + WS_KV), (float*)(ws + WS_GL), ssqp + (size_t)(l == 0 ? 0 : 3) * NTOK * 16};
        pg8::gemm_phase<pg8::EpiInProj, pg8::StaticOrder, true>(lds, g, S, E);
        if (l == 0 && !PROBE && G == 256 && bx >= 128)
            convert_layer(args, 0, CV_IN, CONV_ITEMS, (bx - 128) * 8 + wave, 128 * 8, (LAS float*)(lds + wave * 16384), lane);
    } else if (p == 1) {
      for (int vb = bx; vb < 256; vb += G) {
        if (PROBE && !((MK_P1_ROLES >> (vb < 32 ? 0 : vb < 48 ? 1 : vb < 176 ? 2 : 3)) & 1)) continue;
        if (vb < 32) { if constexpr (!PROBE || (MK_P1_ROLES & 1)) { const int kv = vb >> 4, pm = (vb >> 1) & 7, half = vb & 1;
            pg8::Gemm g; g.A = (const bf16_t*)(ws + WS_KV) + kv * 128; g.Bt = (const bf16_t*)(wl + W_C1 + (size_t)kv * 512 * 1024 * 2); g.K = 1024; g.lda = 16 * 768; g.kstepA = 768 * 2; g.a_s0 = 64 * 2; g.a_s1 = (size_t)T * 768 * 2;
            pg8::OneUnit S{1, {pm, half}};
            EpiCmp E{(const float*)(wl + W_B1P) + kv * 256, (const bf16_t*)(wl + W_C2) + (size_t)kv * 64 * 256, args.in[I_CB2] + l * 128 + kv * 64, kv == 0 ? args.in[I_KNG] + l * 192 : (const float*)nullptr,
                     (bf16_t*)(ws + (kv ? WS_VC : WS_KC)) + (size_t)pm * 256 * 64, (float*)(ws + WS_HID) + (size_t)(kv * 8 + pm) * 256 * 64, (unsigned*)(ws + WS_CTL + CTL_FLAG_BYTE) + (kv * 8 + pm) * 64, (unsigned)(l + 1), half};
            pg8::gemm_phase<EpiCmp, pg8::OneUnit, false>(lds, g, S, E); }
        } else if (vb < 48) { if constexpr (!PROBE || (MK_P1_ROLES & 2)) { const int i = vb - 32;
            pg8::Gemm g = pg8::make_gemm((const bf16_t*)(ws + WS_MEMB), (const bf16_t*)(wl + W_MKV), 1024); pg8::OneUnit S{1, {i >> 2, i & 3}};
            pg8::EpiBf16G<0> E{(bf16_t*)(ws + WS_KVM), 1024, nullptr, ctl + SSQ_MEM_OFF, 1.f / 1024.f, 1};
            pg8::gemm_phase<pg8::EpiBf16G<0>, pg8::OneUnit, true>(lds, g, S, E); }
        } else if (vb < 176) { if constexpr (!PROBE || (MK_P1_ROLES & 4))
            sgu_unit(lds, vb - 48, (const bf16_t*)(ws + WS_U), (const bf16_t*)(ws + WS_V), (const bf16_t*)(wl + W_SG), args.in[I_SGLNG] + l * 512, args.in[I_SGLNB] + l * 512, args.in[I_SGB] + l * 1024, (bf16_t*)(ws + WS_MIX));
        } else {
            for (int t = (vb - 176) * 8 + wave; t < NTOK; t += 4 * 640) tokprep4((bf16_t*)(ws + WS_Q), (bf16_t*)(ws + WS_KV), args.in[I_QNG] + l * 64, args.in[I_KNG] + l * 192, t, 640, lane);
            if (l == 0 && !PROBE) convert_layer(args, 1, 0, CONV_SPLIT, (vb - 176) * 8 + wave, 80 * 8, (LAS float*)(lds + wave * 16384), lane);
        } }
    } else if (p == 3) {
        for (int r = gw; r < 4096; r += NGW) memk_norm_item((bf16_t*)(ws + WS_KVM), args.in[I_MKG] + l * 128, r, lane);
        for (int i = bx; i < 256; i += G) { const int b = (i & 7) >> 1, idx = (i >> 3) * 2 + (i & 1);
            attn_unit<15>(lds, b, 127 - idx, (const bf16_t*)(ws + WS_Q), (const bf16_t*)(ws + WS_KV), (const bf16_t*)(ws + WS_KC), (const bf16_t*)(ws + WS_VC), (const float*)(ws + WS_GL), (bf16_t*)(ws + WS_MIX));
            attn_unit<15>(lds, b, idx, (const bf16_t*)(ws + WS_Q), (const bf16_t*)(ws + WS_KV), (const bf16_t*)(ws + WS_KC), (const bf16_t*)(ws + WS_VC), (const float*)(ws + WS_GL), (bf16_t*)(ws + WS_MIX)); }
    } else if (p == 6) {
        for (int i = bx; i < 256; i += G) { const int b = (i & 7) >> 1, rest = (i >> 3) * 2 + (i & 1);
            memattn_unit(lds, b, rest >> 4, rest & 15, (const bf16_t*)(ws + WS_QM), (const bf16_t*)(ws + WS_KVM), args.in[I_MQG] + l * 128, (bf16_t*)(ws + WS_OM)); }
    } else if (p == 4) {
        pg8::Gemm g = pg8::make_gemm((const bf16_t*)(ws + WS_MIX), (const bf16_t*)(wl + W_OUT), 1024); pg8::StaticOrder S; S.init(NTOK, 1024, G, bx);
        pg8::EpiResid E{nullptr, XB, ssqp + (size_t)(PROBE ? 1 : l * 3 + 1) * NTOK * 16};
        pg8::gemm_phase<pg8::EpiResid, pg8::StaticOrder, true>(lds, g, S, E);
    } else if (p == 5) {
        pg8::Gemm g = pg8::make_gemm(XB, (const bf16_t*)(wl + W_MQ), 1024); pg8::StaticOrder S; S.init(NTOK, 512, G, bx);
        pg8::EpiBf16G<0> E{(bf16_t*)(ws + WS_QM), 512, nullptr, ssqp + (size_t)(l * 3 + 1) * NTOK * 16, 1.f / 1024.f, 16};
        pg8::gemm_phase<pg8::EpiBf16G<0>, pg8::StaticOrder, true>(lds, g, S, E);
        if (l == 0 && !PROBE) { const int nidle = G > 128 ? G - 128 : 0;
            if (nidle == 0) convert_layer(args, 1, CONV_SPLIT, CONV_ITEMS, gw, NGW, (LAS float*)(lds + wave * 16384), lane);
            else if (bx >= 128) convert_layer(args, 1, CONV_SPLIT, CONV_ITEMS, (bx - 128) * 8 + wave, nidle * 8, (LAS float*)(lds + wave * 16384), lane); }
    } else if (p == 7) {
        pg8::Gemm g = pg8::make_gemm((const bf16_t*)(ws + WS_OM), (const bf16_t*)(wl + W_MO), 512); pg8::StaticOrder S; S.init(NTOK, 1024, G, bx);
        pg8::EpiResid E{nullptr, XB, ssqp + (size_t)(PROBE ? 1 : l * 3 + 2) * NTOK * 16};
        pg8::gemm_phase<pg8::EpiResid, pg8::StaticOrder, true>(lds, g, S, E);
    } else if (p == 8) {
        pg8::Gemm g = pg8::make_gemm(XB, (const bf16_t*)(wl + W_FF1), 1024); pg8::StaticOrder S; S.init(NTOK, FF, G, bx);
        pg8::EpiBf16G<2> E{(bf16_t*)(ws + WS_HB), FF, nullptr, ssqp + (size_t)(l * 3 + 2) * NTOK * 16, 1.f / 1024.f, 16};
        pg8::gemm_phase<pg8::EpiBf16G<2>, pg8::StaticOrder, true>(lds, g, S, E);
    } else if (p == 9) {
        pg8::Gemm g = pg8::make_gemm((const bf16_t*)(ws + WS_HB), (const bf16_t*)(wl + W_FF2), FF); pg8::StaticOrder S; S.init(NTOK, 1024, G, bx);
        pg8::EpiResid E{(l == 0 || PROBE) ? (float*)nullptr : xout, XB, ssqp + (size_t)(PROBE ? 1 : 3) * NTOK * 16};
        pg8::gemm_phase<pg8::EpiResid, pg8::StaticOrder, true>(lds, g, S, E);
    }
}

constexpr int LDS_BYTES = 147456;
__global__ void __launch_bounds__(512, 2) mega(Args args) {
    extern __shared__ __attribute__((aligned(16))) unsigned char lds_raw[];
    LAS unsigned char* lds = (LAS unsigned char*)lds_raw;
    const int G = gridDim.x, bx = blockIdx.x, NGW = G * 8;
    volatile LAS unsigned* bar_st = (volatile LAS unsigned*)(lds + LDS_ST_OFF);
    if (threadIdx.x < 2) bar_st[threadIdx.x] = 0u;
    __syncthreads();
    XcdBarrier xbar = xcd_barrier_post((unsigned*)(args.ws + WS_CTL + CTL_BAR_BYTE), bar_st);
    if (args.ph_hi < 0) cooperative_groups::this_grid().sync();
    if (args.ph_lo == 0) { const int tid0 = threadIdx.x, wave0 = __builtin_amdgcn_readfirstlane(tid0 >> 6); for (int e_ = 0; e_ < 1 + MK_PROBE_PRO; ++e_) prologue(args, lds, bx * 8 + wave0, NGW, wave0, tid0 & 63); }
    for (int ph = args.ph_lo > 1 ? args.ph_lo : 1; ph < args.ph_hi; ++ph) {
        if ((ph - 1) % 10 == 2) continue;
        if (ph > args.ph_lo) {
            xcd_barrier(xbar); }
        do_phase<false>((ph - 1) % 10, (ph - 1) / 10, args, lds, G, bx, NGW);
    }
#if MK_PROBE_N > 0
    if (args.ph_hi == 21) {
        xcd_barrier(xbar); do_phase<false>(0, 1, args, lds, G, bx, NGW);
        xcd_barrier(xbar); do_phase<false>(1, 1, args, lds, G, bx, NGW);
        for (int e_ = 0; e_ < MK_PROBE_N; ++e_) { xcd_barrier(xbar);
#if MK_PROBE_KIND == 100
            { int tidp = threadIdx.x; asm volatile("" : "+v"(tidp)); const int w_ = __builtin_amdgcn_readfirstlane(tidp >> 6); convert_layer(args, 1, 0, CONV_ITEMS, bx * 8 + w_, NGW, (LAS float*)(lds + w_ * 16384), tidp & 63); }
#elif MK_PROBE_KIND == 33
            for (int i = bx; i < 256; i += G) { const int b = (i & 7) >> 1, idx = (i >> 3) * 2 + (i & 1); unsigned char* ws = args.ws;
                attn_unit<MK_PROBE_PARTS>(lds, b, 127 - idx, (const bf16_t*)(ws + WS_Q), (const bf16_t*)(ws + WS_KV), (const bf16_t*)(ws + WS_KC), (const bf16_t*)(ws + WS_VC), (const float*)(ws + WS_GL), (bf16_t*)(ws + WS_MIX));
                attn_unit<MK_PROBE_PARTS>(lds, b, idx, (const bf16_t*)(ws + WS_Q), (const bf16_t*)(ws + WS_KV), (const bf16_t*)(ws + WS_KC), (const bf16_t*)(ws + WS_VC), (const float*)(ws + WS_GL), (bf16_t*)(ws + WS_MIX)); }
#elif MK_PROBE_KIND == 34
            { unsigned char* ws = args.ws; unsigned char* wl = ws + WS_W + W_LAYER;
              for (int vb = bx; vb < 256; vb += G) if (vb >= 48 && vb < 176) sgu_unit(lds, vb - 48, (const bf16_t*)(ws + WS_U), (const bf16_t*)(ws + WS_V), (const bf16_t*)(wl + W_SG), args.in[I_SGLNG] + 512, args.in[I_SGLNB] + 512, args.in[I_SGB] + 1024, (bf16_t*)(ws + WS_MIX)); }
#elif MK_PROBE_KIND == 35
            { unsigned char* ws = args.ws; int tidp = threadIdx.x; asm volatile("" : "+v"(tidp)); const int w_ = __builtin_amdgcn_readfirstlane(tidp >> 6);
              for (int vb = bx; vb < 256; vb += G) if (vb >= 176) for (int t = (vb - 176) * 8 + w_; t < NTOK; t += 4 * 640) tokprep4((bf16_t*)(ws + WS_Q), (bf16_t*)(ws + WS_KV), args.in[I_QNG] + 64, args.in[I_KNG] + 192, t, 640, tidp & 63); }
#elif MK_PROBE_KIND != 99
            do_phase<true>(MK_PROBE_KIND, 1, args, lds, G, bx, NGW);
#endif
        }
    }
#endif
}

}

#ifndef MK_FUSED
#define MK_FUSED 1
#endif
extern "C" void kernel_launch(void* const* d_in, const int* in_sizes, int n_in, void* d_out, int out_size, void* d_ws, size_t ws_size, hipStream_t stream) {
    using namespace mk;
    static int grid = 0;
    if (!grid) { (void)hipFuncSetAttribute((const void*)mega, hipFuncAttributeMaxDynamicSharedMemorySize, LDS_BYTES);
        int dev = 0, cus = 0, per_cu = 0; (void)hipGetDevice(&dev); (void)hipDeviceGetAttribute(&cus, hipDeviceAttributeMultiprocessorCount, dev);
        (void)hipOccupancyMaxActiveBlocksPerMultiprocessor(&per_cu, (const void*)mega, 512, LDS_BYTES);
        grid = cus * (per_cu < 1 ? 1 : per_cu); if (grid > 256) grid = 256; }
    Args a{}; for (int i = 0; i < 27; ++i) a.in[i] = (const float*)d_in[i]; a.out = (float*)d_out; a.ws = (unsigned char*)d_ws;
#if MK_FUSED
    (void)hipMemsetAsync((unsigned char*)d_ws + WS_CTL + CTL_BAR_BYTE, 0, 20 * 1024, stream);
    a.ph_lo = 0; a.ph_hi = 21; void* kargs[] = {&a};
    (void)hipLaunchCooperativeKernel((const void*)mega, dim3(grid), dim3(512), kargs, LDS_BYTES, stream);
#else
    for (int ph = 0; ph < 21; ++ph) { a.ph_lo = ph; a.ph_hi = ph + 1; hipLaunchKernelGGL(mega, dim3(grid), dim3(512), LDS_BYTES, stream, a); }
#endif
}
```

```cpp
#include <hip/hip_runtime.h>
#include <hip/hip_cooperative_groups.h>
#include <stdint.h>
#include <math.h>

namespace pg8 {
#define PG8_LAS __attribute__((address_space(3)))
typedef unsigned short bf16_t;
typedef short bf16x8 __attribute__((ext_vector_type(8)));
typedef float f32x4 __attribute__((ext_vector_type(4)));
typedef float f32x2 __attribute__((ext_vector_type(2)));
typedef unsigned u32x4 __attribute__((ext_vector_type(4)));
typedef unsigned u32x2 __attribute__((ext_vector_type(2)));
constexpr int BM = 256, BK = 64, HALF = 128, HTB = HALF * BK * 2, STAGE_BYTES = 8 * HTB, NXCD = 8, WGM = 8;

__host__ __device__ __forceinline__ int lds_byte(int r, int c) { const int st = (r >> 4) * 2 + (c >> 5), rr = r & 15, cc = c & 31, ob = rr * 64 + cc * 2; return st * 1024 + (ob ^ (((ob >> 9) & 1) << 5)); }
__host__ __device__ __forceinline__ void stage_rc(int b, int& R, int& C) { const int st = b / 1024, sb = b % 1024, swz = sb ^ (((sb >> 9) & 1) << 5); R = (st >> 1) * 16 + swz / 64; C = (st & 1) * 32 + (swz % 64) / 2; }
__host__ __device__ __forceinline__ int perm32(int rho) { const int n = rho >> 4, i = rho & 15; return 8 * (i >> 2) + 4 * n + (i & 3); }

struct Unit { int pm, pn; };
struct Gemm { const bf16_t* A; const bf16_t* Bt; int K; int lda; int kstepA; size_t a_s0, a_s1; };
__device__ __forceinline__ Gemm make_gemm(const bf16_t* A, const bf16_t* Bt, int K) { Gemm g; g.A = A; g.Bt = Bt; g.K = K; g.lda = K; g.kstepA = BK * 2; g.a_s0 = (size_t)BM * K * 2; g.a_s1 = 2 * g.a_s0; return g; }

struct StaticOrder {
    int nM, nN, nwg, G, c;
    __device__ void init(int M, int N, int G_, int c_) { nM = M / BM; nN = N / BM; nwg = nM * nN; G = G_; c = c_; }
    __device__ bool next(int i, Unit& u) const {
        const long L = (long)i * G + c; if (L >= nwg) return false;
        int wgid = (int)L; { const int q = nwg / NXCD, r = nwg % NXCD, xcd = wgid % NXCD, off = wgid / NXCD; wgid = (xcd < r ? xcd * (q + 1) : r * (q + 1) + (xcd - r) * q) + off; }
        const int nig = WGM * nN, gid = wgid / nig, fm = gid * WGM, gsz = (nM - fm) < WGM ? (nM - fm) : WGM;
        u.pm = fm + ((wgid % nig) % gsz); u.pn = (wgid % nig) / gsz; return true;
    }
};
struct OneUnit { int has; Unit u; __device__ bool next(int i, Unit& o) const { if (i > 0 || !has) return false; o = u; return true; } };

__device__ __forceinline__ unsigned cvt_pk_bf16(float lo, float hi) { unsigned r; asm volatile("v_cvt_pk_bf16_f32 %0, %1, %2" : "=v"(r) : "v"(lo), "v"(hi)); return r; }
__device__ __forceinline__ float gelu_tanh(float x) { const float u = 0.7978845608028654f * (x + 0.044715f * x * x * x); const float e = __builtin_amdgcn_exp2f(-2.885390081777927f * u); return x * __builtin_amdgcn_rcpf(1.f + e); }

__device__ __forceinline__ float ssq16(const float* p) { const f32x4 a = ((const f32x4*)p)[0], b = ((const f32x4*)p)[1], c = ((const f32x4*)p)[2], d = ((const f32x4*)p)[3];
    return (((a[0] + a[1]) + (a[2] + a[3])) + ((b[0] + b[1]) + (b[2] + b[3]))) + (((c[0] + c[1]) + (c[2] + c[3])) + ((d[0] + d[1]) + (d[2] + d[3]))); }
template <int ACT  > struct EpiBf16G {
    static constexpr bool PERM = true, AFTER_DRAIN = false;
    bf16_t* O; int ldc; const float* bias; const float* ssq; float inv_n; int nparts;
    __device__ __forceinline__ void operator()(const f32x4 (&acc)[2][2][4][2], const Unit& u, int wr, int wc, int fr, int fq) const {
        const int row0 = u.pm * BM + wr * 64 + fr, col0 = u.pn * BM + wc * 32 + 8 * fq;
        f32x4 bv[2][2];
#pragma unroll
        for (int bj = 0; bj < 2; ++bj)
#pragma unroll
            for (int n = 0; n < 2; ++n) bv[bj][n] = bias ? *(const f32x4*)(bias + col0 + bj * HALF + 4 * n) : (f32x4){0.f, 0.f, 0.f, 0.f};
        float rsv[2] = {1.f, 1.f};
        if (ssq) {
#pragma unroll
            for (int ai = 0; ai < 2; ++ai) { const int rr = row0 + ai * HALF + fq * 16; rsv[ai] = rsqrtf((nparts == 16 ? ssq16(ssq + (size_t)rr * 16) : ssq[rr]) * inv_n + 1e-6f); } }
#pragma unroll
        for (int ai = 0; ai < 2; ++ai)
#pragma unroll
            for (int m = 0; m < 4; ++m) { const int row = row0 + ai * HALF + m * 16; const float rs = __shfl(rsv[ai], fr + 16 * m); bf16_t* rowp = O + (size_t)row * ldc + col0;
#pragma unroll
                for (int bj = 0; bj < 2; ++bj) { f32x4 v0 = (acc[ai][bj][m][0] + bv[bj][0]) * rs, v1 = (acc[ai][bj][m][1] + bv[bj][1]) * rs;
                    if (ACT == 1) {
#pragma unroll
                        for (int e = 0; e < 4; ++e) { v0[e] = gelu_tanh(v0[e]); v1[e] = gelu_tanh(v1[e]); } }
                    if (ACT == 2) {
#pragma unroll
                        for (int e = 0; e < 4; ++e) { float a = fmaxf(v0[e], 0.f), b = fmaxf(v1[e], 0.f); v0[e] = a * a; v1[e] = b * b; } }
                    u32x4 w; w.x = cvt_pk_bf16(v0[0], v0[1]); w.y = cvt_pk_bf16(v0[2], v0[3]); w.z = cvt_pk_bf16(v1[0], v1[1]); w.w = cvt_pk_bf16(v1[2], v1[3]);
                    *(u32x4*)(rowp + bj * HALF) = w; } }
    }
};
struct EpiInProj {
    static constexpr bool PERM = true, AFTER_DRAIN = false;
    bf16_t *U, *V, *Q, *KV; float* GL; const float* ssq;
    __device__ __forceinline__ void operator()(const f32x4 (&acc)[2][2][4][2], const Unit& u, int wr, int wc, int fr, int fq) const {
        const int row0 = u.pm * BM + wr * 64 + fr, cit0 = wc * 32 + 8 * fq; const int pn = u.pn;
        bf16_t* base; int ldc, cofs; bool act = false;
        if (pn < 2) { base = U; ldc = 512; cofs = pn * 256; act = true; } else if (pn < 4) { base = V; ldc = 512; cofs = (pn - 2) * 256; act = true; }
        else if (pn < 6) { base = Q; ldc = 512; cofs = (pn - 4) * 256; } else { base = KV; ldc = 768; cofs = (pn - 6) * 256; }
        float rsv[2];
#pragma unroll
        for (int ai = 0; ai < 2; ++ai) rsv[ai] = rsqrtf(ssq16(ssq + (size_t)(row0 + ai * HALF + fq * 16) * 16) * (1.f / 1024.f) + 1e-6f);
#pragma unroll
        for (int ai = 0; ai < 2; ++ai)
#pragma unroll
            for (int m = 0; m < 4; ++m) { const int row = row0 + ai * HALF + m * 16; const float rs = __shfl(rsv[ai], fr + 16 * m);
#pragma unroll
                for (int bj = 0; bj < 2; ++bj) { f32x4 v0 = acc[ai][bj][m][0] * rs, v1 = acc[ai][bj][m][1] * rs; const int cit = cit0 + bj * HALF;
                    if (pn == 9) { if (cit < 24) { *(f32x4*)(GL + (size_t)row * 24 + cit) = v0; *(f32x4*)(GL + (size_t)row * 24 + cit + 4) = v1; } }
                    else { if (act) {
#pragma unroll
                            for (int e = 0; e < 4; ++e) { v0[e] = gelu_tanh(v0[e]); v1[e] = gelu_tanh(v1[e]); } }
                        u32x4 w; w.x = cvt_pk_bf16(v0[0], v0[1]); w.y = cvt_pk_bf16(v0[2], v0[3]); w.z = cvt_pk_bf16(v1[0], v1[1]); w.w = cvt_pk_bf16(v1[2], v1[3]);
                        *(u32x4*)(base + (size_t)row * ldc + cofs + cit) = w; } } }
    }
};
struct EpiResid {
    static constexpr bool PERM = false, AFTER_DRAIN = false;
    float* XF; bf16_t* XB; float* ssq;
    __device__ __forceinline__ void operator()(const f32x4 (&acc)[2][2][4][2], const Unit& u, int wr, int wc, int fr, int fq) const {
        const int col0 = u.pn * BM + wc * 32 + 4 * fq;
#pragma unroll
        for (int ai = 0; ai < 2; ++ai)
#pragma unroll
            for (int m = 0; m < 4; ++m) { const int row = u.pm * BM + ai * HALF + wr * 64 + m * 16 + fr; float sq = 0.f;
#pragma unroll
                for (int bj = 0; bj < 2; ++bj)
#pragma unroll
                    for (int n = 0; n < 2; ++n) { const size_t off = (size_t)row * 1024 + col0 + bj * HALF + n * 16; const u32x2 xw = *(const u32x2*)(XB + off);
                        f32x4 xv; xv[0] = __uint_as_float(xw.x << 16); xv[1] = __uint_as_float(xw.x & 0xffff0000u); xv[2] = __uint_as_float(xw.y << 16); xv[3] = __uint_as_float(xw.y & 0xffff0000u);
                        xv = xv + acc[ai][bj][m][n];
                        if (XF) *(f32x4*)(XF + off) = xv;
                        else { sq += (xv[0] * xv[0] + xv[1] * xv[1]) + (xv[2] * xv[2] + xv[3] * xv[3]); u32x2 w; w.x = cvt_pk_bf16(xv[0], xv[1]); w.y = cvt_pk_bf16(xv[2], xv[3]); *(u32x2*)(XB + off) = w; } }
                if (!XF) { sq += __shfl_xor(sq, 16); sq += __shfl_xor(sq, 32); if (fq == 0) ssq[(size_t)row * 16 + u.pn * 4 + wc] = sq; } }
    }
};

template <class Epi, class Sched, bool ALIGN_EPI>
__device__ __forceinline__ void gemm_phase(PG8_LAS unsigned char* lds, const Gemm g, const Sched& S, const Epi& E) {
    int tid_ = threadIdx.x; asm volatile("" : "+v"(tid_));
    const int tid = tid_, wid = __builtin_amdgcn_readfirstlane(tid >> 6), lane = tid & 63, wr = wid >> 2, wc = wid & 3, fr = lane & 15, fq = lane >> 4;
    const int K = g.K, nt = K / BK;
    unsigned voffA[2], voffB[2];
#pragma unroll
    for (int i = 0; i < 2; ++i) { int R, C; stage_rc(tid * 16 + i * 8192, R, C); const int Rb = Epi::PERM ? ((R & ~31) + perm32(R & 31)) : R;
        voffA[i] = (unsigned)(R * g.lda + C) * 2u; voffB[i] = (unsigned)(Rb * K + C) * 2u; }
    const size_t kstepA = (size_t)g.kstepA, kstepB = (size_t)(BK * 2);
    const size_t hstepA = (size_t)HALF * g.lda * 2, hstepB = (size_t)HALF * K * 2, tstepB = 2 * hstepB;
    const unsigned ldsw = (unsigned)wid * 1024u;
    const int aoff = lds_byte(wr * 64 + fr, fq * 8), boff = lds_byte(wc * 32 + fr, fq * 8);
#define PG8_ABASE(pm) ((const char*)g.A + (size_t)((pm) >> 1) * g.a_s1 + (size_t)((pm) & 1) * g.a_s0)
#define PG8_SA(b, h) (((b) * 2 + (h)) * HTB)
#define PG8_SB(b, h) ((4 + (b) * 2 + (h)) * HTB)
#define PG8_STAGE(bufoff, gbase, voff) do { _Pragma("unroll") for (int _i = 0; _i < 2; ++_i) \
        __builtin_amdgcn_global_load_lds((const unsigned*)((const char*)(gbase) + (voff)[_i]), (PG8_LAS unsigned*)(lds + (bufoff) + ldsw + _i * 8192), 16, 0, 0); } while (0)
#define PG8_LDA(dst, b, h) do { _Pragma("unroll") for (int m = 0; m < 4; ++m) _Pragma("unroll") for (int k = 0; k < 2; ++k) dst[m][k] = *(const PG8_LAS bf16x8*)(lds + PG8_SA(b, h) + aoff + m * 2048 + k * 1024); } while (0)
#define PG8_LDB(dst, b, h) do { _Pragma("unroll") for (int n = 0; n < 2; ++n) _Pragma("unroll") for (int k = 0; k < 2; ++k) dst[n][k] = *(const PG8_LAS bf16x8*)(lds + PG8_SB(b, h) + boff + n * 2048 + k * 1024); } while (0)
#define PG8_MMA(ai, bj, At, Bt) do { __builtin_amdgcn_s_setprio(1); _Pragma("unroll") for (int m = 0; m < 4; ++m) _Pragma("unroll") for (int n = 0; n < 2; ++n) _Pragma("unroll") for (int k = 0; k < 2; ++k) \
        acc[ai][bj][m][n] = __builtin_amdgcn_mfma_f32_16x16x32_bf16(Bt[n][k], At[m][k], acc[ai][bj][m][n], 0, 0, 0); __builtin_amdgcn_s_setprio(0); } while (0)
#define PG8_WAIT_V(n) asm volatile("s_waitcnt vmcnt(" #n ")" ::: "memory")
#define PG8_WAIT_L(n) asm volatile("s_waitcnt lgkmcnt(" #n ")" ::: "memory")
#define PG8_BAR __builtin_amdgcn_s_barrier()
#define PG8_SCHED __builtin_amdgcn_sched_barrier(0)
    Unit cur, nxt; int ui = 0;
    if (!S.next(0, cur)) return;
    f32x4 acc[2][2][4][2];
#pragma unroll
    for (int a = 0; a < 2; ++a)
#pragma unroll
        for (int b = 0; b < 2; ++b)
#pragma unroll
            for (int m = 0; m < 4; ++m)
#pragma unroll
                for (int n = 0; n < 2; ++n) acc[a][b][m][n] = (f32x4){0.f, 0.f, 0.f, 0.f};
    bf16x8 At[4][2], B0[2][2], B1[2][2];
    const char* cA = PG8_ABASE(cur.pm); const char* cB = (const char*)g.Bt + (size_t)cur.pn * tstepB;
    PG8_STAGE(PG8_SB(0, 0), cB, voffB); PG8_STAGE(PG8_SB(0, 1), cB + hstepB, voffB); PG8_STAGE(PG8_SA(0, 0), cA, voffA); PG8_STAGE(PG8_SA(0, 1), cA + hstepA, voffA);
    if (wr == 1) PG8_BAR;
    PG8_WAIT_V(2); PG8_BAR;
    PG8_STAGE(PG8_SB(1, 0), cB + kstepB, voffB); PG8_STAGE(PG8_SA(1, 0), cA + kstepA, voffA); PG8_STAGE(PG8_SB(1, 1), cB + hstepB + kstepB, voffB);
    PG8_WAIT_V(6); PG8_BAR;
    for (;;) {
        const bool has_next = S.next(ui + 1, nxt);
        const char* nA = has_next ? PG8_ABASE(nxt.pm) : cA; const char* nB = has_next ? (const char*)g.Bt + (size_t)nxt.pn * tstepB : cB;
        for (int t = 0; t < nt; t += 2) {
            const bool last = (t == nt - 2);
            const char* a1 = cA + (size_t)(t + 1) * kstepA;
            const char* a2 = last ? nA : cA + (size_t)(t + 2) * kstepA; const char* b2 = last ? nB : cB + (size_t)(t + 2) * kstepB;
            const char* a3 = a2 + kstepA; const char* b3 = b2 + kstepB;
            PG8_LDB(B0, 0, 0); PG8_LDB(B1, 0, 1); PG8_SCHED; PG8_LDA(At, 0, 0); PG8_STAGE(PG8_SA(1, 1), a1 + hstepA, voffA);
            PG8_WAIT_V(8); PG8_WAIT_L(0); PG8_BAR; PG8_MMA(0, 0, At, B0); PG8_MMA(0, 1, At, B1); PG8_BAR; PG8_SCHED;
            PG8_LDA(At, 0, 1); PG8_STAGE(PG8_SB(0, 0), b2, voffB); PG8_STAGE(PG8_SB(0, 1), b2 + hstepB, voffB); PG8_STAGE(PG8_SA(0, 0), a2, voffA);
            PG8_WAIT_V(8); PG8_WAIT_L(0); PG8_BAR; PG8_MMA(1, 0, At, B0); PG8_MMA(1, 1, At, B1); PG8_BAR; PG8_SCHED;
            PG8_LDB(B0, 1, 0); PG8_LDB(B1, 1, 1); PG8_SCHED; PG8_LDA(At, 1, 0); PG8_STAGE(PG8_SA(0, 1), a2 + hstepA, voffA);
            PG8_WAIT_V(8); PG8_WAIT_L(0); PG8_BAR; PG8_MMA(0, 0, At, B0); PG8_MMA(0, 1, At, B1); PG8_BAR; PG8_SCHED;
            PG8_LDA(At, 1, 1); PG8_STAGE(PG8_SB(1, 0), b3, voffB); PG8_STAGE(PG8_SB(1, 1), b3 + hstepB, voffB); PG8_STAGE(PG8_SA(1, 0), a3, voffA);
            PG8_WAIT_V(8); PG8_WAIT_L(0); PG8_BAR; PG8_MMA(1, 0, At, B0); PG8_MMA(1, 1, At, B1); PG8_BAR; PG8_SCHED;
        }
        if constexpr (ALIGN_EPI) { if (wr == 0) PG8_BAR; }
        if constexpr (!Epi::AFTER_DRAIN) { E(acc, cur, wr, wc, fr, fq); }
        if (!has_next) break;
#pragma unroll
        for (int a = 0; a < 2; ++a)
#pragma unroll
            for (int b = 0; b < 2; ++b)
#pragma unroll
                for (int m = 0; m < 4; ++m)
#pragma unroll
                    for (int n = 0; n < 2; ++n) acc[a][b][m][n] = (f32x4){0.f, 0.f, 0.f, 0.f};
        cur = nxt; cA = nA; cB = nB; ++ui;
        if constexpr (ALIGN_EPI) { if (wr == 1) PG8_BAR; }
    }
    PG8_WAIT_V(0);
    if constexpr (!ALIGN_EPI) { if (wr == 0) PG8_BAR; }
    PG8_BAR;
    if constexpr (Epi::AFTER_DRAIN) { E.fused(acc, cur, wr, wc, fr, fq, lds, wid, lane); }
#undef PG8_ABASE
#undef PG8_SA
#undef PG8_SB
#undef PG8_STAGE
#undef PG8_LDA
#undef PG8_LDB
#undef PG8_MMA
#undef PG8_WAIT_V
#undef PG8_WAIT_L
#undef PG8_BAR
#undef PG8_SCHED
}
}

#ifndef MK_PROBE_N
#define MK_PROBE_N 0
#endif
#ifndef MK_P1_ROLES
#define MK_P1_ROLES 15
#endif
#ifndef MK_PROBE_PRO
#define MK_PROBE_PRO 0
#endif
#ifndef MK_PROBE_KIND
#define MK_PROBE_KIND 3
#endif
#ifndef MK_PROBE_PARTS
#define MK_PROBE_PARTS 15
#endif

namespace mk {
using pg8::bf16_t; using pg8::f32x4; using pg8::u32x4; using pg8::u32x2; using pg8::cvt_pk_bf16;
#define LAS __attribute__((address_space(3)))
constexpr int NB = 4, T = 4096, D = 1024, NTOK = NB * T, INC = 2328, INP = 2560, FF = 4096;
constexpr size_t MiB = 1u << 20;
constexpr size_t WS_CTL = 0;
constexpr size_t WS_W = 1 * MiB, W_LAYER = 30 * MiB;
constexpr size_t W_IN = 0, W_OUT = 5 * MiB, W_MQ = 7 * MiB, W_MKV = 8 * MiB, W_MO = 10 * MiB, W_FF1 = 11 * MiB, W_FF2 = 19 * MiB, W_C1 = 27 * MiB, W_C2 = 29 * MiB, W_SG = 29 * MiB + 128 * 1024, W_B1P = 29 * MiB + 512 * 1024;
constexpr size_t WS_XB = 61 * MiB;
constexpr size_t WS_OV = 93 * MiB;
constexpr size_t WS_U = WS_OV, WS_V = WS_OV + 16 * MiB, WS_Q = WS_OV + 32 * MiB, WS_KV = WS_OV + 48 * MiB, WS_MIX = WS_OV + 72 * MiB, WS_QM = WS_OV + 104 * MiB, WS_OM = WS_OV + 120 * MiB;
constexpr size_t WS_HB = WS_OV;
constexpr size_t WS_SM = 229 * MiB;
constexpr size_t WS_GL = WS_SM, WS_KC = WS_SM + 2 * MiB, WS_VC = WS_KC + 256 * 1024, WS_HID = WS_SM + 3 * MiB, WS_MASK = WS_SM + 5 * MiB, WS_MEMB = WS_SM + 6 * MiB, WS_KVM = WS_SM + 8 * MiB, WS_END = WS_SM + 10 * MiB;
constexpr size_t WS_SSQP = 240 * MiB;
static_assert(WS_END <= WS_SSQP && WS_SSQP + 6 * MiB <= 256 * MiB, "ws map");
constexpr int SSQ_MEM_OFF = 6 * NTOK;

struct Args { const float* in[27]; float* out; unsigned char* ws; int ph_lo, ph_hi; };
enum { I_X = 0, I_MEM, I_NMG, I_WIN, I_SGLNG, I_SGLNB, I_SGW, I_SGB, I_QNG, I_KNG, I_CPOS, I_CW1, I_CB1, I_CW2, I_CB2, I_MOG, I_WOUT, I_NMEMG, I_MKVG, I_WMQ, I_WMKV, I_MQG, I_MKG, I_WMO, I_NFG, I_WFF1, I_WFF2 };

__device__ __forceinline__ float bf2f(unsigned short b) { return __uint_as_float((unsigned)b << 16); }
__device__ __forceinline__ float wave_sum(float v) {
#pragma unroll
    for (int o = 1; o < 64; o <<= 1) v += __shfl_xor(v, o);
    return v; }

__device__ __forceinline__ void transpose_item(const float* W, int K, int N, int Npad, const float* gain, bf16_t* WT, LAS float* scr, int item, int lane, int ld = 0) {
    if (ld == 0) ld = N;
    const int nblk = Npad / 32, kb = item / nblk, nb = item % nblk, k0 = 64 * kb, n0 = 32 * nb;
    const int nn = n0 + (lane & 31); const int nnc = nn < N ? nn : N - 1; const float keep = nn < N ? 1.f : 0.f;
    const float* src = W + (size_t)(k0 + (lane >> 5)) * ld + nnc;
    float v[32];
#pragma unroll
    for (int i = 0; i < 32; ++i) v[i] = src[(size_t)(2 * i) * ld];
#pragma unroll
    for (int i = 0; i < 32; ++i) scr[(2 * i + (lane >> 5)) * 33 + (lane & 31)] = v[i] * keep;
    asm volatile("s_waitcnt lgkmcnt(0)" ::: "memory");
    const int c = lane & 7;
    f32x4 g0 = {1.f, 1.f, 1.f, 1.f}, g1 = {1.f, 1.f, 1.f, 1.f};
    if (gain) { g0 = *(const f32x4*)(gain + k0 + 8 * c); g1 = *(const f32x4*)(gain + k0 + 8 * c + 4); }
#pragma unroll
    for (int j = 0; j < 4; ++j) { const int n = (lane >> 3) + 8 * j; const LAS float* sp = scr + (8 * c) * 33 + n;
        u32x4 o; o.x = cvt_pk_bf16(sp[0 * 33] * g0[0], sp[1 * 33] * g0[1]); o.y = cvt_pk_bf16(sp[2 * 33] * g0[2], sp[3 * 33] * g0[3]); o.z = cvt_pk_bf16(sp[4 * 33] * g1[0], sp[5 * 33] * g1[1]); o.w = cvt_pk_bf16(sp[6 * 33] * g1[2], sp[7 * 33] * g1[3]);
        *(u32x4*)(WT + (size_t)(n0 + n) * K + k0 + 8 * c) = o; }
    asm volatile("s_waitcnt lgkmcnt(0)" ::: "memory");
}

constexpr int CV_IN = 16 * 80, CV_OUT = 16 * 32, CV_MQ = 16 * 16, CV_MKV = 16 * 32, CV_MO = 8 * 32, CV_FF1 = 16 * 128, CV_FF2 = 64 * 32, CV_C1 = 32 * 8, CV_C2 = 4 * 2;
constexpr int CV_TR = CV_IN + CV_OUT + CV_MQ + CV_MKV + CV_MO + CV_FF1 + CV_FF2 + 2 * CV_C1 + 2 * CV_C2, CV_B1 = 64, CV_SG = 1024, CONV_ITEMS = CV_TR + CV_B1 + CV_SG;
__device__ __forceinline__ void convert_layer(const Args& a, int l, int it_lo, int it_hi, int gwl, int ngwl, LAS float* scr, int lane_) {
    unsigned char* ws = a.ws; unsigned char* wl = ws + WS_W + l * W_LAYER;
#pragma unroll 1
    for (int it = it_lo + gwl; it < it_hi; it += ngwl) {
        int r = it; int lane = lane_; asm volatile("" : "+v"(lane));
        if (r < CV_IN) { transpose_item(a.in[I_WIN] + (size_t)l * 1024 * INC, 1024, INC, INP, a.in[I_NMG] + l * 1024, (bf16_t*)(wl + W_IN), scr, r, lane); continue; } r -= CV_IN;
        if (r < CV_OUT) { transpose_item(a.in[I_WOUT] + (size_t)l * 1024 * 1024, 1024, 1024, 1024, a.in[I_MOG] + l * 1024, (bf16_t*)(wl + W_OUT), scr, r, lane); continue; } r -= CV_OUT;
        if (r < CV_MQ) { transpose_item(a.in[I_WMQ] + (size_t)l * 1024 * 512, 1024, 512, 512, a.in[I_NMEMG] + l * 1024, (bf16_t*)(wl + W_MQ), scr, r, lane); continue; } r -= CV_MQ;
        if (r < CV_MKV) { transpose_item(a.in[I_WMKV] + (size_t)l * 1024 * 1024, 1024, 1024, 1024, a.in[I_MKVG] + l * 1024, (bf16_t*)(wl + W_MKV), scr, r, lane); continue; } r -= CV_MKV;
        if (r < CV_MO) { transpose_item(a.in[I_WMO] + (size_t)l * 512 * 1024, 512, 1024, 1024, (const float*)nullptr, (bf16_t*)(wl + W_MO), scr, r, lane); continue; } r -= CV_MO;
        if (r < CV_FF1) { transpose_item(a.in[I_WFF1] + (size_t)l * 1024 * 4096, 1024, 4096, 4096, a.in[I_NFG] + l * 1024, (bf16_t*)(wl + W_FF1), scr, r, lane); continue; } r -= CV_FF1;
        if (r < CV_FF2) { transpose_item(a.in[I_WFF2] + (size_t)l * 4096 * 1024, 4096, 1024, 1024, (const float*)nullptr, (bf16_t*)(wl + W_FF2), scr, r, lane); continue; } r -= CV_FF2;
        if (r < 2 * CV_C1) {
            const int kv = r / CV_C1, r2 = r % CV_C1, sub = r2 >> 6, half = sub >> 1, tb = sub & 1;
            transpose_item(a.in[I_CW1] + (size_t)(l * 2 + kv) * 2048 * 256 + (size_t)tb * 1024 * 256 + half * 128, 1024, 128, 128, (const float*)nullptr,
                           (bf16_t*)(wl + W_C1 + (size_t)kv * 512 * 1024 * 2) + (size_t)(half * 256 + tb * 128) * 1024, scr, r2 & 63, lane, 256); continue; } r -= 2 * CV_C1;
        if (r < 2 * CV_C2) { const int kv = r / CV_C2; transpose_item(a.in[I_CW2] + (size_t)(l * 2 + kv) * 256 * 64, 256, 64, 64, (const float*)nullptr, (bf16_t*)(wl + W_C2 + (size_t)kv * 64 * 256 * 2), scr, r % CV_C2, lane); continue; } r -= 2 * CV_C2;
        if (r < CV_B1) {
            const int lk = l * 2 + (r >> 5), j0 = (r & 31) * 8; const float* W1 = a.in[I_CW1] + (size_t)lk * 2048 * 256 + j0; const float* pos = a.in[I_CPOS] + (size_t)lk * 2048;
            float acc[8];
#pragma unroll
            for (int e = 0; e < 8; ++e) acc[e] = 0.f;
#pragma unroll 8
            for (int i = 0; i < 32; ++i) { const int k = i * 64 + lane; const float p = pos[k]; const f32x4 w0 = *(const f32x4*)(W1 + (size_t)k * 256), w1 = *(const f32x4*)(W1 + (size_t)k * 256 + 4);
#pragma unroll
                for (int e = 0; e < 4; ++e) { acc[e] += p * w0[e]; acc[4 + e] += p * w1[e]; } }
#pragma unroll
            for (int e = 0; e < 8; ++e) acc[e] = wave_sum(acc[e]);
            if (lane == 0) { float* dst = (float*)(wl + W_B1P) + (lk & 1) * 256 + j0;
#pragma unroll
                for (int e = 0; e < 8; ++e) dst[e] = acc[e] + a.in[I_CB1][lk * 256 + j0 + e]; }
            continue; } r -= CV_B1;
        {
            const int t = r & 127; const float* wr = a.in[I_SGW] + ((size_t)l * 1024 + r) * 128; unsigned* dst = (unsigned*)(wl + W_SG) + (size_t)r * 64 + lane; float v[2];
#pragma unroll
            for (int e = 0; e < 2; ++e) { const int p = lane * 2 + e, ks = p >> 4, hh = (p >> 3) & 1, j = p & 7, sidx = 16 * ks + 8 * (j >> 2) + 4 * hh + (j & 3); v[e] = wr[sidx <= t ? sidx : t]; v[e] = sidx <= t ? v[e] : 0.f; }
            *dst = cvt_pk_bf16(v[0], v[1]); }
    }
}
constexpr int CONV_SPLIT = 3000;
__device__ __forceinline__ void prologue(const Args& a, LAS unsigned char* lds, int gw, int NGW, int wave, int lane) {
    LAS float* scr = (LAS float*)(lds + wave * 16384);
    unsigned char* ws = a.ws; float* ctl = (float*)(ws + WS_CTL);
    convert_layer(a, 0, 0, NGW == 2048 ? CV_IN : CONV_ITEMS, gw, NGW, scr, lane);
    { const float* x = a.in[I_X]; bf16_t* XB = (bf16_t*)(ws + WS_XB);
      for (int r = gw; r < NTOK; r += NGW) { const f32x4* xr = (const f32x4*)(x + (size_t)r * 1024) + lane; unsigned long long* xb = (unsigned long long*)(XB + (size_t)r * 1024) + lane; float s = 0.f;
#pragma unroll
          for (int j = 0; j < 4; ++j) { const f32x4 v = xr[64 * j]; s += (v[0] * v[0] + v[1] * v[1]) + (v[2] * v[2] + v[3] * v[3]); xb[64 * j] = (unsigned long long)cvt_pk_bf16(v[0], v[1]) | ((unsigned long long)cvt_pk_bf16(v[2], v[3]) << 32); }
          s = wave_sum(s); if (lane < 16) ((float*)(ws + WS_SSQP))[(size_t)r * 16 + lane] = lane == 0 ? s : 0.f; } }
    { const float* mem = a.in[I_MEM]; bf16_t* MB = (bf16_t*)(ws + WS_MEMB);
      for (int r = gw; r < 1024; r += NGW) { const f32x4* xr = (const f32x4*)(mem + (size_t)r * 1024) + lane; unsigned long long* xb = (unsigned long long*)(MB + (size_t)r * 1024) + lane; float s = 0.f;
#pragma unroll
          for (int j = 0; j < 4; ++j) { const f32x4 v = xr[64 * j]; s += (v[0] * v[0] + v[1] * v[1]) + (v[2] * v[2] + v[3] * v[3]); xb[64 * j] = (unsigned long long)cvt_pk_bf16(v[0], v[1]) | ((unsigned long long)cvt_pk_bf16(v[2], v[3]) << 32); }
          s = wave_sum(s); if (lane == 0) ctl[SSQ_MEM_OFF + r] = s; } }
}

typedef float f32x16 __attribute__((ext_vector_type(16)));
typedef short s16x4 __attribute__((ext_vector_type(4)));
typedef short v4i16_t __attribute__((ext_vector_type(4)));
using pg8::bf16x8;
__device__ __forceinline__ int crow(int r, int hi) { return (r & 3) + 8 * (r >> 2) + 4 * hi; }
__device__ __forceinline__ s16x4 vtr(const LAS char* p) { return __builtin_bit_cast(s16x4, __builtin_amdgcn_ds_read_tr16_b64_v4i16((LAS v4i16_t*)p)); }
#define MFMA32(a, b, c) __builtin_amdgcn_mfma_f32_32x32x16_bf16(a, b, c, 0, 0, 0)
#define VFRAG(lo, hi) (bf16x8){lo[0], lo[1], lo[2], lo[3], hi[0], hi[1], hi[2], hi[3]}
__device__ __forceinline__ unsigned short f2bf(float f) { return (unsigned short)(cvt_pk_bf16(f, 0.f) & 0xffffu); }

__device__ __forceinline__ void memk_norm_item(bf16_t* KVM, const float* kg, int r, int lane) {
    unsigned* p = (unsigned*)(KVM + (size_t)(r >> 2) * 1024 + (r & 3) * 128) + lane; const unsigned w = *p; const float v0 = __uint_as_float(w << 16), v1 = __uint_as_float(w & 0xffff0000u);
    const float ss = wave_sum(v0 * v0 + v1 * v1); const float rs = rsqrtf(ss * (1.f / 128.f) + 1e-6f); *p = cvt_pk_bf16(v0 * rs * kg[2 * lane], v1 * rs * kg[2 * lane + 1]);
}

__device__ __forceinline__ void tokprep4(bf16_t* Q, bf16_t* KV, const float* qg, const float* kg, int t, int S, int lane) {
    u32x4 wq[4], wk[4]; const int br = 1 + ((lane >> 4) & 1);
#pragma unroll
    for (int i = 0; i < 4; ++i) { const int tt = t + i * S < NTOK ? t + i * S : NTOK - 1; wq[i] = *((const u32x4*)(Q + (size_t)tt * 512) + lane); wk[i] = *((const u32x4*)(KV + (size_t)tt * 768 + br * 256) + (lane & 15)); }
    f32x4 gq0 = *(const f32x4*)(qg + (lane & 7) * 8), gq1 = *(const f32x4*)(qg + (lane & 7) * 8 + 4), gk0 = *(const f32x4*)(kg + br * 64 + (lane & 7) * 8), gk1 = *(const f32x4*)(kg + br * 64 + (lane & 7) * 8 + 4);
#pragma unroll
    for (int i = 0; i < 4; ++i) { if (t + i * S >= NTOK) break; const int tt = t + i * S;
        { const u32x4 w = wq[i]; float v[8];
#pragma unroll
          for (int e = 0; e < 4; ++e) { v[2 * e] = __uint_as_float(w[e] << 16); v[2 * e + 1] = __uint_as_float(w[e] & 0xffff0000u); }
          float ss = 0.f;
#pragma unroll
          for (int e = 0; e < 8; ++e) ss += v[e] * v[e];
          ss += __shfl_xor(ss, 1); ss += __shfl_xor(ss, 2); ss += __shfl_xor(ss, 4);
          const float rs = rsqrtf(ss * (1.f / 64.f) + 1e-6f) * (0.125f * 1.4426950408889634f);
          u32x4 o; o[0] = cvt_pk_bf16(v[0] * rs * gq0[0], v[1] * rs * gq0[1]); o[1] = cvt_pk_bf16(v[2] * rs * gq0[2], v[3] * rs * gq0[3]); o[2] = cvt_pk_bf16(v[4] * rs * gq1[0], v[5] * rs * gq1[1]); o[3] = cvt_pk_bf16(v[6] * rs * gq1[2], v[7] * rs * gq1[3]);
          *((u32x4*)(Q + (size_t)tt * 512) + lane) = o; }
        { const u32x4 w = wk[i]; float v[8];
#pragma unroll
          for (int e = 0; e < 4; ++e) { v[2 * e] = __uint_as_float(w[e] << 16); v[2 * e + 1] = __uint_as_float(w[e] & 0xffff0000u); }
          float ss = 0.f;
#pragma unroll
          for (int e = 0; e < 8; ++e) ss += v[e] * v[e];
          ss += __shfl_xor(ss, 1); ss += __shfl_xor(ss, 2); ss += __shfl_xor(ss, 4);
          const float rs = rsqrtf(ss * (1.f / 64.f) + 1e-6f);
          u32x4 o; o[0] = cvt_pk_bf16(v[0] * rs * gk0[0], v[1] * rs * gk0[1]); o[1] = cvt_pk_bf16(v[2] * rs * gk0[2], v[3] * rs * gk0[3]); o[2] = cvt_pk_bf16(v[4] * rs * gk1[0], v[5] * rs * gk1[1]); o[3] = cvt_pk_bf16(v[6] * rs * gk1[2], v[7] * rs * gk1[3]);
          if (lane < 32) *((u32x4*)(KV + (size_t)tt * 768 + br * 256) + (lane & 15)) = o; } }
}
constexpr int SG_STAT = 0, SG_SSQ = 1024, SG_VN = 5120;
__device__ __forceinline__ void sgu_unit(LAS unsigned char* lds, int unit, const bf16_t* U, const bf16_t* Vb, const bf16_t* Wsg, const float* lng, const float* lnb, const float* sgb, bf16_t* MIX) {
    int tid_ = threadIdx.x; asm volatile("" : "+v"(tid_)); const int tid = tid_, lane = tid & 63, g = __builtin_amdgcn_readfirstlane(tid >> 6), r32 = lane & 31, hi = lane >> 5;
    const int tok0 = unit * 128;
    LAS float* STAT = (LAS float*)(lds + SG_STAT); LAS float* SSQA = (LAS float*)(lds + SG_SSQ);
    { const int tl = tid >> 2, part = tid & 3; const u32x4* p = (const u32x4*)(Vb + (size_t)(tok0 + tl) * 512 + part * 128); float s = 0.f, s2 = 0.f; u32x4 wl_[16];
#pragma unroll
      for (int i = 0; i < 16; ++i) wl_[i] = p[i];
#pragma unroll
      for (int i = 0; i < 16; ++i) { const u32x4 w = wl_[i];
#pragma unroll
          for (int e = 0; e < 4; ++e) { const float a = __uint_as_float(w[e] << 16), b = __uint_as_float(w[e] & 0xffff0000u); s += a + b; s2 += a * a + b * b; } }
      s += __shfl_xor(s, 1); s += __shfl_xor(s, 2); s2 += __shfl_xor(s2, 1); s2 += __shfl_xor(s2, 2);
      if (part == 0) { const float mu = s * (1.f / 512.f); const float var = fmaxf(s2 * (1.f / 512.f) - mu * mu, 0.f); STAT[tl * 2] = mu; STAT[tl * 2 + 1] = rsqrtf(var + 1e-6f); }
      }
    __syncthreads();
    LAS unsigned char* VN = lds + SG_VN + g * 16384;
    { const int piece = lane & 7; float gg[8], bb[8];
#pragma unroll
      for (int i = 0; i < 8; ++i) { gg[i] = lng[g * 64 + piece * 8 + i]; bb[i] = lnb[g * 64 + piece * 8 + i]; }
      u32x4 wv[16];
#pragma unroll
      for (int it = 0; it < 16; ++it) wv[it] = *(const u32x4*)(Vb + (size_t)(tok0 + it * 8 + (lane >> 3)) * 512 + g * 64 + piece * 8);
#pragma unroll
      for (int it = 0; it < 16; ++it) { const int row = it * 8 + (lane >> 3); const u32x4 w = wv[it]; const float mu = STAT[row * 2], rs = STAT[row * 2 + 1]; u32x4 o;
#pragma unroll
          for (int e = 0; e < 4; ++e) { const float a = (__uint_as_float(w[e] << 16) - mu) * rs * gg[2 * e] + bb[2 * e], b = (__uint_as_float(w[e] & 0xffff0000u) - mu) * rs * gg[2 * e + 1] + bb[2 * e + 1]; o[e] = cvt_pk_bf16(a, b); }
          *(LAS u32x4*)(VN + (piece >> 2) * 8192 + row * 64 + (piece & 3) * 16) = o; } }
    asm volatile("s_waitcnt lgkmcnt(0)" ::: "memory");
    f32x16 acc[2][4];
#pragma unroll
    for (int dh = 0; dh < 2; ++dh)
#pragma unroll
        for (int mt = 0; mt < 4; ++mt)
#pragma unroll
            for (int r = 0; r < 16; ++r) acc[dh][mt][r] = 0.f;
    const LAS char* vb = (const LAS char*)VN + ((lane >> 4) & 1) * 32 + (lane & 3) * 8 + (4 * hi + ((lane & 15) >> 2)) * 64;
    const bf16_t* wrow = Wsg + ((size_t)g * 128 + r32) * 128 + 8 * hi;
    bf16x8 wf[2][4];
#pragma unroll
    for (int mt = 0; mt < 4; ++mt) wf[0][mt] = *(const bf16x8*)(wrow + (size_t)mt * 32 * 128);
#pragma unroll
    for (int ks = 0; ks < 8; ++ks) { bf16x8 vf[2];
        if (ks < 7) {
#pragma unroll
            for (int mt = 0; mt < 4; ++mt) if (ks + 1 <= 2 * mt + 1) wf[(ks + 1) & 1][mt] = *(const bf16x8*)(wrow + (size_t)mt * 32 * 128 + (ks + 1) * 16); }
#pragma unroll
        for (int dh = 0; dh < 2; ++dh) { const s16x4 lo = vtr(vb + dh * 8192 + ks * 1024), hh = vtr(vb + dh * 8192 + ks * 1024 + 512); vf[dh] = VFRAG(lo, hh); }
#pragma unroll
        for (int mt = 0; mt < 4; ++mt) { if (ks <= 2 * mt + 1) { acc[0][mt] = MFMA32(vf[0], wf[ks & 1][mt], acc[0][mt]); acc[1][mt] = MFMA32(vf[1], wf[ks & 1][mt], acc[1][mt]); } } }
    u32x2 uu[2][8];
    { const bf16_t* up = U + (size_t)(tok0 + r32) * 512 + g * 64 + 4 * hi;
#pragma unroll
      for (int q = 0; q < 8; ++q) uu[0][q] = *(const u32x2*)(up + (q >> 2) * 32 + (q & 3) * 8); }
#pragma unroll
    for (int mt = 0; mt < 4; ++mt) { const int t = mt * 32 + r32; const float bias = sgb[g * 128 + t]; float ss = 0.f;
        if (mt < 3) { const bf16_t* upn = U + (size_t)(tok0 + t + 32) * 512 + g * 64 + 4 * hi;
#pragma unroll
            for (int q = 0; q < 8; ++q) uu[(mt + 1) & 1][q] = *(const u32x2*)(upn + (q >> 2) * 32 + (q & 3) * 8); }
#pragma unroll
        for (int dh = 0; dh < 2; ++dh)
#pragma unroll
            for (int a4 = 0; a4 < 4; ++a4) { const u32x2 w = uu[mt & 1][dh * 4 + a4];
                const float u0 = __uint_as_float(w.x << 16), u1 = __uint_as_float(w.x & 0xffff0000u), u2 = __uint_as_float(w.y << 16), u3 = __uint_as_float(w.y & 0xffff0000u);
                float x0 = u0 * (acc[dh][mt][4 * a4] + bias), x1 = u1 * (acc[dh][mt][4 * a4 + 1] + bias), x2 = u2 * (acc[dh][mt][4 * a4 + 2] + bias), x3 = u3 * (acc[dh][mt][4 * a4 + 3] + bias);
                acc[dh][mt][4 * a4] = x0; acc[dh][mt][4 * a4 + 1] = x1; acc[dh][mt][4 * a4 + 2] = x2; acc[dh][mt][4 * a4 + 3] = x3; ss += (x0 * x0 + x1 * x1) + (x2 * x2 + x3 * x3); }
        ss += __shfl_xor(ss, 32); if (hi == 0) SSQA[g * 128 + t] = ss; }
    __syncthreads();
#pragma unroll
    for (int mt = 0; mt < 4; ++mt) { const int t = mt * 32 + r32; float sa = 0.f;
#pragma unroll
        for (int w8 = 0; w8 < 8; ++w8) sa += SSQA[w8 * 128 + t];
        const float rs = rsqrtf(sa * (1.f / 512.f) + 1e-6f); bf16_t* op = MIX + (size_t)(tok0 + t) * 1024 + g * 64 + 4 * hi;
#pragma unroll
        for (int dh = 0; dh < 2; ++dh)
#pragma unroll
            for (int a4 = 0; a4 < 4; ++a4) { u32x2 w; w.x = cvt_pk_bf16(acc[dh][mt][4 * a4] * rs, acc[dh][mt][4 * a4 + 1] * rs); w.y = cvt_pk_bf16(acc[dh][mt][4 * a4 + 2] * rs, acc[dh][mt][4 * a4 + 3] * rs); *(u32x2*)(op + dh * 32 + a4 * 8) = w; } }
    __syncthreads();
}

constexpr int A_KB = 0, A_VB = 32768, A_IMPH = 65536, A_LINV = 132096, A_MASK = 133120, A_SSQ = 133632  ;
__device__ __forceinline__ void attn_cmp(LAS unsigned char* lds, const bf16_t* Kb, const bf16_t* Vb, int ntc, const bf16x8 (&qr)[4], f32x16 (&oT)[2], float& lsum,
                                         int kmin, int kmax, int kvh, int wave, int lane, int r32, int hi) {
    const int pitch = 64, hstride = 256 * 64;
    u32x4 sk0, sk1, sv0, sv1;
    const bf16_t* kthr = Kb + (size_t)lane * pitch + wave * 8; const bf16_t* vthr = Vb + (size_t)(16 * (wave & 3) + (lane >> 2)) * pitch + (wave >> 2) * 32 + (lane & 3) * 8;
    const int sdst = wave * 1024 + lane * 16;
#define A_LD(tile) do { const size_t to_ = (size_t)(tile) * 64 * pitch; sk0 = *(const u32x4*)(kthr + to_); sk1 = *(const u32x4*)(kthr + to_ + hstride); sv0 = *(const u32x4*)(vthr + to_); sv1 = *(const u32x4*)(vthr + to_ + hstride); } while (0)
#define A_ST(so) do { *(LAS u32x4*)(lds + A_KB + (so) + sdst) = sk0; *(LAS u32x4*)(lds + A_KB + (so) + 8192 + sdst) = sk1; *(LAS u32x4*)(lds + A_VB + (so) + sdst) = sv0; *(LAS u32x4*)(lds + A_VB + (so) + 8192 + sdst) = sv1; } while (0)
    const LAS char* kbase = (const LAS char*)(lds + A_KB) + kvh * 8192 + hi * 1024 + r32 * 16;
    const LAS char* vbase = (const LAS char*)(lds + A_VB) + kvh * 8192 + ((lane >> 4) & 1) * 32 + (lane & 3) * 8 + (4 * hi + ((lane & 15) >> 2)) * 64;
    LAS float* IMPH = (LAS float*)(lds + A_IMPH) + (wave * 32 + r32) * 65;
    float carry = 0.f;
    A_LD(0); A_ST(0); __syncthreads();
#pragma unroll 1
    for (int tile = 0; tile < ntc; ++tile) {
        const int so = (tile & 1) * 16384;
        if (tile + 1 < ntc) A_LD(tile + 1);
        bf16x8 kf[8];
#pragma unroll
        for (int d0 = 0; d0 < 4; ++d0) { kf[2 * d0] = *(const LAS bf16x8*)(kbase + so + d0 * 2048); kf[2 * d0 + 1] = *(const LAS bf16x8*)(kbase + so + d0 * 2048 + 512); }
        f32x16 p0, p1;
#pragma unroll
        for (int r = 0; r < 16; ++r) { p0[r] = 0.f; p1[r] = 0.f; }
#pragma unroll
        for (int d0 = 0; d0 < 4; ++d0) { p0 = MFMA32(kf[2 * d0], qr[d0], p0); p1 = MFMA32(kf[2 * d0 + 1], qr[d0], p1); }
        const int a = kmin - 64 * tile, bb = kmax - 64 * tile;
#pragma unroll
        for (int r = 0; r < 16; ++r) { p0[r] = __builtin_amdgcn_exp2f(p0[r]); p1[r] = __builtin_amdgcn_exp2f(p1[r]); }
        if (!__all(a <= 0 && bb >= 63)) { const unsigned span = (unsigned)(bb - a);
#pragma unroll
            for (int r = 0; r < 16; ++r) { const int rel = crow(r, hi); p0[r] = ((unsigned)(rel - a) <= span) ? p0[r] : 0.f; p1[r] = ((unsigned)(rel + 32 - a) <= span) ? p1[r] : 0.f; } }
        { float s = 0.f;
#pragma unroll
          for (int r = 0; r < 16; ++r) s += p0[r] + p1[r];
          lsum += s; }
        { float own[2][4], rcv[2][4];
#pragma unroll
          for (int a4 = 0; a4 < 4; ++a4) { const float h0 = 0.5f * p0[4 * a4 + 3], h1 = 0.5f * p1[4 * a4 + 3];
              own[0][a4] = (p0[4 * a4] + p0[4 * a4 + 1]) + (p0[4 * a4 + 2] + h0); own[1][a4] = (p1[4 * a4] + p1[4 * a4 + 1]) + (p1[4 * a4 + 2] + h1);
              rcv[0][a4] = __shfl_xor(h0, 32); rcv[1][a4] = __shfl_xor(h1, 32); }
#pragma unroll
          for (int h2 = 0; h2 < 2; ++h2)
#pragma unroll
              for (int a4 = 0; a4 < 4; ++a4) { const float fromprev = a4 > 0 ? rcv[h2][a4 - 1] : (h2 ? rcv[0][3] : carry);
                  IMPH[16 * tile + 8 * h2 + 2 * a4 + hi] = own[h2][a4] + (hi ? rcv[h2][a4] : fromprev); }
          carry = rcv[1][3]; }
        bf16x8 pa[4];
        { u32x4 w0, w1, w2, w3;
#pragma unroll
          for (int i = 0; i < 4; ++i) { w0[i] = cvt_pk_bf16(p0[2 * i], p0[2 * i + 1]); w1[i] = cvt_pk_bf16(p0[8 + 2 * i], p0[8 + 2 * i + 1]); w2[i] = cvt_pk_bf16(p1[2 * i], p1[2 * i + 1]); w3[i] = cvt_pk_bf16(p1[8 + 2 * i], p1[8 + 2 * i + 1]); }
          pa[0] = __builtin_bit_cast(bf16x8, w0); pa[1] = __builtin_bit_cast(bf16x8, w1); pa[2] = __builtin_bit_cast(bf16x8, w2); pa[3] = __builtin_bit_cast(bf16x8, w3); }
#pragma unroll
        for (int dh = 0; dh < 2; ++dh)
#pragma unroll
            for (int ks = 0; ks < 4; ++ks) { const s16x4 lo = vtr(vbase + so + dh * 4096 + ks * 1024), hh = vtr(vbase + so + dh * 4096 + ks * 1024 + 512); oT[dh] = MFMA32(VFRAG(lo, hh), pa[ks], oT[dh]); }
        if (tile + 1 < ntc) A_ST(so ^ 16384);
        __syncthreads();
    }
#undef A_LD
#undef A_ST
}

constexpr int A2_K = 0, A2_V = 49152, A2_SL = 16384;
#define SBAR() __builtin_amdgcn_sched_barrier(0)
#define PIN(x) asm volatile("" : "+v"(x))
#define WAIT_BAR(N) asm volatile("s_waitcnt vmcnt(" #N ") lgkmcnt(0)\n\ts_barrier" ::: "memory")
__device__ __forceinline__ void glds16(const void* g, unsigned lds_base) {
    unsigned sv; asm volatile("s_mov_b32 %0, m0\n\ts_mov_b32 m0, %2\n\ts_nop 0\n\tglobal_load_lds_dwordx4 %1, off\n\ts_mov_b32 m0, %0" : "=&s"(sv) : "v"(g), "s"(lds_base) : "memory"); }
__device__ __forceinline__ void range_mask(f32x16& c0, f32x16& c1, int a, int bb, int hi) {
    const unsigned span = (unsigned)(bb - a);
#pragma unroll
    for (int r = 0; r < 16; ++r) { const int rel = crow(r, hi); c0[r] = ((unsigned)(rel - a) <= span) ? c0[r] : -INFINITY; c1[r] = ((unsigned)(rel + 32 - a) <= span) ? c1[r] : -INFINITY; }
}
template <bool WIN>
__device__ __forceinline__ void attn_stream(LAS unsigned char* lds, const bf16_t* Kb, const bf16_t* Vb, int tlo, int NT, const bf16x8 (&qr)[4], f32x16 (&oT)[2], float& l_out,
                                            unsigned mlo, unsigned mhi, int tq, int kvh, int wave, int lane, int r32, int hi) {
    const unsigned lds0 = (unsigned)(uintptr_t)lds;
    const bf16_t* ksrc = Kb + (size_t)lane * 768 + wave * 8;
    const bf16_t* vsrc = Vb + (size_t)(16 * (wave & 3) + (lane >> 2)) * 768 + (wave >> 2) * 32 + (lane & 3) * 8;
    const unsigned kdst = lds0 + A2_K + wave * 1024, vdst = lds0 + A2_V + wave * 1024;
#define RFL(x) ((unsigned)__builtin_amdgcn_readfirstlane((int)(x)))
#define TCL(i) ((size_t)(tlo + ((i) < NT ? (i) : NT - 1)) * (64 * 768))
#define DMA_K(i, slot) do { const bf16_t* s_ = ksrc + TCL(i); glds16(s_, RFL(kdst + (slot))); glds16(s_ + 64, RFL(kdst + (slot) + 8192)); } while (0)
#define DMA_V(i, slot) do { const bf16_t* s_ = vsrc + TCL(i); glds16(s_, RFL(vdst + (slot))); glds16(s_ + 64, RFL(vdst + (slot) + 8192)); } while (0)
#define TMASK(idx_, a_, bb_, selm_) do { const int tt_ = tlo + (idx_); if (WIN) { a_ = tq - 511 - 64 * tt_; bb_ = tq - 64 * tt_; selm_ = ~0u; } \
        else { const unsigned s_ = tt_ < 32 ? (mlo >> tt_) & 1u : (mhi >> (tt_ - 32)) & 1u; a_ = -64 * tt_; bb_ = tq - 64 * tt_; selm_ = 0u - s_; } } while (0)
#define NEEDM(a_, bb_, selm_) (!__all((selm_) == 0u || ((a_) <= 0 && (bb_) >= 63)))
    const LAS char* kp0 = (const LAS char*)(lds + A2_K) + kvh * 8192 + hi * 1024 + r32 * 16;
    const LAS char* vp0 = (const LAS char*)(lds + A2_V) + kvh * 8192 + ((lane >> 4) & 1) * 32 + (lane & 3) * 8 + (4 * hi + ((lane & 15) >> 2)) * 64;
    asm volatile("s_waitcnt vmcnt(0)" ::: "memory");
    DMA_K(0, 0); DMA_V(0, 0); DMA_K(1, A2_SL); DMA_K(2, 2 * A2_SL);
    float l_reg = 0.f; f32x16 pA0, pA1, pB0, pB1; bf16x8 kf[8]; s16x4 vlo[8], vhi[8]; u32x4 pw0, pw1, pw2, pw3; unsigned selm_prev;
    const f32x16 zero16 = {0.f, 0.f, 0.f, 0.f, 0.f, 0.f, 0.f, 0.f, 0.f, 0.f, 0.f, 0.f, 0.f, 0.f, 0.f, 0.f};
    int sl_prev = 0, sl_cur = 0, sl_next = A2_SL;
#define ROT() do { sl_prev = sl_cur; sl_cur = sl_next; sl_next = (sl_next == 2 * A2_SL) ? 0 : sl_next + A2_SL; } while (0)
#define KLD(kp, d0) do { kf[2 * (d0)] = *(const LAS bf16x8*)((kp) + (d0) * 2048); kf[2 * (d0) + 1] = *(const LAS bf16x8*)((kp) + (d0) * 2048 + 512); } while (0)
    WAIT_BAR(6);
    KLD(kp0, 0); KLD(kp0, 1); KLD(kp0, 2); KLD(kp0, 3);
    pA0 = MFMA32(kf[0], qr[0], zero16); pA1 = MFMA32(kf[1], qr[0], zero16); pA0 = MFMA32(kf[2], qr[1], pA0); pA1 = MFMA32(kf[3], qr[1], pA1);
    pA0 = MFMA32(kf[4], qr[2], pA0); pA1 = MFMA32(kf[5], qr[2], pA1); pA0 = MFMA32(kf[6], qr[3], pA0); pA1 = MFMA32(kf[7], qr[3], pA1);
    { int a_, bb_; TMASK(0, a_, bb_, selm_prev); if (NEEDM(a_, bb_, selm_prev)) range_mask(pA0, pA1, a_, bb_, hi); }
#pragma unroll
    for (int r = 0; r < 16; ++r) { pA0[r] = __builtin_amdgcn_exp2f(pA0[r]); pA1[r] = __builtin_amdgcn_exp2f(pA1[r]); }
    WAIT_BAR(0);
    DMA_K(3, 0); DMA_V(1, A2_SL); ROT();
    KLD(kp0 + sl_cur, 0); KLD(kp0 + sl_cur, 1); KLD(kp0 + sl_cur, 2); KLD(kp0 + sl_cur, 3);
    WAIT_BAR(4);
#define PKW(P, i) cvt_pk_bf16(P[i], P[(i) + 1])
#define PAF(k) __builtin_bit_cast(bf16x8, pw##k)
#define VFR(i) VFRAG(vlo[i], vhi[i])
#define VRD(i) do { vlo[i] = vtr(vp_ + (((i) >> 2) * 4096 + ((i) & 3) * 1024)); vhi[i] = vtr(vp_ + (((i) >> 2) * 4096 + ((i) & 3) * 1024 + 512)); } while (0)
#define KRD(d0) do { KLD(kp0 + sl_next, d0); SBAR(); } while (0)
#define EX(v) __builtin_amdgcn_exp2f(v)
#define GAPA(MF, a0, a1, a2, a3, W0, W1, PW) do { MF; sacc += a0; sacc += a1; sacc += a2; sacc += a3; W0; W1; PIN(PW); PIN(sacc); SBAR(); } while (0)
#define GAPB(MF, X, i) do { MF; X[i] = EX(X[i]); X[(i) + 1] = EX(X[(i) + 1]); X[(i) + 2] = EX(X[(i) + 2]); X[(i) + 3] = EX(X[(i) + 3]); PIN(X); SBAR(); } while (0)
#define SELPW() do { if (!__all(selm_prev == ~0u)) { const u32x4 m_ = {selm_prev, selm_prev, selm_prev, selm_prev}; pw0 = pw0 & m_; pw1 = pw1 & m_; pw2 = pw2 & m_; pw3 = pw3 & m_; } } while (0)
#define STEP(C0, C1, P0, P1, idx) do { SBAR(); \
    const LAS char* vp_ = vp0 + sl_prev; \
    VRD(0); SBAR(); float sacc = P0[0] + P0[1]; \
                    GAPA(C0 = MFMA32(kf[0], qr[0], zero16), P0[2], P0[3], P0[4], P0[5],     pw0[0] = PKW(P0, 0),  pw0[1] = PKW(P0, 2),  pw0); \
    VRD(4); SBAR(); GAPA(C1 = MFMA32(kf[1], qr[0], zero16), P0[6], P0[7], P0[8], P0[9],     pw0[2] = PKW(P0, 4),  pw0[3] = PKW(P0, 6),  pw0); \
    VRD(1); SBAR(); GAPA(C0 = MFMA32(kf[2], qr[1], C0),     P0[10], P0[11], P0[12], P0[13], pw1[0] = PKW(P0, 8),  pw1[1] = PKW(P0, 10), pw1); \
    VRD(5); SBAR(); GAPA(C1 = MFMA32(kf[3], qr[1], C1),     P0[14], P0[15], P1[0], P1[1],   pw1[2] = PKW(P0, 12), pw1[3] = PKW(P0, 14), pw1); \
    VRD(2); SBAR(); GAPA(C0 = MFMA32(kf[4], qr[2], C0),     P1[2], P1[3], P1[4], P1[5],     pw2[0] = PKW(P1, 0),  pw2[1] = PKW(P1, 2),  pw2); \
    VRD(6); SBAR(); GAPA(C1 = MFMA32(kf[5], qr[2], C1),     P1[6], P1[7], P1[8], P1[9],     pw2[2] = PKW(P1, 4),  pw2[3] = PKW(P1, 6),  pw2); \
    VRD(3); SBAR(); GAPA(C0 = MFMA32(kf[6], qr[3], C0),     P1[10], P1[11], P1[12], P1[13], pw3[0] = PKW(P1, 8),  pw3[1] = PKW(P1, 10), pw3); \
    VRD(7); SBAR(); GAPA(C1 = MFMA32(kf[7], qr[3], C1),     P1[14], P1[15], 0.f, 0.f,       pw3[2] = PKW(P1, 12), pw3[3] = PKW(P1, 14), pw3); \
    l_reg += __uint_as_float(__float_as_uint(sacc) & selm_prev); SELPW(); \
    DMA_K((idx) + 3, sl_cur); DMA_V((idx) + 1, sl_next); \
    { int a_, bb_; unsigned selm_; TMASK(idx, a_, bb_, selm_); if (NEEDM(a_, bb_, selm_)) range_mask(C0, C1, a_, bb_, hi); selm_prev = selm_; } \
    SBAR(); \
    GAPB(oT[0] = MFMA32(VFR(0), PAF(0), oT[0]), C0, 0);            GAPB(oT[1] = MFMA32(VFR(4), PAF(0), oT[1]), C0, 4); \
    KRD(0); GAPB(oT[0] = MFMA32(VFR(1), PAF(1), oT[0]), C0, 8);    KRD(1); GAPB(oT[1] = MFMA32(VFR(5), PAF(1), oT[1]), C0, 12); \
    KRD(2); GAPB(oT[0] = MFMA32(VFR(2), PAF(2), oT[0]), C1, 0);    KRD(3); GAPB(oT[1] = MFMA32(VFR(6), PAF(2), oT[1]), C1, 4); \
    GAPB(oT[0] = MFMA32(VFR(3), PAF(3), oT[0]), C1, 8);            GAPB(oT[1] = MFMA32(VFR(7), PAF(3), oT[1]), C1, 12); \
    } while (0)
    int idx = 1;
#pragma unroll 1
    for (; idx + 1 < NT; idx += 2) {
        STEP(pB0, pB1, pA0, pA1, idx);     WAIT_BAR(4); ROT();
        STEP(pA0, pA1, pB0, pB1, idx + 1); WAIT_BAR(4); ROT();
    }
    if (idx < NT) { STEP(pB0, pB1, pA0, pA1, idx); WAIT_BAR(4); ROT(); pA0 = pB0; pA1 = pB1; }
    { float sacc = 0.f;
#pragma unroll
      for (int r = 0; r < 16; ++r) sacc += pA0[r] + pA1[r];
      l_reg += __uint_as_float(__float_as_uint(sacc) & selm_prev);
      pw0 = (u32x4){PKW(pA0, 0), PKW(pA0, 2), PKW(pA0, 4), PKW(pA0, 6)}; pw1 = (u32x4){PKW(pA0, 8), PKW(pA0, 10), PKW(pA0, 12), PKW(pA0, 14)};
      pw2 = (u32x4){PKW(pA1, 0), PKW(pA1, 2), PKW(pA1, 4), PKW(pA1, 6)}; pw3 = (u32x4){PKW(pA1, 8), PKW(pA1, 10), PKW(pA1, 12), PKW(pA1, 14)};
      SELPW();
      const LAS char* vp_ = vp0 + ((NT - 1) % 3) * A2_SL;
#pragma unroll
      for (int i = 0; i < 8; ++i) VRD(i);
      oT[0] = MFMA32(VFR(0), PAF(0), oT[0]); oT[1] = MFMA32(VFR(4), PAF(0), oT[1]); oT[0] = MFMA32(VFR(1), PAF(1), oT[0]); oT[1] = MFMA32(VFR(5), PAF(1), oT[1]);
      oT[0] = MFMA32(VFR(2), PAF(2), oT[0]); oT[1] = MFMA32(VFR(6), PAF(2), oT[1]); oT[0] = MFMA32(VFR(3), PAF(3), oT[0]); oT[1] = MFMA32(VFR(7), PAF(3), oT[1]); }
    WAIT_BAR(0);
    l_out = l_reg;
#undef RFL
#undef TCL
#undef DMA_K
#undef DMA_V
#undef TMASK
#undef NEEDM
#undef ROT
#undef KLD
#undef PKW
#undef PAF
#undef VFR
#undef VRD
#undef KRD
#undef EX
#undef GAPA
#undef GAPB
#undef SELPW
#undef STEP
}

template <int PARTS>
__device__ __forceinline__ void attn_unit(LAS unsigned char* lds, int b, int qt, const bf16_t* Q, const bf16_t* KV, const bf16_t* KC, const bf16_t* VC, const float* GL, bf16_t* MIX) {
    int tid_ = threadIdx.x; asm volatile("" : "+v"(tid_)); const int tid = tid_, lane = tid & 63, wave = __builtin_amdgcn_readfirstlane(tid >> 6), r32 = lane & 31, hi = lane >> 5, kvh = wave >> 2;
    const int t0 = qt * 32, tq = t0 + r32; const size_t tok = (size_t)b * T + tq;
    bf16x8 qr[4];
#pragma unroll
    for (int d0 = 0; d0 < 4; ++d0) qr[d0] = *(const bf16x8*)(Q + tok * 512 + wave * 64 + d0 * 16 + hi * 8);
    LAS float* IMPHA = (LAS float*)(lds + A_IMPH); LAS float* LINV = (LAS float*)(lds + A_LINV); LAS unsigned* MASKL = (LAS unsigned*)(lds + A_MASK); LAS float* SSQL = (LAS float*)(lds + A_SSQ);
    const float* glp = GL + tok * 24 + wave * 3;
    const float g0 = 1.f / (1.f + __expf(-glp[0])), g1 = 1.f / (1.f + __expf(-glp[1])), g2 = 1.f / (1.f + __expf(-glp[2]));
    f32x16 tot[2], oT[2];
    const int nvalid = tq >= 31 ? (tq - 31) / 16 + 1 : 0; const int ntc = (2 * qt + 1 + 63) >> 6;
    const int ckmin = nvalid > 0 ? 0 : (1 << 20), ckmax = nvalid > 0 ? nvalid - 1 : (1 << 20);
    const bf16_t* KCb = KC + (size_t)(b * 2) * 256 * 64; const bf16_t* VCb = VC + (size_t)(b * 2) * 256 * 64;
    float lc = 0.f;
#pragma unroll
    for (int r = 0; r < 16; ++r) { oT[0][r] = 0.f; oT[1][r] = 0.f; }
    if constexpr (PARTS & 1) attn_cmp(lds, KCb, VCb, ntc, qr, oT, lc, ckmin, ckmax, kvh, wave, lane, r32, hi);
    lc += __shfl_xor(lc, 32); const float inv_lc = lc > 0.f ? 1.f / lc : 0.f;
    if (hi == 0) LINV[wave * 32 + r32] = inv_lc;
    { const float c = g0 * inv_lc;
#pragma unroll
      for (int r = 0; r < 16; ++r) { tot[0][r] = oT[0][r] * c; tot[1][r] = oT[1][r] * c; oT[0][r] = 0.f; oT[1][r] = 0.f; } }
    __syncthreads();
    if constexpr (PARTS & 2) {
      unsigned key[8], srt[8];
#pragma unroll
      for (int i = 0; i < 8; ++i) { const int pair = wave * 8 + i, kvp = pair >> 5, qq = pair & 31, j = lane; const int tb = (t0 + qq) >> 6; float v = 0.f;
#pragma unroll
          for (int g = 0; g < 4; ++g) v += IMPHA[((kvp * 4 + g) * 32 + qq) * 65 + j] * LINV[(kvp * 4 + g) * 32 + qq];
          const bool forced = (j == 0) || (j == tb) || (j == tb - 1); const float val = forced ? 1e4f : (j <= tb ? v : -1e4f);
          unsigned k = __float_as_uint(val); k ^= (k & 0x80000000u) ? 0xffffffffu : 0x80000000u; key[i] = (k & ~63u) | (unsigned)(63 - j); srt[i] = key[i]; }
#define TK_STAGE(K_, J_) do { const bool keepmax_ = (((lane & (K_)) == 0) == ((lane & (J_)) == 0)); \
        _Pragma("unroll") for (int i = 0; i < 8; ++i) { const unsigned o_ = (J_) == 32 ? (unsigned)__shfl_xor((int)srt[i], 32) : (unsigned)__builtin_amdgcn_ds_swizzle((int)srt[i], 0x1f | ((J_) << 10)); \
            const unsigned mx_ = srt[i] > o_ ? srt[i] : o_, mn_ = srt[i] > o_ ? o_ : srt[i]; srt[i] = keepmax_ ? mx_ : mn_; } } while (0)
      TK_STAGE(2, 1);
      TK_STAGE(4, 2); TK_STAGE(4, 1);
      TK_STAGE(8, 4); TK_STAGE(8, 2); TK_STAGE(8, 1);
      TK_STAGE(16, 8); TK_STAGE(16, 4); TK_STAGE(16, 2); TK_STAGE(16, 1);
      TK_STAGE(32, 16); TK_STAGE(32, 8); TK_STAGE(32, 4); TK_STAGE(32, 2); TK_STAGE(32, 1);
      TK_STAGE(64, 32); TK_STAGE(64, 16); TK_STAGE(64, 8); TK_STAGE(64, 4); TK_STAGE(64, 2); TK_STAGE(64, 1);
#undef TK_STAGE
#pragma unroll
      for (int i = 0; i < 8; ++i) { const unsigned thr = (unsigned)__builtin_amdgcn_readlane((int)srt[i], 15);
          const unsigned long long m = __ballot(key[i] >= thr); if (lane == 0) { MASKL[(wave * 8 + i) * 2] = (unsigned)m; MASKL[(wave * 8 + i) * 2 + 1] = (unsigned)(m >> 32); } } }
    __syncthreads();
    const unsigned mlo = MASKL[(kvh * 32 + r32) * 2], mhi = MASKL[(kvh * 32 + r32) * 2 + 1];
    const int jmax = (t0 + 31) >> 6;
    const bf16_t* KVb = KV + (size_t)b * T * 768;
    unsigned totp[16];
#pragma unroll
    for (int i = 0; i < 8; ++i) { totp[i] = cvt_pk_bf16(tot[0][2 * i], tot[0][2 * i + 1]); totp[8 + i] = cvt_pk_bf16(tot[1][2 * i], tot[1][2 * i + 1]); }
    float ls = 0.f;
    if constexpr (PARTS & 4) attn_stream<false>(lds, KVb + 256, KVb + 384, 0, jmax + 1, qr, oT, ls, mlo, mhi, tq, kvh, wave, lane, r32, hi);
    ls += __shfl_xor(ls, 32);
    { const float c = ls > 0.f ? g1 / ls : 0.f;
#pragma unroll
      for (int i = 0; i < 8; ++i) { totp[i] = cvt_pk_bf16(__uint_as_float(totp[i] << 16) + oT[0][2 * i] * c, __uint_as_float(totp[i] & 0xffff0000u) + oT[0][2 * i + 1] * c);
                                    totp[8 + i] = cvt_pk_bf16(__uint_as_float(totp[8 + i] << 16) + oT[1][2 * i] * c, __uint_as_float(totp[8 + i] & 0xffff0000u) + oT[1][2 * i + 1] * c); }
#pragma unroll
      for (int r = 0; r < 16; ++r) { oT[0][r] = 0.f; oT[1][r] = 0.f; } }
    float lw = 0.f; const int jlo = t0 >= 511 ? (t0 - 511) >> 6 : 0;
    if constexpr (PARTS & 8) attn_stream<true>(lds, KVb + 512, KVb + 640, jlo, jmax - jlo + 1, qr, oT, lw, 0u, 0u, tq, kvh, wave, lane, r32, hi);
    lw += __shfl_xor(lw, 32);
    { const float c = lw > 0.f ? g2 / lw : 0.f;
#pragma unroll
      for (int i = 0; i < 8; ++i) { tot[0][2 * i] = __uint_as_float(totp[i] << 16) + oT[0][2 * i] * c; tot[0][2 * i + 1] = __uint_as_float(totp[i] & 0xffff0000u) + oT[0][2 * i + 1] * c;
                                    tot[1][2 * i] = __uint_as_float(totp[8 + i] << 16) + oT[1][2 * i] * c; tot[1][2 * i + 1] = __uint_as_float(totp[8 + i] & 0xffff0000u) + oT[1][2 * i + 1] * c; } }
    { float ss = 0.f;
#pragma unroll
      for (int r = 0; r < 16; ++r) ss += tot[0][r] * tot[0][r] + tot[1][r] * tot[1][r];
      ss += __shfl_xor(ss, 32); if (hi == 0) SSQL[wave * 32 + r32] = ss; }
    __syncthreads();
    { float sa = 0.f;
#pragma unroll
      for (int w8 = 0; w8 < 8; ++w8) sa += SSQL[w8 * 32 + r32];
      const float rs = rsqrtf(sa * (1.f / 512.f) + 1e-6f); bf16_t* op = MIX + tok * 1024 + 512 + wave * 64 + 4 * hi;
#pragma unroll
      for (int dh = 0; dh < 2; ++dh)
#pragma unroll
          for (int a4 = 0; a4 < 4; ++a4) { u32x2 w; w.x = cvt_pk_bf16(tot[dh][4 * a4] * rs, tot[dh][4 * a4 + 1] * rs); w.y = cvt_pk_bf16(tot[dh][4 * a4 + 2] * rs, tot[dh][4 * a4 + 3] * rs); *(u32x2*)(op + dh * 32 + a4 * 8) = w; } }
    __syncthreads();
}

__device__ __forceinline__ void memattn_unit(LAS unsigned char* lds, int b, int h, int qt, const bf16_t* QM, const bf16_t* KVM, const float* qg, bf16_t* OM) {
    int tid_ = threadIdx.x; asm volatile("" : "+v"(tid_)); const int tid = tid_, lane = tid & 63, wave = __builtin_amdgcn_readfirstlane(tid >> 6), r32 = lane & 31, hi = lane >> 5;
    const size_t tok = (size_t)b * T + qt * 256 + wave * 32 + r32;
    bf16x8 qr[8];
    { float v[64]; float ss = 0.f;
#pragma unroll
      for (int d0 = 0; d0 < 8; ++d0) { const u32x4 w = *(const u32x4*)(QM + tok * 512 + h * 128 + d0 * 16 + hi * 8);
#pragma unroll
          for (int i = 0; i < 4; ++i) { const float a = __uint_as_float(w[i] << 16), c = __uint_as_float(w[i] & 0xffff0000u); v[d0 * 8 + 2 * i] = a; v[d0 * 8 + 2 * i + 1] = c; ss += a * a + c * c; } }
      ss += __shfl_xor(ss, 32); const float rs = rsqrtf(ss * (1.f / 128.f) + 1e-6f) * (0.08838834764831845f * 1.4426950408889634f);
#pragma unroll
      for (int d0 = 0; d0 < 8; ++d0) { u32x4 w; const float* gp = qg + d0 * 16 + hi * 8;
#pragma unroll
          for (int i = 0; i < 4; ++i) w[i] = cvt_pk_bf16(v[d0 * 8 + 2 * i] * rs * gp[2 * i], v[d0 * 8 + 2 * i + 1] * rs * gp[2 * i + 1]);
          qr[d0] = __builtin_bit_cast(bf16x8, w); } }
    const bf16_t* Kg = KVM + (size_t)b * 256 * 1024 + h * 128; const bf16_t* Vg = Kg + 512;
    { u32x4 sk[8], sv[8];
#pragma unroll
      for (int tile = 0; tile < 4; ++tile)
#pragma unroll
          for (int i = 0; i < 2; ++i) { sk[tile * 2 + i] = *(const u32x4*)(Kg + (size_t)(tile * 64 + lane) * 1024 + (wave * 2 + i) * 8); const int p = i * 512 + tid;
              sv[tile * 2 + i] = *(const u32x4*)(Vg + (size_t)(tile * 64 + ((p & 255) >> 2)) * 1024 + (p >> 8) * 32 + (p & 3) * 8); }
#pragma unroll
      for (int tile = 0; tile < 4; ++tile)
#pragma unroll
          for (int i = 0; i < 2; ++i) { *(LAS u32x4*)(lds + tile * 16384 + (wave * 2 + i) * 1024 + lane * 16) = sk[tile * 2 + i]; *(LAS u32x4*)(lds + 65536 + tile * 16384 + (i * 512 + tid) * 16) = sv[tile * 2 + i]; } }
    const LAS char* kbase = (const LAS char*)lds + hi * 1024 + r32 * 16;
    const LAS char* vbase = (const LAS char*)lds + 65536 + ((lane >> 4) & 1) * 32 + (lane & 3) * 8 + (4 * hi + ((lane & 15) >> 2)) * 64;
    f32x16 oT[4]; float lsum = 0.f;
#pragma unroll
    for (int dq = 0; dq < 4; ++dq)
#pragma unroll
        for (int r = 0; r < 16; ++r) oT[dq][r] = 0.f;
    __syncthreads();
#pragma unroll 1
    for (int tile = 0; tile < 4; ++tile) { const int so = tile * 16384;
        f32x16 p0, p1;
#pragma unroll
        for (int r = 0; r < 16; ++r) { p0[r] = 0.f; p1[r] = 0.f; }
#pragma unroll
        for (int d0 = 0; d0 < 8; ++d0) { const bf16x8 k0 = *(const LAS bf16x8*)(kbase + so + d0 * 2048), k1 = *(const LAS bf16x8*)(kbase + so + d0 * 2048 + 512); p0 = MFMA32(k0, qr[d0], p0); p1 = MFMA32(k1, qr[d0], p1); }
        float s = 0.f;
#pragma unroll
        for (int r = 0; r < 16; ++r) { p0[r] = __builtin_amdgcn_exp2f(p0[r]); p1[r] = __builtin_amdgcn_exp2f(p1[r]); s += p0[r] + p1[r]; }
        lsum += s;
        bf16x8 pa[4];
        { u32x4 w0, w1, w2, w3;
#pragma unroll
          for (int i = 0; i < 4; ++i) { w0[i] = cvt_pk_bf16(p0[2 * i], p0[2 * i + 1]); w1[i] = cvt_pk_bf16(p0[8 + 2 * i], p0[8 + 2 * i + 1]); w2[i] = cvt_pk_bf16(p1[2 * i], p1[2 * i + 1]); w3[i] = cvt_pk_bf16(p1[8 + 2 * i], p1[8 + 2 * i + 1]); }
          pa[0] = __builtin_bit_cast(bf16x8, w0); pa[1] = __builtin_bit_cast(bf16x8, w1); pa[2] = __builtin_bit_cast(bf16x8, w2); pa[3] = __builtin_bit_cast(bf16x8, w3); }
#pragma unroll
        for (int dq = 0; dq < 4; ++dq)
#pragma unroll
            for (int ks = 0; ks < 4; ++ks) { const s16x4 lo = vtr(vbase + so + dq * 4096 + ks * 1024), hh = vtr(vbase + so + dq * 4096 + ks * 1024 + 512); oT[dq] = MFMA32(VFRAG(lo, hh), pa[ks], oT[dq]); }
    }
    __syncthreads();
    lsum += __shfl_xor(lsum, 32); const float il = 1.f / lsum; bf16_t* op = OM + tok * 512 + h * 128 + 4 * hi;
#pragma unroll
    for (int dq = 0; dq < 4; ++dq)
#pragma unroll
        for (int a4 = 0; a4 < 4; ++a4) { u32x2 w; w.x = cvt_pk_bf16(oT[dq][4 * a4] * il, oT[dq][4 * a4 + 1] * il); w.y = cvt_pk_bf16(oT[dq][4 * a4 + 2] * il, oT[dq][4 * a4 + 3] * il); *(u32x2*)(op + dq * 32 + a4 * 8) = w; }
}

#define XB_TMO      128
#define XB_XCNT(j)  (256  + 64 * (j))
#define XB_XSUB(j)  (1280 + 64 * (j))
#define XB_XGEN(j)  (2304 + 64 * (j))
#define XB_TOP      3328
#define XB_TOPGEN   3392
#define XCD_BAR_WORDS 3456
#define XB_SPIN_CAP (1u << 18)
__device__ __forceinline__ unsigned xb_ld(unsigned* p)              { return __hip_atomic_load(p, __ATOMIC_RELAXED, __HIP_MEMORY_SCOPE_AGENT); }
__device__ __forceinline__ unsigned xb_add(unsigned* p, unsigned v) { return __hip_atomic_fetch_add(p, v, __ATOMIC_RELAXED, __HIP_MEMORY_SCOPE_AGENT); }
__device__ __forceinline__ unsigned xb_xcc_id() { return (unsigned)__builtin_amdgcn_s_getreg((3 << 11) | 20) & 0xFu; }
#define XB_SPIN(cond, bar) do { unsigned _sp = 0; while (cond) { __builtin_amdgcn_s_sleep(1); \
    if ((++_sp & 255u) == 0u) { if (xb_ld(&(bar)[XB_TMO])) break; if (_sp > XB_SPIN_CAP) { atomicAdd(&(bar)[XB_TMO], 1u); break; } } } } while (0)
struct XcdBarrier { unsigned* bar; unsigned x; volatile LAS unsigned* st; };
__device__ __forceinline__ XcdBarrier xcd_barrier_post(unsigned* bar, volatile LAS unsigned* st) {
    XcdBarrier b; b.bar = bar; b.x = xb_xcc_id(); b.st = st;
    if (threadIdx.x == 0) (void)xb_add(&bar[XB_XCNT(b.x)], 1u);
    return b;
}
__device__ __forceinline__ void xcd_barrier_complete(unsigned* bar, unsigned x, unsigned& nloc, unsigned& nx) {
    const unsigned G = gridDim.x * gridDim.y * gridDim.z;
    unsigned sum, cnt, mine, sp = 0u;
    for (;;) {
        sum = 0u; cnt = 0u; mine = 0u;
#pragma unroll
        for (unsigned j = 0; j < 16; ++j) { const unsigned c = xb_ld(&bar[XB_XCNT(j)]); sum += c; cnt += (c > 0u) ? 1u : 0u; mine = (j == x) ? c : mine; }
        if (sum == G) break;
        __builtin_amdgcn_s_sleep(1);
        if ((++sp & 255u) == 0u) { if (xb_ld(&bar[XB_TMO])) break; if (sp > XB_SPIN_CAP) { atomicAdd(&bar[XB_TMO], 1u); break; } }
    }
    nloc = mine > 0u ? mine : 1u; nx = cnt > 0u ? cnt : 1u;
}
__device__ __forceinline__ void xcd_barrier(const XcdBarrier& b) {
    asm volatile("s_waitcnt vmcnt(0)" ::: "memory");
    __syncthreads();
    if (threadIdx.x == 0) {
        unsigned* bar = b.bar;
        __builtin_amdgcn_s_waitcnt(0);
        unsigned nloc = b.st[0], nx = b.st[1];
        if (nloc == 0u) { xcd_barrier_complete(bar, b.x, nloc, nx); b.st[0] = nloc; b.st[1] = nx; }
        const unsigned old = xb_add(&bar[XB_XSUB(b.x)], 1u);
        const unsigned gen = old / nloc;
        if (old + 1u == (gen + 1u) * nloc) {
            __builtin_amdgcn_fence(__ATOMIC_RELEASE, "agent");
            asm volatile("s_waitcnt vmcnt(0)" ::: "memory");
            const unsigned og = xb_add(&bar[XB_TOP], 1u);
            const unsigned tg = og / nx;
            if (og + 1u == (tg + 1u) * nx) xb_add(&bar[XB_TOPGEN], 1u);
            else XB_SPIN(xb_ld(&bar[XB_TOPGEN]) == tg, bar);
            __builtin_amdgcn_fence(__ATOMIC_ACQUIRE, "agent");
            xb_add(&bar[XB_XGEN(b.x)], 1u);
            asm volatile("s_waitcnt vmcnt(0)" ::: "memory");
        } else {
            XB_SPIN(xb_ld(&bar[XB_XGEN(b.x)]) == gen, bar);
            __builtin_amdgcn_fence(__ATOMIC_ACQUIRE, "agent");
            asm volatile("s_waitcnt vmcnt(0)" ::: "memory");
        }
    }
    __syncthreads();
}
constexpr size_t CTL_BAR_BYTE = 704 * 1024;
constexpr size_t CTL_FLAG_BYTE = 720 * 1024;
constexpr int LDS_ST_OFF = 147456 - 64;

struct EpiCmp {
    static constexpr bool PERM = false, AFTER_DRAIN = true;
    const float* b1p; const bf16_t* w2t; const float* b2; const float* kg0; bf16_t* OUT; float* PART; unsigned* flag; unsigned epoch; int half;
    __device__ __forceinline__ void fused(f32x4 (&acc)[2][2][4][2], const pg8::Unit&, int wr, int wc, int fr, int fq, LAS unsigned char* lds, int wid, int lane) const {
        unsigned ep = epoch; asm volatile("" : "+s"(ep));
        LAS float* PB = (LAS float*)lds;
        LAS unsigned char* HB = lds;
#pragma unroll
        for (int ai = 0; ai < 2; ++ai)
#pragma unroll
            for (int m = 0; m < 4; ++m) { const int row = ai * 128 + wr * 64 + m * 16 + fr;
#pragma unroll
                for (int n = 0; n < 2; ++n) *(LAS f32x4*)(PB + row * 132 + wc * 32 + n * 16 + 4 * fq) = acc[ai][1][m][n]; }
        __syncthreads();
        u32x2 hv[2][4][2];
#pragma unroll
        for (int ai = 0; ai < 2; ++ai)
#pragma unroll
            for (int m = 0; m < 4; ++m) { const int row = ai * 128 + wr * 64 + m * 16 + fr;
#pragma unroll
                for (int n = 0; n < 2; ++n) { const int col = wc * 32 + n * 16 + 4 * fq; f32x4 pb = {0.f, 0.f, 0.f, 0.f}; if (row < 255) pb = *(const LAS f32x4*)(PB + (row + 1) * 132 + col);
                    const f32x4 bb = *(const f32x4*)(b1p + half * 128 + col); const f32x4 v = acc[ai][0][m][n] + pb + bb;
                    hv[ai][m][n].x = cvt_pk_bf16(pg8::gelu_tanh(v[0]), pg8::gelu_tanh(v[1])); hv[ai][m][n].y = cvt_pk_bf16(pg8::gelu_tanh(v[2]), pg8::gelu_tanh(v[3])); } }
        __syncthreads();
#pragma unroll
        for (int ai = 0; ai < 2; ++ai)
#pragma unroll
            for (int m = 0; m < 4; ++m) { const int row = ai * 128 + wr * 64 + m * 16 + fr;
#pragma unroll
                for (int n = 0; n < 2; ++n) *(LAS u32x2*)(HB + row * 272 + (wc * 32 + n * 16 + 4 * fq) * 2) = hv[ai][m][n]; }
        __syncthreads();
        const int r32 = lane & 31, hi = lane >> 5, row = wid * 32 + r32;
        bf16x8 a0[8], a1[8], bf[8];
#pragma unroll
        for (int ks = 0; ks < 8; ++ks) { a0[ks] = *(const bf16x8*)(w2t + (size_t)r32 * 256 + half * 128 + ks * 16 + hi * 8); a1[ks] = *(const bf16x8*)(w2t + (size_t)(32 + r32) * 256 + half * 128 + ks * 16 + hi * 8);
            bf[ks] = *(const LAS bf16x8*)(HB + row * 272 + (ks * 16 + hi * 8) * 2); }
        f32x16 o2[2];
#pragma unroll
        for (int r = 0; r < 16; ++r) { o2[0][r] = 0.f; o2[1][r] = 0.f; }
#pragma unroll
        for (int ks = 0; ks < 8; ++ks) { o2[0] = MFMA32(a0[ks], bf[ks], o2[0]); o2[1] = MFMA32(a1[ks], bf[ks], o2[1]); }
        float* pp = PART + (size_t)row * 64 + 4 * hi;
        if (half == 1) {
#pragma unroll
            for (int h = 0; h < 2; ++h)
#pragma unroll
                for (int a4 = 0; a4 < 4; ++a4) *(f32x4*)(pp + 32 * h + 8 * a4) = (f32x4){o2[h][4 * a4], o2[h][4 * a4 + 1], o2[h][4 * a4 + 2], o2[h][4 * a4 + 3]};
            asm volatile("s_waitcnt vmcnt(0)" ::: "memory"); __syncthreads();
            if (threadIdx.x == 0) { __builtin_amdgcn_fence(__ATOMIC_RELEASE, "agent"); asm volatile("s_waitcnt vmcnt(0)" ::: "memory"); __hip_atomic_store(flag, ep, __ATOMIC_RELAXED, __HIP_MEMORY_SCOPE_AGENT); }
            return; }
        if (wid == 0) { unsigned sp = 0;
            while ((unsigned)__builtin_amdgcn_readfirstlane(__hip_atomic_load(flag, __ATOMIC_RELAXED, __HIP_MEMORY_SCOPE_AGENT)) < ep) { __builtin_amdgcn_s_sleep(2); if (++sp > (1u << 22)) break; }
            __builtin_amdgcn_fence(__ATOMIC_ACQUIRE, "agent"); asm volatile("s_waitcnt vmcnt(0)" ::: "memory"); }
        __syncthreads();
        float ss = 0.f;
#pragma unroll
        for (int h = 0; h < 2; ++h)
#pragma unroll
            for (int a4 = 0; a4 < 4; ++a4) { const f32x4 pv = *(const f32x4*)(pp + 32 * h + 8 * a4); const f32x4 bv = *(const f32x4*)(b2 + 32 * h + 8 * a4 + 4 * hi);
#pragma unroll
                for (int e = 0; e < 4; ++e) { const float v = o2[h][4 * a4 + e] + pv[e] + bv[e]; o2[h][4 * a4 + e] = v; ss += v * v; } }
        if (kg0) { ss += __shfl_xor(ss, 32); const float rs = rsqrtf(ss * (1.f / 64.f) + 1e-6f);
#pragma unroll
            for (int h = 0; h < 2; ++h)
#pragma unroll
                for (int a4 = 0; a4 < 4; ++a4) { const f32x4 gv = *(const f32x4*)(kg0 + 32 * h + 8 * a4 + 4 * hi);
#pragma unroll
                    for (int e = 0; e < 4; ++e) o2[h][4 * a4 + e] *= rs * gv[e]; } }
        const float keep = row == 255 ? 0.f : 1.f;
#pragma unroll
        for (int h = 0; h < 2; ++h)
#pragma unroll
            for (int a4 = 0; a4 < 4; ++a4) { u32x2 w; w.x = cvt_pk_bf16(o2[h][4 * a4] * keep, o2[h][4 * a4 + 1] * keep); w.y = cvt_pk_bf16(o2[h][4 * a4 + 2] * keep, o2[h][4 * a4 + 3] * keep); *(u32x2*)(OUT + (size_t)row * 64 + 32 * h + 8 * a4 + 4 * hi) = w; }
    }
};

template <bool PROBE>
__device__ __forceinline__ void do_phase(const int p, const int l, const Args& args, LAS unsigned char* lds, const int G, const int bx, const int NGW) {
    unsigned char* ws = args.ws; float* xout = args.out; asm volatile("" : "+s"(ws), "+s"(xout));
    int tidp = threadIdx.x; asm volatile("" : "+v"(tidp)); const int lane = tidp & 63, wave = __builtin_amdgcn_readfirstlane(tidp >> 6), gw = bx * 8 + wave; (void)lane; (void)gw; (void)NGW;
    float* ctl = (float*)(ws + WS_CTL); bf16_t* XB = (bf16_t*)(ws + WS_XB); float* ssqp = (float*)(ws + WS_SSQP);
    unsigned char* wl = ws + WS_W + l * W_LAYER;
    if (p == 0) {
        pg8::Gemm g = pg8::make_gemm(XB, (const bf16_t*)(wl + W_IN), 1024); pg8::StaticOrder S; S.init(NTOK, INP, G, bx);
        pg8::EpiInProj E{(bf16_t*)(ws + WS_U), (bf16_t*)(ws + WS_V), (bf16_t*)(ws + WS_Q), (bf16_t*)(ws + WS_KV), (float*)(ws + WS_GL), ssqp + (size_t)(l == 0 ? 0 : 3) * NTOK * 16};
        pg8::gemm_phase<pg8::EpiInProj, pg8::StaticOrder, true>(lds, g, S, E);
        if (l == 0 && !PROBE && G == 256 && bx >= 128)
            convert_layer(args, 0, CV_IN, CONV_ITEMS, (bx - 128) * 8 + wave, 128 * 8, (LAS float*)(lds + wave * 16384), lane);
    } else if (p == 1) {
      for (int vb = bx; vb < 256; vb += G) {
        if (PROBE && !((MK_P1_ROLES >> (vb < 32 ? 0 : vb < 48 ? 1 : vb < 176 ? 2 : 3)) & 1)) continue;
        if (vb < 32) { if constexpr (!PROBE || (MK_P1_ROLES & 1)) { const int kv = vb >> 4, pm = (vb >> 1) & 7, half = vb & 1;
            pg8::Gemm g; g.A = (const bf16_t*)(ws + WS_KV) + kv * 128; g.Bt = (const bf16_t*)(wl + W_C1 + (size_t)kv * 512 * 1024 * 2); g.K = 1024; g.lda = 16 * 768; g.kstepA = 768 * 2; g.a_s0 = 64 * 2; g.a_s1 = (size_t)T * 768 * 2;
            pg8::OneUnit S{1, {pm, half}};
            EpiCmp E{(const float*)(wl + W_B1P) + kv * 256, (const bf16_t*)(wl + W_C2) + (size_t)kv * 64 * 256, args.in[I_CB2] + l * 128 + kv * 64, kv == 0 ? args.in[I_KNG] + l * 192 : (const float*)nullptr,
                     (bf16_t*)(ws + (kv ? WS_VC : WS_KC)) + (size_t)pm * 256 * 64, (float*)(ws + WS_HID) + (size_t)(kv * 8 + pm) * 256 * 64, (unsigned*)(ws + WS_CTL + CTL_FLAG_BYTE) + (kv * 8 + pm) * 64, (unsigned)(l + 1), half};
            pg8::gemm_phase<EpiCmp, pg8::OneUnit, false>(lds, g, S, E); }
        } else if (vb < 48) { if constexpr (!PROBE || (MK_P1_ROLES & 2)) { const int i = vb - 32;
            pg8::Gemm g = pg8::make_gemm((const bf16_t*)(ws + WS_MEMB), (const bf16_t*)(wl + W_MKV), 1024); pg8::OneUnit S{1, {i >> 2, i & 3}};
            pg8::EpiBf16G<0> E{(bf16_t*)(ws + WS_KVM), 1024, nullptr, ctl + SSQ_MEM_OFF, 1.f / 1024.f, 1};
            pg8::gemm_phase<pg8::EpiBf16G<0>, pg8::OneUnit, true>(lds, g, S, E); }
        } else if (vb < 176) { if constexpr (!PROBE || (MK_P1_ROLES & 4))
            sgu_unit(lds, vb - 48, (const bf16_t*)(ws + WS_U), (const bf16_t*)(ws + WS_V), (const bf16_t*)(wl + W_SG), args.in[I_SGLNG] + l * 512, args.in[I_SGLNB] + l * 512, args.in[I_SGB] + l * 1024, (bf16_t*)(ws + WS_MIX));
        } else {
            for (int t = (vb - 176) * 8 + wave; t < NTOK; t += 4 * 640) tokprep4((bf16_t*)(ws + WS_Q), (bf16_t*)(ws + WS_KV), args.in[I_QNG] + l * 64, args.in[I_KNG] + l * 192, t, 640, lane);
            if (l == 0 && !PROBE) convert_layer(args, 1, 0, CONV_SPLIT, (vb - 176) * 8 + wave, 80 * 8, (LAS float*)(lds + wave * 16384), lane);
        } }
    } else if (p == 3) {
        for (int r = gw; r < 4096; r += NGW) memk_norm_item((bf16_t*)(ws + WS_KVM), args.in[I_MKG] + l * 128, r, lane);
        for (int i = bx; i < 256; i += G) { const int b = (i & 7) >> 1, idx = (i >> 3) * 2 + (i & 1);
            attn_unit<15>(lds, b, 127 - idx, (const bf16_t*)(ws + WS_Q), (const bf16_t*)(ws + WS_KV), (const bf16_t*)(ws + WS_KC), (const bf16_t*)(ws + WS_VC), (const float*)(ws + WS_GL), (bf16_t*)(ws + WS_MIX));
            attn_unit<15>(lds, b, idx, (const bf16_t*)(ws + WS_Q), (const bf16_t*)(ws + WS_KV), (const bf16_t*)(ws + WS_KC), (const bf16_t*)(ws + WS_VC), (const float*)(ws + WS_GL), (bf16_t*)(ws + WS_MIX)); }
    } else if (p == 6) {
        for (int i = bx; i < 256; i += G) { const int b = (i & 7) >> 1, rest = (i >> 3) * 2 + (i & 1);
            memattn_unit(lds, b, rest >> 4, rest & 15, (const bf16_t*)(ws + WS_QM), (const bf16_t*)(ws + WS_KVM), args.in[I_MQG] + l * 128, (bf16_t*)(ws + WS_OM)); }
    } else if (p == 4) {
        pg8::Gemm g = pg8::make_gemm((const bf16_t*)(ws + WS_MIX), (const bf16_t*)(wl + W_OUT), 1024); pg8::StaticOrder S; S.init(NTOK, 1024, G, bx);
        pg8::EpiResid E{nullptr, XB, ssqp + (size_t)(PROBE ? 1 : l * 3 + 1) * NTOK * 16};
        pg8::gemm_phase<pg8::EpiResid, pg8::StaticOrder, true>(lds, g, S, E);
    } else if (p == 5) {
        pg8::Gemm g = pg8::make_gemm(XB, (const bf16_t*)(wl + W_MQ), 1024); pg8::StaticOrder S; S.init(NTOK, 512, G, bx);
        pg8::EpiBf16G<0> E{(bf16_t*)(ws + WS_QM), 512, nullptr, ssqp + (size_t)(l * 3 + 1) * NTOK * 16, 1.f / 1024.f, 16};
        pg8::gemm_phase<pg8::EpiBf16G<0>, pg8::StaticOrder, true>(lds, g, S, E);
        if (l == 0 && !PROBE) { const int nidle = G > 128 ? G - 128 : 0;
            if (nidle == 0) convert_layer(args, 1, CONV_SPLIT, CONV_ITEMS, gw, NGW, (LAS float*)(lds + wave * 16384), lane);
            else if (bx >= 128) convert_layer(args, 1, CONV_SPLIT, CONV_ITEMS, (bx - 128) * 8 + wave, nidle * 8, (LAS float*)(lds + wave * 16384), lane); }
    } else if (p == 7) {
        pg8::Gemm g = pg8::make_gemm((const bf16_t*)(ws + WS_OM), (const bf16_t*)(wl + W_MO), 512); pg8::StaticOrder S; S.init(NTOK, 1024, G, bx);
        pg8::EpiResid E{nullptr, XB, ssqp + (size_t)(PROBE ? 1 : l * 3 + 2) * NTOK * 16};
        pg8::gemm_phase<pg8::EpiResid, pg8::StaticOrder, true>(lds, g, S, E);
    } else if (p == 8) {
        pg8::Gemm g = pg8::make_gemm(XB, (const bf16_t*)(wl + W_FF1), 1024); pg8::StaticOrder S; S.init(NTOK, FF, G, bx);
        pg8::EpiBf16G<2> E{(bf16_t*)(ws + WS_HB), FF, nullptr, ssqp + (size_t)(l * 3 + 2) * NTOK * 16, 1.f / 1024.f, 16};
        pg8::gemm_phase<pg8::EpiBf16G<2>, pg8::StaticOrder, true>(lds, g, S, E);
    } else if (p == 9) {
        pg8::Gemm g = pg8::make_gemm((const bf16_t*)(ws + WS_HB), (const bf16_t*)(wl + W_FF2), FF); pg8::StaticOrder S; S.init(NTOK, 1024, G, bx);
        pg8::EpiResid E{(l == 0 || PROBE) ? (float*)nullptr : xout, XB, ssqp + (size_t)(PROBE ? 1 : 3) * NTOK * 16};
        pg8::gemm_phase<pg8::EpiResid, pg8::StaticOrder, true>(lds, g, S, E);
    }
}

constexpr int LDS_BYTES = 147456;
__global__ void __launch_bounds__(512, 2) mega(Args args) {
    extern __shared__ __attribute__((aligned(16))) unsigned char lds_raw[];
    LAS unsigned char* lds = (LAS unsigned char*)lds_raw;
    const int G = gridDim.x, bx = blockIdx.x, NGW = G * 8;
    volatile LAS unsigned* bar_st = (volatile LAS unsigned*)(lds + LDS_ST_OFF);
    if (threadIdx.x < 2) bar_st[threadIdx.x] = 0u;
    __syncthreads();
    XcdBarrier xbar = xcd_barrier_post((unsigned*)(args.ws + WS_CTL + CTL_BAR_BYTE), bar_st);
    if (args.ph_hi < 0) cooperative_groups::this_grid().sync();
    if (args.ph_lo == 0) { const int tid0 = threadIdx.x, wave0 = __builtin_amdgcn_readfirstlane(tid0 >> 6); for (int e_ = 0; e_ < 1 + MK_PROBE_PRO; ++e_) prologue(args, lds, bx * 8 + wave0, NGW, wave0, tid0 & 63); }
    for (int ph = args.ph_lo > 1 ? args.ph_lo : 1; ph < args.ph_hi; ++ph) {
        if ((ph - 1) % 10 == 2) continue;
        if (ph > args.ph_lo) {
            xcd_barrier(xbar); }
        do_phase<false>((ph - 1) % 10, (ph - 1) / 10, args, lds, G, bx, NGW);
    }
#if MK_PROBE_N > 0
    if (args.ph_hi == 21) {
        xcd_barrier(xbar); do_phase<false>(0, 1, args, lds, G, bx, NGW);
        xcd_barrier(xbar); do_phase<false>(1, 1, args, lds, G, bx, NGW);
        for (int e_ = 0; e_ < MK_PROBE_N; ++e_) { xcd_barrier(xbar);
#if MK_PROBE_KIND == 100
            { int tidp = threadIdx.x; asm volatile("" : "+v"(tidp)); const int w_ = __builtin_amdgcn_readfirstlane(tidp >> 6); convert_layer(args, 1, 0, CONV_ITEMS, bx * 8 + w_, NGW, (LAS float*)(lds + w_ * 16384), tidp & 63); }
#elif MK_PROBE_KIND == 33
            for (int i = bx; i < 256; i += G) { const int b = (i & 7) >> 1, idx = (i >> 3) * 2 + (i & 1); unsigned char* ws = args.ws;
                attn_unit<MK_PROBE_PARTS>(lds, b, 127 - idx, (const bf16_t*)(ws + WS_Q), (const bf16_t*)(ws + WS_KV), (const bf16_t*)(ws + WS_KC), (const bf16_t*)(ws + WS_VC), (const float*)(ws + WS_GL), (bf16_t*)(ws + WS_MIX));
                attn_unit<MK_PROBE_PARTS>(lds, b, idx, (const bf16_t*)(ws + WS_Q), (const bf16_t*)(ws + WS_KV), (const bf16_t*)(ws + WS_KC), (const bf16_t*)(ws + WS_VC), (const float*)(ws + WS_GL), (bf16_t*)(ws + WS_MIX)); }
#elif MK_PROBE_KIND == 34
            { unsigned char* ws = args.ws; unsigned char* wl = ws + WS_W + W_LAYER;
              for (int vb = bx; vb < 256; vb += G) if (vb >= 48 && vb < 176) sgu_unit(lds, vb - 48, (const bf16_t*)(ws + WS_U), (const bf16_t*)(ws + WS_V), (const bf16_t*)(wl + W_SG), args.in[I_SGLNG] + 512, args.in[I_SGLNB] + 512, args.in[I_SGB] + 1024, (bf16_t*)(ws + WS_MIX)); }
#elif MK_PROBE_KIND == 35
            { unsigned char* ws = args.ws; int tidp = threadIdx.x; asm volatile("" : "+v"(tidp)); const int w_ = __builtin_amdgcn_readfirstlane(tidp >> 6);
              for (int vb = bx; vb < 256; vb += G) if (vb >= 176) for (int t = (vb - 176) * 8 + w_; t < NTOK; t += 4 * 640) tokprep4((bf16_t*)(ws + WS_Q), (bf16_t*)(ws + WS_KV), args.in[I_QNG] + 64, args.in[I_KNG] + 192, t, 640, tidp & 63); }
#elif MK_PROBE_KIND != 99
            do_phase<true>(MK_PROBE_KIND, 1, args, lds, G, bx, NGW);
#endif
        }
    }
#endif
}

}

#ifndef MK_FUSED
#define MK_FUSED 1
#endif
extern "C" void kernel_launch(void* const* d_in, const int* in_sizes, int n_in, void* d_out, int out_size, void* d_ws, size_t ws_size, hipStream_t stream) {
    using namespace mk;
    static int grid = 0;
    if (!grid) { (void)hipFuncSetAttribute((const void*)mega, hipFuncAttributeMaxDynamicSharedMemorySize, LDS_BYTES);
        int dev = 0, cus = 0, per_cu = 0; (void)hipGetDevice(&dev); (void)hipDeviceGetAttribute(&cus, hipDeviceAttributeMultiprocessorCount, dev);
        (void)hipOccupancyMaxActiveBlocksPerMultiprocessor(&per_cu, (const void*)mega, 512, LDS_BYTES);
        grid = cus * (per_cu < 1 ? 1 : per_cu); if (grid > 256) grid = 256; }
    Args a{}; for (int i = 0; i < 27; ++i) a.in[i] = (const float*)d_in[i]; a.out = (float*)d_out; a.ws = (unsigned char*)d_ws;
#if MK_FUSED
    (void)hipMemsetAsync((unsigned char*)d_ws + WS_CTL + CTL_BAR_BYTE, 0, 20 * 1024, stream);
    a.ph_lo = 0; a.ph_hi = 21; void* kargs[] = {&a};
    (void)hipLaunchCooperativeKernel((const void*)mega, dim3(grid), dim3(512), kargs, LDS_BYTES, stream);
#else
    for (int ph = 0; ph < 21; ++ph) { a.ph_lo = ph; a.ph_hi = ph + 1; hipLaunchKernelGGL(mega, dim3(grid), dim3(512), LDS_BYTES, stream, a); }
#endif
}
```

```cpp
#include <hip/hip_runtime.h>
#include <hip/hip_cooperative_groups.h>
#include <stdint.h>
#include <math.h>

namespace pg8 {
#define PG8_LAS __attribute__((address_space(3)))
typedef unsigned short bf16_t;
typedef short bf16x8 __attribute__((ext_vector_type(8)));
typedef float f32x4 __attribute__((ext_vector_type(4)));
typedef float f32x2 __attribute__((ext_vector_type(2)));
typedef unsigned u32x4 __attribute__((ext_vector_type(4)));
typedef unsigned u32x2 __attribute__((ext_vector_type(2)));
constexpr int BM = 256, BK = 64, HALF = 128, HTB = HALF * BK * 2, STAGE_BYTES = 8 * HTB, NXCD = 8, WGM = 2;

__host__ __device__ __forceinline__ int lds_byte(int r, int c) { const int st = (r >> 4) * 2 + (c >> 5), rr = r & 15, cc = c & 31, ob = rr * 64 + cc * 2; return st * 1024 + (ob ^ (((ob >> 9) & 1) << 5)); }
__host__ __device__ __forceinline__ void stage_rc(int b, int& R, int& C) { const int st = b / 1024, sb = b % 1024, swz = sb ^ (((sb >> 9) & 1) << 5); R = (st >> 1) * 16 + swz / 64; C = (st & 1) * 32 + (swz % 64) / 2; }
__host__ __device__ __forceinline__ int perm32(int rho) { const int n = rho >> 4, i = rho & 15; return 8 * (i >> 2) + 4 * n + (i & 3); }

struct Unit { int pm, pn; };
struct Gemm { const bf16_t* A; const bf16_t* Bt; int K; int lda; int kstepA; size_t a_s0, a_s1; };
__device__ __forceinline__ Gemm make_gemm(const bf16_t* A, const bf16_t* Bt, int K) { Gemm g; g.A = A; g.Bt = Bt; g.K = K; g.lda = K; g.kstepA = BK * 2; g.a_s0 = (size_t)BM * K * 2; g.a_s1 = 2 * g.a_s0; return g; }

struct StaticOrder {
    int nM, nN, nwg, G, c;
    __device__ void init(int M, int N, int G_, int c_) { nM = M / BM; nN = N / BM; nwg = nM * nN; G = G_; c = c_; }
    __device__ bool next(int i, Unit& u) const {
        const long L = (long)i * G + c; if (L >= nwg) return false;
        int wgid = (int)L; { const int q = nwg / NXCD, r = nwg % NXCD, xcd = wgid % NXCD, off = wgid / NXCD; wgid = (xcd < r ? xcd * (q + 1) : r * (q + 1) + (xcd - r) * q) + off; }
        const int nig = WGM * nN, gid = wgid / nig, fm = gid * WGM, gsz = (nM - fm) < WGM ? (nM - fm) : WGM;
        u.pm = fm + ((wgid % nig) % gsz); u.pn = (wgid % nig) / gsz; return true;
    }
};
struct OneUnit { int has; Unit u; __device__ bool next(int i, Unit& o) const { if (i > 0 || !has) return false; o = u; return true; } };

__device__ __forceinline__ unsigned cvt_pk_bf16(float lo, float hi) { unsigned r; asm volatile("v_cvt_pk_bf16_f32 %0, %1, %2" : "=v"(r) : "v"(lo), "v"(hi)); return r; }
__device__ __forceinline__ float gelu_tanh(float x) { const float u = 0.7978845608028654f * (x + 0.044715f * x * x * x); const float e = __builtin_amdgcn_exp2f(-2.885390081777927f * u); return x * __builtin_amdgcn_rcpf(1.f + e); }

__device__ __forceinline__ float ssq16(const float* p) { const f32x4 a = ((const f32x4*)p)[0], b = ((const f32x4*)p)[1], c = ((const f32x4*)p)[2], d = ((const f32x4*)p)[3];
    return (((a[0] + a[1]) + (a[2] + a[3])) + ((b[0] + b[1]) + (b[2] + b[3]))) + (((c[0] + c[1]) + (c[2] + c[3])) + ((d[0] + d[1]) + (d[2] + d[3]))); }
template <int ACT  > struct EpiBf16G {
    static constexpr bool PERM = true, AFTER_DRAIN = false;
    bf16_t* O; int ldc; const float* bias; const float* ssq; float inv_n; int nparts;
    __device__ __forceinline__ void operator()(const f32x4 (&acc)[2][2][4][2], const Unit& u, int wr, int wc, int fr, int fq) const {
        const int row0 = u.pm * BM + wr * 64 + fr, col0 = u.pn * BM + wc * 32 + 8 * fq;
        f32x4 bv[2][2];
#pragma unroll
        for (int bj = 0; bj < 2; ++bj)
#pragma unroll
            for (int n = 0; n < 2; ++n) bv[bj][n] = bias ? *(const f32x4*)(bias + col0 + bj * HALF + 4 * n) : (f32x4){0.f, 0.f, 0.f, 0.f};
        float rsv[2] = {1.f, 1.f};
        if (ssq) {
#pragma unroll
            for (int ai = 0; ai < 2; ++ai) { const int rr = row0 + ai * HALF + fq * 16; rsv[ai] = rsqrtf((nparts == 16 ? ssq16(ssq + (size_t)rr * 16) : ssq[rr]) * inv_n + 1e-6f); } }
#pragma unroll
        for (int ai = 0; ai < 2; ++ai)
#pragma unroll
            for (int m = 0; m < 4; ++m) { const int row = row0 + ai * HALF + m * 16; const float rs = __shfl(rsv[ai], fr + 16 * m); bf16_t* rowp = O + (size_t)row * ldc + col0;
#pragma unroll
                for (int bj = 0; bj < 2; ++bj) { f32x4 v0 = (acc[ai][bj][m][0] + bv[bj][0]) * rs, v1 = (acc[ai][bj][m][1] + bv[bj][1]) * rs;
                    if (ACT == 1) {
#pragma unroll
                        for (int e = 0; e < 4; ++e) { v0[e] = gelu_tanh(v0[e]); v1[e] = gelu_tanh(v1[e]); } }
                    if (ACT == 2) {
#pragma unroll
                        for (int e = 0; e < 4; ++e) { float a = fmaxf(v0[e], 0.f), b = fmaxf(v1[e], 0.f); v0[e] = a * a; v1[e] = b * b; } }
                    u32x4 w; w.x = cvt_pk_bf16(v0[0], v0[1]); w.y = cvt_pk_bf16(v0[2], v0[3]); w.z = cvt_pk_bf16(v1[0], v1[1]); w.w = cvt_pk_bf16(v1[2], v1[3]);
                    *(u32x4*)(rowp + bj * HALF) = w; } }
    }
};
struct EpiInProj {
    static constexpr bool PERM = true, AFTER_DRAIN = false;
    bf16_t *U, *V, *Q, *KV; float* GL; const float* ssq;
    __device__ __forceinline__ void operator()(const f32x4 (&acc)[2][2][4][2], const Unit& u, int wr, int wc, int fr, int fq) const {
        const int row0 = u.pm * BM + wr * 64 + fr, cit0 = wc * 32 + 8 * fq; const int pn = u.pn;
        bf16_t* base; int ldc, cofs; bool act = false;
        if (pn < 2) { base = U; ldc = 512; cofs = pn * 256; act = true; } else if (pn < 4) { base = V; ldc = 512; cofs = (pn - 2) * 256; act = true; }
        else if (pn < 6) { base = Q; ldc = 512; cofs = (pn - 4) * 256; } else { base = KV; ldc = 768; cofs = (pn - 6) * 256; }
        float rsv[2];
#pragma unroll
        for (int ai = 0; ai < 2; ++ai) rsv[ai] = rsqrtf(ssq16(ssq + (size_t)(row0 + ai * HALF + fq * 16) * 16) * (1.f / 1024.f) + 1e-6f);
#pragma unroll
        for (int ai = 0; ai < 2; ++ai)
#pragma unroll
            for (int m = 0; m < 4; ++m) { const int row = row0 + ai * HALF + m * 16; const float rs = __shfl(rsv[ai], fr + 16 * m);
#pragma unroll
                for (int bj = 0; bj < 2; ++bj) { f32x4 v0 = acc[ai][bj][m][0] * rs, v1 = acc[ai][bj][m][1] * rs; const int cit = cit0 + bj * HALF;
                    if (pn == 9) { if (cit < 24) { *(f32x4*)(GL + (size_t)row * 24 + cit) = v0; *(f32x4*)(GL + (size_t)row * 24 + cit + 4) = v1; } }
                    else { if (act) {
#pragma unroll
                            for (int e = 0; e < 4; ++e) { v0[e] = gelu_tanh(v0[e]); v1[e] = gelu_tanh(v1[e]); } }
                        u32x4 w; w.x = cvt_pk_bf16(v0[0], v0[1]); w.y = cvt_pk_bf16(v0[2], v0[3]); w.z = cvt_pk_bf16(v1[0], v1[1]); w.w = cvt_pk_bf16(v1[2], v1[3]);
                        *(u32x4*)(base + (size_t)row * ldc + cofs + cit) = w; } } }
    }
};
struct EpiResid {
    static constexpr bool PERM = false, AFTER_DRAIN = false;
    float* XF; bf16_t* XB; float* ssq;
    __device__ __forceinline__ void operator()(const f32x4 (&acc)[2][2][4][2], const Unit& u, int wr, int wc, int fr, int fq) const {
        const int col0 = u.pn * BM + wc * 32 + 4 * fq;
#pragma unroll
        for (int ai = 0; ai < 2; ++ai)
#pragma unroll
            for (int m = 0; m < 4; ++m) { const int row = u.pm * BM + ai * HALF + wr * 64 + m * 16 + fr; float sq = 0.f;
#pragma unroll
                for (int bj = 0; bj < 2; ++bj)
#pragma unroll
                    for (int n = 0; n < 2; ++n) { const size_t off = (size_t)row * 1024 + col0 + bj * HALF + n * 16; const u32x2 xw = *(const u32x2*)(XB + off);
                        f32x4 xv; xv[0] = __uint_as_float(xw.x << 16); xv[1] = __uint_as_float(xw.x & 0xffff0000u); xv[2] = __uint_as_float(xw.y << 16); xv[3] = __uint_as_float(xw.y & 0xffff0000u);
                        xv = xv + acc[ai][bj][m][n];
                        if (XF) *(f32x4*)(XF + off) = xv;
                        else { sq += (xv[0] * xv[0] + xv[1] * xv[1]) + (xv[2] * xv[2] + xv[3] * xv[3]); u32x2 w; w.x = cvt_pk_bf16(xv[0], xv[1]); w.y = cvt_pk_bf16(xv[2], xv[3]); *(u32x2*)(XB + off) = w; } }
                if (!XF) { sq += __shfl_xor(sq, 16); sq += __shfl_xor(sq, 32); if (fq == 0) ssq[(size_t)row * 16 + u.pn * 4 + wc] = sq; } }
    }
};

template <class Epi, class Sched, bool ALIGN_EPI>
__device__ __forceinline__ void gemm_phase(PG8_LAS unsigned char* lds, const Gemm g, const Sched& S, const Epi& E) {
    int tid_ = threadIdx.x; asm volatile("" : "+v"(tid_));
    const int tid = tid_, wid = __builtin_amdgcn_readfirstlane(tid >> 6), lane = tid & 63, wr = wid >> 2, wc = wid & 3, fr = lane & 15, fq = lane >> 4;
    const int K = g.K, nt = K / BK;
    unsigned voffA[2], voffB[2];
#pragma unroll
    for (int i = 0; i < 2; ++i) { int R, C; stage_rc(tid * 16 + i * 8192, R, C); const int Rb = Epi::PERM ? ((R & ~31) + perm32(R & 31)) : R;
        voffA[i] = (unsigned)(R * g.lda + C) * 2u; voffB[i] = (unsigned)(Rb * K + C) * 2u; }
    const size_t kstepA = (size_t)g.kstepA, kstepB = (size_t)(BK * 2);
    const size_t hstepA = (size_t)HALF * g.lda * 2, hstepB = (size_t)HALF * K * 2, tstepB = 2 * hstepB;
    const unsigned ldsw = (unsigned)wid * 1024u;
    const int aoff = lds_byte(wr * 64 + fr, fq * 8), boff = lds_byte(wc * 32 + fr, fq * 8);
#define PG8_ABASE(pm) ((const char*)g.A + (size_t)((pm) >> 1) * g.a_s1 + (size_t)((pm) & 1) * g.a_s0)
#define PG8_SA(b, h) (((b) * 2 + (h)) * HTB)
#define PG8_SB(b, h) ((4 + (b) * 2 + (h)) * HTB)
#define PG8_STAGE(bufoff, gbase, voff) do { _Pragma("unroll") for (int _i = 0; _i < 2; ++_i) \
        __builtin_amdgcn_global_load_lds((const unsigned*)((const char*)(gbase) + (voff)[_i]), (PG8_LAS unsigned*)(lds + (bufoff) + ldsw + _i * 8192), 16, 0, 0); } while (0)
#define PG8_LDA(dst, b, h) do { _Pragma("unroll") for (int m = 0; m < 4; ++m) _Pragma("unroll") for (int k = 0; k < 2; ++k) dst[m][k] = *(const PG8_LAS bf16x8*)(lds + PG8_SA(b, h) + aoff + m * 2048 + k * 1024); } while (0)
#define PG8_LDB(dst, b, h) do { _Pragma("unroll") for (int n = 0; n < 2; ++n) _Pragma("unroll") for (int k = 0; k < 2; ++k) dst[n][k] = *(const PG8_LAS bf16x8*)(lds + PG8_SB(b, h) + boff + n * 2048 + k * 1024); } while (0)
#define PG8_MMA(ai, bj, At, Bt) do { __builtin_amdgcn_s_setprio(1); _Pragma("unroll") for (int m = 0; m < 4; ++m) _Pragma("unroll") for (int n = 0; n < 2; ++n) _Pragma("unroll") for (int k = 0; k < 2; ++k) \
        acc[ai][bj][m][n] = __builtin_amdgcn_mfma_f32_16x16x32_bf16(Bt[n][k], At[m][k], acc[ai][bj][m][n], 0, 0, 0); __builtin_amdgcn_s_setprio(0); } while (0)
#define PG8_WAIT_V(n) asm volatile("s_waitcnt vmcnt(" #n ")" ::: "memory")
#define PG8_WAIT_L(n) asm volatile("s_waitcnt lgkmcnt(" #n ")" ::: "memory")
#define PG8_BAR __builtin_amdgcn_s_barrier()
#define PG8_SCHED __builtin_amdgcn_sched_barrier(0)
    Unit cur, nxt; int ui = 0;
    if (!S.next(0, cur)) return;
    f32x4 acc[2][2][4][2];
#pragma unroll
    for (int a = 0; a < 2; ++a)
#pragma unroll
        for (int b = 0; b < 2; ++b)
#pragma unroll
            for (int m = 0; m < 4; ++m)
#pragma unroll
                for (int n = 0; n < 2; ++n) acc[a][b][m][n] = (f32x4){0.f, 0.f, 0.f, 0.f};
    bf16x8 At[4][2], B0[2][2], B1[2][2];
    const char* cA = PG8_ABASE(cur.pm); const char* cB = (const char*)g.Bt + (size_t)cur.pn * tstepB;
    PG8_STAGE(PG8_SB(0, 0), cB, voffB); PG8_STAGE(PG8_SB(0, 1), cB + hstepB, voffB); PG8_STAGE(PG8_SA(0, 0), cA, voffA); PG8_STAGE(PG8_SA(0, 1), cA + hstepA, voffA);
    if (wr == 1) PG8_BAR;
    PG8_WAIT_V(2); PG8_BAR;
    PG8_STAGE(PG8_SB(1, 0), cB + kstepB, voffB); PG8_STAGE(PG8_SA(1, 0), cA + kstepA, voffA); PG8_STAGE(PG8_SB(1, 1), cB + hstepB + kstepB, voffB);
    PG8_WAIT_V(6); PG8_BAR;
    for (;;) {
        const bool has_next = S.next(ui + 1, nxt);
        const char* nA = has_next ? PG8_ABASE(nxt.pm) : cA; const char* nB = has_next ? (const char*)g.Bt + (size_t)nxt.pn * tstepB : cB;
        for (int t = 0; t < nt; t += 2) {
            const bool last = (t == nt - 2);
            const char* a1 = cA + (size_t)(t + 1) * kstepA;
            const char* a2 = last ? nA : cA + (size_t)(t + 2) * kstepA; const char* b2 = last ? nB : cB + (size_t)(t + 2) * kstepB;
            const char* a3 = a2 + kstepA; const char* b3 = b2 + kstepB;
            PG8_LDB(B0, 0, 0); PG8_LDB(B1, 0, 1); PG8_SCHED; PG8_LDA(At, 0, 0); PG8_STAGE(PG8_SA(1, 1), a1 + hstepA, voffA);
            PG8_WAIT_V(8); PG8_WAIT_L(0); PG8_BAR; PG8_MMA(0, 0, At, B0); PG8_MMA(0, 1, At, B1); PG8_BAR; PG8_SCHED;
            PG8_LDA(At, 0, 1); PG8_STAGE(PG8_SB(0, 0), b2, voffB); PG8_STAGE(PG8_SB(0, 1), b2 + hstepB, voffB); PG8_STAGE(PG8_SA(0, 0), a2, voffA);
            PG8_WAIT_V(8); PG8_WAIT_L(0); PG8_BAR; PG8_MMA(1, 0, At, B0); PG8_MMA(1, 1, At, B1); PG8_BAR; PG8_SCHED;
            PG8_LDB(B0, 1, 0); PG8_LDB(B1, 1, 1); PG8_SCHED; PG8_LDA(At, 1, 0); PG8_STAGE(PG8_SA(0, 1), a2 + hstepA, voffA);
            PG8_WAIT_V(8); PG8_WAIT_L(0); PG8_BAR; PG8_MMA(0, 0, At, B0); PG8_MMA(0, 1, At, B1); PG8_BAR; PG8_SCHED;
            PG8_LDA(At, 1, 1); PG8_STAGE(PG8_SB(1, 0), b3, voffB); PG8_STAGE(PG8_SB(1, 1), b3 + hstepB, voffB); PG8_STAGE(PG8_SA(1, 0), a3, voffA);
            PG8_WAIT_V(8); PG8_WAIT_L(0); PG8_BAR; PG8_MMA(1, 0, At, B0); PG8_MMA(1, 1, At, B1); PG8_BAR; PG8_SCHED;
        }
        if constexpr (ALIGN_EPI) { if (wr == 0) PG8_BAR; }
        if constexpr (!Epi::AFTER_DRAIN) { E(acc, cur, wr, wc, fr, fq); }
        if (!has_next) break;
#pragma unroll
        for (int a = 0; a < 2; ++a)
#pragma unroll
            for (int b = 0; b < 2; ++b)
#pragma unroll
                for (int m = 0; m < 4; ++m)
#pragma unroll
                    for (int n = 0; n < 2; ++n) acc[a][b][m][n] = (f32x4){0.f, 0.f, 0.f, 0.f};
        cur = nxt; cA = nA; cB = nB; ++ui;
        if constexpr (ALIGN_EPI) { if (wr == 1) PG8_BAR; }
    }
    PG8_WAIT_V(0);
    if constexpr (!ALIGN_EPI) { if (wr == 0) PG8_BAR; }
    PG8_BAR;
    if constexpr (Epi::AFTER_DRAIN) { E.fused(acc, cur, wr, wc, fr, fq, lds, wid, lane); }
#undef PG8_ABASE
#undef PG8_SA
#undef PG8_SB
#undef PG8_STAGE
#undef PG8_LDA
#undef PG8_LDB
#undef PG8_MMA
#undef PG8_WAIT_V
#undef PG8_WAIT_L
#undef PG8_BAR
#undef PG8_SCHED
}
}

#ifndef MK_PROBE_N
#define MK_PROBE_N 0
#endif
#ifndef MK_P1_ROLES
#define MK_P1_ROLES 15
#endif
#ifndef MK_PROBE_PRO
#define MK_PROBE_PRO 0
#endif
#ifndef MK_PROBE_KIND
#define MK_PROBE_KIND 3
#endif
#ifndef MK_PROBE_PARTS
#define MK_PROBE_PARTS 15
#endif

namespace mk {
using pg8::bf16_t; using pg8::f32x4; using pg8::u32x4; using pg8::u32x2; using pg8::cvt_pk_bf16;
#define LAS __attribute__((address_space(3)))
constexpr int NB = 4, T = 4096, D = 1024, NTOK = NB * T, INC = 2328, INP = 2560, FF = 4096;
constexpr size_t MiB = 1u << 20;
constexpr size_t WS_CTL = 0;
constexpr size_t WS_W = 1 * MiB, W_LAYER = 30 * MiB;
constexpr size_t W_IN = 0, W_OUT = 5 * MiB, W_MQ = 7 * MiB, W_MKV = 8 * MiB, W_MO = 10 * MiB, W_FF1 = 11 * MiB, W_FF2 = 19 * MiB, W_C1 = 27 * MiB, W_C2 = 29 * MiB, W_SG = 29 * MiB + 128 * 1024, W_B1P = 29 * MiB + 512 * 1024;
constexpr size_t WS_XB = 61 * MiB;
constexpr size_t WS_OV = 93 * MiB;
constexpr size_t WS_U = WS_OV, WS_V = WS_OV + 16 * MiB, WS_Q = WS_OV + 32 * MiB, WS_KV = WS_OV + 48 * MiB, WS_MIX = WS_OV + 72 * MiB, WS_QM = WS_OV + 104 * MiB, WS_OM = WS_OV + 120 * MiB;
constexpr size_t WS_HB = WS_OV;
constexpr size_t WS_SM = 229 * MiB;
constexpr size_t WS_GL = WS_SM, WS_KC = WS_SM + 2 * MiB, WS_VC = WS_KC + 256 * 1024, WS_HID = WS_SM + 3 * MiB, WS_MASK = WS_SM + 5 * MiB, WS_MEMB = WS_SM + 6 * MiB, WS_KVM = WS_SM + 8 * MiB, WS_END = WS_SM + 10 * MiB;
constexpr size_t WS_SSQP = 240 * MiB;
static_assert(WS_END <= WS_SSQP && WS_SSQP + 6 * MiB <= 256 * MiB, "ws map");
constexpr int SSQ_MEM_OFF = 6 * NTOK;

struct Args { const float* in[27]; float* out; unsigned char* ws; int ph_lo, ph_hi; };
enum { I_X = 0, I_MEM, I_NMG, I_WIN, I_SGLNG, I_SGLNB, I_SGW, I_SGB, I_QNG, I_KNG, I_CPOS, I_CW1, I_CB1, I_CW2, I_CB2, I_MOG, I_WOUT, I_NMEMG, I_MKVG, I_WMQ, I_WMKV, I_MQG, I_MKG, I_WMO, I_NFG, I_WFF1, I_WFF2 };

__device__ __forceinline__ float bf2f(unsigned short b) { return __uint_as_float((unsigned)b << 16); }
__device__ __forceinline__ float wave_sum(float v) {
#pragma unroll
    for (int o = 1; o < 64; o <<= 1) v += __shfl_xor(v, o);
    return v; }

__device__ __forceinline__ void transpose_item(const float* W, int K, int N, int Npad, const float* gain, bf16_t* WT, LAS float* scr, int item, int lane, int ld = 0) {
    if (ld == 0) ld = N;
    const int nblk = Npad / 32, kb = item / nblk, nb = item % nblk, k0 = 64 * kb, n0 = 32 * nb;
    const int nn = n0 + (lane & 31); const int nnc = nn < N ? nn : N - 1; const float keep = nn < N ? 1.f : 0.f;
    const float* src = W + (size_t)(k0 + (lane >> 5)) * ld + nnc;
    float v[32];
#pragma unroll
    for (int i = 0; i < 32; ++i) v[i] = src[(size_t)(2 * i) * ld];
#pragma unroll
    for (int i = 0; i < 32; ++i) scr[(2 * i + (lane >> 5)) * 33 + (lane & 31)] = v[i] * keep;
    asm volatile("s_waitcnt lgkmcnt(0)" ::: "memory");
    const int c = lane & 7;
    f32x4 g0 = {1.f, 1.f, 1.f, 1.f}, g1 = {1.f, 1.f, 1.f, 1.f};
    if (gain) { g0 = *(const f32x4*)(gain + k0 + 8 * c); g1 = *(const f32x4*)(gain + k0 + 8 * c + 4); }
#pragma unroll
    for (int j = 0; j < 4; ++j) { const int n = (lane >> 3) + 8 * j; const LAS float* sp = scr + (8 * c) * 33 + n;
        u32x4 o; o.x = cvt_pk_bf16(sp[0 * 33] * g0[0], sp[1 * 33] * g0[1]); o.y = cvt_pk_bf16(sp[2 * 33] * g0[2], sp[3 * 33] * g0[3]); o.z = cvt_pk_bf16(sp[4 * 33] * g1[0], sp[5 * 33] * g1[1]); o.w = cvt_pk_bf16(sp[6 * 33] * g1[2], sp[7 * 33] * g1[3]);
        *(u32x4*)(WT + (size_t)(n0 + n) * K + k0 + 8 * c) = o; }
    asm volatile("s_waitcnt lgkmcnt(0)" ::: "memory");
}

constexpr int CV_IN = 16 * 80, CV_OUT = 16 * 32, CV_MQ = 16 * 16, CV_MKV = 16 * 32, CV_MO = 8 * 32, CV_FF1 = 16 * 128, CV_FF2 = 64 * 32, CV_C1 = 32 * 8, CV_C2 = 4 * 2;
constexpr int CV_TR = CV_IN + CV_OUT + CV_MQ + CV_MKV + CV_MO + CV_FF1 + CV_FF2 + 2 * CV_C1 + 2 * CV_C2, CV_B1 = 64, CV_SG = 1024, CONV_ITEMS = CV_TR + CV_B1 + CV_SG;
__device__ __forceinline__ void convert_layer(const Args& a, int l, int it_lo, int it_hi, int gwl, int ngwl, LAS float* scr, int lane_) {
    unsigned char* ws = a.ws; unsigned char* wl = ws + WS_W + l * W_LAYER;
#pragma unroll 1
    for (int it = it_lo + gwl; it < it_hi; it += ngwl) {
        int r = it; int lane = lane_; asm volatile("" : "+v"(lane));
        if (r < CV_IN) { transpose_item(a.in[I_WIN] + (size_t)l * 1024 * INC, 1024, INC, INP, a.in[I_NMG] + l * 1024, (bf16_t*)(wl + W_IN), scr, r, lane); continue; } r -= CV_IN;
        if (r < CV_OUT) { transpose_item(a.in[I_WOUT] + (size_t)l * 1024 * 1024, 1024, 1024, 1024, a.in[I_MOG] + l * 1024, (bf16_t*)(wl + W_OUT), scr, r, lane); continue; } r -= CV_OUT;
        if (r < CV_MQ) { transpose_item(a.in[I_WMQ] + (size_t)l * 1024 * 512, 1024, 512, 512, a.in[I_NMEMG] + l * 1024, (bf16_t*)(wl + W_MQ), scr, r, lane); continue; } r -= CV_MQ;
        if (r < CV_MKV) { transpose_item(a.in[I_WMKV] + (size_t)l * 1024 * 1024, 1024, 1024, 1024, a.in[I_MKVG] + l * 1024, (bf16_t*)(wl + W_MKV), scr, r, lane); continue; } r -= CV_MKV;
        if (r < CV_MO) { transpose_item(a.in[I_WMO] + (size_t)l * 512 * 1024, 512, 1024, 1024, (const float*)nullptr, (bf16_t*)(wl + W_MO), scr, r, lane); continue; } r -= CV_MO;
        if (r < CV_FF1) { transpose_item(a.in[I_WFF1] + (size_t)l * 1024 * 4096, 1024, 4096, 4096, a.in[I_NFG] + l * 1024, (bf16_t*)(wl + W_FF1), scr, r, lane); continue; } r -= CV_FF1;
        if (r < CV_FF2) { transpose_item(a.in[I_WFF2] + (size_t)l * 4096 * 1024, 4096, 1024, 1024, (const float*)nullptr, (bf16_t*)(wl + W_FF2), scr, r, lane); continue; } r -= CV_FF2;
        if (r < 2 * CV_C1) {
            const int kv = r / CV_C1, r2 = r % CV_C1, sub = r2 >> 6, half = sub >> 1, tb = sub & 1;
            transpose_item(a.in[I_CW1] + (size_t)(l * 2 + kv) * 2048 * 256 + (size_t)tb * 1024 * 256 + half * 128, 1024, 128, 128, (const float*)nullptr,
                           (bf16_t*)(wl + W_C1 + (size_t)kv * 512 * 1024 * 2) + (size_t)(half * 256 + tb * 128) * 1024, scr, r2 & 63, lane, 256); continue; } r -= 2 * CV_C1;
        if (r < 2 * CV_C2) { const int kv = r / CV_C2; transpose_item(a.in[I_CW2] + (size_t)(l * 2 + kv) * 256 * 64, 256, 64, 64, (const float*)nullptr, (bf16_t*)(wl + W_C2 + (size_t)kv * 64 * 256 * 2), scr, r % CV_C2, lane); continue; } r -= 2 * CV_C2;
        if (r < CV_B1) {
            const int lk = l * 2 + (r >> 5), j0 = (r & 31) * 8; const float* W1 = a.in[I_CW1] + (size_t)lk * 2048 * 256 + j0; const float* pos = a.in[I_CPOS] + (size_t)lk * 2048;
            float acc[8];
#pragma unroll
            for (int e = 0; e < 8; ++e) acc[e] = 0.f;
#pragma unroll 8
            for (int i = 0; i < 32; ++i) { const int k = i * 64 + lane; const float p = pos[k]; const f32x4 w0 = *(const f32x4*)(W1 + (size_t)k * 256), w1 = *(const f32x4*)(W1 + (size_t)k * 256 + 4);
#pragma unroll
                for (int e = 0; e < 4; ++e) { acc[e] += p * w0[e]; acc[4 + e] += p * w1[e]; } }
#pragma unroll
            for (int e = 0; e < 8; ++e) acc[e] = wave_sum(acc[e]);
            if (lane == 0) { float* dst = (float*)(wl + W_B1P) + (lk & 1) * 256 + j0;
#pragma unroll
                for (int e = 0; e < 8; ++e) dst[e] = acc[e] + a.in[I_CB1][lk * 256 + j0 + e]; }
            continue; } r -= CV_B1;
        {
            const int t = r & 127; const float* wr = a.in[I_SGW] + ((size_t)l * 1024 + r) * 128; unsigned* dst = (unsigned*)(wl + W_SG) + (size_t)r * 64 + lane; float v[2];
#pragma unroll
            for (int e = 0; e < 2; ++e) { const int p = lane * 2 + e, ks = p >> 4, hh = (p >> 3) & 1, j = p & 7, sidx = 16 * ks + 8 * (j >> 2) + 4 * hh + (j & 3); v[e] = wr[sidx <= t ? sidx : t]; v[e] = sidx <= t ? v[e] : 0.f; }
            *dst = cvt_pk_bf16(v[0], v[1]); }
    }
}
constexpr int CONV_SPLIT = 3000;
__device__ __forceinline__ void prologue(const Args& a, LAS unsigned char* lds, int gw, int NGW, int wave, int lane) {
    LAS float* scr = (LAS float*)(lds + wave * 16384);
    unsigned char* ws = a.ws; float* ctl = (float*)(ws + WS_CTL);
    convert_layer(a, 0, 0, NGW == 2048 ? CV_IN : CONV_ITEMS, gw, NGW, scr, lane);
    { const float* x = a.in[I_X]; bf16_t* XB = (bf16_t*)(ws + WS_XB);
      for (int r = gw; r < NTOK; r += NGW) { const f32x4* xr = (const f32x4*)(x + (size_t)r * 1024) + lane; unsigned long long* xb = (unsigned long long*)(XB + (size_t)r * 1024) + lane; float s = 0.f;
#pragma unroll
          for (int j = 0; j < 4; ++j) { const f32x4 v = xr[64 * j]; s += (v[0] * v[0] + v[1] * v[1]) + (v[2] * v[2] + v[3] * v[3]); xb[64 * j] = (unsigned long long)cvt_pk_bf16(v[0], v[1]) | ((unsigned long long)cvt_pk_bf16(v[2], v[3]) << 32); }
          s = wave_sum(s); if (lane < 16) ((float*)(ws + WS_SSQP))[(size_t)r * 16 + lane] = lane == 0 ? s : 0.f; } }
    { const float* mem = a.in[I_MEM]; bf16_t* MB = (bf16_t*)(ws + WS_MEMB);
      for (int r = gw; r < 1024; r += NGW) { const f32x4* xr = (const f32x4*)(mem + (size_t)r * 1024) + lane; unsigned long long* xb = (unsigned long long*)(MB + (size_t)r * 1024) + lane; float s = 0.f;
#pragma unroll
          for (int j = 0; j < 4; ++j) { const f32x4 v = xr[64 * j]; s += (v[0] * v[0] + v[1] * v[1]) + (v[2] * v[2] + v[3] * v[3]); xb[64 * j] = (unsigned long long)cvt_pk_bf16(v[0], v[1]) | ((unsigned long long)cvt_pk_bf16(v[2], v[3]) << 32); }
          s = wave_sum(s); if (lane == 0) ctl[SSQ_MEM_OFF + r] = s; } }
}

typedef float f32x16 __attribute__((ext_vector_type(16)));
typedef short s16x4 __attribute__((ext_vector_type(4)));
typedef short v4i16_t __attribute__((ext_vector_type(4)));
using pg8::bf16x8;
__device__ __forceinline__ int crow(int r, int hi) { return (r & 3) + 8 * (r >> 2) + 4 * hi; }
__device__ __forceinline__ s16x4 vtr(const LAS char* p) { return __builtin_bit_cast(s16x4, __builtin_amdgcn_ds_read_tr16_b64_v4i16((LAS v4i16_t*)p)); }
#define MFMA32(a, b, c) __builtin_amdgcn_mfma_f32_32x32x16_bf16(a, b, c, 0, 0, 0)
#define VFRAG(lo, hi) (bf16x8){lo[0], lo[1], lo[2], lo[3], hi[0], hi[1], hi[2], hi[3]}
__device__ __forceinline__ unsigned short f2bf(float f) { return (unsigned short)(cvt_pk_bf16(f, 0.f) & 0xffffu); }

__device__ __forceinline__ void memk_norm_item(bf16_t* KVM, const float* kg, int r, int lane) {
    unsigned* p = (unsigned*)(KVM + (size_t)(r >> 2) * 1024 + (r & 3) * 128) + lane; const unsigned w = *p; const float v0 = __uint_as_float(w << 16), v1 = __uint_as_float(w & 0xffff0000u);
    const float ss = wave_sum(v0 * v0 + v1 * v1); const float rs = rsqrtf(ss * (1.f / 128.f) + 1e-6f); *p = cvt_pk_bf16(v0 * rs * kg[2 * lane], v1 * rs * kg[2 * lane + 1]);
}

__device__ __forceinline__ void tokprep4(bf16_t* Q, bf16_t* KV, const float* qg, const float* kg, int t, int S, int lane) {
    u32x4 wq[4], wk[4]; const int br = 1 + ((lane >> 4) & 1);
#pragma unroll
    for (int i = 0; i < 4; ++i) { const int tt = t + i * S < NTOK ? t + i * S : NTOK - 1; wq[i] = *((const u32x4*)(Q + (size_t)tt * 512) + lane); wk[i] = *((const u32x4*)(KV + (size_t)tt * 768 + br * 256) + (lane & 15)); }
    f32x4 gq0 = *(const f32x4*)(qg + (lane & 7) * 8), gq1 = *(const f32x4*)(qg + (lane & 7) * 8 + 4), gk0 = *(const f32x4*)(kg + br * 64 + (lane & 7) * 8), gk1 = *(const f32x4*)(kg + br * 64 + (lane & 7) * 8 + 4);
#pragma unroll
    for (int i = 0; i < 4; ++i) { if (t + i * S >= NTOK) break; const int tt = t + i * S;
        { const u32x4 w = wq[i]; float v[8];
#pragma unroll
          for (int e = 0; e < 4; ++e) { v[2 * e] = __uint_as_float(w[e] << 16); v[2 * e + 1] = __uint_as_float(w[e] & 0xffff0000u); }
          float ss = 0.f;
#pragma unroll
          for (int e = 0; e < 8; ++e) ss += v[e] * v[e];
          ss += __shfl_xor(ss, 1); ss += __shfl_xor(ss, 2); ss += __shfl_xor(ss, 4);
          const float rs = rsqrtf(ss * (1.f / 64.f) + 1e-6f) * (0.125f * 1.4426950408889634f);
          u32x4 o; o[0] = cvt_pk_bf16(v[0] * rs * gq0[0], v[1] * rs * gq0[1]); o[1] = cvt_pk_bf16(v[2] * rs * gq0[2], v[3] * rs * gq0[3]); o[2] = cvt_pk_bf16(v[4] * rs * gq1[0], v[5] * rs * gq1[1]); o[3] = cvt_pk_bf16(v[6] * rs * gq1[2], v[7] * rs * gq1[3]);
          *((u32x4*)(Q + (size_t)tt * 512) + lane) = o; }
        { const u32x4 w = wk[i]; float v[8];
#pragma unroll
          for (int e = 0; e < 4; ++e) { v[2 * e] = __uint_as_float(w[e] << 16); v[2 * e + 1] = __uint_as_float(w[e] & 0xffff0000u); }
          float ss = 0.f;
#pragma unroll
          for (int e = 0; e < 8; ++e) ss += v[e] * v[e];
          ss += __shfl_xor(ss, 1); ss += __shfl_xor(ss, 2); ss += __shfl_xor(ss, 4);
          const float rs = rsqrtf(ss * (1.f / 64.f) + 1e-6f);
          u32x4 o; o[0] = cvt_pk_bf16(v[0] * rs * gk0[0], v[1] * rs * gk0[1]); o[1] = cvt_pk_bf16(v[2] * rs * gk0[2], v[3] * rs * gk0[3]); o[2] = cvt_pk_bf16(v[4] * rs * gk1[0], v[5] * rs * gk1[1]); o[3] = cvt_pk_bf16(v[6] * rs * gk1[2], v[7] * rs * gk1[3]);
          if (lane < 32) *((u32x4*)(KV + (size_t)tt * 768 + br * 256) + (lane & 15)) = o; } }
}
constexpr int SG_STAT = 0, SG_SSQ = 1024, SG_VN = 5120;
__device__ __forceinline__ void sgu_unit(LAS unsigned char* lds, int unit, const bf16_t* U, const bf16_t* Vb, const bf16_t* Wsg, const float* lng, const float* lnb, const float* sgb, bf16_t* MIX) {
    int tid_ = threadIdx.x; asm volatile("" : "+v"(tid_)); const int tid = tid_, lane = tid & 63, g = __builtin_amdgcn_readfirstlane(tid >> 6), r32 = lane & 31, hi = lane >> 5;
    const int tok0 = unit * 128;
    LAS float* STAT = (LAS float*)(lds + SG_STAT); LAS float* SSQA = (LAS float*)(lds + SG_SSQ);
    { const int tl = tid >> 2, part = tid & 3; const u32x4* p = (const u32x4*)(Vb + (size_t)(tok0 + tl) * 512 + part * 128); float s = 0.f, s2 = 0.f; u32x4 wl_[16];
#pragma unroll
      for (int i = 0; i < 16; ++i) wl_[i] = p[i];
#pragma unroll
      for (int i = 0; i < 16; ++i) { const u32x4 w = wl_[i];
#pragma unroll
          for (int e = 0; e < 4; ++e) { const float a = __uint_as_float(w[e] << 16), b = __uint_as_float(w[e] & 0xffff0000u); s += a + b; s2 += a * a + b * b; } }
      s += __shfl_xor(s, 1); s += __shfl_xor(s, 2); s2 += __shfl_xor(s2, 1); s2 += __shfl_xor(s2, 2);
      if (part == 0) { const float mu = s * (1.f / 512.f); const float var = fmaxf(s2 * (1.f / 512.f) - mu * mu, 0.f); STAT[tl * 2] = mu; STAT[tl * 2 + 1] = rsqrtf(var + 1e-6f); }
      }
    __syncthreads();
    LAS unsigned char* VN = lds + SG_VN + g * 16384;
    { const int piece = lane & 7; float gg[8], bb[8];
#pragma unroll
      for (int i = 0; i < 8; ++i) { gg[i] = lng[g * 64 + piece * 8 + i]; bb[i] = lnb[g * 64 + piece * 8 + i]; }
      u32x4 wv[16];
#pragma unroll
      for (int it = 0; it < 16; ++it) wv[it] = *(const u32x4*)(Vb + (size_t)(tok0 + it * 8 + (lane >> 3)) * 512 + g * 64 + piece * 8);
#pragma unroll
      for (int it = 0; it < 16; ++it) { const int row = it * 8 + (lane >> 3); const u32x4 w = wv[it]; const float mu = STAT[row * 2], rs = STAT[row * 2 + 1]; u32x4 o;
#pragma unroll
          for (int e = 0; e < 4; ++e) { const float a = (__uint_as_float(w[e] << 16) - mu) * rs * gg[2 * e] + bb[2 * e], b = (__uint_as_float(w[e] & 0xffff0000u) - mu) * rs * gg[2 * e + 1] + bb[2 * e + 1]; o[e] = cvt_pk_bf16(a, b); }
          *(LAS u32x4*)(VN + (piece >> 2) * 8192 + row * 64 + (piece & 3) * 16) = o; } }
    asm volatile("s_waitcnt lgkmcnt(0)" ::: "memory");
    f32x16 acc[2][4];
#pragma unroll
    for (int dh = 0; dh < 2; ++dh)
#pragma unroll
        for (int mt = 0; mt < 4; ++mt)
#pragma unroll
            for (int r = 0; r < 16; ++r) acc[dh][mt][r] = 0.f;
    const LAS char* vb = (const LAS char*)VN + ((lane >> 4) & 1) * 32 + (lane & 3) * 8 + (4 * hi + ((lane & 15) >> 2)) * 64;
    const bf16_t* wrow = Wsg + ((size_t)g * 128 + r32) * 128 + 8 * hi;
    bf16x8 wf[2][4];
#pragma unroll
    for (int mt = 0; mt < 4; ++mt) wf[0][mt] = *(const bf16x8*)(wrow + (size_t)mt * 32 * 128);
#pragma unroll
    for (int ks = 0; ks < 8; ++ks) { bf16x8 vf[2];
        if (ks < 7) {
#pragma unroll
            for (int mt = 0; mt < 4; ++mt) if (ks + 1 <= 2 * mt + 1) wf[(ks + 1) & 1][mt] = *(const bf16x8*)(wrow + (size_t)mt * 32 * 128 + (ks + 1) * 16); }
#pragma unroll
        for (int dh = 0; dh < 2; ++dh) { const s16x4 lo = vtr(vb + dh * 8192 + ks * 1024), hh = vtr(vb + dh * 8192 + ks * 1024 + 512); vf[dh] = VFRAG(lo, hh); }
#pragma unroll
        for (int mt = 0; mt < 4; ++mt) { if (ks <= 2 * mt + 1) { acc[0][mt] = MFMA32(vf[0], wf[ks & 1][mt], acc[0][mt]); acc[1][mt] = MFMA32(vf[1], wf[ks & 1][mt], acc[1][mt]); } } }
    u32x2 uu[2][8];
    { const bf16_t* up = U + (size_t)(tok0 + r32) * 512 + g * 64 + 4 * hi;
#pragma unroll
      for (int q = 0; q < 8; ++q) uu[0][q] = *(const u32x2*)(up + (q >> 2) * 32 + (q & 3) * 8); }
#pragma unroll
    for (int mt = 0; mt < 4; ++mt) { const int t = mt * 32 + r32; const float bias = sgb[g * 128 + t]; float ss = 0.f;
        if (mt < 3) { const bf16_t* upn = U + (size_t)(tok0 + t + 32) * 512 + g * 64 + 4 * hi;
#pragma unroll
            for (int q = 0; q < 8; ++q) uu[(mt + 1) & 1][q] = *(const u32x2*)(upn + (q >> 2) * 32 + (q & 3) * 8); }
#pragma unroll
        for (int dh = 0; dh < 2; ++dh)
#pragma unroll
            for (int a4 = 0; a4 < 4; ++a4) { const u32x2 w = uu[mt & 1][dh * 4 + a4];
                const float u0 = __uint_as_float(w.x << 16), u1 = __uint_as_float(w.x & 0xffff0000u), u2 = __uint_as_float(w.y << 16), u3 = __uint_as_float(w.y & 0xffff0000u);
                float x0 = u0 * (acc[dh][mt][4 * a4] + bias), x1 = u1 * (acc[dh][mt][4 * a4 + 1] + bias), x2 = u2 * (acc[dh][mt][4 * a4 + 2] + bias), x3 = u3 * (acc[dh][mt][4 * a4 + 3] + bias);
                acc[dh][mt][4 * a4] = x0; acc[dh][mt][4 * a4 + 1] = x1; acc[dh][mt][4 * a4 + 2] = x2; acc[dh][mt][4 * a4 + 3] = x3; ss += (x0 * x0 + x1 * x1) + (x2 * x2 + x3 * x3); }
        ss += __shfl_xor(ss, 32); if (hi == 0) SSQA[g * 128 + t] = ss; }
    __syncthreads();
#pragma unroll
    for (int mt = 0; mt < 4; ++mt) { const int t = mt * 32 + r32; float sa = 0.f;
#pragma unroll
        for (int w8 = 0; w8 < 8; ++w8) sa += SSQA[w8 * 128 + t];
        const float rs = rsqrtf(sa * (1.f / 512.f) + 1e-6f); bf16_t* op = MIX + (size_t)(tok0 + t) * 1024 + g * 64 + 4 * hi;
#pragma unroll
        for (int dh = 0; dh < 2; ++dh)
#pragma unroll
            for (int a4 = 0; a4 < 4; ++a4) { u32x2 w; w.x = cvt_pk_bf16(acc[dh][mt][4 * a4] * rs, acc[dh][mt][4 * a4 + 1] * rs); w.y = cvt_pk_bf16(acc[dh][mt][4 * a4 + 2] * rs, acc[dh][mt][4 * a4 + 3] * rs); *(u32x2*)(op + dh * 32 + a4 * 8) = w; } }
    __syncthreads();
}

constexpr int A_KB = 0, A_VB = 32768, A_IMPH = 65536, A_LINV = 132096, A_MASK = 133120, A_SSQ = 133632  ;
__device__ __forceinline__ void attn_cmp(LAS unsigned char* lds, const bf16_t* Kb, const bf16_t* Vb, int ntc, const bf16x8 (&qr)[4], f32x16 (&oT)[2], float& lsum,
                                         int kmin, int kmax, int kvh, int wave, int lane, int r32, int hi) {
    const int pitch = 64, hstride = 256 * 64;
    u32x4 sk0, sk1, sv0, sv1;
    const bf16_t* kthr = Kb + (size_t)lane * pitch + wave * 8; const bf16_t* vthr = Vb + (size_t)(16 * (wave & 3) + (lane >> 2)) * pitch + (wave >> 2) * 32 + (lane & 3) * 8;
    const int sdst = wave * 1024 + lane * 16;
#define A_LD(tile) do { const size_t to_ = (size_t)(tile) * 64 * pitch; sk0 = *(const u32x4*)(kthr + to_); sk1 = *(const u32x4*)(kthr + to_ + hstride); sv0 = *(const u32x4*)(vthr + to_); sv1 = *(const u32x4*)(vthr + to_ + hstride); } while (0)
#define A_ST(so) do { *(LAS u32x4*)(lds + A_KB + (so) + sdst) = sk0; *(LAS u32x4*)(lds + A_KB + (so) + 8192 + sdst) = sk1; *(LAS u32x4*)(lds + A_VB + (so) + sdst) = sv0; *(LAS u32x4*)(lds + A_VB + (so) + 8192 + sdst) = sv1; } while (0)
    const LAS char* kbase = (const LAS char*)(lds + A_KB) + kvh * 8192 + hi * 1024 + r32 * 16;
    const LAS char* vbase = (const LAS char*)(lds + A_VB) + kvh * 8192 + ((lane >> 4) & 1) * 32 + (lane & 3) * 8 + (4 * hi + ((lane & 15) >> 2)) * 64;
    LAS float* IMPH = (LAS float*)(lds + A_IMPH) + (wave * 32 + r32) * 65;
    float carry = 0.f;
    A_LD(0); A_ST(0); __syncthreads();
#pragma unroll 1
    for (int tile = 0; tile < ntc; ++tile) {
        const int so = (tile & 1) * 16384;
        if (tile + 1 < ntc) A_LD(tile + 1);
        bf16x8 kf[8];
#pragma unroll
        for (int d0 = 0; d0 < 4; ++d0) { kf[2 * d0] = *(const LAS bf16x8*)(kbase + so + d0 * 2048); kf[2 * d0 + 1] = *(const LAS bf16x8*)(kbase + so + d0 * 2048 + 512); }
        f32x16 p0, p1;
#pragma unroll
        for (int r = 0; r < 16; ++r) { p0[r] = 0.f; p1[r] = 0.f; }
#pragma unroll
        for (int d0 = 0; d0 < 4; ++d0) { p0 = MFMA32(kf[2 * d0], qr[d0], p0); p1 = MFMA32(kf[2 * d0 + 1], qr[d0], p1); }
        const int a = kmin - 64 * tile, bb = kmax - 64 * tile;
#pragma unroll
        for (int r = 0; r < 16; ++r) { p0[r] = __builtin_amdgcn_exp2f(p0[r]); p1[r] = __builtin_amdgcn_exp2f(p1[r]); }
        if (!__all(a <= 0 && bb >= 63)) { const unsigned span = (unsigned)(bb - a);
#pragma unroll
            for (int r = 0; r < 16; ++r) { const int rel = crow(r, hi); p0[r] = ((unsigned)(rel - a) <= span) ? p0[r] : 0.f; p1[r] = ((unsigned)(rel + 32 - a) <= span) ? p1[r] : 0.f; } }
        { float s = 0.f;
#pragma unroll
          for (int r = 0; r < 16; ++r) s += p0[r] + p1[r];
          lsum += s; }
        { float own[2][4], rcv[2][4];
#pragma unroll
          for (int a4 = 0; a4 < 4; ++a4) { const float h0 = 0.5f * p0[4 * a4 + 3], h1 = 0.5f * p1[4 * a4 + 3];
              own[0][a4] = (p0[4 * a4] + p0[4 * a4 + 1]) + (p0[4 * a4 + 2] + h0); own[1][a4] = (p1[4 * a4] + p1[4 * a4 + 1]) + (p1[4 * a4 + 2] + h1);
              rcv[0][a4] = __shfl_xor(h0, 32); rcv[1][a4] = __shfl_xor(h1, 32); }
#pragma unroll
          for (int h2 = 0; h2 < 2; ++h2)
#pragma unroll
              for (int a4 = 0; a4 < 4; ++a4) { const float fromprev = a4 > 0 ? rcv[h2][a4 - 1] : (h2 ? rcv[0][3] : carry);
                  IMPH[16 * tile + 8 * h2 + 2 * a4 + hi] = own[h2][a4] + (hi ? rcv[h2][a4] : fromprev); }
          carry = rcv[1][3]; }
        bf16x8 pa[4];
        { u32x4 w0, w1, w2, w3;
#pragma unroll
          for (int i = 0; i < 4; ++i) { w0[i] = cvt_pk_bf16(p0[2 * i], p0[2 * i + 1]); w1[i] = cvt_pk_bf16(p0[8 + 2 * i], p0[8 + 2 * i + 1]); w2[i] = cvt_pk_bf16(p1[2 * i], p1[2 * i + 1]); w3[i] = cvt_pk_bf16(p1[8 + 2 * i], p1[8 + 2 * i + 1]); }
          pa[0] = __builtin_bit_cast(bf16x8, w0); pa[1] = __builtin_bit_cast(bf16x8, w1); pa[2] = __builtin_bit_cast(bf16x8, w2); pa[3] = __builtin_bit_cast(bf16x8, w3); }
#pragma unroll
        for (int dh = 0; dh < 2; ++dh)
#pragma unroll
            for (int ks = 0; ks < 4; ++ks) { const s16x4 lo = vtr(vbase + so + dh * 4096 + ks * 1024), hh = vtr(vbase + so + dh * 4096 + ks * 1024 + 512); oT[dh] = MFMA32(VFRAG(lo, hh), pa[ks], oT[dh]); }
        if (tile + 1 < ntc) A_ST(so ^ 16384);
        __syncthreads();
    }
#undef A_LD
#undef A_ST
}

constexpr int A2_K = 0, A2_V = 49152, A2_SL = 16384;
#define SBAR() __builtin_amdgcn_sched_barrier(0)
#define PIN(x) asm volatile("" : "+v"(x))
#define WAIT_BAR(N) asm volatile("s_waitcnt vmcnt(" #N ") lgkmcnt(0)\n\ts_barrier" ::: "memory")
__device__ __forceinline__ void glds16(const void* g, unsigned lds_base) {
    unsigned sv; asm volatile("s_mov_b32 %0, m0\n\ts_mov_b32 m0, %2\n\ts_nop 0\n\tglobal_load_lds_dwordx4 %1, off\n\ts_mov_b32 m0, %0" : "=&s"(sv) : "v"(g), "s"(lds_base) : "memory"); }
__device__ __forceinline__ void range_mask(f32x16& c0, f32x16& c1, int a, int bb, int hi) {
    const unsigned span = (unsigned)(bb - a);
#pragma unroll
    for (int r = 0; r < 16; ++r) { const int rel = crow(r, hi); c0[r] = ((unsigned)(rel - a) <= span) ? c0[r] : -INFINITY; c1[r] = ((unsigned)(rel + 32 - a) <= span) ? c1[r] : -INFINITY; }
}
template <bool WIN>
__device__ __forceinline__ void attn_stream(LAS unsigned char* lds, const bf16_t* Kb, const bf16_t* Vb, int tlo, int NT, const bf16x8 (&qr)[4], f32x16 (&oT)[2], float& l_out,
                                            unsigned mlo, unsigned mhi, int tq, int kvh, int wave, int lane, int r32, int hi) {
    const unsigned lds0 = (unsigned)(uintptr_t)lds;
    const bf16_t* ksrc = Kb + (size_t)lane * 768 + wave * 8;
    const bf16_t* vsrc = Vb + (size_t)(16 * (wave & 3) + (lane >> 2)) * 768 + (wave >> 2) * 32 + (lane & 3) * 8;
    const unsigned kdst = lds0 + A2_K + wave * 1024, vdst = lds0 + A2_V + wave * 1024;
#define RFL(x) ((unsigned)__builtin_amdgcn_readfirstlane((int)(x)))
#define TCL(i) ((size_t)(tlo + ((i) < NT ? (i) : NT - 1)) * (64 * 768))
#define DMA_K(i, slot) do { const bf16_t* s_ = ksrc + TCL(i); glds16(s_, RFL(kdst + (slot))); glds16(s_ + 64, RFL(kdst + (slot) + 8192)); } while (0)
#define DMA_V(i, slot) do { const bf16_t* s_ = vsrc + TCL(i); glds16(s_, RFL(vdst + (slot))); glds16(s_ + 64, RFL(vdst + (slot) + 8192)); } while (0)
#define TMASK(idx_, a_, bb_, selm_) do { const int tt_ = tlo + (idx_); if (WIN) { a_ = tq - 511 - 64 * tt_; bb_ = tq - 64 * tt_; selm_ = ~0u; } \
        else { const unsigned s_ = tt_ < 32 ? (mlo >> tt_) & 1u : (mhi >> (tt_ - 32)) & 1u; a_ = -64 * tt_; bb_ = tq - 64 * tt_; selm_ = 0u - s_; } } while (0)
#define NEEDM(a_, bb_, selm_) (!__all((selm_) == 0u || ((a_) <= 0 && (bb_) >= 63)))
    const LAS char* kp0 = (const LAS char*)(lds + A2_K) + kvh * 8192 + hi * 1024 + r32 * 16;
    const LAS char* vp0 = (const LAS char*)(lds + A2_V) + kvh * 8192 + ((lane >> 4) & 1) * 32 + (lane & 3) * 8 + (4 * hi + ((lane & 15) >> 2)) * 64;
    asm volatile("s_waitcnt vmcnt(0)" ::: "memory");
    DMA_K(0, 0); DMA_V(0, 0); DMA_K(1, A2_SL); DMA_K(2, 2 * A2_SL);
    float l_reg = 0.f; f32x16 pA0, pA1, pB0, pB1; bf16x8 kf[8]; s16x4 vlo[8], vhi[8]; u32x4 pw0, pw1, pw2, pw3; unsigned selm_prev;
    const f32x16 zero16 = {0.f, 0.f, 0.f, 0.f, 0.f, 0.f, 0.f, 0.f, 0.f, 0.f, 0.f, 0.f, 0.f, 0.f, 0.f, 0.f};
    int sl_prev = 0, sl_cur = 0, sl_next = A2_SL;
#define ROT() do { sl_prev = sl_cur; sl_cur = sl_next; sl_next = (sl_next == 2 * A2_SL) ? 0 : sl_next + A2_SL; } while (0)
#define KLD(kp, d0) do { kf[2 * (d0)] = *(const LAS bf16x8*)((kp) + (d0) * 2048); kf[2 * (d0) + 1] = *(const LAS bf16x8*)((kp) + (d0) * 2048 + 512); } while (0)
    WAIT_BAR(6);
    KLD(kp0, 0); KLD(kp0, 1); KLD(kp0, 2); KLD(kp0, 3);
    pA0 = MFMA32(kf[0], qr[0], zero16); pA1 = MFMA32(kf[1], qr[0], zero16); pA0 = MFMA32(kf[2], qr[1], pA0); pA1 = MFMA32(kf[3], qr[1], pA1);
    pA0 = MFMA32(kf[4], qr[2], pA0); pA1 = MFMA32(kf[5], qr[2], pA1); pA0 = MFMA32(kf[6], qr[3], pA0); pA1 = MFMA32(kf[7], qr[3], pA1);
    { int a_, bb_; TMASK(0, a_, bb_, selm_prev); if (NEEDM(a_, bb_, selm_prev)) range_mask(pA0, pA1, a_, bb_, hi); }
#pragma unroll
    for (int r = 0; r < 16; ++r) { pA0[r] = __builtin_amdgcn_exp2f(pA0[r]); pA1[r] = __builtin_amdgcn_exp2f(pA1[r]); }
    WAIT_BAR(0);
    DMA_K(3, 0); DMA_V(1, A2_SL); ROT();
    KLD(kp0 + sl_cur, 0); KLD(kp0 + sl_cur, 1); KLD(kp0 + sl_cur, 2); KLD(kp0 + sl_cur, 3);
    WAIT_BAR(4);
#define PKW(P, i) cvt_pk_bf16(P[i], P[(i) + 1])
#define PAF(k) __builtin_bit_cast(bf16x8, pw##k)
#define VFR(i) VFRAG(vlo[i], vhi[i])
#define VRD(i) do { vlo[i] = vtr(vp_ + (((i) >> 2) * 4096 + ((i) & 3) * 1024)); vhi[i] = vtr(vp_ + (((i) >> 2) * 4096 + ((i) & 3) * 1024 + 512)); } while (0)
#define KRD(d0) do { KLD(kp0 + sl_next, d0); SBAR(); } while (0)
#define EX(v) __builtin_amdgcn_exp2f(v)
#define GAPA(MF, a0, a1, a2, a3, W0, W1, PW) do { MF; sacc += a0; sacc += a1; sacc += a2; sacc += a3; W0; W1; PIN(PW); PIN(sacc); SBAR(); } while (0)
#define GAPB(MF, X, i) do { MF; X[i] = EX(X[i]); X[(i) + 1] = EX(X[(i) + 1]); X[(i) + 2] = EX(X[(i) + 2]); X[(i) + 3] = EX(X[(i) + 3]); PIN(X); SBAR(); } while (0)
#define SELPW() do { if (!__all(selm_prev == ~0u)) { const u32x4 m_ = {selm_prev, selm_prev, selm_prev, selm_prev}; pw0 = pw0 & m_; pw1 = pw1 & m_; pw2 = pw2 & m_; pw3 = pw3 & m_; } } while (0)
#define STEP(C0, C1, P0, P1, idx) do { SBAR(); \
    const LAS char* vp_ = vp0 + sl_prev; \
    VRD(0); SBAR(); float sacc = P0[0] + P0[1]; \
                    GAPA(C0 = MFMA32(kf[0], qr[0], zero16), P0[2], P0[3], P0[4], P0[5],     pw0[0] = PKW(P0, 0),  pw0[1] = PKW(P0, 2),  pw0); \
    VRD(4); SBAR(); GAPA(C1 = MFMA32(kf[1], qr[0], zero16), P0[6], P0[7], P0[8], P0[9],     pw0[2] = PKW(P0, 4),  pw0[3] = PKW(P0, 6),  pw0); \
    VRD(1); SBAR(); GAPA(C0 = MFMA32(kf[2], qr[1], C0),     P0[10], P0[11], P0[12], P0[13], pw1[0] = PKW(P0, 8),  pw1[1] = PKW(P0, 10), pw1); \
    VRD(5); SBAR(); GAPA(C1 = MFMA32(kf[3], qr[1], C1),     P0[14], P0[15], P1[0], P1[1],   pw1[2] = PKW(P0, 12), pw1[3] = PKW(P0, 14), pw1); \
    VRD(2); SBAR(); GAPA(C0 = MFMA32(kf[4], qr[2], C0),     P1[2], P1[3], P1[4], P1[5],     pw2[0] = PKW(P1, 0),  pw2[1] = PKW(P1, 2),  pw2); \
    VRD(6); SBAR(); GAPA(C1 = MFMA32(kf[5], qr[2], C1),     P1[6], P1[7], P1[8], P1[9],     pw2[2] = PKW(P1, 4),  pw2[3] = PKW(P1, 6),  pw2); \
    VRD(3); SBAR(); GAPA(C0 = MFMA32(kf[6], qr[3], C0),     P1[10], P1[11], P1[12], P1[13], pw3[0] = PKW(P1, 8),  pw3[1] = PKW(P1, 10), pw3); \
    VRD(7); SBAR(); GAPA(C1 = MFMA32(kf[7], qr[3], C1),     P1[14], P1[15], 0.f, 0.f,       pw3[2] = PKW(P1, 12), pw3[3] = PKW(P1, 14), pw3); \
    l_reg += __uint_as_float(__float_as_uint(sacc) & selm_prev); SELPW(); \
    DMA_K((idx) + 3, sl_cur); DMA_V((idx) + 1, sl_next); \
    { int a_, bb_; unsigned selm_; TMASK(idx, a_, bb_, selm_); if (NEEDM(a_, bb_, selm_)) range_mask(C0, C1, a_, bb_, hi); selm_prev = selm_; } \
    SBAR(); \
    GAPB(oT[0] = MFMA32(VFR(0), PAF(0), oT[0]), C0, 0);            GAPB(oT[1] = MFMA32(VFR(4), PAF(0), oT[1]), C0, 4); \
    KRD(0); GAPB(oT[0] = MFMA32(VFR(1), PAF(1), oT[0]), C0, 8);    KRD(1); GAPB(oT[1] = MFMA32(VFR(5), PAF(1), oT[1]), C0, 12); \
    KRD(2); GAPB(oT[0] = MFMA32(VFR(2), PAF(2), oT[0]), C1, 0);    KRD(3); GAPB(oT[1] = MFMA32(VFR(6), PAF(2), oT[1]), C1, 4); \
    GAPB(oT[0] = MFMA32(VFR(3), PAF(3), oT[0]), C1, 8);            GAPB(oT[1] = MFMA32(VFR(7), PAF(3), oT[1]), C1, 12); \
    } while (0)
    int idx = 1;
#pragma unroll 1
    for (; idx + 1 < NT; idx += 2) {
        STEP(pB0, pB1, pA0, pA1, idx);     WAIT_BAR(4); ROT();
        STEP(pA0, pA1, pB0, pB1, idx + 1); WAIT_BAR(4); ROT();
    }
    if (idx < NT) { STEP(pB0, pB1, pA0, pA1, idx); WAIT_BAR(4); ROT(); pA0 = pB0; pA1 = pB1; }
    { float sacc = 0.f;
#pragma unroll
      for (int r = 0; r < 16; ++r) sacc += pA0[r] + pA1[r];
      l_reg += __uint_as_float(__float_as_uint(sacc) & selm_prev);
      pw0 = (u32x4){PKW(pA0, 0), PKW(pA0, 2), PKW(pA0, 4), PKW(pA0, 6)}; pw1 = (u32x4){PKW(pA0, 8), PKW(pA0, 10), PKW(pA0, 12), PKW(pA0, 14)};
      pw2 = (u32x4){PKW(pA1, 0), PKW(pA1, 2), PKW(pA1, 4), PKW(pA1, 6)}; pw3 = (u32x4){PKW(pA1, 8), PKW(pA1, 10), PKW(pA1, 12), PKW(pA1, 14)};
      SELPW();
      const LAS char* vp_ = vp0 + ((NT - 1) % 3) * A2_SL;
#pragma unroll
      for (int i = 0; i < 8; ++i) VRD(i);
      oT[0] = MFMA32(VFR(0), PAF(0), oT[0]); oT[1] = MFMA32(VFR(4), PAF(0), oT[1]); oT[0] = MFMA32(VFR(1), PAF(1), oT[0]); oT[1] = MFMA32(VFR(5), PAF(1), oT[1]);
      oT[0] = MFMA32(VFR(2), PAF(2), oT[0]); oT[1] = MFMA32(VFR(6), PAF(2), oT[1]); oT[0] = MFMA32(VFR(3), PAF(3), oT[0]); oT[1] = MFMA32(VFR(7), PAF(3), oT[1]); }
    WAIT_BAR(0);
    l_out = l_reg;
#undef RFL
#undef TCL
#undef DMA_K
#undef DMA_V
#undef TMASK
#undef NEEDM
#undef ROT
#undef KLD
#undef PKW
#undef PAF
#undef VFR
#undef VRD
#undef KRD
#undef EX
#undef GAPA
#undef GAPB
#undef SELPW
#undef STEP
}

template <int PARTS>
__device__ __forceinline__ void attn_unit(LAS unsigned char* lds, int b, int qt, const bf16_t* Q, const bf16_t* KV, const bf16_t* KC, const bf16_t* VC, const float* GL, bf16_t* MIX) {
    int tid_ = threadIdx.x; asm volatile("" : "+v"(tid_)); const int tid = tid_, lane = tid & 63, wave = __builtin_amdgcn_readfirstlane(tid >> 6), r32 = lane & 31, hi = lane >> 5, kvh = wave >> 2;
    const int t0 = qt * 32, tq = t0 + r32; const size_t tok = (size_t)b * T + tq;
    bf16x8 qr[4];
#pragma unroll
    for (int d0 = 0; d0 < 4; ++d0) qr[d0] = *(const bf16x8*)(Q + tok * 512 + wave * 64 + d0 * 16 + hi * 8);
    LAS float* IMPHA = (LAS float*)(lds + A_IMPH); LAS float* LINV = (LAS float*)(lds + A_LINV); LAS unsigned* MASKL = (LAS unsigned*)(lds + A_MASK); LAS float* SSQL = (LAS float*)(lds + A_SSQ);
    const float* glp = GL + tok * 24 + wave * 3;
    const float g0 = 1.f / (1.f + __expf(-glp[0])), g1 = 1.f / (1.f + __expf(-glp[1])), g2 = 1.f / (1.f + __expf(-glp[2]));
    f32x16 tot[2], oT[2];
    const int nvalid = tq >= 31 ? (tq - 31) / 16 + 1 : 0; const int ntc = (2 * qt + 1 + 63) >> 6;
    const int ckmin = nvalid > 0 ? 0 : (1 << 20), ckmax = nvalid > 0 ? nvalid - 1 : (1 << 20);
    const bf16_t* KCb = KC + (size_t)(b * 2) * 256 * 64; const bf16_t* VCb = VC + (size_t)(b * 2) * 256 * 64;
    float lc = 0.f;
#pragma unroll
    for (int r = 0; r < 16; ++r) { oT[0][r] = 0.f; oT[1][r] = 0.f; }
    if constexpr (PARTS & 1) attn_cmp(lds, KCb, VCb, ntc, qr, oT, lc, ckmin, ckmax, kvh, wave, lane, r32, hi);
    lc += __shfl_xor(lc, 32); const float inv_lc = lc > 0.f ? 1.f / lc : 0.f;
    if (hi == 0) LINV[wave * 32 + r32] = inv_lc;
    { const float c = g0 * inv_lc;
#pragma unroll
      for (int r = 0; r < 16; ++r) { tot[0][r] = oT[0][r] * c; tot[1][r] = oT[1][r] * c; oT[0][r] = 0.f; oT[1][r] = 0.f; } }
    __syncthreads();
    if constexpr (PARTS & 2) {
      unsigned key[8], srt[8];
#pragma unroll
      for (int i = 0; i < 8; ++i) { const int pair = wave * 8 + i, kvp = pair >> 5, qq = pair & 31, j = lane; const int tb = (t0 + qq) >> 6; float v = 0.f;
#pragma unroll
          for (int g = 0; g < 4; ++g) v += IMPHA[((kvp * 4 + g) * 32 + qq) * 65 + j] * LINV[(kvp * 4 + g) * 32 + qq];
          const bool forced = (j == 0) || (j == tb) || (j == tb - 1); const float val = forced ? 1e4f : (j <= tb ? v : -1e4f);
          unsigned k = __float_as_uint(val); k ^= (k & 0x80000000u) ? 0xffffffffu : 0x80000000u; key[i] = (k & ~63u) | (unsigned)(63 - j); srt[i] = key[i]; }
#define TK_STAGE(K_, J_) do { const bool keepmax_ = (((lane & (K_)) == 0) == ((lane & (J_)) == 0)); \
        _Pragma("unroll") for (int i = 0; i < 8; ++i) { const unsigned o_ = (J_) == 32 ? (unsigned)__shfl_xor((int)srt[i], 32) : (unsigned)__builtin_amdgcn_ds_swizzle((int)srt[i], 0x1f | ((J_) << 10)); \
            const unsigned mx_ = srt[i] > o_ ? srt[i] : o_, mn_ = srt[i] > o_ ? o_ : srt[i]; srt[i] = keepmax_ ? mx_ : mn_; } } while (0)
      TK_STAGE(2, 1);
      TK_STAGE(4, 2); TK_STAGE(4, 1);
      TK_STAGE(8, 4); TK_STAGE(8, 2); TK_STAGE(8, 1);
      TK_STAGE(16, 8); TK_STAGE(16, 4); TK_STAGE(16, 2); TK_STAGE(16, 1);
      TK_STAGE(32, 16); TK_STAGE(32, 8); TK_STAGE(32, 4); TK_STAGE(32, 2); TK_STAGE(32, 1);
      TK_STAGE(64, 32); TK_STAGE(64, 16); TK_STAGE(64, 8); TK_STAGE(64, 4); TK_STAGE(64, 2); TK_STAGE(64, 1);
#undef TK_STAGE
#pragma unroll
      for (int i = 0; i < 8; ++i) { const unsigned thr = (unsigned)__builtin_amdgcn_readlane((int)srt[i], 15);
          const unsigned long long m = __ballot(key[i] >= thr); if (lane == 0) { MASKL[(wave * 8 + i) * 2] = (unsigned)m; MASKL[(wave * 8 + i) * 2 + 1] = (unsigned)(m >> 32); } } }
    __syncthreads();
    const unsigned mlo = MASKL[(kvh * 32 + r32) * 2], mhi = MASKL[(kvh * 32 + r32) * 2 + 1];
    const int jmax = (t0 + 31) >> 6;
    const bf16_t* KVb = KV + (size_t)b * T * 768;
    unsigned totp[16];
#pragma unroll
    for (int i = 0; i < 8; ++i) { totp[i] = cvt_pk_bf16(tot[0][2 * i], tot[0][2 * i + 1]); totp[8 + i] = cvt_pk_bf16(tot[1][2 * i], tot[1][2 * i + 1]); }
    float ls = 0.f;
    if constexpr (PARTS & 4) attn_stream<false>(lds, KVb + 256, KVb + 384, 0, jmax + 1, qr, oT, ls, mlo, mhi, tq, kvh, wave, lane, r32, hi);
    ls += __shfl_xor(ls, 32);
    { const float c = ls > 0.f ? g1 / ls : 0.f;
#pragma unroll
      for (int i = 0; i < 8; ++i) { totp[i] = cvt_pk_bf16(__uint_as_float(totp[i] << 16) + oT[0][2 * i] * c, __uint_as_float(totp[i] & 0xffff0000u) + oT[0][2 * i + 1] * c);
                                    totp[8 + i] = cvt_pk_bf16(__uint_as_float(totp[8 + i] << 16) + oT[1][2 * i] * c, __uint_as_float(totp[8 + i] & 0xffff0000u) + oT[1][2 * i + 1] * c); }
#pragma unroll
      for (int r = 0; r < 16; ++r) { oT[0][r] = 0.f; oT[1][r] = 0.f; } }
    float lw = 0.f; const int jlo = t0 >= 511 ? (t0 - 511) >> 6 : 0;
    if constexpr (PARTS & 8) attn_stream<true>(lds, KVb + 512, KVb + 640, jlo, jmax - jlo + 1, qr, oT, lw, 0u, 0u, tq, kvh, wave, lane, r32, hi);
    lw += __shfl_xor(lw, 32);
    { const float c = lw > 0.f ? g2 / lw : 0.f;
#pragma unroll
      for (int i = 0; i < 8; ++i) { tot[0][2 * i] = __uint_as_float(totp[i] << 16) + oT[0][2 * i] * c; tot[0][2 * i + 1] = __uint_as_float(totp[i] & 0xffff0000u) + oT[0][2 * i + 1] * c;
                                    tot[1][2 * i] = __uint_as_float(totp[8 + i] << 16) + oT[1][2 * i] * c; tot[1][2 * i + 1] = __uint_as_float(totp[8 + i] & 0xffff0000u) + oT[1][2 * i + 1] * c; } }
    { float ss = 0.f;
#pragma unroll
      for (int r = 0; r < 16; ++r) ss += tot[0][r] * tot[0][r] + tot[1][r] * tot[1][r];
      ss += __shfl_xor(ss, 32); if (hi == 0) SSQL[wave * 32 + r32] = ss; }
    __syncthreads();
    { float sa = 0.f;
#pragma unroll
      for (int w8 = 0; w8 < 8; ++w8) sa += SSQL[w8 * 32 + r32];
      const float rs = rsqrtf(sa * (1.f / 512.f) + 1e-6f); bf16_t* op = MIX + tok * 1024 + 512 + wave * 64 + 4 * hi;
#pragma unroll
      for (int dh = 0; dh < 2; ++dh)
#pragma unroll
          for (int a4 = 0; a4 < 4; ++a4) { u32x2 w; w.x = cvt_pk_bf16(tot[dh][4 * a4] * rs, tot[dh][4 * a4 + 1] * rs); w.y = cvt_pk_bf16(tot[dh][4 * a4 + 2] * rs, tot[dh][4 * a4 + 3] * rs); *(u32x2*)(op + dh * 32 + a4 * 8) = w; } }
    __syncthreads();
}

__device__ __forceinline__ void memattn_unit(LAS unsigned char* lds, int b, int h, int qt, const bf16_t* QM, const bf16_t* KVM, const float* qg, bf16_t* OM) {
    int tid_ = threadIdx.x; asm volatile("" : "+v"(tid_)); const int tid = tid_, lane = tid & 63, wave = __builtin_amdgcn_readfirstlane(tid >> 6), r32 = lane & 31, hi = lane >> 5;
    const size_t tok = (size_t)b * T + qt * 256 + wave * 32 + r32;
    bf16x8 qr[8];
    { float v[64]; float ss = 0.f;
#pragma unroll
      for (int d0 = 0; d0 < 8; ++d0) { const u32x4 w = *(const u32x4*)(QM + tok * 512 + h * 128 + d0 * 16 + hi * 8);
#pragma unroll
          for (int i = 0; i < 4; ++i) { const float a = __uint_as_float(w[i] << 16), c = __uint_as_float(w[i] & 0xffff0000u); v[d0 * 8 + 2 * i] = a; v[d0 * 8 + 2 * i + 1] = c; ss += a * a + c * c; } }
      ss += __shfl_xor(ss, 32); const float rs = rsqrtf(ss * (1.f / 128.f) + 1e-6f) * (0.08838834764831845f * 1.4426950408889634f);
#pragma unroll
      for (int d0 = 0; d0 < 8; ++d0) { u32x4 w; const float* gp = qg + d0 * 16 + hi * 8;
#pragma unroll
          for (int i = 0; i < 4; ++i) w[i] = cvt_pk_bf16(v[d0 * 8 + 2 * i] * rs * gp[2 * i], v[d0 * 8 + 2 * i + 1] * rs * gp[2 * i + 1]);
          qr[d0] = __builtin_bit_cast(bf16x8, w); } }
    const bf16_t* Kg = KVM + (size_t)b * 256 * 1024 + h * 128; const bf16_t* Vg = Kg + 512;
    { u32x4 sk[8], sv[8];
#pragma unroll
      for (int tile = 0; tile < 4; ++tile)
#pragma unroll
          for (int i = 0; i < 2; ++i) { sk[tile * 2 + i] = *(const u32x4*)(Kg + (size_t)(tile * 64 + lane) * 1024 + (wave * 2 + i) * 8); const int p = i * 512 + tid;
              sv[tile * 2 + i] = *(const u32x4*)(Vg + (size_t)(tile * 64 + ((p & 255) >> 2)) * 1024 + (p >> 8) * 32 + (p & 3) * 8); }
#pragma unroll
      for (int tile = 0; tile < 4; ++tile)
#pragma unroll
          for (int i = 0; i < 2; ++i) { *(LAS u32x4*)(lds + tile * 16384 + (wave * 2 + i) * 1024 + lane * 16) = sk[tile * 2 + i]; *(LAS u32x4*)(lds + 65536 + tile * 16384 + (i * 512 + tid) * 16) = sv[tile * 2 + i]; } }
    const LAS char* kbase = (const LAS char*)lds + hi * 1024 + r32 * 16;
    const LAS char* vbase = (const LAS char*)lds + 65536 + ((lane >> 4) & 1) * 32 + (lane & 3) * 8 + (4 * hi + ((lane & 15) >> 2)) * 64;
    f32x16 oT[4]; float lsum = 0.f;
#pragma unroll
    for (int dq = 0; dq < 4; ++dq)
#pragma unroll
        for (int r = 0; r < 16; ++r) oT[dq][r] = 0.f;
    __syncthreads();
#pragma unroll 1
    for (int tile = 0; tile < 4; ++tile) { const int so = tile * 16384;
        f32x16 p0, p1;
#pragma unroll
        for (int r = 0; r < 16; ++r) { p0[r] = 0.f; p1[r] = 0.f; }
#pragma unroll
        for (int d0 = 0; d0 < 8; ++d0) { const bf16x8 k0 = *(const LAS bf16x8*)(kbase + so + d0 * 2048), k1 = *(const LAS bf16x8*)(kbase + so + d0 * 2048 + 512); p0 = MFMA32(k0, qr[d0], p0); p1 = MFMA32(k1, qr[d0], p1); }
        float s = 0.f;
#pragma unroll
        for (int r = 0; r < 16; ++r) { p0[r] = __builtin_amdgcn_exp2f(p0[r]); p1[r] = __builtin_amdgcn_exp2f(p1[r]); s += p0[r] + p1[r]; }
        lsum += s;
        bf16x8 pa[4];
        { u32x4 w0, w1, w2, w3;
#pragma unroll
          for (int i = 0; i < 4; ++i) { w0[i] = cvt_pk_bf16(p0[2 * i], p0[2 * i + 1]); w1[i] = cvt_pk_bf16(p0[8 + 2 * i], p0[8 + 2 * i + 1]); w2[i] = cvt_pk_bf16(p1[2 * i], p1[2 * i + 1]); w3[i] = cvt_pk_bf16(p1[8 + 2 * i], p1[8 + 2 * i + 1]); }
          pa[0] = __builtin_bit_cast(bf16x8, w0); pa[1] = __builtin_bit_cast(bf16x8, w1); pa[2] = __builtin_bit_cast(bf16x8, w2); pa[3] = __builtin_bit_cast(bf16x8, w3); }
#pragma unroll
        for (int dq = 0; dq < 4; ++dq)
#pragma unroll
            for (int ks = 0; ks < 4; ++ks) { const s16x4 lo = vtr(vbase + so + dq * 4096 + ks * 1024), hh = vtr(vbase + so + dq * 4096 + ks * 1024 + 512); oT[dq] = MFMA32(VFRAG(lo, hh), pa[ks], oT[dq]); }
    }
    __syncthreads();
    lsum += __shfl_xor(lsum, 32); const float il = 1.f / lsum; bf16_t* op = OM + tok * 512 + h * 128 + 4 * hi;
#pragma unroll
    for (int dq = 0; dq < 4; ++dq)
#pragma unroll
        for (int a4 = 0; a4 < 4; ++a4) { u32x2 w; w.x = cvt_pk_bf16(oT[dq][4 * a4] * il, oT[dq][4 * a4 + 1] * il); w.y = cvt_pk_bf16(oT[dq][4 * a4 + 2] * il, oT[dq][4 * a4 + 3] * il); *(u32x2*)(op + dq * 32 + a4 * 8) = w; }
}

#define XB_TMO      128
#define XB_XCNT(j)  (256  + 64 * (j))
#define XB_XSUB(j)  (1280 + 64 * (j))
#define XB_XGEN(j)  (2304 + 64 * (j))
#define XB_TOP      3328
#define XB_TOPGEN   3392
#define XCD_BAR_WORDS 3456
#define XB_SPIN_CAP (1u << 18)
__device__ __forceinline__ unsigned xb_ld(unsigned* p)              { return __hip_atomic_load(p, __ATOMIC_RELAXED, __HIP_MEMORY_SCOPE_AGENT); }
__device__ __forceinline__ unsigned xb_add(unsigned* p, unsigned v) { return __hip_atomic_fetch_add(p, v, __ATOMIC_RELAXED, __HIP_MEMORY_SCOPE_AGENT); }
__device__ __forceinline__ unsigned xb_xcc_id() { return (unsigned)__builtin_amdgcn_s_getreg((3 << 11) | 20) & 0xFu; }
#define XB_SPIN(cond, bar) do { unsigned _sp = 0; while (cond) { __builtin_amdgcn_s_sleep(1); \
    if ((++_sp & 255u) == 0u) { if (xb_ld(&(bar)[XB_TMO])) break; if (_sp > XB_SPIN_CAP) { atomicAdd(&(bar)[XB_TMO], 1u); break; } } } } while (0)
struct XcdBarrier { unsigned* bar; unsigned x; volatile LAS unsigned* st; };
__device__ __forceinline__ XcdBarrier xcd_barrier_post(unsigned* bar, volatile LAS unsigned* st) {
    XcdBarrier b; b.bar = bar; b.x = xb_xcc_id(); b.st = st;
    if (threadIdx.x == 0) (void)xb_add(&bar[XB_XCNT(b.x)], 1u);
    return b;
}
__device__ __forceinline__ void xcd_barrier_complete(unsigned* bar, unsigned x, unsigned& nloc, unsigned& nx) {
    const unsigned G = gridDim.x * gridDim.y * gridDim.z;
    unsigned sum, cnt, mine, sp = 0u;
    for (;;) {
        sum = 0u; cnt = 0u; mine = 0u;
#pragma unroll
        for (unsigned j = 0; j < 16; ++j) { const unsigned c = xb_ld(&bar[XB_XCNT(j)]); sum += c; cnt += (c > 0u) ? 1u : 0u; mine = (j == x) ? c : mine; }
        if (sum == G) break;
        __builtin_amdgcn_s_sleep(1);
        if ((++sp & 255u) == 0u) { if (xb_ld(&bar[XB_TMO])) break; if (sp > XB_SPIN_CAP) { atomicAdd(&bar[XB_TMO], 1u); break; } }
    }
    nloc = mine > 0u ? mine : 1u; nx = cnt > 0u ? cnt : 1u;
}
__device__ __forceinline__ void xcd_barrier(const XcdBarrier& b) {
    asm volatile("s_waitcnt vmcnt(0)" ::: "memory");
    __syncthreads();
    if (threadIdx.x == 0) {
        unsigned* bar = b.bar;
        __builtin_amdgcn_s_waitcnt(0);
        unsigned nloc = b.st[0], nx = b.st[1];
        if (nloc == 0u) { xcd_barrier_complete(bar, b.x, nloc, nx); b.st[0] = nloc; b.st[1] = nx; }
        const unsigned old = xb_add(&bar[XB_XSUB(b.x)], 1u);
        const unsigned gen = old / nloc;
        if (old + 1u == (gen + 1u) * nloc) {
            __builtin_amdgcn_fence(__ATOMIC_RELEASE, "agent");
            asm volatile("s_waitcnt vmcnt(0)" ::: "memory");
            const unsigned og = xb_add(&bar[XB_TOP], 1u);
            const unsigned tg = og / nx;
            if (og + 1u == (tg + 1u) * nx) xb_add(&bar[XB_TOPGEN], 1u);
            else XB_SPIN(xb_ld(&bar[XB_TOPGEN]) == tg, bar);
            __builtin_amdgcn_fence(__ATOMIC_ACQUIRE, "agent");
            xb_add(&bar[XB_XGEN(b.x)], 1u);
            asm volatile("s_waitcnt vmcnt(0)" ::: "memory");
        } else {
            XB_SPIN(xb_ld(&bar[XB_XGEN(b.x)]) == gen, bar);
            __builtin_amdgcn_fence(__ATOMIC_ACQUIRE, "agent");
            asm volatile("s_waitcnt vmcnt(0)" ::: "memory");
        }
    }
    __syncthreads();
}
constexpr size_t CTL_BAR_BYTE = 704 * 1024;
constexpr size_t CTL_FLAG_BYTE = 720 * 1024;
constexpr int LDS_ST_OFF = 147456 - 64;

struct EpiCmp {
    static constexpr bool PERM = false, AFTER_DRAIN = true;
    const float* b1p; const bf16_t* w2t; const float* b2; const float* kg0; bf16_t* OUT; float* PART; unsigned* flag; unsigned epoch; int half;
    __device__ __forceinline__ void fused(f32x4 (&acc)[2][2][4][2], const pg8::Unit&, int wr, int wc, int fr, int fq, LAS unsigned char* lds, int wid, int lane) const {
        unsigned ep = epoch; asm volatile("" : "+s"(ep));
        LAS float* PB = (LAS float*)lds;
        LAS unsigned char* HB = lds;
#pragma unroll
        for (int ai = 0; ai < 2; ++ai)
#pragma unroll
            for (int m = 0; m < 4; ++m) { const int row = ai * 128 + wr * 64 + m * 16 + fr;
#pragma unroll
                for (int n = 0; n < 2; ++n) *(LAS f32x4*)(PB + row * 132 + wc * 32 + n * 16 + 4 * fq) = acc[ai][1][m][n]; }
        __syncthreads();
        u32x2 hv[2][4][2];
#pragma unroll
        for (int ai = 0; ai < 2; ++ai)
#pragma unroll
            for (int m = 0; m < 4; ++m) { const int row = ai * 128 + wr * 64 + m * 16 + fr;
#pragma unroll
                for (int n = 0; n < 2; ++n) { const int col = wc * 32 + n * 16 + 4 * fq; f32x4 pb = {0.f, 0.f, 0.f, 0.f}; if (row < 255) pb = *(const LAS f32x4*)(PB + (row + 1) * 132 + col);
                    const f32x4 bb = *(const f32x4*)(b1p + half * 128 + col); const f32x4 v = acc[ai][0][m][n] + pb + bb;
                    hv[ai][m][n].x = cvt_pk_bf16(pg8::gelu_tanh(v[0]), pg8::gelu_tanh(v[1])); hv[ai][m][n].y = cvt_pk_bf16(pg8::gelu_tanh(v[2]), pg8::gelu_tanh(v[3])); } }
        __syncthreads();
#pragma unroll
        for (int ai = 0; ai < 2; ++ai)
#pragma unroll
            for (int m = 0; m < 4; ++m) { const int row = ai * 128 + wr * 64 + m * 16 + fr;
#pragma unroll
                for (int n = 0; n < 2; ++n) *(LAS u32x2*)(HB + row * 272 + (wc * 32 + n * 16 + 4 * fq) * 2) = hv[ai][m][n]; }
        __syncthreads();
        const int r32 = lane & 31, hi = lane >> 5, row = wid * 32 + r32;
        bf16x8 a0[8], a1[8], bf[8];
#pragma unroll
        for (int ks = 0; ks < 8; ++ks) { a0[ks] = *(const bf16x8*)(w2t + (size_t)r32 * 256 + half * 128 + ks * 16 + hi * 8); a1[ks] = *(const bf16x8*)(w2t + (size_t)(32 + r32) * 256 + half * 128 + ks * 16 + hi * 8);
            bf[ks] = *(const LAS bf16x8*)(HB + row * 272 + (ks * 16 + hi * 8) * 2); }
        f32x16 o2[2];
#pragma unroll
        for (int r = 0; r < 16; ++r) { o2[0][r] = 0.f; o2[1][r] = 0.f; }
#pragma unroll
        for (int ks = 0; ks < 8; ++ks) { o2[0] = MFMA32(a0[ks], bf[ks], o2[0]); o2[1] = MFMA32(a1[ks], bf[ks], o2[1]); }
        float* pp = PART + (size_t)row * 64 + 4 * hi;
        if (half == 1) {
#pragma unroll
            for (int h = 0; h < 2; ++h)
#pragma unroll
                for (int a4 = 0; a4 < 4; ++a4) *(f32x4*)(pp + 32 * h + 8 * a4) = (f32x4){o2[h][4 * a4], o2[h][4 * a4 + 1], o2[h][4 * a4 + 2], o2[h][4 * a4 + 3]};
            asm volatile("s_waitcnt vmcnt(0)" ::: "memory"); __syncthreads();
            if (threadIdx.x == 0) { __builtin_amdgcn_fence(__ATOMIC_RELEASE, "agent"); asm volatile("s_waitcnt vmcnt(0)" ::: "memory"); __hip_atomic_store(flag, ep, __ATOMIC_RELAXED, __HIP_MEMORY_SCOPE_AGENT); }
            return; }
        if (wid == 0) { unsigned sp = 0;
            while ((unsigned)__builtin_amdgcn_readfirstlane(__hip_atomic_load(flag, __ATOMIC_RELAXED, __HIP_MEMORY_SCOPE_AGENT)) < ep) { __builtin_amdgcn_s_sleep(2); if (++sp > (1u << 22)) break; }
            __builtin_amdgcn_fence(__ATOMIC_ACQUIRE, "agent"); asm volatile("s_waitcnt vmcnt(0)" ::: "memory"); }
        __syncthreads();
        float ss = 0.f;
#pragma unroll
        for (int h = 0; h < 2; ++h)
#pragma unroll
            for (int a4 = 0; a4 < 4; ++a4) { const f32x4 pv = *(const f32x4*)(pp + 32 * h + 8 * a4); const f32x4 bv = *(const f32x4*)(b2 + 32 * h + 8 * a4 + 4 * hi);
#pragma unroll
                for (int e = 0; e < 4; ++e) { const float v = o2[h][4 * a4 + e] + pv[e] + bv[e]; o2[h][4 * a4 + e] = v; ss += v * v; } }
        if (kg0) { ss += __shfl_xor(ss, 32); const float rs = rsqrtf(ss * (1.f / 64.f) + 1e-6f);
#pragma unroll
            for (int h = 0; h < 2; ++h)
#pragma unroll
                for (int a4 = 0; a4 < 4; ++a4) { const f32x4 gv = *(const f32x4*)(kg0 + 32 * h + 8 * a4 + 4 * hi);
#pragma unroll
                    for (int e = 0; e < 4; ++e) o2[h][4 * a4 + e] *= rs * gv[e]; } }
        const float keep = row == 255 ? 0.f : 1.f;
#pragma unroll
        for (int h = 0; h < 2; ++h)
#pragma unroll
            for (int a4 = 0; a4 < 4; ++a4) { u32x2 w; w.x = cvt_pk_bf16(o2[h][4 * a4] * keep, o2[h][4 * a4 + 1] * keep); w.y = cvt_pk_bf16(o2[h][4 * a4 + 2] * keep, o2[h][4 * a4 + 3] * keep); *(u32x2*)(OUT + (size_t)row * 64 + 32 * h + 8 * a4 + 4 * hi) = w; }
    }
};

template <bool PROBE>
__device__ __forceinline__ void do_phase(const int p, const int l, const Args& args, LAS unsigned char* lds, const int G, const int bx, const int NGW) {
    unsigned char* ws = args.ws; float* xout = args.out; asm volatile("" : "+s"(ws), "+s"(xout));
    int tidp = threadIdx.x; asm volatile("" : "+v"(tidp)); const int lane = tidp & 63, wave = __builtin_amdgcn_readfirstlane(tidp >> 6), gw = bx * 8 + wave; (void)lane; (void)gw; (void)NGW;
    float* ctl = (float*)(ws + WS_CTL); bf16_t* XB = (bf16_t*)(ws + WS_XB); float* ssqp = (float*)(ws + WS_SSQP);
    unsigned char* wl = ws + WS_W + l * W_LAYER;
    if (p == 0) {
        pg8::Gemm g = pg8::make_gemm(XB, (const bf16_t*)(wl + W_IN), 1024); pg8::StaticOrder S; S.init(NTOK, INP, G, bx);
        pg8::EpiInProj E{(bf16_t*)(ws + WS_U), (bf16_t*)(ws + WS_V), (bf16_t*)(ws + WS_Q), (bf16_t*)(ws + WS_KV), (float*)(ws + WS_GL), ssqp + (size_t)(l == 0 ? 0 : 3) * NTOK * 16};
        pg8::gemm_phase<pg8::EpiInProj, pg8::StaticOrder, true>(lds, g, S, E);
        if (l == 0 && !PROBE && G == 256 && bx >= 128)
            convert_layer(args, 0, CV_IN, CONV_ITEMS, (bx - 128) * 8 + wave, 128 * 8, (LAS float*)(lds + wave * 16384), lane);
    } else if (p == 1) {
      for (int vb = bx; vb < 256; vb += G) {
        if (PROBE && !((MK_P1_ROLES >> (vb < 32 ? 0 : vb < 48 ? 1 : vb < 176 ? 2 : 3)) & 1)) continue;
        if (vb < 32) { if constexpr (!PROBE || (MK_P1_ROLES & 1)) { const int kv = vb >> 4, pm = (vb >> 1) & 7, half = vb & 1;
            pg8::Gemm g; g.A = (const bf16_t*)(ws + WS_KV) + kv * 128; g.Bt = (const bf16_t*)(wl + W_C1 + (size_t)kv * 512 * 1024 * 2); g.K = 1024; g.lda = 16 * 768; g.kstepA = 768 * 2; g.a_s0 = 64 * 2; g.a_s1 = (size_t)T * 768 * 2;
            pg8::OneUnit S{1, {pm, half}};
            EpiCmp E{(const float*)(wl + W_B1P) + kv * 256, (const bf16_t*)(wl + W_C2) + (size_t)kv * 64 * 256, args.in[I_CB2] + l * 128 + kv * 64, kv == 0 ? args.in[I_KNG] + l * 192 : (const float*)nullptr,
                     (bf16_t*)(ws + (kv ? WS_VC : WS_KC)) + (size_t)pm * 256 * 64, (float*)(ws + WS_HID) + (size_t)(kv * 8 + pm) * 256 * 64, (unsigned*)(ws + WS_CTL + CTL_FLAG_BYTE) + (kv * 8 + pm) * 64, (unsigned)(l + 1), half};
            pg8::gemm_phase<EpiCmp, pg8::OneUnit, false>(lds, g, S, E); }
        } else if (vb < 48) { if constexpr (!PROBE || (MK_P1_ROLES & 2)) { const int i = vb - 32;
            pg8::Gemm g = pg8::make_gemm((const bf16_t*)(ws + WS_MEMB), (const bf16_t*)(wl + W_MKV), 1024); pg8::OneUnit S{1, {i >> 2, i & 3}};
            pg8::EpiBf16G<0> E{(bf16_t*)(ws + WS_KVM), 1024, nullptr, ctl + SSQ_MEM_OFF, 1.f / 1024.f, 1};
            pg8::gemm_phase<pg8::EpiBf16G<0>, pg8::OneUnit, true>(lds, g, S, E); }
        } else if (vb < 176) { if constexpr (!PROBE || (MK_P1_ROLES & 4))
            sgu_unit(lds, vb - 48, (const bf16_t*)(ws + WS_U), (const bf16_t*)(ws + WS_V), (const bf16_t*)(wl + W_SG), args.in[I_SGLNG] + l * 512, args.in[I_SGLNB] + l * 512, args.in[I_SGB] + l * 1024, (bf16_t*)(ws + WS_MIX));
        } else {
            for (int t = (vb - 176) * 8 + wave; t < NTOK; t += 4 * 640) tokprep4((bf16_t*)(ws + WS_Q), (bf16_t*)(ws + WS_KV), args.in[I_QNG] + l * 64, args.in[I_KNG] + l * 192, t, 640, lane);
            if (l == 0 && !PROBE) convert_layer(args, 1, 0, CONV_SPLIT, (vb - 176) * 8 + wave, 80 * 8, (LAS float*)(lds + wave * 16384), lane);
        } }
    } else if (p == 3) {
        for (int r = gw; r < 4096; r += NGW) memk_norm_item((bf16_t*)(ws + WS_KVM), args.in[I_MKG] + l * 128, r, lane);
        for (int i = bx; i < 256; i += G) { const int b = (i & 7) >> 1, idx = (i >> 3) * 2 + (i & 1);
            attn_unit<15>(lds, b, 127 - idx, (const bf16_t*)(ws + WS_Q), (const bf16_t*)(ws + WS_KV), (const bf16_t*)(ws + WS_KC), (const bf16_t*)(ws + WS_VC), (const float*)(ws + WS_GL), (bf16_t*)(ws + WS_MIX));
            attn_unit<15>(lds, b, idx, (const bf16_t*)(ws + WS_Q), (const bf16_t*)(ws + WS_KV), (const bf16_t*)(ws + WS_KC), (const bf16_t*)(ws + WS_VC), (const float*)(ws + WS_GL), (bf16_t*)(ws + WS_MIX)); }
    } else if (p == 6) {
        for (int i = bx; i < 256; i += G) { const int b = (i & 7) >> 1, rest = (i >> 3) * 2 + (i & 1);
            memattn_unit(lds, b, rest >> 4, rest & 15, (const bf16_t*)(ws + WS_QM), (const bf16_t*)(ws + WS_KVM), args.in[I_MQG] + l * 128, (bf16_t*)(ws + WS_OM)); }
    } else if (p == 4) {
        pg8::Gemm g = pg8::make_gemm((const bf16_t*)(ws + WS_MIX), (const bf16_t*)(wl + W_OUT), 1024); pg8::StaticOrder S; S.init(NTOK, 1024, G, bx);
        pg8::EpiResid E{nullptr, XB, ssqp + (size_t)(PROBE ? 1 : l * 3 + 1) * NTOK * 16};
        pg8::gemm_phase<pg8::EpiResid, pg8::StaticOrder, true>(lds, g, S, E);
    } else if (p == 5) {
        pg8::Gemm g = pg8::make_gemm(XB, (const bf16_t*)(wl + W_MQ), 1024); pg8::StaticOrder S; S.init(NTOK, 512, G, bx);
        pg8::EpiBf16G<0> E{(bf16_t*)(ws + WS_QM), 512, nullptr, ssqp + (size_t)(l * 3 + 1) * NTOK * 16, 1.f / 1024.f, 16};
        pg8::gemm_phase<pg8::EpiBf16G<0>, pg8::StaticOrder, true>(lds, g, S, E);
        if (l == 0 && !PROBE) { const int nidle = G > 128 ? G - 128 : 0;
            if (nidle == 0) convert_layer(args, 1, CONV_SPLIT, CONV_ITEMS, gw, NGW, (LAS float*)(lds + wave * 16384), lane);
            else if (bx >= 128) convert_layer(args, 1, CONV_SPLIT, CONV_ITEMS, (bx - 128) * 8 + wave, nidle * 8, (LAS float*)(lds + wave * 16384), lane); }
    } else if (p == 7) {
        pg8::Gemm g = pg8::make_gemm((const bf16_t*)(ws + WS_OM), (const bf16_t*)(wl + W_MO), 512); pg8::StaticOrder S; S.init(NTOK, 1024, G, bx);
        pg8::EpiResid E{nullptr, XB, ssqp + (size_t)(PROBE ? 1 : l * 3 + 2) * NTOK * 16};
        pg8::gemm_phase<pg8::EpiResid, pg8::StaticOrder, true>(lds, g, S, E);
    } else if (p == 8) {
        pg8::Gemm g = pg8::make_gemm(XB, (const bf16_t*)(wl + W_FF1), 1024); pg8::StaticOrder S; S.init(NTOK, FF, G, bx);
        pg8::EpiBf16G<2> E{(bf16_t*)(ws + WS_HB), FF, nullptr, ssqp + (size_t)(l * 3 + 2) * NTOK * 16, 1.f / 1024.f, 16};
        pg8::gemm_phase<pg8::EpiBf16G<2>, pg8::StaticOrder, true>(lds, g, S, E);
    } else if (p == 9) {
        pg8::Gemm g = pg8::make_gemm((const bf16_t*)(ws + WS_HB), (const bf16_t*)(wl + W_FF2), FF); pg8::StaticOrder S; S.init(NTOK, 1024, G, bx);
        pg8::EpiResid E{(l == 0 || PROBE) ? (float*)nullptr : xout, XB, ssqp + (size_t)(PROBE ? 1 : 3) * NTOK * 16};
        pg8::gemm_phase<pg8::EpiResid, pg8::StaticOrder, true>(lds, g, S, E);
    }
}

constexpr int LDS_BYTES = 147456;
__global__ void __launch_bounds__(512, 2) mega(Args args) {
    extern __shared__ __attribute__((aligned(16))) unsigned char lds_raw[];
    LAS unsigned char* lds = (LAS unsigned char*)lds_raw;
    const int G = gridDim.x, bx = blockIdx.x, NGW = G * 8;
    volatile LAS unsigned* bar_st = (volatile LAS unsigned*)(lds + LDS_ST_OFF);
    if (threadIdx.x < 2) bar_st[threadIdx.x] = 0u;
    __syncthreads();
    XcdBarrier xbar = xcd_barrier_post((unsigned*)(args.ws + WS_CTL + CTL_BAR_BYTE), bar_st);
    if (args.ph_hi < 0) cooperative_groups::this_grid().sync();
    if (args.ph_lo == 0) { const int tid0 = threadIdx.x, wave0 = __builtin_amdgcn_readfirstlane(tid0 >> 6); for (int e_ = 0; e_ < 1 + MK_PROBE_PRO; ++e_) prologue(args, lds, bx * 8 + wave0, NGW, wave0, tid0 & 63); }
    for (int ph = args.ph_lo > 1 ? args.ph_lo : 1; ph < args.ph_hi; ++ph) {
        if ((ph - 1) % 10 == 2) continue;
        if (ph > args.ph_lo) {
            xcd_barrier(xbar); }
        do_phase<false>((ph - 1) % 10, (ph - 1) / 10, args, lds, G, bx, NGW);
    }
#if MK_PROBE_N > 0
    if (args.ph_hi == 21) {
        xcd_barrier(xbar); do_phase<false>(0, 1, args, lds, G, bx, NGW);
        xcd_barrier(xbar); do_phase<false>(1, 1, args, lds, G, bx, NGW);
        for (int e_ = 0; e_ < MK_PROBE_N; ++e_) { xcd_barrier(xbar);
#if MK_PROBE_KIND == 100
            { int tidp = threadIdx.x; asm volatile("" : "+v"(tidp)); const int w_ = __builtin_amdgcn_readfirstlane(tidp >> 6); convert_layer(args, 1, 0, CONV_ITEMS, bx * 8 + w_, NGW, (LAS float*)(lds + w_ * 16384), tidp & 63); }
#elif MK_PROBE_KIND == 33
            for (int i = bx; i < 256; i += G) { const int b = (i & 7) >> 1, idx = (i >> 3) * 2 + (i & 1); unsigned char* ws = args.ws;
                attn_unit<MK_PROBE_PARTS>(lds, b, 127 - idx, (const bf16_t*)(ws + WS_Q), (const bf16_t*)(ws + WS_KV), (const bf16_t*)(ws + WS_KC), (const bf16_t*)(ws + WS_VC), (const float*)(ws + WS_GL), (bf16_t*)(ws + WS_MIX));
                attn_unit<MK_PROBE_PARTS>(lds, b, idx, (const bf16_t*)(ws + WS_Q), (const bf16_t*)(ws + WS_KV), (const bf16_t*)(ws + WS_KC), (const bf16_t*)(ws + WS_VC), (const float*)(ws + WS_GL), (bf16_t*)(ws + WS_MIX)); }
#elif MK_PROBE_KIND == 34
            { unsigned char* ws = args.ws; unsigned char* wl = ws + WS_W + W_LAYER;
              for (int vb = bx; vb < 256; vb += G) if (vb >= 48 && vb < 176) sgu_unit(lds, vb - 48, (const bf16_t*)(ws + WS_U), (const bf16_t*)(ws + WS_V), (const bf16_t*)(wl + W_SG), args.in[I_SGLNG] + 512, args.in[I_SGLNB] + 512, args.in[I_SGB] + 1024, (bf16_t*)(ws + WS_MIX)); }
#elif MK_PROBE_KIND == 35
            { unsigned char* ws = args.ws; int tidp = threadIdx.x; asm volatile("" : "+v"(tidp)); const int w_ = __builtin_amdgcn_readfirstlane(tidp >> 6);
              for (int vb = bx; vb < 256; vb += G) if (vb >= 176) for (int t = (vb - 176) * 8 + w_; t < NTOK; t += 4 * 640) tokprep4((bf16_t*)(ws + WS_Q), (bf16_t*)(ws + WS_KV), args.in[I_QNG] + 64, args.in[I_KNG] + 192, t, 640, tidp & 63); }
#elif MK_PROBE_KIND != 99
            do_phase<true>(MK_PROBE_KIND, 1, args, lds, G, bx, NGW);
#endif
        }
    }
#endif
}

}

#ifndef MK_FUSED
#define MK_FUSED 1
#endif
extern "C" void kernel_launch(void* const* d_in, const int* in_sizes, int n_in, void* d_out, int out_size, void* d_ws, size_t ws_size, hipStream_t stream) {
    using namespace mk;
    static int grid = 0;
    if (!grid) { (void)hipFuncSetAttribute((const void*)mega, hipFuncAttributeMaxDynamicSharedMemorySize, LDS_BYTES);
        int dev = 0, cus = 0, per_cu = 0; (void)hipGetDevice(&dev); (void)hipDeviceGetAttribute(&cus, hipDeviceAttributeMultiprocessorCount, dev);
        (void)hipOccupancyMaxActiveBlocksPerMultiprocessor(&per_cu, (const void*)mega, 512, LDS_BYTES);
        grid = cus * (per_cu < 1 ? 1 : per_cu); if (grid > 256) grid = 256; }
    Args a{}; for (int i = 0; i < 27; ++i) a.in[i] = (const float*)d_in[i]; a.out = (float*)d_out; a.ws = (unsigned char*)d_ws;
#if MK_FUSED
    (void)hipMemsetAsync((unsigned char*)d_ws + WS_CTL + CTL_BAR_BYTE, 0, 20 * 1024, stream);
    a.ph_lo = 0; a.ph_hi = 21; void* kargs[] = {&a};
    (void)hipLaunchCooperativeKernel((const void*)mega, dim3(grid), dim3(512), kargs, LDS_BYTES, stream);
#else
    for (int ph = 0; ph < 21; ++ph) { a.ph_lo = ph; a.ph_hi = ph + 1; hipLaunchKernelGGL(mega, dim3(grid), dim3(512), LDS_BYTES, stream, a); }
#endif
}
```

```cpp
#include <hip/hip_runtime.h>
#include <hip/hip_cooperative_groups.h>
#include <stdint.h>
#include <math.h>

namespace pg8 {
#define PG8_LAS __attribute__((address_space(3)))
typedef unsigned short bf16_t;
typedef short bf16x8 __attribute__((ext_vector_type(8)));
typedef float f32x4 __attribute__((ext_vector_type(4)));
typedef float f32x2 __attribute__((ext_vector_type(2)));
typedef unsigned u32x4 __attribute__((ext_vector_type(4)));
typedef unsigned u32x2 __attribute__((ext_vector_type(2)));
constexpr int BM = 256, BK = 64, HALF = 128, HTB = HALF * BK * 2, STAGE_BYTES = 8 * HTB, NXCD = 8, WGM = 2;

__host__ __device__ __forceinline__ int lds_byte(int r, int c) { const int st = (r >> 4) * 2 + (c >> 5), rr = r & 15, cc = c & 31, ob = rr * 64 + cc * 2; return st * 1024 + (ob ^ (((ob >> 9) & 1) << 5)); }
__host__ __device__ __forceinline__ void stage_rc(int b, int& R, int& C) { const int st = b / 1024, sb = b % 1024, swz = sb ^ (((sb >> 9) & 1) << 5); R = (st >> 1) * 16 + swz / 64; C = (st & 1) * 32 + (swz % 64) / 2; }
__host__ __device__ __forceinline__ int perm32(int rho) { const int n = rho >> 4, i = rho & 15; return 8 * (i >> 2) + 4 * n + (i & 3); }

struct Unit { int pm, pn; };
struct Gemm { const bf16_t* A; const bf16_t* Bt; int K; int lda; int kstepA; size_t a_s0, a_s1; };
__device__ __forceinline__ Gemm make_gemm(const bf16_t* A, const bf16_t* Bt, int K) { Gemm g; g.A = A; g.Bt = Bt; g.K = K; g.lda = K; g.kstepA = BK * 2; g.a_s0 = (size_t)BM * K * 2; g.a_s1 = 2 * g.a_s0; return g; }

struct StaticOrder {
    int nM, nN, nwg, G, c;
    __device__ void init(int M, int N, int G_, int c_) { nM = M / BM; nN = N / BM; nwg = nM * nN; G = G_; c = c_; }
    __device__ bool next(int i, Unit& u) const {
        const long L = (long)i * G + c; if (L >= nwg) return false;
        int wgid = (int)L; { const int q = nwg / NXCD, r = nwg % NXCD, xcd = wgid % NXCD, off = wgid / NXCD; wgid = (xcd < r ? xcd * (q + 1) : r * (q + 1) + (xcd - r) * q) + off; }
        const int nig = WGM * nN, gid = wgid / nig, fm = gid * WGM, gsz = (nM - fm) < WGM ? (nM - fm) : WGM;
        u.pm = fm + ((wgid % nig) % gsz); u.pn = (wgid % nig) / gsz; return true;
    }
};
struct OneUnit { int has; Unit u; __device__ bool next(int i, Unit& o) const { if (i > 0 || !has) return false; o = u; return true; } };

__device__ __forceinline__ unsigned cvt_pk_bf16(float lo, float hi) { unsigned r; asm volatile("v_cvt_pk_bf16_f32 %0, %1, %2" : "=v"(r) : "v"(lo), "v"(hi)); return r; }
__device__ __forceinline__ float gelu_tanh(float x) { const float u = 0.7978845608028654f * (x + 0.044715f * x * x * x); const float e = __builtin_amdgcn_exp2f(-2.885390081777927f * u); return x * __builtin_amdgcn_rcpf(1.f + e); }

__device__ __forceinline__ float ssq16(const float* p) { const f32x4 a = ((const f32x4*)p)[0], b = ((const f32x4*)p)[1], c = ((const f32x4*)p)[2], d = ((const f32x4*)p)[3];
    return (((a[0] + a[1]) + (a[2] + a[3])) + ((b[0] + b[1]) + (b[2] + b[3]))) + (((c[0] + c[1]) + (c[2] + c[3])) + ((d[0] + d[1]) + (d[2] + d[3]))); }
template <int ACT  > struct EpiBf16G {
    static constexpr bool PERM = true, AFTER_DRAIN = false;
    bf16_t* O; int ldc; const float* bias; const float* ssq; float inv_n; int nparts;
    __device__ __forceinline__ void operator()(const f32x4 (&acc)[2][2][4][2], const Unit& u, int wr, int wc, int fr, int fq) const {
        const int row0 = u.pm * BM + wr * 64 + fr, col0 = u.pn * BM + wc * 32 + 8 * fq;
        f32x4 bv[2][2];
#pragma unroll
        for (int bj = 0; bj < 2; ++bj)
#pragma unroll
            for (int n = 0; n < 2; ++n) bv[bj][n] = bias ? *(const f32x4*)(bias + col0 + bj * HALF + 4 * n) : (f32x4){0.f, 0.f, 0.f, 0.f};
        float rsv[2] = {1.f, 1.f};
        if (ssq) {
#pragma unroll
            for (int ai = 0; ai < 2; ++ai) { const int rr = row0 + ai * HALF + fq * 16; rsv[ai] = rsqrtf((nparts == 16 ? ssq16(ssq + (size_t)rr * 16) : ssq[rr]) * inv_n + 1e-6f); } }
#pragma unroll
        for (int ai = 0; ai < 2; ++ai)
#pragma unroll
            for (int m = 0; m < 4; ++m) { const int row = row0 + ai * HALF + m * 16; const float rs = __shfl(rsv[ai], fr + 16 * m); bf16_t* rowp = O + (size_t)row * ldc + col0;
#pragma unroll
                for (int bj = 0; bj < 2; ++bj) { f32x4 v0 = (acc[ai][bj][m][0] + bv[bj][0]) * rs, v1 = (acc[ai][bj][m][1] + bv[bj][1]) * rs;
                    if (ACT == 1) {
#pragma unroll
                        for (int e = 0; e < 4; ++e) { v0[e] = gelu_tanh(v0[e]); v1[e] = gelu_tanh(v1[e]); } }
                    if (ACT == 2) {
#pragma unroll
                        for (int e = 0; e < 4; ++e) { float a = fmaxf(v0[e], 0.f), b = fmaxf(v1[e], 0.f); v0[e] = a * a; v1[e] = b * b; } }
                    u32x4 w; w.x = cvt_pk_bf16(v0[0], v0[1]); w.y = cvt_pk_bf16(v0[2], v0[3]); w.z = cvt_pk_bf16(v1[0], v1[1]); w.w = cvt_pk_bf16(v1[2], v1[3]);
                    *(u32x4*)(rowp + bj * HALF) = w; } }
    }
};
struct EpiInProj {
    static constexpr bool PERM = true, AFTER_DRAIN = false;
    bf16_t *U, *V, *Q, *KV; float* GL; const float* ssq;
    __device__ __forceinline__ void operator()(const f32x4 (&acc)[2][2][4][2], const Unit& u, int wr, int wc, int fr, int fq) const {
        const int row0 = u.pm * BM + wr * 64 + fr, cit0 = wc * 32 + 8 * fq; const int pn = u.pn;
        bf16_t* base; int ldc, cofs; bool act = false;
        if (pn < 2) { base = U; ldc = 512; cofs = pn * 256; act = true; } else if (pn < 4) { base = V; ldc = 512; cofs = (pn - 2) * 256; act = true; }
        else if (pn < 6) { base = Q; ldc = 512; cofs = (pn - 4) * 256; } else { base = KV; ldc = 768; cofs = (pn - 6) * 256; }
        float rsv[2];
#pragma unroll
        for (int ai = 0; ai < 2; ++ai) rsv[ai] = rsqrtf(ssq16(ssq + (size_t)(row0 + ai * HALF + fq * 16) * 16) * (1.f / 1024.f) + 1e-6f);
#pragma unroll
        for (int ai = 0; ai < 2; ++ai)
#pragma unroll
            for (int m = 0; m < 4; ++m) { const int row = row0 + ai * HALF + m * 16; const float rs = __shfl(rsv[ai], fr + 16 * m);
#pragma unroll
                for (int bj = 0; bj < 2; ++bj) { f32x4 v0 = acc[ai][bj][m][0] * rs, v1 = acc[ai][bj][m][1] * rs; const int cit = cit0 + bj * HALF;
                    if (pn == 9) { if (cit < 24) { *(f32x4*)(GL + (size_t)row * 24 + cit) = v0; *(f32x4*)(GL + (size_t)row * 24 + cit + 4) = v1; } }
                    else { if (act) {
#pragma unroll
                            for (int e = 0; e < 4; ++e) { v0[e] = gelu_tanh(v0[e]); v1[e] = gelu_tanh(v1[e]); } }
                        u32x4 w; w.x = cvt_pk_bf16(v0[0], v0[1]); w.y = cvt_pk_bf16(v0[2], v0[3]); w.z = cvt_pk_bf16(v1[0], v1[1]); w.w = cvt_pk_bf16(v1[2], v1[3]);
                        *(u32x4*)(base + (size_t)row * ldc + cofs + cit) = w; } } }
    }
};
struct EpiResid {
    static constexpr bool PERM = false, AFTER_DRAIN = false;
    float* XF; bf16_t* XB; float* ssq;
    __device__ __forceinline__ void operator()(const f32x4 (&acc)[2][2][4][2], const Unit& u, int wr, int wc, int fr, int fq) const {
        const int col0 = u.pn * BM + wc * 32 + 4 * fq;
#pragma unroll
        for (int ai = 0; ai < 2; ++ai)
#pragma unroll
            for (int m = 0; m < 4; ++m) { const int row = u.pm * BM + ai * HALF + wr * 64 + m * 16 + fr; float sq = 0.f;
#pragma unroll
                for (int bj = 0; bj < 2; ++bj)
#pragma unroll
                    for (int n = 0; n < 2; ++n) { const size_t off = (size_t)row * 1024 + col0 + bj * HALF + n * 16; const u32x2 xw = *(const u32x2*)(XB + off);
                        f32x4 xv; xv[0] = __uint_as_float(xw.x << 16); xv[1] = __uint_as_float(xw.x & 0xffff0000u); xv[2] = __uint_as_float(xw.y << 16); xv[3] = __uint_as_float(xw.y & 0xffff0000u);
                        xv = xv + acc[ai][bj][m][n];
                        if (XF) *(f32x4*)(XF + off) = xv;
                        else { sq += (xv[0] * xv[0] + xv[1] * xv[1]) + (xv[2] * xv[2] + xv[3] * xv[3]); u32x2 w; w.x = cvt_pk_bf16(xv[0], xv[1]); w.y = cvt_pk_bf16(xv[2], xv[3]); *(u32x2*)(XB + off) = w; } }
                if (!XF) { sq += __shfl_xor(sq, 16); sq += __shfl_xor(sq, 32); if (fq == 0) ssq[(size_t)row * 16 + u.pn * 4 + wc] = sq; } }
    }
};

template <class Epi, class Sched, bool ALIGN_EPI>
__device__ __forceinline__ void gemm_phase(PG8_LAS unsigned char* lds, const Gemm g, const Sched& S, const Epi& E) {
    int tid_ = threadIdx.x; asm volatile("" : "+v"(tid_));
    const int tid = tid_, wid = __builtin_amdgcn_readfirstlane(tid >> 6), lane = tid & 63, wr = wid >> 2, wc = wid & 3, fr = lane & 15, fq = lane >> 4;
    const int K = g.K, nt = K / BK;
    unsigned voffA[2], voffB[2];
#pragma unroll
    for (int i = 0; i < 2; ++i) { int R, C; stage_rc(tid * 16 + i * 8192, R, C); const int Rb = Epi::PERM ? ((R & ~31) + perm32(R & 31)) : R;
        voffA[i] = (unsigned)(R * g.lda + C) * 2u; voffB[i] = (unsigned)(Rb * K + C) * 2u; }
    const size_t kstepA = (size_t)g.kstepA, kstepB = (size_t)(BK * 2);
    const size_t hstepA = (size_t)HALF * g.lda * 2, hstepB = (size_t)HALF * K * 2, tstepB = 2 * hstepB;
    const unsigned ldsw = (unsigned)wid * 1024u;
    const int aoff = lds_byte(wr * 64 + fr, fq * 8), boff = lds_byte(wc * 32 + fr, fq * 8);
#define PG8_ABASE(pm) ((const char*)g.A + (size_t)((pm) >> 1) * g.a_s1 + (size_t)((pm) & 1) * g.a_s0)
#define PG8_SA(b, h) (((b) * 2 + (h)) * HTB)
#define PG8_SB(b, h) ((4 + (b) * 2 + (h)) * HTB)
#define PG8_STAGE(bufoff, gbase, voff) do { _Pragma("unroll") for (int _i = 0; _i < 2; ++_i) \
        __builtin_amdgcn_global_load_lds((const unsigned*)((const char*)(gbase) + (voff)[_i]), (PG8_LAS unsigned*)(lds + (bufoff) + ldsw + _i * 8192), 16, 0, 0); } while (0)
#define PG8_LDA(dst, b, h) do { _Pragma("unroll") for (int m = 0; m < 4; ++m) _Pragma("unroll") for (int k = 0; k < 2; ++k) dst[m][k] = *(const PG8_LAS bf16x8*)(lds + PG8_SA(b, h) + aoff + m * 2048 + k * 1024); } while (0)
#define PG8_LDB(dst, b, h) do { _Pragma("unroll") for (int n = 0; n < 2; ++n) _Pragma("unroll") for (int k = 0; k < 2; ++k) dst[n][k] = *(const PG8_LAS bf16x8*)(lds + PG8_SB(b, h) + boff + n * 2048 + k * 1024); } while (0)
#define PG8_MMA(ai, bj, At, Bt) do { __builtin_amdgcn_s_setprio(1); _Pragma("unroll") for (int m = 0; m < 4; ++m) _Pragma("unroll") for (int n = 0; n < 2; ++n) _Pragma("unroll") for (int k = 0; k < 2; ++k) \
        acc[ai][bj][m][n] = __builtin_amdgcn_mfma_f32_16x16x32_bf16(Bt[n][k], At[m][k], acc[ai][bj][m][n], 0, 0, 0); __builtin_amdgcn_s_setprio(0); } while (0)
#define PG8_WAIT_V(n) asm volatile("s_waitcnt vmcnt(" #n ")" ::: "memory")
#define PG8_WAIT_L(n) asm volatile("s_waitcnt lgkmcnt(" #n ")" ::: "memory")
#define PG8_BAR __builtin_amdgcn_s_barrier()
#define PG8_SCHED __builtin_amdgcn_sched_barrier(0)
    Unit cur, nxt; int ui = 0;
    if (!S.next(0, cur)) return;
    f32x4 acc[2][2][4][2];
#pragma unroll
    for (int a = 0; a < 2; ++a)
#pragma unroll
        for (int b = 0; b < 2; ++b)
#pragma unroll
            for (int m = 0; m < 4; ++m)
#pragma unroll
                for (int n = 0; n < 2; ++n) acc[a][b][m][n] = (f32x4){0.f, 0.f, 0.f, 0.f};
    bf16x8 At[4][2], B0[2][2], B1[2][2];
    const char* cA = PG8_ABASE(cur.pm); const char* cB = (const char*)g.Bt + (size_t)cur.pn * tstepB;
    PG8_STAGE(PG8_SB(0, 0), cB, voffB); PG8_STAGE(PG8_SB(0, 1), cB + hstepB, voffB); PG8_STAGE(PG8_SA(0, 0), cA, voffA); PG8_STAGE(PG8_SA(0, 1), cA + hstepA, voffA);
    if (wr == 1) PG8_BAR;
    PG8_WAIT_V(2); PG8_BAR;
    PG8_STAGE(PG8_SB(1, 0), cB + kstepB, voffB); PG8_STAGE(PG8_SA(1, 0), cA + kstepA, voffA); PG8_STAGE(PG8_SB(1, 1), cB + hstepB + kstepB, voffB);
    PG8_WAIT_V(6); PG8_BAR;
    for (;;) {
        const bool has_next = S.next(ui + 1, nxt);
        const char* nA = has_next ? PG8_ABASE(nxt.pm) : cA; const char* nB = has_next ? (const char*)g.Bt + (size_t)nxt.pn * tstepB : cB;
        for (int t = 0; t < nt; t += 2) {
            const bool last = (t == nt - 2);
            const char* a1 = cA + (size_t)(t + 1) * kstepA;
            const char* a2 = last ? nA : cA + (size_t)(t + 2) * kstepA; const char* b2 = last ? nB : cB + (size_t)(t + 2) * kstepB;
            const char* a3 = a2 + kstepA; const char* b3 = b2 + kstepB;
            PG8_LDB(B0, 0, 0); PG8_LDB(B1, 0, 1); PG8_SCHED; PG8_LDA(At, 0, 0); PG8_STAGE(PG8_SA(1, 1), a1 + hstepA, voffA);
            PG8_WAIT_V(8); PG8_WAIT_L(0); PG8_BAR; PG8_MMA(0, 0, At, B0); PG8_MMA(0, 1, At, B1); PG8_BAR; PG8_SCHED;
            PG8_LDA(At, 0, 1); PG8_STAGE(PG8_SB(0, 0), b2, voffB); PG8_STAGE(PG8_SB(0, 1), b2 + hstepB, voffB); PG8_STAGE(PG8_SA(0, 0), a2, voffA);
            PG8_WAIT_V(8); PG8_WAIT_L(0); PG8_BAR; PG8_MMA(1, 0, At, B0); PG8_MMA(1, 1, At, B1); PG8_BAR; PG8_SCHED;
            PG8_LDB(B0, 1, 0); PG8_LDB(B1, 1, 1); PG8_SCHED; PG8_LDA(At, 1, 0); PG8_STAGE(PG8_SA(0, 1), a2 + hstepA, voffA);
            PG8_WAIT_V(8); PG8_WAIT_L(0); PG8_BAR; PG8_MMA(0, 0, At, B0); PG8_MMA(0, 1, At, B1); PG8_BAR; PG8_SCHED;
            PG8_LDA(At, 1, 1); PG8_STAGE(PG8_SB(1, 0), b3, voffB); PG8_STAGE(PG8_SB(1, 1), b3 + hstepB, voffB); PG8_STAGE(PG8_SA(1, 0), a3, voffA);
            PG8_WAIT_V(8); PG8_WAIT_L(0); PG8_BAR; PG8_MMA(1, 0, At, B0); PG8_MMA(1, 1, At, B1); PG8_BAR; PG8_SCHED;
        }
        if constexpr (ALIGN_EPI) { if (wr == 0) PG8_BAR; }
        if constexpr (!Epi::AFTER_DRAIN) { E(acc, cur, wr, wc, fr, fq); }
        if (!has_next) break;
#pragma unroll
        for (int a = 0; a < 2; ++a)
#pragma unroll
            for (int b = 0; b < 2; ++b)
#pragma unroll
                for (int m = 0; m < 4; ++m)
#pragma unroll
                    for (int n = 0; n < 2; ++n) acc[a][b][m][n] = (f32x4){0.f, 0.f, 0.f, 0.f};
        cur = nxt; cA = nA; cB = nB; ++ui;
        if constexpr (ALIGN_EPI) { if (wr == 1) PG8_BAR; }
    }
    PG8_WAIT_V(0);
    if constexpr (!ALIGN_EPI) { if (wr == 0) PG8_BAR; }
    PG8_BAR;
    if constexpr (Epi::AFTER_DRAIN) { E.fused(acc, cur, wr, wc, fr, fq, lds, wid, lane); }
#undef PG8_ABASE
#undef PG8_SA
#undef PG8_SB
#undef PG8_STAGE
#undef PG8_LDA
#undef PG8_LDB
#undef PG8_MMA
#undef PG8_WAIT_V
#undef PG8_WAIT_L
#undef PG8_BAR
#undef PG8_SCHED
}
}

#ifndef MK_PROBE_N
#define MK_PROBE_N 0
#endif
#ifndef MK_P1_ROLES
#define MK_P1_ROLES 15
#endif
#ifndef MK_PROBE_PRO
#define MK_PROBE_PRO 0
#endif
#ifndef MK_PROBE_KIND
#define MK_PROBE_KIND 3
#endif
#ifndef MK_PROBE_PARTS
#define MK_PROBE_PARTS 15
#endif

namespace mk {
using pg8::bf16_t; using pg8::f32x4; using pg8::u32x4; using pg8::u32x2; using pg8::cvt_pk_bf16;
#define LAS __attribute__((address_space(3)))
constexpr int NB = 4, T = 4096, D = 1024, NTOK = NB * T, INC = 2328, INP = 2560, FF = 4096;
constexpr size_t MiB = 1u << 20;
constexpr size_t WS_CTL = 0;
constexpr size_t WS_W = 1 * MiB, W_LAYER = 30 * MiB;
constexpr size_t W_IN = 0, W_OUT = 5 * MiB, W_MQ = 7 * MiB, W_MKV = 8 * MiB, W_MO = 10 * MiB, W_FF1 = 11 * MiB, W_FF2 = 19 * MiB, W_C1 = 27 * MiB, W_C2 = 29 * MiB, W_SG = 29 * MiB + 128 * 1024, W_B1P = 29 * MiB + 512 * 1024;
constexpr size_t WS_XB = 61 * MiB;
constexpr size_t WS_OV = 93 * MiB;
constexpr size_t WS_U = WS_OV, WS_V = WS_OV + 16 * MiB, WS_Q = WS_OV + 32 * MiB, WS_KV = WS_OV + 48 * MiB, WS_MIX = WS_OV + 72 * MiB, WS_QM = WS_OV + 104 * MiB, WS_OM = WS_OV + 120 * MiB;
constexpr size_t WS_HB = WS_OV;
constexpr size_t WS_SM = 229 * MiB;
constexpr size_t WS_GL = WS_SM, WS_KC = WS_SM + 2 * MiB, WS_VC = WS_KC + 256 * 1024, WS_HID = WS_SM + 3 * MiB, WS_MASK = WS_SM + 5 * MiB, WS_MEMB = WS_SM + 6 * MiB, WS_KVM = WS_SM + 8 * MiB, WS_END = WS_SM + 10 * MiB;
constexpr size_t WS_SSQP = 240 * MiB;
static_assert(WS_END <= WS_SSQP && WS_SSQP + 6 * MiB <= 256 * MiB, "ws map");
constexpr int SSQ_MEM_OFF = 6 * NTOK;

struct Args { const float* in[27]; float* out; unsigned char* ws; int ph_lo, ph_hi; };
enum { I_X = 0, I_MEM, I_NMG, I_WIN, I_SGLNG, I_SGLNB, I_SGW, I_SGB, I_QNG, I_KNG, I_CPOS, I_CW1, I_CB1, I_CW2, I_CB2, I_MOG, I_WOUT, I_NMEMG, I_MKVG, I_WMQ, I_WMKV, I_MQG, I_MKG, I_WMO, I_NFG, I_WFF1, I_WFF2 };

__device__ __forceinline__ float bf2f(unsigned short b) { return __uint_as_float((unsigned)b << 16); }
__device__ __forceinline__ float wave_sum(float v) {
#pragma unroll
    for (int o = 1; o < 64; o <<= 1) v += __shfl_xor(v, o);
    return v; }

__device__ __forceinline__ void transpose_item(const float* W, int K, int N, int Npad, const float* gain, bf16_t* WT, LAS float* scr, int item, int lane, int ld = 0) {
    if (ld == 0) ld = N;
    const int nblk = Npad / 32, kb = item / nblk, nb = item % nblk, k0 = 64 * kb, n0 = 32 * nb;
    const int nn = n0 + (lane & 31); const int nnc = nn < N ? nn : N - 1; const float keep = nn < N ? 1.f : 0.f;
    const float* src = W + (size_t)(k0 + (lane >> 5)) * ld + nnc;
    float v[32];
#pragma unroll
    for (int i = 0; i < 32; ++i) v[i] = src[(size_t)(2 * i) * ld];
#pragma unroll
    for (int i = 0; i < 32; ++i) scr[(2 * i + (lane >> 5)) * 33 + (lane & 31)] = v[i] * keep;
    asm volatile("s_waitcnt lgkmcnt(0)" ::: "memory");
    const int c = lane & 7;
    f32x4 g0 = {1.f, 1.f, 1.f, 1.f}, g1 = {1.f, 1.f, 1.f, 1.f};
    if (gain) { g0 = *(const f32x4*)(gain + k0 + 8 * c); g1 = *(const f32x4*)(gain + k0 + 8 * c + 4); }
#pragma unroll
    for (int j = 0; j < 4; ++j) { const int n = (lane >> 3) + 8 * j; const LAS float* sp = scr + (8 * c) * 33 + n;
        u32x4 o; o.x = cvt_pk_bf16(sp[0 * 33] * g0[0], sp[1 * 33] * g0[1]); o.y = cvt_pk_bf16(sp[2 * 33] * g0[2], sp[3 * 33] * g0[3]); o.z = cvt_pk_bf16(sp[4 * 33] * g1[0], sp[5 * 33] * g1[1]); o.w = cvt_pk_bf16(sp[6 * 33] * g1[2], sp[7 * 33] * g1[3]);
        *(u32x4*)(WT + (size_t)(n0 + n) * K + k0 + 8 * c) = o; }
    asm volatile("s_waitcnt lgkmcnt(0)" ::: "memory");
}

constexpr int CV_IN = 16 * 80, CV_OUT = 16 * 32, CV_MQ = 16 * 16, CV_MKV = 16 * 32, CV_MO = 8 * 32, CV_FF1 = 16 * 128, CV_FF2 = 64 * 32, CV_C1 = 32 * 8, CV_C2 = 4 * 2;
constexpr int CV_TR = CV_IN + CV_OUT + CV_MQ + CV_MKV + CV_MO + CV_FF1 + CV_FF2 + 2 * CV_C1 + 2 * CV_C2, CV_B1 = 64, CV_SG = 1024, CONV_ITEMS = CV_TR + CV_B1 + CV_SG;
__device__ __forceinline__ void convert_layer(const Args& a, int l, int it_lo, int it_hi, int gwl, int ngwl, LAS float* scr, int lane_) {
    unsigned char* ws = a.ws; unsigned char* wl = ws + WS_W + l * W_LAYER;
#pragma unroll 1
    for (int it = it_lo + gwl; it < it_hi; it += ngwl) {
        int r = it; int lane = lane_; asm volatile("" : "+v"(lane));
        if (r < CV_IN) { transpose_item(a.in[I_WIN] + (size_t)l * 1024 * INC, 1024, INC, INP, a.in[I_NMG] + l * 1024, (bf16_t*)(wl + W_IN), scr, r, lane); continue; } r -= CV_IN;
        if (r < CV_OUT) { transpose_item(a.in[I_WOUT] + (size_t)l * 1024 * 1024, 1024, 1024, 1024, a.in[I_MOG] + l * 1024, (bf16_t*)(wl + W_OUT), scr, r, lane); continue; } r -= CV_OUT;
        if (r < CV_MQ) { transpose_item(a.in[I_WMQ] + (size_t)l * 1024 * 512, 1024, 512, 512, a.in[I_NMEMG] + l * 1024, (bf16_t*)(wl + W_MQ), scr, r, lane); continue; } r -= CV_MQ;
        if (r < CV_MKV) { transpose_item(a.in[I_WMKV] + (size_t)l * 1024 * 1024, 1024, 1024, 1024, a.in[I_MKVG] + l * 1024, (bf16_t*)(wl + W_MKV), scr, r, lane); continue; } r -= CV_MKV;
        if (r < CV_MO) { transpose_item(a.in[I_WMO] + (size_t)l * 512 * 1024, 512, 1024, 1024, (const float*)nullptr, (bf16_t*)(wl + W_MO), scr, r, lane); continue; } r -= CV_MO;
        if (r < CV_FF1) { transpose_item(a.in[I_WFF1] + (size_t)l * 1024 * 4096, 1024, 4096, 4096, a.in[I_NFG] + l * 1024, (bf16_t*)(wl + W_FF1), scr, r, lane); continue; } r -= CV_FF1;
        if (r < CV_FF2) { transpose_item(a.in[I_WFF2] + (size_t)l * 4096 * 1024, 4096, 1024, 1024, (const float*)nullptr, (bf16_t*)(wl + W_FF2), scr, r, lane); continue; } r -= CV_FF2;
        if (r < 2 * CV_C1) {
            const int kv = r / CV_C1, r2 = r % CV_C1, sub = r2 >> 6, half = sub >> 1, tb = sub & 1;
            transpose_item(a.in[I_CW1] + (size_t)(l * 2 + kv) * 2048 * 256 + (size_t)tb * 1024 * 256 + half * 128, 1024, 128, 128, (const float*)nullptr,
                           (bf16_t*)(wl + W_C1 + (size_t)kv * 512 * 1024 * 2) + (size_t)(half * 256 + tb * 128) * 1024, scr, r2 & 63, lane, 256); continue; } r -= 2 * CV_C1;
        if (r < 2 * CV_C2) { const int kv = r / CV_C2; transpose_item(a.in[I_CW2] + (size_t)(l * 2 + kv) * 256 * 64, 256, 64, 64, (const float*)nullptr, (bf16_t*)(wl + W_C2 + (size_t)kv * 64 * 256 * 2), scr, r % CV_C2, lane); continue; } r -= 2 * CV_C2;
        if (r < CV_B1) {
            const int lk = l * 2 + (r >> 5), j0 = (r & 31) * 8; const float* W1 = a.in[I_CW1] + (size_t)lk * 2048 * 256 + j0; const float* pos = a.in[I_CPOS] + (size_t)lk * 2048;
            float acc[8];
#pragma unroll
            for (int e = 0; e < 8; ++e) acc[e] = 0.f;
#pragma unroll 8
            for (int i = 0; i < 32; ++i) { const int k = i * 64 + lane; const float p = pos[k]; const f32x4 w0 = *(const f32x4*)(W1 + (size_t)k * 256), w1 = *(const f32x4*)(W1 + (size_t)k * 256 + 4);
#pragma unroll
                for (int e = 0; e < 4; ++e) { acc[e] += p * w0[e]; acc[4 + e] += p * w1[e]; } }
#pragma unroll
            for (int e = 0; e < 8; ++e) acc[e] = wave_sum(acc[e]);
            if (lane == 0) { float* dst = (float*)(wl + W_B1P) + (lk & 1) * 256 + j0;
#pragma unroll
                for (int e = 0; e < 8; ++e) dst[e] = acc[e] + a.in[I_CB1][lk * 256 + j0 + e]; }
            continue; } r -= CV_B1;
        {
            const int t = r & 127; const float* wr = a.in[I_SGW] + ((size_t)l * 1024 + r) * 128; unsigned* dst = (unsigned*)(wl + W_SG) + (size_t)r * 64 + lane; float v[2];
#pragma unroll
            for (int e = 0; e < 2; ++e) { const int p = lane * 2 + e, ks = p >> 4, hh = (p >> 3) & 1, j = p & 7, sidx = 16 * ks + 8 * (j >> 2) + 4 * hh + (j & 3); v[e] = wr[sidx <= t ? sidx : t]; v[e] = sidx <= t ? v[e] : 0.f; }
            *dst = cvt_pk_bf16(v[0], v[1]); }
    }
}
constexpr int CONV_SPLIT = 3000;
__device__ __forceinline__ void prologue(const Args& a, LAS unsigned char* lds, int gw, int NGW, int wave, int lane) {
    LAS float* scr = (LAS float*)(lds + wave * 16384);
    unsigned char* ws = a.ws; float* ctl = (float*)(ws + WS_CTL);
    convert_layer(a, 0, 0, NGW == 2048 ? CV_IN : CONV_ITEMS, gw, NGW, scr, lane);
    { const float* x = a.in[I_X]; bf16_t* XB = (bf16_t*)(ws + WS_XB);
      for (int r = gw; r < NTOK; r += NGW) { const f32x4* xr = (const f32x4*)(x + (size_t)r * 1024) + lane; unsigned long long* xb = (unsigned long long*)(XB + (size_t)r * 1024) + lane; float s = 0.f;
#pragma unroll
          for (int j = 0; j < 4; ++j) { const f32x4 v = xr[64 * j]; s += (v[0] * v[0] + v[1] * v[1]) + (v[2] * v[2] + v[3] * v[3]); xb[64 * j] = (unsigned long long)cvt_pk_bf16(v[0], v[1]) | ((unsigned long long)cvt_pk_bf16(v[2], v[3]) << 32); }
          s = wave_sum(s); if (lane < 16) ((float*)(ws + WS_SSQP))[(size_t)r * 16 + lane] = lane == 0 ? s : 0.f; } }
    { const float* mem = a.in[I_MEM]; bf16_t* MB = (bf16_t*)(ws + WS_MEMB);
      for (int r = gw; r < 1024; r += NGW) { const f32x4* xr = (const f32x4*)(mem + (size_t)r * 1024) + lane; unsigned long long* xb = (unsigned long long*)(MB + (size_t)r * 1024) + lane; float s = 0.f;
#pragma unroll
          for (int j = 0; j < 4; ++j) { const f32x4 v = xr[64 * j]; s += (v[0] * v[0] + v[1] * v[1]) + (v[2] * v[2] + v[3] * v[3]); xb[64 * j] = (unsigned long long)cvt_pk_bf16(v[0], v[1]) | ((unsigned long long)cvt_pk_bf16(v[2], v[3]) << 32); }
          s = wave_sum(s); if (lane == 0) ctl[SSQ_MEM_OFF + r] = s; } }
}

typedef float f32x16 __attribute__((ext_vector_type(16)));
typedef short s16x4 __attribute__((ext_vector_type(4)));
typedef short v4i16_t __attribute__((ext_vector_type(4)));
using pg8::bf16x8;
__device__ __forceinline__ int crow(int r, int hi) { return (r & 3) + 8 * (r >> 2) + 4 * hi; }
__device__ __forceinline__ s16x4 vtr(const LAS char* p) { return __builtin_bit_cast(s16x4, __builtin_amdgcn_ds_read_tr16_b64_v4i16((LAS v4i16_t*)p)); }
#define MFMA32(a, b, c) __builtin_amdgcn_mfma_f32_32x32x16_bf16(a, b, c, 0, 0, 0)
#define VFRAG(lo, hi) (bf16x8){lo[0], lo[1], lo[2], lo[3], hi[0], hi[1], hi[2], hi[3]}
__device__ __forceinline__ unsigned short f2bf(float f) { return (unsigned short)(cvt_pk_bf16(f, 0.f) & 0xffffu); }

__device__ __forceinline__ void memk_norm_item(bf16_t* KVM, const float* kg, int r, int lane) {
    unsigned* p = (unsigned*)(KVM + (size_t)(r >> 2) * 1024 + (r & 3) * 128) + lane; const unsigned w = *p; const float v0 = __uint_as_float(w << 16), v1 = __uint_as_float(w & 0xffff0000u);
    const float ss = wave_sum(v0 * v0 + v1 * v1); const float rs = rsqrtf(ss * (1.f / 128.f) + 1e-6f); *p = cvt_pk_bf16(v0 * rs * kg[2 * lane], v1 * rs * kg[2 * lane + 1]);
}

__device__ __forceinline__ void tokprep4(bf16_t* Q, bf16_t* KV, const float* qg, const float* kg, int t, int S, int lane) {
    u32x4 wq[4], wk[4]; const int br = 1 + ((lane >> 4) & 1);
#pragma unroll
    for (int i = 0; i < 4; ++i) { const int tt = t + i * S < NTOK ? t + i * S : NTOK - 1; wq[i] = *((const u32x4*)(Q + (size_t)tt * 512) + lane); wk[i] = *((const u32x4*)(KV + (size_t)tt * 768 + br * 256) + (lane & 15)); }
    f32x4 gq0 = *(const f32x4*)(qg + (lane & 7) * 8), gq1 = *(const f32x4*)(qg + (lane & 7) * 8 + 4), gk0 = *(const f32x4*)(kg + br * 64 + (lane & 7) * 8), gk1 = *(const f32x4*)(kg + br * 64 + (lane & 7) * 8 + 4);
#pragma unroll
    for (int i = 0; i < 4; ++i) { if (t + i * S >= NTOK) break; const int tt = t + i * S;
        { const u32x4 w = wq[i]; float v[8];
#pragma unroll
          for (int e = 0; e < 4; ++e) { v[2 * e] = __uint_as_float(w[e] << 16); v[2 * e + 1] = __uint_as_float(w[e] & 0xffff0000u); }
          float ss = 0.f;
#pragma unroll
          for (int e = 0; e < 8; ++e) ss += v[e] * v[e];
          ss += __shfl_xor(ss, 1); ss += __shfl_xor(ss, 2); ss += __shfl_xor(ss, 4);
          const float rs = rsqrtf(ss * (1.f / 64.f) + 1e-6f) * (0.125f * 1.4426950408889634f);
          u32x4 o; o[0] = cvt_pk_bf16(v[0] * rs * gq0[0], v[1] * rs * gq0[1]); o[1] = cvt_pk_bf16(v[2] * rs * gq0[2], v[3] * rs * gq0[3]); o[2] = cvt_pk_bf16(v[4] * rs * gq1[0], v[5] * rs * gq1[1]); o[3] = cvt_pk_bf16(v[6] * rs * gq1[2], v[7] * rs * gq1[3]);
          *((u32x4*)(Q + (size_t)tt * 512) + lane) = o; }
        { const u32x4 w = wk[i]; float v[8];
#pragma unroll
          for (int e = 0; e < 4; ++e) { v[2 * e] = __uint_as_float(w[e] << 16); v[2 * e + 1] = __uint_as_float(w[e] & 0xffff0000u); }
          float ss = 0.f;
#pragma unroll
          for (int e = 0; e < 8; ++e) ss += v[e] * v[e];
          ss += __shfl_xor(ss, 1); ss += __shfl_xor(ss, 2); ss += __shfl_xor(ss, 4);
          const float rs = rsqrtf(ss * (1.f / 64.f) + 1e-6f);
          u32x4 o; o[0] = cvt_pk_bf16(v[0] * rs * gk0[0], v[1] * rs * gk0[1]); o[1] = cvt_pk_bf16(v[2] * rs * gk0[2], v[3] * rs * gk0[3]); o[2] = cvt_pk_bf16(v[4] * rs * gk1[0], v[5] * rs * gk1[1]); o[3] = cvt_pk_bf16(v[6] * rs * gk1[2], v[7] * rs * gk1[3]);
          if (lane < 32) *((u32x4*)(KV + (size_t)tt * 768 + br * 256) + (lane & 15)) = o; } }
}
constexpr int SG_STAT = 0, SG_SSQ = 1024, SG_VN = 5120;
__device__ __forceinline__ void sgu_unit(LAS unsigned char* lds, int unit, const bf16_t* U, const bf16_t* Vb, const bf16_t* Wsg, const float* lng, const float* lnb, const float* sgb, bf16_t* MIX) {
    int tid_ = threadIdx.x; asm volatile("" : "+v"(tid_)); const int tid = tid_, lane = tid & 63, g = __builtin_amdgcn_readfirstlane(tid >> 6), r32 = lane & 31, hi = lane >> 5;
    const int tok0 = unit * 128;
    LAS float* STAT = (LAS float*)(lds + SG_STAT); LAS float* SSQA = (LAS float*)(lds + SG_SSQ);
    { const int tl = tid >> 2, part = tid & 3; const u32x4* p = (const u32x4*)(Vb + (size_t)(tok0 + tl) * 512 + part * 128); float s = 0.f, s2 = 0.f; u32x4 wl_[16];
#pragma unroll
      for (int i = 0; i < 16; ++i) wl_[i] = p[i];
#pragma unroll
      for (int i = 0; i < 16; ++i) { const u32x4 w = wl_[i];
#pragma unroll
          for (int e = 0; e < 4; ++e) { const float a = __uint_as_float(w[e] << 16), b = __uint_as_float(w[e] & 0xffff0000u); s += a + b; s2 += a * a + b * b; } }
      s += __shfl_xor(s, 1); s += __shfl_xor(s, 2); s2 += __shfl_xor(s2, 1); s2 += __shfl_xor(s2, 2);
      if (part == 0) { const float mu = s * (1.f / 512.f); const float var = fmaxf(s2 * (1.f / 512.f) - mu * mu, 0.f); STAT[tl * 2] = mu; STAT[tl * 2 + 1] = rsqrtf(var + 1e-6f); }
      }
    __syncthreads();
    LAS unsigned char* VN = lds + SG_VN + g * 16384;
    { const int piece = lane & 7; float gg[8], bb[8];
#pragma unroll
      for (int i = 0; i < 8; ++i) { gg[i] = lng[g * 64 + piece * 8 + i]; bb[i] = lnb[g * 64 + piece * 8 + i]; }
      u32x4 wv[16];
#pragma unroll
      for (int it = 0; it < 16; ++it) wv[it] = *(const u32x4*)(Vb + (size_t)(tok0 + it * 8 + (lane >> 3)) * 512 + g * 64 + piece * 8);
#pragma unroll
      for (int it = 0; it < 16; ++it) { const int row = it * 8 + (lane >> 3); const u32x4 w = wv[it]; const float mu = STAT[row * 2], rs = STAT[row * 2 + 1]; u32x4 o;
#pragma unroll
          for (int e = 0; e < 4; ++e) { const float a = (__uint_as_float(w[e] << 16) - mu) * rs * gg[2 * e] + bb[2 * e], b = (__uint_as_float(w[e] & 0xffff0000u) - mu) * rs * gg[2 * e + 1] + bb[2 * e + 1]; o[e] = cvt_pk_bf16(a, b); }
          *(LAS u32x4*)(VN + (piece >> 2) * 8192 + row * 64 + (piece & 3) * 16) = o; } }
    asm volatile("s_waitcnt lgkmcnt(0)" ::: "memory");
    f32x16 acc[2][4];
#pragma unroll
    for (int dh = 0; dh < 2; ++dh)
#pragma unroll
        for (int mt = 0; mt < 4; ++mt)
#pragma unroll
            for (int r = 0; r < 16; ++r) acc[dh][mt][r] = 0.f;
    const LAS char* vb = (const LAS char*)VN + ((lane >> 4) & 1) * 32 + (lane & 3) * 8 + (4 * hi + ((lane & 15) >> 2)) * 64;
    const bf16_t* wrow = Wsg + ((size_t)g * 128 + r32) * 128 + 8 * hi;
    bf16x8 wf[2][4];
#pragma unroll
    for (int mt = 0; mt < 4; ++mt) wf[0][mt] = *(const bf16x8*)(wrow + (size_t)mt * 32 * 128);
#pragma unroll
    for (int ks = 0; ks < 8; ++ks) { bf16x8 vf[2];
        if (ks < 7) {
#pragma unroll
            for (int mt = 0; mt < 4; ++mt) if (ks + 1 <= 2 * mt + 1) wf[(ks + 1) & 1][mt] = *(const bf16x8*)(wrow + (size_t)mt * 32 * 128 + (ks + 1) * 16); }
#pragma unroll
        for (int dh = 0; dh < 2; ++dh) { const s16x4 lo = vtr(vb + dh * 8192 + ks * 1024), hh = vtr(vb + dh * 8192 + ks * 1024 + 512); vf[dh] = VFRAG(lo, hh); }
#pragma unroll
        for (int mt = 0; mt < 4; ++mt) { if (ks <= 2 * mt + 1) { acc[0][mt] = MFMA32(vf[0], wf[ks & 1][mt], acc[0][mt]); acc[1][mt] = MFMA32(vf[1], wf[ks & 1][mt], acc[1][mt]); } } }
    u32x2 uu[2][8];
    { const bf16_t* up = U + (size_t)(tok0 + r32) * 512 + g * 64 + 4 * hi;
#pragma unroll
      for (int q = 0; q < 8; ++q) uu[0][q] = *(const u32x2*)(up + (q >> 2) * 32 + (q & 3) * 8); }
#pragma unroll
    for (int mt = 0; mt < 4; ++mt) { const int t = mt * 32 + r32; const float bias = sgb[g * 128 + t]; float ss = 0.f;
        if (mt < 3) { const bf16_t* upn = U + (size_t)(tok0 + t + 32) * 512 + g * 64 + 4 * hi;
#pragma unroll
            for (int q = 0; q < 8; ++q) uu[(mt + 1) & 1][q] = *(const u32x2*)(upn + (q >> 2) * 32 + (q & 3) * 8); }
#pragma unroll
        for (int dh = 0; dh < 2; ++dh)
#pragma unroll
            for (int a4 = 0; a4 < 4; ++a4) { const u32x2 w = uu[mt & 1][dh * 4 + a4];
                const float u0 = __uint_as_float(w.x << 16), u1 = __uint_as_float(w.x & 0xffff0000u), u2 = __uint_as_float(w.y << 16), u3 = __uint_as_float(w.y & 0xffff0000u);
                float x0 = u0 * (acc[dh][mt][4 * a4] + bias), x1 = u1 * (acc[dh][mt][4 * a4 + 1] + bias), x2 = u2 * (acc[dh][mt][4 * a4 + 2] + bias), x3 = u3 * (acc[dh][mt][4 * a4 + 3] + bias);
                acc[dh][mt][4 * a4] = x0; acc[dh][mt][4 * a4 + 1] = x1; acc[dh][mt][4 * a4 + 2] = x2; acc[dh][mt][4 * a4 + 3] = x3; ss += (x0 * x0 + x1 * x1) + (x2 * x2 + x3 * x3); }
        ss += __shfl_xor(ss, 32); if (hi == 0) SSQA[g * 128 + t] = ss; }
    __syncthreads();
#pragma unroll
    for (int mt = 0; mt < 4; ++mt) { const int t = mt * 32 + r32; float sa = 0.f;
#pragma unroll
        for (int w8 = 0; w8 < 8; ++w8) sa += SSQA[w8 * 128 + t];
        const float rs = rsqrtf(sa * (1.f / 512.f) + 1e-6f); bf16_t* op = MIX + (size_t)(tok0 + t) * 1024 + g * 64 + 4 * hi;
#pragma unroll
        for (int dh = 0; dh < 2; ++dh)
#pragma unroll
            for (int a4 = 0; a4 < 4; ++a4) { u32x2 w; w.x = cvt_pk_bf16(acc[dh][mt][4 * a4] * rs, acc[dh][mt][4 * a4 + 1] * rs); w.y = cvt_pk_bf16(acc[dh][mt][4 * a4 + 2] * rs, acc[dh][mt][4 * a4 + 3] * rs); *(u32x2*)(op + dh * 32 + a4 * 8) = w; } }
    __syncthreads();
}

constexpr int A_KB = 0, A_VB = 32768, A_IMPH = 65536, A_LINV = 132096, A_MASK = 133120, A_SSQ = 133632  ;
__device__ __forceinline__ void attn_cmp(LAS unsigned char* lds, const bf16_t* Kb, const bf16_t* Vb, int ntc, const bf16x8 (&qr)[4], f32x16 (&oT)[2], float& lsum,
                                         int kmin, int kmax, int kvh, int wave, int lane, int r32, int hi) {
    const int pitch = 64, hstride = 256 * 64;
    u32x4 sk0, sk1, sv0, sv1;
    const bf16_t* kthr = Kb + (size_t)lane * pitch + wave * 8; const bf16_t* vthr = Vb + (size_t)(16 * (wave & 3) + (lane >> 2)) * pitch + (wave >> 2) * 32 + (lane & 3) * 8;
    const int sdst = wave * 1024 + lane * 16;
#define A_LD(tile) do { const size_t to_ = (size_t)(tile) * 64 * pitch; sk0 = *(const u32x4*)(kthr + to_); sk1 = *(const u32x4*)(kthr + to_ + hstride); sv0 = *(const u32x4*)(vthr + to_); sv1 = *(const u32x4*)(vthr + to_ + hstride); } while (0)
#define A_ST(so) do { *(LAS u32x4*)(lds + A_KB + (so) + sdst) = sk0; *(LAS u32x4*)(lds + A_KB + (so) + 8192 + sdst) = sk1; *(LAS u32x4*)(lds + A_VB + (so) + sdst) = sv0; *(LAS u32x4*)(lds + A_VB + (so) + 8192 + sdst) = sv1; } while (0)
    const LAS char* kbase = (const LAS char*)(lds + A_KB) + kvh * 8192 + hi * 1024 + r32 * 16;
    const LAS char* vbase = (const LAS char*)(lds + A_VB) + kvh * 8192 + ((lane >> 4) & 1) * 32 + (lane & 3) * 8 + (4 * hi + ((lane & 15) >> 2)) * 64;
    LAS float* IMPH = (LAS float*)(lds + A_IMPH) + (wave * 32 + r32) * 65;
    float carry = 0.f;
    A_LD(0); A_ST(0); __syncthreads();
#pragma unroll 1
    for (int tile = 0; tile < ntc; ++tile) {
        const int so = (tile & 1) * 16384;
        if (tile + 1 < ntc) A_LD(tile + 1);
        bf16x8 kf[8];
#pragma unroll
        for (int d0 = 0; d0 < 4; ++d0) { kf[2 * d0] = *(const LAS bf16x8*)(kbase + so + d0 * 2048); kf[2 * d0 + 1] = *(const LAS bf16x8*)(kbase + so + d0 * 2048 + 512); }
        f32x16 p0, p1;
#pragma unroll
        for (int r = 0; r < 16; ++r) { p0[r] = 0.f; p1[r] = 0.f; }
#pragma unroll
        for (int d0 = 0; d0 < 4; ++d0) { p0 = MFMA32(kf[2 * d0], qr[d0], p0); p1 = MFMA32(kf[2 * d0 + 1], qr[d0], p1); }
        const int a = kmin - 64 * tile, bb = kmax - 64 * tile;
#pragma unroll
        for (int r = 0; r < 16; ++r) { p0[r] = __builtin_amdgcn_exp2f(p0[r]); p1[r] = __builtin_amdgcn_exp2f(p1[r]); }
        if (!__all(a <= 0 && bb >= 63)) { const unsigned span = (unsigned)(bb - a);
#pragma unroll
            for (int r = 0; r < 16; ++r) { const int rel = crow(r, hi); p0[r] = ((unsigned)(rel - a) <= span) ? p0[r] : 0.f; p1[r] = ((unsigned)(rel + 32 - a) <= span) ? p1[r] : 0.f; } }
        { float s = 0.f;
#pragma unroll
          for (int r = 0; r < 16; ++r) s += p0[r] + p1[r];
          lsum += s; }
        { float own[2][4], rcv[2][4];
#pragma unroll
          for (int a4 = 0; a4 < 4; ++a4) { const float h0 = 0.5f * p0[4 * a4 + 3], h1 = 0.5f * p1[4 * a4 + 3];
              own[0][a4] = (p0[4 * a4] + p0[4 * a4 + 1]) + (p0[4 * a4 + 2] + h0); own[1][a4] = (p1[4 * a4] + p1[4 * a4 + 1]) + (p1[4 * a4 + 2] + h1);
              rcv[0][a4] = __shfl_xor(h0, 32); rcv[1][a4] = __shfl_xor(h1, 32); }
#pragma unroll
          for (int h2 = 0; h2 < 2; ++h2)
#pragma unroll
              for (int a4 = 0; a4 < 4; ++a4) { const float fromprev = a4 > 0 ? rcv[h2][a4 - 1] : (h2 ? rcv[0][3] : carry);
                  IMPH[16 * tile + 8 * h2 + 2 * a4 + hi] = own[h2][a4] + (hi ? rcv[h2][a4] : fromprev); }
          carry = rcv[1][3]; }
        bf16x8 pa[4];
        { u32x4 w0, w1, w2, w3;
#pragma unroll
          for (int i = 0; i < 4; ++i) { w0[i] = cvt_pk_bf16(p0[2 * i], p0[2 * i + 1]); w1[i] = cvt_pk_bf16(p0[8 + 2 * i], p0[8 + 2 * i + 1]); w2[i] = cvt_pk_bf16(p1[2 * i], p1[2 * i + 1]); w3[i] = cvt_pk_bf16(p1[8 + 2 * i], p1[8 + 2 * i + 1]); }
          pa[0] = __builtin_bit_cast(bf16x8, w0); pa[1] = __builtin_bit_cast(bf16x8, w1); pa[2] = __builtin_bit_cast(bf16x8, w2); pa[3] = __builtin_bit_cast(bf16x8, w3); }
#pragma unroll
        for (int dh = 0; dh < 2; ++dh)
#pragma unroll
            for (int ks = 0; ks < 4; ++ks) { const s16x4 lo = vtr(vbase + so + dh * 4096 + ks * 1024), hh = vtr(vbase + so + dh * 4096 + ks * 1024 + 512); oT[dh] = MFMA32(VFRAG(lo, hh), pa[ks], oT[dh]); }
        if (tile + 1 < ntc) A_ST(so ^ 16384);
        __syncthreads();
    }
#undef A_LD
#undef A_ST
}

constexpr int A2_K = 0, A2_V = 49152, A2_SL = 16384;
#define SBAR() __builtin_amdgcn_sched_barrier(0)
#define PIN(x) asm volatile("" : "+v"(x))
#define WAIT_BAR(N) asm volatile("s_waitcnt vmcnt(" #N ") lgkmcnt(0)\n\ts_barrier" ::: "memory")
__device__ __forceinline__ void glds16(const void* g, unsigned lds_base) {
    unsigned sv; asm volatile("s_mov_b32 %0, m0\n\ts_mov_b32 m0, %2\n\ts_nop 0\n\tglobal_load_lds_dwordx4 %1, off\n\ts_mov_b32 m0, %0" : "=&s"(sv) : "v"(g), "s"(lds_base) : "memory"); }
__device__ __forceinline__ void range_mask(f32x16& c0, f32x16& c1, int a, int bb, int hi) {
    const unsigned span = (unsigned)(bb - a);
#pragma unroll
    for (int r = 0; r < 16; ++r) { const int rel = crow(r, hi); c0[r] = ((unsigned)(rel - a) <= span) ? c0[r] : -INFINITY; c1[r] = ((unsigned)(rel + 32 - a) <= span) ? c1[r] : -INFINITY; }
}
template <bool WIN>
__device__ __forceinline__ void attn_stream(LAS unsigned char* lds, const bf16_t* Kb, const bf16_t* Vb, int tlo, int NT, const bf16x8 (&qr)[4], f32x16 (&oT)[2], float& l_out,
                                            unsigned mlo, unsigned mhi, int tq, int kvh, int wave, int lane, int r32, int hi) {
    const unsigned lds0 = (unsigned)(uintptr_t)lds;
    const bf16_t* ksrc = Kb + (size_t)lane * 768 + wave * 8;
    const bf16_t* vsrc = Vb + (size_t)(16 * (wave & 3) + (lane >> 2)) * 768 + (wave >> 2) * 32 + (lane & 3) * 8;
    const unsigned kdst = lds0 + A2_K + wave * 1024, vdst = lds0 + A2_V + wave * 1024;
#define RFL(x) ((unsigned)__builtin_amdgcn_readfirstlane((int)(x)))
#define TCL(i) ((size_t)(tlo + ((i) < NT ? (i) : NT - 1)) * (64 * 768))
#define DMA_K(i, slot) do { const bf16_t* s_ = ksrc + TCL(i); glds16(s_, RFL(kdst + (slot))); glds16(s_ + 64, RFL(kdst + (slot) + 8192)); } while (0)
#define DMA_V(i, slot) do { const bf16_t* s_ = vsrc + TCL(i); glds16(s_, RFL(vdst + (slot))); glds16(s_ + 64, RFL(vdst + (slot) + 8192)); } while (0)
#define TMASK(idx_, a_, bb_, selm_) do { const int tt_ = tlo + (idx_); if (WIN) { a_ = tq - 511 - 64 * tt_; bb_ = tq - 64 * tt_; selm_ = ~0u; } \
        else { const unsigned s_ = tt_ < 32 ? (mlo >> tt_) & 1u : (mhi >> (tt_ - 32)) & 1u; a_ = -64 * tt_; bb_ = tq - 64 * tt_; selm_ = 0u - s_; } } while (0)
#define NEEDM(a_, bb_, selm_) (!__all((selm_) == 0u || ((a_) <= 0 && (bb_) >= 63)))
    const LAS char* kp0 = (const LAS char*)(lds + A2_K) + kvh * 8192 + hi * 1024 + r32 * 16;
    const LAS char* vp0 = (const LAS char*)(lds + A2_V) + kvh * 8192 + ((lane >> 4) & 1) * 32 + (lane & 3) * 8 + (4 * hi + ((lane & 15) >> 2)) * 64;
    asm volatile("s_waitcnt vmcnt(0)" ::: "memory");
    DMA_K(0, 0); DMA_V(0, 0); DMA_K(1, A2_SL); DMA_K(2, 2 * A2_SL);
    float l_reg = 0.f; f32x16 pA0, pA1, pB0, pB1; bf16x8 kf[8]; s16x4 vlo[8], vhi[8]; u32x4 pw0, pw1, pw2, pw3; unsigned selm_prev;
    const f32x16 zero16 = {0.f, 0.f, 0.f, 0.f, 0.f, 0.f, 0.f, 0.f, 0.f, 0.f, 0.f, 0.f, 0.f, 0.f, 0.f, 0.f};
    int sl_prev = 0, sl_cur = 0, sl_next = A2_SL;
#define ROT() do { sl_prev = sl_cur; sl_cur = sl_next; sl_next = (sl_next == 2 * A2_SL) ? 0 : sl_next + A2_SL; } while (0)
#define KLD(kp, d0) do { kf[2 * (d0)] = *(const LAS bf16x8*)((kp) + (d0) * 2048); kf[2 * (d0) + 1] = *(const LAS bf16x8*)((kp) + (d0) * 2048 + 512); } while (0)
    WAIT_BAR(6);
    KLD(kp0, 0); KLD(kp0, 1); KLD(kp0, 2); KLD(kp0, 3);
    pA0 = MFMA32(kf[0], qr[0], zero16); pA1 = MFMA32(kf[1], qr[0], zero16); pA0 = MFMA32(kf[2], qr[1], pA0); pA1 = MFMA32(kf[3], qr[1], pA1);
    pA0 = MFMA32(kf[4], qr[2], pA0); pA1 = MFMA32(kf[5], qr[2], pA1); pA0 = MFMA32(kf[6], qr[3], pA0); pA1 = MFMA32(kf[7], qr[3], pA1);
    { int a_, bb_; TMASK(0, a_, bb_, selm_prev); if (NEEDM(a_, bb_, selm_prev)) range_mask(pA0, pA1, a_, bb_, hi); }
#pragma unroll
    for (int r = 0; r < 16; ++r) { pA0[r] = __builtin_amdgcn_exp2f(pA0[r]); pA1[r] = __builtin_amdgcn_exp2f(pA1[r]); }
    WAIT_BAR(0);
    DMA_K(3, 0); DMA_V(1, A2_SL); ROT();
    KLD(kp0 + sl_cur, 0); KLD(kp0 + sl_cur, 1); KLD(kp0 + sl_cur, 2); KLD(kp0 + sl_cur, 3);
    WAIT_BAR(4);
#define PKW(P, i) cvt_pk_bf16(P[i], P[(i) + 1])
#define PAF(k) __builtin_bit_cast(bf16x8, pw##k)
#define VFR(i) VFRAG(vlo[i], vhi[i])
#define VRD(i) do { vlo[i] = vtr(vp_ + (((i) >> 2) * 4096 + ((i) & 3) * 1024)); vhi[i] = vtr(vp_ + (((i) >> 2) * 4096 + ((i) & 3) * 1024 + 512)); } while (0)
#define KRD(d0) do { KLD(kp0 + sl_next, d0); SBAR(); } while (0)
#define EX(v) __builtin_amdgcn_exp2f(v)
#define GAPA(MF, a0, a1, a2, a3, W0, W1, PW) do { MF; sacc += a0; sacc += a1; sacc += a2; sacc += a3; W0; W1; PIN(PW); PIN(sacc); SBAR(); } while (0)
#define GAPB(MF, X, i) do { MF; X[i] = EX(X[i]); X[(i) + 1] = EX(X[(i) + 1]); X[(i) + 2] = EX(X[(i) + 2]); X[(i) + 3] = EX(X[(i) + 3]); PIN(X); SBAR(); } while (0)
#define SELPW() do { if (!__all(selm_prev == ~0u)) { const u32x4 m_ = {selm_prev, selm_prev, selm_prev, selm_prev}; pw0 = pw0 & m_; pw1 = pw1 & m_; pw2 = pw2 & m_; pw3 = pw3 & m_; } } while (0)
#define STEP(C0, C1, P0, P1, idx) do { SBAR(); \
    const LAS char* vp_ = vp0 + sl_prev; \
    VRD(0); SBAR(); float sacc = P0[0] + P0[1]; \
                    GAPA(C0 = MFMA32(kf[0], qr[0], zero16), P0[2], P0[3], P0[4], P0[5],     pw0[0] = PKW(P0, 0),  pw0[1] = PKW(P0, 2),  pw0); \
    VRD(4); SBAR(); GAPA(C1 = MFMA32(kf[1], qr[0], zero16), P0[6], P0[7], P0[8], P0[9],     pw0[2] = PKW(P0, 4),  pw0[3] = PKW(P0, 6),  pw0); \
    VRD(1); SBAR(); GAPA(C0 = MFMA32(kf[2], qr[1], C0),     P0[10], P0[11], P0[12], P0[13], pw1[0] = PKW(P0, 8),  pw1[1] = PKW(P0, 10), pw1); \
    VRD(5); SBAR(); GAPA(C1 = MFMA32(kf[3], qr[1], C1),     P0[14], P0[15], P1[0], P1[1],   pw1[2] = PKW(P0, 12), pw1[3] = PKW(P0, 14), pw1); \
    VRD(2); SBAR(); GAPA(C0 = MFMA32(kf[4], qr[2], C0),     P1[2], P1[3], P1[4], P1[5],     pw2[0] = PKW(P1, 0),  pw2[1] = PKW(P1, 2),  pw2); \
    VRD(6); SBAR(); GAPA(C1 = MFMA32(kf[5], qr[2], C1),     P1[6], P1[7], P1[8], P1[9],     pw2[2] = PKW(P1, 4),  pw2[3] = PKW(P1, 6),  pw2); \
    VRD(3); SBAR(); GAPA(C0 = MFMA32(kf[6], qr[3], C0),     P1[10], P1[11], P1[12], P1[13], pw3[0] = PKW(P1, 8),  pw3[1] = PKW(P1, 10), pw3); \
    VRD(7); SBAR(); GAPA(C1 = MFMA32(kf[7], qr[3], C1),     P1[14], P1[15], 0.f, 0.f,       pw3[2] = PKW(P1, 12), pw3[3] = PKW(P1, 14), pw3); \
    l_reg += __uint_as_float(__float_as_uint(sacc) & selm_prev); SELPW(); \
    DMA_K((idx) + 3, sl_cur); DMA_V((idx) + 1, sl_next); \
    { int a_, bb_; unsigned selm_; TMASK(idx, a_, bb_, selm_); if (NEEDM(a_, bb_, selm_)) range_mask(C0, C1, a_, bb_, hi); selm_prev = selm_; } \
    SBAR(); \
    GAPB(oT[0] = MFMA32(VFR(0), PAF(0), oT[0]), C0, 0);            GAPB(oT[1] = MFMA32(VFR(4), PAF(0), oT[1]), C0, 4); \
    KRD(0); GAPB(oT[0] = MFMA32(VFR(1), PAF(1), oT[0]), C0, 8);    KRD(1); GAPB(oT[1] = MFMA32(VFR(5), PAF(1), oT[1]), C0, 12); \
    KRD(2); GAPB(oT[0] = MFMA32(VFR(2), PAF(2), oT[0]), C1, 0);    KRD(3); GAPB(oT[1] = MFMA32(VFR(6), PAF(2), oT[1]), C1, 4); \
    GAPB(oT[0] = MFMA32(VFR(3), PAF(3), oT[0]), C1, 8);            GAPB(oT[1] = MFMA32(VFR(7), PAF(3), oT[1]), C1, 12); \
    } while (0)
    int idx = 1;
#pragma unroll 1
    for (; idx + 1 < NT; idx += 2) {
        STEP(pB0, pB1, pA0, pA1, idx);     WAIT_BAR(4); ROT();
        STEP(pA0, pA1, pB0, pB1, idx + 1); WAIT_BAR(4); ROT();
    }
    if (idx < NT) { STEP(pB0, pB1, pA0, pA1, idx); WAIT_BAR(4); ROT(); pA0 = pB0; pA1 = pB1; }
    { float sacc = 0.f;
#pragma unroll
      for (int r = 0; r < 16; ++r) sacc += pA0[r] + pA1[r];
      l_reg += __uint_as_float(__float_as_uint(sacc) & selm_prev);
      pw0 = (u32x4){PKW(pA0, 0), PKW(pA0, 2), PKW(pA0, 4), PKW(pA0, 6)}; pw1 = (u32x4){PKW(pA0, 8), PKW(pA0, 10), PKW(pA0, 12), PKW(pA0, 14)};
      pw2 = (u32x4){PKW(pA1, 0), PKW(pA1, 2), PKW(pA1, 4), PKW(pA1, 6)}; pw3 = (u32x4){PKW(pA1, 8), PKW(pA1, 10), PKW(pA1, 12), PKW(pA1, 14)};
      SELPW();
      const LAS char* vp_ = vp0 + ((NT - 1) % 3) * A2_SL;
#pragma unroll
      for (int i = 0; i < 8; ++i) VRD(i);
      oT[0] = MFMA32(VFR(0), PAF(0), oT[0]); oT[1] = MFMA32(VFR(4), PAF(0), oT[1]); oT[0] = MFMA32(VFR(1), PAF(1), oT[0]); oT[1] = MFMA32(VFR(5), PAF(1), oT[1]);
      oT[0] = MFMA32(VFR(2), PAF(2), oT[0]); oT[1] = MFMA32(VFR(6), PAF(2), oT[1]); oT[0] = MFMA32(VFR(3), PAF(3), oT[0]); oT[1] = MFMA32(VFR(7), PAF(3), oT[1]); }
    WAIT_BAR(0);
    l_out = l_reg;
#undef RFL
#undef TCL
#undef DMA_K
#undef DMA_V
#undef TMASK
#undef NEEDM
#undef ROT
#undef KLD
#undef PKW
#undef PAF
#undef VFR
#undef VRD
#undef KRD
#undef EX
#undef GAPA
#undef GAPB
#undef SELPW
#undef STEP
}

template <int PARTS>
__device__ __forceinline__ void attn_unit(LAS unsigned char* lds, int b, int qt, const bf16_t* Q, const bf16_t* KV, const bf16_t* KC, const bf16_t* VC, const float* GL, bf16_t* MIX) {
    int tid_ = threadIdx.x; asm volatile("" : "+v"(tid_)); const int tid = tid_, lane = tid & 63, wave = __builtin_amdgcn_readfirstlane(tid >> 6), r32 = lane & 31, hi = lane >> 5, kvh = wave >> 2;
    const int t0 = qt * 32, tq = t0 + r32; const size_t tok = (size_t)b * T + tq;
    bf16x8 qr[4];
#pragma unroll
    for (int d0 = 0; d0 < 4; ++d0) qr[d0] = *(const bf16x8*)(Q + tok * 512 + wave * 64 + d0 * 16 + hi * 8);
    LAS float* IMPHA = (LAS float*)(lds + A_IMPH); LAS float* LINV = (LAS float*)(lds + A_LINV); LAS unsigned* MASKL = (LAS unsigned*)(lds + A_MASK); LAS float* SSQL = (LAS float*)(lds + A_SSQ);
    const float* glp = GL + tok * 24 + wave * 3;
    const float g0 = 1.f / (1.f + __expf(-glp[0])), g1 = 1.f / (1.f + __expf(-glp[1])), g2 = 1.f / (1.f + __expf(-glp[2]));
    f32x16 tot[2], oT[2];
    const int nvalid = tq >= 31 ? (tq - 31) / 16 + 1 : 0; const int ntc = (2 * qt + 1 + 63) >> 6;
    const int ckmin = nvalid > 0 ? 0 : (1 << 20), ckmax = nvalid > 0 ? nvalid - 1 : (1 << 20);
    const bf16_t* KCb = KC + (size_t)(b * 2) * 256 * 64; const bf16_t* VCb = VC + (size_t)(b * 2) * 256 * 64;
    float lc = 0.f;
#pragma unroll
    for (int r = 0; r < 16; ++r) { oT[0][r] = 0.f; oT[1][r] = 0.f; }
    if constexpr (PARTS & 1) attn_cmp(lds, KCb, VCb, ntc, qr, oT, lc, ckmin, ckmax, kvh, wave, lane, r32, hi);
    lc += __shfl_xor(lc, 32); const float inv_lc = lc > 0.f ? 1.f / lc : 0.f;
    if (hi == 0) LINV[wave * 32 + r32] = inv_lc;
    { const float c = g0 * inv_lc;
#pragma unroll
      for (int r = 0; r < 16; ++r) { tot[0][r] = oT[0][r] * c; tot[1][r] = oT[1][r] * c; oT[0][r] = 0.f; oT[1][r] = 0.f; } }
    __syncthreads();
    if constexpr (PARTS & 2) {
      unsigned key[8], srt[8];
#pragma unroll
      for (int i = 0; i < 8; ++i) { const int pair = wave * 8 + i, kvp = pair >> 5, qq = pair & 31, j = lane; const int tb = (t0 + qq) >> 6; float v = 0.f;
#pragma unroll
          for (int g = 0; g < 4; ++g) v += IMPHA[((kvp * 4 + g) * 32 + qq) * 65 + j] * LINV[(kvp * 4 + g) * 32 + qq];
          const bool forced = (j == 0) || (j == tb) || (j == tb - 1); const float val = forced ? 1e4f : (j <= tb ? v : -1e4f);
          unsigned k = __float_as_uint(val); k ^= (k & 0x80000000u) ? 0xffffffffu : 0x80000000u; key[i] = (k & ~63u) | (unsigned)(63 - j); srt[i] = key[i]; }
#define TK_STAGE(K_, J_) do { const bool keepmax_ = (((lane & (K_)) == 0) == ((lane & (J_)) == 0)); \
        _Pragma("unroll") for (int i = 0; i < 8; ++i) { const unsigned o_ = (J_) == 32 ? (unsigned)__shfl_xor((int)srt[i], 32) : (unsigned)__builtin_amdgcn_ds_swizzle((int)srt[i], 0x1f | ((J_) << 10)); \
            const unsigned mx_ = srt[i] > o_ ? srt[i] : o_, mn_ = srt[i] > o_ ? o_ : srt[i]; srt[i] = keepmax_ ? mx_ : mn_; } } while (0)
      TK_STAGE(2, 1);
      TK_STAGE(4, 2); TK_STAGE(4, 1);
      TK_STAGE(8, 4); TK_STAGE(8, 2); TK_STAGE(8, 1);
      TK_STAGE(16, 8); TK_STAGE(16, 4); TK_STAGE(16, 2); TK_STAGE(16, 1);
      TK_STAGE(32, 16); TK_STAGE(32, 8); TK_STAGE(32, 4); TK_STAGE(32, 2); TK_STAGE(32, 1);
      TK_STAGE(64, 32); TK_STAGE(64, 16); TK_STAGE(64, 8); TK_STAGE(64, 4); TK_STAGE(64, 2); TK_STAGE(64, 1);
#undef TK_STAGE
#pragma unroll
      for (int i = 0; i < 8; ++i) { const unsigned thr = (unsigned)__builtin_amdgcn_readlane((int)srt[i], 15);
          const unsigned long long m = __ballot(key[i] >= thr); if (lane == 0) { MASKL[(wave * 8 + i) * 2] = (unsigned)m; MASKL[(wave * 8 + i) * 2 + 1] = (unsigned)(m >> 32); } } }
    __syncthreads();
    const unsigned mlo = MASKL[(kvh * 32 + r32) * 2], mhi = MASKL[(kvh * 32 + r32) * 2 + 1];
    const int jmax = (t0 + 31) >> 6;
    const bf16_t* KVb = KV + (size_t)b * T * 768;
    unsigned totp[16];
#pragma unroll
    for (int i = 0; i < 8; ++i) { totp[i] = cvt_pk_bf16(tot[0][2 * i], tot[0][2 * i + 1]); totp[8 + i] = cvt_pk_bf16(tot[1][2 * i], tot[1][2 * i + 1]); }
    float ls = 0.f;
    if constexpr (PARTS & 4) attn_stream<false>(lds, KVb + 256, KVb + 384, 0, jmax + 1, qr, oT, ls, mlo, mhi, tq, kvh, wave, lane, r32, hi);
    ls += __shfl_xor(ls, 32);
    { const float c = ls > 0.f ? g1 / ls : 0.f;
#pragma unroll
      for (int i = 0; i < 8; ++i) { totp[i] = cvt_pk_bf16(__uint_as_float(totp[i] << 16) + oT[0][2 * i] * c, __uint_as_float(totp[i] & 0xffff0000u) + oT[0][2 * i + 1] * c);
                                    totp[8 + i] = cvt_pk_bf16(__uint_as_float(totp[8 + i] << 16) + oT[1][2 * i] * c, __uint_as_float(totp[8 + i] & 0xffff0000u) + oT[1][2 * i + 1] * c); }
#pragma unroll
      for (int r = 0; r < 16; ++r) { oT[0][r] = 0.f; oT[1][r] = 0.f; } }
    float lw = 0.f; const int jlo = t0 >= 511 ? (t0 - 511) >> 6 : 0;
    if constexpr (PARTS & 8) attn_stream<true>(lds, KVb + 512, KVb + 640, jlo, jmax - jlo + 1, qr, oT, lw, 0u, 0u, tq, kvh, wave, lane, r32, hi);
    lw += __shfl_xor(lw, 32);
    { const float c = lw > 0.f ? g2 / lw : 0.f;
#pragma unroll
      for (int i = 0; i < 8; ++i) { tot[0][2 * i] = __uint_as_float(totp[i] << 16) + oT[0][2 * i] * c; tot[0][2 * i + 1] = __uint_as_float(totp[i] & 0xffff0000u) + oT[0][2 * i + 1] * c;
                                    tot[1][2 * i] = __uint_as_float(totp[8 + i] << 16) + oT[1][2 * i] * c; tot[1][2 * i + 1] = __uint_as_float(totp[8 + i] & 0xffff0000u) + oT[1][2 * i + 1] * c; } }
    { float ss = 0.f;
#pragma unroll
      for (int r = 0; r < 16; ++r) ss += tot[0][r] * tot[0][r] + tot[1][r] * tot[1][r];
      ss += __shfl_xor(ss, 32); if (hi == 0) SSQL[wave * 32 + r32] = ss; }
    __syncthreads();
    { float sa = 0.f;
#pragma unroll
      for (int w8 = 0; w8 < 8; ++w8) sa += SSQL[w8 * 32 + r32];
      const float rs = rsqrtf(sa * (1.f / 512.f) + 1e-6f); bf16_t* op = MIX + tok * 1024 + 512 + wave * 64 + 4 * hi;
#pragma unroll
      for (int dh = 0; dh < 2; ++dh)
#pragma unroll
          for (int a4 = 0; a4 < 4; ++a4) { u32x2 w; w.x = cvt_pk_bf16(tot[dh][4 * a4] * rs, tot[dh][4 * a4 + 1] * rs); w.y = cvt_pk_bf16(tot[dh][4 * a4 + 2] * rs, tot[dh][4 * a4 + 3] * rs); *(u32x2*)(op + dh * 32 + a4 * 8) = w; } }
    __syncthreads();
}

__device__ __forceinline__ void memattn_unit(LAS unsigned char* lds, int b, int h, int qt, const bf16_t* QM, const bf16_t* KVM, const float* qg, bf16_t* OM) {
    int tid_ = threadIdx.x; asm volatile("" : "+v"(tid_)); const int tid = tid_, lane = tid & 63, wave = __builtin_amdgcn_readfirstlane(tid >> 6), r32 = lane & 31, hi = lane >> 5;
    const size_t tok = (size_t)b * T + qt * 256 + wave * 32 + r32;
    bf16x8 qr[8];
    { float v[64]; float ss = 0.f;
#pragma unroll
      for (int d0 = 0; d0 < 8; ++d0) { const u32x4 w = *(const u32x4*)(QM + tok * 512 + h * 128 + d0 * 16 + hi * 8);
#pragma unroll
          for (int i = 0; i < 4; ++i) { const float a = __uint_as_float(w[i] << 16), c = __uint_as_float(w[i] & 0xffff0000u); v[d0 * 8 + 2 * i] = a; v[d0 * 8 + 2 * i + 1] = c; ss += a * a + c * c; } }
      ss += __shfl_xor(ss, 32); const float rs = rsqrtf(ss * (1.f / 128.f) + 1e-6f) * (0.08838834764831845f * 1.4426950408889634f);
#pragma unroll
      for (int d0 = 0; d0 < 8; ++d0) { u32x4 w; const float* gp = qg + d0 * 16 + hi * 8;
#pragma unroll
          for (int i = 0; i < 4; ++i) w[i] = cvt_pk_bf16(v[d0 * 8 + 2 * i] * rs * gp[2 * i], v[d0 * 8 + 2 * i + 1] * rs * gp[2 * i + 1]);
          qr[d0] = __builtin_bit_cast(bf16x8, w); } }
    const bf16_t* Kg = KVM + (size_t)b * 256 * 1024 + h * 128; const bf16_t* Vg = Kg + 512;
    { u32x4 sk[8], sv[8];
#pragma unroll
      for (int tile = 0; tile < 4; ++tile)
#pragma unroll
          for (int i = 0; i < 2; ++i) { sk[tile * 2 + i] = *(const u32x4*)(Kg + (size_t)(tile * 64 + lane) * 1024 + (wave * 2 + i) * 8); const int p = i * 512 + tid;
              sv[tile * 2 + i] = *(const u32x4*)(Vg + (size_t)(tile * 64 + ((p & 255) >> 2)) * 1024 + (p >> 8) * 32 + (p & 3) * 8); }
#pragma unroll
      for (int tile = 0; tile < 4; ++tile)
#pragma unroll
          for (int i = 0; i < 2; ++i) { *(LAS u32x4*)(lds + tile * 16384 + (wave * 2 + i) * 1024 + lane * 16) = sk[tile * 2 + i]; *(LAS u32x4*)(lds + 65536 + tile * 16384 + (i * 512 + tid) * 16) = sv[tile * 2 + i]; } }
    const LAS char* kbase = (const LAS char*)lds + hi * 1024 + r32 * 16;
    const LAS char* vbase = (const LAS char*)lds + 65536 + ((lane >> 4) & 1) * 32 + (lane & 3) * 8 + (4 * hi + ((lane & 15) >> 2)) * 64;
    f32x16 oT[4]; float lsum = 0.f;
#pragma unroll
    for (int dq = 0; dq < 4; ++dq)
#pragma unroll
        for (int r = 0; r < 16; ++r) oT[dq][r] = 0.f;
    __syncthreads();
#pragma unroll 1
    for (int tile = 0; tile < 4; ++tile) { const int so = tile * 16384;
        f32x16 p0, p1;
#pragma unroll
        for (int r = 0; r < 16; ++r) { p0[r] = 0.f; p1[r] = 0.f; }
#pragma unroll
        for (int d0 = 0; d0 < 8; ++d0) { const bf16x8 k0 = *(const LAS bf16x8*)(kbase + so + d0 * 2048), k1 = *(const LAS bf16x8*)(kbase + so + d0 * 2048 + 512); p0 = MFMA32(k0, qr[d0], p0); p1 = MFMA32(k1, qr[d0], p1); }
        float s = 0.f;
#pragma unroll
        for (int r = 0; r < 16; ++r) { p0[r] = __builtin_amdgcn_exp2f(p0[r]); p1[r] = __builtin_amdgcn_exp2f(p1[r]); s += p0[r] + p1[r]; }
        lsum += s;
        bf16x8 pa[4];
        { u32x4 w0, w1, w2, w3;
#pragma unroll
          for (int i = 0; i < 4; ++i) { w0[i] = cvt_pk_bf16(p0[2 * i], p0[2 * i + 1]); w1[i] = cvt_pk_bf16(p0[8 + 2 * i], p0[8 + 2 * i + 1]); w2[i] = cvt_pk_bf16(p1[2 * i], p1[2 * i + 1]); w3[i] = cvt_pk_bf16(p1[8 + 2 * i], p1[8 + 2 * i + 1]); }
          pa[0] = __builtin_bit_cast(bf16x8, w0); pa[1] = __builtin_bit_cast(bf16x8, w1); pa[2] = __builtin_bit_cast(bf16x8, w2); pa[3] = __builtin_bit_cast(bf16x8, w3); }
#pragma unroll
        for (int dq = 0; dq < 4; ++dq)
#pragma unroll
            for (int ks = 0; ks < 4; ++ks) { const s16x4 lo = vtr(vbase + so + dq * 4096 + ks * 1024), hh = vtr(vbase + so + dq * 4096 + ks * 1024 + 512); oT[dq] = MFMA32(VFRAG(lo, hh), pa[ks], oT[dq]); }
    }
    __syncthreads();
    lsum += __shfl_xor(lsum, 32); const float il = 1.f / lsum; bf16_t* op = OM + tok * 512 + h * 128 + 4 * hi;
#pragma unroll
    for (int dq = 0; dq < 4; ++dq)
#pragma unroll
        for (int a4 = 0; a4 < 4; ++a4) { u32x2 w; w.x = cvt_pk_bf16(oT[dq][4 * a4] * il, oT[dq][4 * a4 + 1] * il); w.y = cvt_pk_bf16(oT[dq][4 * a4 + 2] * il, oT[dq][4 * a4 + 3] * il); *(u32x2*)(op + dq * 32 + a4 * 8) = w; }
}

#define XB_TMO      128
#define XB_XCNT(j)  (256  + 64 * (j))
#define XB_XSUB(j)  (1280 + 64 * (j))
#define XB_XGEN(j)  (2304 + 64 * (j))
#define XB_TOP      3328
#define XB_TOPGEN   3392
#define XCD_BAR_WORDS 3456
#define XB_SPIN_CAP (1u << 18)
__device__ __forceinline__ unsigned xb_ld(unsigned* p)              { return __hip_atomic_load(p, __ATOMIC_RELAXED, __HIP_MEMORY_SCOPE_AGENT); }
__device__ __forceinline__ unsigned xb_add(unsigned* p, unsigned v) { return __hip_atomic_fetch_add(p, v, __ATOMIC_RELAXED, __HIP_MEMORY_SCOPE_AGENT); }
__device__ __forceinline__ unsigned xb_xcc_id() { return (unsigned)__builtin_amdgcn_s_getreg((3 << 11) | 20) & 0xFu; }
#define XB_SPIN(cond, bar) do { unsigned _sp = 0; while (cond) { __builtin_amdgcn_s_sleep(1); \
    if ((++_sp & 255u) == 0u) { if (xb_ld(&(bar)[XB_TMO])) break; if (_sp > XB_SPIN_CAP) { atomicAdd(&(bar)[XB_TMO], 1u); break; } } } } while (0)
struct XcdBarrier { unsigned* bar; unsigned x; volatile LAS unsigned* st; };
__device__ __forceinline__ XcdBarrier xcd_barrier_post(unsigned* bar, volatile LAS unsigned* st) {
    XcdBarrier b; b.bar = bar; b.x = xb_xcc_id(); b.st = st;
    if (threadIdx.x == 0) (void)xb_add(&bar[XB_XCNT(b.x)], 1u);
    return b;
}
__device__ __forceinline__ void xcd_barrier_complete(unsigned* bar, unsigned x, unsigned& nloc, unsigned& nx) {
    const unsigned G = gridDim.x * gridDim.y * gridDim.z;
    unsigned sum, cnt, mine, sp = 0u;
    for (;;) {
        sum = 0u; cnt = 0u; mine = 0u;
#pragma unroll
        for (unsigned j = 0; j < 16; ++j) { const unsigned c = xb_ld(&bar[XB_XCNT(j)]); sum += c; cnt += (c > 0u) ? 1u : 0u; mine = (j == x) ? c : mine; }
        if (sum == G) break;
        __builtin_amdgcn_s_sleep(1);
        if ((++sp & 255u) == 0u) { if (xb_ld(&bar[XB_TMO])) break; if (sp > XB_SPIN_CAP) { atomicAdd(&bar[XB_TMO], 1u); break; } }
    }
    nloc = mine > 0u ? mine : 1u; nx = cnt > 0u ? cnt : 1u;
}
__device__ __forceinline__ void xcd_barrier(const XcdBarrier& b) {
    asm volatile("s_waitcnt vmcnt(0)" ::: "memory");
    __syncthreads();
    if (threadIdx.x == 0) {
        unsigned* bar = b.bar;
        __builtin_amdgcn_s_waitcnt(0);
        unsigned nloc = b.st[0], nx = b.st[1];
        if (nloc == 0u) { xcd_barrier_complete(bar, b.x, nloc, nx); b.st[0] = nloc; b.st[1] = nx; }
        const unsigned old = xb_add(&bar[XB_XSUB(b.x)], 1u);
        const unsigned gen = old / nloc;
        if (old + 1u == (gen + 1u) * nloc) {
            __builtin_amdgcn_fence(__ATOMIC_RELEASE, "agent");
            asm volatile("s_waitcnt vmcnt(0)" ::: "memory");
            const unsigned og = xb_add(&bar[XB_TOP], 1u);
            const unsigned tg = og / nx;
            if (og + 1u == (tg + 1u) * nx) xb_add(&bar[XB_TOPGEN], 1u);
            else XB_SPIN(xb_ld(&bar[XB_TOPGEN]) == tg, bar);
            __builtin_amdgcn_fence(__ATOMIC_ACQUIRE, "agent");
            xb_add(&bar[XB_XGEN(b.x)], 1u);
            asm volatile("s_waitcnt vmcnt(0)" ::: "memory");
        } else {
            XB_SPIN(xb_ld(&bar[XB_XGEN(b.x)]) == gen, bar);
            __builtin_amdgcn_fence(__ATOMIC_ACQUIRE, "agent");
            asm volatile("s_waitcnt vmcnt(0)" ::: "memory");
        }
    }
    __syncthreads();
}
constexpr size_t CTL_BAR_BYTE = 704 * 1024;
constexpr size_t CTL_FLAG_BYTE = 720 * 1024;
constexpr size_t CTL_MQFLAG_BYTE = 768 * 1024;
constexpr int LDS_ST_OFF = 147456 - 64;

struct EpiCmp {
    static constexpr bool PERM = false, AFTER_DRAIN = true;
    const float* b1p; const bf16_t* w2t; const float* b2; const float* kg0; bf16_t* OUT; float* PART; unsigned* flag; unsigned epoch; int half;
    __device__ __forceinline__ void fused(f32x4 (&acc)[2][2][4][2], const pg8::Unit&, int wr, int wc, int fr, int fq, LAS unsigned char* lds, int wid, int lane) const {
        unsigned ep = epoch; asm volatile("" : "+s"(ep));
        LAS float* PB = (LAS float*)lds;
        LAS unsigned char* HB = lds;
#pragma unroll
        for (int ai = 0; ai < 2; ++ai)
#pragma unroll
            for (int m = 0; m < 4; ++m) { const int row = ai * 128 + wr * 64 + m * 16 + fr;
#pragma unroll
                for (int n = 0; n < 2; ++n) *(LAS f32x4*)(PB + row * 132 + wc * 32 + n * 16 + 4 * fq) = acc[ai][1][m][n]; }
        __syncthreads();
        u32x2 hv[2][4][2];
#pragma unroll
        for (int ai = 0; ai < 2; ++ai)
#pragma unroll
            for (int m = 0; m < 4; ++m) { const int row = ai * 128 + wr * 64 + m * 16 + fr;
#pragma unroll
                for (int n = 0; n < 2; ++n) { const int col = wc * 32 + n * 16 + 4 * fq; f32x4 pb = {0.f, 0.f, 0.f, 0.f}; if (row < 255) pb = *(const LAS f32x4*)(PB + (row + 1) * 132 + col);
                    const f32x4 bb = *(const f32x4*)(b1p + half * 128 + col); const f32x4 v = acc[ai][0][m][n] + pb + bb;
                    hv[ai][m][n].x = cvt_pk_bf16(pg8::gelu_tanh(v[0]), pg8::gelu_tanh(v[1])); hv[ai][m][n].y = cvt_pk_bf16(pg8::gelu_tanh(v[2]), pg8::gelu_tanh(v[3])); } }
        __syncthreads();
#pragma unroll
        for (int ai = 0; ai < 2; ++ai)
#pragma unroll
            for (int m = 0; m < 4; ++m) { const int row = ai * 128 + wr * 64 + m * 16 + fr;
#pragma unroll
                for (int n = 0; n < 2; ++n) *(LAS u32x2*)(HB + row * 272 + (wc * 32 + n * 16 + 4 * fq) * 2) = hv[ai][m][n]; }
        __syncthreads();
        const int r32 = lane & 31, hi = lane >> 5, row = wid * 32 + r32;
        bf16x8 a0[8], a1[8], bf[8];
#pragma unroll
        for (int ks = 0; ks < 8; ++ks) { a0[ks] = *(const bf16x8*)(w2t + (size_t)r32 * 256 + half * 128 + ks * 16 + hi * 8); a1[ks] = *(const bf16x8*)(w2t + (size_t)(32 + r32) * 256 + half * 128 + ks * 16 + hi * 8);
            bf[ks] = *(const LAS bf16x8*)(HB + row * 272 + (ks * 16 + hi * 8) * 2); }
        f32x16 o2[2];
#pragma unroll
        for (int r = 0; r < 16; ++r) { o2[0][r] = 0.f; o2[1][r] = 0.f; }
#pragma unroll
        for (int ks = 0; ks < 8; ++ks) { o2[0] = MFMA32(a0[ks], bf[ks], o2[0]); o2[1] = MFMA32(a1[ks], bf[ks], o2[1]); }
        float* pp = PART + (size_t)row * 64 + 4 * hi;
        if (half == 1) {
#pragma unroll
            for (int h = 0; h < 2; ++h)
#pragma unroll
                for (int a4 = 0; a4 < 4; ++a4) *(f32x4*)(pp + 32 * h + 8 * a4) = (f32x4){o2[h][4 * a4], o2[h][4 * a4 + 1], o2[h][4 * a4 + 2], o2[h][4 * a4 + 3]};
            asm volatile("s_waitcnt vmcnt(0)" ::: "memory"); __syncthreads();
            if (threadIdx.x == 0) { __builtin_amdgcn_fence(__ATOMIC_RELEASE, "agent"); asm volatile("s_waitcnt vmcnt(0)" ::: "memory"); __hip_atomic_store(flag, ep, __ATOMIC_RELAXED, __HIP_MEMORY_SCOPE_AGENT); }
            return; }
        if (wid == 0) { unsigned sp = 0;
            while ((unsigned)__builtin_amdgcn_readfirstlane(__hip_atomic_load(flag, __ATOMIC_RELAXED, __HIP_MEMORY_SCOPE_AGENT)) < ep) { __builtin_amdgcn_s_sleep(2); if (++sp > (1u << 22)) break; }
            __builtin_amdgcn_fence(__ATOMIC_ACQUIRE, "agent"); asm volatile("s_waitcnt vmcnt(0)" ::: "memory"); }
        __syncthreads();
        float ss = 0.f;
#pragma unroll
        for (int h = 0; h < 2; ++h)
#pragma unroll
            for (int a4 = 0; a4 < 4; ++a4) { const f32x4 pv = *(const f32x4*)(pp + 32 * h + 8 * a4); const f32x4 bv = *(const f32x4*)(b2 + 32 * h + 8 * a4 + 4 * hi);
#pragma unroll
                for (int e = 0; e < 4; ++e) { const float v = o2[h][4 * a4 + e] + pv[e] + bv[e]; o2[h][4 * a4 + e] = v; ss += v * v; } }
        if (kg0) { ss += __shfl_xor(ss, 32); const float rs = rsqrtf(ss * (1.f / 64.f) + 1e-6f);
#pragma unroll
            for (int h = 0; h < 2; ++h)
#pragma unroll
                for (int a4 = 0; a4 < 4; ++a4) { const f32x4 gv = *(const f32x4*)(kg0 + 32 * h + 8 * a4 + 4 * hi);
#pragma unroll
                    for (int e = 0; e < 4; ++e) o2[h][4 * a4 + e] *= rs * gv[e]; } }
        const float keep = row == 255 ? 0.f : 1.f;
#pragma unroll
        for (int h = 0; h < 2; ++h)
#pragma unroll
            for (int a4 = 0; a4 < 4; ++a4) { u32x2 w; w.x = cvt_pk_bf16(o2[h][4 * a4] * keep, o2[h][4 * a4 + 1] * keep); w.y = cvt_pk_bf16(o2[h][4 * a4 + 2] * keep, o2[h][4 * a4 + 3] * keep); *(u32x2*)(OUT + (size_t)row * 64 + 32 * h + 8 * a4 + 4 * hi) = w; }
    }
};

template <bool PROBE>
__device__ __forceinline__ void do_phase(const int p, const int l, const Args& args, LAS unsigned char* lds, const int G, const int bx, const int NGW) {
    unsigned char* ws = args.ws; float* xout = args.out; asm volatile("" : "+s"(ws), "+s"(xout));
    int tidp = threadIdx.x; asm volatile("" : "+v"(tidp)); const int lane = tidp & 63, wave = __builtin_amdgcn_readfirstlane(tidp >> 6), gw = bx * 8 + wave; (void)lane; (void)gw; (void)NGW;
    float* ctl = (float*)(ws + WS_CTL); bf16_t* XB = (bf16_t*)(ws + WS_XB); float* ssqp = (float*)(ws + WS_SSQP);
    unsigned char* wl = ws + WS_W + l * W_LAYER;
    if (p == 0) {
        pg8::Gemm g = pg8::make_gemm(XB, (const bf16_t*)(wl + W_IN), 1024); pg8::StaticOrder S; S.init(NTOK, INP, G, bx);
        pg8::EpiInProj E{(bf16_t*)(ws + WS_U), (bf16_t*)(ws + WS_V), (bf16_t*)(ws + WS_Q), (bf16_t*)(ws + WS_KV), (float*)(ws + WS_GL), ssqp + (size_t)(l == 0 ? 0 : 3) * NTOK * 16};
        pg8::gemm_phase<pg8::EpiInProj, pg8::StaticOrder, true>(lds, g, S, E);
        if (l == 0 && !PROBE && G == 256 && bx >= 128)
            convert_layer(args, 0, CV_IN, CONV_ITEMS, (bx - 128) * 8 + wave, 128 * 8, (LAS float*)(lds + wave * 16384), lane);
    } else if (p == 1) {
      for (int vb = bx; vb < 256; vb += G) {
        if (PROBE && !((MK_P1_ROLES >> (vb < 32 ? 0 : vb < 48 ? 1 : vb < 176 ? 2 : 3)) & 1)) continue;
        if (vb < 32) { if constexpr (!PROBE || (MK_P1_ROLES & 1)) { const int kv = vb >> 4, pm = (vb >> 1) & 7, half = vb & 1;
            pg8::Gemm g; g.A = (const bf16_t*)(ws + WS_KV) + kv * 128; g.Bt = (const bf16_t*)(wl + W_C1 + (size_t)kv * 512 * 1024 * 2); g.K = 1024; g.lda = 16 * 768; g.kstepA = 768 * 2; g.a_s0 = 64 * 2; g.a_s1 = (size_t)T * 768 * 2;
            pg8::OneUnit S{1, {pm, half}};
            EpiCmp E{(const float*)(wl + W_B1P) + kv * 256, (const bf16_t*)(wl + W_C2) + (size_t)kv * 64 * 256, args.in[I_CB2] + l * 128 + kv * 64, kv == 0 ? args.in[I_KNG] + l * 192 : (const float*)nullptr,
                     (bf16_t*)(ws + (kv ? WS_VC : WS_KC)) + (size_t)pm * 256 * 64, (float*)(ws + WS_HID) + (size_t)(kv * 8 + pm) * 256 * 64, (unsigned*)(ws + WS_CTL + CTL_FLAG_BYTE) + (kv * 8 + pm) * 64, (unsigned)(l + 1), half};
            pg8::gemm_phase<EpiCmp, pg8::OneUnit, false>(lds, g, S, E); }
        } else if (vb < 48) { if constexpr (!PROBE || (MK_P1_ROLES & 2)) { const int i = vb - 32;
            pg8::Gemm g = pg8::make_gemm((const bf16_t*)(ws + WS_MEMB), (const bf16_t*)(wl + W_MKV), 1024); pg8::OneUnit S{1, {i >> 2, i & 3}};
            pg8::EpiBf16G<0> E{(bf16_t*)(ws + WS_KVM), 1024, nullptr, ctl + SSQ_MEM_OFF, 1.f / 1024.f, 1};
            pg8::gemm_phase<pg8::EpiBf16G<0>, pg8::OneUnit, true>(lds, g, S, E); }
        } else if (vb < 176) { if constexpr (!PROBE || (MK_P1_ROLES & 4))
            sgu_unit(lds, vb - 48, (const bf16_t*)(ws + WS_U), (const bf16_t*)(ws + WS_V), (const bf16_t*)(wl + W_SG), args.in[I_SGLNG] + l * 512, args.in[I_SGLNB] + l * 512, args.in[I_SGB] + l * 1024, (bf16_t*)(ws + WS_MIX));
        } else {
            int ln2 = lane; asm volatile("" : "+v"(ln2));
            for (int t = (vb - 176) * 8 + wave; t < NTOK; t += 4 * 640) tokprep4((bf16_t*)(ws + WS_Q), (bf16_t*)(ws + WS_KV), args.in[I_QNG] + l * 64, args.in[I_KNG] + l * 192, t, 640, ln2);
            if (l == 0 && !PROBE) convert_layer(args, 1, 0, CONV_SPLIT, (vb - 176) * 8 + wave, 80 * 8, (LAS float*)(lds + wave * 16384), ln2);
        } }
    } else if (p == 3) {
        for (int r = gw; r < 4096; r += NGW) memk_norm_item((bf16_t*)(ws + WS_KVM), args.in[I_MKG] + l * 128, r, lane);
        for (int i = bx; i < 256; i += G) { const int b = (i & 7) >> 1, idx = (i >> 3) * 2 + (i & 1);
            attn_unit<15>(lds, b, 127 - idx, (const bf16_t*)(ws + WS_Q), (const bf16_t*)(ws + WS_KV), (const bf16_t*)(ws + WS_KC), (const bf16_t*)(ws + WS_VC), (const float*)(ws + WS_GL), (bf16_t*)(ws + WS_MIX));
            attn_unit<15>(lds, b, idx, (const bf16_t*)(ws + WS_Q), (const bf16_t*)(ws + WS_KV), (const bf16_t*)(ws + WS_KC), (const bf16_t*)(ws + WS_VC), (const float*)(ws + WS_GL), (bf16_t*)(ws + WS_MIX)); }
    } else if (p == 6) {
        for (int i = bx; i < 256; i += G) { const int b = (i & 7) >> 1, rest = (i >> 3) * 2 + (i & 1);
            if (!PROBE) { const int h_ = rest >> 4, qt_ = rest & 15;
                if (wave == 0) { unsigned* fl = (unsigned*)(ws + WS_CTL + CTL_MQFLAG_BYTE) + ((b * 16 + qt_) * 2 + (h_ >> 1)) * 64; unsigned sp = 0;
                    while ((unsigned)__builtin_amdgcn_readfirstlane(__hip_atomic_load(fl, __ATOMIC_RELAXED, __HIP_MEMORY_SCOPE_AGENT)) < (unsigned)(l + 1)) { __builtin_amdgcn_s_sleep(2); if (++sp > (1u << 22)) break; }
                    __builtin_amdgcn_fence(__ATOMIC_ACQUIRE, "agent"); asm volatile("s_waitcnt vmcnt(0)" ::: "memory"); }
                __syncthreads(); }
            memattn_unit(lds, b, rest >> 4, rest & 15, (const bf16_t*)(ws + WS_QM), (const bf16_t*)(ws + WS_KVM), args.in[I_MQG] + l * 128, (bf16_t*)(ws + WS_OM)); }
    } else if (p == 4) {
        pg8::Gemm g = pg8::make_gemm((const bf16_t*)(ws + WS_MIX), (const bf16_t*)(wl + W_OUT), 1024); pg8::StaticOrder S; S.init(NTOK, 1024, G, bx);
        pg8::EpiResid E{nullptr, XB, ssqp + (size_t)(PROBE ? 1 : l * 3 + 1) * NTOK * 16};
        pg8::gemm_phase<pg8::EpiResid, pg8::StaticOrder, true>(lds, g, S, E);
    } else if (p == 5) {
        pg8::Gemm g = pg8::make_gemm(XB, (const bf16_t*)(wl + W_MQ), 1024); pg8::StaticOrder S; S.init(NTOK, 512, G, bx);
        pg8::EpiBf16G<0> E{(bf16_t*)(ws + WS_QM), 512, nullptr, ssqp + (size_t)(l * 3 + 1) * NTOK * 16, 1.f / 1024.f, 16};
        pg8::gemm_phase<pg8::EpiBf16G<0>, pg8::StaticOrder, true>(lds, g, S, E);
        if (!PROBE) {
            asm volatile("s_waitcnt vmcnt(0)" ::: "memory"); __syncthreads();
            if (threadIdx.x == 0) { pg8::Unit u; bool any = false; for (int i = 0; S.next(i, u); ++i) any = true;
                if (any) { __builtin_amdgcn_fence(__ATOMIC_RELEASE, "agent"); asm volatile("s_waitcnt vmcnt(0)" ::: "memory");
                    for (int i = 0; S.next(i, u); ++i) __hip_atomic_store((unsigned*)(ws + WS_CTL + CTL_MQFLAG_BYTE) + (u.pm * 2 + u.pn) * 64, (unsigned)(l + 1), __ATOMIC_RELAXED, __HIP_MEMORY_SCOPE_AGENT); } } }
        if (l == 0 && !PROBE) { const int nidle = G > 128 ? G - 128 : 0;
            if (nidle == 0) convert_layer(args, 1, CONV_SPLIT, CONV_ITEMS, gw, NGW, (LAS float*)(lds + wave * 16384), lane);
            else if (bx >= 128) convert_layer(args, 1, CONV_SPLIT, CONV_ITEMS, (bx - 128) * 8 + wave, nidle * 8, (LAS float*)(lds + wave * 16384), lane); }
    } else if (p == 7) {
        pg8::Gemm g = pg8::make_gemm((const bf16_t*)(ws + WS_OM), (const bf16_t*)(wl + W_MO), 512); pg8::StaticOrder S; S.init(NTOK, 1024, G, bx);
        pg8::EpiResid E{nullptr, XB, ssqp + (size_t)(PROBE ? 1 : l * 3 + 2) * NTOK * 16};
        pg8::gemm_phase<pg8::EpiResid, pg8::StaticOrder, true>(lds, g, S, E);
    } else if (p == 8) {
        pg8::Gemm g = pg8::make_gemm(XB, (const bf16_t*)(wl + W_FF1), 1024); pg8::StaticOrder S; S.init(NTOK, FF, G, bx);
        pg8::EpiBf16G<2> E{(bf16_t*)(ws + WS_HB), FF, nullptr, ssqp + (size_t)(l * 3 + 2) * NTOK * 16, 1.f / 1024.f, 16};
        pg8::gemm_phase<pg8::EpiBf16G<2>, pg8::StaticOrder, true>(lds, g, S, E);
    } else if (p == 9) {
        pg8::Gemm g = pg8::make_gemm((const bf16_t*)(ws + WS_HB), (const bf16_t*)(wl + W_FF2), FF); pg8::StaticOrder S; S.init(NTOK, 1024, G, bx);
        pg8::EpiResid E{(l == 0 || PROBE) ? (float*)nullptr : xout, XB, ssqp + (size_t)(PROBE ? 1 : 3) * NTOK * 16};
        pg8::gemm_phase<pg8::EpiResid, pg8::StaticOrder, true>(lds, g, S, E);
    }
}

constexpr int LDS_BYTES = 147456;
__global__ void __launch_bounds__(512, 2) mega(Args args) {
    extern __shared__ __attribute__((aligned(16))) unsigned char lds_raw[];
    LAS unsigned char* lds = (LAS unsigned char*)lds_raw;
    const int G = gridDim.x, bx = blockIdx.x, NGW = G * 8;
    volatile LAS unsigned* bar_st = (volatile LAS unsigned*)(lds + LDS_ST_OFF);
    if (threadIdx.x < 2) bar_st[threadIdx.x] = 0u;
    __syncthreads();
    XcdBarrier xbar = xcd_barrier_post((unsigned*)(args.ws + WS_CTL + CTL_BAR_BYTE), bar_st);
    if (args.ph_hi < 0) cooperative_groups::this_grid().sync();
    if (args.ph_lo == 0) { const int tid0 = threadIdx.x, wave0 = __builtin_amdgcn_readfirstlane(tid0 >> 6); for (int e_ = 0; e_ < 1 + MK_PROBE_PRO; ++e_) prologue(args, lds, bx * 8 + wave0, NGW, wave0, tid0 & 63); }
    for (int ph = args.ph_lo > 1 ? args.ph_lo : 1; ph < args.ph_hi; ++ph) {
        if ((ph - 1) % 10 == 2) continue;
        if (ph > args.ph_lo && (ph - 1) % 10 != 6) {
            xcd_barrier(xbar); }
        do_phase<false>((ph - 1) % 10, (ph - 1) / 10, args, lds, G, bx, NGW);
    }
#if MK_PROBE_N > 0
    if (args.ph_hi == 21) {
        xcd_barrier(xbar); do_phase<false>(0, 1, args, lds, G, bx, NGW);
        xcd_barrier(xbar); do_phase<false>(1, 1, args, lds, G, bx, NGW);
        for (int e_ = 0; e_ < MK_PROBE_N; ++e_) { xcd_barrier(xbar);
#if MK_PROBE_KIND == 100
            { int tidp = threadIdx.x; asm volatile("" : "+v"(tidp)); const int w_ = __builtin_amdgcn_readfirstlane(tidp >> 6); convert_layer(args, 1, 0, CONV_ITEMS, bx * 8 + w_, NGW, (LAS float*)(lds + w_ * 16384), tidp & 63); }
#elif MK_PROBE_KIND == 33
            for (int i = bx; i < 256; i += G) { const int b = (i & 7) >> 1, idx = (i >> 3) * 2 + (i & 1); unsigned char* ws = args.ws;
                attn_unit<MK_PROBE_PARTS>(lds, b, 127 - idx, (const bf16_t*)(ws + WS_Q), (const bf16_t*)(ws + WS_KV), (const bf16_t*)(ws + WS_KC), (const bf16_t*)(ws + WS_VC), (const float*)(ws + WS_GL), (bf16_t*)(ws + WS_MIX));
                attn_unit<MK_PROBE_PARTS>(lds, b, idx, (const bf16_t*)(ws + WS_Q), (const bf16_t*)(ws + WS_KV), (const bf16_t*)(ws + WS_KC), (const bf16_t*)(ws + WS_VC), (const float*)(ws + WS_GL), (bf16_t*)(ws + WS_MIX)); }
#elif MK_PROBE_KIND == 34
            { unsigned char* ws = args.ws; unsigned char* wl = ws + WS_W + W_LAYER;
              for (int vb = bx; vb < 256; vb += G) if (vb >= 48 && vb < 176) sgu_unit(lds, vb - 48, (const bf16_t*)(ws + WS_U), (const bf16_t*)(ws + WS_V), (const bf16_t*)(wl + W_SG), args.in[I_SGLNG] + 512, args.in[I_SGLNB] + 512, args.in[I_SGB] + 1024, (bf16_t*)(ws + WS_MIX)); }
#elif MK_PROBE_KIND == 35
            { unsigned char* ws = args.ws; int tidp = threadIdx.x; asm volatile("" : "+v"(tidp)); const int w_ = __builtin_amdgcn_readfirstlane(tidp >> 6);
              for (int vb = bx; vb < 256; vb += G) if (vb >= 176) for (int t = (vb - 176) * 8 + w_; t < NTOK; t += 4 * 640) tokprep4((bf16_t*)(ws + WS_Q), (bf16_t*)(ws + WS_KV), args.in[I_QNG] + 64, args.in[I_KNG] + 192, t, 640, tidp & 63); }
#elif MK_PROBE_KIND != 99
            do_phase<true>(MK_PROBE_KIND, 1, args, lds, G, bx, NGW);
#endif
        }
    }
#endif
}

}

#ifndef MK_FUSED
#define MK_FUSED 1
#endif
extern "C" void kernel_launch(void* const* d_in, const int* in_sizes, int n_in, void* d_out, int out_size, void* d_ws, size_t ws_size, hipStream_t stream) {
    using namespace mk;
    static int grid = 0;
    if (!grid) { (void)hipFuncSetAttribute((const void*)mega, hipFuncAttributeMaxDynamicSharedMemorySize, LDS_BYTES);
        int dev = 0, cus = 0, per_cu = 0; (void)hipGetDevice(&dev); (void)hipDeviceGetAttribute(&cus, hipDeviceAttributeMultiprocessorCount, dev);
        (void)hipOccupancyMaxActiveBlocksPerMultiprocessor(&per_cu, (const void*)mega, 512, LDS_BYTES);
        grid = cus * (per_cu < 1 ? 1 : per_cu); if (grid > 256) grid = 256; }
    Args a{}; for (int i = 0; i < 27; ++i) a.in[i] = (const float*)d_in[i]; a.out = (float*)d_out; a.ws = (unsigned char*)d_ws;
#if MK_FUSED
    (void)hipMemsetAsync((unsigned char*)d_ws + WS_CTL + CTL_BAR_BYTE, 0, 96 * 1024, stream);
    a.ph_lo = 0; a.ph_hi = 21; void* kargs[] = {&a};
    (void)hipLaunchCooperativeKernel((const void*)mega, dim3(grid), dim3(512), kargs, LDS_BYTES, stream);
#else
    for (int ph = 0; ph < 21; ++ph) { a.ph_lo = ph; a.ph_hi = ph + 1; hipLaunchKernelGGL(mega, dim3(grid), dim3(512), LDS_BYTES, stream, a); }
#endif
}
```

```cpp
#include <hip/hip_runtime.h>
#include <hip/hip_cooperative_groups.h>
#include <stdint.h>
#include <math.h>

namespace pg8 {
#define PG8_LAS __attribute__((address_space(3)))
typedef unsigned short bf16_t;
typedef short bf16x8 __attribute__((ext_vector_type(8)));
typedef float f32x4 __attribute__((ext_vector_type(4)));
typedef float f32x2 __attribute__((ext_vector_type(2)));
typedef unsigned u32x4 __attribute__((ext_vector_type(4)));
typedef unsigned u32x2 __attribute__((ext_vector_type(2)));
constexpr int BM = 256, BK = 64, HALF = 128, HTB = HALF * BK * 2, STAGE_BYTES = 8 * HTB, NXCD = 8, WGM = 2;
constexpr int RTAB_OFF = STAGE_BYTES;

__host__ __device__ __forceinline__ int lds_byte(int r, int c) { const int st = (r >> 4) * 2 + (c >> 5), rr = r & 15, cc = c & 31, ob = rr * 64 + cc * 2; return st * 1024 + (ob ^ (((ob >> 9) & 1) << 5)); }
__host__ __device__ __forceinline__ void stage_rc(int b, int& R, int& C) { const int st = b / 1024, sb = b % 1024, swz = sb ^ (((sb >> 9) & 1) << 5); R = (st >> 1) * 16 + swz / 64; C = (st & 1) * 32 + (swz % 64) / 2; }
__host__ __device__ __forceinline__ int perm32(int rho) { const int n = rho >> 4, i = rho & 15; return 8 * (i >> 2) + 4 * n + (i & 3); }

struct Unit { int pm, pn, hs; };
struct Gemm { const bf16_t* A; const bf16_t* Bt; int K; int lda; int kstepA; size_t a_s0, a_s1; int aimg; };
__device__ __forceinline__ Gemm make_gemm(const bf16_t* A, const bf16_t* Bt, int K) { Gemm g; g.A = A; g.Bt = Bt; g.K = K; g.lda = K; g.kstepA = BK * 2; g.a_s0 = (size_t)BM * K * 2; g.a_s1 = 2 * g.a_s0; g.aimg = 0; return g; }

struct StaticOrder {
    int nM, nN, nwg, G, c, R, split, wg;
    __device__ __forceinline__ void init(int M, int N, int G_, int c_) { nM = M / BM; nN = N / BM; nwg = nM * nN; G = G_; c = c_; R = nwg / G; split = 0; wg = WGM; }
    __device__ __forceinline__ void split_tail() { split = (G == 256 && 2 * (nwg - R * G) == G) ? 1 : 0; }
    __device__ __forceinline__ bool next(int i, Unit& u) const {
        long L = (long)i * G + c; int hs = 0;
        if (split) { if (i > R) return false; if (i == R) { L = (long)R * G + (((c >> 4) << 3) | (c & 7)); hs = 1 + ((c >> 3) & 1); } }
        if (L >= nwg) return false;
        int wgid = (int)L; { const int q = nwg / NXCD, r = nwg % NXCD, xcd = wgid % NXCD, off = wgid / NXCD; wgid = (xcd < r ? xcd * (q + 1) : r * (q + 1) + (xcd - r) * q) + off; }
        const int nig = wg * nN, gid = wgid / nig, fm = gid * wg, gsz = (nM - fm) < wg ? (nM - fm) : wg;
        u.pm = fm + ((wgid % nig) % gsz); u.pn = (wgid % nig) / gsz; u.hs = hs; return true;
    }
};
struct OneUnit { int has; Unit u; __device__ __forceinline__ bool next(int i, Unit& o) const { if (i > 0 || !has) return false; o = u; return true; } };

__device__ __forceinline__ unsigned cvt_pk_bf16(float lo, float hi) { unsigned r; asm volatile("v_cvt_pk_bf16_f32 %0, %1, %2" : "=v"(r) : "v"(lo), "v"(hi)); return r; }
__device__ __forceinline__ float gelu_tanh(float x) {
    const float w = x * __builtin_fmaf(x * x, -0.10294324f, -2.3022082f); const float e = __builtin_amdgcn_exp2f(w); return x * __builtin_amdgcn_rcpf(1.f + e); }

__device__ __forceinline__ float ssq16(const float* p) { const f32x4 a = ((const f32x4*)p)[0], b = ((const f32x4*)p)[1], c = ((const f32x4*)p)[2], d = ((const f32x4*)p)[3];
    return (((a[0] + a[1]) + (a[2] + a[3])) + ((b[0] + b[1]) + (b[2] + b[3]))) + (((c[0] + c[1]) + (c[2] + c[3])) + ((d[0] + d[1]) + (d[2] + d[3]))); }
template <int ACT  , bool TAB = false  > struct EpiBf16G {
    static constexpr bool PERM = true, AFTER_DRAIN = false;
    bf16_t* O; int ldc; const float* bias; const float* ssq; float inv_n; int nparts; int aimg;
    __device__ __forceinline__ void operator()(const f32x4 (&acc)[2][2][4][2], const Unit& u, int wr, int wc, int fr, int fq, int ui) const {
        const int hs = u.hs; const int row0 = u.pm * BM + wr * 64 + fr, col0 = u.pn * BM + wc * 32 + 8 * fq + (hs == 2 ? HALF : 0);
        f32x4 bv[2][2];
#pragma unroll
        for (int bj = 0; bj < 2; ++bj)
#pragma unroll
            for (int n = 0; n < 2; ++n) bv[bj][n] = bias ? *(const f32x4*)(bias + col0 + bj * HALF + 4 * n) : (f32x4){0.f, 0.f, 0.f, 0.f};
        const bool tab = TAB && ui < 4; const PG8_LAS float* rtab = (const PG8_LAS float*)(uintptr_t)RTAB_OFF;
        float rsv[2] = {1.f, 1.f};
        if (ssq && !tab) {
#pragma unroll
            for (int ai = 0; ai < 2; ++ai) { const int rr = row0 + ai * HALF + fq * 16; rsv[ai] = rsqrtf((nparts == 16 ? ssq16(ssq + (size_t)rr * 16) : ssq[rr]) * inv_n + 1e-6f); } }
#pragma unroll
        for (int ai = 0; ai < 2; ++ai)
#pragma unroll
            for (int m = 0; m < 4; ++m) { const int row = row0 + ai * HALF + m * 16; const float rs = tab ? rtab[ui * 256 + ai * HALF + wr * 64 + m * 16 + fr] : __shfl(rsv[ai], fr + 16 * m); bf16_t* rowp = O + (size_t)row * ldc + col0;
#pragma unroll
                for (int bj = 0; bj < 2; ++bj) { if (bj && hs) continue; f32x4 v0 = (acc[ai][bj][m][0] + bv[bj][0]) * rs, v1 = (acc[ai][bj][m][1] + bv[bj][1]) * rs;
                    if (ACT == 1) {
#pragma unroll
                        for (int e = 0; e < 4; ++e) { v0[e] = gelu_tanh(v0[e]); v1[e] = gelu_tanh(v1[e]); } }
                    if (ACT == 2) {
#pragma unroll
                        for (int e = 0; e < 4; ++e) { float a = fmaxf(v0[e], 0.f), b = fmaxf(v1[e], 0.f); v0[e] = a * a; v1[e] = b * b; } }
                    u32x4 w; w.x = cvt_pk_bf16(v0[0], v0[1]); w.y = cvt_pk_bf16(v0[2], v0[3]); w.z = cvt_pk_bf16(v1[0], v1[1]); w.w = cvt_pk_bf16(v1[2], v1[3]);
                    if (aimg == 3) { const int cc = col0 + bj * HALF, c = cc & 127, t = row & 4095;
                        *(u32x4*)((char*)O + (unsigned)((((((row >> 12) * 4 + (cc >> 7)) * 16 + (t >> 8)) * 8 + ((t >> 5) & 7)) * 8 + (c >> 4)) * 64 + ((c >> 3) & 1) * 32 + (t & 31)) * 16u) = w; }
                    else if (aimg == 2) { const int cc = col0 + bj * HALF, c = cc & 127, rr = row & 63, tl = (row >> 6) & 3;
                        const int eo = (cc >> 9) ? 32768 + (tl * 1024 + (c >> 5) * 256 + rr * 4 + ((c & 31) >> 3)) * 8 : ((tl * 16 + (c >> 3)) * 64 + rr) * 8;
                        *(u32x4*)(O + (size_t)((row >> 8) * 4 + ((cc >> 7) & 3)) * 65536 + eo) = w; }
                    else if (aimg) { const int cc = col0 + bj * HALF; *(u32x4*)(O + ((size_t)(row >> 7) * (ldc >> 6) + (cc >> 6)) * 8192 + (lds_byte(row & 127, cc & 63) >> 1)) = w; }
                    else *(u32x4*)(rowp + bj * HALF) = w; } }
    }
};
template <bool TAB> struct EpiInProjT {
    static constexpr bool PERM = true, AFTER_DRAIN = false;
    bf16_t *U, *V, *Q, *KV; float* GL; const float* ssq; bf16_t* KVC;
    __device__ __forceinline__ void operator()(const f32x4 (&acc)[2][2][4][2], const Unit& u, int wr, int wc, int fr, int fq, int ui) const {
        const int hs = u.hs; const int row0 = u.pm * BM + wr * 64 + fr, cit0 = wc * 32 + 8 * fq + (hs == 2 ? HALF : 0); const int pn = u.pn;
        bf16_t* base; int ldc, cofs; bool act = false;
        if (pn < 2) { base = U; ldc = 512; cofs = pn * 256; act = true; } else if (pn < 4) { base = V; ldc = 512; cofs = (pn - 2) * 256; act = true; }
        else if (pn < 6) { base = Q; ldc = 512; cofs = (pn - 4) * 256; } else { base = KV; ldc = 768; cofs = (pn - 6) * 256; }
        const bool tab = TAB && ui < 4; const PG8_LAS float* rtab = (const PG8_LAS float*)(uintptr_t)RTAB_OFF;
        float rsv[2] = {1.f, 1.f};
        if (!tab) {
#pragma unroll
            for (int ai = 0; ai < 2; ++ai) rsv[ai] = rsqrtf(ssq16(ssq + (size_t)(row0 + ai * HALF + fq * 16) * 16) * (1.f / 1024.f) + 1e-6f); }
#pragma unroll
        for (int ai = 0; ai < 2; ++ai)
#pragma unroll
            for (int m = 0; m < 4; ++m) { const int row = row0 + ai * HALF + m * 16; const float rs = tab ? rtab[ui * 256 + ai * HALF + wr * 64 + m * 16 + fr] : __shfl(rsv[ai], fr + 16 * m);
#pragma unroll
                for (int bj = 0; bj < 2; ++bj) { if (bj && hs) continue; f32x4 v0 = acc[ai][bj][m][0] * rs, v1 = acc[ai][bj][m][1] * rs; const int cit = cit0 + bj * HALF;
                    if (pn == 9) { if (cit < 24) { *(f32x4*)(GL + (size_t)row * 24 + cit) = v0; *(f32x4*)(GL + (size_t)row * 24 + cit + 4) = v1; } }
                    else { if (act) {
#pragma unroll
                            for (int e = 0; e < 4; ++e) { v0[e] = gelu_tanh(v0[e]); v1[e] = gelu_tanh(v1[e]); } }
                        u32x4 w; w.x = cvt_pk_bf16(v0[0], v0[1]); w.y = cvt_pk_bf16(v0[2], v0[3]); w.z = cvt_pk_bf16(v1[0], v1[1]); w.w = cvt_pk_bf16(v1[2], v1[3]);
                        if (pn == 6) *(u32x4*)(KVC + ((size_t)(cit >> 6) * 16384 + row) * 64 + (cit & 63)) = w;
                        else if (pn >= 7) {
                            const int c = cit & 127, r = row & 63, i = c >> 6, cc = c & 63;
                            const int eo = cit < 128 ? i * 4096 + (cc >> 3) * 512 + r * 8
                                                     : i * 4096 + ((cc >> 5) * 4 + (r >> 4)) * 512 + ((r & 15) * 4 + ((cc & 31) >> 3)) * 8;
                            *(u32x4*)(KV + ((size_t)((pn - 7) * 2 + (cit < 128 ? 0 : 1)) * 256 + (row >> 6)) * 8192 + eo) = w; }
                        else *(u32x4*)(base + (size_t)row * ldc + cofs + cit) = w; } } }
    }
};
typedef EpiInProjT<false> EpiInProj;
struct EpiResid {
    static constexpr bool PERM = true, AFTER_DRAIN = false;
    float* XF; bf16_t* XB; float* ssq;
    __device__ __forceinline__ void operator()(const f32x4 (&acc)[2][2][4][2], const Unit& u, int wr, int wc, int fr, int fq, int) const {
        const int col0 = u.pn * BM + wc * 32 + 8 * fq;
        const unsigned ob0 = (unsigned)((u.pm * BM + wr * 64 + fr) * 1024 + col0) * 2u;
        u32x4 xw[2][4][2];
#pragma unroll
        for (int ai = 0; ai < 2; ++ai)
#pragma unroll
            for (int m = 0; m < 4; ++m)
#pragma unroll
                for (int bj = 0; bj < 2; ++bj) xw[ai][m][bj] = *(const u32x4*)((const char*)XB + (ob0 + (unsigned)((ai * HALF + m * 16) * 1024 + bj * HALF) * 2u));
#pragma unroll
        for (int ai = 0; ai < 2; ++ai) {
#pragma unroll
            for (int m = 0; m < 4; ++m) { const int row = u.pm * BM + ai * HALF + wr * 64 + m * 16 + fr; float sq = 0.f;
#pragma unroll
                for (int bj = 0; bj < 2; ++bj) { const unsigned ob = ob0 + (unsigned)((ai * HALF + m * 16) * 1024 + bj * HALF) * 2u; const u32x4 xv = xw[ai][m][bj];
                    f32x4 x0, x1; x0[0] = __uint_as_float(xv.x << 16); x0[1] = __uint_as_float(xv.x & 0xffff0000u); x0[2] = __uint_as_float(xv.y << 16); x0[3] = __uint_as_float(xv.y & 0xffff0000u);
                    x1[0] = __uint_as_float(xv.z << 16); x1[1] = __uint_as_float(xv.z & 0xffff0000u); x1[2] = __uint_as_float(xv.w << 16); x1[3] = __uint_as_float(xv.w & 0xffff0000u);
                    x0 = x0 + acc[ai][bj][m][0]; x1 = x1 + acc[ai][bj][m][1];
                    if (XF) { float* xf = (float*)((char*)XF + 2u * ob); *(f32x4*)xf = x0; *(f32x4*)(xf + 4) = x1; }
                    else { sq += ((x0[0] * x0[0] + x0[1] * x0[1]) + (x0[2] * x0[2] + x0[3] * x0[3])) + ((x1[0] * x1[0] + x1[1] * x1[1]) + (x1[2] * x1[2] + x1[3] * x1[3]));
                        u32x4 w; w.x = cvt_pk_bf16(x0[0], x0[1]); w.y = cvt_pk_bf16(x0[2], x0[3]); w.z = cvt_pk_bf16(x1[0], x1[1]); w.w = cvt_pk_bf16(x1[2], x1[3]); *(u32x4*)((char*)XB + ob) = w; } }
                if (!XF) { sq += __shfl_xor(sq, 16); sq += __shfl_xor(sq, 32); if (fq == 0) ssq[(size_t)row * 16 + u.pn * 4 + wc] = sq; } } }
    }
};

template <class Sched> __device__ __forceinline__ void rstd_table(PG8_LAS unsigned char* lds, const Sched& S, const float* ssq, float inv_n) {
    PG8_LAS float* tabp = (PG8_LAS float*)(lds + RTAB_OFF); int t = threadIdx.x; asm volatile("" : "+v"(t));
#pragma unroll
    for (int pass = 0; pass < 2; ++pass) { Unit u; const int i = pass * 2 + (t >> 8); if (S.next(i, u)) tabp[i * 256 + (t & 255)] = rsqrtf(ssq16(ssq + (size_t)(u.pm * BM + (t & 255)) * 16) * inv_n + 1e-6f); }
    __syncthreads();
}
template <class Epi, class Sched, bool ALIGN_EPI>
__device__ __forceinline__ void gemm_phase(PG8_LAS unsigned char* lds, const Gemm g, const Sched& S, const Epi& E) {
    int tid_ = threadIdx.x; asm volatile("" : "+v"(tid_));
    const int tid = tid_, wid = __builtin_amdgcn_readfirstlane(tid >> 6), lane = tid & 63, wr = wid >> 2, wc = wid & 3, fr = lane & 15, fq = lane >> 4;
    const int K = g.K, nt = K / BK;
    unsigned voffA[2], voffB[2];
#pragma unroll
    for (int i = 0; i < 2; ++i) { int R, C; stage_rc(tid * 16 + i * 8192, R, C); const int Rb = Epi::PERM ? ((R & ~31) + perm32(R & 31)) : R;
        voffA[i] = g.aimg ? (unsigned)(tid * 16 + i * 8192) : (unsigned)(R * g.lda + C) * 2u; voffB[i] = (unsigned)(tid * 16 + i * 8192); (void)Rb; }
    const size_t kstepA = (size_t)g.kstepA, kstepB = (size_t)16384;
    const size_t hstepA = (size_t)HALF * g.lda * 2, hstepB = (size_t)nt * 16384, tstepB = 2 * hstepB;
    const unsigned ldsw = (unsigned)wid * 1024u;
    const int aoff = lds_byte(wr * 64 + fr, fq * 8), boff = lds_byte(wc * 32 + fr, fq * 8);
#define PG8_ABASE(pm) ((const char*)g.A + (size_t)((pm) >> 1) * g.a_s1 + (size_t)((pm) & 1) * g.a_s0)
#define PG8_SA(b, h) (((b) * 2 + (h)) * HTB)
#define PG8_SB(b, h) ((4 + (b) * 2 + (h)) * HTB)
#define PG8_STAGE(bufoff, gbase, voff) do { _Pragma("unroll") for (int _i = 0; _i < 2; ++_i) \
        __builtin_amdgcn_global_load_lds((const unsigned*)((const char*)(gbase) + (voff)[_i]), (PG8_LAS unsigned*)(lds + (bufoff) + ldsw + _i * 8192), 16, 0, 0); } while (0)
#define PG8_LDA(dst, b, h) do { _Pragma("unroll") for (int m = 0; m < 4; ++m) _Pragma("unroll") for (int k = 0; k < 2; ++k) dst[m][k] = *(const PG8_LAS bf16x8*)(lds + PG8_SA(b, h) + aoff + m * 2048 + k * 1024); } while (0)
#define PG8_LDB(dst, b, h) do { _Pragma("unroll") for (int n = 0; n < 2; ++n) _Pragma("unroll") for (int k = 0; k < 2; ++k) dst[n][k] = *(const PG8_LAS bf16x8*)(lds + PG8_SB(b, h) + boff + n * 2048 + k * 1024); } while (0)
#define PG8_MMA(ai, bj, At, Bt) do { __builtin_amdgcn_s_setprio(1); _Pragma("unroll") for (int m = 0; m < 4; ++m) _Pragma("unroll") for (int n = 0; n < 2; ++n) _Pragma("unroll") for (int k = 0; k < 2; ++k) \
        acc[ai][bj][m][n] = __builtin_amdgcn_mfma_f32_16x16x32_bf16(Bt[n][k], At[m][k], acc[ai][bj][m][n], 0, 0, 0); __builtin_amdgcn_s_setprio(0); } while (0)
#define PG8_WAIT_V(n) asm volatile("s_waitcnt vmcnt(" #n ")" ::: "memory")
#define PG8_WAIT_L(n) asm volatile("s_waitcnt lgkmcnt(" #n ")" ::: "memory")
#define PG8_BAR __builtin_amdgcn_s_barrier()
#define PG8_SCHED __builtin_amdgcn_sched_barrier(0)
    Unit cur, nxt; int ui = 0;
    if (!S.next(0, cur)) return;
    f32x4 acc[2][2][4][2];
#pragma unroll
    for (int a = 0; a < 2; ++a)
#pragma unroll
        for (int b = 0; b < 2; ++b)
#pragma unroll
            for (int m = 0; m < 4; ++m)
#pragma unroll
                for (int n = 0; n < 2; ++n) acc[a][b][m][n] = (f32x4){0.f, 0.f, 0.f, 0.f};
    bf16x8 At[4][2], B0[2][2], B1[2][2];
    const char* cA = PG8_ABASE(cur.pm); const char* cB = (const char*)g.Bt + (size_t)cur.pn * tstepB + (cur.hs == 2 ? hstepB : 0);
    PG8_STAGE(PG8_SB(0, 0), cB, voffB); PG8_STAGE(PG8_SB(0, 1), cB + hstepB, voffB); PG8_STAGE(PG8_SA(0, 0), cA, voffA); PG8_STAGE(PG8_SA(0, 1), cA + hstepA, voffA);
    if (wr == 1) PG8_BAR;
    PG8_WAIT_V(2); PG8_BAR;
    PG8_STAGE(PG8_SB(1, 0), cB + kstepB, voffB); PG8_STAGE(PG8_SA(1, 0), cA + kstepA, voffA); PG8_STAGE(PG8_SB(1, 1), cB + hstepB + kstepB, voffB);
    PG8_WAIT_V(6); PG8_BAR;
    for (;;) {
        const bool has_next = S.next(ui + 1, nxt);
        const char* nA = has_next ? PG8_ABASE(nxt.pm) : cA; const char* nB = has_next ? (const char*)g.Bt + (size_t)nxt.pn * tstepB + (nxt.hs == 2 ? hstepB : 0) : cB;
        if (cur.hs) {
          for (int t = 0; t < nt; t += 2) {
            const bool last = (t == nt - 2);
            const char* a1 = cA + (size_t)(t + 1) * kstepA;
            const char* a2 = last ? nA : cA + (size_t)(t + 2) * kstepA; const char* b2 = last ? nB : cB + (size_t)(t + 2) * kstepB;
            const char* a3 = a2 + kstepA; const char* b3 = b2 + kstepB;
            PG8_LDB(B0, 0, 0); PG8_SCHED; PG8_LDA(At, 0, 0); PG8_STAGE(PG8_SA(1, 1), a1 + hstepA, voffA);
            PG8_WAIT_V(6); PG8_WAIT_L(0); PG8_BAR; PG8_MMA(0, 0, At, B0); PG8_BAR; PG8_SCHED;
            PG8_LDA(At, 0, 1); PG8_STAGE(PG8_SB(0, 0), b2, voffB); PG8_STAGE(PG8_SA(0, 0), a2, voffA);
            PG8_WAIT_V(6); PG8_WAIT_L(0); PG8_BAR; PG8_MMA(1, 0, At, B0); PG8_BAR; PG8_SCHED;
            PG8_LDB(B0, 1, 0); PG8_SCHED; PG8_LDA(At, 1, 0); PG8_STAGE(PG8_SA(0, 1), a2 + hstepA, voffA);
            PG8_WAIT_V(6); PG8_WAIT_L(0); PG8_BAR; PG8_MMA(0, 0, At, B0); PG8_BAR; PG8_SCHED;
            PG8_LDA(At, 1, 1); PG8_STAGE(PG8_SB(1, 0), b3, voffB); PG8_STAGE(PG8_SA(1, 0), a3, voffA);
            PG8_WAIT_V(6); PG8_WAIT_L(0); PG8_BAR; PG8_MMA(1, 0, At, B0); PG8_BAR; PG8_SCHED;
          }
        } else
        for (int t = 0; t < nt; t += 2) {
            const bool last = (t == nt - 2);
            const char* a1 = cA + (size_t)(t + 1) * kstepA;
            const char* a2 = last ? nA : cA + (size_t)(t + 2) * kstepA; const char* b2 = last ? nB : cB + (size_t)(t + 2) * kstepB;
            const char* a3 = a2 + kstepA; const char* b3 = b2 + kstepB;
            PG8_LDB(B0, 0, 0); PG8_LDB(B1, 0, 1); PG8_SCHED; PG8_LDA(At, 0, 0); PG8_STAGE(PG8_SA(1, 1), a1 + hstepA, voffA);
            PG8_WAIT_V(8); PG8_WAIT_L(0); PG8_BAR; PG8_MMA(0, 0, At, B0); PG8_MMA(0, 1, At, B1); PG8_BAR; PG8_SCHED;
            PG8_LDA(At, 0, 1); PG8_STAGE(PG8_SB(0, 0), b2, voffB); PG8_STAGE(PG8_SB(0, 1), b2 + hstepB, voffB); PG8_STAGE(PG8_SA(0, 0), a2, voffA);
            PG8_WAIT_V(8); PG8_WAIT_L(0); PG8_BAR; PG8_MMA(1, 0, At, B0); PG8_MMA(1, 1, At, B1); PG8_BAR; PG8_SCHED;
            PG8_LDB(B0, 1, 0); PG8_LDB(B1, 1, 1); PG8_SCHED; PG8_LDA(At, 1, 0); PG8_STAGE(PG8_SA(0, 1), a2 + hstepA, voffA);
            PG8_WAIT_V(8); PG8_WAIT_L(0); PG8_BAR; PG8_MMA(0, 0, At, B0); PG8_MMA(0, 1, At, B1); PG8_BAR; PG8_SCHED;
            PG8_LDA(At, 1, 1); PG8_STAGE(PG8_SB(1, 0), b3, voffB); PG8_STAGE(PG8_SB(1, 1), b3 + hstepB, voffB); PG8_STAGE(PG8_SA(1, 0), a3, voffA);
            PG8_WAIT_V(8); PG8_WAIT_L(0); PG8_BAR; PG8_MMA(1, 0, At, B0); PG8_MMA(1, 1, At, B1); PG8_BAR; PG8_SCHED;
        }
        if constexpr (ALIGN_EPI) { if (wr == 0) PG8_BAR; }
        if constexpr (!Epi::AFTER_DRAIN) { E(acc, cur, wr, wc, fr, fq, ui); }
        if (!has_next) break;
#pragma unroll
        for (int a = 0; a < 2; ++a)
#pragma unroll
            for (int b = 0; b < 2; ++b)
#pragma unroll
                for (int m = 0; m < 4; ++m)
#pragma unroll
                    for (int n = 0; n < 2; ++n) acc[a][b][m][n] = (f32x4){0.f, 0.f, 0.f, 0.f};
        cur = nxt; cA = nA; cB = nB; ++ui;
        if constexpr (ALIGN_EPI) { if (wr == 1) PG8_BAR; }
    }
    PG8_WAIT_V(0);
    if constexpr (!ALIGN_EPI) { if (wr == 0) PG8_BAR; }
    PG8_BAR;
    if constexpr (Epi::AFTER_DRAIN) { E.fused(acc, cur, wr, wc, fr, fq, lds, wid, lane); }
#undef PG8_ABASE
#undef PG8_SA
#undef PG8_SB
#undef PG8_STAGE
#undef PG8_LDA
#undef PG8_LDB
#undef PG8_MMA
#undef PG8_WAIT_V
#undef PG8_WAIT_L
#undef PG8_BAR
#undef PG8_SCHED
}
}

#ifndef MK_PROBE_N
#define MK_PROBE_N 0
#endif
#ifndef MK_P1_ROLES
#define MK_P1_ROLES 15
#endif
#ifndef MK_PROBE_PRO
#define MK_PROBE_PRO 0
#endif
#ifndef MK_PROBE_KIND
#define MK_PROBE_KIND 3
#endif
#ifndef MK_PROBE_PARTS
#define MK_PROBE_PARTS 15
#endif

namespace mk {
using pg8::bf16_t; using pg8::f32x4; using pg8::u32x4; using pg8::u32x2; using pg8::cvt_pk_bf16;
#define LAS __attribute__((address_space(3)))
constexpr int NB = 4, T = 4096, D = 1024, NTOK = NB * T, INC = 2328, INP = 2560, FF = 4096;
constexpr size_t MiB = 1u << 20;
constexpr size_t WS_CTL = 0;
constexpr size_t WS_W = 1 * MiB, W_LAYER = 30 * MiB;
constexpr size_t W_IN = 0, W_OUT = 5 * MiB, W_MQ = 7 * MiB, W_MKV = 8 * MiB, W_MO = 10 * MiB, W_FF1 = 11 * MiB, W_FF2 = 19 * MiB, W_C1 = 27 * MiB, W_C2 = 29 * MiB, W_SG = 29 * MiB + 128 * 1024, W_B1P = 29 * MiB + 512 * 1024;
constexpr size_t WS_XB = 61 * MiB;
constexpr size_t WS_OV = 93 * MiB;
constexpr size_t WS_U = WS_OV, WS_V = WS_OV + 16 * MiB, WS_Q = WS_OV + 32 * MiB, WS_KV = WS_OV + 48 * MiB, WS_MIX = WS_OV + 72 * MiB, WS_QM = WS_OV + 104 * MiB, WS_OM = WS_OV + 120 * MiB;
constexpr size_t WS_HB = WS_OV;
constexpr size_t WS_SM = 229 * MiB;
constexpr size_t WS_GL = WS_SM, WS_KC = WS_SM + 2 * MiB, WS_VC = WS_KC + 256 * 1024, WS_HID = WS_SM + 3 * MiB, WS_MASK = WS_SM + 5 * MiB, WS_MEMB = WS_SM + 6 * MiB, WS_KVM = WS_SM + 8 * MiB, WS_END = WS_SM + 10 * MiB;
constexpr size_t WS_KVC = 246 * MiB;
constexpr size_t WS_SSQP = 240 * MiB;
static_assert(WS_END <= WS_SSQP && WS_SSQP + 6 * MiB <= WS_KVC && WS_KVC + 8 * MiB <= 256 * MiB, "ws map");
constexpr int SSQ_MEM_OFF = 6 * NTOK;

struct Args { const float* in[27]; float* out; unsigned char* ws; int ph_lo, ph_hi; };
enum { I_X = 0, I_MEM, I_NMG, I_WIN, I_SGLNG, I_SGLNB, I_SGW, I_SGB, I_QNG, I_KNG, I_CPOS, I_CW1, I_CB1, I_CW2, I_CB2, I_MOG, I_WOUT, I_NMEMG, I_MKVG, I_WMQ, I_WMKV, I_MQG, I_MKG, I_WMO, I_NFG, I_WFF1, I_WFF2 };

__device__ __forceinline__ float bf2f(unsigned short b) { return __uint_as_float((unsigned)b << 16); }
__device__ __forceinline__ float wave_sum(float v) {
#pragma unroll
    for (int o = 1; o < 64; o <<= 1) v += __shfl_xor(v, o);
    return v; }

constexpr int CV_IN = 16 * 80, CV_OUT = 16 * 32, CV_MQ = 16 * 16, CV_MKV = 16 * 32, CV_MO = 8 * 32, CV_FF1 = 16 * 128, CV_FF2 = 64 * 32, CV_C1 = 32 * 8, CV_C2 = 4 * 2;
constexpr int CV_TR = CV_IN + CV_OUT + CV_MQ + CV_MKV + CV_MO + CV_FF1 + CV_FF2 + 2 * CV_C1 + 2 * CV_C2, CV_B1 = 64, CV_SG = 1024, CONV_ITEMS = CV_TR + CV_B1 + CV_SG;
struct ConvD { const float* W; const float* gain; bf16_t* WT; int K, N, Npad, ld, item, kind, img; };
__device__ __forceinline__ ConvD conv_desc(const Args& a, int l, int r) {
    unsigned char* wl = a.ws + WS_W + l * W_LAYER; ConvD d; d.gain = nullptr; d.kind = 0; d.ld = 0; d.img = 1;
#define CD_SET(Wp, K_, N_, NP_, G_, DST, IT, LD) do { d.W = (Wp); d.K = (K_); d.N = (N_); d.Npad = (NP_); d.gain = (G_); d.WT = (bf16_t*)(DST); d.item = (IT); d.ld = (LD); return d; } while (0)
    if (r < CV_IN) CD_SET(a.in[I_WIN] + (size_t)l * 1024 * INC, 1024, INC, INP, a.in[I_NMG] + l * 1024, wl + W_IN, r, INC); r -= CV_IN;
    if (r < CV_OUT) CD_SET(a.in[I_WOUT] + (size_t)l * 1024 * 1024, 1024, 1024, 1024, a.in[I_MOG] + l * 1024, wl + W_OUT, r, 1024); r -= CV_OUT;
    if (r < CV_MQ) CD_SET(a.in[I_WMQ] + (size_t)l * 1024 * 512, 1024, 512, 512, a.in[I_NMEMG] + l * 1024, wl + W_MQ, r, 512); r -= CV_MQ;
    if (r < CV_MKV) CD_SET(a.in[I_WMKV] + (size_t)l * 1024 * 1024, 1024, 1024, 1024, a.in[I_MKVG] + l * 1024, wl + W_MKV, r, 1024); r -= CV_MKV;
    if (r < CV_MO) CD_SET(a.in[I_WMO] + (size_t)l * 512 * 1024, 512, 1024, 1024, (const float*)nullptr, wl + W_MO, r, 1024); r -= CV_MO;
    if (r < CV_FF1) CD_SET(a.in[I_WFF1] + (size_t)l * 1024 * 4096, 1024, 4096, 4096, a.in[I_NFG] + l * 1024, wl + W_FF1, r, 4096); r -= CV_FF1;
    if (r < CV_FF2) CD_SET(a.in[I_WFF2] + (size_t)l * 4096 * 1024, 4096, 1024, 1024, (const float*)nullptr, wl + W_FF2, r, 1024); r -= CV_FF2;
    if (r < 2 * CV_C1) {
        const int kv = r / CV_C1, r2 = r % CV_C1, sub = r2 >> 6, half = sub >> 1, tb = sub & 1;
        d.img = 2;
        CD_SET(a.in[I_CW1] + (size_t)(l * 2 + kv) * 2048 * 256 + (size_t)tb * 1024 * 256 + half * 128, 1024, 128, 128, (const float*)nullptr,
               (bf16_t*)(wl + W_C1 + (size_t)kv * 512 * 1024 * 2) + (size_t)(half * 256 + tb * 128) * 1024, r2 & 63, 256); } r -= 2 * CV_C1;
    if (r < 2 * CV_C2) { const int kv = r / CV_C2; d.img = 0; CD_SET(a.in[I_CW2] + (size_t)(l * 2 + kv) * 256 * 64, 256, 64, 64, (const float*)nullptr, wl + W_C2 + (size_t)kv * 64 * 256 * 2, r % CV_C2, 64); } r -= 2 * CV_C2;
#undef CD_SET
    if (r < CV_SG) { d.kind = 2; d.item = r; d.W = nullptr; d.WT = nullptr; d.K = d.N = d.Npad = 0; return d; } r -= CV_SG;
    d.kind = 1; d.item = r; d.W = nullptr; d.WT = nullptr; d.K = d.N = d.Npad = 0; return d;
}
__device__ __forceinline__ void conv_load(const ConvD& d, int lane, float (&v)[32]) {
    if (d.kind != 0) return;
    const int nblk = d.Npad / 32, kb = d.item / nblk, nb = d.item % nblk, k0 = 64 * kb, n0 = 32 * nb;
    const int nn = n0 + (lane & 31); const int nnc = nn < d.N ? nn : d.N - 1;
    const float* src = d.W + (size_t)(k0 + (lane >> 5)) * d.ld + nnc;
#pragma unroll
    for (int i = 0; i < 32; ++i) v[i] = src[(size_t)(2 * i) * d.ld];
}
__device__ __forceinline__ void conv_finish(const Args& a, int l, const ConvD& d, int lane, const float (&v)[32], LAS float* scr) {
    unsigned char* wl = a.ws + WS_W + l * W_LAYER;
    if (d.kind == 0) {
        const int nblk = d.Npad / 32, kb = d.item / nblk, nb = d.item % nblk, k0 = 64 * kb, n0 = 32 * nb; const float keep = (n0 + (lane & 31)) < d.N ? 1.f : 0.f;
#pragma unroll
        for (int i = 0; i < 32; ++i) scr[(2 * i + (lane >> 5)) * 33 + (lane & 31)] = v[i] * keep;
        asm volatile("s_waitcnt lgkmcnt(0)" ::: "memory");
        const int c = lane & 7; f32x4 g0 = {1.f, 1.f, 1.f, 1.f}, g1 = {1.f, 1.f, 1.f, 1.f};
        if (d.gain) { g0 = *(const f32x4*)(d.gain + k0 + 8 * c); g1 = *(const f32x4*)(d.gain + k0 + 8 * c + 4); }
#pragma unroll
        for (int j = 0; j < 4; ++j) { const int n = (lane >> 3) + 8 * j; const LAS float* sp = scr + (8 * c) * 33 + n;
            u32x4 o; o.x = cvt_pk_bf16(sp[0 * 33] * g0[0], sp[1 * 33] * g0[1]); o.y = cvt_pk_bf16(sp[2 * 33] * g0[2], sp[3 * 33] * g0[3]); o.z = cvt_pk_bf16(sp[4 * 33] * g1[0], sp[5 * 33] * g1[1]); o.w = cvt_pk_bf16(sp[6 * 33] * g1[2], sp[7 * 33] * g1[3]);
            if (d.img == 0) *(u32x4*)(d.WT + (size_t)(n0 + n) * d.K + k0 + 8 * c) = o;
            else { const int na = n0 + n, rr = na & 127, sg = rr & 31;
                const int R = (rr & ~31) + (d.img == 1 ? ((sg >> 2) & 1) * 16 + (sg >> 3) * 4 + (sg & 3) : sg);
                *(u32x4*)(d.WT + ((size_t)(na >> 7) * (d.K >> 6) + kb) * 8192 + (pg8::lds_byte(R, 8 * c) >> 1)) = o; } }
        asm volatile("s_waitcnt lgkmcnt(0)" ::: "memory");
    } else if (d.kind == 1) {
        const int r = d.item; const int lk = l * 2 + (r >> 5), j0 = (r & 31) * 8; const float* W1 = a.in[I_CW1] + (size_t)lk * 2048 * 256 + j0; const float* pos = a.in[I_CPOS] + (size_t)lk * 2048;
        float acc[8];
#pragma unroll
        for (int e = 0; e < 8; ++e) acc[e] = 0.f;
#pragma unroll 8
        for (int i = 0; i < 32; ++i) { const int k = i * 64 + lane; const float p = pos[k]; const f32x4 w0 = *(const f32x4*)(W1 + (size_t)k * 256), w1 = *(const f32x4*)(W1 + (size_t)k * 256 + 4);
#pragma unroll
            for (int e = 0; e < 4; ++e) { acc[e] += p * w0[e]; acc[4 + e] += p * w1[e]; } }
#pragma unroll
        for (int e = 0; e < 8; ++e) acc[e] = wave_sum(acc[e]);
        if (lane == 0) { float* dst = (float*)(wl + W_B1P) + (lk & 1) * 256 + j0;
#pragma unroll
            for (int e = 0; e < 8; ++e) dst[e] = acc[e] + a.in[I_CB1][lk * 256 + j0 + e]; }
    } else {
        const int r = d.item; const int t = r & 127; const float* wr = a.in[I_SGW] + ((size_t)l * 1024 + r) * 128; float w2[2];
        unsigned* dst = (unsigned*)(wl + W_SG) + ((((size_t)((r >> 7) * 4 + (t >> 5)) * 8 + (lane >> 3)) * 64 + ((lane >> 2) & 1) * 32 + (t & 31)) * 8 + ((lane * 2) & 7)) / 2;
#pragma unroll
        for (int e = 0; e < 2; ++e) { const int p = lane * 2 + e, ks = p >> 4, hh = (p >> 3) & 1, j = p & 7, sidx = 16 * ks + 8 * (j >> 2) + 4 * hh + (j & 3); w2[e] = wr[sidx <= t ? sidx : t]; w2[e] = sidx <= t ? w2[e] : 0.f; }
        *dst = cvt_pk_bf16(w2[0], w2[1]); }
}
__device__ __forceinline__ void convert_layer(const Args& a, int l, int it_lo, int it_hi, int gwl, int ngwl, LAS float* scr, int lane_) {
    int it = it_lo + gwl; if (it >= it_hi) return;
    float vA[32], vB[32];
    { int lane = lane_; asm volatile("" : "+v"(lane)); conv_load(conv_desc(a, l, it), lane, vA); }
#pragma unroll 1
    for (;;) { int lane = lane_; asm volatile("" : "+v"(lane));
        const int itB = it + ngwl; if (itB < it_hi) conv_load(conv_desc(a, l, itB), lane, vB);
        conv_finish(a, l, conv_desc(a, l, it), lane, vA, scr);
        if (itB >= it_hi) break;
        const int itA = itB + ngwl; if (itA < it_hi) conv_load(conv_desc(a, l, itA), lane, vA);
        conv_finish(a, l, conv_desc(a, l, itB), lane, vB, scr);
        if (itA >= it_hi) break;
        it = itA; }
}
constexpr int CONV_SPLIT = 3000, CONV_B1 = CONV_ITEMS - CV_B1;
__device__ __forceinline__ void prologue(const Args& a, LAS unsigned char* lds, int gw, int NGW, int wave, int lane) {
    LAS float* scr = (LAS float*)(lds + wave * 16384);
    unsigned char* ws = a.ws; float* ctl = (float*)(ws + WS_CTL);
    const float* x = a.in[I_X]; bf16_t* XB = (bf16_t*)(ws + WS_XB); const float* mem = a.in[I_MEM]; bf16_t* MB = (bf16_t*)(ws + WS_MEMB);
#define PRO_LOADX(r0) do { _Pragma("unroll") for (int q = 0; q < 4; ++q) { const int r_ = (r0) + q * NGW < NTOK ? (r0) + q * NGW : gw; const f32x4* xr_ = (const f32x4*)(x + (size_t)r_ * 1024) + lane; \
        _Pragma("unroll") for (int j = 0; j < 4; ++j) v[q][j] = __builtin_nontemporal_load(xr_ + 64 * j); } } while (0)
#define PRO_PROCX(r0) do { _Pragma("unroll") for (int q = 0; q < 4; ++q) { const int r_ = (r0) + q * NGW; if (r_ < NTOK) { unsigned long long* xb_ = (unsigned long long*)(XB + (size_t)r_ * 1024) + lane; float s_ = 0.f; \
        _Pragma("unroll") for (int j = 0; j < 4; ++j) { const f32x4 w_ = v[q][j]; s_ += (w_[0] * w_[0] + w_[1] * w_[1]) + (w_[2] * w_[2] + w_[3] * w_[3]); xb_[64 * j] = (unsigned long long)cvt_pk_bf16(w_[0], w_[1]) | ((unsigned long long)cvt_pk_bf16(w_[2], w_[3]) << 32); } \
        s_ = wave_sum(s_); if (lane < 16) ((float*)(ws + WS_SSQP))[(size_t)r_ * 16 + lane] = lane == 0 ? s_ : 0.f; } } } while (0)
    f32x4 v[4][4], mv[4]; const bool hasm = gw < 1024;
    PRO_LOADX(gw);
    { const f32x4* xr = (const f32x4*)(mem + (size_t)(hasm ? gw : 0) * 1024) + lane;
#pragma unroll
      for (int j = 0; j < 4; ++j) mv[j] = xr[64 * j]; }
    convert_layer(a, 0, 0, NGW == 2048 ? CV_IN : CONV_ITEMS, gw, NGW, scr, lane);
    PRO_PROCX(gw);
    if (hasm) { unsigned long long* xb = (unsigned long long*)(MB + (size_t)gw * 1024) + lane; float s = 0.f;
#pragma unroll
        for (int j = 0; j < 4; ++j) { const f32x4 w = mv[j]; s += (w[0] * w[0] + w[1] * w[1]) + (w[2] * w[2] + w[3] * w[3]); xb[64 * j] = (unsigned long long)cvt_pk_bf16(w[0], w[1]) | ((unsigned long long)cvt_pk_bf16(w[2], w[3]) << 32); }
        s = wave_sum(s); if (lane == 0) ctl[SSQ_MEM_OFF + gw] = s; }
    for (int r0 = gw + 4 * NGW; r0 < NTOK; r0 += 4 * NGW) { PRO_LOADX(r0); PRO_PROCX(r0); }
#undef PRO_LOADX
#undef PRO_PROCX
    for (int r = gw + NGW; r < 1024; r += NGW) { const f32x4* xr = (const f32x4*)(mem + (size_t)r * 1024) + lane; unsigned long long* xb = (unsigned long long*)(MB + (size_t)r * 1024) + lane; float s = 0.f;
#pragma unroll
        for (int j = 0; j < 4; ++j) { const f32x4 w = xr[64 * j]; s += (w[0] * w[0] + w[1] * w[1]) + (w[2] * w[2] + w[3] * w[3]); xb[64 * j] = (unsigned long long)cvt_pk_bf16(w[0], w[1]) | ((unsigned long long)cvt_pk_bf16(w[2], w[3]) << 32); }
        s = wave_sum(s); if (lane == 0) ctl[SSQ_MEM_OFF + r] = s; }
}

typedef float f32x16 __attribute__((ext_vector_type(16)));
typedef short s16x4 __attribute__((ext_vector_type(4)));
typedef short v4i16_t __attribute__((ext_vector_type(4)));
using pg8::bf16x8;
__device__ __forceinline__ int crow(int r, int hi) { return (r & 3) + 8 * (r >> 2) + 4 * hi; }
__device__ __forceinline__ s16x4 vtr(const LAS char* p) { return __builtin_bit_cast(s16x4, __builtin_amdgcn_ds_read_tr16_b64_v4i16((LAS v4i16_t*)p)); }
#define MFMA32(a, b, c) __builtin_amdgcn_mfma_f32_32x32x16_bf16(a, b, c, 0, 0, 0)
#define VFRAG(lo, hi) (bf16x8){lo[0], lo[1], lo[2], lo[3], hi[0], hi[1], hi[2], hi[3]}
__device__ __forceinline__ unsigned short f2bf(float f) { return (unsigned short)(cvt_pk_bf16(f, 0.f) & 0xffffu); }
__device__ __forceinline__ void st16_pair(bf16_t* p, int hi, u32x2 we, u32x2 wo) {
    const auto sx = __builtin_amdgcn_permlane32_swap(we.x, wo.x, false, false), sy = __builtin_amdgcn_permlane32_swap(we.y, wo.y, false, false);
    u32x4 o; o.x = sx[0]; o.y = sy[0]; o.z = sx[1]; o.w = sy[1];
    *(u32x4*)(p + hi * 8) = o;
}

__device__ __forceinline__ void memk_norm_tile(bf16_t* img, const float* kg, int lane) {
    u32x4 w[16]; float ss = 0.f;
#pragma unroll
    for (int c = 0; c < 16; ++c) w[c] = *(const u32x4*)(img + c * 512 + lane * 8);
#pragma unroll
    for (int c = 0; c < 16; ++c)
#pragma unroll
        for (int e = 0; e < 4; ++e) { const float a0 = __uint_as_float(w[c][e] << 16), a1 = __uint_as_float(w[c][e] & 0xffff0000u); ss += a0 * a0 + a1 * a1; }
    const float rs = rsqrtf(ss * (1.f / 128.f) + 1e-6f);
#pragma unroll
    for (int c = 0; c < 16; ++c) { u32x4 o;
#pragma unroll
        for (int e = 0; e < 4; ++e) o[e] = cvt_pk_bf16(__uint_as_float(w[c][e] << 16) * rs * kg[c * 8 + 2 * e], __uint_as_float(w[c][e] & 0xffff0000u) * rs * kg[c * 8 + 2 * e + 1]);
        *(u32x4*)(img + c * 512 + lane * 8) = o; }
}

__device__ __forceinline__ void memk_norm_item(bf16_t* KVM, const float* kg, int r, int lane) {
    unsigned* p = (unsigned*)(KVM + (size_t)(r >> 2) * 1024 + (r & 3) * 128) + lane; const unsigned w = *p; const float v0 = __uint_as_float(w << 16), v1 = __uint_as_float(w & 0xffff0000u);
    const float ss = wave_sum(v0 * v0 + v1 * v1); const float rs = rsqrtf(ss * (1.f / 128.f) + 1e-6f); *p = cvt_pk_bf16(v0 * rs * kg[2 * lane], v1 * rs * kg[2 * lane + 1]);
}

__device__ __forceinline__ void kprep_tile(bf16_t* img, const float* kgb, int lane) {
    u32x4 w[16];
#pragma unroll
    for (int c = 0; c < 16; ++c) w[c] = *(const u32x4*)(img + (c >> 3) * 4096 + (c & 7) * 512 + lane * 8);
#pragma unroll
    for (int i = 0; i < 2; ++i) { float ss = 0.f;
#pragma unroll
        for (int c = 0; c < 8; ++c)
#pragma unroll
            for (int e = 0; e < 4; ++e) { const float a = __uint_as_float(w[i * 8 + c][e] << 16), b = __uint_as_float(w[i * 8 + c][e] & 0xffff0000u); ss += a * a + b * b; }
        const float rs = rsqrtf(ss * (1.f / 64.f) + 1e-6f);
#pragma unroll
        for (int c = 0; c < 8; ++c) { u32x4 o;
#pragma unroll
            for (int e = 0; e < 4; ++e) { const float a = __uint_as_float(w[i * 8 + c][e] << 16), b = __uint_as_float(w[i * 8 + c][e] & 0xffff0000u); o[e] = cvt_pk_bf16(a * rs * kgb[c * 8 + 2 * e], b * rs * kgb[c * 8 + 2 * e + 1]); }
            *(u32x4*)(img + i * 4096 + c * 512 + lane * 8) = o; } }
}

__device__ __forceinline__ void tokprep4(bf16_t* Q, bf16_t* KV, const float* qg, const float* kg, int t, int S, int lane) {
    u32x4 wq[4]; (void)KV; (void)kg;
#pragma unroll
    for (int i = 0; i < 4; ++i) { const int tt = t + i * S < NTOK ? t + i * S : NTOK - 1; wq[i] = *((const u32x4*)(Q + (size_t)tt * 512) + lane); }
    f32x4 gq0 = *(const f32x4*)(qg + (lane & 7) * 8), gq1 = *(const f32x4*)(qg + (lane & 7) * 8 + 4);
#pragma unroll
    for (int i = 0; i < 4; ++i) { if (t + i * S >= NTOK) break; const int tt = t + i * S;
        { const u32x4 w = wq[i]; float v[8];
#pragma unroll
          for (int e = 0; e < 4; ++e) { v[2 * e] = __uint_as_float(w[e] << 16); v[2 * e + 1] = __uint_as_float(w[e] & 0xffff0000u); }
          float ss = 0.f;
#pragma unroll
          for (int e = 0; e < 8; ++e) ss += v[e] * v[e];
          ss += __shfl_xor(ss, 1); ss += __shfl_xor(ss, 2); ss += __shfl_xor(ss, 4);
          const float rs = rsqrtf(ss * (1.f / 64.f) + 1e-6f) * (0.125f * 1.4426950408889634f);
          u32x4 o; o[0] = cvt_pk_bf16(v[0] * rs * gq0[0], v[1] * rs * gq0[1]); o[1] = cvt_pk_bf16(v[2] * rs * gq0[2], v[3] * rs * gq0[3]); o[2] = cvt_pk_bf16(v[4] * rs * gq1[0], v[5] * rs * gq1[1]); o[3] = cvt_pk_bf16(v[6] * rs * gq1[2], v[7] * rs * gq1[3]);
          *((u32x4*)(Q + (size_t)tt * 512) + lane) = o; }
 }
}
constexpr int SG_STAT = 0, SG_SSQ = 1024, SG_VN = 5120;
__device__ __forceinline__ void sgu_unit(LAS unsigned char* lds, int unit, const bf16_t* U, const bf16_t* Vb, const bf16_t* Wsg, const float* lng, const float* lnb, const float* sgb, bf16_t* MIX) {
    int tid_ = threadIdx.x; asm volatile("" : "+v"(tid_)); const int tid = tid_, lane = tid & 63, g = __builtin_amdgcn_readfirstlane(tid >> 6), r32 = lane & 31, hi = lane >> 5;
    const int tok0 = unit * 128;
    LAS float* STAT = (LAS float*)(lds + SG_STAT); LAS float* SSQA = (LAS float*)(lds + SG_SSQ);
    { const int tl = tid >> 2, part = tid & 3; const u32x4* p = (const u32x4*)(Vb + (size_t)(tok0 + tl) * 512) + part; float s = 0.f, s2 = 0.f; u32x4 wl_[16];
#pragma unroll
      for (int i = 0; i < 16; ++i) wl_[i] = p[4 * i];
#pragma unroll
      for (int i = 0; i < 16; ++i) { const u32x4 w = wl_[i];
#pragma unroll
          for (int e = 0; e < 4; ++e) { const float a = __uint_as_float(w[e] << 16), b = __uint_as_float(w[e] & 0xffff0000u); s += a + b; s2 += a * a + b * b; } }
      s += __shfl_xor(s, 1); s += __shfl_xor(s, 2); s2 += __shfl_xor(s2, 1); s2 += __shfl_xor(s2, 2);
      if (part == 0) { const float mu = s * (1.f / 512.f); const float var = fmaxf(s2 * (1.f / 512.f) - mu * mu, 0.f); STAT[tl * 2] = mu; STAT[tl * 2 + 1] = rsqrtf(var + 1e-6f); }
      }
    __syncthreads();
    const bf16_t* wrow = Wsg + (size_t)g * 4 * 8 * 512 + lane * 8;
    bf16x8 wfa[4][8];
#pragma unroll
    for (int mt = 0; mt < 4; ++mt)
#pragma unroll
        for (int ks = 0; ks < 8; ++ks) if (ks <= 2 * mt + 1) wfa[mt][ks] = *(const bf16x8*)(wrow + (mt * 8 + ks) * 512);
    LAS unsigned char* VN = lds + SG_VN + g * 16384;
    { const int piece = lane & 7; float gg[8], bb[8];
#pragma unroll
      for (int i = 0; i < 8; ++i) { gg[i] = lng[g * 64 + piece * 8 + i]; bb[i] = lnb[g * 64 + piece * 8 + i]; }
      u32x4 wv[16];
#pragma unroll
      for (int it = 0; it < 16; ++it) wv[it] = *(const u32x4*)(Vb + (size_t)(tok0 + it * 8 + (lane >> 3)) * 512 + g * 64 + piece * 8);
#pragma unroll
      for (int it = 0; it < 16; ++it) { const int row = it * 8 + (lane >> 3); const u32x4 w = wv[it]; const float mu = STAT[row * 2], rs = STAT[row * 2 + 1]; u32x4 o;
#pragma unroll
          for (int e = 0; e < 4; ++e) { const float a = (__uint_as_float(w[e] << 16) - mu) * rs * gg[2 * e] + bb[2 * e], b = (__uint_as_float(w[e] & 0xffff0000u) - mu) * rs * gg[2 * e + 1] + bb[2 * e + 1]; o[e] = cvt_pk_bf16(a, b); }
          *(LAS u32x4*)(VN + (piece >> 2) * 8192 + row * 64 + (piece & 3) * 16) = o; } }
    asm volatile("s_waitcnt lgkmcnt(0)" ::: "memory");
    f32x16 acc[2][4];
#pragma unroll
    for (int dh = 0; dh < 2; ++dh)
#pragma unroll
        for (int mt = 0; mt < 4; ++mt)
#pragma unroll
            for (int r = 0; r < 16; ++r) acc[dh][mt][r] = 0.f;
    const LAS char* vb = (const LAS char*)VN + ((lane >> 4) & 1) * 32 + (lane & 3) * 8 + (4 * hi + ((lane & 15) >> 2)) * 64;
    u32x4 ul[2][4];
    { const bf16_t* up = U + (size_t)(tok0 + r32) * 512 + g * 64 + hi * 8;
#pragma unroll
      for (int q = 0; q < 4; ++q) ul[0][q] = *(const u32x4*)(up + (q >> 1) * 32 + (q & 1) * 16); }
#pragma unroll
    for (int ks = 0; ks < 8; ++ks) { bf16x8 vf[2];
#pragma unroll
        for (int dh = 0; dh < 2; ++dh) { const s16x4 lo = vtr(vb + dh * 8192 + ks * 1024), hh = vtr(vb + dh * 8192 + ks * 1024 + 512); vf[dh] = VFRAG(lo, hh); }
#pragma unroll
        for (int mt = 0; mt < 4; ++mt) { if (ks <= 2 * mt + 1) { acc[0][mt] = MFMA32(vf[0], wfa[mt][ks], acc[0][mt]); acc[1][mt] = MFMA32(vf[1], wfa[mt][ks], acc[1][mt]); } } }
#pragma unroll
    for (int mt = 0; mt < 4; ++mt) { const int t = mt * 32 + r32; const float bias = sgb[g * 128 + t]; float ss = 0.f;
        if (mt < 3) { const bf16_t* upn = U + (size_t)(tok0 + t + 32) * 512 + g * 64 + hi * 8;
#pragma unroll
            for (int q = 0; q < 4; ++q) ul[(mt + 1) & 1][q] = *(const u32x4*)(upn + (q >> 1) * 32 + (q & 1) * 16); }
        u32x2 uu8[8];
#pragma unroll
        for (int q = 0; q < 4; ++q) { const u32x4 L = ul[mt & 1][q]; const auto sx = __builtin_amdgcn_permlane32_swap(L.x, L.z, false, false), sy = __builtin_amdgcn_permlane32_swap(L.y, L.w, false, false);
            uu8[(q >> 1) * 4 + (q & 1) * 2].x = sx[0]; uu8[(q >> 1) * 4 + (q & 1) * 2].y = sy[0]; uu8[(q >> 1) * 4 + (q & 1) * 2 + 1].x = sx[1]; uu8[(q >> 1) * 4 + (q & 1) * 2 + 1].y = sy[1]; }
#pragma unroll
        for (int dh = 0; dh < 2; ++dh)
#pragma unroll
            for (int a4 = 0; a4 < 4; ++a4) { const u32x2 w = uu8[dh * 4 + a4];
                const float u0 = __uint_as_float(w.x << 16), u1 = __uint_as_float(w.x & 0xffff0000u), u2 = __uint_as_float(w.y << 16), u3 = __uint_as_float(w.y & 0xffff0000u);
                float x0 = u0 * (acc[dh][mt][4 * a4] + bias), x1 = u1 * (acc[dh][mt][4 * a4 + 1] + bias), x2 = u2 * (acc[dh][mt][4 * a4 + 2] + bias), x3 = u3 * (acc[dh][mt][4 * a4 + 3] + bias);
                acc[dh][mt][4 * a4] = x0; acc[dh][mt][4 * a4 + 1] = x1; acc[dh][mt][4 * a4 + 2] = x2; acc[dh][mt][4 * a4 + 3] = x3; ss += (x0 * x0 + x1 * x1) + (x2 * x2 + x3 * x3); }
        ss += __shfl_xor(ss, 32); if (hi == 0) SSQA[g * 128 + t] = ss; }
    __syncthreads();
#pragma unroll
    for (int mt = 0; mt < 4; ++mt) { const int t = mt * 32 + r32; float sa = 0.f;
#pragma unroll
        for (int w8 = 0; w8 < 8; ++w8) sa += SSQA[w8 * 128 + t];
        const float rs = rsqrtf(sa * (1.f / 512.f) + 1e-6f); bf16_t* op = MIX + (size_t)(tok0 + t) * 1024 + g * 64;
#pragma unroll
        for (int dh = 0; dh < 2; ++dh)
#pragma unroll
            for (int a2 = 0; a2 < 2; ++a2) { u32x2 w[2];
#pragma unroll
                for (int o = 0; o < 2; ++o) { const int a4 = 2 * a2 + o; w[o].x = cvt_pk_bf16(acc[dh][mt][4 * a4] * rs, acc[dh][mt][4 * a4 + 1] * rs); w[o].y = cvt_pk_bf16(acc[dh][mt][4 * a4 + 2] * rs, acc[dh][mt][4 * a4 + 3] * rs); }
                st16_pair(op + dh * 32 + a2 * 16, hi, w[0], w[1]); } }
    __syncthreads();
}

constexpr int A_KB = 0, A_VB = 32768, A_IMPH = 65536, A_LINV = 132096, A_MASK = 133120, A_SSQ = 133632  ;
__device__ __forceinline__ void attn_cmp(LAS unsigned char* lds, const bf16_t* Kb, const bf16_t* Vb, int ntc, const bf16x8 (&qr)[4], f32x16 (&oT)[2], float& lsum,
                                         int kmin, int kmax, int kvh, int wave, int lane, int r32, int hi) {
    const int pitch = 64, hstride = 256 * 64;
    u32x4 sk0, sk1, sv0, sv1;
    const bf16_t* kthr = Kb + wave * 512 + lane * 8; const bf16_t* vthr = Vb + wave * 512 + lane * 8;
    const int sdst = wave * 1024 + lane * 16;
#define A_LD(tile) do { const size_t to_ = (size_t)(tile) * 8192; sk0 = *(const u32x4*)(kthr + to_); sk1 = *(const u32x4*)(kthr + to_ + 4096); sv0 = *(const u32x4*)(vthr + to_); sv1 = *(const u32x4*)(vthr + to_ + 4096); } while (0)
#define A_ST(so) do { *(LAS u32x4*)(lds + A_KB + (so) + sdst) = sk0; *(LAS u32x4*)(lds + A_KB + (so) + 8192 + sdst) = sk1; *(LAS u32x4*)(lds + A_VB + (so) + sdst) = sv0; *(LAS u32x4*)(lds + A_VB + (so) + 8192 + sdst) = sv1; } while (0)
    const LAS char* kbase = (const LAS char*)(lds + A_KB) + kvh * 8192 + hi * 1024 + r32 * 16;
    const LAS char* vbase = (const LAS char*)(lds + A_VB) + kvh * 8192 + ((lane >> 4) & 1) * 32 + (lane & 3) * 8 + (4 * hi + ((lane & 15) >> 2)) * 64;
    LAS float* IMPH = (LAS float*)(lds + A_IMPH) + (wave * 32 + r32) * 65;
    float carry = 0.f;
    A_LD(0); A_ST(0); __syncthreads();
#pragma unroll 1
    for (int tile = 0; tile < ntc; ++tile) {
        const int so = (tile & 1) * 16384;
        if (tile + 1 < ntc) A_LD(tile + 1);
        bf16x8 kf[8];
#pragma unroll
        for (int d0 = 0; d0 < 4; ++d0) { kf[2 * d0] = *(const LAS bf16x8*)(kbase + so + d0 * 2048); kf[2 * d0 + 1] = *(const LAS bf16x8*)(kbase + so + d0 * 2048 + 512); }
        f32x16 p0, p1;
#pragma unroll
        for (int r = 0; r < 16; ++r) { p0[r] = 0.f; p1[r] = 0.f; }
#pragma unroll
        for (int d0 = 0; d0 < 4; ++d0) { p0 = MFMA32(kf[2 * d0], qr[d0], p0); p1 = MFMA32(kf[2 * d0 + 1], qr[d0], p1); }
        const int a = kmin - 64 * tile, bb = kmax - 64 * tile;
#pragma unroll
        for (int r = 0; r < 16; ++r) { p0[r] = __builtin_amdgcn_exp2f(p0[r]); p1[r] = __builtin_amdgcn_exp2f(p1[r]); }
        if (!__all(a <= 0 && bb >= 63)) { const unsigned span = (unsigned)(bb - a);
#pragma unroll
            for (int r = 0; r < 16; ++r) { const int rel = crow(r, hi); p0[r] = ((unsigned)(rel - a) <= span) ? p0[r] : 0.f; p1[r] = ((unsigned)(rel + 32 - a) <= span) ? p1[r] : 0.f; } }
        { float s = 0.f;
#pragma unroll
          for (int r = 0; r < 16; ++r) s += p0[r] + p1[r];
          lsum += s; }
        { float own[2][4], rcv[2][4];
#pragma unroll
          for (int a4 = 0; a4 < 4; ++a4) { const float h0 = 0.5f * p0[4 * a4 + 3], h1 = 0.5f * p1[4 * a4 + 3];
              own[0][a4] = (p0[4 * a4] + p0[4 * a4 + 1]) + (p0[4 * a4 + 2] + h0); own[1][a4] = (p1[4 * a4] + p1[4 * a4 + 1]) + (p1[4 * a4 + 2] + h1);
              rcv[0][a4] = __shfl_xor(h0, 32); rcv[1][a4] = __shfl_xor(h1, 32); }
#pragma unroll
          for (int h2 = 0; h2 < 2; ++h2)
#pragma unroll
              for (int a4 = 0; a4 < 4; ++a4) { const float fromprev = a4 > 0 ? rcv[h2][a4 - 1] : (h2 ? rcv[0][3] : carry);
                  IMPH[16 * tile + 8 * h2 + 2 * a4 + hi] = own[h2][a4] + (hi ? rcv[h2][a4] : fromprev); }
          carry = rcv[1][3]; }
        bf16x8 pa[4];
        { u32x4 w0, w1, w2, w3;
#pragma unroll
          for (int i = 0; i < 4; ++i) { w0[i] = cvt_pk_bf16(p0[2 * i], p0[2 * i + 1]); w1[i] = cvt_pk_bf16(p0[8 + 2 * i], p0[8 + 2 * i + 1]); w2[i] = cvt_pk_bf16(p1[2 * i], p1[2 * i + 1]); w3[i] = cvt_pk_bf16(p1[8 + 2 * i], p1[8 + 2 * i + 1]); }
          pa[0] = __builtin_bit_cast(bf16x8, w0); pa[1] = __builtin_bit_cast(bf16x8, w1); pa[2] = __builtin_bit_cast(bf16x8, w2); pa[3] = __builtin_bit_cast(bf16x8, w3); }
#pragma unroll
        for (int dh = 0; dh < 2; ++dh)
#pragma unroll
            for (int ks = 0; ks < 4; ++ks) { const s16x4 lo = vtr(vbase + so + dh * 4096 + ks * 1024), hh = vtr(vbase + so + dh * 4096 + ks * 1024 + 512); oT[dh] = MFMA32(VFRAG(lo, hh), pa[ks], oT[dh]); }
        if (tile + 1 < ntc) A_ST(so ^ 16384);
        __syncthreads();
    }
#undef A_LD
#undef A_ST
}

constexpr int A2_K = 0, A2_V = 49152, A2_SL = 16384;
#define SBAR() __builtin_amdgcn_sched_barrier(0)
#define PIN(x) asm volatile("" : "+v"(x))
#define WAIT_BAR(N) asm volatile("s_waitcnt vmcnt(" #N ") lgkmcnt(0)\n\ts_barrier" ::: "memory")
__device__ __forceinline__ void glds16(const void* g, unsigned lds_base) {
    unsigned sv; asm volatile("s_mov_b32 %0, m0\n\ts_mov_b32 m0, %2\n\ts_nop 0\n\tglobal_load_lds_dwordx4 %1, off\n\ts_mov_b32 m0, %0" : "=&s"(sv) : "v"(g), "s"(lds_base) : "memory"); }
__device__ __forceinline__ void range_mask(f32x16& c0, f32x16& c1, int a, int bb, int hi) {
    const unsigned span = (unsigned)(bb - a);
#pragma unroll
    for (int r = 0; r < 16; ++r) { const int rel = crow(r, hi); c0[r] = ((unsigned)(rel - a) <= span) ? c0[r] : -INFINITY; c1[r] = ((unsigned)(rel + 32 - a) <= span) ? c1[r] : -INFINITY; }
}
template <bool WIN, int MODE = 0  >
__device__ __forceinline__ void attn_stream(LAS unsigned char* lds, const bf16_t* Kb, const bf16_t* Vb, int tlo, int NT, const bf16x8 (&qr)[4], f32x16 (&oT)[2], float& l_out,
                                            unsigned mlo, unsigned mhi, int tq, int kvh, int wave, int lane, int r32, int hi) {
    const unsigned lds0 = (unsigned)(uintptr_t)lds;
    const bf16_t* ksrc = Kb + wave * 512 + lane * 8;
    const bf16_t* vsrc = Vb + wave * 512 + lane * 8;
    const unsigned kdst = lds0 + A2_K + wave * 1024, vdst = lds0 + A2_V + wave * 1024;
#define RFL(x) ((unsigned)__builtin_amdgcn_readfirstlane((int)(x)))
#define TCL(i) ((size_t)(tlo + ((i) < NT ? (i) : NT - 1)) * 8192)
#define DMA_K(i, slot) do { const bf16_t* s_ = ksrc + TCL(i); glds16(s_, RFL(kdst + (slot))); glds16(s_ + 4096, RFL(kdst + (slot) + 8192)); } while (0)
#define DMA_V(i, slot) do { const bf16_t* s_ = vsrc + TCL(i); glds16(s_, RFL(vdst + (slot))); glds16(s_ + 4096, RFL(vdst + (slot) + 8192)); } while (0)
#define TMASK(idx_, a_, bb_, selm_) do { const int tt_ = tlo + (idx_); if (WIN) { a_ = tq - 511 - 64 * tt_; bb_ = tq - 64 * tt_; selm_ = ~0u; } \
        else { const unsigned s_ = tt_ < 32 ? (mlo >> tt_) & 1u : (mhi >> (tt_ - 32)) & 1u; a_ = -64 * tt_; bb_ = tq - 64 * tt_; selm_ = 0u - s_; } } while (0)
#define NEEDM(a_, bb_, selm_) (!__all((selm_) == 0u || ((a_) <= 0 && (bb_) >= 63)))
    const LAS char* kp0 = (const LAS char*)(lds + A2_K) + kvh * 8192 + hi * 1024 + r32 * 16;
    const LAS char* vp0 = (const LAS char*)(lds + A2_V) + kvh * 8192 + ((lane >> 4) & 1) * 32 + (lane & 3) * 8 + (4 * hi + ((lane & 15) >> 2)) * 64;
    if constexpr (MODE != 2) {
    asm volatile("s_waitcnt vmcnt(0)" ::: "memory");
    DMA_K(0, 0); DMA_V(0, 0); DMA_K(1, A2_SL); DMA_K(2, 2 * A2_SL); }
    if constexpr (MODE == 1) return;
    float l_reg = 0.f; f32x16 pA0, pA1, pB0, pB1; bf16x8 kf[8]; s16x4 vlo[8], vhi[8]; u32x4 pw0, pw1, pw2, pw3; unsigned selm_prev;
    const f32x16 zero16 = {0.f, 0.f, 0.f, 0.f, 0.f, 0.f, 0.f, 0.f, 0.f, 0.f, 0.f, 0.f, 0.f, 0.f, 0.f, 0.f};
    int sl_prev = 0, sl_cur = 0, sl_next = A2_SL;
#define ROT() do { sl_prev = sl_cur; sl_cur = sl_next; sl_next = (sl_next == 2 * A2_SL) ? 0 : sl_next + A2_SL; } while (0)
#define KLD(kp, d0) do { kf[2 * (d0)] = *(const LAS bf16x8*)((kp) + (d0) * 2048); kf[2 * (d0) + 1] = *(const LAS bf16x8*)((kp) + (d0) * 2048 + 512); } while (0)
    WAIT_BAR(6);
    KLD(kp0, 0); KLD(kp0, 1); KLD(kp0, 2); KLD(kp0, 3);
    pA0 = MFMA32(kf[0], qr[0], zero16); pA1 = MFMA32(kf[1], qr[0], zero16); pA0 = MFMA32(kf[2], qr[1], pA0); pA1 = MFMA32(kf[3], qr[1], pA1);
    pA0 = MFMA32(kf[4], qr[2], pA0); pA1 = MFMA32(kf[5], qr[2], pA1); pA0 = MFMA32(kf[6], qr[3], pA0); pA1 = MFMA32(kf[7], qr[3], pA1);
    { int a_, bb_; TMASK(0, a_, bb_, selm_prev); if (NEEDM(a_, bb_, selm_prev)) range_mask(pA0, pA1, a_, bb_, hi); }
#pragma unroll
    for (int r = 0; r < 16; ++r) { pA0[r] = __builtin_amdgcn_exp2f(pA0[r]); pA1[r] = __builtin_amdgcn_exp2f(pA1[r]); }
    WAIT_BAR(0);
    DMA_K(3, 0); DMA_V(1, A2_SL); ROT();
    KLD(kp0 + sl_cur, 0); KLD(kp0 + sl_cur, 1); KLD(kp0 + sl_cur, 2); KLD(kp0 + sl_cur, 3);
    WAIT_BAR(4);
#define PKW(P, i) cvt_pk_bf16(P[i], P[(i) + 1])
#define PAF(k) __builtin_bit_cast(bf16x8, pw##k)
#define VFR(i) VFRAG(vlo[i], vhi[i])
#define VRD(i) do { vlo[i] = vtr(vp_ + (((i) >> 2) * 4096 + ((i) & 3) * 1024)); vhi[i] = vtr(vp_ + (((i) >> 2) * 4096 + ((i) & 3) * 1024 + 512)); } while (0)
#define KRD(d0) do { KLD(kp0 + sl_next, d0); SBAR(); } while (0)
#define EX(v) __builtin_amdgcn_exp2f(v)
#define GAPA(MF, a0, a1, a2, a3, W0, W1, PW) do { MF; sacc += a0; sacc += a1; sacc += a2; sacc += a3; W0; W1; PIN(PW); PIN(sacc); SBAR(); } while (0)
#define GAPB(MF, X, i) do { MF; X[i] = EX(X[i]); X[(i) + 1] = EX(X[(i) + 1]); X[(i) + 2] = EX(X[(i) + 2]); X[(i) + 3] = EX(X[(i) + 3]); PIN(X); SBAR(); } while (0)
#define SELPW() do { if (!__all(selm_prev == ~0u)) { const u32x4 m_ = {selm_prev, selm_prev, selm_prev, selm_prev}; pw0 = pw0 & m_; pw1 = pw1 & m_; pw2 = pw2 & m_; pw3 = pw3 & m_; } } while (0)
#define STEP(C0, C1, P0, P1, idx) do { SBAR(); \
    const LAS char* vp_ = vp0 + sl_prev; \
    VRD(0); SBAR(); float sacc = P0[0] + P0[1]; \
                    GAPA(C0 = MFMA32(kf[0], qr[0], zero16), P0[2], P0[3], P0[4], P0[5],     pw0[0] = PKW(P0, 0),  pw0[1] = PKW(P0, 2),  pw0); \
    VRD(4); SBAR(); GAPA(C1 = MFMA32(kf[1], qr[0], zero16), P0[6], P0[7], P0[8], P0[9],     pw0[2] = PKW(P0, 4),  pw0[3] = PKW(P0, 6),  pw0); \
    VRD(1); SBAR(); GAPA(C0 = MFMA32(kf[2], qr[1], C0),     P0[10], P0[11], P0[12], P0[13], pw1[0] = PKW(P0, 8),  pw1[1] = PKW(P0, 10), pw1); \
    VRD(5); SBAR(); GAPA(C1 = MFMA32(kf[3], qr[1], C1),     P0[14], P0[15], P1[0], P1[1],   pw1[2] = PKW(P0, 12), pw1[3] = PKW(P0, 14), pw1); \
    VRD(2); SBAR(); GAPA(C0 = MFMA32(kf[4], qr[2], C0),     P1[2], P1[3], P1[4], P1[5],     pw2[0] = PKW(P1, 0),  pw2[1] = PKW(P1, 2),  pw2); \
    VRD(6); SBAR(); GAPA(C1 = MFMA32(kf[5], qr[2], C1),     P1[6], P1[7], P1[8], P1[9],     pw2[2] = PKW(P1, 4),  pw2[3] = PKW(P1, 6),  pw2); \
    VRD(3); SBAR(); GAPA(C0 = MFMA32(kf[6], qr[3], C0),     P1[10], P1[11], P1[12], P1[13], pw3[0] = PKW(P1, 8),  pw3[1] = PKW(P1, 10), pw3); \
    VRD(7); SBAR(); GAPA(C1 = MFMA32(kf[7], qr[3], C1),     P1[14], P1[15], 0.f, 0.f,       pw3[2] = PKW(P1, 12), pw3[3] = PKW(P1, 14), pw3); \
    l_reg += __uint_as_float(__float_as_uint(sacc) & selm_prev); SELPW(); \
    DMA_K((idx) + 3, sl_cur); DMA_V((idx) + 1, sl_next); \
    { int a_, bb_; unsigned selm_; TMASK(idx, a_, bb_, selm_); if (NEEDM(a_, bb_, selm_)) range_mask(C0, C1, a_, bb_, hi); selm_prev = selm_; } \
    SBAR(); \
    GAPB(oT[0] = MFMA32(VFR(0), PAF(0), oT[0]), C0, 0);            GAPB(oT[1] = MFMA32(VFR(4), PAF(0), oT[1]), C0, 4); \
    KRD(0); GAPB(oT[0] = MFMA32(VFR(1), PAF(1), oT[0]), C0, 8);    KRD(1); GAPB(oT[1] = MFMA32(VFR(5), PAF(1), oT[1]), C0, 12); \
    KRD(2); GAPB(oT[0] = MFMA32(VFR(2), PAF(2), oT[0]), C1, 0);    KRD(3); GAPB(oT[1] = MFMA32(VFR(6), PAF(2), oT[1]), C1, 4); \
    GAPB(oT[0] = MFMA32(VFR(3), PAF(3), oT[0]), C1, 8);            GAPB(oT[1] = MFMA32(VFR(7), PAF(3), oT[1]), C1, 12); \
    } while (0)
    int idx = 1;
#pragma unroll 1
    for (; idx + 1 < NT; idx += 2) {
        STEP(pB0, pB1, pA0, pA1, idx);     WAIT_BAR(4); ROT();
        STEP(pA0, pA1, pB0, pB1, idx + 1); WAIT_BAR(4); ROT();
    }
    if (idx < NT) { STEP(pB0, pB1, pA0, pA1, idx); WAIT_BAR(4); ROT(); pA0 = pB0; pA1 = pB1; }
    { float sacc = 0.f;
#pragma unroll
      for (int r = 0; r < 16; ++r) sacc += pA0[r] + pA1[r];
      l_reg += __uint_as_float(__float_as_uint(sacc) & selm_prev);
      pw0 = (u32x4){PKW(pA0, 0), PKW(pA0, 2), PKW(pA0, 4), PKW(pA0, 6)}; pw1 = (u32x4){PKW(pA0, 8), PKW(pA0, 10), PKW(pA0, 12), PKW(pA0, 14)};
      pw2 = (u32x4){PKW(pA1, 0), PKW(pA1, 2), PKW(pA1, 4), PKW(pA1, 6)}; pw3 = (u32x4){PKW(pA1, 8), PKW(pA1, 10), PKW(pA1, 12), PKW(pA1, 14)};
      SELPW();
      const LAS char* vp_ = vp0 + ((NT - 1) % 3) * A2_SL;
#pragma unroll
      for (int i = 0; i < 8; ++i) VRD(i);
      oT[0] = MFMA32(VFR(0), PAF(0), oT[0]); oT[1] = MFMA32(VFR(4), PAF(0), oT[1]); oT[0] = MFMA32(VFR(1), PAF(1), oT[0]); oT[1] = MFMA32(VFR(5), PAF(1), oT[1]);
      oT[0] = MFMA32(VFR(2), PAF(2), oT[0]); oT[1] = MFMA32(VFR(6), PAF(2), oT[1]); oT[0] = MFMA32(VFR(3), PAF(3), oT[0]); oT[1] = MFMA32(VFR(7), PAF(3), oT[1]); }
    WAIT_BAR(0);
    l_out = l_reg;
#undef RFL
#undef TCL
#undef DMA_K
#undef DMA_V
#undef TMASK
#undef NEEDM
#undef ROT
#undef KLD
#undef PKW
#undef PAF
#undef VFR
#undef VRD
#undef KRD
#undef EX
#undef GAPA
#undef GAPB
#undef SELPW
#undef STEP
}

template <int J> __device__ __forceinline__ unsigned tk_partner(unsigned x) {
    if constexpr (J == 1) return (unsigned)__builtin_amdgcn_update_dpp(0, (int)x, 0xB1, 0xF, 0xF, false);
    else if constexpr (J == 2) return (unsigned)__builtin_amdgcn_update_dpp(0, (int)x, 0x4E, 0xF, 0xF, false);
    else if constexpr (J == 4) { const int o = __builtin_amdgcn_update_dpp(0, (int)x, 0x104, 0xF, 0x5, false); return (unsigned)__builtin_amdgcn_update_dpp(o, (int)x, 0x114, 0xF, 0xA, false); }
    else if constexpr (J == 8) return (unsigned)__builtin_amdgcn_update_dpp(0, (int)x, 0x128, 0xF, 0xF, false);
    else return (unsigned)__builtin_amdgcn_ds_swizzle((int)x, 0x1f | (J << 10));
}
template <int PARTS>
__device__ __forceinline__ void attn_unit(LAS unsigned char* lds, int b, int qt, const bf16_t* Q, const bf16_t* KV, const bf16_t* KC, const bf16_t* VC, const float* GL, bf16_t* MIX) {
    int tid_ = threadIdx.x; asm volatile("" : "+v"(tid_)); const int tid = tid_, lane = tid & 63, wave = __builtin_amdgcn_readfirstlane(tid >> 6), r32 = lane & 31, hi = lane >> 5, kvh = wave >> 2;
    const int t0 = qt * 32, tq = t0 + r32; const size_t tok = (size_t)b * T + tq;
    bf16x8 qr[4];
#pragma unroll
    for (int d0 = 0; d0 < 4; ++d0) qr[d0] = *(const bf16x8*)(Q + tok * 512 + wave * 64 + d0 * 16 + hi * 8);
    LAS float* IMPHA = (LAS float*)(lds + A_IMPH); LAS float* LINV = (LAS float*)(lds + A_LINV); LAS unsigned* MASKL = (LAS unsigned*)(lds + A_MASK); LAS float* SSQL = (LAS float*)(lds + A_SSQ);
    const float* glp = GL + tok * 24 + wave * 3;
    const float gl0 = glp[0], gl1 = glp[1], gl2 = glp[2];
    f32x16 tot[2], oT[2];
    const int nvalid = tq >= 31 ? (tq - 31) / 16 + 1 : 0; const int ntc = (2 * qt + 1 + 63) >> 6;
    const int ckmin = nvalid > 0 ? 0 : (1 << 20), ckmax = nvalid > 0 ? nvalid - 1 : (1 << 20);
    const bf16_t* KCb = KC + (size_t)b * 4 * 8192; const bf16_t* VCb = VC + (size_t)b * 4 * 8192;
    float lc = 0.f;
#pragma unroll
    for (int r = 0; r < 16; ++r) { oT[0][r] = 0.f; oT[1][r] = 0.f; }
    if constexpr (PARTS & 1) attn_cmp(lds, KCb, VCb, ntc, qr, oT, lc, ckmin, ckmax, kvh, wave, lane, r32, hi);
    const float g0 = 1.f / (1.f + __expf(-gl0)), g1 = 1.f / (1.f + __expf(-gl1)), g2 = 1.f / (1.f + __expf(-gl2));
    lc += __shfl_xor(lc, 32); const float inv_lc = lc > 0.f ? 1.f / lc : 0.f;
    if (hi == 0) LINV[wave * 32 + r32] = inv_lc;
    const int jmax = (t0 + 31) >> 6;
    const bf16_t* KVb = KV + (size_t)b * 64 * 8192;
    { float dl_ = 0.f;
      if constexpr (PARTS & 4) attn_stream<false, 1>(lds, KVb, KVb + (size_t)256 * 8192, 0, jmax + 1, qr, oT, dl_, 0u, 0u, tq, kvh, wave, lane, r32, hi); }
    { const float c = g0 * inv_lc;
#pragma unroll
      for (int r = 0; r < 16; ++r) { tot[0][r] = oT[0][r] * c; tot[1][r] = oT[1][r] * c; oT[0][r] = 0.f; oT[1][r] = 0.f; } }
    __syncthreads();
    if constexpr (PARTS & 2) {
     if (t0 + 31 < 1024) {
      if (tid < 64) { unsigned ones = 0xffffffffu; asm volatile("" : "+v"(ones)); MASKL[tid * 2] = ones; MASKL[tid * 2 + 1] = ones; }
     } else if (t0 + 31 < 2048) {
      unsigned key[4], srt[4]; const int j = lane & 31;
#pragma unroll
      for (int i = 0; i < 4; ++i) { const int pair = wave * 8 + i * 2 + hi, kvp = pair >> 5, qq = pair & 31; const int tb = (t0 + qq) >> 6; float v = 0.f;
#pragma unroll
          for (int g = 0; g < 4; ++g) v += IMPHA[((kvp * 4 + g) * 32 + qq) * 65 + j] * LINV[(kvp * 4 + g) * 32 + qq];
          const bool forced = (j == 0) || (j == tb) || (j == tb - 1); const float val = forced ? 1e4f : (j <= tb ? v : -1e4f);
          unsigned k = __float_as_uint(val); k ^= (k & 0x80000000u) ? 0xffffffffu : 0x80000000u; key[i] = (k & ~63u) | (unsigned)(63 - j); srt[i] = key[i]; }
#define TK_STAGE(K_, J_) do { const bool keepmax_ = (((j & (K_)) == 0) == ((j & (J_)) == 0)); \
        _Pragma("unroll") for (int i = 0; i < 4; ++i) { const unsigned o_ = tk_partner<(J_)>(srt[i]); \
            const unsigned mx_ = srt[i] > o_ ? srt[i] : o_, mn_ = srt[i] > o_ ? o_ : srt[i]; srt[i] = keepmax_ ? mx_ : mn_; } } while (0)
      TK_STAGE(2, 1);
      TK_STAGE(4, 2); TK_STAGE(4, 1);
      TK_STAGE(8, 4); TK_STAGE(8, 2); TK_STAGE(8, 1);
      TK_STAGE(16, 8); TK_STAGE(16, 4); TK_STAGE(16, 2); TK_STAGE(16, 1);
      TK_STAGE(32, 16); TK_STAGE(32, 8); TK_STAGE(32, 4); TK_STAGE(32, 2); TK_STAGE(32, 1);
#undef TK_STAGE
#pragma unroll
      for (int i = 0; i < 4; ++i) { const unsigned t0_ = (unsigned)__builtin_amdgcn_readlane((int)srt[i], 15), t1_ = (unsigned)__builtin_amdgcn_readlane((int)srt[i], 47);
          const unsigned long long m = __ballot(key[i] >= (hi ? t1_ : t0_));
          if (lane == 0) { MASKL[(wave * 8 + i * 2) * 2] = (unsigned)m; MASKL[(wave * 8 + i * 2) * 2 + 1] = 0u; MASKL[(wave * 8 + i * 2 + 1) * 2] = (unsigned)(m >> 32); MASKL[(wave * 8 + i * 2 + 1) * 2 + 1] = 0u; } }
     } else {
      unsigned key[8], srt[8];
#pragma unroll
      for (int i = 0; i < 8; ++i) { const int pair = wave * 8 + i, kvp = pair >> 5, qq = pair & 31, j = lane; const int tb = (t0 + qq) >> 6; float v = 0.f;
#pragma unroll
          for (int g = 0; g < 4; ++g) v += IMPHA[((kvp * 4 + g) * 32 + qq) * 65 + j] * LINV[(kvp * 4 + g) * 32 + qq];
          const bool forced = (j == 0) || (j == tb) || (j == tb - 1); const float val = forced ? 1e4f : (j <= tb ? v : -1e4f);
          unsigned k = __float_as_uint(val); k ^= (k & 0x80000000u) ? 0xffffffffu : 0x80000000u; key[i] = (k & ~63u) | (unsigned)(63 - j); srt[i] = key[i]; }
#define TK_STAGE(K_, J_) do { const bool keepmax_ = (((lane & (K_)) == 0) == ((lane & (J_)) == 0)); \
        _Pragma("unroll") for (int i = 0; i < 8; ++i) { const unsigned o_ = (J_) == 32 ? (unsigned)__shfl_xor((int)srt[i], 32) : tk_partner<((J_) == 32 ? 16 : (J_))>(srt[i]); \
            const unsigned mx_ = srt[i] > o_ ? srt[i] : o_, mn_ = srt[i] > o_ ? o_ : srt[i]; srt[i] = keepmax_ ? mx_ : mn_; } } while (0)
      TK_STAGE(2, 1);
      TK_STAGE(4, 2); TK_STAGE(4, 1);
      TK_STAGE(8, 4); TK_STAGE(8, 2); TK_STAGE(8, 1);
      TK_STAGE(16, 8); TK_STAGE(16, 4); TK_STAGE(16, 2); TK_STAGE(16, 1);
      TK_STAGE(32, 16); TK_STAGE(32, 8); TK_STAGE(32, 4); TK_STAGE(32, 2); TK_STAGE(32, 1);
      TK_STAGE(64, 32); TK_STAGE(64, 16); TK_STAGE(64, 8); TK_STAGE(64, 4); TK_STAGE(64, 2); TK_STAGE(64, 1);
#undef TK_STAGE
#pragma unroll
      for (int i = 0; i < 8; ++i) { const unsigned thr = (unsigned)__builtin_amdgcn_readlane((int)srt[i], 15);
          const unsigned long long m = __ballot(key[i] >= thr); if (lane == 0) { MASKL[(wave * 8 + i) * 2] = (unsigned)m; MASKL[(wave * 8 + i) * 2 + 1] = (unsigned)(m >> 32); } } } }
    __syncthreads();
    const unsigned mlo = MASKL[(kvh * 32 + r32) * 2], mhi = MASKL[(kvh * 32 + r32) * 2 + 1];
    unsigned totp[16];
#pragma unroll
    for (int i = 0; i < 8; ++i) { totp[i] = cvt_pk_bf16(tot[0][2 * i], tot[0][2 * i + 1]); totp[8 + i] = cvt_pk_bf16(tot[1][2 * i], tot[1][2 * i + 1]); }
    float ls = 0.f;
    if constexpr (PARTS & 4) attn_stream<false, 2>(lds, KVb, KVb + (size_t)256 * 8192, 0, jmax + 1, qr, oT, ls, mlo, mhi, tq, kvh, wave, lane, r32, hi);
    ls += __shfl_xor(ls, 32);
    { const float c = ls > 0.f ? g1 / ls : 0.f;
#pragma unroll
      for (int i = 0; i < 8; ++i) { totp[i] = cvt_pk_bf16(__uint_as_float(totp[i] << 16) + oT[0][2 * i] * c, __uint_as_float(totp[i] & 0xffff0000u) + oT[0][2 * i + 1] * c);
                                    totp[8 + i] = cvt_pk_bf16(__uint_as_float(totp[8 + i] << 16) + oT[1][2 * i] * c, __uint_as_float(totp[8 + i] & 0xffff0000u) + oT[1][2 * i + 1] * c); }
#pragma unroll
      for (int r = 0; r < 16; ++r) { oT[0][r] = 0.f; oT[1][r] = 0.f; } }
    float lw = 0.f; const int jlo = t0 >= 511 ? (t0 - 511) >> 6 : 0;
    if constexpr (PARTS & 8) attn_stream<true>(lds, KVb + (size_t)512 * 8192, KVb + (size_t)768 * 8192, jlo, jmax - jlo + 1, qr, oT, lw, 0u, 0u, tq, kvh, wave, lane, r32, hi);
    lw += __shfl_xor(lw, 32);
    { const float c = lw > 0.f ? g2 / lw : 0.f;
#pragma unroll
      for (int i = 0; i < 8; ++i) { tot[0][2 * i] = __uint_as_float(totp[i] << 16) + oT[0][2 * i] * c; tot[0][2 * i + 1] = __uint_as_float(totp[i] & 0xffff0000u) + oT[0][2 * i + 1] * c;
                                    tot[1][2 * i] = __uint_as_float(totp[8 + i] << 16) + oT[1][2 * i] * c; tot[1][2 * i + 1] = __uint_as_float(totp[8 + i] & 0xffff0000u) + oT[1][2 * i + 1] * c; } }
    { float ss = 0.f;
#pragma unroll
      for (int r = 0; r < 16; ++r) ss += tot[0][r] * tot[0][r] + tot[1][r] * tot[1][r];
      ss += __shfl_xor(ss, 32); if (hi == 0) SSQL[wave * 32 + r32] = ss; }
    __syncthreads();
    { float sa = 0.f;
#pragma unroll
      for (int w8 = 0; w8 < 8; ++w8) sa += SSQL[w8 * 32 + r32];
      const float rs = rsqrtf(sa * (1.f / 512.f) + 1e-6f); bf16_t* op = MIX + tok * 1024 + 512 + wave * 64;
#pragma unroll
      for (int dh = 0; dh < 2; ++dh)
#pragma unroll
          for (int a2 = 0; a2 < 2; ++a2) { u32x2 w[2];
#pragma unroll
              for (int o = 0; o < 2; ++o) { const int a4 = 2 * a2 + o; w[o].x = cvt_pk_bf16(tot[dh][4 * a4] * rs, tot[dh][4 * a4 + 1] * rs); w[o].y = cvt_pk_bf16(tot[dh][4 * a4 + 2] * rs, tot[dh][4 * a4 + 3] * rs); }
              st16_pair(op + dh * 32 + a2 * 16, hi, w[0], w[1]); } }
    __syncthreads();
}

__device__ __forceinline__ void memattn_unit(LAS unsigned char* lds, int b, int h, int qt, const bf16_t* QM, const bf16_t* KVM, const float* qg, bf16_t* OM) {
    int tid_ = threadIdx.x; asm volatile("" : "+v"(tid_)); const int tid = tid_, lane = tid & 63, wave = __builtin_amdgcn_readfirstlane(tid >> 6), r32 = lane & 31, hi = lane >> 5;
    const size_t tok = (size_t)b * T + qt * 256 + wave * 32 + r32;
    const bf16_t* Kg = KVM + (size_t)(b * 4 + h) * 65536; const bf16_t* Vg = Kg + 32768;
    u32x4 sk[8], sv[8];
#pragma unroll
    for (int tile = 0; tile < 4; ++tile)
#pragma unroll
        for (int i = 0; i < 2; ++i) { sk[tile * 2 + i] = *(const u32x4*)(Kg + ((tile * 16 + wave * 2 + i) * 64 + lane) * 8); sv[tile * 2 + i] = *(const u32x4*)(Vg + (tile * 1024 + i * 512 + tid) * 8); }
    bf16x8 qr[8];
    { float v[64]; float ss = 0.f;
#pragma unroll
      for (int d0 = 0; d0 < 8; ++d0) { const u32x4 w = *(const u32x4*)(QM + ((((size_t)((b * 4 + h) * 16 + qt) * 8 + wave) * 8 + d0) * 64 + lane) * 8);
#pragma unroll
          for (int i = 0; i < 4; ++i) { const float a = __uint_as_float(w[i] << 16), c = __uint_as_float(w[i] & 0xffff0000u); v[d0 * 8 + 2 * i] = a; v[d0 * 8 + 2 * i + 1] = c; ss += a * a + c * c; } }
      ss += __shfl_xor(ss, 32); const float rs = rsqrtf(ss * (1.f / 128.f) + 1e-6f) * (0.08838834764831845f * 1.4426950408889634f);
#pragma unroll
      for (int d0 = 0; d0 < 8; ++d0) { u32x4 w; const float* gp = qg + d0 * 16 + hi * 8;
#pragma unroll
          for (int i = 0; i < 4; ++i) w[i] = cvt_pk_bf16(v[d0 * 8 + 2 * i] * rs * gp[2 * i], v[d0 * 8 + 2 * i + 1] * rs * gp[2 * i + 1]);
          qr[d0] = __builtin_bit_cast(bf16x8, w); } }
#pragma unroll
    for (int tile = 0; tile < 4; ++tile)
#pragma unroll
        for (int i = 0; i < 2; ++i) { *(LAS u32x4*)(lds + tile * 16384 + (wave * 2 + i) * 1024 + lane * 16) = sk[tile * 2 + i]; *(LAS u32x4*)(lds + 65536 + tile * 16384 + (i * 512 + tid) * 16) = sv[tile * 2 + i]; }
    const LAS char* kbase = (const LAS char*)lds + hi * 1024 + r32 * 16;
    const LAS char* vbase = (const LAS char*)lds + 65536 + ((lane >> 4) & 1) * 32 + (lane & 3) * 8 + (4 * hi + ((lane & 15) >> 2)) * 64;
    f32x16 oT[4]; float lsum = 0.f;
#pragma unroll
    for (int dq = 0; dq < 4; ++dq)
#pragma unroll
        for (int r = 0; r < 16; ++r) oT[dq][r] = 0.f;
    __syncthreads();
#pragma unroll 1
    for (int tile = 0; tile < 4; ++tile) { const int so = tile * 16384;
        f32x16 p0, p1;
#pragma unroll
        for (int r = 0; r < 16; ++r) { p0[r] = 0.f; p1[r] = 0.f; }
#pragma unroll
        for (int d0 = 0; d0 < 8; ++d0) { const bf16x8 k0 = *(const LAS bf16x8*)(kbase + so + d0 * 2048), k1 = *(const LAS bf16x8*)(kbase + so + d0 * 2048 + 512); p0 = MFMA32(k0, qr[d0], p0); p1 = MFMA32(k1, qr[d0], p1); }
        float s = 0.f;
#pragma unroll
        for (int r = 0; r < 16; ++r) { p0[r] = __builtin_amdgcn_exp2f(p0[r]); p1[r] = __builtin_amdgcn_exp2f(p1[r]); s += p0[r] + p1[r]; }
        lsum += s;
        bf16x8 pa[4];
        { u32x4 w0, w1, w2, w3;
#pragma unroll
          for (int i = 0; i < 4; ++i) { w0[i] = cvt_pk_bf16(p0[2 * i], p0[2 * i + 1]); w1[i] = cvt_pk_bf16(p0[8 + 2 * i], p0[8 + 2 * i + 1]); w2[i] = cvt_pk_bf16(p1[2 * i], p1[2 * i + 1]); w3[i] = cvt_pk_bf16(p1[8 + 2 * i], p1[8 + 2 * i + 1]); }
          pa[0] = __builtin_bit_cast(bf16x8, w0); pa[1] = __builtin_bit_cast(bf16x8, w1); pa[2] = __builtin_bit_cast(bf16x8, w2); pa[3] = __builtin_bit_cast(bf16x8, w3); }
#pragma unroll
        for (int dq = 0; dq < 4; ++dq)
#pragma unroll
            for (int ks = 0; ks < 4; ++ks) { const s16x4 lo = vtr(vbase + so + dq * 4096 + ks * 1024), hh = vtr(vbase + so + dq * 4096 + ks * 1024 + 512); oT[dq] = MFMA32(VFRAG(lo, hh), pa[ks], oT[dq]); }
    }
    __syncthreads();
    lsum += __shfl_xor(lsum, 32); const float il = 1.f / lsum; bf16_t* op = OM + tok * 512 + h * 128;
#pragma unroll
    for (int dq = 0; dq < 4; ++dq)
#pragma unroll
        for (int a2 = 0; a2 < 2; ++a2) { u32x2 w[2];
#pragma unroll
            for (int o = 0; o < 2; ++o) { const int a4 = 2 * a2 + o; w[o].x = cvt_pk_bf16(oT[dq][4 * a4] * il, oT[dq][4 * a4 + 1] * il); w[o].y = cvt_pk_bf16(oT[dq][4 * a4 + 2] * il, oT[dq][4 * a4 + 3] * il); }
            st16_pair(op + dq * 32 + a2 * 16, hi, w[0], w[1]); }
}

#define XB_TMO      128
#define XB_XCNT(j)  (256  + 64 * (j))
#define XB_XSUB(j)  (1280 + 64 * (j))
#define XB_XGEN(j)  (2304 + 64 * (j))
#define XB_TOP      3328
#define XB_TOPGEN   3392
#define XCD_BAR_WORDS 3456
#define XB_SPIN_CAP (1u << 18)
__device__ __forceinline__ unsigned xb_ld(unsigned* p)              { return __hip_atomic_load(p, __ATOMIC_RELAXED, __HIP_MEMORY_SCOPE_AGENT); }
__device__ __forceinline__ unsigned xb_add(unsigned* p, unsigned v) { return __hip_atomic_fetch_add(p, v, __ATOMIC_RELAXED, __HIP_MEMORY_SCOPE_AGENT); }
__device__ __forceinline__ unsigned xb_xcc_id() { return (unsigned)__builtin_amdgcn_s_getreg((3 << 11) | 20) & 0xFu; }
#define XB_SPIN(cond, bar) do { unsigned _sp = 0; while (cond) { __builtin_amdgcn_s_sleep(1); \
    if ((++_sp & 255u) == 0u) { if (xb_ld(&(bar)[XB_TMO])) break; if (_sp > XB_SPIN_CAP) { atomicAdd(&(bar)[XB_TMO], 1u); break; } } } } while (0)
struct XcdBarrier { unsigned* bar; unsigned x; volatile LAS unsigned* st; };
__device__ __forceinline__ XcdBarrier xcd_barrier_post(unsigned* bar, volatile LAS unsigned* st) {
    XcdBarrier b; b.bar = bar; b.x = xb_xcc_id(); b.st = st;
    if (threadIdx.x == 0) (void)xb_add(&bar[XB_XCNT(b.x)], 1u);
    return b;
}
__device__ __forceinline__ void xcd_barrier_complete(unsigned* bar, unsigned x, unsigned& nloc, unsigned& nx) {
    const unsigned G = gridDim.x * gridDim.y * gridDim.z;
    unsigned sum, cnt, mine, sp = 0u;
    for (;;) {
        sum = 0u; cnt = 0u; mine = 0u;
#pragma unroll
        for (unsigned j = 0; j < 16; ++j) { const unsigned c = xb_ld(&bar[XB_XCNT(j)]); sum += c; cnt += (c > 0u) ? 1u : 0u; mine = (j == x) ? c : mine; }
        if (sum == G) break;
        __builtin_amdgcn_s_sleep(1);
        if ((++sp & 255u) == 0u) { if (xb_ld(&bar[XB_TMO])) break; if (sp > XB_SPIN_CAP) { atomicAdd(&bar[XB_TMO], 1u); break; } }
    }
    nloc = mine > 0u ? mine : 1u; nx = cnt > 0u ? cnt : 1u;
}
__device__ __forceinline__ void xcd_barrier(const XcdBarrier& b) {
    asm volatile("s_waitcnt vmcnt(0)" ::: "memory");
    __syncthreads();
    if (threadIdx.x == 0) {
        unsigned* bar = b.bar;
        __builtin_amdgcn_s_waitcnt(0);
        unsigned nloc = b.st[0], nx = b.st[1];
        if (nloc == 0u) { xcd_barrier_complete(bar, b.x, nloc, nx); b.st[0] = nloc; b.st[1] = nx; }
        const unsigned old = xb_add(&bar[XB_XSUB(b.x)], 1u);
        const unsigned gen = old / nloc;
        if (old + 1u == (gen + 1u) * nloc) {
            __builtin_amdgcn_fence(__ATOMIC_RELEASE, "agent");
            asm volatile("s_waitcnt vmcnt(0)" ::: "memory");
            const unsigned og = xb_add(&bar[XB_TOP], 1u);
            const unsigned tg = og / nx;
            if (og + 1u == (tg + 1u) * nx) xb_add(&bar[XB_TOPGEN], 1u);
            else XB_SPIN(xb_ld(&bar[XB_TOPGEN]) == tg, bar);
            __builtin_amdgcn_fence(__ATOMIC_ACQUIRE, "agent");
            xb_add(&bar[XB_XGEN(b.x)], 1u);
            asm volatile("s_waitcnt vmcnt(0)" ::: "memory");
        } else {
            XB_SPIN(xb_ld(&bar[XB_XGEN(b.x)]) == gen, bar);
            __builtin_amdgcn_fence(__ATOMIC_ACQUIRE, "agent");
            asm volatile("s_waitcnt vmcnt(0)" ::: "memory");
        }
    }
    __syncthreads();
}
constexpr size_t CTL_BAR_BYTE = 704 * 1024;
constexpr size_t CTL_FLAG_BYTE = 720 * 1024;
constexpr size_t CTL_MQFLAG_BYTE = 768 * 1024;
constexpr int LDS_ST_OFF = 147456 - 64;

struct EpiCmp {
    static constexpr bool PERM = false, AFTER_DRAIN = true;
    const float* b1p; const bf16_t* w2t; const float* b2; const float* kg0; bf16_t* OUT; float* PART; unsigned* flag; unsigned epoch; int half; int isk;
    __device__ __forceinline__ void fused(f32x4 (&acc)[2][2][4][2], const pg8::Unit&, int wr, int wc, int fr, int fq, LAS unsigned char* lds, int wid, int lane) const {
        unsigned ep = epoch; asm volatile("" : "+s"(ep));
        LAS float* PB = (LAS float*)lds;
        LAS unsigned char* HB = lds;
#pragma unroll
        for (int ai = 0; ai < 2; ++ai)
#pragma unroll
            for (int m = 0; m < 4; ++m) { const int row = ai * 128 + wr * 64 + m * 16 + fr;
#pragma unroll
                for (int n = 0; n < 2; ++n) *(LAS f32x4*)(PB + row * 132 + wc * 32 + n * 16 + 4 * fq) = acc[ai][1][m][n]; }
        __syncthreads();
        const int r32 = lane & 31, hi = lane >> 5;
        bf16x8 a0[8], a1[8], bf[8];
#pragma unroll
        for (int ks = 0; ks < 8; ++ks) { a0[ks] = *(const bf16x8*)(w2t + (size_t)r32 * 256 + half * 128 + ks * 16 + hi * 8); a1[ks] = *(const bf16x8*)(w2t + (size_t)(32 + r32) * 256 + half * 128 + ks * 16 + hi * 8); }
        f32x4 bbv[2];
#pragma unroll
        for (int n = 0; n < 2; ++n) bbv[n] = *(const f32x4*)(b1p + half * 128 + wc * 32 + n * 16 + 4 * fq);
        u32x2 hv[2][4][2];
#pragma unroll
        for (int ai = 0; ai < 2; ++ai)
#pragma unroll
            for (int m = 0; m < 4; ++m) { const int row = ai * 128 + wr * 64 + m * 16 + fr;
#pragma unroll
                for (int n = 0; n < 2; ++n) { const int col = wc * 32 + n * 16 + 4 * fq; f32x4 pb = {0.f, 0.f, 0.f, 0.f}; if (row < 255) pb = *(const LAS f32x4*)(PB + (row + 1) * 132 + col);
                    const f32x4 bb = bbv[n]; const f32x4 v = acc[ai][0][m][n] + pb + bb;
                    hv[ai][m][n].x = cvt_pk_bf16(pg8::gelu_tanh(v[0]), pg8::gelu_tanh(v[1])); hv[ai][m][n].y = cvt_pk_bf16(pg8::gelu_tanh(v[2]), pg8::gelu_tanh(v[3])); } }
        __syncthreads();
#pragma unroll
        for (int ai = 0; ai < 2; ++ai)
#pragma unroll
            for (int m = 0; m < 4; ++m) { const int row = ai * 128 + wr * 64 + m * 16 + fr;
#pragma unroll
                for (int n = 0; n < 2; ++n) *(LAS u32x2*)(HB + row * 272 + (wc * 32 + n * 16 + 4 * fq) * 2) = hv[ai][m][n]; }
        __syncthreads();
        const int row = wid * 32 + r32;
#pragma unroll
        for (int ks = 0; ks < 8; ++ks) bf[ks] = *(const LAS bf16x8*)(HB + row * 272 + (ks * 16 + hi * 8) * 2);
        f32x16 o2[2];
#pragma unroll
        for (int r = 0; r < 16; ++r) { o2[0][r] = 0.f; o2[1][r] = 0.f; }
#pragma unroll
        for (int ks = 0; ks < 8; ++ks) { o2[0] = MFMA32(a0[ks], bf[ks], o2[0]); o2[1] = MFMA32(a1[ks], bf[ks], o2[1]); }
        float* pp = PART + (size_t)row * 64 + 4 * hi;
        if (half == 1) {
#pragma unroll
            for (int h = 0; h < 2; ++h)
#pragma unroll
                for (int a4 = 0; a4 < 4; ++a4) *(f32x4*)(pp + 32 * h + 8 * a4) = (f32x4){o2[h][4 * a4], o2[h][4 * a4 + 1], o2[h][4 * a4 + 2], o2[h][4 * a4 + 3]};
            asm volatile("s_waitcnt vmcnt(0)" ::: "memory"); __syncthreads();
            if (threadIdx.x == 0) { __builtin_amdgcn_fence(__ATOMIC_RELEASE, "agent"); asm volatile("s_waitcnt vmcnt(0)" ::: "memory"); __hip_atomic_store(flag, ep, __ATOMIC_RELAXED, __HIP_MEMORY_SCOPE_AGENT); }
            return; }
        if (wid == 0) { unsigned sp = 0;
            while ((unsigned)__builtin_amdgcn_readfirstlane(__hip_atomic_load(flag, __ATOMIC_RELAXED, __HIP_MEMORY_SCOPE_AGENT)) < ep) { __builtin_amdgcn_s_sleep(2); if (++sp > (1u << 22)) break; }
            __builtin_amdgcn_fence(__ATOMIC_ACQUIRE, "agent"); asm volatile("s_waitcnt vmcnt(0)" ::: "memory"); }
        __syncthreads();
        float ss = 0.f;
#pragma unroll
        for (int h = 0; h < 2; ++h)
#pragma unroll
            for (int a4 = 0; a4 < 4; ++a4) { const f32x4 pv = *(const f32x4*)(pp + 32 * h + 8 * a4); const f32x4 bv = *(const f32x4*)(b2 + 32 * h + 8 * a4 + 4 * hi);
#pragma unroll
                for (int e = 0; e < 4; ++e) { const float v = o2[h][4 * a4 + e] + pv[e] + bv[e]; o2[h][4 * a4 + e] = v; ss += v * v; } }
        if (kg0) { ss += __shfl_xor(ss, 32); const float rs = rsqrtf(ss * (1.f / 64.f) + 1e-6f);
#pragma unroll
            for (int h = 0; h < 2; ++h)
#pragma unroll
                for (int a4 = 0; a4 < 4; ++a4) { const f32x4 gv = *(const f32x4*)(kg0 + 32 * h + 8 * a4 + 4 * hi);
#pragma unroll
                    for (int e = 0; e < 4; ++e) o2[h][4 * a4 + e] *= rs * gv[e]; } }
        const float keep = row == 255 ? 0.f : 1.f;
#pragma unroll
        for (int h = 0; h < 2; ++h)
#pragma unroll
            for (int a4 = 0; a4 < 4; ++a4) { u32x2 w; w.x = cvt_pk_bf16(o2[h][4 * a4] * keep, o2[h][4 * a4 + 1] * keep); w.y = cvt_pk_bf16(o2[h][4 * a4 + 2] * keep, o2[h][4 * a4 + 3] * keep); { const int c = 32 * h + 8 * a4 + 4 * hi, r = row & 63;
                  const int eo = isk ? (c >> 3) * 512 + r * 8 + (c & 7) : ((c >> 5) * 4 + (r >> 4)) * 512 + ((r & 15) * 4 + ((c & 31) >> 3)) * 8 + (c & 7);
                  *(u32x2*)(OUT + (size_t)(row >> 6) * 8192 + eo) = w; } }
    }
};

template <bool PROBE>
__device__ __forceinline__ void do_phase(const int p, const int l, const Args& args, LAS unsigned char* lds, const int G, const int bx, const int NGW) {
    unsigned char* ws = args.ws; float* xout = args.out; asm volatile("" : "+s"(ws), "+s"(xout));
    int tidp = threadIdx.x; asm volatile("" : "+v"(tidp)); const int lane = tidp & 63, wave = __builtin_amdgcn_readfirstlane(tidp >> 6), gw = bx * 8 + wave; (void)lane; (void)gw; (void)NGW;
    float* ctl = (float*)(ws + WS_CTL); bf16_t* XB = (bf16_t*)(ws + WS_XB); float* ssqp = (float*)(ws + WS_SSQP);
    unsigned char* wl = ws + WS_W + l * W_LAYER;
    if (p == 0) {
        pg8::Gemm g = pg8::make_gemm(XB, (const bf16_t*)(wl + W_IN), 1024); pg8::StaticOrder S; S.init(NTOK, INP, G, bx); if (l == 1) S.split_tail();
        pg8::rstd_table(lds, S, ssqp + (size_t)(l == 0 ? 0 : 3) * NTOK * 16, 1.f / 1024.f);
        pg8::EpiInProjT<true> E{(bf16_t*)(ws + WS_U), (bf16_t*)(ws + WS_V), (bf16_t*)(ws + WS_Q), (bf16_t*)(ws + WS_KV), (float*)(ws + WS_GL), ssqp + (size_t)(l == 0 ? 0 : 3) * NTOK * 16, (bf16_t*)(ws + WS_KVC)};
        pg8::gemm_phase<pg8::EpiInProjT<true>, pg8::StaticOrder, true>(lds, g, S, E);
        if (l == 0 && !PROBE && G == 256 && bx >= 128)
            { const int gwl = (bx - 128) * 8 + wave;
              if (gwl < 64) convert_layer(args, 0, CONV_B1, CONV_ITEMS, gwl, 64, (LAS float*)(lds + wave * 16384), lane);
              else convert_layer(args, 0, CV_IN, CONV_B1, gwl - 64, 960, (LAS float*)(lds + wave * 16384), lane); }
    } else if (p == 1) {
      const int nmk = (l == 1 && !PROBE) ? 32 : 16, sg0 = 32 + nmk, tk0 = sg0 + 128, ntw = (256 - tk0) * 8;
      for (int vb = bx; vb < 256; vb += G) {
        if (PROBE && !((MK_P1_ROLES >> (vb < 32 ? 0 : vb < 48 ? 1 : vb < 176 ? 2 : 3)) & 1)) continue;
        if (vb < 32) { if constexpr (!PROBE || (MK_P1_ROLES & 1)) { const int kv = vb >> 4, pm = (vb >> 1) & 7, half = vb & 1;
            pg8::Gemm g; g.aimg = 0; g.A = (const bf16_t*)(ws + WS_KVC) + (size_t)(kv * 2) * NTOK * 64; g.Bt = (const bf16_t*)(wl + W_C1 + (size_t)kv * 512 * 1024 * 2); g.K = 1024; g.lda = 16 * 64; g.kstepA = 64 * 2; g.a_s0 = (size_t)NTOK * 64 * 2; g.a_s1 = (size_t)T * 64 * 2;
            pg8::OneUnit S{1, {pm, half, 0}};
            EpiCmp E{(const float*)(wl + W_B1P) + kv * 256, (const bf16_t*)(wl + W_C2) + (size_t)kv * 64 * 256, args.in[I_CB2] + l * 128 + kv * 64, kv == 0 ? args.in[I_KNG] + l * 192 : (const float*)nullptr,
                     (bf16_t*)(ws + (kv ? WS_VC : WS_KC)) + (size_t)(pm >> 1) * 4 * 8192 + (pm & 1) * 4096, (float*)(ws + WS_HID) + (size_t)(kv * 8 + pm) * 256 * 64, (unsigned*)(ws + WS_CTL + CTL_FLAG_BYTE) + (kv * 8 + pm) * 64, (unsigned)(l + 1), half, kv == 0};
            pg8::gemm_phase<EpiCmp, pg8::OneUnit, false>(lds, g, S, E); }
        } else if (vb < sg0) { if constexpr (!PROBE || (MK_P1_ROLES & 2)) { const int i = vb - 32;
            pg8::Gemm g = pg8::make_gemm((const bf16_t*)(ws + WS_MEMB), (const bf16_t*)(wl + W_MKV), 1024); pg8::OneUnit S{1, {nmk == 32 ? i >> 3 : i >> 2, nmk == 32 ? (i >> 1) & 3 : i & 3, nmk == 32 ? 1 + (i & 1) : 0}};
            pg8::EpiBf16G<0> E{(bf16_t*)(ws + WS_KVM), 1024, nullptr, ctl + SSQ_MEM_OFF, 1.f / 1024.f, 1, 2};
            pg8::gemm_phase<pg8::EpiBf16G<0>, pg8::OneUnit, true>(lds, g, S, E);
            if (S.u.pn < 2) {
                asm volatile("s_waitcnt vmcnt(0)" ::: "memory"); __syncthreads();
                const int nh = S.u.hs ? 1 : 2, h0 = S.u.pn * 2 + (S.u.hs == 2 ? 1 : 0); int ln3 = lane; asm volatile("" : "+v"(ln3));
                for (int it = wave; it < nh * 4; it += 8) memk_norm_tile((bf16_t*)(ws + WS_KVM) + (size_t)(S.u.pm * 4 + h0 + (it >> 2)) * 65536 + (it & 3) * 8192, args.in[I_MKG] + l * 128, ln3); } }
        } else if (vb < tk0) { if constexpr (!PROBE || (MK_P1_ROLES & 4))
            sgu_unit(lds, vb - sg0, (const bf16_t*)(ws + WS_U), (const bf16_t*)(ws + WS_V), (const bf16_t*)(wl + W_SG), args.in[I_SGLNG] + l * 512, args.in[I_SGLNB] + l * 512, args.in[I_SGB] + l * 1024, (bf16_t*)(ws + WS_MIX));
        } else {
            int ln2 = lane; asm volatile("" : "+v"(ln2));
            for (int it = (vb - tk0) * 8 + wave; it < 512; it += ntw)
                kprep_tile((bf16_t*)(ws + WS_KV) + ((size_t)((it & 1) * 2) * 256 + (it >> 1)) * 8192, args.in[I_KNG] + l * 192 + (1 + (it & 1)) * 64, ln2);
            for (int t = (vb - tk0) * 8 + wave; t < NTOK; t += 4 * ntw) tokprep4((bf16_t*)(ws + WS_Q), (bf16_t*)(ws + WS_KV), args.in[I_QNG] + l * 64, args.in[I_KNG] + l * 192, t, ntw, ln2);
            if (l == 0 && !PROBE) convert_layer(args, 1, 0, CONV_SPLIT, (vb - 176) * 8 + wave, 80 * 8, (LAS float*)(lds + wave * 16384), ln2);
        } }
    } else if (p == 3) {
        for (int i = bx; i < 256; i += G) { const int b = (i & 7) >> 1, idx = (i >> 3) * 2 + (i & 1);
            attn_unit<15>(lds, b, idx, (const bf16_t*)(ws + WS_Q), (const bf16_t*)(ws + WS_KV), (const bf16_t*)(ws + WS_KC), (const bf16_t*)(ws + WS_VC), (const float*)(ws + WS_GL), (bf16_t*)(ws + WS_MIX));
            attn_unit<15>(lds, b, 127 - idx, (const bf16_t*)(ws + WS_Q), (const bf16_t*)(ws + WS_KV), (const bf16_t*)(ws + WS_KC), (const bf16_t*)(ws + WS_VC), (const float*)(ws + WS_GL), (bf16_t*)(ws + WS_MIX)); }
    } else if (p == 6) {
        for (int i = bx; i < 256; i += G) { const int b = (i & 7) >> 1, rest = (i >> 3) * 2 + (i & 1);
            if (!PROBE) { const int h_ = rest >> 4, qt_ = rest & 15;
                if (wave == 0) { unsigned* fl = (unsigned*)(ws + WS_CTL + CTL_MQFLAG_BYTE) + ((b * 16 + qt_) * 4 + h_) * 32; unsigned sp = 0;
                    while ((unsigned)__builtin_amdgcn_readfirstlane(__hip_atomic_load(fl, __ATOMIC_RELAXED, __HIP_MEMORY_SCOPE_AGENT)) < (unsigned)(l + 1)) { __builtin_amdgcn_s_sleep(2); if (++sp > (1u << 22)) break; }
                    __builtin_amdgcn_fence(__ATOMIC_ACQUIRE, "agent"); asm volatile("s_waitcnt vmcnt(0)" ::: "memory"); }
                __syncthreads(); }
            memattn_unit(lds, b, rest >> 4, rest & 15, (const bf16_t*)(ws + WS_QM), (const bf16_t*)(ws + WS_KVM), args.in[I_MQG] + l * 128, (bf16_t*)(ws + WS_OM)); }
    } else if (p == 4) {
        pg8::Gemm g = pg8::make_gemm((const bf16_t*)(ws + WS_MIX), (const bf16_t*)(wl + W_OUT), 1024); pg8::StaticOrder S; S.init(NTOK, 1024, G, bx);
        pg8::EpiResid E{nullptr, XB, ssqp + (size_t)(PROBE ? 1 : l * 3 + 1) * NTOK * 16};
        pg8::gemm_phase<pg8::EpiResid, pg8::StaticOrder, true>(lds, g, S, E);
    } else if (p == 5) {
        pg8::Gemm g = pg8::make_gemm(XB, (const bf16_t*)(wl + W_MQ), 1024); pg8::StaticOrder S; S.init(NTOK, 512, G, bx); if (l == 1) S.split_tail();
        pg8::rstd_table(lds, S, ssqp + (size_t)(l * 3 + 1) * NTOK * 16, 1.f / 1024.f);
        pg8::EpiBf16G<0, true> E{(bf16_t*)(ws + WS_QM), 512, nullptr, ssqp + (size_t)(l * 3 + 1) * NTOK * 16, 1.f / 1024.f, 16, 3};
        pg8::gemm_phase<pg8::EpiBf16G<0, true>, pg8::StaticOrder, true>(lds, g, S, E);
        if (!PROBE) {
            asm volatile("s_waitcnt vmcnt(0)" ::: "memory"); __syncthreads();
            if (threadIdx.x == 0) { pg8::Unit u; bool any = false; for (int i = 0; S.next(i, u); ++i) any = true;
                if (any) { __builtin_amdgcn_fence(__ATOMIC_RELEASE, "agent"); asm volatile("s_waitcnt vmcnt(0)" ::: "memory");
                    for (int i = 0; S.next(i, u); ++i) { unsigned* fl = (unsigned*)(ws + WS_CTL + CTL_MQFLAG_BYTE) + (u.pm * 4 + u.pn * 2) * 32;
                        if (u.hs != 2) __hip_atomic_store(fl, (unsigned)(l + 1), __ATOMIC_RELAXED, __HIP_MEMORY_SCOPE_AGENT);
                        if (u.hs != 1) __hip_atomic_store(fl + 32, (unsigned)(l + 1), __ATOMIC_RELAXED, __HIP_MEMORY_SCOPE_AGENT); } } } }
        if (l == 0 && !PROBE) { const int nidle = G > 128 ? G - 128 : 0;
            if (nidle == 0) convert_layer(args, 1, CONV_SPLIT, CONV_ITEMS, gw, NGW, (LAS float*)(lds + wave * 16384), lane);
            else if (bx >= 128) { const int gwl = (bx - 128) * 8 + wave;
                if (gwl < 64) convert_layer(args, 1, CONV_B1, CONV_ITEMS, gwl, 64, (LAS float*)(lds + wave * 16384), lane);
                else convert_layer(args, 1, CONV_SPLIT, CONV_B1, gwl - 64, nidle * 8 - 64, (LAS float*)(lds + wave * 16384), lane); } }
    } else if (p == 7) {
        pg8::Gemm g = pg8::make_gemm((const bf16_t*)(ws + WS_OM), (const bf16_t*)(wl + W_MO), 512); pg8::StaticOrder S; S.init(NTOK, 1024, G, bx);
        pg8::EpiResid E{nullptr, XB, ssqp + (size_t)(PROBE ? 1 : l * 3 + 2) * NTOK * 16};
        pg8::gemm_phase<pg8::EpiResid, pg8::StaticOrder, true>(lds, g, S, E);
    } else if (p == 8) {
        pg8::Gemm g = pg8::make_gemm(XB, (const bf16_t*)(wl + W_FF1), 1024); pg8::StaticOrder S; S.init(NTOK, FF, G, bx); S.wg = 4;
        pg8::rstd_table(lds, S, ssqp + (size_t)(l * 3 + 2) * NTOK * 16, 1.f / 1024.f);
        pg8::EpiBf16G<2, true> E{(bf16_t*)(ws + WS_HB), FF, nullptr, ssqp + (size_t)(l * 3 + 2) * NTOK * 16, 1.f / 1024.f, 16, 1};
        pg8::gemm_phase<pg8::EpiBf16G<2, true>, pg8::StaticOrder, true>(lds, g, S, E);
    } else if (p == 9) {
        pg8::Gemm g = pg8::make_gemm((const bf16_t*)(ws + WS_HB), (const bf16_t*)(wl + W_FF2), FF); g.aimg = 1; g.kstepA = 16384; pg8::StaticOrder S; S.init(NTOK, 1024, G, bx);
        pg8::EpiResid E{(l == 0 || PROBE) ? (float*)nullptr : xout, XB, ssqp + (size_t)(PROBE ? 1 : 3) * NTOK * 16};
        pg8::gemm_phase<pg8::EpiResid, pg8::StaticOrder, true>(lds, g, S, E);
    }
}

constexpr int LDS_BYTES = 147456;
__global__ void __launch_bounds__(512, 2) mega(Args args) {
    extern __shared__ __attribute__((aligned(16))) unsigned char lds_raw[];
    LAS unsigned char* lds = (LAS unsigned char*)lds_raw;
    const int G = gridDim.x, bx = blockIdx.x, NGW = G * 8;
    volatile LAS unsigned* bar_st = (volatile LAS unsigned*)(lds + LDS_ST_OFF);
    if (threadIdx.x < 2) bar_st[threadIdx.x] = 0u;
    __syncthreads();
    XcdBarrier xbar = xcd_barrier_post((unsigned*)(args.ws + WS_CTL + CTL_BAR_BYTE), bar_st);
    if (args.ph_lo == 0) { const int tid0 = threadIdx.x, wave0 = __builtin_amdgcn_readfirstlane(tid0 >> 6); for (int e_ = 0; e_ < 1 + MK_PROBE_PRO; ++e_) prologue(args, lds, bx * 8 + wave0, NGW, wave0, tid0 & 63); }
    for (int ph = args.ph_lo > 1 ? args.ph_lo : 1; ph < args.ph_hi; ++ph) {
        if ((ph - 1) % 10 == 2) continue;
        if (ph > args.ph_lo && (ph - 1) % 10 != 6) {
            xcd_barrier(xbar); }
        do_phase<false>((ph - 1) % 10, (ph - 1) / 10, args, lds, G, bx, NGW);
    }
#if MK_PROBE_N > 0
    if (args.ph_hi == 21) {
        xcd_barrier(xbar); do_phase<false>(0, 1, args, lds, G, bx, NGW);
        xcd_barrier(xbar); do_phase<false>(1, 1, args, lds, G, bx, NGW);
        for (int e_ = 0; e_ < MK_PROBE_N; ++e_) { xcd_barrier(xbar);
#if MK_PROBE_KIND == 100
            { int tidp = threadIdx.x; asm volatile("" : "+v"(tidp)); const int w_ = __builtin_amdgcn_readfirstlane(tidp >> 6); convert_layer(args, 1, 0, CONV_ITEMS, bx * 8 + w_, NGW, (LAS float*)(lds + w_ * 16384), tidp & 63); }
#elif MK_PROBE_KIND == 33
            for (int i = bx; i < 256; i += G) { const int b = (i & 7) >> 1, idx = (i >> 3) * 2 + (i & 1); unsigned char* ws = args.ws;
                attn_unit<MK_PROBE_PARTS>(lds, b, 127 - idx, (const bf16_t*)(ws + WS_Q), (const bf16_t*)(ws + WS_KV), (const bf16_t*)(ws + WS_KC), (const bf16_t*)(ws + WS_VC), (const float*)(ws + WS_GL), (bf16_t*)(ws + WS_MIX));
                attn_unit<MK_PROBE_PARTS>(lds, b, idx, (const bf16_t*)(ws + WS_Q), (const bf16_t*)(ws + WS_KV), (const bf16_t*)(ws + WS_KC), (const bf16_t*)(ws + WS_VC), (const float*)(ws + WS_GL), (bf16_t*)(ws + WS_MIX)); }
#elif MK_PROBE_KIND == 34
            { unsigned char* ws = args.ws; unsigned char* wl = ws + WS_W + W_LAYER;
              for (int vb = bx; vb < 256; vb += G) if (vb >= 48 && vb < 176) sgu_unit(lds, vb - 48, (const bf16_t*)(ws + WS_U), (const bf16_t*)(ws + WS_V), (const bf16_t*)(wl + W_SG), args.in[I_SGLNG] + 512, args.in[I_SGLNB] + 512, args.in[I_SGB] + 1024, (bf16_t*)(ws + WS_MIX)); }
#elif MK_PROBE_KIND == 35
            { unsigned char* ws = args.ws; int tidp = threadIdx.x; asm volatile("" : "+v"(tidp)); const int w_ = __builtin_amdgcn_readfirstlane(tidp >> 6);
              for (int vb = bx; vb < 256; vb += G) if (vb >= 176) for (int t = (vb - 176) * 8 + w_; t < NTOK; t += 4 * 640) tokprep4((bf16_t*)(ws + WS_Q), (bf16_t*)(ws + WS_KV), args.in[I_QNG] + 64, args.in[I_KNG] + 192, t, 640, tidp & 63); }
#elif MK_PROBE_KIND != 99
            do_phase<true>(MK_PROBE_KIND, 1, args, lds, G, bx, NGW);
#endif
        }
    }
#endif
}

}

#ifndef MK_FUSED
#define MK_FUSED 1
#endif
extern "C" void kernel_launch(void* const* d_in, const int* in_sizes, int n_in, void* d_out, int out_size, void* d_ws, size_t ws_size, hipStream_t stream) {
    using namespace mk;
    static int grid = 0;
    if (!grid) { (void)hipFuncSetAttribute((const void*)mega, hipFuncAttributeMaxDynamicSharedMemorySize, LDS_BYTES);
        int dev = 0, cus = 0, per_cu = 0; (void)hipGetDevice(&dev); (void)hipDeviceGetAttribute(&cus, hipDeviceAttributeMultiprocessorCount, dev);
        (void)hipOccupancyMaxActiveBlocksPerMultiprocessor(&per_cu, (const void*)mega, 512, LDS_BYTES);
        grid = cus * (per_cu < 1 ? 1 : per_cu); if (grid > 256) grid = 256; }
    Args a{}; for (int i = 0; i < 27; ++i) a.in[i] = (const float*)d_in[i]; a.out = (float*)d_out; a.ws = (unsigned char*)d_ws;
#if MK_FUSED
    (void)hipMemsetAsync((unsigned char*)d_ws + WS_CTL + CTL_BAR_BYTE, 0, 96 * 1024, stream);
    a.ph_lo = 0; a.ph_hi = 21; void* kargs[] = {&a};
    (void)hipLaunchCooperativeKernel((const void*)mega, dim3(grid), dim3(512), kargs, LDS_BYTES, stream);
#else
    for (int ph = 0; ph < 21; ++ph) { a.ph_lo = ph; a.ph_hi = ph + 1; hipLaunchKernelGGL(mega, dim3(grid), dim3(512), LDS_BYTES, stream, a); }
#endif
}
```
